# Optimizing an MI355X kernel written in HIP

```python
import math
import jax, jax.numpy as jnp
from jax import lax
import numpy as np

D_MODEL = 1024
BATCH = 2
SEQ = 8192
DEPTH = 2

N_EVEN = (DEPTH + 1) // 2
N_ODD = DEPTH // 2
MIX_WIDTH = D_MODEL
HEAD_DIM = 64
GMLP_GROUPS = 4
GMLP_CHUNK = 128
GMLP_DIM = MIX_WIDTH // 2 // GMLP_GROUPS
GMLP_WIDTH = GMLP_GROUPS * GMLP_DIM
MOBA_HEADS = (MIX_WIDTH // 2) // HEAD_DIM
MOBA_WIDTH = MOBA_HEADS * HEAD_DIM
MOBA_BLOCK = 256
MOBA_TOPK = 3
MOBA_Q_BLOCK = 64
ROPE_THETA = 500000.0
ROPE_DIM = HEAD_DIM // 4
SB_HEADS = MIX_WIDTH // HEAD_DIM
SB_Q_BLOCK = 128
PEER_HEADS = 8
PEER_NKEYS = 128
PEER_NEXPERTS = PEER_NKEYS * PEER_NKEYS
PEER_DKEY = 256
PEER_TOPK = 16
PEER_TOKEN_CHUNK = 128
EVEN_IN = 2 * GMLP_WIDTH + 3 * MOBA_WIDTH
ODD_IN = 3 * SB_HEADS * HEAD_DIM
EPS = 1e-6

kernel_name = "hybrid_gmlp_moba_stickbreak_peer"


def rmsnorm(x, g):
    xf = x.astype(jnp.float32)
    y = xf * lax.rsqrt(jnp.mean(xf * xf, axis=-1, keepdims=True) + EPS)
    return (y * g.astype(jnp.float32)).astype(x.dtype)


def partial_rope(x, pos):
    half = ROPE_DIM // 2
    inv_freq = ROPE_THETA ** (-jnp.arange(half, dtype=jnp.float32) / half)
    ang = pos.astype(jnp.float32)[:, None] * inv_freq[None, :]
    cos = jnp.cos(ang)[None, :, None, :]
    sin = jnp.sin(ang)[None, :, None, :]
    xr = x[..., :ROPE_DIM].astype(jnp.float32)
    x1, x2 = xr[..., :half], xr[..., half:]
    rot = jnp.concatenate([x1 * cos - x2 * sin, x1 * sin + x2 * cos], axis=-1)
    return jnp.concatenate([rot.astype(x.dtype), x[..., ROPE_DIM:]], axis=-1)


def gmlp_spatial_gating(u, v, v_gain, w_s, b_s):
    B_, S_, G, Dg = u.shape
    u = jax.nn.gelu(u)
    v = rmsnorm(jax.nn.gelu(v), v_gain)
    n_chunks = S_ // GMLP_CHUNK
    vc = v.reshape(B_, n_chunks, GMLP_CHUNK, G, Dg)
    causal = jnp.tril(jnp.ones((GMLP_CHUNK, GMLP_CHUNK), dtype=bool))
    w = jnp.where(causal[None], w_s, 0.0).astype(v.dtype)
    mixed = jnp.einsum('gts,bcsgd->bctgd', w, vc) + b_s.T[None, None, :, :, None].astype(v.dtype)
    return u * mixed.reshape(B_, S_, G, Dg)


def moba_attention(q, k, v):
    B_, H, S_, Dh = q.shape
    scale = Dh ** -0.5
    nb = -(-S_ // MOBA_BLOCK)
    k_sel = min(MOBA_TOPK, nb)
    pad = nb * MOBA_BLOCK - S_
    kp = jnp.pad(k, ((0, 0), (0, 0), (0, pad), (0, 0)))
    vp = jnp.pad(v, ((0, 0), (0, 0), (0, pad), (0, 0)))
    kb = kp.reshape(B_, H, nb, MOBA_BLOCK, Dh)
    vb = vp.reshape(B_, H, nb, MOBA_BLOCK, Dh)
    kmean = jnp.mean(kb.astype(jnp.float32), axis=3)
    nq = S_ // MOBA_Q_BLOCK
    qc = q.reshape(B_, H, nq, MOBA_Q_BLOCK, Dh).transpose(2, 0, 1, 3, 4)
    bidx = jnp.arange(B_)[:, None, None, None]
    hidx = jnp.arange(H)[None, :, None, None]
    n_sel = k_sel * MOBA_BLOCK

    def one_block(args):
        ci, qi = args
        q_pos = ci * MOBA_Q_BLOCK + jnp.arange(MOBA_Q_BLOCK)
        own = (ci * MOBA_Q_BLOCK) // MOBA_BLOCK
        gate = jnp.einsum('bhqd,bhnd->bhqn', qi.astype(jnp.float32), kmean)
        gate = jnp.where(jnp.arange(nb) < own, gate, -jnp.inf)
        _, sel = lax.top_k(gate, k_sel)
        sel_valid = jnp.arange(k_sel) < own
        ks = kb[bidx, hidx, sel]
        vs = vb[bidx, hidx, sel]
        s_sel = jnp.einsum('bhqd,bhqnkd->bhqnk', qi, ks).astype(jnp.float32) * scale
        s_sel = jnp.where(sel_valid[:, None], s_sel, -jnp.inf).reshape(B_, H, MOBA_Q_BLOCK, n_sel)
        k_own = lax.dynamic_index_in_dim(kb, own, axis=2, keepdims=False)
        v_own = lax.dynamic_index_in_dim(vb, own, axis=2, keepdims=False)
        key_pos = own * MOBA_BLOCK + jnp.arange(MOBA_BLOCK)
        s_own = jnp.einsum('bhqd,bhkd->bhqk', qi, k_own).astype(jnp.float32) * scale
        s_own = jnp.where(key_pos[None, :] <= q_pos[:, None], s_own, -jnp.inf)
        p = jax.nn.softmax(jnp.concatenate([s_sel, s_own], axis=-1), axis=-1)
        p_sel = p[..., :n_sel].reshape(B_, H, MOBA_Q_BLOCK, k_sel, MOBA_BLOCK).astype(v.dtype)
        p_own = p[..., n_sel:].astype(v.dtype)
        return (jnp.einsum('bhqnk,bhqnkd->bhqd', p_sel, vs)
                + jnp.einsum('bhqk,bhkd->bhqd', p_own, v_own))

    out = lax.map(one_block, (jnp.arange(nq), qc))
    return out.transpose(1, 2, 0, 3, 4).reshape(B_, H, S_, Dh)


def stick_breaking_attention(q, k, v):
    B_, H, S_, Dh = q.shape
    scale = Dh ** -0.5
    nq = S_ // SB_Q_BLOCK
    qc = q.reshape(B_, H, nq, SB_Q_BLOCK, Dh).transpose(2, 0, 1, 3, 4)
    key_pos = jnp.arange(S_)

    def one_block(args):
        ci, qi = args
        q_pos = ci * SB_Q_BLOCK + jnp.arange(SB_Q_BLOCK)
        causal = key_pos[None, :] < q_pos[:, None]
        z = jnp.einsum('bhqd,bhkd->bhqk', qi, k).astype(jnp.float32) * scale
        log_beta = jax.nn.log_sigmoid(z)
        log_one_minus = jnp.where(causal, jax.nn.log_sigmoid(-z), 0.0)
        log_remaining = lax.cumsum(log_one_minus, axis=3, reverse=True) - log_one_minus
        a = jnp.where(causal, jnp.exp(log_beta + log_remaining), 0.0)
        return jnp.einsum('bhqk,bhkd->bhqd', a.astype(v.dtype), v)

    out = lax.map(one_block, (jnp.arange(nq), qc))
    return out.transpose(1, 2, 0, 3, 4).reshape(B_, H, S_, Dh)


def peer_ffn(h, w_q, subkeys, u_tab, v_tab):
    B_, S_, D = h.shape
    q = jnp.einsum('bsd,de->bse', h, w_q).reshape(B_, S_, PEER_HEADS, 2, PEER_DKEY // 2)
    s = jnp.einsum('bshpd,hpnd->bshpn', q, subkeys).astype(jnp.float32)
    s_top, i_top = lax.top_k(s, PEER_TOPK)
    cand = s_top[..., 0, :, None] + s_top[..., 1, None, :]
    cand_idx = i_top[..., 0, :, None] * PEER_NKEYS + i_top[..., 1, None, :]
    n_cand = PEER_TOPK * PEER_TOPK
    best, pos = lax.top_k(cand.reshape(B_, S_, PEER_HEADS, n_cand), PEER_TOPK)
    experts = jnp.take_along_axis(cand_idx.reshape(B_, S_, PEER_HEADS, n_cand), pos, axis=-1)
    gates = jax.nn.softmax(best, axis=-1).astype(h.dtype)
    n_tok = B_ * S_
    nt = n_tok // PEER_TOKEN_CHUNK
    hc = h.reshape(nt, PEER_TOKEN_CHUNK, D)
    ec = experts.reshape(nt, PEER_TOKEN_CHUNK, PEER_HEADS * PEER_TOPK)
    gc = gates.reshape(nt, PEER_TOKEN_CHUNK, PEER_HEADS * PEER_TOPK)

    def one_chunk(args):
        hi, ei, gi = args
        u = u_tab[ei]
        act = jax.nn.gelu(jnp.einsum('td,ted->te', hi, u))
        vv = v_tab[ei]
        return jnp.einsum('te,ted->td', gi * act, vv)

    out = lax.map(one_chunk, (hc, ec, gc))
    return out.reshape(B_, S_, D)


def setup_inputs(seed: int = 0) -> dict:
    key = jax.random.key(seed)
    ks = jax.random.split(key, 20)
    nrm = jax.random.normal
    f32 = jnp.float32
    D = D_MODEL
    return {
        "x": nrm(ks[0], (BATCH, SEQ, D), f32),
        "c": nrm(ks[1], (BATCH, D), f32),
        "w_mod": nrm(ks[2], (DEPTH, D, 6 * D), f32) * (0.5 * D ** -0.5),
        "b_mod": nrm(ks[3], (DEPTH, 6 * D), f32) * 0.02,
        "norm_mix": 1.0 + 0.02 * nrm(ks[4], (DEPTH, D), f32),
        "norm_ffn": 1.0 + 0.02 * nrm(ks[5], (DEPTH, D), f32),
        "even_w_in": nrm(ks[6], (N_EVEN, D, EVEN_IN), f32) * D ** -0.5,
        "gmlp_v_gain": 1.0 + 0.02 * nrm(ks[7], (N_EVEN, GMLP_GROUPS, GMLP_DIM), f32),
        "gmlp_w_s": nrm(ks[8], (N_EVEN, GMLP_GROUPS, GMLP_CHUNK, GMLP_CHUNK), f32) * GMLP_CHUNK ** -0.5,
        "gmlp_b_s": 1.0 + 0.02 * nrm(ks[9], (N_EVEN, GMLP_GROUPS, GMLP_CHUNK), f32),
        "moba_q_gain": 1.0 + 0.02 * nrm(ks[10], (N_EVEN, HEAD_DIM), f32),
        "moba_k_gain": 1.0 + 0.02 * nrm(ks[11], (N_EVEN, HEAD_DIM), f32),
        "even_w_out": nrm(ks[12], (N_EVEN, MIX_WIDTH, D), f32) * MIX_WIDTH ** -0.5,
        "odd_w_in": nrm(ks[13], (N_ODD, D, ODD_IN), f32) * D ** -0.5,
        "odd_w_out": nrm(ks[14], (N_ODD, MIX_WIDTH, D), f32) * MIX_WIDTH ** -0.5,
        "peer_w_q": nrm(ks[15], (DEPTH, D, PEER_HEADS * PEER_DKEY), f32) * D ** -0.5,
        "peer_subkeys": nrm(ks[16], (DEPTH, PEER_HEADS, 2, PEER_NKEYS, PEER_DKEY // 2), f32) * (PEER_DKEY // 2) ** -0.5,
        "peer_u": nrm(ks[17], (DEPTH, PEER_NEXPERTS, D), f32) * D ** -0.5,
        "peer_v": nrm(ks[18], (DEPTH, PEER_NEXPERTS, D), f32),
    }


def reference(x, c, w_mod, b_mod, norm_mix, norm_ffn, even_w_in, gmlp_v_gain, gmlp_w_s,
              gmlp_b_s, moba_q_gain, moba_k_gain, even_w_out, odd_w_in, odd_w_out,
              peer_w_q, peer_subkeys, peer_u, peer_v):
    B_, S_, D = x.shape
    pos = jnp.arange(S_)
    c_act = jax.nn.silu(c)
    split_even = [GMLP_WIDTH, 2 * GMLP_WIDTH, 2 * GMLP_WIDTH + MOBA_WIDTH,
                  2 * GMLP_WIDTH + 2 * MOBA_WIDTH]
    for layer in range(DEPTH):
        i = layer // 2
        mod = (c_act @ w_mod[layer] + b_mod[layer])[:, None, :]
        sh1, sc1, g1, sh2, sc2, g2 = jnp.split(mod, 6, axis=-1)
        h = rmsnorm(x, norm_mix[layer]) * (1.0 + sc1) + sh1
        if layer % 2 == 0:
            proj = h @ even_w_in[i]
            ua, va, qb, kb, vb = jnp.split(proj, split_even, axis=-1)
            ya = gmlp_spatial_gating(ua.reshape(B_, S_, GMLP_GROUPS, GMLP_DIM),
                                     va.reshape(B_, S_, GMLP_GROUPS, GMLP_DIM),
                                     gmlp_v_gain[i], gmlp_w_s[i], gmlp_b_s[i])
            q = partial_rope(rmsnorm(qb.reshape(B_, S_, MOBA_HEADS, HEAD_DIM), moba_q_gain[i]), pos)
            k = partial_rope(rmsnorm(kb.reshape(B_, S_, MOBA_HEADS, HEAD_DIM), moba_k_gain[i]), pos)
            v = vb.reshape(B_, S_, MOBA_HEADS, HEAD_DIM)
            yb = moba_attention(q.transpose(0, 2, 1, 3), k.transpose(0, 2, 1, 3), v.transpose(0, 2, 1, 3))
            y = jnp.concatenate([ya.reshape(B_, S_, GMLP_WIDTH),
                                 yb.transpose(0, 2, 1, 3).reshape(B_, S_, MOBA_WIDTH)], axis=-1) @ even_w_out[i]
        else:
            q, k, v = jnp.split(h @ odd_w_in[i], 3, axis=-1)
            q = q.reshape(B_, S_, SB_HEADS, HEAD_DIM).transpose(0, 2, 1, 3)
            k = k.reshape(B_, S_, SB_HEADS, HEAD_DIM).transpose(0, 2, 1, 3)
            v = v.reshape(B_, S_, SB_HEADS, HEAD_DIM).transpose(0, 2, 1, 3)
            ys = stick_breaking_attention(q, k, v)
            y = ys.transpose(0, 2, 1, 3).reshape(B_, S_, MIX_WIDTH) @ odd_w_out[i]
        x = x + g1 * y
        h = rmsnorm(x, norm_ffn[layer]) * (1.0 + sc2) + sh2
        x = x + g2 * peer_ffn(h, peer_w_q[layer], peer_subkeys[layer], peer_u[layer], peer_v[layer])
    return x
```

```cpp
#include <hip/hip_runtime.h>
#include <cstdio>
#include <cstdint>
#include <cmath>
namespace pg8 {
#define PG8_LAS __attribute__((address_space(3)))
typedef unsigned short bf16_t;
typedef short bf16x8 __attribute__((ext_vector_type(8)));
typedef float f32x4 __attribute__((ext_vector_type(4)));
typedef unsigned u32x4 __attribute__((ext_vector_type(4)));
constexpr int BM = 256, BK = 64, HALF = 128, HTB = HALF * BK * 2  , STAGE_BYTES = 8 * HTB, NXCD = 8, WGM = 8;

__host__ __device__ __forceinline__ int lds_byte(int r, int c) { const int st = (r >> 4) * 2 + (c >> 5), rr = r & 15, cc = c & 31, ob = rr * 64 + cc * 2; return st * 1024 + (ob ^ (((ob >> 9) & 1) << 5)); }
__host__ __device__ __forceinline__ void stage_rc(int b, int& R, int& C) { const int st = b / 1024, sb = b % 1024, swz = sb ^ (((sb >> 9) & 1) << 5); R = (st >> 1) * 16 + swz / 64; C = (st & 1) * 32 + (swz % 64) / 2; }
__host__ __device__ __forceinline__ int perm32(int rho) { const int n = rho >> 4, i = rho & 15; return 8 * (i >> 2) + 4 * n + (i & 3); }

struct Unit { int pm, pn; };
struct Gemm { const bf16_t* A; const bf16_t* Bt; int M, N, K; };

struct StaticOrder {
    int nM, nN, nwg, G, c;
    __host__ __device__ void init(int M, int N, int G_, int c_) { nM = M / BM; nN = N / BM; nwg = nM * nN; G = G_; c = c_; }
    __host__ __device__ bool next(int i, Unit& u) const {
        const long L = (long)i * G + c; if (L >= nwg) return false;
        int wgid = (int)L; { const int q = nwg / NXCD, r = nwg % NXCD, xcd = wgid % NXCD, off = wgid / NXCD; wgid = (xcd < r ? xcd * (q + 1) : r * (q + 1) + (xcd - r) * q) + off; }
        const int nig = WGM * nN, gid = wgid / nig, fm = gid * WGM, gsz = (nM - fm) < WGM ? (nM - fm) : WGM;
        u.pm = fm + ((wgid % nig) % gsz); u.pn = (wgid % nig) / gsz; return true;
    }
    __device__ __forceinline__ void a_ready(const Unit&) const {}
    __device__ __forceinline__ void done(const Unit&) const {}
};

__device__ __forceinline__ unsigned cvt_pk_bf16(float lo, float hi) { unsigned r; asm volatile("v_cvt_pk_bf16_f32 %0, %1, %2" : "=v"(r) : "v"(lo), "v"(hi)); return r; }
typedef float f32x2 __attribute__((ext_vector_type(2)));
__device__ __forceinline__ f32x2 gelu_pk(f32x2 v) {
    const f32x2 av = __builtin_elementwise_abs(v), d = av * 0.2316418882f + 1.0f;
    f32x2 t; t.x = __builtin_amdgcn_rcpf(d.x); t.y = __builtin_amdgcn_rcpf(d.y);
    f32x2 q = t * 0.5307027145f + (-0.7265760135f); q = q * t + 0.7107068705f; q = q * t + (-0.142248368f); q = q * t + 0.127414796f; q = q * t;
    const f32x2 s = (v * v) * (-0.72134752044f);
    f32x2 e; e.x = __builtin_amdgcn_exp2f(s.x); e.y = __builtin_amdgcn_exp2f(s.y);
    const f32x2 m = v * (q * e), r = v - m;
    f32x2 o; o.x = v.x < 0.f ? m.x : r.x; o.y = v.y < 0.f ? m.y : r.y; return o;
}

template <int ACT  > struct EpiBf16 {
    static constexpr bool PERM = true, AFTER_DRAIN = false; static_assert(ACT == 0 || ACT == 1, "EpiBf16: ACT is 0 (none) or 1 (gelu_pk)");
    bf16_t* O; int ldc; const float* bias; int split_cols; size_t split_stride; float scale0;
    __device__ __forceinline__ void operator()(const f32x4 (&acc)[2][2][4][2], const Unit& u, int wr, int wc, int fr, int fq) const {
        const int row0 = u.pm * BM + wr * 64 + fr; int colt = u.pn * BM; bf16_t* base = O;
        float sc = 1.f; if (split_cols) { const int t = colt / split_cols; base += (size_t)t * split_stride; colt -= t * split_cols; if (t == 0) sc = scale0; }
        const int col0 = colt + wc * 32 + 8 * fq, bcol0 = u.pn * BM + wc * 32 + 8 * fq;
        f32x4 bv[2][2];
#pragma unroll
        for (int bj = 0; bj < 2; ++bj)
#pragma unroll
            for (int n = 0; n < 2; ++n) bv[bj][n] = bias ? *(const f32x4*)(bias + bcol0 + bj * HALF + 4 * n) : (f32x4){0.f, 0.f, 0.f, 0.f};
#pragma unroll
        for (int ai = 0; ai < 2; ++ai)
#pragma unroll
            for (int m = 0; m < 4; ++m) { bf16_t* rowp = base + (size_t)(row0 + ai * HALF + m * 16) * ldc + col0;
#pragma unroll
                for (int bj = 0; bj < 2; ++bj) { f32x4 v0 = acc[ai][bj][m][0] + bv[bj][0], v1 = acc[ai][bj][m][1] + bv[bj][1];
                    if (ACT == 1) { f32x2 a = gelu_pk((f32x2){v0[0], v0[1]}), b = gelu_pk((f32x2){v0[2], v0[3]}), c = gelu_pk((f32x2){v1[0], v1[1]}), d = gelu_pk((f32x2){v1[2], v1[3]});
                        v0 = (f32x4){a.x, a.y, b.x, b.y}; v1 = (f32x4){c.x, c.y, d.x, d.y}; }
                    v0 = v0 * sc; v1 = v1 * sc; u32x4 w; w.x = cvt_pk_bf16(v0[0], v0[1]); w.y = cvt_pk_bf16(v0[2], v0[3]); w.z = cvt_pk_bf16(v1[0], v1[1]); w.w = cvt_pk_bf16(v1[2], v1[3]);
                    *(u32x4*)(rowp + bj * HALF) = w; } }
    }
};
constexpr int XSEQ = 8192;
typedef float f32x2e __attribute__((ext_vector_type(2))); typedef __bf16 bf16x2e __attribute__((ext_vector_type(2)));
__device__ __forceinline__ unsigned cvtpk2(float lo, float hi) { f32x2e v = {lo, hi}; bf16x2e b = __builtin_convertvector(v, bf16x2e); return __builtin_bit_cast(unsigned, b); }
__device__ __forceinline__ float gelu_tanh(float x) {
    const float u2 = x * (1.5957691216f + 0.0713548163f * x * x);
    return x * __builtin_amdgcn_rcpf(1.0f + __builtin_amdgcn_exp2f(-1.4426950409f * u2));
}
struct EpiL0m {
    static constexpr bool PERM = true, AFTER_DRAIN = false;
    bf16_t *UA, *VA, *QKR;
    template <bool ACT> __device__ __forceinline__ void tile(const f32x4 (&acc)[2][2][4][2], bf16_t* base, int ldc, int row0, int colt) const {
#pragma unroll
        for (int ai = 0; ai < 2; ++ai)
#pragma unroll
            for (int m = 0; m < 4; ++m) { bf16_t* rowp = base + (size_t)(row0 + ai * HALF + m * 16) * ldc + colt;
#pragma unroll
                for (int bj = 0; bj < 2; ++bj) { f32x4 v0 = acc[ai][bj][m][0], v1 = acc[ai][bj][m][1]; u32x4 w;
                    if (ACT) { v0[0] = gelu_tanh(v0[0]); v0[1] = gelu_tanh(v0[1]); v0[2] = gelu_tanh(v0[2]); v0[3] = gelu_tanh(v0[3]); v1[0] = gelu_tanh(v1[0]); v1[1] = gelu_tanh(v1[1]); v1[2] = gelu_tanh(v1[2]); v1[3] = gelu_tanh(v1[3]); }
                    w.x = cvtpk2(v0[0], v0[1]); w.y = cvtpk2(v0[2], v0[3]); w.z = cvtpk2(v1[0], v1[1]); w.w = cvtpk2(v1[2], v1[3]);
                    *(u32x4*)(rowp + bj * HALF) = w; } }
    }
    __device__ __forceinline__ void operator()(const f32x4 (&acc)[2][2][4][2], const Unit& u, int wr, int wc, int fr, int fq) const {
        const int pn = u.pn; const int row0 = u.pm * BM + wr * 64 + fr; const int cw = wc * 32 + 8 * fq;
        if (pn < 2) tile<true>(acc, UA, 512, row0, pn * 256 + cw);
        else if (pn < 4) tile<true>(acc, VA, 512, row0, (pn - 2) * 256 + cw);
        else tile<false>(acc, QKR, 1024, row0, (pn - 4) * 256 + cw);
    }
};
struct EpiHeads {
    static constexpr bool PERM = true, AFTER_DRAIN = false;
    bf16_t *Q, *Kp; int nh;
    __device__ __forceinline__ void operator()(const f32x4 (&acc)[2][2][4][2], const Unit& u, int wr, int wc, int fr, int fq) const {
        const int b = u.pm >> 5, sb = (u.pm & 31) * 256 + wr * 64 + fr;
#pragma unroll
        for (int bj = 0; bj < 2; ++bj) { const int c = u.pn * BM + bj * HALF + wc * 32 + 8 * fq; const int t = c / (64 * nh), cc = c - t * 64 * nh, head = cc >> 6, d = cc & 63;
            bf16_t* dst = (t ? Kp : Q) + ((size_t)(b * nh + head) * XSEQ) * 64 + d;
#pragma unroll
            for (int ai = 0; ai < 2; ++ai)
#pragma unroll
                for (int m = 0; m < 4; ++m) { const int s = sb + ai * HALF + m * 16; const f32x4 v0 = acc[ai][bj][m][0], v1 = acc[ai][bj][m][1]; u32x4 w;
                    w.x = cvtpk2(v0[0], v0[1]); w.y = cvtpk2(v0[2], v0[3]); w.z = cvtpk2(v1[0], v1[1]); w.w = cvtpk2(v1[2], v1[3]);
                    *(u32x4*)(dst + (size_t)s * 64) = w; } }
    }
};
struct EpiVT {
    static constexpr bool PERM = true, AFTER_DRAIN = false;
    bf16_t* VT; int nrows;
    __device__ __forceinline__ void operator()(const f32x4 (&acc)[2][2][4][2], const Unit& u, int wr, int wc, int fr, int fq) const {
        const int row0 = u.pm * BM + wr * 64 + fr; const int c0 = u.pn * BM + wc * 32 + 8 * fq; const int b = c0 >> 13, s0 = c0 & (XSEQ - 1);
#pragma unroll
        for (int ai = 0; ai < 2; ++ai)
#pragma unroll
            for (int m = 0; m < 4; ++m) { bf16_t* rowp = VT + ((size_t)b * nrows + row0 + ai * HALF + m * 16) * XSEQ + s0;
#pragma unroll
                for (int bj = 0; bj < 2; ++bj) { const f32x4 v0 = acc[ai][bj][m][0], v1 = acc[ai][bj][m][1]; u32x4 w;
                    w.x = cvtpk2(v0[0], v0[1]); w.y = cvtpk2(v0[2], v0[3]); w.z = cvtpk2(v1[0], v1[1]); w.w = cvtpk2(v1[2], v1[3]);
                    *(u32x4*)(rowp + bj * HALF) = w; } }
    }
};
struct EpiRes {
    static constexpr bool PERM = false, AFTER_DRAIN = false;
    const float* xin; float* xout; const float* g;
    __device__ __forceinline__ void operator()(const f32x4 (&acc)[2][2][4][2], const Unit& u, int wr, int wc, int fr, int fq) const {
        const int row0 = u.pm * BM + wr * 64 + fr, col0 = u.pn * BM + wc * 32 + 4 * fq; const int b = u.pm >> 5;
        f32x4 gv[2][2];
#pragma unroll
        for (int bj = 0; bj < 2; ++bj)
#pragma unroll
            for (int n = 0; n < 2; ++n) gv[bj][n] = *(const f32x4*)(g + b * 6144 + col0 + bj * HALF + n * 16);
#pragma unroll
        for (int ai = 0; ai < 2; ++ai)
#pragma unroll
            for (int m = 0; m < 4; ++m) { const size_t off = (size_t)(row0 + ai * HALF + m * 16) * 1024 + col0;
#pragma unroll
                for (int bj = 0; bj < 2; ++bj)
#pragma unroll
                    for (int n = 0; n < 2; ++n) { const f32x4 xi = *(const f32x4*)(xin + off + bj * HALF + n * 16); *(f32x4*)(xout + off + bj * HALF + n * 16) = xi + gv[bj][n] * acc[ai][bj][m][n]; } }
    }
};
template <class Epi, class Sched, bool ALIGN_EPI = false, bool SP2 = false>
__device__ __forceinline__ void gemm_phase(PG8_LAS unsigned char* lds, const Gemm g, const Sched& S, const Epi& E) {
    const int tid = threadIdx.x, wid = __builtin_amdgcn_readfirstlane(tid >> 6), lane = tid & 63, wr = wid >> 2, wc = wid & 3, fr = lane & 15, fq = lane >> 4;
    const int K = g.K, nt = K / BK;
    unsigned voffA[2], voffB[2];
#pragma unroll
    for (int i = 0; i < 2; ++i) { int R, C; stage_rc(tid * 16 + i * 8192, R, C); const int Rb = Epi::PERM ? ((R & ~31) + perm32(R & 31)) : R;
        voffA[i] = (unsigned)(R * K + C) * 2u; voffB[i] = (unsigned)(Rb * K + C) * 2u; }
    const size_t kstep = (size_t)(BK * 2);
    const size_t hstep = (size_t)HALF * K * 2;
    const size_t tstep = 2 * hstep;
    const unsigned ldsw = (unsigned)wid * 1024u;
    const int aoff = lds_byte(wr * 64 + fr, fq * 8), boff = lds_byte(wc * 32 + fr, fq * 8);
#define PG8_SA(b, h) (((b) * 2 + (h)) * HTB)
#define PG8_SB(b, h) ((4 + (b) * 2 + (h)) * HTB)
#define PG8_STAGE(bufoff, gbase, voff) do { _Pragma("unroll") for (int _i = 0; _i < 2; ++_i) \
        __builtin_amdgcn_global_load_lds((const unsigned*)((const char*)(gbase) + (voff)[_i]), (PG8_LAS unsigned*)(lds + (bufoff) + ldsw + _i * 8192), 16, 0, 0); } while (0)
#define PG8_LDA(dst, b, h) do { _Pragma("unroll") for (int m = 0; m < 4; ++m) _Pragma("unroll") for (int k = 0; k < 2; ++k) dst[m][k] = *(const PG8_LAS bf16x8*)(lds + PG8_SA(b, h) + aoff + m * 2048 + k * 1024); } while (0)
#define PG8_LDB(dst, b, h) do { _Pragma("unroll") for (int n = 0; n < 2; ++n) _Pragma("unroll") for (int k = 0; k < 2; ++k) dst[n][k] = *(const PG8_LAS bf16x8*)(lds + PG8_SB(b, h) + boff + n * 2048 + k * 1024); } while (0)
#define PG8_MMA(ai, bj, At, Bt) do { __builtin_amdgcn_s_setprio(1); _Pragma("unroll") for (int m = 0; m < 4; ++m) _Pragma("unroll") for (int n = 0; n < 2; ++n) _Pragma("unroll") for (int k = 0; k < 2; ++k) \
        acc[ai][bj][m][n] = __builtin_amdgcn_mfma_f32_16x16x32_bf16(Bt[n][k], At[m][k], acc[ai][bj][m][n], 0, 0, 0); __builtin_amdgcn_s_setprio(0); } while (0)
#define PG8_WAIT_V(n) asm volatile("s_waitcnt vmcnt(" #n ")" ::: "memory")
#define PG8_WAIT_L(n) asm volatile("s_waitcnt lgkmcnt(" #n ")" ::: "memory")
#define PG8_BAR __builtin_amdgcn_s_barrier()
#define PG8_SCHED __builtin_amdgcn_sched_barrier(0)
    Unit cur, nxt; int ui = 0;
    if (!S.next(0, cur)) return;
    f32x4 acc[2][2][4][2];
#pragma unroll
    for (int a = 0; a < 2; ++a)
#pragma unroll
        for (int b = 0; b < 2; ++b)
#pragma unroll
            for (int m = 0; m < 4; ++m)
#pragma unroll
                for (int n = 0; n < 2; ++n) acc[a][b][m][n] = (f32x4){0.f, 0.f, 0.f, 0.f};
    bf16x8 At[4][2], B0[2][2], B1[2][2];
    const char* cA = (const char*)g.A + (size_t)cur.pm * tstep; const char* cB = (const char*)g.Bt + (size_t)cur.pn * tstep;
    S.a_ready(cur);
    if constexpr (SP2) {
        PG8_STAGE(PG8_SB(0, 0), cB, voffB); PG8_STAGE(PG8_SB(0, 1), cB + hstep, voffB); PG8_STAGE(PG8_SA(0, 0), cA, voffA); PG8_STAGE(PG8_SA(0, 1), cA + hstep, voffA);
        if (wr == 1) PG8_BAR;
        PG8_WAIT_V(2); PG8_BAR;
        PG8_STAGE(PG8_SB(1, 0), cB + kstep, voffB); PG8_STAGE(PG8_SA(1, 0), cA + kstep, voffA); PG8_STAGE(PG8_SB(1, 1), cB + hstep + kstep, voffB);
        PG8_WAIT_V(6); PG8_BAR;
    } else {
        PG8_STAGE(PG8_SB(0, 0), cB, voffB); PG8_STAGE(PG8_SA(0, 0), cA, voffA); PG8_STAGE(PG8_SB(0, 1), cB + hstep, voffB); PG8_STAGE(PG8_SA(0, 1), cA + hstep, voffA);
        if (wr == 1) PG8_BAR;
        PG8_WAIT_V(4); PG8_BAR;
        PG8_STAGE(PG8_SB(1, 0), cB + kstep, voffB); PG8_STAGE(PG8_SA(1, 0), cA + kstep, voffA); PG8_STAGE(PG8_SB(1, 1), cB + hstep + kstep, voffB);
        PG8_WAIT_V(6); PG8_BAR;
    }
    for (;;) {
        const bool has_next = S.next(ui + 1, nxt);
        const char* nA = has_next ? (const char*)g.A + (size_t)nxt.pm * tstep : cA; const char* nB = has_next ? (const char*)g.Bt + (size_t)nxt.pn * tstep : cB;
        for (int t = 0; t < nt; t += 2) {
            const bool last = (t == nt - 2);
            const char* a1 = cA + (size_t)(t + 1) * kstep;
            const char* a2 = last ? nA : cA + (size_t)(t + 2) * kstep; const char* b2 = last ? nB : cB + (size_t)(t + 2) * kstep;
            const char* a3 = a2 + kstep; const char* b3 = b2 + kstep;
            if (last && has_next) S.a_ready(nxt);
            if constexpr (SP2) {
            PG8_LDB(B0, 0, 0); PG8_LDB(B1, 0, 1); PG8_SCHED; PG8_LDA(At, 0, 0); PG8_STAGE(PG8_SA(1, 1), a1 + hstep, voffA);
            PG8_WAIT_V(8); PG8_WAIT_L(0); PG8_BAR; PG8_MMA(0, 0, At, B0); PG8_MMA(0, 1, At, B1); PG8_BAR; PG8_SCHED;
            PG8_LDA(At, 0, 1); PG8_STAGE(PG8_SB(0, 0), b2, voffB); PG8_STAGE(PG8_SB(0, 1), b2 + hstep, voffB); PG8_STAGE(PG8_SA(0, 0), a2, voffA);
            PG8_WAIT_V(8); PG8_WAIT_L(0); PG8_BAR; PG8_MMA(1, 0, At, B0); PG8_MMA(1, 1, At, B1); PG8_BAR; PG8_SCHED;
            PG8_LDB(B0, 1, 0); PG8_LDB(B1, 1, 1); PG8_SCHED; PG8_LDA(At, 1, 0); PG8_STAGE(PG8_SA(0, 1), a2 + hstep, voffA);
            PG8_WAIT_V(8); PG8_WAIT_L(0); PG8_BAR; PG8_MMA(0, 0, At, B0); PG8_MMA(0, 1, At, B1); PG8_BAR; PG8_SCHED;
            PG8_LDA(At, 1, 1); PG8_STAGE(PG8_SB(1, 0), b3, voffB); PG8_STAGE(PG8_SB(1, 1), b3 + hstep, voffB); PG8_STAGE(PG8_SA(1, 0), a3, voffA);
            PG8_WAIT_V(8); PG8_WAIT_L(0); PG8_BAR; PG8_MMA(1, 0, At, B0); PG8_MMA(1, 1, At, B1); PG8_BAR; PG8_SCHED;
            } else {
            PG8_LDB(B0, 0, 0); PG8_SCHED; PG8_LDA(At, 0, 0); PG8_STAGE(PG8_SA(1, 1), a1 + hstep, voffA);
            PG8_WAIT_L(8); PG8_BAR; PG8_WAIT_L(0); PG8_MMA(0, 0, At, B0); PG8_BAR; PG8_SCHED;
            PG8_LDB(B1, 0, 1); PG8_STAGE(PG8_SB(0, 0), b2, voffB);
            PG8_BAR; PG8_WAIT_L(0); PG8_MMA(0, 1, At, B1); PG8_BAR;
            PG8_LDA(At, 0, 1); PG8_STAGE(PG8_SA(0, 0), a2, voffA);
            PG8_BAR; PG8_WAIT_L(0); PG8_MMA(1, 0, At, B0); PG8_BAR; PG8_SCHED;
            PG8_STAGE(PG8_SB(0, 1), b2 + hstep, voffB);
            PG8_WAIT_V(6); PG8_BAR; PG8_MMA(1, 1, At, B1); PG8_BAR;
            PG8_LDB(B0, 1, 0); PG8_SCHED; PG8_LDA(At, 1, 0); PG8_STAGE(PG8_SA(0, 1), a2 + hstep, voffA);
            PG8_WAIT_L(8); PG8_BAR; PG8_WAIT_L(0); PG8_MMA(0, 0, At, B0); PG8_BAR; PG8_SCHED;
            PG8_LDB(B1, 1, 1); PG8_STAGE(PG8_SB(1, 0), b3, voffB);
            PG8_BAR; PG8_WAIT_L(0); PG8_MMA(0, 1, At, B1); PG8_BAR;
            PG8_LDA(At, 1, 1); PG8_STAGE(PG8_SA(1, 0), a3, voffA);
            PG8_BAR; PG8_WAIT_L(0); PG8_MMA(1, 0, At, B0); PG8_BAR; PG8_SCHED;
            PG8_STAGE(PG8_SB(1, 1), b3 + hstep, voffB);
            PG8_WAIT_V(6); PG8_BAR; PG8_MMA(1, 1, At, B1); PG8_BAR;
            }
        }
        if constexpr (ALIGN_EPI) { if (wr == 0) PG8_BAR; }
        if constexpr (!Epi::AFTER_DRAIN) { E(acc, cur, wr, wc, fr, fq); S.done(cur); }
        if (!has_next) break;
#pragma unroll
        for (int a = 0; a < 2; ++a)
#pragma unroll
            for (int b = 0; b < 2; ++b)
#pragma unroll
                for (int m = 0; m < 4; ++m)
#pragma unroll
                    for (int n = 0; n < 2; ++n) acc[a][b][m][n] = (f32x4){0.f, 0.f, 0.f, 0.f};
        cur = nxt; cA = nA; cB = nB; ++ui;
        if constexpr (ALIGN_EPI) { if (wr == 1) PG8_BAR; }
    }
    PG8_WAIT_V(0);
    if constexpr (!ALIGN_EPI) { if (wr == 0) PG8_BAR; }
    PG8_BAR;
    if constexpr (Epi::AFTER_DRAIN) { E.fused(acc, cur, wr, wc, fr, fq, lds, wid, lane); S.done(cur); }
#undef PG8_SA
#undef PG8_SB
#undef PG8_STAGE
#undef PG8_LDA
#undef PG8_LDB
#undef PG8_MMA
#undef PG8_WAIT_V
#undef PG8_WAIT_L
#undef PG8_BAR
#undef PG8_SCHED
}
}
#define GAS __attribute__((address_space(1)))
#define LAS __attribute__((address_space(3)))
typedef unsigned short bf16;
typedef unsigned v4u __attribute__((ext_vector_type(4)));
typedef float f32x4 __attribute__((ext_vector_type(4)));
typedef short bf16x8 __attribute__((ext_vector_type(8)));
typedef GAS unsigned gu32;
typedef GAS unsigned long long gu64;
#define RLX_AGENT __ATOMIC_RELAXED, __HIP_MEMORY_SCOPE_AGENT
#define LDS_WAIT() asm volatile("s_waitcnt lgkmcnt(0)" ::: "memory")
#define VM_WAIT() asm volatile("s_waitcnt vmcnt(0)" ::: "memory")
__device__ __forceinline__ unsigned long long rt() { return __builtin_amdgcn_s_memrealtime(); }
__device__ __forceinline__ unsigned f2bf(float f) { unsigned u = __builtin_bit_cast(unsigned, f); return (u + 0x7fffu + ((u >> 16) & 1u)) >> 16; }
__device__ __forceinline__ unsigned pk2(float lo, float hi) { return f2bf(lo) | (f2bf(hi) << 16); }

#define XB_TMO      128
#define XB_XCNT(j)  (256  + 64 * (j))
#define XB_XSUB(j)  (1280 + 64 * (j))
#define XB_XGEN(j)  (2304 + 64 * (j))
#define XB_TOP      3328
#define XB_TOPGEN   3392
#define XCD_BAR_WORDS 3456
#define XB_SPIN_CAP (1u << 18)

__device__ __forceinline__ unsigned xb_ld(unsigned* p)              { return __hip_atomic_load(p, __ATOMIC_RELAXED, __HIP_MEMORY_SCOPE_AGENT); }
__device__ __forceinline__ unsigned xb_add(unsigned* p, unsigned v) { return __hip_atomic_fetch_add(p, v, __ATOMIC_RELAXED, __HIP_MEMORY_SCOPE_AGENT); }
__device__ __forceinline__ unsigned xb_xcc_id() { return (unsigned)__builtin_amdgcn_s_getreg((3 << 11) | 20) & 0xFu; }
#define XB_SPIN(cond, bar) do { unsigned _sp = 0; while (cond) { __builtin_amdgcn_s_sleep(1); \
    if ((++_sp & 255u) == 0u) { if (xb_ld(&(bar)[XB_TMO])) break; if (_sp > XB_SPIN_CAP) { atomicAdd(&(bar)[XB_TMO], 1u); break; } } } } while (0)

struct XcdBarrier {
    unsigned* bar; unsigned x;
    volatile LAS unsigned* st;
};

__device__ __forceinline__ XcdBarrier xcd_barrier_post(unsigned* bar, volatile LAS unsigned* st) {
    XcdBarrier b; b.bar = bar; b.x = xb_xcc_id(); b.st = st;
    if (threadIdx.x == 0) (void)xb_add(&bar[XB_XCNT(b.x)], 1u);
    return b;
}
__device__ __forceinline__ void xcd_barrier_complete(unsigned* bar, unsigned x, unsigned& nloc, unsigned& nx) {
    const unsigned G = gridDim.x * gridDim.y * gridDim.z;
    unsigned sum, cnt, mine, sp = 0u;
    for (;;) {
        sum = 0u; cnt = 0u; mine = 0u;
#pragma unroll
        for (unsigned j = 0; j < 16; ++j) { const unsigned c = xb_ld(&bar[XB_XCNT(j)]); sum += c; cnt += (c > 0u) ? 1u : 0u; mine = (j == x) ? c : mine; }
        if (sum == G) break;
        __builtin_amdgcn_s_sleep(1);
        if ((++sp & 255u) == 0u) { if (xb_ld(&bar[XB_TMO])) break; if (sp > XB_SPIN_CAP) { atomicAdd(&bar[XB_TMO], 1u); break; } }
    }
    nloc = mine > 0u ? mine : 1u; nx = cnt > 0u ? cnt : 1u;
}

__device__ __forceinline__ void xcd_barrier(const XcdBarrier& b) {
    asm volatile("s_waitcnt vmcnt(0)" ::: "memory");
    __syncthreads();
    if (threadIdx.x == 0) {
        unsigned* bar = b.bar;
        __builtin_amdgcn_s_waitcnt(0);
        unsigned nloc = b.st[0], nx = b.st[1];
        if (nloc == 0u) { xcd_barrier_complete(bar, b.x, nloc, nx); b.st[0] = nloc; b.st[1] = nx; }
        const unsigned old = xb_add(&bar[XB_XSUB(b.x)], 1u);
        const unsigned gen = old / nloc;
        if (old + 1u == (gen + 1u) * nloc) {
            __builtin_amdgcn_fence(__ATOMIC_RELEASE, "agent");
            asm volatile("s_waitcnt vmcnt(0)" ::: "memory");
            const unsigned og = xb_add(&bar[XB_TOP], 1u);
            const unsigned tg = og / nx;
            if (og + 1u == (tg + 1u) * nx) xb_add(&bar[XB_TOPGEN], 1u);
            else XB_SPIN(xb_ld(&bar[XB_TOPGEN]) == tg, bar);
            __builtin_amdgcn_fence(__ATOMIC_ACQUIRE, "agent");
            xb_add(&bar[XB_XGEN(b.x)], 1u);
            asm volatile("s_waitcnt vmcnt(0)" ::: "memory");
        } else {
            XB_SPIN(xb_ld(&bar[XB_XGEN(b.x)]) == gen, bar);
            __builtin_amdgcn_fence(__ATOMIC_ACQUIRE, "agent");
            asm volatile("s_waitcnt vmcnt(0)" ::: "memory");
        }
    }
    __syncthreads();
}
constexpr int NWAVES = 8, NTHR = 512;
constexpr int SEQ = 8192, DM = 1024, MROWS = 16384;
constexpr size_t MiB = 1u << 20;
constexpr size_t WS_CTL = 0, CTL_ZERO_BYTES = 2 * MiB;
constexpr size_t WS_KSUM = 1 * MiB;
constexpr size_t WS_MOD = 2 * MiB;
constexpr size_t WS_ROPE = 3 * MiB;
constexpr size_t WS_WIN0 = 4 * MiB, WS_WOUT0 = 9 * MiB, WS_WIN1 = 11 * MiB, WS_WOUT1 = 17 * MiB, WS_WQ0 = 19 * MiB, WS_WQ1 = 23 * MiB;
constexpr size_t WS_SUBK = 27 * MiB, WS_GWS = 28 * MiB, WS_MASK = 29 * MiB;
constexpr size_t WS_PTU = 32 * MiB, WS_PTV = 96 * MiB;
constexpr size_t WS_HN = 160 * MiB;
constexpr size_t WS_A = 192 * MiB;
constexpr size_t WS_YCAT = 288 * MiB, WS_QP = 320 * MiB, WS_PO = 384 * MiB, WS_PL = 448 * MiB, WS_END = 450 * MiB;
constexpr int CW_BAR = 4096, CW_WORK = 16384;

constexpr int RING_BYTES = 131072, LDSCTL_OFF = RING_BYTES, MISC_OFF = LDSCTL_OFF + 320, LDS_BYTES = 147456;

#define DI __device__ __forceinline__
typedef short bf16x8 __attribute__((ext_vector_type(8)));
typedef short s16x4 __attribute__((ext_vector_type(4)));
typedef float f32x16 __attribute__((ext_vector_type(16)));
typedef __bf16 bf16x2t __attribute__((ext_vector_type(2)));
#define MFMA32(a, b, c) __builtin_amdgcn_mfma_f32_32x32x16_bf16((a), (b), (c), 0, 0, 0)
using pg8::cvtpk2; using pg8::gelu_tanh;
DI int crow(int reg, int h) { return (reg & 3) + 8 * (reg >> 2) + 4 * h; }
DI float bf_lo(unsigned w) { return __uint_as_float(w << 16); }
DI float bf_hi(unsigned w) { return __uint_as_float(w & 0xffff0000u); }
DI bf16x8 ld16g(const bf16* p) { return *(const bf16x8*)p; }
DI bf16x8 ld8x2g(const bf16* p0, const bf16* p1) { const s16x4 a = *(const s16x4*)p0, b = *(const s16x4*)p1; return __builtin_shufflevector(a, b, 0, 1, 2, 3, 4, 5, 6, 7); }
DI float dot2bf(unsigned a, unsigned b, float c) { return __builtin_amdgcn_fdot2_f32_bf16(__builtin_bit_cast(bf16x2t, a), __builtin_bit_cast(bf16x2t, b), c, false); }
DI int f_ord(float f) { int i = __float_as_int(f); return i ^ ((i >> 31) & 0x7fffffff); }
DI float f_unord(int i) { return __int_as_float(i ^ ((i >> 31) & 0x7fffffff)); }
constexpr float LOG2E = 1.4426950408889634f, LN2 = 0.6931471805599453f;
#define KEY_MIN ((int)0x80000000)

struct Frame {
    LAS unsigned char* lds; volatile LAS unsigned* MISC; gu32* ctl; int tid, lane, wave, G, gw, NGW;
};

struct MapId { DI int operator()(int n) const { return n; } };
struct MapWin0 { DI int operator()(int n) const {
    if (n < 1024) return n;
    const int t = (n - 1024) >> 9, c = (n - 1024) & 511, hd = c >> 6, d = c & 63; int bj, p;
    if (t < 2) { if (d < 16) { const int nn = d >> 3, rr = d & 7; bj = 0; p = 8 * (rr >> 2) + 4 * nn + (rr & 3); } else if (d < 32) { bj = 0; p = d; } else { bj = 1; p = d - 32; } }
    else { bj = d >> 5; p = d & 31; }
    return 1024 + 512 * t + 256 * (hd >> 2) + 128 * bj + 32 * (hd & 3) + p; } };
struct MapWin1 { DI int operator()(int n) const { const int t = n >> 10, c = n & 1023, hd = c >> 6, d = c & 63; return 1024 * t + 256 * (hd >> 2) + 128 * (d >> 5) + 32 * (hd & 3) + (d & 31); } };
template <class Map> DI void p0_transpose_item(const float* W, int K, int N, bf16* WT, LAS float* scr, int item, int lane, Map map) {
    const int nblk = N / 32, kb = item / nblk, nb = item % nblk, k0 = 64 * kb, n0 = 32 * nb;
#pragma unroll 8
    for (int i = 0; i < 32; ++i) { const int kk = 2 * i + (lane >> 5); scr[kk * 33 + (lane & 31)] = W[(size_t)(k0 + kk) * N + n0 + (lane & 31)]; }
    LDS_WAIT(); asm volatile("" ::: "memory");
    const int c = lane & 7;
#pragma unroll
    for (int j = 0; j < 4; ++j) { const int n = (lane >> 3) + 8 * j; const LAS float* s = scr + (8 * c) * 33 + n;
        v4u o; o.x = pk2(s[0 * 33], s[1 * 33]); o.y = pk2(s[2 * 33], s[3 * 33]); o.z = pk2(s[4 * 33], s[5 * 33]); o.w = pk2(s[6 * 33], s[7 * 33]);
        *(GAS v4u*)(WT + (size_t)map(n0 + n) * K + k0 + 8 * c) = o; }
    LDS_WAIT(); asm volatile("" ::: "memory");
}
DI float wave_sum(float v) {
#pragma unroll
    for (int o = 1; o < 64; o <<= 1) v += __shfl_xor(v, o);
    return v;
}
struct P0Args { const float *c, *w_mod, *b_mod, *win0, *wout0, *win1, *wout1, *wq, *subk, *pu, *pv, *gws;
                float *MOD, *ROPE; bf16 *WIN0, *WOUT0, *WIN1, *WOUT1, *WQ0, *WQ1, *SUBK, *GWS, *PTU, *PTV; };
DI void p0_prologue(const Frame& F, const P0Args& A) {
    { LAS float* scr = (LAS float*)F.lds;
      for (int task = blockIdx.x; task < 192; task += F.G) {
          const int l = task / 96, n0 = (task % 96) * 64; const float* W = A.w_mod + (size_t)l * 1024 * 6144;
          float a0 = 0.f, a1 = 0.f; const int k0 = F.wave * 128;
#pragma unroll 8
          for (int k = k0; k < k0 + 128; ++k) { const float c0 = A.c[k], c1 = A.c[1024 + k]; const float s0 = c0 / (1.f + __expf(-c0)), s1 = c1 / (1.f + __expf(-c1));
              const float w = W[(size_t)k * 6144 + n0 + F.lane]; a0 += s0 * w; a1 += s1 * w; }
          scr[(F.wave * 2 + 0) * 64 + F.lane] = a0; scr[(F.wave * 2 + 1) * 64 + F.lane] = a1;
          __syncthreads();
          if (F.tid < 128) { const int b = F.tid >> 6, n = F.tid & 63; float s = 0.f;
#pragma unroll
              for (int w = 0; w < 8; ++w) s += scr[(w * 2 + b) * 64 + n];
              A.MOD[(size_t)(l * 2 + b) * 6144 + n0 + n] = s + A.b_mod[l * 6144 + n0 + n]; }
          __syncthreads();
      } }
    { LAS float* scr = (LAS float*)(F.lds + F.wave * 16384);
      constexpr int I0 = 16 * 80, I1 = 16 * 32, I2 = 16 * 96, I3 = 16 * 32, I4 = 16 * 64, I5 = 16 * 64, NIT = I0 + I1 + I2 + I3 + I4 + I5;
      for (int it = F.gw; it < NIT; it += F.NGW) { int r = it;
          if (r < I0) { p0_transpose_item(A.win0, 1024, 2560, A.WIN0, scr, r, F.lane, MapId()); continue; } r -= I0;
          if (r < I1) { p0_transpose_item(A.wout0, 1024, 1024, A.WOUT0, scr, r, F.lane, MapId()); continue; } r -= I1;
          if (r < I2) { p0_transpose_item(A.win1, 1024, 3072, A.WIN1, scr, r, F.lane, MapId()); continue; } r -= I2;
          if (r < I3) { p0_transpose_item(A.wout1, 1024, 1024, A.WOUT1, scr, r, F.lane, MapId()); continue; } r -= I3;
          if (r < I4) { p0_transpose_item(A.wq, 1024, 2048, A.WQ0, scr, r, F.lane, MapId()); continue; } r -= I4;
          p0_transpose_item(A.wq + (size_t)1024 * 2048, 1024, 2048, A.WQ1, scr, r, F.lane, MapId()); } }
    { const size_t gt = (size_t)F.gw * 64 + F.lane, NT = (size_t)F.NGW * 64;
      const size_t NPT = (size_t)2 * 16384 * 1024 / 8;
      for (size_t i = gt; i < 2 * NPT; i += NT) { const bool isv = i >= NPT; const size_t j = isv ? i - NPT : i; const float* src = (isv ? A.pv : A.pu) + j * 8;
          const f32x4 a = *(const f32x4*)src, b = *(const f32x4*)(src + 4); v4u o; o.x = cvtpk2(a[0], a[1]); o.y = cvtpk2(a[2], a[3]); o.z = cvtpk2(b[0], b[1]); o.w = cvtpk2(b[2], b[3]);
          *(v4u*)((isv ? A.PTV : A.PTU) + j * 8) = o; }
      for (size_t i = gt; i < 524288 / 8; i += NT) { const float* src = A.subk + i * 8; const f32x4 a = *(const f32x4*)src, b = *(const f32x4*)(src + 4); v4u o; o.x = cvtpk2(a[0], a[1]); o.y = cvtpk2(a[2], a[3]); o.z = cvtpk2(b[0], b[1]); o.w = cvtpk2(b[2], b[3]);
          *(v4u*)(A.SUBK + i * 8) = o; }
      for (size_t i = gt; i < 65536; i += NT) { const int t = (int)(i >> 7) & 127, s = (int)i & 127; A.GWS[i] = (bf16)(cvtpk2(s <= t ? A.gws[i] : 0.f, 0.f) & 0xffffu); }
      for (size_t i = gt; i < 65536; i += NT) { const int pos = (int)(i >> 3), fi = (int)i & 7; const float inv = powf(500000.0f, -(float)fi / 8.0f); const float ang = (float)pos * inv; float sn, cs; sincosf(ang, &sn, &cs);
          A.ROPE[(size_t)pos * 16 + fi] = cs; A.ROPE[(size_t)pos * 16 + 8 + fi] = sn; } }
}

DI void norm_rows(const Frame& F, const float* xs, const float* gamma, const float* modl, int shi, int sci, bf16* HN) {
    for (int m = F.gw; m < MROWS; m += F.NGW) { const int b = m >> 13;
        const f32x4* xr = (const f32x4*)(xs + (size_t)m * 1024) + F.lane; f32x4 v[4]; float s = 0.f;
#pragma unroll
        for (int j = 0; j < 4; ++j) { v[j] = xr[64 * j]; s += (v[j][0] * v[j][0] + v[j][1] * v[j][1]) + (v[j][2] * v[j][2] + v[j][3] * v[j][3]); }
        const float rinv = rsqrtf(wave_sum(s) * (1.0f / 1024.0f) + 1e-6f);
        unsigned long long* o8 = (unsigned long long*)(HN + (size_t)m * 1024) + F.lane;
#pragma unroll
        for (int j = 0; j < 4; ++j) { const int col = 4 * F.lane + 256 * j; const f32x4 gm = *(const f32x4*)(gamma + col), sc = *(const f32x4*)(modl + b * 6144 + sci * 1024 + col), sh = *(const f32x4*)(modl + b * 6144 + shi * 1024 + col);
            const f32x4 o = v[j] * rinv * gm * (sc + 1.0f) + sh; o8[64 * j] = (unsigned long long)cvtpk2(o[0], o[1]) | ((unsigned long long)cvtpk2(o[2], o[3]) << 32); }
    }
}


DI void qk_post_task(int task, const bf16* QKR, bf16* Q0, bf16* K0, float* KSUM, const float* rope, const float* gq, const float* gk, LAS float* scr, int tid, int wave, int lane) {
    const int tb = task >> 2, cq = task & 3; const bool isk = cq >= 2; const int head0 = (cq & 1) * 4, hl = (lane >> 2) & 3, qt = lane & 3, rsub = lane >> 4;
    const float* g = (isk ? gk : gq) + qt * 16; float gv[16];
#pragma unroll
    for (int i = 0; i < 16; ++i) gv[i] = g[i];
    float ks[16];
#pragma unroll
    for (int i = 0; i < 16; ++i) ks[i] = 0.f;
    const int b = tb >> 5; bf16* dstb = (isk ? K0 : Q0) + (size_t)(b * 8 + head0 + hl) * SEQ * 64 + qt * 16;
    for (int it = 0; it < 8; ++it) { const int row = tb * 256 + wave * 32 + it * 4 + rsub, s = row & (SEQ - 1);
        const bf16* src = QKR + (size_t)row * 1024 + cq * 256 + hl * 64 + qt * 16; const v4u w0 = *(const v4u*)src, w1 = *(const v4u*)(src + 8);
        float y[16]; y[0] = bf_lo(w0.x); y[1] = bf_hi(w0.x); y[2] = bf_lo(w0.y); y[3] = bf_hi(w0.y); y[4] = bf_lo(w0.z); y[5] = bf_hi(w0.z); y[6] = bf_lo(w0.w); y[7] = bf_hi(w0.w);
        y[8] = bf_lo(w1.x); y[9] = bf_hi(w1.x); y[10] = bf_lo(w1.y); y[11] = bf_hi(w1.y); y[12] = bf_lo(w1.z); y[13] = bf_hi(w1.z); y[14] = bf_lo(w1.w); y[15] = bf_hi(w1.w);
        float ss = 0.f;
#pragma unroll
        for (int i = 0; i < 16; ++i) ss += y[i] * y[i];
        ss += __shfl_xor(ss, 1); ss += __shfl_xor(ss, 2);
        const float rinv = rsqrtf(ss * (1.0f / 64.0f) + 1e-6f);
#pragma unroll
        for (int i = 0; i < 16; ++i) y[i] = y[i] * rinv * gv[i];
        if (qt == 0) { const float* rp = rope + (size_t)s * 16;
#pragma unroll
            for (int i = 0; i < 8; ++i) { const float c = rp[i], sn = rp[8 + i], x1 = y[i], x2 = y[i + 8]; y[i] = x1 * c - x2 * sn; y[i + 8] = x1 * sn + x2 * c; } }
        v4u o0, o1; o0.x = cvtpk2(y[0], y[1]); o0.y = cvtpk2(y[2], y[3]); o0.z = cvtpk2(y[4], y[5]); o0.w = cvtpk2(y[6], y[7]); o1.x = cvtpk2(y[8], y[9]); o1.y = cvtpk2(y[10], y[11]); o1.z = cvtpk2(y[12], y[13]); o1.w = cvtpk2(y[14], y[15]);
        bf16* d = dstb + (size_t)s * 64; *(v4u*)d = o0; *(v4u*)(d + 8) = o1;
#pragma unroll
        for (int i = 0; i < 16; ++i) ks[i] += y[i];
    }
    if (isk) {
#pragma unroll
        for (int i = 0; i < 16; ++i) { float c = ks[i]; c += __shfl_xor(c, 16); c += __shfl_xor(c, 32); ks[i] = c; }
        if (lane < 16) {
#pragma unroll
            for (int i = 0; i < 16; ++i) scr[(wave * 16 + lane) * 16 + i] = ks[i]; }
        __syncthreads();
        if (tid < 256) { const int l16 = tid >> 4, i = tid & 15; float sum = 0.f;
#pragma unroll
            for (int w = 0; w < 8; ++w) sum += scr[(w * 16 + l16) * 16 + i];
            KSUM[((size_t)(b * 8 + head0 + (l16 >> 2)) * 32 + (tb & 31)) * 64 + (l16 & 3) * 16 + i] = sum; }
        __syncthreads();
    }
}

DI f32x16 qk_tile(const bf16* krow, const bf16x8 (&qf)[4]) {
    f32x16 s;
#pragma unroll
    for (int i = 0; i < 16; ++i) s[i] = 0.f;
#pragma unroll
    for (int ks = 0; ks < 4; ++ks) s = MFMA32(ld16g(krow + 16 * ks), qf[ks], s);
    return s;
}
DI bf16x8 pack8(const f32x16& x, int s) { v4u p; p.x = cvtpk2(x[8 * s], x[8 * s + 1]); p.y = cvtpk2(x[8 * s + 2], x[8 * s + 3]); p.z = cvtpk2(x[8 * s + 4], x[8 * s + 5]); p.w = cvtpk2(x[8 * s + 6], x[8 * s + 7]); return __builtin_bit_cast(bf16x8, p); }
DI void pv_tile(f32x16 (&o)[2], const bf16* vt, const f32x16& p) {
#pragma unroll
    for (int s = 0; s < 2; ++s) { const bf16x8 pb = pack8(p, s);
#pragma unroll
        for (int mt = 0; mt < 2; ++mt) { const bf16* v = vt + (size_t)mt * 32 * SEQ + 16 * s; o[mt] = MFMA32(ld8x2g(v, v + 8), pb, o[mt]); } }
}
DI void store_ot(bf16* dst, const f32x16 (&o)[2], float sc, int h) {
#pragma unroll
    for (int mt = 0; mt < 2; ++mt)
#pragma unroll
        for (int g = 0; g < 4; ++g) { const unsigned lo = cvtpk2(o[mt][4 * g] * sc, o[mt][4 * g + 1] * sc), hi = cvtpk2(o[mt][4 * g + 2] * sc, o[mt][4 * g + 3] * sc);
            *(unsigned long long*)(dst + 32 * mt + 8 * g + 4 * h) = (unsigned long long)lo | ((unsigned long long)hi << 32); }
}
DI void moba_keys(const bf16* Kh, const bf16* VTh, const bf16x8 (&qf)[4], int key0, int nt, int diag, float mc2, f32x16 (&o)[2], float& l, int r, int h) {
    for (int kt = 0; kt < nt; ++kt) { const int kb = key0 + 32 * kt;
        f32x16 s = qk_tile(Kh + (size_t)(kb + r) * 64 + 8 * h, qf);
        float ls = 0.f;
#pragma unroll
        for (int i = 0; i < 16; ++i) { float p = __builtin_amdgcn_exp2f(s[i] * (0.125f * LOG2E) - mc2); if (kt == diag && crow(i, h) > r) p = 0.f; s[i] = p; ls += p; }
        l += ls;
        pv_tile(o, VTh + (size_t)r * SEQ + kb + 4 * h, s);
    }
}
DI float moba_mc2(const float* gq, const float* gk, int lane) {
    float a = fabsf(gq[lane]), b = fabsf(gk[lane]);
#pragma unroll
    for (int o = 1; o < 64; o <<= 1) { a = fmaxf(a, __shfl_xor(a, o)); b = fmaxf(b, __shfl_xor(b, o)); }
    return 8.0f * a * b * LOG2E;
}
struct MobaT { const bf16 *Q, *K, *VT; const float* ksum; unsigned* masks; bf16* PO; float* PL; const float *gq, *gk; };
DI void moba_mask_unit(int u, const MobaT& T, int lane) {
    const int bh = u >> 8, t0 = (u & 255) * 32, own = t0 >> 8, r = lane & 31, h = lane >> 5;
    unsigned mask = 0u;
    if (own > 0) {
        f32x16 g;
#pragma unroll
        for (int i = 0; i < 16; ++i) g[i] = 0.f;
        const float* km = T.ksum + ((size_t)bh * 32 + r) * 64 + 8 * h; const bf16* qp = T.Q + ((size_t)bh * SEQ + t0 + r) * 64 + 8 * h;
#pragma unroll
        for (int ks = 0; ks < 4; ++ks) { const f32x4 a0 = *(const f32x4*)(km + 16 * ks) * (1.0f / 256.0f), a1 = *(const f32x4*)(km + 16 * ks + 4) * (1.0f / 256.0f);
            v4u aw; aw.x = cvtpk2(a0[0], a0[1]); aw.y = cvtpk2(a0[2], a0[3]); aw.z = cvtpk2(a1[0], a1[1]); aw.w = cvtpk2(a1[2], a1[3]);
            g = MFMA32(__builtin_bit_cast(bf16x8, aw), ld16g(qp + 16 * ks), g); }
        int ka = KEY_MIN, kb2 = KEY_MIN, kc = KEY_MIN;
#define INS3(x_) do { int x = (x_); int t = min(ka, x); ka = max(ka, x); int uu = min(kb2, t); kb2 = max(kb2, t); kc = max(kc, uu); } while (0)
#pragma unroll
        for (int i = 0; i < 16; ++i) { const int blk = crow(i, h); const int key = (blk < own) ? ((f_ord(g[i]) & ~31) | (31 - blk)) : KEY_MIN; INS3(key); }
        const int pa = __shfl_xor(ka, 32), pb = __shfl_xor(kb2, 32), pc = __shfl_xor(kc, 32);
        INS3(pa); INS3(pb); INS3(pc);
#undef INS3
        if (ka != KEY_MIN) mask |= 1u << (31 - (ka & 31));
        if (kb2 != KEY_MIN) mask |= 1u << (31 - (kb2 & 31));
        if (kc != KEY_MIN) mask |= 1u << (31 - (kc & 31));
    }
    if (h == 0) T.masks[(size_t)bh * SEQ + t0 + r] = mask;
}
DI void moba_own_unit(int u, const MobaT& T, float mc2, int lane) {
    const int bh = u >> 8, t0 = (u & 255) * 32, own = t0 >> 8, r = lane & 31, h = lane >> 5;
    const bf16* qp = T.Q + ((size_t)bh * SEQ + t0 + r) * 64 + 8 * h; bf16x8 qf[4];
#pragma unroll
    for (int ks = 0; ks < 4; ++ks) qf[ks] = ld16g(qp + 16 * ks);
    f32x16 o[2];
#pragma unroll
    for (int i = 0; i < 16; ++i) { o[0][i] = 0.f; o[1][i] = 0.f; }
    float l = 0.f; const int key0 = own * 256, nt = ((t0 - key0) >> 5) + 1;
    moba_keys(T.K + (size_t)bh * SEQ * 64, T.VT + (size_t)bh * 64 * SEQ, qf, key0, nt, nt - 1, mc2, o, l, r, h);
    l += __shfl_xor(l, 32);
    const size_t base = ((size_t)bh * SEQ + t0 + r) * 4 + 3;
    store_ot(T.PO + base * 64, o, 1.0f, h); if (h == 0) T.PL[base] = l;
}
DI void moba_sel_batch(const MobaT& T, int bh, int j, const LAS unsigned* wq, int nv, float mc2, int lane) {
    const int r = lane & 31, h = lane >> 5; const bool valid = r < nv; const int t = (int)wq[valid ? r : 0];
    const unsigned m = T.masks[(size_t)bh * SEQ + t]; const int slot = __builtin_popcount(m & ((1u << j) - 1u));
    const bf16* qp = T.Q + ((size_t)bh * SEQ + t) * 64 + 8 * h; bf16x8 qf[4];
#pragma unroll
    for (int ks = 0; ks < 4; ++ks) qf[ks] = ld16g(qp + 16 * ks);
    f32x16 o[2];
#pragma unroll
    for (int i = 0; i < 16; ++i) { o[0][i] = 0.f; o[1][i] = 0.f; }
    float l = 0.f;
    moba_keys(T.K + (size_t)bh * SEQ * 64, T.VT + (size_t)bh * 64 * SEQ, qf, j * 256, 8, -1, mc2, o, l, r, h);
    l += __shfl_xor(l, 32);
    if (valid) { const size_t base = ((size_t)bh * SEQ + t) * 4 + slot; store_ot(T.PO + base * 64, o, 1.0f, h); if (h == 0) T.PL[base] = l; }
}
constexpr int MOBA_NTASK = 16 * 136;
DI void moba_sel_task(int task, const MobaT& T, LAS unsigned* wq, float mc2, int lane) {
    int c = 0, rem = task; while (rem >= 16 * (4 * c + 3)) { rem -= 16 * (4 * c + 3); ++c; }
    const int j = rem >> 4, bh = rem & 15; int n = 0;
    for (int step = 0; step < 16; ++step) { const int t = c * 1024 + step * 64 + lane; const unsigned m = T.masks[(size_t)bh * SEQ + t]; const bool sel = (m >> j) & 1u;
        const unsigned long long bal = __ballot(sel);
        if (sel) wq[n + __builtin_popcountll(bal & ((1ull << lane) - 1ull))] = (unsigned)t;
        n += __builtin_popcountll(bal);
        asm volatile("s_waitcnt lgkmcnt(0)" ::: "memory");
        while (n >= 32) { moba_sel_batch(T, bh, j, wq + (n - 32), 32, mc2, lane); n -= 32; asm volatile("s_waitcnt lgkmcnt(0)" ::: "memory"); }
    }
    if (n > 0) moba_sel_batch(T, bh, j, wq, n, mc2, lane);
    asm volatile("s_waitcnt lgkmcnt(0)" ::: "memory");
}
DI void moba_combine(const Frame& F, const bf16* PO, const float* PL, bf16* YCAT) {
    const size_t gt = (size_t)F.gw * 64 + F.lane, NT = (size_t)F.NGW * 64;
    for (size_t i = gt; i < (size_t)16 * SEQ * 8; i += NT) { const int dq = (int)i & 7, t = (int)(i >> 3) & (SEQ - 1), bh = (int)(i >> 16); const int own = t >> 8, ns = own < 3 ? own : 3;
        float o[8]; float l = 0.f;
#pragma unroll
        for (int k = 0; k < 8; ++k) o[k] = 0.f;
#pragma unroll
        for (int s = 0; s < 4; ++s) { if (s < ns || s == 3) { const size_t base = ((size_t)bh * SEQ + t) * 4 + s; l += PL[base]; const v4u w = *(const v4u*)(PO + base * 64 + dq * 8);
                o[0] += bf_lo(w.x); o[1] += bf_hi(w.x); o[2] += bf_lo(w.y); o[3] += bf_hi(w.y); o[4] += bf_lo(w.z); o[5] += bf_hi(w.z); o[6] += bf_lo(w.w); o[7] += bf_hi(w.w); } }
        const float il = 1.0f / l; v4u w; w.x = cvtpk2(o[0] * il, o[1] * il); w.y = cvtpk2(o[2] * il, o[3] * il); w.z = cvtpk2(o[4] * il, o[5] * il); w.w = cvtpk2(o[6] * il, o[7] * il);
        *(v4u*)(YCAT + ((size_t)(bh >> 3) * SEQ + t) * 1024 + 512 + (bh & 7) * 64 + dq * 8) = w; }
}

DI void gmlp_unit(int unit, const bf16* UA, const bf16* VA, const float* vgain, const bf16* GWS, const float* bs, bf16* YCAT, LAS unsigned char* lds, int tid, int wave, int lane) {
    const int cidx = unit >> 2, g = unit & 3, row0 = cidx * 128; LAS bf16* VNT = (LAS bf16*)lds;
    { const int row = tid >> 2, dq = (tid & 3) * 32; const bf16* src = VA + (size_t)(row0 + row) * 512 + g * 128 + dq;
      float f[32]; float ss = 0.f;
#pragma unroll
      for (int k = 0; k < 4; ++k) { const v4u w = *(const v4u*)(src + 8 * k); f[8 * k] = bf_lo(w.x); f[8 * k + 1] = bf_hi(w.x); f[8 * k + 2] = bf_lo(w.y); f[8 * k + 3] = bf_hi(w.y); f[8 * k + 4] = bf_lo(w.z); f[8 * k + 5] = bf_hi(w.z); f[8 * k + 6] = bf_lo(w.w); f[8 * k + 7] = bf_hi(w.w); }
#pragma unroll
      for (int k = 0; k < 32; ++k) ss += f[k] * f[k];
      ss += __shfl_xor(ss, 1); ss += __shfl_xor(ss, 2);
      const float rinv = rsqrtf(ss * (1.0f / 128.0f) + 1e-6f);
#pragma unroll
      for (int k = 0; k < 32; ++k) VNT[(dq + k) * 136 + row] = (bf16)(cvtpk2(f[k] * rinv * vgain[g * 128 + dq + k], 0.f) & 0xffffu); }
    __syncthreads();
    { const int mt = wave >> 1, ntb = (wave & 1) * 2, r = lane & 31, h = lane >> 5;
      f32x16 acc[2];
#pragma unroll
      for (int i = 0; i < 16; ++i) { acc[0][i] = 0.f; acc[1][i] = 0.f; }
      const bf16* wp = GWS + ((size_t)g * 128 + 32 * mt + r) * 128 + 8 * h;
      for (int ks = 0; ks < 2 * (mt + 1); ++ks) { const bf16x8 a = ld16g(wp + 16 * ks);
#pragma unroll
          for (int nn = 0; nn < 2; ++nn) { const bf16x8 b = *(const LAS bf16x8*)(VNT + (32 * (ntb + nn) + r) * 136 + 16 * ks + 8 * h); acc[nn] = MFMA32(a, b, acc[nn]); } }
#pragma unroll
      for (int nn = 0; nn < 2; ++nn)
#pragma unroll
          for (int i = 0; i < 16; ++i) { const int t = 32 * mt + crow(i, h), d = 32 * (ntb + nn) + r; const float mixed = acc[nn][i] + bs[g * 128 + t];
              const float uv = __uint_as_float((unsigned)UA[(size_t)(row0 + t) * 512 + g * 128 + d] << 16);
              YCAT[(size_t)(row0 + t) * 1024 + g * 128 + d] = (bf16)(cvtpk2(uv * mixed, 0.f) & 0xffffu); } }
    __syncthreads();
}

DI void sb_unit(int u, const bf16* Q, const bf16* K, const bf16* VT, bf16* YCAT, int lane) {
    const int bh = u >> 8, t0 = (u & 255) * 32, r = lane & 31, h = lane >> 5;
    const bf16* qp = Q + ((size_t)bh * SEQ + t0 + r) * 64 + 8 * h; bf16x8 qf[4];
#pragma unroll
    for (int ks = 0; ks < 4; ++ks) qf[ks] = ld16g(qp + 16 * ks);
    const bf16* Kh = K + (size_t)bh * SEQ * 64; const bf16* VTh = VT + (size_t)bh * 64 * SEQ;
    f32x16 o[2];
#pragma unroll
    for (int i = 0; i < 16; ++i) { o[0][i] = 0.f; o[1][i] = 0.f; }
    float R = 0.f;
    for (int kb = t0; kb >= 0; kb -= 32) {
        f32x16 s = qk_tile(Kh + (size_t)(kb + r) * 64 + 8 * h, qf);
        const bool diag = (kb == t0);
        f32x16 x;
#pragma unroll
        for (int i = 0; i < 16; ++i) { const float z = s[i] * 0.125f; const float t = __builtin_amdgcn_exp2f(-fabsf(z) * LOG2E); const float sp = fmaxf(z, 0.f) + LN2 * __builtin_amdgcn_logf(1.0f + t);
            const bool valid = !(diag && crow(i, h) >= r); x[i] = valid ? -sp : 0.f; s[i] = valid ? z : -INFINITY; }
        float T4[4], E[16];
#pragma unroll
        for (int g = 0; g < 4; ++g) { E[4 * g + 3] = 0.f; E[4 * g + 2] = x[4 * g + 3]; E[4 * g + 1] = E[4 * g + 2] + x[4 * g + 2]; E[4 * g] = E[4 * g + 1] + x[4 * g + 1]; T4[g] = E[4 * g] + x[4 * g]; }
        float P4[4];
#pragma unroll
        for (int g = 0; g < 4; ++g) P4[g] = __shfl_xor(T4[g], 32);
        float C[4]; float run = 0.f;
#pragma unroll
        for (int g = 3; g >= 0; --g) { C[g] = run + (h == 0 ? P4[g] : 0.f); run += T4[g] + P4[g]; }
#pragma unroll
        for (int i = 0; i < 16; ++i) { const float arg = x[i] + s[i] + (R + C[i >> 2] + E[i]); x[i] = __builtin_amdgcn_exp2f(arg * LOG2E); }
        pv_tile(o, VTh + (size_t)r * SEQ + kb + 4 * h, x);
        R += run;
        if (!__any(R >= -104.0f)) break;
    }
    store_ot(YCAT + ((size_t)(bh >> 4) * SEQ + t0 + r) * 1024 + (bh & 15) * 64, o, 1.0f, h);
}

#define INS16(L, x_) do { int x = (x_); _Pragma("unroll") for (int q_ = 0; q_ < 16; ++q_) { const int hi_ = max(L[q_], x); x = min(L[q_], x); L[q_] = hi_; } } while (0)
DI void peer_scores(int tokg, int head, const bf16* QP, const bf16* SUBK, LAS unsigned* ent, int lane) {
    const int r = lane & 31, h = lane >> 5;
    int L1[16], L2[16];
#pragma unroll
    for (int p = 0; p < 2; ++p) {
        const bf16* qp = QP + (size_t)(tokg + r) * 2048 + head * 256 + p * 128 + 8 * h; bf16x8 qf[8];
#pragma unroll
        for (int ks = 0; ks < 8; ++ks) qf[ks] = ld16g(qp + 16 * ks);
        const bf16* sk = SUBK + (size_t)((head * 2 + p) * 128 + r) * 128 + 8 * h;
        int L[16];
#pragma unroll
        for (int i = 0; i < 16; ++i) L[i] = KEY_MIN;
#pragma unroll 1
        for (int mt = 0; mt < 4; ++mt) {
            f32x16 acc;
#pragma unroll
            for (int i = 0; i < 16; ++i) acc[i] = 0.f;
#pragma unroll
            for (int ks = 0; ks < 8; ++ks) acc = MFMA32(ld16g(sk + (size_t)mt * 32 * 128 + 16 * ks), qf[ks], acc);
#pragma unroll
            for (int i = 0; i < 16; ++i) INS16(L, (f_ord(acc[i]) & ~127) | (32 * mt + crow(i, h)));
        }
        int Pn[16];
#pragma unroll
        for (int i = 0; i < 16; ++i) Pn[i] = __shfl_xor(L[i], 32);
#pragma unroll
        for (int i = 0; i < 16; ++i) INS16(L, Pn[i]);
#pragma unroll
        for (int i = 0; i < 16; ++i) { if (p == 0) L1[i] = L[i]; else L2[i] = L[i]; }
    }
    int Cn[16];
#pragma unroll
    for (int i = 0; i < 16; ++i) Cn[i] = KEY_MIN;
#pragma unroll
    for (int i = 0; i < 16; ++i)
#pragma unroll
        for (int j = 0; j < 16; ++j) if ((i + 1) * (j + 1) <= 16) { const float v = f_unord(L1[i] & ~127) + f_unord(L2[j] & ~127); INS16(Cn, (f_ord(v) & ~0x3fff) | ((L1[i] & 127) << 7) | (L2[j] & 127)); }
    float e[16]; float sum = 0.f; const float m0 = f_unord(Cn[0] & ~0x3fff);
#pragma unroll
    for (int k = 0; k < 16; ++k) { e[k] = __builtin_amdgcn_exp2f((f_unord(Cn[k] & ~0x3fff) - m0) * LOG2E); sum += e[k]; }
    const float inv = 1.0f / sum;
    if (h == 0) {
#pragma unroll
        for (int k = 0; k < 16; ++k) ent[r * 128 + head * 16 + k] = (cvtpk2(0.f, e[k] * inv) & 0xffff0000u) | (unsigned)(Cn[k] & 0x3fff); }
}
struct PeerT { const bf16 *HN, *U, *V; float* X; const float* g2; bf16* HNo; const float *ngamma, *nmod; int nshi, nsci; };
DI void peer_token(int tok, const LAS unsigned* ent, LAS float* actw, const PeerT& T, int lane) {
    const int b = tok >> 13;
    const unsigned* hp = (const unsigned*)(T.HN + (size_t)tok * 1024); const v4u ha = *(const v4u*)(hp + 4 * lane), hb = *(const v4u*)(hp + 256 + 4 * lane);
#pragma unroll 1
    for (int q = 0; q < 4; ++q) {
        float p[32];
#pragma unroll
        for (int e = 0; e < 32; ++e) { const unsigned eid = (unsigned)__builtin_amdgcn_readfirstlane((int)ent[32 * q + e]) & 0x3fffu; const v4u* row = (const v4u*)(T.U + (size_t)eid * 1024);
            const v4u ua = row[lane], ub = row[64 + lane];
            float a = dot2bf(ua.x, ha.x, 0.f); a = dot2bf(ua.y, ha.y, a); a = dot2bf(ua.z, ha.z, a); a = dot2bf(ua.w, ha.w, a);
            a = dot2bf(ub.x, hb.x, a); a = dot2bf(ub.y, hb.y, a); a = dot2bf(ub.z, hb.z, a); a = dot2bf(ub.w, hb.w, a); p[e] = a; }
#pragma unroll
        for (int st = 0; st < 5; ++st) { const int mk = 16 >> st, nh = 16 >> st; const bool up = (lane & mk) != 0;
#pragma unroll
            for (int i = 0; i < nh; ++i) { const float keep = up ? p[i + nh] : p[i], send = up ? p[i] : p[i + nh]; p[i] = keep + __shfl_xor(send, mk); } }
        const float dot = p[0] + __shfl_xor(p[0], 32);
        const unsigned ev = ent[32 * q + (lane & 31)];
        const float act = gelu_tanh(dot) * __uint_as_float(ev & 0xffff0000u);
        if (lane < 32) actw[32 * q + lane] = act;
    }
    asm volatile("s_waitcnt lgkmcnt(0)" ::: "memory");
    float out[16];
#pragma unroll
    for (int i = 0; i < 16; ++i) out[i] = 0.f;
#pragma unroll 8
    for (int e = 0; e < 128; ++e) { const unsigned eid = (unsigned)__builtin_amdgcn_readfirstlane((int)ent[e]) & 0x3fffu; const float w = actw[e]; const v4u* row = (const v4u*)(T.V + (size_t)eid * 1024);
        const v4u va = row[lane], vb = row[64 + lane];
        out[0] += w * bf_lo(va.x); out[1] += w * bf_hi(va.x); out[2] += w * bf_lo(va.y); out[3] += w * bf_hi(va.y); out[4] += w * bf_lo(va.z); out[5] += w * bf_hi(va.z); out[6] += w * bf_lo(va.w); out[7] += w * bf_hi(va.w);
        out[8] += w * bf_lo(vb.x); out[9] += w * bf_hi(vb.x); out[10] += w * bf_lo(vb.y); out[11] += w * bf_hi(vb.y); out[12] += w * bf_lo(vb.z); out[13] += w * bf_hi(vb.z); out[14] += w * bf_lo(vb.w); out[15] += w * bf_hi(vb.w); }
    float* xr = T.X + (size_t)tok * 1024; const float* gr = T.g2 + b * 6144;
    f32x4 xn[4]; float ss = 0.f;
#pragma unroll
    for (int k = 0; k < 4; ++k) { const int col = (k >> 1) * 512 + 8 * lane + 4 * (k & 1); const f32x4 xv = *(const f32x4*)(xr + col), gv = *(const f32x4*)(gr + col);
        f32x4 ov; ov[0] = out[4 * k]; ov[1] = out[4 * k + 1]; ov[2] = out[4 * k + 2]; ov[3] = out[4 * k + 3];
        xn[k] = xv + gv * ov; *(f32x4*)(xr + col) = xn[k]; ss += (xn[k][0] * xn[k][0] + xn[k][1] * xn[k][1]) + (xn[k][2] * xn[k][2] + xn[k][3] * xn[k][3]); }
    if (T.HNo) { const float rinv = rsqrtf(wave_sum(ss) * (1.0f / 1024.0f) + 1e-6f);
#pragma unroll
        for (int k = 0; k < 4; ++k) { const int col = (k >> 1) * 512 + 8 * lane + 4 * (k & 1); const f32x4 gm = *(const f32x4*)(T.ngamma + col), sc = *(const f32x4*)(T.nmod + b * 6144 + T.nsci * 1024 + col), sh = *(const f32x4*)(T.nmod + b * 6144 + T.nshi * 1024 + col);
            const f32x4 o = xn[k] * rinv * gm * (sc + 1.0f) + sh; *(unsigned long long*)(T.HNo + (size_t)tok * 1024 + col) = (unsigned long long)cvtpk2(o[0], o[1]) | ((unsigned long long)cvtpk2(o[2], o[3]) << 32); } }
}
DI void peer_phase(const Frame& F, const bf16* QP, const bf16* SUBK, const PeerT& T) {
    LAS unsigned* ent = (LAS unsigned*)F.lds;
    LAS float* actw = (LAS float*)(F.lds + 32768) + F.wave * 128;
    for (int unit = blockIdx.x; unit < MROWS / 64; unit += F.G) { const int tok0 = unit * 64;
#pragma unroll 1
        for (int grp = 0; grp < 2; ++grp) peer_scores(tok0 + 32 * grp, F.wave, QP, SUBK, ent + grp * 32 * 128, F.lane);
        __syncthreads();
        for (int i = 0; i < 8; ++i) peer_token(tok0 + F.wave * 8 + i, ent + (F.wave * 8 + i) * 128, actw, T, F.lane);
        __syncthreads();
    }
}
struct Args { const float* in[19]; float* out; unsigned char* ws; int stage, pad; };
__global__ void __launch_bounds__(NTHR, 2) hybrid_fwd(Args args) {
    extern __shared__ __attribute__((aligned(16))) unsigned char lds_raw[];
    for (int u = threadIdx.x; u < (LDS_BYTES - LDSCTL_OFF) / 4; u += NTHR) ((LAS unsigned*)((LAS unsigned char*)lds_raw + LDSCTL_OFF))[u] = 0u;
    __syncthreads();
    XcdBarrier bar = xcd_barrier_post((unsigned*)((gu32*)(args.ws + WS_CTL) + CW_BAR), (volatile LAS unsigned*)((LAS unsigned char*)lds_raw + MISC_OFF) + 8);
#define GRID_BAR() xcd_barrier(bar)
#define OPQ(p) ({ auto p_ = (p); asm volatile("" : "+s"(p_)); p_; })
#define PH_PTRS \
    unsigned char* ws = OPQ(args.ws); const float* x_in = OPQ(args.in[0]); float* X = OPQ(args.out); \
    const float *norm_mix = args.in[4], *norm_ffn = args.in[5]; \
    float* MOD = (float*)(ws + WS_MOD); float* ROPE = (float*)(ws + WS_ROPE); float* KSUM = (float*)(ws + WS_KSUM); \
    bf16 *WIN0 = (bf16*)(ws + WS_WIN0), *WOUT0 = (bf16*)(ws + WS_WOUT0), *WIN1 = (bf16*)(ws + WS_WIN1), *WOUT1 = (bf16*)(ws + WS_WOUT1), *WQ0 = (bf16*)(ws + WS_WQ0), *WQ1 = (bf16*)(ws + WS_WQ1); \
    bf16 *SUBK = (bf16*)(ws + WS_SUBK), *GWS = (bf16*)(ws + WS_GWS), *PTU = (bf16*)(ws + WS_PTU), *PTV = (bf16*)(ws + WS_PTV), *HN = (bf16*)(ws + WS_HN); \
    bf16 *UA = (bf16*)(ws + WS_A), *VA = (bf16*)(ws + WS_A + 16 * MiB), *Q0 = (bf16*)(ws + WS_A + 32 * MiB), *K0 = (bf16*)(ws + WS_A + 48 * MiB), *VT0 = (bf16*)(ws + WS_A + 64 * MiB); \
    bf16 *Q1 = (bf16*)(ws + WS_A), *K1 = (bf16*)(ws + WS_A + 32 * MiB), *VT1 = (bf16*)(ws + WS_A + 64 * MiB); \
    bf16 *YCAT = (bf16*)(ws + WS_YCAT), *QP = (bf16*)(ws + WS_QP), *PO = (bf16*)(ws + WS_PO); float* PL = (float*)(ws + WS_PL); unsigned* MASKS = (unsigned*)(ws + WS_MASK); bf16* QKR = (bf16*)(ws + WS_QP); (void)QKR; \
    (void)x_in; (void)X; (void)norm_mix; (void)norm_ffn; (void)MOD; (void)ROPE; (void)KSUM; (void)WIN0; (void)WOUT0; (void)WIN1; (void)WOUT1; (void)WQ0; (void)WQ1; (void)SUBK; (void)GWS; (void)PTU; (void)PTV; (void)HN; \
    (void)UA; (void)VA; (void)Q0; (void)K0; (void)VT0; (void)Q1; (void)K1; (void)VT1; (void)YCAT; (void)QP; (void)PO; (void)PL; (void)MASKS;
#define PH_FRAME Frame F; F.lds = (LAS unsigned char*)lds_raw; F.MISC = (volatile LAS unsigned*)(F.lds + MISC_OFF); F.tid = threadIdx.x; F.lane = F.tid & 63; F.wave = __builtin_amdgcn_readfirstlane(F.tid >> 6); \
    F.G = gridDim.x; F.gw = blockIdx.x * NWAVES + F.wave; F.NGW = F.G * NWAVES; F.ctl = (gu32*)(OPQ(args.ws) + WS_CTL);
    { PH_FRAME PH_PTRS
      P0Args A; A.c = args.in[1]; A.w_mod = args.in[2]; A.b_mod = args.in[3]; A.win0 = args.in[6]; A.wout0 = args.in[12]; A.win1 = args.in[13]; A.wout1 = args.in[14]; A.wq = args.in[15]; A.subk = args.in[16];
      A.pu = args.in[17]; A.pv = args.in[18]; A.gws = args.in[8]; A.MOD = MOD; A.ROPE = ROPE; A.WIN0 = WIN0; A.WOUT0 = WOUT0; A.WIN1 = WIN1; A.WOUT1 = WOUT1; A.WQ0 = WQ0; A.WQ1 = WQ1; A.SUBK = SUBK; A.GWS = GWS; A.PTU = PTU; A.PTV = PTV;
      p0_prologue(F, A); }
    GRID_BAR();
    { PH_FRAME PH_PTRS norm_rows(F, x_in, norm_mix, MOD, 0, 1, HN); }
    GRID_BAR();
    { PH_FRAME PH_PTRS
      pg8::Gemm g{HN, WIN0, MROWS, 2048, 1024}; pg8::StaticOrder S; S.init(MROWS, 2048, F.G, (int)blockIdx.x);
      pg8::EpiL0m E{UA, VA, QKR};
      pg8::gemm_phase<pg8::EpiL0m, pg8::StaticOrder, true, true>(F.lds, g, S, E); }
    { PH_FRAME PH_PTRS
      pg8::Gemm g{WIN0 + (size_t)2048 * 1024, HN, 512, MROWS, 1024}; pg8::StaticOrder S; S.init(512, MROWS, F.G, (int)blockIdx.x);
      pg8::EpiVT E{VT0, 512};
      pg8::gemm_phase<pg8::EpiVT, pg8::StaticOrder, true, true>(F.lds, g, S, E); }
    GRID_BAR();
    { PH_FRAME PH_PTRS
      for (int t = blockIdx.x; t < 256; t += F.G) qk_post_task(t, QKR, Q0, K0, KSUM, ROPE, args.in[10], args.in[11], (LAS float*)F.lds, F.tid, F.wave, F.lane);
      for (int u = blockIdx.x; u < 512; u += F.G) gmlp_unit(u, UA, VA, args.in[7], GWS, args.in[9], YCAT, F.lds, F.tid, F.wave, F.lane); }
    GRID_BAR();
    { PH_FRAME PH_PTRS
      MobaT T{Q0, K0, VT0, KSUM, MASKS, PO, PL, args.in[10], args.in[11]}; const float mc2 = moba_mc2(args.in[10], args.in[11], F.lane);
      for (int u = F.gw; u < 4096; u += F.NGW) { moba_mask_unit(u, T, F.lane); moba_own_unit(u, T, mc2, F.lane); } }
    GRID_BAR();
    { PH_FRAME PH_PTRS
      MobaT T{Q0, K0, VT0, KSUM, MASKS, PO, PL, args.in[10], args.in[11]}; const float mc2 = moba_mc2(args.in[10], args.in[11], F.lane);
      LAS unsigned* wq = (LAS unsigned*)(F.lds) + F.wave * 128;
      for (;;) { int task = 0; if (F.lane == 0) task = (int)__hip_atomic_fetch_add((unsigned*)(F.ctl + CW_WORK), 1u, __ATOMIC_RELAXED, __HIP_MEMORY_SCOPE_AGENT);
          task = __builtin_amdgcn_readfirstlane(task); if (task >= MOBA_NTASK) break;
          moba_sel_task(task, T, wq, mc2, F.lane); } }
    GRID_BAR();
    { PH_FRAME PH_PTRS moba_combine(F, PO, PL, YCAT); }
    GRID_BAR();
    { PH_FRAME PH_PTRS
      pg8::Gemm g{YCAT, WOUT0, MROWS, 1024, 1024}; pg8::StaticOrder S; S.init(MROWS, 1024, F.G, (int)blockIdx.x);
      pg8::EpiRes E{x_in, X, MOD + 2 * 1024};
      pg8::gemm_phase<pg8::EpiRes, pg8::StaticOrder, true, true>(F.lds, g, S, E); }
    GRID_BAR();
    { PH_FRAME PH_PTRS norm_rows(F, X, norm_ffn, MOD, 3, 4, HN); }
    GRID_BAR();
    { PH_FRAME PH_PTRS
      pg8::Gemm g{HN, WQ0, MROWS, 2048, 1024}; pg8::StaticOrder S; S.init(MROWS, 2048, F.G, (int)blockIdx.x);
      pg8::EpiBf16<0> E{QP, 2048, nullptr, 0, 0, 1.f};
      pg8::gemm_phase<pg8::EpiBf16<0>, pg8::StaticOrder, true, true>(F.lds, g, S, E); }
    GRID_BAR();
    { PH_FRAME PH_PTRS
      PeerT T{HN, PTU, PTV, X, MOD + 5 * 1024, HN, norm_mix + 1024, MOD + 2 * 6144, 0, 1};
      peer_phase(F, QP, SUBK, T); }
    GRID_BAR();
    { PH_FRAME PH_PTRS
      pg8::Gemm g{HN, WIN1, MROWS, 2048, 1024}; pg8::StaticOrder S; S.init(MROWS, 2048, F.G, (int)blockIdx.x);
      pg8::EpiHeads E{Q1, K1, 16};
      pg8::gemm_phase<pg8::EpiHeads, pg8::StaticOrder, true, true>(F.lds, g, S, E); }
    { PH_FRAME PH_PTRS
      pg8::Gemm g{WIN1 + (size_t)2048 * 1024, HN, 1024, MROWS, 1024}; pg8::StaticOrder S; S.init(1024, MROWS, F.G, (int)blockIdx.x);
      pg8::EpiVT E{VT1, 1024};
      pg8::gemm_phase<pg8::EpiVT, pg8::StaticOrder, true, true>(F.lds, g, S, E); }
    GRID_BAR();
    { PH_FRAME PH_PTRS for (int u = F.gw; u < 8192; u += F.NGW) sb_unit(u, Q1, K1, VT1, YCAT, F.lane); }
    GRID_BAR();
    { PH_FRAME PH_PTRS
      pg8::Gemm g{YCAT, WOUT1, MROWS, 1024, 1024}; pg8::StaticOrder S; S.init(MROWS, 1024, F.G, (int)blockIdx.x);
      pg8::EpiRes E{X, X, MOD + 2 * 6144 + 2 * 1024};
      pg8::gemm_phase<pg8::EpiRes, pg8::StaticOrder, true, true>(F.lds, g, S, E); }
    GRID_BAR();
    { PH_FRAME PH_PTRS norm_rows(F, X, norm_ffn + 1024, MOD + 2 * 6144, 3, 4, HN); }
    GRID_BAR();
    { PH_FRAME PH_PTRS
      pg8::Gemm g{HN, WQ1, MROWS, 2048, 1024}; pg8::StaticOrder S; S.init(MROWS, 2048, F.G, (int)blockIdx.x);
      pg8::EpiBf16<0> E{QP, 2048, nullptr, 0, 0, 1.f};
      pg8::gemm_phase<pg8::EpiBf16<0>, pg8::StaticOrder, true, true>(F.lds, g, S, E); }
    GRID_BAR();
    { PH_FRAME PH_PTRS
      PeerT T{HN, PTU + (size_t)16384 * 1024, PTV + (size_t)16384 * 1024, X, MOD + 2 * 6144 + 5 * 1024, nullptr, nullptr, nullptr, 0, 0};
      peer_phase(F, QP, SUBK + 262144, T);
      if (__hip_atomic_load((gu32*)((unsigned*)(F.ctl + CW_BAR) + XB_TMO), RLX_AGENT) != 0u) { for (int m = F.gw; m < MROWS; m += F.NGW) X[(size_t)m * 1024 + F.lane] = __builtin_nanf(""); } }
}

extern "C" void kernel_launch(void* const* d_in, const int* in_sizes, int n_in, void* d_out, int out_size, void* d_ws, size_t ws_size, hipStream_t stream) {
    static int grid = 0;
    if (grid == 0) {
        if (n_in != 19 || out_size != MROWS * DM || ws_size < WS_END) { fprintf(stderr, "kernel_launch: unexpected shapes (n_in %d, out %d, ws %zu)\n", n_in, out_size, ws_size); grid = -1; return; }
        int dev = 0, cus = 0, per_cu = 0;
        if (hipGetDevice(&dev) != hipSuccess || hipDeviceGetAttribute(&cus, hipDeviceAttributeMultiprocessorCount, dev) != hipSuccess) { grid = -1; return; }
        if (hipFuncSetAttribute((const void*)hybrid_fwd, hipFuncAttributeMaxDynamicSharedMemorySize, LDS_BYTES) != hipSuccess) { fprintf(stderr, "kernel_launch: hipFuncSetAttribute failed\n"); grid = -1; return; }
        if (hipOccupancyMaxActiveBlocksPerMultiprocessor(&per_cu, (const void*)hybrid_fwd, NTHR, LDS_BYTES) != hipSuccess || per_cu < 1) { fprintf(stderr, "kernel_launch: occupancy query says %d\n", per_cu); per_cu = 1; }
        (void)hipGetLastError();
        grid = cus;
    }
    if (grid < 0) return;
    if (hipMemsetAsync((char*)d_ws + WS_CTL, 0, CTL_ZERO_BYTES, stream) != hipSuccess) { fprintf(stderr, "kernel_launch: memset failed\n"); return; }
    Args a{};
    for (int i = 0; i < 19; ++i) a.in[i] = (const float*)d_in[i];
    a.out = (float*)d_out; a.ws = (unsigned char*)d_ws; a.stage = 0; a.pad = 0;
    void* kargs[] = {&a};
    hipError_t e = hipLaunchCooperativeKernel((const void*)hybrid_fwd, dim3(grid), dim3(NTHR), kargs, LDS_BYTES, stream);
    if (e != hipSuccess) fprintf(stderr, "kernel_launch: cooperative launch failed: %s (grid %d)\n", hipGetErrorString(e), grid);
}
```

```cpp
#include <hip/hip_runtime.h>
#include <cstdio>
#include <cstdint>
#include <cmath>
namespace pg8 {
#define PG8_LAS __attribute__((address_space(3)))
typedef unsigned short bf16_t;
typedef short bf16x8 __attribute__((ext_vector_type(8)));
typedef float f32x4 __attribute__((ext_vector_type(4)));
typedef unsigned u32x4 __attribute__((ext_vector_type(4)));
constexpr int BM = 256, BK = 64, HALF = 128, HTB = HALF * BK * 2  , STAGE_BYTES = 8 * HTB, NXCD = 8, WGM = 8;

__host__ __device__ __forceinline__ int lds_byte(int r, int c) { const int st = (r >> 4) * 2 + (c >> 5), rr = r & 15, cc = c & 31, ob = rr * 64 + cc * 2; return st * 1024 + (ob ^ (((ob >> 9) & 1) << 5)); }
__host__ __device__ __forceinline__ void stage_rc(int b, int& R, int& C) { const int st = b / 1024, sb = b % 1024, swz = sb ^ (((sb >> 9) & 1) << 5); R = (st >> 1) * 16 + swz / 64; C = (st & 1) * 32 + (swz % 64) / 2; }
__host__ __device__ __forceinline__ int perm32(int rho) { const int n = rho >> 4, i = rho & 15; return 8 * (i >> 2) + 4 * n + (i & 3); }

struct Unit { int pm, pn; };
struct Gemm { const bf16_t* A; const bf16_t* Bt; int M, N, K; };

struct StaticOrder {
    int nM, nN, nwg, G, c;
    __host__ __device__ void init(int M, int N, int G_, int c_) { nM = M / BM; nN = N / BM; nwg = nM * nN; G = G_; c = c_; }
    __host__ __device__ bool next(int i, Unit& u) const {
        const long L = (long)i * G + c; if (L >= nwg) return false;
        int wgid = (int)L; { const int q = nwg / NXCD, r = nwg % NXCD, xcd = wgid % NXCD, off = wgid / NXCD; wgid = (xcd < r ? xcd * (q + 1) : r * (q + 1) + (xcd - r) * q) + off; }
        const int nig = WGM * nN, gid = wgid / nig, fm = gid * WGM, gsz = (nM - fm) < WGM ? (nM - fm) : WGM;
        u.pm = fm + ((wgid % nig) % gsz); u.pn = (wgid % nig) / gsz; return true;
    }
    __device__ __forceinline__ void a_ready(const Unit&) const {}
    __device__ __forceinline__ void done(const Unit&) const {}
};

__device__ __forceinline__ unsigned cvt_pk_bf16(float lo, float hi) { unsigned r; asm volatile("v_cvt_pk_bf16_f32 %0, %1, %2" : "=v"(r) : "v"(lo), "v"(hi)); return r; }
typedef float f32x2 __attribute__((ext_vector_type(2)));
__device__ __forceinline__ f32x2 gelu_pk(f32x2 v) {
    const f32x2 av = __builtin_elementwise_abs(v), d = av * 0.2316418882f + 1.0f;
    f32x2 t; t.x = __builtin_amdgcn_rcpf(d.x); t.y = __builtin_amdgcn_rcpf(d.y);
    f32x2 q = t * 0.5307027145f + (-0.7265760135f); q = q * t + 0.7107068705f; q = q * t + (-0.142248368f); q = q * t + 0.127414796f; q = q * t;
    const f32x2 s = (v * v) * (-0.72134752044f);
    f32x2 e; e.x = __builtin_amdgcn_exp2f(s.x); e.y = __builtin_amdgcn_exp2f(s.y);
    const f32x2 m = v * (q * e), r = v - m;
    f32x2 o; o.x = v.x < 0.f ? m.x : r.x; o.y = v.y < 0.f ? m.y : r.y; return o;
}

template <int ACT  > struct EpiBf16 {
    static constexpr bool PERM = true, AFTER_DRAIN = false; static_assert(ACT == 0 || ACT == 1, "EpiBf16: ACT is 0 (none) or 1 (gelu_pk)");
    bf16_t* O; int ldc; const float* bias; int split_cols; size_t split_stride; float scale0;
    __device__ __forceinline__ void operator()(const f32x4 (&acc)[2][2][4][2], const Unit& u, int wr, int wc, int fr, int fq) const {
        const int row0 = u.pm * BM + wr * 64 + fr; int colt = u.pn * BM; bf16_t* base = O;
        float sc = 1.f; if (split_cols) { const int t = colt / split_cols; base += (size_t)t * split_stride; colt -= t * split_cols; if (t == 0) sc = scale0; }
        const int col0 = colt + wc * 32 + 8 * fq, bcol0 = u.pn * BM + wc * 32 + 8 * fq;
        f32x4 bv[2][2];
#pragma unroll
        for (int bj = 0; bj < 2; ++bj)
#pragma unroll
            for (int n = 0; n < 2; ++n) bv[bj][n] = bias ? *(const f32x4*)(bias + bcol0 + bj * HALF + 4 * n) : (f32x4){0.f, 0.f, 0.f, 0.f};
#pragma unroll
        for (int ai = 0; ai < 2; ++ai)
#pragma unroll
            for (int m = 0; m < 4; ++m) { bf16_t* rowp = base + (size_t)(row0 + ai * HALF + m * 16) * ldc + col0;
#pragma unroll
                for (int bj = 0; bj < 2; ++bj) { f32x4 v0 = acc[ai][bj][m][0] + bv[bj][0], v1 = acc[ai][bj][m][1] + bv[bj][1];
                    if (ACT == 1) { f32x2 a = gelu_pk((f32x2){v0[0], v0[1]}), b = gelu_pk((f32x2){v0[2], v0[3]}), c = gelu_pk((f32x2){v1[0], v1[1]}), d = gelu_pk((f32x2){v1[2], v1[3]});
                        v0 = (f32x4){a.x, a.y, b.x, b.y}; v1 = (f32x4){c.x, c.y, d.x, d.y}; }
                    v0 = v0 * sc; v1 = v1 * sc; u32x4 w; w.x = cvt_pk_bf16(v0[0], v0[1]); w.y = cvt_pk_bf16(v0[2], v0[3]); w.z = cvt_pk_bf16(v1[0], v1[1]); w.w = cvt_pk_bf16(v1[2], v1[3]);
                    *(u32x4*)(rowp + bj * HALF) = w; } }
    }
};
constexpr int XSEQ = 8192;
typedef float f32x2e __attribute__((ext_vector_type(2))); typedef __bf16 bf16x2e __attribute__((ext_vector_type(2)));
__device__ __forceinline__ unsigned cvtpk2(float lo, float hi) { f32x2e v = {lo, hi}; bf16x2e b = __builtin_convertvector(v, bf16x2e); return __builtin_bit_cast(unsigned, b); }
__device__ __forceinline__ float gelu_tanh(float x) {
    const float u2 = x * (1.5957691216f + 0.0713548163f * x * x);
    return x * __builtin_amdgcn_rcpf(1.0f + __builtin_amdgcn_exp2f(-1.4426950409f * u2));
}
struct EpiL0m {
    static constexpr bool PERM = true, AFTER_DRAIN = false;
    bf16_t *UA, *VA, *QKR;
    template <bool ACT> __device__ __forceinline__ void tile(const f32x4 (&acc)[2][2][4][2], bf16_t* base, int ldc, int row0, int colt) const {
#pragma unroll
        for (int ai = 0; ai < 2; ++ai)
#pragma unroll
            for (int m = 0; m < 4; ++m) { bf16_t* rowp = base + (size_t)(row0 + ai * HALF + m * 16) * ldc + colt;
#pragma unroll
                for (int bj = 0; bj < 2; ++bj) { f32x4 v0 = acc[ai][bj][m][0], v1 = acc[ai][bj][m][1]; u32x4 w;
                    if (ACT) { v0[0] = gelu_tanh(v0[0]); v0[1] = gelu_tanh(v0[1]); v0[2] = gelu_tanh(v0[2]); v0[3] = gelu_tanh(v0[3]); v1[0] = gelu_tanh(v1[0]); v1[1] = gelu_tanh(v1[1]); v1[2] = gelu_tanh(v1[2]); v1[3] = gelu_tanh(v1[3]); }
                    w.x = cvtpk2(v0[0], v0[1]); w.y = cvtpk2(v0[2], v0[3]); w.z = cvtpk2(v1[0], v1[1]); w.w = cvtpk2(v1[2], v1[3]);
                    *(u32x4*)(rowp + bj * HALF) = w; } }
    }
    __device__ __forceinline__ void operator()(const f32x4 (&acc)[2][2][4][2], const Unit& u, int wr, int wc, int fr, int fq) const {
        const int pn = u.pn; const int row0 = u.pm * BM + wr * 64 + fr; const int cw = wc * 32 + 8 * fq;
        if (pn < 2) tile<true>(acc, UA, 512, row0, pn * 256 + cw);
        else if (pn < 4) tile<true>(acc, VA, 512, row0, (pn - 2) * 256 + cw);
        else tile<false>(acc, QKR, 1024, row0, (pn - 4) * 256 + cw);
    }
};
struct EpiHeads {
    static constexpr bool PERM = true, AFTER_DRAIN = false;
    bf16_t *Q, *Kp; int nh;
    __device__ __forceinline__ void operator()(const f32x4 (&acc)[2][2][4][2], const Unit& u, int wr, int wc, int fr, int fq) const {
        const int b = u.pm >> 5, sb = (u.pm & 31) * 256 + wr * 64 + fr;
#pragma unroll
        for (int bj = 0; bj < 2; ++bj) { const int c = u.pn * BM + bj * HALF + wc * 32 + 8 * fq; const int t = c / (64 * nh), cc = c - t * 64 * nh, head = cc >> 6, d = cc & 63;
            bf16_t* dst = (t ? Kp : Q) + ((size_t)(b * nh + head) * XSEQ) * 64 + d;
#pragma unroll
            for (int ai = 0; ai < 2; ++ai)
#pragma unroll
                for (int m = 0; m < 4; ++m) { const int s = sb + ai * HALF + m * 16; const f32x4 v0 = acc[ai][bj][m][0], v1 = acc[ai][bj][m][1]; u32x4 w;
                    w.x = cvtpk2(v0[0], v0[1]); w.y = cvtpk2(v0[2], v0[3]); w.z = cvtpk2(v1[0], v1[1]); w.w = cvtpk2(v1[2], v1[3]);
                    *(u32x4*)(dst + (size_t)s * 64) = w; } }
    }
};
struct EpiVT {
    static constexpr bool PERM = true, AFTER_DRAIN = false;
    bf16_t* VT; int nrows;
    __device__ __forceinline__ void operator()(const f32x4 (&acc)[2][2][4][2], const Unit& u, int wr, int wc, int fr, int fq) const {
        const int row0 = u.pm * BM + wr * 64 + fr; const int c0 = u.pn * BM + wc * 32 + 8 * fq; const int b = c0 >> 13, s0 = c0 & (XSEQ - 1);
#pragma unroll
        for (int ai = 0; ai < 2; ++ai)
#pragma unroll
            for (int m = 0; m < 4; ++m) { bf16_t* rowp = VT + ((size_t)b * nrows + row0 + ai * HALF + m * 16) * XSEQ + s0;
#pragma unroll
                for (int bj = 0; bj < 2; ++bj) { const f32x4 v0 = acc[ai][bj][m][0], v1 = acc[ai][bj][m][1]; u32x4 w;
                    w.x = cvtpk2(v0[0], v0[1]); w.y = cvtpk2(v0[2], v0[3]); w.z = cvtpk2(v1[0], v1[1]); w.w = cvtpk2(v1[2], v1[3]);
                    *(u32x4*)(rowp + bj * HALF) = w; } }
    }
};
struct EpiRes {
    static constexpr bool PERM = false, AFTER_DRAIN = false;
    const float* xin; float* xout; const float* g;
    __device__ __forceinline__ void operator()(const f32x4 (&acc)[2][2][4][2], const Unit& u, int wr, int wc, int fr, int fq) const {
        const int row0 = u.pm * BM + wr * 64 + fr, col0 = u.pn * BM + wc * 32 + 4 * fq; const int b = u.pm >> 5;
        f32x4 gv[2][2];
#pragma unroll
        for (int bj = 0; bj < 2; ++bj)
#pragma unroll
            for (int n = 0; n < 2; ++n) gv[bj][n] = *(const f32x4*)(g + b * 6144 + col0 + bj * HALF + n * 16);
#pragma unroll
        for (int ai = 0; ai < 2; ++ai)
#pragma unroll
            for (int m = 0; m < 4; ++m) { const size_t off = (size_t)(row0 + ai * HALF + m * 16) * 1024 + col0;
#pragma unroll
                for (int bj = 0; bj < 2; ++bj)
#pragma unroll
                    for (int n = 0; n < 2; ++n) { const f32x4 xi = *(const f32x4*)(xin + off + bj * HALF + n * 16); *(f32x4*)(xout + off + bj * HALF + n * 16) = xi + gv[bj][n] * acc[ai][bj][m][n]; } }
    }
};
template <class Epi, class Sched, bool ALIGN_EPI = false, bool SP2 = false>
__device__ __forceinline__ void gemm_phase(PG8_LAS unsigned char* lds, const Gemm g, const Sched& S, const Epi& E) {
    int tid_ = threadIdx.x; asm volatile("" : "+v"(tid_));
    const int tid = tid_, wid = __builtin_amdgcn_readfirstlane(tid >> 6), lane = tid & 63, wr = wid >> 2, wc = wid & 3, fr = lane & 15, fq = lane >> 4;
    const int K = g.K, nt = K / BK;
    unsigned voffA[2], voffB[2];
#pragma unroll
    for (int i = 0; i < 2; ++i) { int R, C; stage_rc(tid * 16 + i * 8192, R, C); const int Rb = Epi::PERM ? ((R & ~31) + perm32(R & 31)) : R;
        voffA[i] = (unsigned)(R * K + C) * 2u; voffB[i] = (unsigned)(Rb * K + C) * 2u; }
    const size_t kstep = (size_t)(BK * 2);
    const size_t hstep = (size_t)HALF * K * 2;
    const size_t tstep = 2 * hstep;
    const unsigned ldsw = (unsigned)wid * 1024u;
    const int aoff = lds_byte(wr * 64 + fr, fq * 8), boff = lds_byte(wc * 32 + fr, fq * 8);
#define PG8_SA(b, h) (((b) * 2 + (h)) * HTB)
#define PG8_SB(b, h) ((4 + (b) * 2 + (h)) * HTB)
#define PG8_STAGE(bufoff, gbase, voff) do { _Pragma("unroll") for (int _i = 0; _i < 2; ++_i) \
        __builtin_amdgcn_global_load_lds((const unsigned*)((const char*)(gbase) + (voff)[_i]), (PG8_LAS unsigned*)(lds + (bufoff) + ldsw + _i * 8192), 16, 0, 0); } while (0)
#define PG8_LDA(dst, b, h) do { _Pragma("unroll") for (int m = 0; m < 4; ++m) _Pragma("unroll") for (int k = 0; k < 2; ++k) dst[m][k] = *(const PG8_LAS bf16x8*)(lds + PG8_SA(b, h) + aoff + m * 2048 + k * 1024); } while (0)
#define PG8_LDB(dst, b, h) do { _Pragma("unroll") for (int n = 0; n < 2; ++n) _Pragma("unroll") for (int k = 0; k < 2; ++k) dst[n][k] = *(const PG8_LAS bf16x8*)(lds + PG8_SB(b, h) + boff + n * 2048 + k * 1024); } while (0)
#define PG8_MMA(ai, bj, At, Bt) do { __builtin_amdgcn_s_setprio(1); _Pragma("unroll") for (int m = 0; m < 4; ++m) _Pragma("unroll") for (int n = 0; n < 2; ++n) _Pragma("unroll") for (int k = 0; k < 2; ++k) \
        acc[ai][bj][m][n] = __builtin_amdgcn_mfma_f32_16x16x32_bf16(Bt[n][k], At[m][k], acc[ai][bj][m][n], 0, 0, 0); __builtin_amdgcn_s_setprio(0); } while (0)
#define PG8_WAIT_V(n) asm volatile("s_waitcnt vmcnt(" #n ")" ::: "memory")
#define PG8_WAIT_L(n) asm volatile("s_waitcnt lgkmcnt(" #n ")" ::: "memory")
#define PG8_BAR __builtin_amdgcn_s_barrier()
#define PG8_SCHED __builtin_amdgcn_sched_barrier(0)
    Unit cur, nxt; int ui = 0;
    if (!S.next(0, cur)) return;
    f32x4 acc[2][2][4][2];
#pragma unroll
    for (int a = 0; a < 2; ++a)
#pragma unroll
        for (int b = 0; b < 2; ++b)
#pragma unroll
            for (int m = 0; m < 4; ++m)
#pragma unroll
                for (int n = 0; n < 2; ++n) acc[a][b][m][n] = (f32x4){0.f, 0.f, 0.f, 0.f};
    bf16x8 At[4][2], B0[2][2], B1[2][2];
    const char* cA = (const char*)g.A + (size_t)cur.pm * tstep; const char* cB = (const char*)g.Bt + (size_t)cur.pn * tstep;
    S.a_ready(cur);
    if constexpr (SP2) {
        PG8_STAGE(PG8_SB(0, 0), cB, voffB); PG8_STAGE(PG8_SB(0, 1), cB + hstep, voffB); PG8_STAGE(PG8_SA(0, 0), cA, voffA); PG8_STAGE(PG8_SA(0, 1), cA + hstep, voffA);
        if (wr == 1) PG8_BAR;
        PG8_WAIT_V(2); PG8_BAR;
        PG8_STAGE(PG8_SB(1, 0), cB + kstep, voffB); PG8_STAGE(PG8_SA(1, 0), cA + kstep, voffA); PG8_STAGE(PG8_SB(1, 1), cB + hstep + kstep, voffB);
        PG8_WAIT_V(6); PG8_BAR;
    } else {
        PG8_STAGE(PG8_SB(0, 0), cB, voffB); PG8_STAGE(PG8_SA(0, 0), cA, voffA); PG8_STAGE(PG8_SB(0, 1), cB + hstep, voffB); PG8_STAGE(PG8_SA(0, 1), cA + hstep, voffA);
        if (wr == 1) PG8_BAR;
        PG8_WAIT_V(4); PG8_BAR;
        PG8_STAGE(PG8_SB(1, 0), cB + kstep, voffB); PG8_STAGE(PG8_SA(1, 0), cA + kstep, voffA); PG8_STAGE(PG8_SB(1, 1), cB + hstep + kstep, voffB);
        PG8_WAIT_V(6); PG8_BAR;
    }
    for (;;) {
        const bool has_next = S.next(ui + 1, nxt);
        const char* nA = has_next ? (const char*)g.A + (size_t)nxt.pm * tstep : cA; const char* nB = has_next ? (const char*)g.Bt + (size_t)nxt.pn * tstep : cB;
        for (int t = 0; t < nt; t += 2) {
            const bool last = (t == nt - 2);
            const char* a1 = cA + (size_t)(t + 1) * kstep;
            const char* a2 = last ? nA : cA + (size_t)(t + 2) * kstep; const char* b2 = last ? nB : cB + (size_t)(t + 2) * kstep;
            const char* a3 = a2 + kstep; const char* b3 = b2 + kstep;
            if (last && has_next) S.a_ready(nxt);
            if constexpr (SP2) {
            PG8_LDB(B0, 0, 0); PG8_LDB(B1, 0, 1); PG8_SCHED; PG8_LDA(At, 0, 0); PG8_STAGE(PG8_SA(1, 1), a1 + hstep, voffA);
            PG8_WAIT_V(8); PG8_WAIT_L(0); PG8_BAR; PG8_MMA(0, 0, At, B0); PG8_MMA(0, 1, At, B1); PG8_BAR; PG8_SCHED;
            PG8_LDA(At, 0, 1); PG8_STAGE(PG8_SB(0, 0), b2, voffB); PG8_STAGE(PG8_SB(0, 1), b2 + hstep, voffB); PG8_STAGE(PG8_SA(0, 0), a2, voffA);
            PG8_WAIT_V(8); PG8_WAIT_L(0); PG8_BAR; PG8_MMA(1, 0, At, B0); PG8_MMA(1, 1, At, B1); PG8_BAR; PG8_SCHED;
            PG8_LDB(B0, 1, 0); PG8_LDB(B1, 1, 1); PG8_SCHED; PG8_LDA(At, 1, 0); PG8_STAGE(PG8_SA(0, 1), a2 + hstep, voffA);
            PG8_WAIT_V(8); PG8_WAIT_L(0); PG8_BAR; PG8_MMA(0, 0, At, B0); PG8_MMA(0, 1, At, B1); PG8_BAR; PG8_SCHED;
            PG8_LDA(At, 1, 1); PG8_STAGE(PG8_SB(1, 0), b3, voffB); PG8_STAGE(PG8_SB(1, 1), b3 + hstep, voffB); PG8_STAGE(PG8_SA(1, 0), a3, voffA);
            PG8_WAIT_V(8); PG8_WAIT_L(0); PG8_BAR; PG8_MMA(1, 0, At, B0); PG8_MMA(1, 1, At, B1); PG8_BAR; PG8_SCHED;
            } else {
            PG8_LDB(B0, 0, 0); PG8_SCHED; PG8_LDA(At, 0, 0); PG8_STAGE(PG8_SA(1, 1), a1 + hstep, voffA);
            PG8_WAIT_L(8); PG8_BAR; PG8_WAIT_L(0); PG8_MMA(0, 0, At, B0); PG8_BAR; PG8_SCHED;
            PG8_LDB(B1, 0, 1); PG8_STAGE(PG8_SB(0, 0), b2, voffB);
            PG8_BAR; PG8_WAIT_L(0); PG8_MMA(0, 1, At, B1); PG8_BAR;
            PG8_LDA(At, 0, 1); PG8_STAGE(PG8_SA(0, 0), a2, voffA);
            PG8_BAR; PG8_WAIT_L(0); PG8_MMA(1, 0, At, B0); PG8_BAR; PG8_SCHED;
            PG8_STAGE(PG8_SB(0, 1), b2 + hstep, voffB);
            PG8_WAIT_V(6); PG8_BAR; PG8_MMA(1, 1, At, B1); PG8_BAR;
            PG8_LDB(B0, 1, 0); PG8_SCHED; PG8_LDA(At, 1, 0); PG8_STAGE(PG8_SA(0, 1), a2 + hstep, voffA);
            PG8_WAIT_L(8); PG8_BAR; PG8_WAIT_L(0); PG8_MMA(0, 0, At, B0); PG8_BAR; PG8_SCHED;
            PG8_LDB(B1, 1, 1); PG8_STAGE(PG8_SB(1, 0), b3, voffB);
            PG8_BAR; PG8_WAIT_L(0); PG8_MMA(0, 1, At, B1); PG8_BAR;
            PG8_LDA(At, 1, 1); PG8_STAGE(PG8_SA(1, 0), a3, voffA);
            PG8_BAR; PG8_WAIT_L(0); PG8_MMA(1, 0, At, B0); PG8_BAR; PG8_SCHED;
            PG8_STAGE(PG8_SB(1, 1), b3 + hstep, voffB);
            PG8_WAIT_V(6); PG8_BAR; PG8_MMA(1, 1, At, B1); PG8_BAR;
            }
        }
        if constexpr (ALIGN_EPI) { if (wr == 0) PG8_BAR; }
        if constexpr (!Epi::AFTER_DRAIN) { E(acc, cur, wr, wc, fr, fq); S.done(cur); }
        if (!has_next) break;
#pragma unroll
        for (int a = 0; a < 2; ++a)
#pragma unroll
            for (int b = 0; b < 2; ++b)
#pragma unroll
                for (int m = 0; m < 4; ++m)
#pragma unroll
                    for (int n = 0; n < 2; ++n) acc[a][b][m][n] = (f32x4){0.f, 0.f, 0.f, 0.f};
        cur = nxt; cA = nA; cB = nB; ++ui;
        if constexpr (ALIGN_EPI) { if (wr == 1) PG8_BAR; }
    }
    PG8_WAIT_V(0);
    if constexpr (!ALIGN_EPI) { if (wr == 0) PG8_BAR; }
    PG8_BAR;
    if constexpr (Epi::AFTER_DRAIN) { E.fused(acc, cur, wr, wc, fr, fq, lds, wid, lane); S.done(cur); }
#undef PG8_SA
#undef PG8_SB
#undef PG8_STAGE
#undef PG8_LDA
#undef PG8_LDB
#undef PG8_MMA
#undef PG8_WAIT_V
#undef PG8_WAIT_L
#undef PG8_BAR
#undef PG8_SCHED
}
}
#define GAS __attribute__((address_space(1)))
#define LAS __attribute__((address_space(3)))
typedef unsigned short bf16;
typedef unsigned v4u __attribute__((ext_vector_type(4)));
typedef float f32x4 __attribute__((ext_vector_type(4)));
typedef short bf16x8 __attribute__((ext_vector_type(8)));
typedef GAS unsigned gu32;
typedef GAS unsigned long long gu64;
#define RLX_AGENT __ATOMIC_RELAXED, __HIP_MEMORY_SCOPE_AGENT
#define LDS_WAIT() asm volatile("s_waitcnt lgkmcnt(0)" ::: "memory")
#define VM_WAIT() asm volatile("s_waitcnt vmcnt(0)" ::: "memory")
__device__ __forceinline__ unsigned long long rt() { return __builtin_amdgcn_s_memrealtime(); }
__device__ __forceinline__ unsigned f2bf(float f) { unsigned u = __builtin_bit_cast(unsigned, f); return (u + 0x7fffu + ((u >> 16) & 1u)) >> 16; }
__device__ __forceinline__ unsigned pk2(float lo, float hi) { return f2bf(lo) | (f2bf(hi) << 16); }

#define XB_TMO      128
#define XB_XCNT(j)  (256  + 64 * (j))
#define XB_XSUB(j)  (1280 + 64 * (j))
#define XB_XGEN(j)  (2304 + 64 * (j))
#define XB_TOP      3328
#define XB_TOPGEN   3392
#define XCD_BAR_WORDS 3456
#define XB_SPIN_CAP (1u << 18)

__device__ __forceinline__ unsigned xb_ld(unsigned* p)              { return __hip_atomic_load(p, __ATOMIC_RELAXED, __HIP_MEMORY_SCOPE_AGENT); }
__device__ __forceinline__ unsigned xb_add(unsigned* p, unsigned v) { return __hip_atomic_fetch_add(p, v, __ATOMIC_RELAXED, __HIP_MEMORY_SCOPE_AGENT); }
__device__ __forceinline__ unsigned xb_xcc_id() { return (unsigned)__builtin_amdgcn_s_getreg((3 << 11) | 20) & 0xFu; }
#define XB_SPIN(cond, bar) do { unsigned _sp = 0; while (cond) { __builtin_amdgcn_s_sleep(1); \
    if ((++_sp & 255u) == 0u) { if (xb_ld(&(bar)[XB_TMO])) break; if (_sp > XB_SPIN_CAP) { atomicAdd(&(bar)[XB_TMO], 1u); break; } } } } while (0)

struct XcdBarrier {
    unsigned* bar; unsigned x;
    volatile LAS unsigned* st;
};

__device__ __forceinline__ XcdBarrier xcd_barrier_post(unsigned* bar, volatile LAS unsigned* st) {
    XcdBarrier b; b.bar = bar; b.x = xb_xcc_id(); b.st = st;
    if (threadIdx.x == 0) (void)xb_add(&bar[XB_XCNT(b.x)], 1u);
    return b;
}
__device__ __forceinline__ void xcd_barrier_complete(unsigned* bar, unsigned x, unsigned& nloc, unsigned& nx) {
    const unsigned G = gridDim.x * gridDim.y * gridDim.z;
    unsigned sum, cnt, mine, sp = 0u;
    for (;;) {
        sum = 0u; cnt = 0u; mine = 0u;
#pragma unroll
        for (unsigned j = 0; j < 16; ++j) { const unsigned c = xb_ld(&bar[XB_XCNT(j)]); sum += c; cnt += (c > 0u) ? 1u : 0u; mine = (j == x) ? c : mine; }
        if (sum == G) break;
        __builtin_amdgcn_s_sleep(1);
        if ((++sp & 255u) == 0u) { if (xb_ld(&bar[XB_TMO])) break; if (sp > XB_SPIN_CAP) { atomicAdd(&bar[XB_TMO], 1u); break; } }
    }
    nloc = mine > 0u ? mine : 1u; nx = cnt > 0u ? cnt : 1u;
}

__device__ __forceinline__ void xcd_barrier(const XcdBarrier& b) {
    asm volatile("s_waitcnt vmcnt(0)" ::: "memory");
    __syncthreads();
    if (threadIdx.x == 0) {
        unsigned* bar = b.bar;
        __builtin_amdgcn_s_waitcnt(0);
        unsigned nloc = b.st[0], nx = b.st[1];
        if (nloc == 0u) { xcd_barrier_complete(bar, b.x, nloc, nx); b.st[0] = nloc; b.st[1] = nx; }
        const unsigned old = xb_add(&bar[XB_XSUB(b.x)], 1u);
        const unsigned gen = old / nloc;
        if (old + 1u == (gen + 1u) * nloc) {
            __builtin_amdgcn_fence(__ATOMIC_RELEASE, "agent");
            asm volatile("s_waitcnt vmcnt(0)" ::: "memory");
            const unsigned og = xb_add(&bar[XB_TOP], 1u);
            const unsigned tg = og / nx;
            if (og + 1u == (tg + 1u) * nx) xb_add(&bar[XB_TOPGEN], 1u);
            else XB_SPIN(xb_ld(&bar[XB_TOPGEN]) == tg, bar);
            __builtin_amdgcn_fence(__ATOMIC_ACQUIRE, "agent");
            xb_add(&bar[XB_XGEN(b.x)], 1u);
            asm volatile("s_waitcnt vmcnt(0)" ::: "memory");
        } else {
            XB_SPIN(xb_ld(&bar[XB_XGEN(b.x)]) == gen, bar);
            __builtin_amdgcn_fence(__ATOMIC_ACQUIRE, "agent");
            asm volatile("s_waitcnt vmcnt(0)" ::: "memory");
        }
    }
    __syncthreads();
}
constexpr int NWAVES = 8, NTHR = 512;
constexpr int SEQ = 8192, DM = 1024, MROWS = 16384;
constexpr size_t MiB = 1u << 20;
constexpr size_t WS_CTL = 0, CTL_ZERO_BYTES = 2 * MiB;
constexpr size_t WS_KSUM = 1 * MiB;
constexpr size_t WS_MOD = 2 * MiB;
constexpr size_t WS_ROPE = 3 * MiB;
constexpr size_t WS_WIN0 = 4 * MiB, WS_WOUT0 = 9 * MiB, WS_WIN1 = 11 * MiB, WS_WOUT1 = 17 * MiB, WS_WQ0 = 19 * MiB, WS_WQ1 = 23 * MiB;
constexpr size_t WS_SUBK = 27 * MiB, WS_GWS = 28 * MiB, WS_MASK = 29 * MiB, WS_SC = 30 * MiB;
constexpr size_t WS_PTU = 32 * MiB, WS_PTV = 96 * MiB;
constexpr size_t WS_HN = 160 * MiB;
constexpr size_t WS_A = 192 * MiB;
constexpr size_t WS_YCAT = 288 * MiB, WS_QP = 320 * MiB, WS_PO = 384 * MiB, WS_PL = 448 * MiB, WS_END = 450 * MiB;
constexpr int CW_BAR = 4096, CW_WORK = 16384;

constexpr int RING_BYTES = 131072, LDSCTL_OFF = RING_BYTES, MISC_OFF = LDSCTL_OFF + 320, LDS_BYTES = 147456;

#define DI __device__ __forceinline__
typedef short bf16x8 __attribute__((ext_vector_type(8)));
typedef short s16x4 __attribute__((ext_vector_type(4)));
typedef float f32x16 __attribute__((ext_vector_type(16)));
typedef __bf16 bf16x2t __attribute__((ext_vector_type(2)));
#define MFMA32(a, b, c) __builtin_amdgcn_mfma_f32_32x32x16_bf16((a), (b), (c), 0, 0, 0)
using pg8::cvtpk2; using pg8::gelu_tanh;
DI int crow(int reg, int h) { return (reg & 3) + 8 * (reg >> 2) + 4 * h; }
DI float bf_lo(unsigned w) { return __uint_as_float(w << 16); }
DI float bf_hi(unsigned w) { return __uint_as_float(w & 0xffff0000u); }
DI bf16x8 ld16g(const bf16* p) { return *(const bf16x8*)p; }
DI bf16x8 ld8x2g(const bf16* p0, const bf16* p1) { const s16x4 a = *(const s16x4*)p0, b = *(const s16x4*)p1; return __builtin_shufflevector(a, b, 0, 1, 2, 3, 4, 5, 6, 7); }
DI float dot2bf(unsigned a, unsigned b, float c) { return __builtin_amdgcn_fdot2_f32_bf16(__builtin_bit_cast(bf16x2t, a), __builtin_bit_cast(bf16x2t, b), c, false); }
DI int f_ord(float f) { int i = __float_as_int(f); return i ^ ((i >> 31) & 0x7fffffff); }
DI float f_unord(int i) { return __int_as_float(i ^ ((i >> 31) & 0x7fffffff)); }
constexpr float LOG2E = 1.4426950408889634f, LN2 = 0.6931471805599453f;
#define KEY_MIN ((int)0x80000000)

struct Frame {
    LAS unsigned char* lds; volatile LAS unsigned* MISC; gu32* ctl; int tid, lane, wave, G, gw, NGW;
};

struct MapId { DI int operator()(int n) const { return n; } };
struct MapWin0 { DI int operator()(int n) const {
    if (n < 1024) return n;
    const int t = (n - 1024) >> 9, c = (n - 1024) & 511, hd = c >> 6, d = c & 63; int bj, p;
    if (t < 2) { if (d < 16) { const int nn = d >> 3, rr = d & 7; bj = 0; p = 8 * (rr >> 2) + 4 * nn + (rr & 3); } else if (d < 32) { bj = 0; p = d; } else { bj = 1; p = d - 32; } }
    else { bj = d >> 5; p = d & 31; }
    return 1024 + 512 * t + 256 * (hd >> 2) + 128 * bj + 32 * (hd & 3) + p; } };
struct MapWin1 { DI int operator()(int n) const { const int t = n >> 10, c = n & 1023, hd = c >> 6, d = c & 63; return 1024 * t + 256 * (hd >> 2) + 128 * (d >> 5) + 32 * (hd & 3) + (d & 31); } };
template <class Map> DI void p0_transpose_item(const float* W, int K, int N, bf16* WT, LAS float* scr, int item, int lane, Map map) {
    const int nblk = N / 32, kb = item / nblk, nb = item % nblk, k0 = 64 * kb, n0 = 32 * nb;
#pragma unroll 8
    for (int i = 0; i < 32; ++i) { const int kk = 2 * i + (lane >> 5); scr[kk * 33 + (lane & 31)] = W[(size_t)(k0 + kk) * N + n0 + (lane & 31)]; }
    LDS_WAIT(); asm volatile("" ::: "memory");
    const int c = lane & 7;
#pragma unroll
    for (int j = 0; j < 4; ++j) { const int n = (lane >> 3) + 8 * j; const LAS float* s = scr + (8 * c) * 33 + n;
        v4u o; o.x = pk2(s[0 * 33], s[1 * 33]); o.y = pk2(s[2 * 33], s[3 * 33]); o.z = pk2(s[4 * 33], s[5 * 33]); o.w = pk2(s[6 * 33], s[7 * 33]);
        *(GAS v4u*)(WT + (size_t)map(n0 + n) * K + k0 + 8 * c) = o; }
    LDS_WAIT(); asm volatile("" ::: "memory");
}
DI float wave_sum(float v) {
#pragma unroll
    for (int o = 1; o < 64; o <<= 1) v += __shfl_xor(v, o);
    return v;
}
struct P0Args { const float *c, *w_mod, *b_mod, *win0, *wout0, *win1, *wout1, *wq, *subk, *pu, *pv, *gws;
                float *MOD, *ROPE; bf16 *WIN0, *WOUT0, *WIN1, *WOUT1, *WQ0, *WQ1, *SUBK, *GWS; unsigned char *U8, *V8s; float *USC, *VSC; };
DI void p0_prologue(const Frame& F, const P0Args& A) {
    { LAS float* scr = (LAS float*)F.lds;
      for (int task = blockIdx.x; task < 192; task += F.G) {
          const int l = task / 96, n0 = (task % 96) * 64; const float* W = A.w_mod + (size_t)l * 1024 * 6144;
          float a0 = 0.f, a1 = 0.f; const int k0 = F.wave * 128;
#pragma unroll 8
          for (int k = k0; k < k0 + 128; ++k) { const float c0 = A.c[k], c1 = A.c[1024 + k]; const float s0 = c0 / (1.f + __expf(-c0)), s1 = c1 / (1.f + __expf(-c1));
              const float w = W[(size_t)k * 6144 + n0 + F.lane]; a0 += s0 * w; a1 += s1 * w; }
          scr[(F.wave * 2 + 0) * 64 + F.lane] = a0; scr[(F.wave * 2 + 1) * 64 + F.lane] = a1;
          __syncthreads();
          if (F.tid < 128) { const int b = F.tid >> 6, n = F.tid & 63; float s = 0.f;
#pragma unroll
              for (int w = 0; w < 8; ++w) s += scr[(w * 2 + b) * 64 + n];
              A.MOD[(size_t)(l * 2 + b) * 6144 + n0 + n] = s + A.b_mod[l * 6144 + n0 + n]; }
          __syncthreads();
      } }
    { LAS float* scr = (LAS float*)(F.lds + F.wave * 16384);
      constexpr int I0 = 16 * 80, I1 = 16 * 32, I2 = 16 * 96, I3 = 16 * 32, I4 = 16 * 64, I5 = 16 * 64, NIT = I0 + I1 + I2 + I3 + I4 + I5;
      for (int it = F.gw; it < NIT; it += F.NGW) { int r = it;
          if (r < I0) { p0_transpose_item(A.win0, 1024, 2560, A.WIN0, scr, r, F.lane, MapId()); continue; } r -= I0;
          if (r < I1) { p0_transpose_item(A.wout0, 1024, 1024, A.WOUT0, scr, r, F.lane, MapId()); continue; } r -= I1;
          if (r < I2) { p0_transpose_item(A.win1, 1024, 3072, A.WIN1, scr, r, F.lane, MapId()); continue; } r -= I2;
          if (r < I3) { p0_transpose_item(A.wout1, 1024, 1024, A.WOUT1, scr, r, F.lane, MapId()); continue; } r -= I3;
          if (r < I4) { p0_transpose_item(A.wq, 1024, 2048, A.WQ0, scr, r, F.lane, MapId()); continue; } r -= I4;
          p0_transpose_item(A.wq + (size_t)1024 * 2048, 1024, 2048, A.WQ1, scr, r, F.lane, MapId()); } }
    for (int row = F.gw; row < 65536; row += F.NGW) { const bool isv = row >= 32768; const int rr = row & 32767;
        const float* src = (isv ? A.pv : A.pu) + (size_t)rr * 1024; f32x4 v[4]; float mx = 0.f;
#pragma unroll
        for (int k = 0; k < 4; ++k) { v[k] = *(const f32x4*)(src + 4 * F.lane + 256 * k); mx = fmaxf(mx, fmaxf(fmaxf(fabsf(v[k][0]), fabsf(v[k][1])), fmaxf(fabsf(v[k][2]), fabsf(v[k][3])))); }
#pragma unroll
        for (int o = 1; o < 64; o <<= 1) mx = fmaxf(mx, __shfl_xor(mx, o));
        const float sc = mx > 0.f ? 384.0f / mx : 1.0f, inv = mx > 0.f ? mx * (1.0f / 384.0f) : 1.0f;
#pragma unroll
        for (int k = 0; k < 4; ++k) { int w = 0; w = __builtin_amdgcn_cvt_pk_fp8_f32(v[k][0] * sc, v[k][1] * sc, w, false); w = __builtin_amdgcn_cvt_pk_fp8_f32(v[k][2] * sc, v[k][3] * sc, w, true);
            if (!isv) *(unsigned*)(A.U8 + (size_t)rr * 1024 + 4 * F.lane + 256 * k) = (unsigned)w;
            else { const int l = rr >> 14, e = rr & 16383, slab = 2 * k + (F.lane >> 5); *(unsigned*)(A.V8s + (((size_t)l * 8 + slab) * 16384 + e) * 128 + 4 * (F.lane & 31)) = (unsigned)w; } }
        if (F.lane == 0) (isv ? A.VSC : A.USC)[rr] = inv; }
    { const size_t gt = (size_t)F.gw * 64 + F.lane, NT = (size_t)F.NGW * 64;
      for (size_t i = gt; i < 524288 / 8; i += NT) { const float* src = A.subk + i * 8; const f32x4 a = *(const f32x4*)src, b = *(const f32x4*)(src + 4); v4u o; o.x = cvtpk2(a[0], a[1]); o.y = cvtpk2(a[2], a[3]); o.z = cvtpk2(b[0], b[1]); o.w = cvtpk2(b[2], b[3]);
          *(v4u*)(A.SUBK + i * 8) = o; }
      for (size_t i = gt; i < 65536; i += NT) { const int t = (int)(i >> 7) & 127, s = (int)i & 127; A.GWS[i] = (bf16)(cvtpk2(s <= t ? A.gws[i] : 0.f, 0.f) & 0xffffu); }
      for (size_t i = gt; i < 65536; i += NT) { const int pos = (int)(i >> 3), fi = (int)i & 7; const float inv = powf(500000.0f, -(float)fi / 8.0f); const float ang = (float)pos * inv; float sn, cs; sincosf(ang, &sn, &cs);
          A.ROPE[(size_t)pos * 16 + fi] = cs; A.ROPE[(size_t)pos * 16 + 8 + fi] = sn; } }
}

DI void norm_rows(const Frame& F, const float* xs, const float* gamma, const float* modl, int shi, int sci, bf16* HN) {
    for (int m = F.gw; m < MROWS; m += F.NGW) { const int b = m >> 13;
        const f32x4* xr = (const f32x4*)(xs + (size_t)m * 1024) + F.lane; f32x4 v[4]; float s = 0.f;
#pragma unroll
        for (int j = 0; j < 4; ++j) { v[j] = xr[64 * j]; s += (v[j][0] * v[j][0] + v[j][1] * v[j][1]) + (v[j][2] * v[j][2] + v[j][3] * v[j][3]); }
        const float rinv = rsqrtf(wave_sum(s) * (1.0f / 1024.0f) + 1e-6f);
        unsigned long long* o8 = (unsigned long long*)(HN + (size_t)m * 1024) + F.lane;
#pragma unroll
        for (int j = 0; j < 4; ++j) { const int col = 4 * F.lane + 256 * j; const f32x4 gm = *(const f32x4*)(gamma + col), sc = *(const f32x4*)(modl + b * 6144 + sci * 1024 + col), sh = *(const f32x4*)(modl + b * 6144 + shi * 1024 + col);
            const f32x4 o = v[j] * rinv * gm * (sc + 1.0f) + sh; o8[64 * j] = (unsigned long long)cvtpk2(o[0], o[1]) | ((unsigned long long)cvtpk2(o[2], o[3]) << 32); }
    }
}


DI void qk_post_task(int task, const bf16* QKR, bf16* Q0, bf16* K0, float* KSUM, const float* rope, const float* gq, const float* gk, LAS float* scr, int tid, int wave, int lane) {
    const int tb = task >> 2, cq = task & 3; const bool isk = cq >= 2; const int head0 = (cq & 1) * 4, hl = (lane >> 2) & 3, qt = lane & 3, rsub = lane >> 4;
    const float* g = (isk ? gk : gq) + qt * 16; float gv[16];
#pragma unroll
    for (int i = 0; i < 16; ++i) gv[i] = g[i];
    float ks[16];
#pragma unroll
    for (int i = 0; i < 16; ++i) ks[i] = 0.f;
    const int b = tb >> 5; bf16* dstb = (isk ? K0 : Q0) + (size_t)(b * 8 + head0 + hl) * SEQ * 64 + qt * 16;
    for (int it = 0; it < 8; ++it) { const int row = tb * 256 + wave * 32 + it * 4 + rsub, s = row & (SEQ - 1);
        const bf16* src = QKR + (size_t)row * 1024 + cq * 256 + hl * 64 + qt * 16; const v4u w0 = *(const v4u*)src, w1 = *(const v4u*)(src + 8);
        float y[16]; y[0] = bf_lo(w0.x); y[1] = bf_hi(w0.x); y[2] = bf_lo(w0.y); y[3] = bf_hi(w0.y); y[4] = bf_lo(w0.z); y[5] = bf_hi(w0.z); y[6] = bf_lo(w0.w); y[7] = bf_hi(w0.w);
        y[8] = bf_lo(w1.x); y[9] = bf_hi(w1.x); y[10] = bf_lo(w1.y); y[11] = bf_hi(w1.y); y[12] = bf_lo(w1.z); y[13] = bf_hi(w1.z); y[14] = bf_lo(w1.w); y[15] = bf_hi(w1.w);
        float ss = 0.f;
#pragma unroll
        for (int i = 0; i < 16; ++i) ss += y[i] * y[i];
        ss += __shfl_xor(ss, 1); ss += __shfl_xor(ss, 2);
        const float rinv = rsqrtf(ss * (1.0f / 64.0f) + 1e-6f);
#pragma unroll
        for (int i = 0; i < 16; ++i) y[i] = y[i] * rinv * gv[i];
        if (qt == 0) { const float* rp = rope + (size_t)s * 16;
#pragma unroll
            for (int i = 0; i < 8; ++i) { const float c = rp[i], sn = rp[8 + i], x1 = y[i], x2 = y[i + 8]; y[i] = x1 * c - x2 * sn; y[i + 8] = x1 * sn + x2 * c; } }
        v4u o0, o1; o0.x = cvtpk2(y[0], y[1]); o0.y = cvtpk2(y[2], y[3]); o0.z = cvtpk2(y[4], y[5]); o0.w = cvtpk2(y[6], y[7]); o1.x = cvtpk2(y[8], y[9]); o1.y = cvtpk2(y[10], y[11]); o1.z = cvtpk2(y[12], y[13]); o1.w = cvtpk2(y[14], y[15]);
        bf16* d = dstb + (size_t)s * 64; *(v4u*)d = o0; *(v4u*)(d + 8) = o1;
#pragma unroll
        for (int i = 0; i < 16; ++i) ks[i] += y[i];
    }
    if (isk) {
#pragma unroll
        for (int i = 0; i < 16; ++i) { float c = ks[i]; c += __shfl_xor(c, 16); c += __shfl_xor(c, 32); ks[i] = c; }
        if (lane < 16) {
#pragma unroll
            for (int i = 0; i < 16; ++i) scr[(wave * 16 + lane) * 16 + i] = ks[i]; }
        __syncthreads();
        if (tid < 256) { const int l16 = tid >> 4, i = tid & 15; float sum = 0.f;
#pragma unroll
            for (int w = 0; w < 8; ++w) sum += scr[(w * 16 + l16) * 16 + i];
            KSUM[((size_t)(b * 8 + head0 + (l16 >> 2)) * 32 + (tb & 31)) * 64 + (l16 & 3) * 16 + i] = sum; }
        __syncthreads();
    }
}

DI f32x16 qk_tile(const bf16* krow, const bf16x8 (&qf)[4]) {
    f32x16 s;
#pragma unroll
    for (int i = 0; i < 16; ++i) s[i] = 0.f;
#pragma unroll
    for (int ks = 0; ks < 4; ++ks) s = MFMA32(ld16g(krow + 16 * ks), qf[ks], s);
    return s;
}
DI bf16x8 pack8(const f32x16& x, int s) { v4u p; p.x = cvtpk2(x[8 * s], x[8 * s + 1]); p.y = cvtpk2(x[8 * s + 2], x[8 * s + 3]); p.z = cvtpk2(x[8 * s + 4], x[8 * s + 5]); p.w = cvtpk2(x[8 * s + 6], x[8 * s + 7]); return __builtin_bit_cast(bf16x8, p); }
DI void pv_tile(f32x16 (&o)[2], const bf16* vt, const f32x16& p) {
#pragma unroll
    for (int s = 0; s < 2; ++s) { const bf16x8 pb = pack8(p, s);
#pragma unroll
        for (int mt = 0; mt < 2; ++mt) { const bf16* v = vt + (size_t)mt * 32 * SEQ + 16 * s; o[mt] = MFMA32(ld8x2g(v, v + 8), pb, o[mt]); } }
}
DI void store_ot(bf16* dst, const f32x16 (&o)[2], float sc, int h) {
#pragma unroll
    for (int mt = 0; mt < 2; ++mt)
#pragma unroll
        for (int g = 0; g < 4; ++g) { const unsigned lo = cvtpk2(o[mt][4 * g] * sc, o[mt][4 * g + 1] * sc), hi = cvtpk2(o[mt][4 * g + 2] * sc, o[mt][4 * g + 3] * sc);
            *(unsigned long long*)(dst + 32 * mt + 8 * g + 4 * h) = (unsigned long long)lo | ((unsigned long long)hi << 32); }
}
DI void moba_keys(const bf16* Kh, const bf16* VTh, const bf16x8 (&qf)[4], int key0, int nt, int diag, float mc2, f32x16 (&o)[2], float& l, int r, int h) {
    for (int kt = 0; kt < nt; ++kt) { const int kb = key0 + 32 * kt;
        f32x16 s = qk_tile(Kh + (size_t)(kb + r) * 64 + 8 * h, qf);
        float ls = 0.f;
#pragma unroll
        for (int i = 0; i < 16; ++i) { float p = __builtin_amdgcn_exp2f(s[i] * (0.125f * LOG2E) - mc2); if (kt == diag && crow(i, h) > r) p = 0.f; s[i] = p; ls += p; }
        l += ls;
        pv_tile(o, VTh + (size_t)r * SEQ + kb + 4 * h, s);
    }
}
DI float moba_mc2(const float* gq, const float* gk, int lane) {
    float a = fabsf(gq[lane]), b = fabsf(gk[lane]);
#pragma unroll
    for (int o = 1; o < 64; o <<= 1) { a = fmaxf(a, __shfl_xor(a, o)); b = fmaxf(b, __shfl_xor(b, o)); }
    return 8.0f * a * b * LOG2E;
}
struct MobaT { const bf16 *Q, *K, *VT; const float* ksum; unsigned* masks; bf16* PO; float* PL; const float *gq, *gk; };
DI void moba_mask_unit(int u, const MobaT& T, int lane) {
    const int bh = u >> 8, t0 = (u & 255) * 32, own = t0 >> 8, r = lane & 31, h = lane >> 5;
    unsigned mask = 0u;
    if (own > 0) {
        f32x16 g;
#pragma unroll
        for (int i = 0; i < 16; ++i) g[i] = 0.f;
        const float* km = T.ksum + ((size_t)bh * 32 + r) * 64 + 8 * h; const bf16* qp = T.Q + ((size_t)bh * SEQ + t0 + r) * 64 + 8 * h;
#pragma unroll
        for (int ks = 0; ks < 4; ++ks) { const f32x4 a0 = *(const f32x4*)(km + 16 * ks) * (1.0f / 256.0f), a1 = *(const f32x4*)(km + 16 * ks + 4) * (1.0f / 256.0f);
            v4u aw; aw.x = cvtpk2(a0[0], a0[1]); aw.y = cvtpk2(a0[2], a0[3]); aw.z = cvtpk2(a1[0], a1[1]); aw.w = cvtpk2(a1[2], a1[3]);
            g = MFMA32(__builtin_bit_cast(bf16x8, aw), ld16g(qp + 16 * ks), g); }
        int ka = KEY_MIN, kb2 = KEY_MIN, kc = KEY_MIN;
#define INS3(x_) do { int x = (x_); int t = min(ka, x); ka = max(ka, x); int uu = min(kb2, t); kb2 = max(kb2, t); kc = max(kc, uu); } while (0)
#pragma unroll
        for (int i = 0; i < 16; ++i) { const int blk = crow(i, h); const int key = (blk < own) ? ((f_ord(g[i]) & ~31) | (31 - blk)) : KEY_MIN; INS3(key); }
        const int pa = __shfl_xor(ka, 32), pb = __shfl_xor(kb2, 32), pc = __shfl_xor(kc, 32);
        INS3(pa); INS3(pb); INS3(pc);
#undef INS3
        if (ka != KEY_MIN) mask |= 1u << (31 - (ka & 31));
        if (kb2 != KEY_MIN) mask |= 1u << (31 - (kb2 & 31));
        if (kc != KEY_MIN) mask |= 1u << (31 - (kc & 31));
    }
    if (h == 0) T.masks[(size_t)bh * SEQ + t0 + r] = mask;
}
DI void moba_own_unit(int u, const MobaT& T, float mc2, int lane) {
    const int bh = u >> 8, t0 = (u & 255) * 32, own = t0 >> 8, r = lane & 31, h = lane >> 5;
    const bf16* qp = T.Q + ((size_t)bh * SEQ + t0 + r) * 64 + 8 * h; bf16x8 qf[4];
#pragma unroll
    for (int ks = 0; ks < 4; ++ks) qf[ks] = ld16g(qp + 16 * ks);
    f32x16 o[2];
#pragma unroll
    for (int i = 0; i < 16; ++i) { o[0][i] = 0.f; o[1][i] = 0.f; }
    float l = 0.f; const int key0 = own * 256, nt = ((t0 - key0) >> 5) + 1;
    moba_keys(T.K + (size_t)bh * SEQ * 64, T.VT + (size_t)bh * 64 * SEQ, qf, key0, nt, nt - 1, mc2, o, l, r, h);
    l += __shfl_xor(l, 32);
    const size_t base = ((size_t)bh * SEQ + t0 + r) * 4 + 3;
    store_ot(T.PO + base * 64, o, 1.0f, h); if (h == 0) T.PL[base] = l;
}
DI void moba_sel_batch(const MobaT& T, int bh, int j, const LAS unsigned* wq, int nv, float mc2, int lane) {
    const int r = lane & 31, h = lane >> 5; const bool valid = r < nv; const int t = (int)wq[valid ? r : 0];
    const unsigned m = T.masks[(size_t)bh * SEQ + t]; const int slot = __builtin_popcount(m & ((1u << j) - 1u));
    const bf16* qp = T.Q + ((size_t)bh * SEQ + t) * 64 + 8 * h; bf16x8 qf[4];
#pragma unroll
    for (int ks = 0; ks < 4; ++ks) qf[ks] = ld16g(qp + 16 * ks);
    f32x16 o[2];
#pragma unroll
    for (int i = 0; i < 16; ++i) { o[0][i] = 0.f; o[1][i] = 0.f; }
    float l = 0.f;
    moba_keys(T.K + (size_t)bh * SEQ * 64, T.VT + (size_t)bh * 64 * SEQ, qf, j * 256, 8, -1, mc2, o, l, r, h);
    l += __shfl_xor(l, 32);
    if (valid) { const size_t base = ((size_t)bh * SEQ + t) * 4 + slot; store_ot(T.PO + base * 64, o, 1.0f, h); if (h == 0) T.PL[base] = l; }
}
constexpr int MOBA_NTASK = 16 * 136;
DI void moba_sel_task(int task, const MobaT& T, LAS unsigned* wq, float mc2, int lane) {
    int c = 0, rem = task; while (rem >= 16 * (4 * c + 3)) { rem -= 16 * (4 * c + 3); ++c; }
    const int j = rem >> 4, bh = rem & 15; int n = 0;
    for (int step = 0; step < 16; ++step) { const int t = c * 1024 + step * 64 + lane; const unsigned m = T.masks[(size_t)bh * SEQ + t]; const bool sel = (m >> j) & 1u;
        const unsigned long long bal = __ballot(sel);
        if (sel) wq[n + __builtin_popcountll(bal & ((1ull << lane) - 1ull))] = (unsigned)t;
        n += __builtin_popcountll(bal);
        asm volatile("s_waitcnt lgkmcnt(0)" ::: "memory");
        while (n >= 32) { moba_sel_batch(T, bh, j, wq + (n - 32), 32, mc2, lane); n -= 32; asm volatile("s_waitcnt lgkmcnt(0)" ::: "memory"); }
    }
    if (n > 0) moba_sel_batch(T, bh, j, wq, n, mc2, lane);
    asm volatile("s_waitcnt lgkmcnt(0)" ::: "memory");
}
DI void moba_combine(const Frame& F, const bf16* PO, const float* PL, bf16* YCAT) {
    const size_t gt = (size_t)F.gw * 64 + F.lane, NT = (size_t)F.NGW * 64;
    for (size_t i = gt; i < (size_t)16 * SEQ * 8; i += NT) { const int dq = (int)i & 7, t = (int)(i >> 3) & (SEQ - 1), bh = (int)(i >> 16); const int own = t >> 8, ns = own < 3 ? own : 3;
        float o[8]; float l = 0.f;
#pragma unroll
        for (int k = 0; k < 8; ++k) o[k] = 0.f;
#pragma unroll
        for (int s = 0; s < 4; ++s) { if (s < ns || s == 3) { const size_t base = ((size_t)bh * SEQ + t) * 4 + s; l += PL[base]; const v4u w = *(const v4u*)(PO + base * 64 + dq * 8);
                o[0] += bf_lo(w.x); o[1] += bf_hi(w.x); o[2] += bf_lo(w.y); o[3] += bf_hi(w.y); o[4] += bf_lo(w.z); o[5] += bf_hi(w.z); o[6] += bf_lo(w.w); o[7] += bf_hi(w.w); } }
        const float il = 1.0f / l; v4u w; w.x = cvtpk2(o[0] * il, o[1] * il); w.y = cvtpk2(o[2] * il, o[3] * il); w.z = cvtpk2(o[4] * il, o[5] * il); w.w = cvtpk2(o[6] * il, o[7] * il);
        *(v4u*)(YCAT + ((size_t)(bh >> 3) * SEQ + t) * 1024 + 512 + (bh & 7) * 64 + dq * 8) = w; }
}

DI void gmlp_unit(int unit, const bf16* UA, const bf16* VA, const float* vgain, const bf16* GWS, const float* bs, bf16* YCAT, LAS unsigned char* lds, int tid, int wave, int lane) {
    const int cidx = unit >> 2, g = unit & 3, row0 = cidx * 128; LAS bf16* VNT = (LAS bf16*)lds;
    { const int row = tid >> 2, dq = (tid & 3) * 32; const bf16* src = VA + (size_t)(row0 + row) * 512 + g * 128 + dq;
      float f[32]; float ss = 0.f;
#pragma unroll
      for (int k = 0; k < 4; ++k) { const v4u w = *(const v4u*)(src + 8 * k); f[8 * k] = bf_lo(w.x); f[8 * k + 1] = bf_hi(w.x); f[8 * k + 2] = bf_lo(w.y); f[8 * k + 3] = bf_hi(w.y); f[8 * k + 4] = bf_lo(w.z); f[8 * k + 5] = bf_hi(w.z); f[8 * k + 6] = bf_lo(w.w); f[8 * k + 7] = bf_hi(w.w); }
#pragma unroll
      for (int k = 0; k < 32; ++k) ss += f[k] * f[k];
      ss += __shfl_xor(ss, 1); ss += __shfl_xor(ss, 2);
      const float rinv = rsqrtf(ss * (1.0f / 128.0f) + 1e-6f);
#pragma unroll
      for (int k = 0; k < 32; ++k) VNT[(dq + k) * 136 + row] = (bf16)(cvtpk2(f[k] * rinv * vgain[g * 128 + dq + k], 0.f) & 0xffffu); }
    __syncthreads();
    { const int mt = wave >> 1, ntb = (wave & 1) * 2, r = lane & 31, h = lane >> 5;
      f32x16 acc[2];
#pragma unroll
      for (int i = 0; i < 16; ++i) { acc[0][i] = 0.f; acc[1][i] = 0.f; }
      const bf16* wp = GWS + ((size_t)g * 128 + 32 * mt + r) * 128 + 8 * h;
      for (int ks = 0; ks < 2 * (mt + 1); ++ks) { const bf16x8 a = ld16g(wp + 16 * ks);
#pragma unroll
          for (int nn = 0; nn < 2; ++nn) { const bf16x8 b = *(const LAS bf16x8*)(VNT + (32 * (ntb + nn) + r) * 136 + 16 * ks + 8 * h); acc[nn] = MFMA32(a, b, acc[nn]); } }
#pragma unroll
      for (int nn = 0; nn < 2; ++nn)
#pragma unroll
          for (int i = 0; i < 16; ++i) { const int t = 32 * mt + crow(i, h), d = 32 * (ntb + nn) + r; const float mixed = acc[nn][i] + bs[g * 128 + t];
              const float uv = __uint_as_float((unsigned)UA[(size_t)(row0 + t) * 512 + g * 128 + d] << 16);
              YCAT[(size_t)(row0 + t) * 1024 + g * 128 + d] = (bf16)(cvtpk2(uv * mixed, 0.f) & 0xffffu); } }
    __syncthreads();
}

DI void sb_unit(int u, const bf16* Q, const bf16* K, const bf16* VT, bf16* YCAT, int lane) {
    const int bh = u >> 8, t0 = (u & 255) * 32, r = lane & 31, h = lane >> 5;
    const bf16* qp = Q + ((size_t)bh * SEQ + t0 + r) * 64 + 8 * h; bf16x8 qf[4];
#pragma unroll
    for (int ks = 0; ks < 4; ++ks) qf[ks] = ld16g(qp + 16 * ks);
    const bf16* Kh = K + (size_t)bh * SEQ * 64; const bf16* VTh = VT + (size_t)bh * 64 * SEQ;
    f32x16 o[2];
#pragma unroll
    for (int i = 0; i < 16; ++i) { o[0][i] = 0.f; o[1][i] = 0.f; }
    float R = 0.f;
    for (int kb = t0; kb >= 0; kb -= 32) {
        f32x16 s = qk_tile(Kh + (size_t)(kb + r) * 64 + 8 * h, qf);
        const bool diag = (kb == t0);
        f32x16 x;
#pragma unroll
        for (int i = 0; i < 16; ++i) { const float z = s[i] * 0.125f; const float t = __builtin_amdgcn_exp2f(-fabsf(z) * LOG2E); const float sp = fmaxf(z, 0.f) + LN2 * __builtin_amdgcn_logf(1.0f + t);
            const bool valid = !(diag && crow(i, h) >= r); x[i] = valid ? -sp : 0.f; s[i] = valid ? z : -INFINITY; }
        float T4[4], E[16];
#pragma unroll
        for (int g = 0; g < 4; ++g) { E[4 * g + 3] = 0.f; E[4 * g + 2] = x[4 * g + 3]; E[4 * g + 1] = E[4 * g + 2] + x[4 * g + 2]; E[4 * g] = E[4 * g + 1] + x[4 * g + 1]; T4[g] = E[4 * g] + x[4 * g]; }
        float P4[4];
#pragma unroll
        for (int g = 0; g < 4; ++g) P4[g] = __shfl_xor(T4[g], 32);
        float C[4]; float run = 0.f;
#pragma unroll
        for (int g = 3; g >= 0; --g) { C[g] = run + (h == 0 ? P4[g] : 0.f); run += T4[g] + P4[g]; }
#pragma unroll
        for (int i = 0; i < 16; ++i) { const float arg = x[i] + s[i] + (R + C[i >> 2] + E[i]); x[i] = __builtin_amdgcn_exp2f(arg * LOG2E); }
        pv_tile(o, VTh + (size_t)r * SEQ + kb + 4 * h, x);
        R += run;
        if (!__any(R >= -104.0f)) break;
    }
    store_ot(YCAT + ((size_t)(bh >> 4) * SEQ + t0 + r) * 1024 + (bh & 15) * 64, o, 1.0f, h);
}

#define INS16(L, x_) do { int x = (x_); _Pragma("unroll") for (int q_ = 0; q_ < 16; ++q_) { const int hi_ = max(L[q_], x); x = min(L[q_], x); L[q_] = hi_; } } while (0)
DI void peer_scores(int tokg, int head, const bf16* QP, const bf16* SUBK, unsigned* ent  , int lane) {
    const int r = lane & 31, h = lane >> 5;
    int L1[16], L2[16];
#pragma unroll
    for (int p = 0; p < 2; ++p) {
        const bf16* qp = QP + (size_t)(tokg + r) * 2048 + head * 256 + p * 128 + 8 * h; bf16x8 qf[8];
#pragma unroll
        for (int ks = 0; ks < 8; ++ks) qf[ks] = ld16g(qp + 16 * ks);
        const bf16* sk = SUBK + (size_t)((head * 2 + p) * 128 + r) * 128 + 8 * h;
        int L[16];
#pragma unroll
        for (int i = 0; i < 16; ++i) L[i] = KEY_MIN;
#pragma unroll 1
        for (int mt = 0; mt < 4; ++mt) {
            f32x16 acc;
#pragma unroll
            for (int i = 0; i < 16; ++i) acc[i] = 0.f;
#pragma unroll
            for (int ks = 0; ks < 8; ++ks) acc = MFMA32(ld16g(sk + (size_t)mt * 32 * 128 + 16 * ks), qf[ks], acc);
#pragma unroll
            for (int i = 0; i < 16; ++i) INS16(L, (f_ord(acc[i]) & ~127) | (32 * mt + crow(i, h)));
        }
        int Pn[16];
#pragma unroll
        for (int i = 0; i < 16; ++i) Pn[i] = __shfl_xor(L[i], 32);
#pragma unroll
        for (int i = 0; i < 16; ++i) INS16(L, Pn[i]);
#pragma unroll
        for (int i = 0; i < 16; ++i) { if (p == 0) L1[i] = L[i]; else L2[i] = L[i]; }
    }
    int Cn[16];
#pragma unroll
    for (int i = 0; i < 16; ++i) Cn[i] = KEY_MIN;
#pragma unroll
    for (int i = 0; i < 16; ++i)
#pragma unroll
        for (int j = 0; j < 16; ++j) if ((i + 1) * (j + 1) <= 16) { const float v = f_unord(L1[i] & ~127) + f_unord(L2[j] & ~127); INS16(Cn, (f_ord(v) & ~0x3fff) | ((L1[i] & 127) << 7) | (L2[j] & 127)); }
    float e[16]; float sum = 0.f; const float m0 = f_unord(Cn[0] & ~0x3fff);
#pragma unroll
    for (int k = 0; k < 16; ++k) { e[k] = __builtin_amdgcn_exp2f((f_unord(Cn[k] & ~0x3fff) - m0) * LOG2E); sum += e[k]; }
    const float inv = 1.0f / sum;
    if (h == 0) { unsigned* dst = ent + (size_t)r * 128 + head * 16;
#pragma unroll
        for (int g4 = 0; g4 < 4; ++g4) { v4u w;
            w.x = (cvtpk2(0.f, e[4 * g4] * inv) & 0xffff0000u) | (unsigned)(Cn[4 * g4] & 0x3fff); w.y = (cvtpk2(0.f, e[4 * g4 + 1] * inv) & 0xffff0000u) | (unsigned)(Cn[4 * g4 + 1] & 0x3fff);
            w.z = (cvtpk2(0.f, e[4 * g4 + 2] * inv) & 0xffff0000u) | (unsigned)(Cn[4 * g4 + 2] & 0x3fff); w.w = (cvtpk2(0.f, e[4 * g4 + 3] * inv) & 0xffff0000u) | (unsigned)(Cn[4 * g4 + 3] & 0x3fff);
            *(v4u*)(dst + 4 * g4) = w; } }
}
typedef float f32x2 __attribute__((ext_vector_type(2)));
DI f32x2 fp8lo(unsigned w) { return __builtin_amdgcn_cvt_pk_f32_fp8((int)w, false); }
DI f32x2 fp8hi(unsigned w) { return __builtin_amdgcn_cvt_pk_f32_fp8((int)w, true); }
DI f32x2 fma2(f32x2 a, f32x2 b, f32x2 c) { return __builtin_elementwise_fma(a, b, c); }
DI void peer_u_token(int tok, int slab, const unsigned* ENT, const bf16* HN, const unsigned char* U8, const float* USC, const float* VSC, float* ACT, int lane) {
    const unsigned e0 = ENT[(size_t)tok * 128 + lane], e1 = ENT[(size_t)tok * 128 + 64 + lane];
    unsigned long long b0 = __ballot(((e0 >> 11) & 7u) == (unsigned)slab), b1 = __ballot(((e1 >> 11) & 7u) == (unsigned)slab);
    const v4u ha = *(const v4u*)(HN + (size_t)tok * 1024 + 16 * lane), hb = *(const v4u*)(HN + (size_t)tok * 1024 + 16 * lane + 8);
    f32x2 hf[8];
    hf[0] = (f32x2){bf_lo(ha.x), bf_hi(ha.x)}; hf[1] = (f32x2){bf_lo(ha.y), bf_hi(ha.y)}; hf[2] = (f32x2){bf_lo(ha.z), bf_hi(ha.z)}; hf[3] = (f32x2){bf_lo(ha.w), bf_hi(ha.w)};
    hf[4] = (f32x2){bf_lo(hb.x), bf_hi(hb.x)}; hf[5] = (f32x2){bf_lo(hb.y), bf_hi(hb.y)}; hf[6] = (f32x2){bf_lo(hb.z), bf_hi(hb.z)}; hf[7] = (f32x2){bf_lo(hb.w), bf_hi(hb.w)};
    const int myk = 2 * (lane & 1) + ((lane >> 1) & 1);
    while (b0 | b1) {
        unsigned ev[4]; int slot[4]; bool ok[4];
#pragma unroll
        for (int k = 0; k < 4; ++k) {
            if (b0) { const int i = __builtin_ctzll(b0); b0 &= b0 - 1; ev[k] = (unsigned)__builtin_amdgcn_readlane((int)e0, i); slot[k] = i; ok[k] = true; }
            else if (b1) { const int i = __builtin_ctzll(b1); b1 &= b1 - 1; ev[k] = (unsigned)__builtin_amdgcn_readlane((int)e1, i); slot[k] = 64 + i; ok[k] = true; }
            else { ev[k] = ev[0]; slot[k] = slot[0]; ok[k] = false; } }
        v4u rw[4];
#pragma unroll
        for (int k = 0; k < 4; ++k) rw[k] = *(const v4u*)(U8 + (size_t)(ev[k] & 0x3fffu) * 1024 + 16 * lane);
        float p[4];
#pragma unroll
        for (int k = 0; k < 4; ++k) { f32x2 a = (f32x2){0.f, 0.f};
            a = fma2(fp8lo(rw[k].x), hf[0], a); a = fma2(fp8hi(rw[k].x), hf[1], a); a = fma2(fp8lo(rw[k].y), hf[2], a); a = fma2(fp8hi(rw[k].y), hf[3], a);
            a = fma2(fp8lo(rw[k].z), hf[4], a); a = fma2(fp8hi(rw[k].z), hf[5], a); a = fma2(fp8lo(rw[k].w), hf[6], a); a = fma2(fp8hi(rw[k].w), hf[7], a); p[k] = a.x + a.y; }
        const bool u0 = (lane & 1) != 0, u1 = (lane & 2) != 0;
        float k0 = u0 ? p[2] : p[0], k1 = u0 ? p[3] : p[1]; const float s0 = u0 ? p[0] : p[2], s1 = u0 ? p[1] : p[3];
        k0 += __shfl_xor(s0, 1); k1 += __shfl_xor(s1, 1);
        float kk = u1 ? k1 : k0; const float ss = u1 ? k0 : k1; kk += __shfl_xor(ss, 2);
        kk += __shfl_xor(kk, 4); kk += __shfl_xor(kk, 8); kk += __shfl_xor(kk, 16); kk += __shfl_xor(kk, 32);
        const unsigned mev = myk == 0 ? ev[0] : (myk == 1 ? ev[1] : (myk == 2 ? ev[2] : ev[3]));
        const int mslot = myk == 0 ? slot[0] : (myk == 1 ? slot[1] : (myk == 2 ? slot[2] : slot[3]));
        const bool mok = myk == 0 ? ok[0] : (myk == 1 ? ok[1] : (myk == 2 ? ok[2] : ok[3]));
        if (lane < 4 && mok) { const unsigned eid = mev & 0x3fffu; ACT[(size_t)tok * 128 + mslot] = gelu_tanh(kk * USC[eid]) * __uint_as_float(mev & 0xffff0000u) * VSC[eid]; }
    }
}
DI void peer_v_token(int tok, int slab, const unsigned* ENT, const float* ACT, const unsigned char* V8slab, float* X, const float* g2, int lane) {
    const int sub = lane & 7, j = lane >> 3;
    const v4u* ep = (const v4u*)(ENT + (size_t)tok * 128 + 16 * j); const f32x4* ap = (const f32x4*)(ACT + (size_t)tok * 128 + 16 * j);
    v4u en[4]; f32x4 aw[4];
#pragma unroll
    for (int q = 0; q < 4; ++q) { en[q] = ep[q]; aw[q] = ap[q]; }
    f32x2 acc[8];
#pragma unroll
    for (int c = 0; c < 8; ++c) acc[c] = (f32x2){0.f, 0.f};
    v4u rw[16];
#pragma unroll
    for (int i = 0; i < 16; ++i) rw[i] = *(const v4u*)(V8slab + (size_t)(en[i >> 2][i & 3] & 0x3fffu) * 128 + 16 * sub);
#pragma unroll
    for (int i = 0; i < 16; ++i) { const float w = aw[i >> 2][i & 3]; const f32x2 w2 = (f32x2){w, w};
        acc[0] = fma2(fp8lo(rw[i].x), w2, acc[0]); acc[1] = fma2(fp8hi(rw[i].x), w2, acc[1]); acc[2] = fma2(fp8lo(rw[i].y), w2, acc[2]); acc[3] = fma2(fp8hi(rw[i].y), w2, acc[3]);
        acc[4] = fma2(fp8lo(rw[i].z), w2, acc[4]); acc[5] = fma2(fp8hi(rw[i].z), w2, acc[5]); acc[6] = fma2(fp8lo(rw[i].w), w2, acc[6]); acc[7] = fma2(fp8hi(rw[i].w), w2, acc[7]); }
    { const bool up = (lane & 8) != 0;
#pragma unroll
      for (int c = 0; c < 4; ++c) { const f32x2 keep = up ? acc[c + 4] : acc[c], send = up ? acc[c] : acc[c + 4]; acc[c] = (f32x2){keep.x + __shfl_xor(send.x, 8), keep.y + __shfl_xor(send.y, 8)}; } }
    { const bool up = (lane & 16) != 0;
#pragma unroll
      for (int c = 0; c < 2; ++c) { const f32x2 keep = up ? acc[c + 2] : acc[c], send = up ? acc[c] : acc[c + 2]; acc[c] = (f32x2){keep.x + __shfl_xor(send.x, 16), keep.y + __shfl_xor(send.y, 16)}; } }
    { const bool up = (lane & 32) != 0; const f32x2 keep = up ? acc[1] : acc[0], send = up ? acc[0] : acc[1]; acc[0] = (f32x2){keep.x + __shfl_xor(send.x, 32), keep.y + __shfl_xor(send.y, 32)}; }
    const int col = 128 * slab + 16 * sub + 2 * (4 * ((lane >> 3) & 1) + 2 * ((lane >> 4) & 1) + ((lane >> 5) & 1));
    float* xp = X + (size_t)tok * 1024 + col; const f32x2 xv = *(const f32x2*)xp, gv = *(const f32x2*)(g2 + (tok >> 13) * 6144 + col);
    *(f32x2*)xp = (f32x2){xv.x + gv.x * acc[0].x, xv.y + gv.y * acc[0].y};
}
struct PeerT { const unsigned char *U8, *V8s; const float *USC, *VSC; unsigned* ENT; float* ACT; const bf16* HN; float* X; const float* g2; };
DI void peer_scores_phase(const Frame& F, const bf16* QP, const bf16* SUBK, unsigned* ENT) {
    for (int unit = blockIdx.x; unit < MROWS / 64; unit += F.G) {
#pragma unroll 1
        for (int grp = 0; grp < 2; ++grp) { const int tokg = unit * 64 + 32 * grp; peer_scores(tokg, F.wave, QP, SUBK, ENT + (size_t)tokg * 128, F.lane); } }
}
template <int PASS> DI void peer_gather_phase(const Frame& F, int cnt_base, const PeerT& T) {
    const int xcc = (int)(xb_xcc_id() & 7u); LAS int* bc = (LAS int*)(F.lds + 65536);
    for (int k = 0; k < 8; ++k) { const int s = (xcc + k) & 7; unsigned* cnt = (unsigned*)(F.ctl + CW_WORK + 64 * (cnt_base + s));
        for (;;) {
            if (F.tid == 0) *bc = (int)__hip_atomic_fetch_add(cnt, 1u, __ATOMIC_RELAXED, __HIP_MEMORY_SCOPE_AGENT);
            __syncthreads(); const int chunk = *bc; __syncthreads();
            if (chunk >= MROWS / 64) break;
#pragma unroll 1
            for (int i = 0; i < 8; ++i) { const int tok = chunk * 64 + F.wave * 8 + i;
                if (PASS == 0) peer_u_token(tok, s, T.ENT, T.HN, T.U8, T.USC, T.VSC, T.ACT, F.lane);
                else peer_v_token(tok, s, T.ENT, T.ACT, T.V8s + (size_t)s * 16384 * 128, T.X, T.g2, F.lane); }
        } }
}
struct Args { const float* in[19]; float* out; unsigned char* ws; int stage, pad; };
__global__ void __launch_bounds__(NTHR, 2) hybrid_fwd(Args args) {
    extern __shared__ __attribute__((aligned(16))) unsigned char lds_raw[];
    for (int u = threadIdx.x; u < (LDS_BYTES - LDSCTL_OFF) / 4; u += NTHR) ((LAS unsigned*)((LAS unsigned char*)lds_raw + LDSCTL_OFF))[u] = 0u;
    __syncthreads();
    XcdBarrier bar = xcd_barrier_post((unsigned*)((gu32*)(args.ws + WS_CTL) + CW_BAR), (volatile LAS unsigned*)((LAS unsigned char*)lds_raw + MISC_OFF) + 8);
#define GRID_BAR() xcd_barrier(bar)
#define OPQ(p) ({ auto p_ = (p); asm volatile("" : "+s"(p_)); p_; })
#define PH_PTRS \
    unsigned char* ws = OPQ(args.ws); const float* x_in = OPQ(args.in[0]); float* X = OPQ(args.out); \
    const float *norm_mix = args.in[4], *norm_ffn = args.in[5]; \
    float* MOD = (float*)(ws + WS_MOD); float* ROPE = (float*)(ws + WS_ROPE); float* KSUM = (float*)(ws + WS_KSUM); \
    bf16 *WIN0 = (bf16*)(ws + WS_WIN0), *WOUT0 = (bf16*)(ws + WS_WOUT0), *WIN1 = (bf16*)(ws + WS_WIN1), *WOUT1 = (bf16*)(ws + WS_WOUT1), *WQ0 = (bf16*)(ws + WS_WQ0), *WQ1 = (bf16*)(ws + WS_WQ1); \
    bf16 *SUBK = (bf16*)(ws + WS_SUBK), *GWS = (bf16*)(ws + WS_GWS), *HN = (bf16*)(ws + WS_HN); \
    bf16 *UA = (bf16*)(ws + WS_A), *VA = (bf16*)(ws + WS_A + 16 * MiB), *Q0 = (bf16*)(ws + WS_A + 32 * MiB), *K0 = (bf16*)(ws + WS_A + 48 * MiB), *VT0 = (bf16*)(ws + WS_A + 64 * MiB); \
    bf16 *Q1 = (bf16*)(ws + WS_A), *K1 = (bf16*)(ws + WS_A + 32 * MiB), *VT1 = (bf16*)(ws + WS_A + 64 * MiB); \
    bf16 *YCAT = (bf16*)(ws + WS_YCAT), *QP = (bf16*)(ws + WS_QP), *PO = (bf16*)(ws + WS_PO); float* PL = (float*)(ws + WS_PL); unsigned* MASKS = (unsigned*)(ws + WS_MASK); unsigned char *U8 = ws + WS_PTU, *V8s = ws + WS_PTV; float *USC = (float*)(ws + WS_SC), *VSC = USC + 32768; unsigned* ENT = (unsigned*)(ws + WS_PO); float* ACT = (float*)(ws + WS_PO + 8 * MiB); (void)U8; (void)V8s; (void)USC; (void)VSC; (void)ENT; (void)ACT; bf16* QKR = (bf16*)(ws + WS_QP); (void)QKR; \
    (void)x_in; (void)X; (void)norm_mix; (void)norm_ffn; (void)MOD; (void)ROPE; (void)KSUM; (void)WIN0; (void)WOUT0; (void)WIN1; (void)WOUT1; (void)WQ0; (void)WQ1; (void)SUBK; (void)GWS; (void)HN; \
    (void)UA; (void)VA; (void)Q0; (void)K0; (void)VT0; (void)Q1; (void)K1; (void)VT1; (void)YCAT; (void)QP; (void)PO; (void)PL; (void)MASKS;
#define PH_FRAME Frame F; F.lds = (LAS unsigned char*)lds_raw; F.MISC = (volatile LAS unsigned*)(F.lds + MISC_OFF); { int t_ = threadIdx.x; asm volatile("" : "+v"(t_)); F.tid = t_; } F.lane = F.tid & 63; F.wave = __builtin_amdgcn_readfirstlane(F.tid >> 6); \
    F.G = gridDim.x; F.gw = blockIdx.x * NWAVES + F.wave; F.NGW = F.G * NWAVES; F.ctl = (gu32*)(OPQ(args.ws) + WS_CTL);
    { PH_FRAME PH_PTRS
      P0Args A; A.c = args.in[1]; A.w_mod = args.in[2]; A.b_mod = args.in[3]; A.win0 = args.in[6]; A.wout0 = args.in[12]; A.win1 = args.in[13]; A.wout1 = args.in[14]; A.wq = args.in[15]; A.subk = args.in[16];
      A.pu = args.in[17]; A.pv = args.in[18]; A.gws = args.in[8]; A.MOD = MOD; A.ROPE = ROPE; A.WIN0 = WIN0; A.WOUT0 = WOUT0; A.WIN1 = WIN1; A.WOUT1 = WOUT1; A.WQ0 = WQ0; A.WQ1 = WQ1; A.SUBK = SUBK; A.GWS = GWS; A.U8 = U8; A.V8s = V8s; A.USC = USC; A.VSC = VSC;
      p0_prologue(F, A); }
    GRID_BAR();
    { PH_FRAME PH_PTRS norm_rows(F, x_in, norm_mix, MOD, 0, 1, HN); }
    GRID_BAR();
    { PH_FRAME PH_PTRS
      pg8::Gemm g{HN, WIN0, MROWS, 2048, 1024}; pg8::StaticOrder S; S.init(MROWS, 2048, F.G, (int)blockIdx.x);
      pg8::EpiL0m E{UA, VA, QKR};
      pg8::gemm_phase<pg8::EpiL0m, pg8::StaticOrder, true, true>(F.lds, g, S, E); }
    { PH_FRAME PH_PTRS
      pg8::Gemm g{WIN0 + (size_t)2048 * 1024, HN, 512, MROWS, 1024}; pg8::StaticOrder S; S.init(512, MROWS, F.G, (int)blockIdx.x);
      pg8::EpiVT E{VT0, 512};
      pg8::gemm_phase<pg8::EpiVT, pg8::StaticOrder, true, true>(F.lds, g, S, E); }
    GRID_BAR();
    { PH_FRAME PH_PTRS
      for (int t = blockIdx.x; t < 256; t += F.G) qk_post_task(t, QKR, Q0, K0, KSUM, ROPE, args.in[10], args.in[11], (LAS float*)F.lds, F.tid, F.wave, F.lane);
      for (int u = blockIdx.x; u < 512; u += F.G) gmlp_unit(u, UA, VA, args.in[7], GWS, args.in[9], YCAT, F.lds, F.tid, F.wave, F.lane); }
    GRID_BAR();
    { PH_FRAME PH_PTRS
      MobaT T{Q0, K0, VT0, KSUM, MASKS, PO, PL, args.in[10], args.in[11]}; const float mc2 = moba_mc2(args.in[10], args.in[11], F.lane);
      for (int u = F.gw; u < 4096; u += F.NGW) { moba_mask_unit(u, T, F.lane); moba_own_unit(u, T, mc2, F.lane); } }
    GRID_BAR();
    { PH_FRAME PH_PTRS
      MobaT T{Q0, K0, VT0, KSUM, MASKS, PO, PL, args.in[10], args.in[11]}; const float mc2 = moba_mc2(args.in[10], args.in[11], F.lane);
      LAS unsigned* wq = (LAS unsigned*)(F.lds) + F.wave * 128;
      for (;;) { int task = 0; if (F.lane == 0) task = (int)__hip_atomic_fetch_add((unsigned*)(F.ctl + CW_WORK), 1u, __ATOMIC_RELAXED, __HIP_MEMORY_SCOPE_AGENT);
          task = __builtin_amdgcn_readfirstlane(task); if (task >= MOBA_NTASK) break;
          moba_sel_task(task, T, wq, mc2, F.lane); } }
    GRID_BAR();
    { PH_FRAME PH_PTRS moba_combine(F, PO, PL, YCAT); }
    GRID_BAR();
    { PH_FRAME PH_PTRS
      pg8::Gemm g{YCAT, WOUT0, MROWS, 1024, 1024}; pg8::StaticOrder S; S.init(MROWS, 1024, F.G, (int)blockIdx.x);
      pg8::EpiRes E{x_in, X, MOD + 2 * 1024};
      pg8::gemm_phase<pg8::EpiRes, pg8::StaticOrder, true, true>(F.lds, g, S, E); }
    GRID_BAR();
    { PH_FRAME PH_PTRS norm_rows(F, X, norm_ffn, MOD, 3, 4, HN); }
    GRID_BAR();
    { PH_FRAME PH_PTRS
      pg8::Gemm g{HN, WQ0, MROWS, 2048, 1024}; pg8::StaticOrder S; S.init(MROWS, 2048, F.G, (int)blockIdx.x);
      pg8::EpiBf16<0> E{QP, 2048, nullptr, 0, 0, 1.f};
      pg8::gemm_phase<pg8::EpiBf16<0>, pg8::StaticOrder, true, true>(F.lds, g, S, E); }
    GRID_BAR();
    { PH_FRAME PH_PTRS peer_scores_phase(F, QP, SUBK, ENT); }
    GRID_BAR();
    { PH_FRAME PH_PTRS PeerT T{U8, V8s, USC, VSC, ENT, ACT, HN, X, MOD + 5 * 1024}; peer_gather_phase<0>(F, 1, T); }
    GRID_BAR();
    { PH_FRAME PH_PTRS PeerT T{U8, V8s, USC, VSC, ENT, ACT, HN, X, MOD + 5 * 1024}; peer_gather_phase<1>(F, 9, T); }
    GRID_BAR();
    { PH_FRAME PH_PTRS norm_rows(F, X, norm_mix + 1024, MOD + 2 * 6144, 0, 1, HN); }
    GRID_BAR();
    { PH_FRAME PH_PTRS
      pg8::Gemm g{HN, WIN1, MROWS, 2048, 1024}; pg8::StaticOrder S; S.init(MROWS, 2048, F.G, (int)blockIdx.x);
      pg8::EpiHeads E{Q1, K1, 16};
      pg8::gemm_phase<pg8::EpiHeads, pg8::StaticOrder, true, true>(F.lds, g, S, E); }
    { PH_FRAME PH_PTRS
      pg8::Gemm g{WIN1 + (size_t)2048 * 1024, HN, 1024, MROWS, 1024}; pg8::StaticOrder S; S.init(1024, MROWS, F.G, (int)blockIdx.x);
      pg8::EpiVT E{VT1, 1024};
      pg8::gemm_phase<pg8::EpiVT, pg8::StaticOrder, true, true>(F.lds, g, S, E); }
    GRID_BAR();
    { PH_FRAME PH_PTRS for (int u = F.gw; u < 8192; u += F.NGW) sb_unit(u, Q1, K1, VT1, YCAT, F.lane); }
    GRID_BAR();
    { PH_FRAME PH_PTRS
      pg8::Gemm g{YCAT, WOUT1, MROWS, 1024, 1024}; pg8::StaticOrder S; S.init(MROWS, 1024, F.G, (int)blockIdx.x);
      pg8::EpiRes E{X, X, MOD + 2 * 6144 + 2 * 1024};
      pg8::gemm_phase<pg8::EpiRes, pg8::StaticOrder, true, true>(F.lds, g, S, E); }
    GRID_BAR();
    { PH_FRAME PH_PTRS norm_rows(F, X, norm_ffn + 1024, MOD + 2 * 6144, 3, 4, HN); }
    GRID_BAR();
    { PH_FRAME PH_PTRS
      pg8::Gemm g{HN, WQ1, MROWS, 2048, 1024}; pg8::StaticOrder S; S.init(MROWS, 2048, F.G, (int)blockIdx.x);
      pg8::EpiBf16<0> E{QP, 2048, nullptr, 0, 0, 1.f};
      pg8::gemm_phase<pg8::EpiBf16<0>, pg8::StaticOrder, true, true>(F.lds, g, S, E); }
    GRID_BAR();
    { PH_FRAME PH_PTRS peer_scores_phase(F, QP, SUBK + 262144, ENT); }
    GRID_BAR();
    { PH_FRAME PH_PTRS PeerT T{U8 + (size_t)16384 * 1024, V8s + (size_t)16384 * 1024, USC + 16384, VSC + 16384, ENT, ACT, HN, X, MOD + 2 * 6144 + 5 * 1024}; peer_gather_phase<0>(F, 17, T); }
    GRID_BAR();
    { PH_FRAME PH_PTRS PeerT T{U8 + (size_t)16384 * 1024, V8s + (size_t)16384 * 1024, USC + 16384, VSC + 16384, ENT, ACT, HN, X, MOD + 2 * 6144 + 5 * 1024}; peer_gather_phase<1>(F, 25, T);
      if (__hip_atomic_load((gu32*)((unsigned*)(F.ctl + CW_BAR) + XB_TMO), RLX_AGENT) != 0u) { for (int m = F.gw; m < MROWS; m += F.NGW) X[(size_t)m * 1024 + F.lane] = __builtin_nanf(""); } }
}

extern "C" void kernel_launch(void* const* d_in, const int* in_sizes, int n_in, void* d_out, int out_size, void* d_ws, size_t ws_size, hipStream_t stream) {
    static int grid = 0;
    if (grid == 0) {
        if (n_in != 19 || out_size != MROWS * DM || ws_size < WS_END) { fprintf(stderr, "kernel_launch: unexpected shapes (n_in %d, out %d, ws %zu)\n", n_in, out_size, ws_size); grid = -1; return; }
        int dev = 0, cus = 0, per_cu = 0;
        if (hipGetDevice(&dev) != hipSuccess || hipDeviceGetAttribute(&cus, hipDeviceAttributeMultiprocessorCount, dev) != hipSuccess) { grid = -1; return; }
        if (hipFuncSetAttribute((const void*)hybrid_fwd, hipFuncAttributeMaxDynamicSharedMemorySize, LDS_BYTES) != hipSuccess) { fprintf(stderr, "kernel_launch: hipFuncSetAttribute failed\n"); grid = -1; return; }
        if (hipOccupancyMaxActiveBlocksPerMultiprocessor(&per_cu, (const void*)hybrid_fwd, NTHR, LDS_BYTES) != hipSuccess || per_cu < 1) { fprintf(stderr, "kernel_launch: occupancy query says %d\n", per_cu); per_cu = 1; }
        (void)hipGetLastError();
        grid = cus;
    }
    if (grid < 0) return;
    if (hipMemsetAsync((char*)d_ws + WS_CTL, 0, CTL_ZERO_BYTES, stream) != hipSuccess) { fprintf(stderr, "kernel_launch: memset failed\n"); return; }
    Args a{};
    for (int i = 0; i < 19; ++i) a.in[i] = (const float*)d_in[i];
    a.out = (float*)d_out; a.ws = (unsigned char*)d_ws; a.stage = 0; a.pad = 0;
    void* kargs[] = {&a};
    hipError_t e = hipLaunchCooperativeKernel((const void*)hybrid_fwd, dim3(grid), dim3(NTHR), kargs, LDS_BYTES, stream);
    if (e != hipSuccess) fprintf(stderr, "kernel_launch: cooperative launch failed: %s (grid %d)\n", hipGetErrorString(e), grid);
}
```

```cpp
#include <hip/hip_runtime.h>
#include <cstdio>
#include <cstdint>
#include <cmath>
namespace pg8 {
#define PG8_LAS __attribute__((address_space(3)))
typedef unsigned short bf16_t;
typedef short bf16x8 __attribute__((ext_vector_type(8)));
typedef float f32x4 __attribute__((ext_vector_type(4)));
typedef unsigned u32x4 __attribute__((ext_vector_type(4)));
constexpr int BM = 256, BK = 64, HALF = 128, HTB = HALF * BK * 2  , STAGE_BYTES = 8 * HTB, NXCD = 8, WGM = 8;

__host__ __device__ __forceinline__ int lds_byte(int r, int c) { const int st = (r >> 4) * 2 + (c >> 5), rr = r & 15, cc = c & 31, ob = rr * 64 + cc * 2; return st * 1024 + (ob ^ (((ob >> 9) & 1) << 5)); }
__host__ __device__ __forceinline__ void stage_rc(int b, int& R, int& C) { const int st = b / 1024, sb = b % 1024, swz = sb ^ (((sb >> 9) & 1) << 5); R = (st >> 1) * 16 + swz / 64; C = (st & 1) * 32 + (swz % 64) / 2; }
__host__ __device__ __forceinline__ int perm32(int rho) { const int n = rho >> 4, i = rho & 15; return 8 * (i >> 2) + 4 * n + (i & 3); }

struct Unit { int pm, pn; };
struct Gemm { const bf16_t* A; const bf16_t* Bt; int M, N, K; };

struct StaticOrder {
    int nM, nN, nwg, G, c;
    __host__ __device__ void init(int M, int N, int G_, int c_) { nM = M / BM; nN = N / BM; nwg = nM * nN; G = G_; c = c_; }
    __host__ __device__ bool next(int i, Unit& u) const {
        const long L = (long)i * G + c; if (L >= nwg) return false;
        int wgid = (int)L; { const int q = nwg / NXCD, r = nwg % NXCD, xcd = wgid % NXCD, off = wgid / NXCD; wgid = (xcd < r ? xcd * (q + 1) : r * (q + 1) + (xcd - r) * q) + off; }
        const int nig = WGM * nN, gid = wgid / nig, fm = gid * WGM, gsz = (nM - fm) < WGM ? (nM - fm) : WGM;
        u.pm = fm + ((wgid % nig) % gsz); u.pn = (wgid % nig) / gsz; return true;
    }
    __device__ __forceinline__ void a_ready(const Unit&) const {}
    __device__ __forceinline__ void done(const Unit&) const {}
};

__device__ __forceinline__ unsigned cvt_pk_bf16(float lo, float hi) { unsigned r; asm volatile("v_cvt_pk_bf16_f32 %0, %1, %2" : "=v"(r) : "v"(lo), "v"(hi)); return r; }
typedef float f32x2 __attribute__((ext_vector_type(2)));
__device__ __forceinline__ f32x2 gelu_pk(f32x2 v) {
    const f32x2 av = __builtin_elementwise_abs(v), d = av * 0.2316418882f + 1.0f;
    f32x2 t; t.x = __builtin_amdgcn_rcpf(d.x); t.y = __builtin_amdgcn_rcpf(d.y);
    f32x2 q = t * 0.5307027145f + (-0.7265760135f); q = q * t + 0.7107068705f; q = q * t + (-0.142248368f); q = q * t + 0.127414796f; q = q * t;
    const f32x2 s = (v * v) * (-0.72134752044f);
    f32x2 e; e.x = __builtin_amdgcn_exp2f(s.x); e.y = __builtin_amdgcn_exp2f(s.y);
    const f32x2 m = v * (q * e), r = v - m;
    f32x2 o; o.x = v.x < 0.f ? m.x : r.x; o.y = v.y < 0.f ? m.y : r.y; return o;
}

template <int ACT  > struct EpiBf16 {
    static constexpr bool PERM = true, AFTER_DRAIN = false; static_assert(ACT == 0 || ACT == 1, "EpiBf16: ACT is 0 (none) or 1 (gelu_pk)");
    bf16_t* O; int ldc; const float* bias; int split_cols; size_t split_stride; float scale0;
    __device__ __forceinline__ void operator()(const f32x4 (&acc)[2][2][4][2], const Unit& u, int wr, int wc, int fr, int fq) const {
        const int row0 = u.pm * BM + wr * 64 + fr; int colt = u.pn * BM; bf16_t* base = O;
        float sc = 1.f; if (split_cols) { const int t = colt / split_cols; base += (size_t)t * split_stride; colt -= t * split_cols; if (t == 0) sc = scale0; }
        const int col0 = colt + wc * 32 + 8 * fq, bcol0 = u.pn * BM + wc * 32 + 8 * fq;
        f32x4 bv[2][2];
#pragma unroll
        for (int bj = 0; bj < 2; ++bj)
#pragma unroll
            for (int n = 0; n < 2; ++n) bv[bj][n] = bias ? *(const f32x4*)(bias + bcol0 + bj * HALF + 4 * n) : (f32x4){0.f, 0.f, 0.f, 0.f};
#pragma unroll
        for (int ai = 0; ai < 2; ++ai)
#pragma unroll
            for (int m = 0; m < 4; ++m) { bf16_t* rowp = base + (size_t)(row0 + ai * HALF + m * 16) * ldc + col0;
#pragma unroll
                for (int bj = 0; bj < 2; ++bj) { f32x4 v0 = acc[ai][bj][m][0] + bv[bj][0], v1 = acc[ai][bj][m][1] + bv[bj][1];
                    if (ACT == 1) { f32x2 a = gelu_pk((f32x2){v0[0], v0[1]}), b = gelu_pk((f32x2){v0[2], v0[3]}), c = gelu_pk((f32x2){v1[0], v1[1]}), d = gelu_pk((f32x2){v1[2], v1[3]});
                        v0 = (f32x4){a.x, a.y, b.x, b.y}; v1 = (f32x4){c.x, c.y, d.x, d.y}; }
                    v0 = v0 * sc; v1 = v1 * sc; u32x4 w; w.x = cvt_pk_bf16(v0[0], v0[1]); w.y = cvt_pk_bf16(v0[2], v0[3]); w.z = cvt_pk_bf16(v1[0], v1[1]); w.w = cvt_pk_bf16(v1[2], v1[3]);
                    *(u32x4*)(rowp + bj * HALF) = w; } }
    }
};
constexpr int XSEQ = 8192;
typedef float f32x2e __attribute__((ext_vector_type(2))); typedef __bf16 bf16x2e __attribute__((ext_vector_type(2)));
__device__ __forceinline__ unsigned cvtpk2(float lo, float hi) { f32x2e v = {lo, hi}; bf16x2e b = __builtin_convertvector(v, bf16x2e); return __builtin_bit_cast(unsigned, b); }
__device__ __forceinline__ float gelu_tanh(float x) {
    const float u2 = x * (1.5957691216f + 0.0713548163f * x * x);
    return x * __builtin_amdgcn_rcpf(1.0f + __builtin_amdgcn_exp2f(-1.4426950409f * u2));
}
struct EpiL0m {
    static constexpr bool PERM = true, AFTER_DRAIN = false;
    bf16_t *UA, *VA, *QKR;
    template <bool ACT> __device__ __forceinline__ void tile(const f32x4 (&acc)[2][2][4][2], bf16_t* base, int ldc, int row0, int colt) const {
#pragma unroll
        for (int ai = 0; ai < 2; ++ai)
#pragma unroll
            for (int m = 0; m < 4; ++m) { bf16_t* rowp = base + (size_t)(row0 + ai * HALF + m * 16) * ldc + colt;
#pragma unroll
                for (int bj = 0; bj < 2; ++bj) { f32x4 v0 = acc[ai][bj][m][0], v1 = acc[ai][bj][m][1]; u32x4 w;
                    if (ACT) { v0[0] = gelu_tanh(v0[0]); v0[1] = gelu_tanh(v0[1]); v0[2] = gelu_tanh(v0[2]); v0[3] = gelu_tanh(v0[3]); v1[0] = gelu_tanh(v1[0]); v1[1] = gelu_tanh(v1[1]); v1[2] = gelu_tanh(v1[2]); v1[3] = gelu_tanh(v1[3]); }
                    w.x = cvtpk2(v0[0], v0[1]); w.y = cvtpk2(v0[2], v0[3]); w.z = cvtpk2(v1[0], v1[1]); w.w = cvtpk2(v1[2], v1[3]);
                    *(u32x4*)(rowp + bj * HALF) = w; } }
    }
    __device__ __forceinline__ void operator()(const f32x4 (&acc)[2][2][4][2], const Unit& u, int wr, int wc, int fr, int fq) const {
        const int pn = u.pn; const int row0 = u.pm * BM + wr * 64 + fr; const int cw = wc * 32 + 8 * fq;
        if (pn < 2) tile<true>(acc, UA, 512, row0, pn * 256 + cw);
        else if (pn < 4) tile<true>(acc, VA, 512, row0, (pn - 2) * 256 + cw);
        else tile<false>(acc, QKR, 1024, row0, (pn - 4) * 256 + cw);
    }
};
struct EpiHeads {
    static constexpr bool PERM = true, AFTER_DRAIN = false;
    bf16_t *Q, *Kp; int nh;
    __device__ __forceinline__ void operator()(const f32x4 (&acc)[2][2][4][2], const Unit& u, int wr, int wc, int fr, int fq) const {
        const int b = u.pm >> 5, sb = (u.pm & 31) * 256 + wr * 64 + fr;
#pragma unroll
        for (int bj = 0; bj < 2; ++bj) { const int c = u.pn * BM + bj * HALF + wc * 32 + 8 * fq; const int t = c / (64 * nh), cc = c - t * 64 * nh, head = cc >> 6, d = cc & 63;
            bf16_t* dst = (t ? Kp : Q) + ((size_t)(b * nh + head) * XSEQ) * 64 + d;
#pragma unroll
            for (int ai = 0; ai < 2; ++ai)
#pragma unroll
                for (int m = 0; m < 4; ++m) { const int s = sb + ai * HALF + m * 16; const f32x4 v0 = acc[ai][bj][m][0], v1 = acc[ai][bj][m][1]; u32x4 w;
                    w.x = cvtpk2(v0[0], v0[1]); w.y = cvtpk2(v0[2], v0[3]); w.z = cvtpk2(v1[0], v1[1]); w.w = cvtpk2(v1[2], v1[3]);
                    *(u32x4*)(dst + (size_t)s * 64) = w; } }
    }
};
struct EpiVT {
    static constexpr bool PERM = true, AFTER_DRAIN = false;
    bf16_t* VT; int nrows;
    __device__ __forceinline__ void operator()(const f32x4 (&acc)[2][2][4][2], const Unit& u, int wr, int wc, int fr, int fq) const {
        const int row0 = u.pm * BM + wr * 64 + fr; const int c0 = u.pn * BM + wc * 32 + 8 * fq; const int b = c0 >> 13, s0 = c0 & (XSEQ - 1);
#pragma unroll
        for (int ai = 0; ai < 2; ++ai)
#pragma unroll
            for (int m = 0; m < 4; ++m) { bf16_t* rowp = VT + ((size_t)b * nrows + row0 + ai * HALF + m * 16) * XSEQ + s0;
#pragma unroll
                for (int bj = 0; bj < 2; ++bj) { const f32x4 v0 = acc[ai][bj][m][0], v1 = acc[ai][bj][m][1]; u32x4 w;
                    w.x = cvtpk2(v0[0], v0[1]); w.y = cvtpk2(v0[2], v0[3]); w.z = cvtpk2(v1[0], v1[1]); w.w = cvtpk2(v1[2], v1[3]);
                    *(u32x4*)(rowp + bj * HALF) = w; } }
    }
};
struct EpiRes {
    static constexpr bool PERM = false, AFTER_DRAIN = false;
    const float* xin; float* xout; const float* g;
    __device__ __forceinline__ void operator()(const f32x4 (&acc)[2][2][4][2], const Unit& u, int wr, int wc, int fr, int fq) const {
        const int row0 = u.pm * BM + wr * 64 + fr, col0 = u.pn * BM + wc * 32 + 4 * fq; const int b = u.pm >> 5;
        f32x4 gv[2][2];
#pragma unroll
        for (int bj = 0; bj < 2; ++bj)
#pragma unroll
            for (int n = 0; n < 2; ++n) gv[bj][n] = *(const f32x4*)(g + b * 6144 + col0 + bj * HALF + n * 16);
#pragma unroll
        for (int ai = 0; ai < 2; ++ai)
#pragma unroll
            for (int m = 0; m < 4; ++m) { const size_t off = (size_t)(row0 + ai * HALF + m * 16) * 1024 + col0;
#pragma unroll
                for (int bj = 0; bj < 2; ++bj)
#pragma unroll
                    for (int n = 0; n < 2; ++n) { const f32x4 xi = *(const f32x4*)(xin + off + bj * HALF + n * 16); *(f32x4*)(xout + off + bj * HALF + n * 16) = xi + gv[bj][n] * acc[ai][bj][m][n]; } }
    }
};
template <class Epi, class Sched, bool ALIGN_EPI = false, bool SP2 = false>
__device__ __forceinline__ void gemm_phase(PG8_LAS unsigned char* lds, const Gemm g, const Sched& S, const Epi& E) {
    int tid_ = threadIdx.x; asm volatile("" : "+v"(tid_));
    const int tid = tid_, wid = __builtin_amdgcn_readfirstlane(tid >> 6), lane = tid & 63, wr = wid >> 2, wc = wid & 3, fr = lane & 15, fq = lane >> 4;
    const int K = g.K, nt = K / BK;
    unsigned voffA[2], voffB[2];
#pragma unroll
    for (int i = 0; i < 2; ++i) { int R, C; stage_rc(tid * 16 + i * 8192, R, C); const int Rb = Epi::PERM ? ((R & ~31) + perm32(R & 31)) : R;
        voffA[i] = (unsigned)(R * K + C) * 2u; voffB[i] = (unsigned)(Rb * K + C) * 2u; }
    const size_t kstep = (size_t)(BK * 2);
    const size_t hstep = (size_t)HALF * K * 2;
    const size_t tstep = 2 * hstep;
    const unsigned ldsw = (unsigned)wid * 1024u;
    const int aoff = lds_byte(wr * 64 + fr, fq * 8), boff = lds_byte(wc * 32 + fr, fq * 8);
#define PG8_SA(b, h) (((b) * 2 + (h)) * HTB)
#define PG8_SB(b, h) ((4 + (b) * 2 + (h)) * HTB)
#define PG8_STAGE(bufoff, gbase, voff) do { _Pragma("unroll") for (int _i = 0; _i < 2; ++_i) \
        __builtin_amdgcn_global_load_lds((const unsigned*)((const char*)(gbase) + (voff)[_i]), (PG8_LAS unsigned*)(lds + (bufoff) + ldsw + _i * 8192), 16, 0, 0); } while (0)
#define PG8_LDA(dst, b, h) do { _Pragma("unroll") for (int m = 0; m < 4; ++m) _Pragma("unroll") for (int k = 0; k < 2; ++k) dst[m][k] = *(const PG8_LAS bf16x8*)(lds + PG8_SA(b, h) + aoff + m * 2048 + k * 1024); } while (0)
#define PG8_LDB(dst, b, h) do { _Pragma("unroll") for (int n = 0; n < 2; ++n) _Pragma("unroll") for (int k = 0; k < 2; ++k) dst[n][k] = *(const PG8_LAS bf16x8*)(lds + PG8_SB(b, h) + boff + n * 2048 + k * 1024); } while (0)
#define PG8_MMA(ai, bj, At, Bt) do { __builtin_amdgcn_s_setprio(1); _Pragma("unroll") for (int m = 0; m < 4; ++m) _Pragma("unroll") for (int n = 0; n < 2; ++n) _Pragma("unroll") for (int k = 0; k < 2; ++k) \
        acc[ai][bj][m][n] = __builtin_amdgcn_mfma_f32_16x16x32_bf16(Bt[n][k], At[m][k], acc[ai][bj][m][n], 0, 0, 0); __builtin_amdgcn_s_setprio(0); } while (0)
#define PG8_WAIT_V(n) asm volatile("s_waitcnt vmcnt(" #n ")" ::: "memory")
#define PG8_WAIT_L(n) asm volatile("s_waitcnt lgkmcnt(" #n ")" ::: "memory")
#define PG8_BAR __builtin_amdgcn_s_barrier()
#define PG8_SCHED __builtin_amdgcn_sched_barrier(0)
    Unit cur, nxt; int ui = 0;
    if (!S.next(0, cur)) return;
    f32x4 acc[2][2][4][2];
#pragma unroll
    for (int a = 0; a < 2; ++a)
#pragma unroll
        for (int b = 0; b < 2; ++b)
#pragma unroll
            for (int m = 0; m < 4; ++m)
#pragma unroll
                for (int n = 0; n < 2; ++n) acc[a][b][m][n] = (f32x4){0.f, 0.f, 0.f, 0.f};
    bf16x8 At[4][2], B0[2][2], B1[2][2];
    const char* cA = (const char*)g.A + (size_t)cur.pm * tstep; const char* cB = (const char*)g.Bt + (size_t)cur.pn * tstep;
    S.a_ready(cur);
    if constexpr (SP2) {
        PG8_STAGE(PG8_SB(0, 0), cB, voffB); PG8_STAGE(PG8_SB(0, 1), cB + hstep, voffB); PG8_STAGE(PG8_SA(0, 0), cA, voffA); PG8_STAGE(PG8_SA(0, 1), cA + hstep, voffA);
        if (wr == 1) PG8_BAR;
        PG8_WAIT_V(2); PG8_BAR;
        PG8_STAGE(PG8_SB(1, 0), cB + kstep, voffB); PG8_STAGE(PG8_SA(1, 0), cA + kstep, voffA); PG8_STAGE(PG8_SB(1, 1), cB + hstep + kstep, voffB);
        PG8_WAIT_V(6); PG8_BAR;
    } else {
        PG8_STAGE(PG8_SB(0, 0), cB, voffB); PG8_STAGE(PG8_SA(0, 0), cA, voffA); PG8_STAGE(PG8_SB(0, 1), cB + hstep, voffB); PG8_STAGE(PG8_SA(0, 1), cA + hstep, voffA);
        if (wr == 1) PG8_BAR;
        PG8_WAIT_V(4); PG8_BAR;
        PG8_STAGE(PG8_SB(1, 0), cB + kstep, voffB); PG8_STAGE(PG8_SA(1, 0), cA + kstep, voffA); PG8_STAGE(PG8_SB(1, 1), cB + hstep + kstep, voffB);
        PG8_WAIT_V(6); PG8_BAR;
    }
    for (;;) {
        const bool has_next = S.next(ui + 1, nxt);
        const char* nA = has_next ? (const char*)g.A + (size_t)nxt.pm * tstep : cA; const char* nB = has_next ? (const char*)g.Bt + (size_t)nxt.pn * tstep : cB;
        for (int t = 0; t < nt; t += 2) {
            const bool last = (t == nt - 2);
            const char* a1 = cA + (size_t)(t + 1) * kstep;
            const char* a2 = last ? nA : cA + (size_t)(t + 2) * kstep; const char* b2 = last ? nB : cB + (size_t)(t + 2) * kstep;
            const char* a3 = a2 + kstep; const char* b3 = b2 + kstep;
            if (last && has_next) S.a_ready(nxt);
            if constexpr (SP2) {
            PG8_LDB(B0, 0, 0); PG8_LDB(B1, 0, 1); PG8_SCHED; PG8_LDA(At, 0, 0); PG8_STAGE(PG8_SA(1, 1), a1 + hstep, voffA);
            PG8_WAIT_V(8); PG8_WAIT_L(0); PG8_BAR; PG8_MMA(0, 0, At, B0); PG8_MMA(0, 1, At, B1); PG8_BAR; PG8_SCHED;
            PG8_LDA(At, 0, 1); PG8_STAGE(PG8_SB(0, 0), b2, voffB); PG8_STAGE(PG8_SB(0, 1), b2 + hstep, voffB); PG8_STAGE(PG8_SA(0, 0), a2, voffA);
            PG8_WAIT_V(8); PG8_WAIT_L(0); PG8_BAR; PG8_MMA(1, 0, At, B0); PG8_MMA(1, 1, At, B1); PG8_BAR; PG8_SCHED;
            PG8_LDB(B0, 1, 0); PG8_LDB(B1, 1, 1); PG8_SCHED; PG8_LDA(At, 1, 0); PG8_STAGE(PG8_SA(0, 1), a2 + hstep, voffA);
            PG8_WAIT_V(8); PG8_WAIT_L(0); PG8_BAR; PG8_MMA(0, 0, At, B0); PG8_MMA(0, 1, At, B1); PG8_BAR; PG8_SCHED;
            PG8_LDA(At, 1, 1); PG8_STAGE(PG8_SB(1, 0), b3, voffB); PG8_STAGE(PG8_SB(1, 1), b3 + hstep, voffB); PG8_STAGE(PG8_SA(1, 0), a3, voffA);
            PG8_WAIT_V(8); PG8_WAIT_L(0); PG8_BAR; PG8_MMA(1, 0, At, B0); PG8_MMA(1, 1, At, B1); PG8_BAR; PG8_SCHED;
            } else {
            PG8_LDB(B0, 0, 0); PG8_SCHED; PG8_LDA(At, 0, 0); PG8_STAGE(PG8_SA(1, 1), a1 + hstep, voffA);
            PG8_WAIT_L(8); PG8_BAR; PG8_WAIT_L(0); PG8_MMA(0, 0, At, B0); PG8_BAR; PG8_SCHED;
            PG8_LDB(B1, 0, 1); PG8_STAGE(PG8_SB(0, 0), b2, voffB);
            PG8_BAR; PG8_WAIT_L(0); PG8_MMA(0, 1, At, B1); PG8_BAR;
            PG8_LDA(At, 0, 1); PG8_STAGE(PG8_SA(0, 0), a2, voffA);
            PG8_BAR; PG8_WAIT_L(0); PG8_MMA(1, 0, At, B0); PG8_BAR; PG8_SCHED;
            PG8_STAGE(PG8_SB(0, 1), b2 + hstep, voffB);
            PG8_WAIT_V(6); PG8_BAR; PG8_MMA(1, 1, At, B1); PG8_BAR;
            PG8_LDB(B0, 1, 0); PG8_SCHED; PG8_LDA(At, 1, 0); PG8_STAGE(PG8_SA(0, 1), a2 + hstep, voffA);
            PG8_WAIT_L(8); PG8_BAR; PG8_WAIT_L(0); PG8_MMA(0, 0, At, B0); PG8_BAR; PG8_SCHED;
            PG8_LDB(B1, 1, 1); PG8_STAGE(PG8_SB(1, 0), b3, voffB);
            PG8_BAR; PG8_WAIT_L(0); PG8_MMA(0, 1, At, B1); PG8_BAR;
            PG8_LDA(At, 1, 1); PG8_STAGE(PG8_SA(1, 0), a3, voffA);
            PG8_BAR; PG8_WAIT_L(0); PG8_MMA(1, 0, At, B0); PG8_BAR; PG8_SCHED;
            PG8_STAGE(PG8_SB(1, 1), b3 + hstep, voffB);
            PG8_WAIT_V(6); PG8_BAR; PG8_MMA(1, 1, At, B1); PG8_BAR;
            }
        }
        if constexpr (ALIGN_EPI) { if (wr == 0) PG8_BAR; }
        if constexpr (!Epi::AFTER_DRAIN) { E(acc, cur, wr, wc, fr, fq); S.done(cur); }
        if (!has_next) break;
#pragma unroll
        for (int a = 0; a < 2; ++a)
#pragma unroll
            for (int b = 0; b < 2; ++b)
#pragma unroll
                for (int m = 0; m < 4; ++m)
#pragma unroll
                    for (int n = 0; n < 2; ++n) acc[a][b][m][n] = (f32x4){0.f, 0.f, 0.f, 0.f};
        cur = nxt; cA = nA; cB = nB; ++ui;
        if constexpr (ALIGN_EPI) { if (wr == 1) PG8_BAR; }
    }
    PG8_WAIT_V(0);
    if constexpr (!ALIGN_EPI) { if (wr == 0) PG8_BAR; }
    PG8_BAR;
    if constexpr (Epi::AFTER_DRAIN) { E.fused(acc, cur, wr, wc, fr, fq, lds, wid, lane); S.done(cur); }
#undef PG8_SA
#undef PG8_SB
#undef PG8_STAGE
#undef PG8_LDA
#undef PG8_LDB
#undef PG8_MMA
#undef PG8_WAIT_V
#undef PG8_WAIT_L
#undef PG8_BAR
#undef PG8_SCHED
}
}
#define GAS __attribute__((address_space(1)))
#define LAS __attribute__((address_space(3)))
typedef unsigned short bf16;
typedef unsigned v4u __attribute__((ext_vector_type(4)));
typedef float f32x4 __attribute__((ext_vector_type(4)));
typedef short bf16x8 __attribute__((ext_vector_type(8)));
typedef GAS unsigned gu32;
typedef GAS unsigned long long gu64;
#define RLX_AGENT __ATOMIC_RELAXED, __HIP_MEMORY_SCOPE_AGENT
#define LDS_WAIT() asm volatile("s_waitcnt lgkmcnt(0)" ::: "memory")
#define VM_WAIT() asm volatile("s_waitcnt vmcnt(0)" ::: "memory")
__device__ __forceinline__ unsigned long long rt() { return __builtin_amdgcn_s_memrealtime(); }
__device__ __forceinline__ unsigned f2bf(float f) { unsigned u = __builtin_bit_cast(unsigned, f); return (u + 0x7fffu + ((u >> 16) & 1u)) >> 16; }
__device__ __forceinline__ unsigned pk2(float lo, float hi) { return f2bf(lo) | (f2bf(hi) << 16); }

#define XB_TMO      128
#define XB_XCNT(j)  (256  + 64 * (j))
#define XB_XSUB(j)  (1280 + 64 * (j))
#define XB_XGEN(j)  (2304 + 64 * (j))
#define XB_TOP      3328
#define XB_TOPGEN   3392
#define XCD_BAR_WORDS 3456
#define XB_SPIN_CAP (1u << 18)

__device__ __forceinline__ unsigned xb_ld(unsigned* p)              { return __hip_atomic_load(p, __ATOMIC_RELAXED, __HIP_MEMORY_SCOPE_AGENT); }
__device__ __forceinline__ unsigned xb_add(unsigned* p, unsigned v) { return __hip_atomic_fetch_add(p, v, __ATOMIC_RELAXED, __HIP_MEMORY_SCOPE_AGENT); }
__device__ __forceinline__ unsigned xb_xcc_id() { return (unsigned)__builtin_amdgcn_s_getreg((3 << 11) | 20) & 0xFu; }
#define XB_SPIN(cond, bar) do { unsigned _sp = 0; while (cond) { __builtin_amdgcn_s_sleep(1); \
    if ((++_sp & 255u) == 0u) { if (xb_ld(&(bar)[XB_TMO])) break; if (_sp > XB_SPIN_CAP) { atomicAdd(&(bar)[XB_TMO], 1u); break; } } } } while (0)

struct XcdBarrier {
    unsigned* bar; unsigned x;
    volatile LAS unsigned* st;
};

__device__ __forceinline__ XcdBarrier xcd_barrier_post(unsigned* bar, volatile LAS unsigned* st) {
    XcdBarrier b; b.bar = bar; b.x = xb_xcc_id(); b.st = st;
    if (threadIdx.x == 0) (void)xb_add(&bar[XB_XCNT(b.x)], 1u);
    return b;
}
__device__ __forceinline__ void xcd_barrier_complete(unsigned* bar, unsigned x, unsigned& nloc, unsigned& nx) {
    const unsigned G = gridDim.x * gridDim.y * gridDim.z;
    unsigned sum, cnt, mine, sp = 0u;
    for (;;) {
        sum = 0u; cnt = 0u; mine = 0u;
#pragma unroll
        for (unsigned j = 0; j < 16; ++j) { const unsigned c = xb_ld(&bar[XB_XCNT(j)]); sum += c; cnt += (c > 0u) ? 1u : 0u; mine = (j == x) ? c : mine; }
        if (sum == G) break;
        __builtin_amdgcn_s_sleep(1);
        if ((++sp & 255u) == 0u) { if (xb_ld(&bar[XB_TMO])) break; if (sp > XB_SPIN_CAP) { atomicAdd(&bar[XB_TMO], 1u); break; } }
    }
    nloc = mine > 0u ? mine : 1u; nx = cnt > 0u ? cnt : 1u;
}

__device__ __forceinline__ void xcd_barrier(const XcdBarrier& b) {
    asm volatile("s_waitcnt vmcnt(0)" ::: "memory");
    __syncthreads();
    if (threadIdx.x == 0) {
        unsigned* bar = b.bar;
        __builtin_amdgcn_s_waitcnt(0);
        unsigned nloc = b.st[0], nx = b.st[1];
        if (nloc == 0u) { xcd_barrier_complete(bar, b.x, nloc, nx); b.st[0] = nloc; b.st[1] = nx; }
        const unsigned old = xb_add(&bar[XB_XSUB(b.x)], 1u);
        const unsigned gen = old / nloc;
        if (old + 1u == (gen + 1u) * nloc) {
            __builtin_amdgcn_fence(__ATOMIC_RELEASE, "agent");
            asm volatile("s_waitcnt vmcnt(0)" ::: "memory");
            const unsigned og = xb_add(&bar[XB_TOP], 1u);
            const unsigned tg = og / nx;
            if (og + 1u == (tg + 1u) * nx) xb_add(&bar[XB_TOPGEN], 1u);
            else XB_SPIN(xb_ld(&bar[XB_TOPGEN]) == tg, bar);
            __builtin_amdgcn_fence(__ATOMIC_ACQUIRE, "agent");
            xb_add(&bar[XB_XGEN(b.x)], 1u);
            asm volatile("s_waitcnt vmcnt(0)" ::: "memory");
        } else {
            XB_SPIN(xb_ld(&bar[XB_XGEN(b.x)]) == gen, bar);
            __builtin_amdgcn_fence(__ATOMIC_ACQUIRE, "agent");
            asm volatile("s_waitcnt vmcnt(0)" ::: "memory");
        }
    }
    __syncthreads();
}
constexpr int NWAVES = 8, NTHR = 512;
constexpr int SEQ = 8192, DM = 1024, MROWS = 16384;
constexpr size_t MiB = 1u << 20;
constexpr size_t WS_CTL = 0, CTL_ZERO_BYTES = 2 * MiB;
constexpr size_t WS_KSUM = 1 * MiB;
constexpr size_t WS_MOD = 2 * MiB;
constexpr size_t WS_ROPE = 3 * MiB;
constexpr size_t WS_WIN0 = 4 * MiB, WS_WOUT0 = 9 * MiB, WS_WIN1 = 11 * MiB, WS_WOUT1 = 17 * MiB, WS_WQ0 = 19 * MiB, WS_WQ1 = 23 * MiB;
constexpr size_t WS_SUBK = 27 * MiB, WS_GWS = 28 * MiB, WS_MASK = 29 * MiB, WS_SC = 30 * MiB;
constexpr size_t WS_PTU = 32 * MiB, WS_PTV = 96 * MiB;
constexpr size_t WS_HN = 160 * MiB;
constexpr size_t WS_A = 192 * MiB;
constexpr size_t WS_YCAT = 288 * MiB, WS_QP = 320 * MiB, WS_PO = 384 * MiB, WS_PL = 448 * MiB, WS_END = 450 * MiB;
constexpr int CW_BAR = 4096, CW_WORK = 16384;

constexpr int RING_BYTES = 131072, LDSCTL_OFF = RING_BYTES, MISC_OFF = LDSCTL_OFF + 320, LDS_BYTES = 147456;

#define DI __device__ __forceinline__
typedef short bf16x8 __attribute__((ext_vector_type(8)));
typedef short s16x4 __attribute__((ext_vector_type(4)));
typedef float f32x16 __attribute__((ext_vector_type(16)));
typedef __bf16 bf16x2t __attribute__((ext_vector_type(2)));
#define MFMA32(a, b, c) __builtin_amdgcn_mfma_f32_32x32x16_bf16((a), (b), (c), 0, 0, 0)
using pg8::cvtpk2; using pg8::gelu_tanh;
DI int crow(int reg, int h) { return (reg & 3) + 8 * (reg >> 2) + 4 * h; }
DI float bf_lo(unsigned w) { return __uint_as_float(w << 16); }
DI float bf_hi(unsigned w) { return __uint_as_float(w & 0xffff0000u); }
DI bf16x8 ld16g(const bf16* p) { return *(const bf16x8*)p; }
DI bf16x8 ld8x2g(const bf16* p0, const bf16* p1) { const s16x4 a = *(const s16x4*)p0, b = *(const s16x4*)p1; return __builtin_shufflevector(a, b, 0, 1, 2, 3, 4, 5, 6, 7); }
DI float dot2bf(unsigned a, unsigned b, float c) { return __builtin_amdgcn_fdot2_f32_bf16(__builtin_bit_cast(bf16x2t, a), __builtin_bit_cast(bf16x2t, b), c, false); }
DI int f_ord(float f) { int i = __float_as_int(f); return i ^ ((i >> 31) & 0x7fffffff); }
DI float f_unord(int i) { return __int_as_float(i ^ ((i >> 31) & 0x7fffffff)); }
constexpr float LOG2E = 1.4426950408889634f, LN2 = 0.6931471805599453f;
#define KEY_MIN ((int)0x80000000)


template <int CTRL> DI float dppf(float x) { return __builtin_bit_cast(float, __builtin_amdgcn_update_dpp(0, __builtin_bit_cast(int, x), CTRL, 0xF, 0xF, true)); }
template <int CTRL> DI int dppi(int x) { return __builtin_amdgcn_update_dpp(0, x, CTRL, 0xF, 0xF, true); }
#define DPP_X1 0xB1
#define DPP_X2 0x4E
#define DPP_HM 0x141
#define DPP_RM 0x140
#define DPP_R8 0x128
DI unsigned px32u(unsigned x, int lane) { auto r = __builtin_amdgcn_permlane32_swap(x, x, false, false); return (lane & 32) ? r[0] : r[1]; }
DI float px32(float x, int lane) { return __uint_as_float(px32u(__float_as_uint(x), lane)); }
DI int px32(int x, int lane) { return (int)px32u((unsigned)x, lane); }
DI unsigned px16u(unsigned x, int lane) { auto r = __builtin_amdgcn_permlane16_swap(x, x, false, false); return (lane & 16) ? r[0] : r[1]; }
DI float px16(float x, int lane) { return __uint_as_float(px16u(__float_as_uint(x), lane)); }
DI float sum32(float x) { auto r = __builtin_amdgcn_permlane32_swap(__float_as_uint(x), __float_as_uint(x), false, false); return __uint_as_float(r[0]) + __uint_as_float(r[1]); }
DI float sum16(float x) { auto r = __builtin_amdgcn_permlane16_swap(__float_as_uint(x), __float_as_uint(x), false, false); return __uint_as_float(r[0]) + __uint_as_float(r[1]); }
DI float row_sum16(float v) { v += dppf<DPP_X1>(v); v += dppf<DPP_X2>(v); v += dppf<DPP_HM>(v); v += dppf<DPP_RM>(v); return v; }
DI float wave_sum(float v) { return sum32(sum16(row_sum16(v))); }
DI float wave_max(float v) { v = fmaxf(v, dppf<DPP_X1>(v)); v = fmaxf(v, dppf<DPP_X2>(v)); v = fmaxf(v, dppf<DPP_HM>(v)); v = fmaxf(v, dppf<DPP_RM>(v));
    { auto r = __builtin_amdgcn_permlane16_swap(__float_as_uint(v), __float_as_uint(v), false, false); v = fmaxf(__uint_as_float(r[0]), __uint_as_float(r[1])); }
    { auto r = __builtin_amdgcn_permlane32_swap(__float_as_uint(v), __float_as_uint(v), false, false); v = fmaxf(__uint_as_float(r[0]), __uint_as_float(r[1])); } return v; }

struct Frame {
    LAS unsigned char* lds; volatile LAS unsigned* MISC; gu32* ctl; int tid, lane, wave, G, gw, NGW;
};

struct MapId { DI int operator()(int n) const { return n; } };
struct MapWin0 { DI int operator()(int n) const {
    if (n < 1024) return n;
    const int t = (n - 1024) >> 9, c = (n - 1024) & 511, hd = c >> 6, d = c & 63; int bj, p;
    if (t < 2) { if (d < 16) { const int nn = d >> 3, rr = d & 7; bj = 0; p = 8 * (rr >> 2) + 4 * nn + (rr & 3); } else if (d < 32) { bj = 0; p = d; } else { bj = 1; p = d - 32; } }
    else { bj = d >> 5; p = d & 31; }
    return 1024 + 512 * t + 256 * (hd >> 2) + 128 * bj + 32 * (hd & 3) + p; } };
struct MapWin1 { DI int operator()(int n) const { const int t = n >> 10, c = n & 1023, hd = c >> 6, d = c & 63; return 1024 * t + 256 * (hd >> 2) + 128 * (d >> 5) + 32 * (hd & 3) + (d & 31); } };
template <class Map> DI void p0_transpose_item(const float* W, int K, int N, bf16* WT, LAS float* scr, int item, int lane, Map map) {
    const int nblk = N / 32, kb = item / nblk, nb = item % nblk, k0 = 64 * kb, n0 = 32 * nb;
#pragma unroll 8
    for (int i = 0; i < 32; ++i) { const int kk = 2 * i + (lane >> 5); scr[kk * 33 + (lane & 31)] = W[(size_t)(k0 + kk) * N + n0 + (lane & 31)]; }
    LDS_WAIT(); asm volatile("" ::: "memory");
    const int c = lane & 7;
#pragma unroll
    for (int j = 0; j < 4; ++j) { const int n = (lane >> 3) + 8 * j; const LAS float* s = scr + (8 * c) * 33 + n;
        v4u o; o.x = pk2(s[0 * 33], s[1 * 33]); o.y = pk2(s[2 * 33], s[3 * 33]); o.z = pk2(s[4 * 33], s[5 * 33]); o.w = pk2(s[6 * 33], s[7 * 33]);
        *(GAS v4u*)(WT + (size_t)map(n0 + n) * K + k0 + 8 * c) = o; }
    LDS_WAIT(); asm volatile("" ::: "memory");
}
struct P0Args { const float *c, *w_mod, *b_mod, *win0, *wout0, *win1, *wout1, *wq, *subk, *pu, *pv, *gws;
                float *MOD, *ROPE; bf16 *WIN0, *WOUT0, *WIN1, *WOUT1, *WQ0, *WQ1, *SUBK, *GWS; unsigned char *U8, *V8s; float *USC, *VSC; };
DI void p0_prologue(const Frame& F, const P0Args& A) {
    { LAS float* scr = (LAS float*)F.lds;
      for (int task = blockIdx.x; task < 192; task += F.G) {
          const int l = task / 96, n0 = (task % 96) * 64; const float* W = A.w_mod + (size_t)l * 1024 * 6144;
          float a0 = 0.f, a1 = 0.f; const int k0 = F.wave * 128;
#pragma unroll 8
          for (int k = k0; k < k0 + 128; ++k) { const float c0 = A.c[k], c1 = A.c[1024 + k]; const float s0 = c0 / (1.f + __expf(-c0)), s1 = c1 / (1.f + __expf(-c1));
              const float w = W[(size_t)k * 6144 + n0 + F.lane]; a0 += s0 * w; a1 += s1 * w; }
          scr[(F.wave * 2 + 0) * 64 + F.lane] = a0; scr[(F.wave * 2 + 1) * 64 + F.lane] = a1;
          __syncthreads();
          if (F.tid < 128) { const int b = F.tid >> 6, n = F.tid & 63; float s = 0.f;
#pragma unroll
              for (int w = 0; w < 8; ++w) s += scr[(w * 2 + b) * 64 + n];
              A.MOD[(size_t)(l * 2 + b) * 6144 + n0 + n] = s + A.b_mod[l * 6144 + n0 + n]; }
          __syncthreads();
      } }
    { LAS float* scr = (LAS float*)(F.lds + F.wave * 16384);
      constexpr int I0 = 16 * 80, I1 = 16 * 32, I2 = 16 * 96, I3 = 16 * 32, I4 = 16 * 64, I5 = 16 * 64, NIT = I0 + I1 + I2 + I3 + I4 + I5;
      for (int it = F.gw; it < NIT; it += F.NGW) { int r = it;
          if (r < I0) { p0_transpose_item(A.win0, 1024, 2560, A.WIN0, scr, r, F.lane, MapId()); continue; } r -= I0;
          if (r < I1) { p0_transpose_item(A.wout0, 1024, 1024, A.WOUT0, scr, r, F.lane, MapId()); continue; } r -= I1;
          if (r < I2) { p0_transpose_item(A.win1, 1024, 3072, A.WIN1, scr, r, F.lane, MapId()); continue; } r -= I2;
          if (r < I3) { p0_transpose_item(A.wout1, 1024, 1024, A.WOUT1, scr, r, F.lane, MapId()); continue; } r -= I3;
          if (r < I4) { p0_transpose_item(A.wq, 1024, 2048, A.WQ0, scr, r, F.lane, MapId()); continue; } r -= I4;
          p0_transpose_item(A.wq + (size_t)1024 * 2048, 1024, 2048, A.WQ1, scr, r, F.lane, MapId()); } }
    for (int row = F.gw; row < 65536; row += F.NGW) { const bool isv = row >= 32768; const int rr = row & 32767;
        const float* src = (isv ? A.pv : A.pu) + (size_t)rr * 1024; f32x4 v[4]; float mx = 0.f;
#pragma unroll
        for (int k = 0; k < 4; ++k) { v[k] = *(const f32x4*)(src + 4 * F.lane + 256 * k); mx = fmaxf(mx, fmaxf(fmaxf(fabsf(v[k][0]), fabsf(v[k][1])), fmaxf(fabsf(v[k][2]), fabsf(v[k][3])))); }
        mx = wave_max(mx);
        const float sc = mx > 0.f ? 384.0f / mx : 1.0f, inv = mx > 0.f ? mx * (1.0f / 384.0f) : 1.0f;
#pragma unroll
        for (int k = 0; k < 4; ++k) { int w = 0; w = __builtin_amdgcn_cvt_pk_fp8_f32(v[k][0] * sc, v[k][1] * sc, w, false); w = __builtin_amdgcn_cvt_pk_fp8_f32(v[k][2] * sc, v[k][3] * sc, w, true);
            if (!isv) *(unsigned*)(A.U8 + (size_t)rr * 1024 + 4 * F.lane + 256 * k) = (unsigned)w;
            else { const int l = rr >> 14, e = rr & 16383, slab = 2 * k + (F.lane >> 5); *(unsigned*)(A.V8s + (((size_t)l * 8 + slab) * 16384 + e) * 128 + 4 * (F.lane & 31)) = (unsigned)w; } }
        if (F.lane == 0) (isv ? A.VSC : A.USC)[rr] = inv; }
    { const size_t gt = (size_t)F.gw * 64 + F.lane, NT = (size_t)F.NGW * 64;
      for (size_t i = gt; i < 524288 / 8; i += NT) { const float* src = A.subk + i * 8; const f32x4 a = *(const f32x4*)src, b = *(const f32x4*)(src + 4); v4u o; o.x = cvtpk2(a[0], a[1]); o.y = cvtpk2(a[2], a[3]); o.z = cvtpk2(b[0], b[1]); o.w = cvtpk2(b[2], b[3]);
          *(v4u*)(A.SUBK + i * 8) = o; }
      for (size_t i = gt; i < 65536; i += NT) { const int t = (int)(i >> 7) & 127, s = (int)i & 127; A.GWS[i] = (bf16)(cvtpk2(s <= t ? A.gws[i] : 0.f, 0.f) & 0xffffu); }
      for (size_t i = gt; i < 65536; i += NT) { const int pos = (int)(i >> 3), fi = (int)i & 7; const float inv = powf(500000.0f, -(float)fi / 8.0f); const float ang = (float)pos * inv; float sn, cs; sincosf(ang, &sn, &cs);
          A.ROPE[(size_t)pos * 16 + fi] = cs; A.ROPE[(size_t)pos * 16 + 8 + fi] = sn; } }
}

DI void norm_rows(const Frame& F, const float* xs, const float* gamma, const float* modl, int shi, int sci, bf16* HN) {
    for (int m = F.gw; m < MROWS; m += F.NGW) { const int b = m >> 13;
        const f32x4* xr = (const f32x4*)(xs + (size_t)m * 1024) + F.lane; f32x4 v[4]; float s = 0.f;
#pragma unroll
        for (int j = 0; j < 4; ++j) { v[j] = xr[64 * j]; s += (v[j][0] * v[j][0] + v[j][1] * v[j][1]) + (v[j][2] * v[j][2] + v[j][3] * v[j][3]); }
        const float rinv = rsqrtf(wave_sum(s) * (1.0f / 1024.0f) + 1e-6f);
        unsigned long long* o8 = (unsigned long long*)(HN + (size_t)m * 1024) + F.lane;
#pragma unroll
        for (int j = 0; j < 4; ++j) { const int col = 4 * F.lane + 256 * j; const f32x4 gm = *(const f32x4*)(gamma + col), sc = *(const f32x4*)(modl + b * 6144 + sci * 1024 + col), sh = *(const f32x4*)(modl + b * 6144 + shi * 1024 + col);
            const f32x4 o = v[j] * rinv * gm * (sc + 1.0f) + sh; o8[64 * j] = (unsigned long long)cvtpk2(o[0], o[1]) | ((unsigned long long)cvtpk2(o[2], o[3]) << 32); }
    }
}


DI void qk_post_task(int task, const bf16* QKR, bf16* Q0, bf16* K0, float* KSUM, const float* rope, const float* gq, const float* gk, LAS float* scr, int tid, int wave, int lane) {
    const int tb = task >> 2, cq = task & 3; const bool isk = cq >= 2; const int head0 = (cq & 1) * 4, hl = (lane >> 2) & 3, qt = lane & 3, rsub = lane >> 4;
    const float* g = (isk ? gk : gq) + qt * 16; float gv[16];
#pragma unroll
    for (int i = 0; i < 16; ++i) gv[i] = g[i];
    float ks[16];
#pragma unroll
    for (int i = 0; i < 16; ++i) ks[i] = 0.f;
    const int b = tb >> 5; bf16* dstb = (isk ? K0 : Q0) + (size_t)(b * 8 + head0 + hl) * SEQ * 64 + qt * 16;
    for (int it = 0; it < 8; ++it) { const int row = tb * 256 + wave * 32 + it * 4 + rsub, s = row & (SEQ - 1);
        const bf16* src = QKR + (size_t)row * 1024 + cq * 256 + hl * 64 + qt * 16; const v4u w0 = *(const v4u*)src, w1 = *(const v4u*)(src + 8);
        float y[16]; y[0] = bf_lo(w0.x); y[1] = bf_hi(w0.x); y[2] = bf_lo(w0.y); y[3] = bf_hi(w0.y); y[4] = bf_lo(w0.z); y[5] = bf_hi(w0.z); y[6] = bf_lo(w0.w); y[7] = bf_hi(w0.w);
        y[8] = bf_lo(w1.x); y[9] = bf_hi(w1.x); y[10] = bf_lo(w1.y); y[11] = bf_hi(w1.y); y[12] = bf_lo(w1.z); y[13] = bf_hi(w1.z); y[14] = bf_lo(w1.w); y[15] = bf_hi(w1.w);
        float ss = 0.f;
#pragma unroll
        for (int i = 0; i < 16; ++i) ss += y[i] * y[i];
        ss += dppf<DPP_X1>(ss); ss += dppf<DPP_X2>(ss);
        const float rinv = rsqrtf(ss * (1.0f / 64.0f) + 1e-6f);
#pragma unroll
        for (int i = 0; i < 16; ++i) y[i] = y[i] * rinv * gv[i];
        if (qt == 0) { const float* rp = rope + (size_t)s * 16;
#pragma unroll
            for (int i = 0; i < 8; ++i) { const float c = rp[i], sn = rp[8 + i], x1 = y[i], x2 = y[i + 8]; y[i] = x1 * c - x2 * sn; y[i + 8] = x1 * sn + x2 * c; } }
        v4u o0, o1; o0.x = cvtpk2(y[0], y[1]); o0.y = cvtpk2(y[2], y[3]); o0.z = cvtpk2(y[4], y[5]); o0.w = cvtpk2(y[6], y[7]); o1.x = cvtpk2(y[8], y[9]); o1.y = cvtpk2(y[10], y[11]); o1.z = cvtpk2(y[12], y[13]); o1.w = cvtpk2(y[14], y[15]);
        bf16* d = dstb + (size_t)s * 64; *(v4u*)d = o0; *(v4u*)(d + 8) = o1;
#pragma unroll
        for (int i = 0; i < 16; ++i) ks[i] += y[i];
    }
    if (isk) {
#pragma unroll
        for (int i = 0; i < 16; ++i) { ks[i] = sum32(sum16(ks[i])); }
        if (lane < 16) {
#pragma unroll
            for (int i = 0; i < 16; ++i) scr[(wave * 16 + lane) * 16 + i] = ks[i]; }
        __syncthreads();
        if (tid < 256) { const int l16 = tid >> 4, i = tid & 15; float sum = 0.f;
#pragma unroll
            for (int w = 0; w < 8; ++w) sum += scr[(w * 16 + l16) * 16 + i];
            KSUM[((size_t)(b * 8 + head0 + (l16 >> 2)) * 32 + (tb & 31)) * 64 + (l16 & 3) * 16 + i] = sum; }
        __syncthreads();
    }
}

DI f32x16 qk_tile(const bf16* krow, const bf16x8 (&qf)[4]) {
    f32x16 s;
#pragma unroll
    for (int i = 0; i < 16; ++i) s[i] = 0.f;
#pragma unroll
    for (int ks = 0; ks < 4; ++ks) s = MFMA32(ld16g(krow + 16 * ks), qf[ks], s);
    return s;
}
DI bf16x8 pack8(const f32x16& x, int s) { v4u p; p.x = cvtpk2(x[8 * s], x[8 * s + 1]); p.y = cvtpk2(x[8 * s + 2], x[8 * s + 3]); p.z = cvtpk2(x[8 * s + 4], x[8 * s + 5]); p.w = cvtpk2(x[8 * s + 6], x[8 * s + 7]); return __builtin_bit_cast(bf16x8, p); }
DI void pv_tile(f32x16 (&o)[2], const bf16* vt, const f32x16& p) {
#pragma unroll
    for (int s = 0; s < 2; ++s) { const bf16x8 pb = pack8(p, s);
#pragma unroll
        for (int mt = 0; mt < 2; ++mt) { const bf16* v = vt + (size_t)mt * 32 * SEQ + 16 * s; o[mt] = MFMA32(ld8x2g(v, v + 8), pb, o[mt]); } }
}
DI void store_ot(bf16* dst, const f32x16 (&o)[2], float sc, int h) {
#pragma unroll
    for (int mt = 0; mt < 2; ++mt)
#pragma unroll
        for (int g = 0; g < 4; ++g) { const unsigned lo = cvtpk2(o[mt][4 * g] * sc, o[mt][4 * g + 1] * sc), hi = cvtpk2(o[mt][4 * g + 2] * sc, o[mt][4 * g + 3] * sc);
            *(unsigned long long*)(dst + 32 * mt + 8 * g + 4 * h) = (unsigned long long)lo | ((unsigned long long)hi << 32); }
}
DI void moba_keys(const bf16* Kh, const bf16* VTh, const bf16x8 (&qf)[4], int key0, int nt, int diag, float mc2, f32x16 (&o)[2], float& l, int r, int h) {
    for (int kt = 0; kt < nt; ++kt) { const int kb = key0 + 32 * kt;
        f32x16 s = qk_tile(Kh + (size_t)(kb + r) * 64 + 8 * h, qf);
        float ls = 0.f;
#pragma unroll
        for (int i = 0; i < 16; ++i) { float p = __builtin_amdgcn_exp2f(s[i] * (0.125f * LOG2E) - mc2); if (kt == diag && crow(i, h) > r) p = 0.f; s[i] = p; ls += p; }
        l += ls;
        pv_tile(o, VTh + (size_t)r * SEQ + kb + 4 * h, s);
    }
}
DI float moba_mc2(const float* gq, const float* gk, int lane) {
    float a = fabsf(gq[lane]), b = fabsf(gk[lane]);
    a = wave_max(a); b = wave_max(b);
    return 8.0f * a * b * LOG2E;
}
struct MobaT { const bf16 *Q, *K, *VT; const float* ksum; unsigned* masks; bf16* PO; float* PL; const float *gq, *gk; };
DI void moba_mask_unit(int u, const MobaT& T, int lane) {
    const int bh = u >> 8, t0 = (u & 255) * 32, own = t0 >> 8, r = lane & 31, h = lane >> 5;
    unsigned mask = 0u;
    if (own > 0) {
        f32x16 g;
#pragma unroll
        for (int i = 0; i < 16; ++i) g[i] = 0.f;
        const float* km = T.ksum + ((size_t)bh * 32 + r) * 64 + 8 * h; const bf16* qp = T.Q + ((size_t)bh * SEQ + t0 + r) * 64 + 8 * h;
#pragma unroll
        for (int ks = 0; ks < 4; ++ks) { const f32x4 a0 = *(const f32x4*)(km + 16 * ks) * (1.0f / 256.0f), a1 = *(const f32x4*)(km + 16 * ks + 4) * (1.0f / 256.0f);
            v4u aw; aw.x = cvtpk2(a0[0], a0[1]); aw.y = cvtpk2(a0[2], a0[3]); aw.z = cvtpk2(a1[0], a1[1]); aw.w = cvtpk2(a1[2], a1[3]);
            g = MFMA32(__builtin_bit_cast(bf16x8, aw), ld16g(qp + 16 * ks), g); }
        int ka = KEY_MIN, kb2 = KEY_MIN, kc = KEY_MIN;
#define INS3(x_) do { int x = (x_); int t = min(ka, x); ka = max(ka, x); int uu = min(kb2, t); kb2 = max(kb2, t); kc = max(kc, uu); } while (0)
#pragma unroll
        for (int i = 0; i < 16; ++i) { const int blk = crow(i, h); const int key = (blk < own) ? ((f_ord(g[i]) & ~31) | (31 - blk)) : KEY_MIN; INS3(key); }
        const int pa = px32(ka, lane), pb = px32(kb2, lane), pc = px32(kc, lane);
        INS3(pa); INS3(pb); INS3(pc);
#undef INS3
        if (ka != KEY_MIN) mask |= 1u << (31 - (ka & 31));
        if (kb2 != KEY_MIN) mask |= 1u << (31 - (kb2 & 31));
        if (kc != KEY_MIN) mask |= 1u << (31 - (kc & 31));
    }
    if (h == 0) T.masks[(size_t)bh * SEQ + t0 + r] = mask;
}
DI void moba_own_unit(int u, const MobaT& T, float mc2, int lane) {
    const int bh = u >> 8, t0 = (u & 255) * 32, own = t0 >> 8, r = lane & 31, h = lane >> 5;
    const bf16* qp = T.Q + ((size_t)bh * SEQ + t0 + r) * 64 + 8 * h; bf16x8 qf[4];
#pragma unroll
    for (int ks = 0; ks < 4; ++ks) qf[ks] = ld16g(qp + 16 * ks);
    f32x16 o[2];
#pragma unroll
    for (int i = 0; i < 16; ++i) { o[0][i] = 0.f; o[1][i] = 0.f; }
    float l = 0.f; const int key0 = own * 256, nt = ((t0 - key0) >> 5) + 1;
    moba_keys(T.K + (size_t)bh * SEQ * 64, T.VT + (size_t)bh * 64 * SEQ, qf, key0, nt, nt - 1, mc2, o, l, r, h);
    l = sum32(l);
    const size_t base = ((size_t)bh * SEQ + t0 + r) * 4 + 3;
    store_ot(T.PO + base * 64, o, 1.0f, h); if (h == 0) T.PL[base] = l;
}
DI void moba_sel_batch(const MobaT& T, int bh, int j, const LAS unsigned* wq, int nv, float mc2, int lane) {
    const int r = lane & 31, h = lane >> 5; const bool valid = r < nv; const int t = (int)wq[valid ? r : 0];
    const unsigned m = T.masks[(size_t)bh * SEQ + t]; const int slot = __builtin_popcount(m & ((1u << j) - 1u));
    const bf16* qp = T.Q + ((size_t)bh * SEQ + t) * 64 + 8 * h; bf16x8 qf[4];
#pragma unroll
    for (int ks = 0; ks < 4; ++ks) qf[ks] = ld16g(qp + 16 * ks);
    f32x16 o[2];
#pragma unroll
    for (int i = 0; i < 16; ++i) { o[0][i] = 0.f; o[1][i] = 0.f; }
    float l = 0.f;
    moba_keys(T.K + (size_t)bh * SEQ * 64, T.VT + (size_t)bh * 64 * SEQ, qf, j * 256, 8, -1, mc2, o, l, r, h);
    l = sum32(l);
    if (valid) { const size_t base = ((size_t)bh * SEQ + t) * 4 + slot; store_ot(T.PO + base * 64, o, 1.0f, h); if (h == 0) T.PL[base] = l; }
}
constexpr int MOBA_NTASK = 16 * 136;
DI void moba_sel_task(int task, const MobaT& T, LAS unsigned* wq, float mc2, int lane) {
    int c = 0, rem = task; while (rem >= 16 * (4 * c + 3)) { rem -= 16 * (4 * c + 3); ++c; }
    const int j = rem >> 4, bh = rem & 15; int n = 0;
    for (int step = 0; step < 16; ++step) { const int t = c * 1024 + step * 64 + lane; const unsigned m = T.masks[(size_t)bh * SEQ + t]; const bool sel = (m >> j) & 1u;
        const unsigned long long bal = __ballot(sel);
        if (sel) wq[n + __builtin_popcountll(bal & ((1ull << lane) - 1ull))] = (unsigned)t;
        n += __builtin_popcountll(bal);
        asm volatile("s_waitcnt lgkmcnt(0)" ::: "memory");
        while (n >= 32) { moba_sel_batch(T, bh, j, wq + (n - 32), 32, mc2, lane); n -= 32; asm volatile("s_waitcnt lgkmcnt(0)" ::: "memory"); }
    }
    if (n > 0) moba_sel_batch(T, bh, j, wq, n, mc2, lane);
    asm volatile("s_waitcnt lgkmcnt(0)" ::: "memory");
}
DI void moba_combine(const Frame& F, const bf16* PO, const float* PL, bf16* YCAT) {
    const size_t gt = (size_t)F.gw * 64 + F.lane, NT = (size_t)F.NGW * 64;
    for (size_t i = gt; i < (size_t)16 * SEQ * 8; i += NT) { const int dq = (int)i & 7, t = (int)(i >> 3) & (SEQ - 1), bh = (int)(i >> 16); const int own = t >> 8, ns = own < 3 ? own : 3;
        float o[8]; float l = 0.f;
#pragma unroll
        for (int k = 0; k < 8; ++k) o[k] = 0.f;
#pragma unroll
        for (int s = 0; s < 4; ++s) { if (s < ns || s == 3) { const size_t base = ((size_t)bh * SEQ + t) * 4 + s; l += PL[base]; const v4u w = *(const v4u*)(PO + base * 64 + dq * 8);
                o[0] += bf_lo(w.x); o[1] += bf_hi(w.x); o[2] += bf_lo(w.y); o[3] += bf_hi(w.y); o[4] += bf_lo(w.z); o[5] += bf_hi(w.z); o[6] += bf_lo(w.w); o[7] += bf_hi(w.w); } }
        const float il = 1.0f / l; v4u w; w.x = cvtpk2(o[0] * il, o[1] * il); w.y = cvtpk2(o[2] * il, o[3] * il); w.z = cvtpk2(o[4] * il, o[5] * il); w.w = cvtpk2(o[6] * il, o[7] * il);
        *(v4u*)(YCAT + ((size_t)(bh >> 3) * SEQ + t) * 1024 + 512 + (bh & 7) * 64 + dq * 8) = w; }
}

DI void gmlp_unit(int unit, const bf16* UA, const bf16* VA, const float* vgain, const bf16* GWS, const float* bs, bf16* YCAT, LAS unsigned char* lds, int tid, int wave, int lane) {
    const int cidx = unit >> 2, g = unit & 3, row0 = cidx * 128; LAS bf16* VNT = (LAS bf16*)lds;
    { const int row = tid >> 2, dq = (tid & 3) * 32; const bf16* src = VA + (size_t)(row0 + row) * 512 + g * 128 + dq;
      float f[32]; float ss = 0.f;
#pragma unroll
      for (int k = 0; k < 4; ++k) { const v4u w = *(const v4u*)(src + 8 * k); f[8 * k] = bf_lo(w.x); f[8 * k + 1] = bf_hi(w.x); f[8 * k + 2] = bf_lo(w.y); f[8 * k + 3] = bf_hi(w.y); f[8 * k + 4] = bf_lo(w.z); f[8 * k + 5] = bf_hi(w.z); f[8 * k + 6] = bf_lo(w.w); f[8 * k + 7] = bf_hi(w.w); }
#pragma unroll
      for (int k = 0; k < 32; ++k) ss += f[k] * f[k];
      ss += dppf<DPP_X1>(ss); ss += dppf<DPP_X2>(ss);
      const float rinv = rsqrtf(ss * (1.0f / 128.0f) + 1e-6f);
#pragma unroll
      for (int k = 0; k < 32; ++k) VNT[(dq + k) * 136 + row] = (bf16)(cvtpk2(f[k] * rinv * vgain[g * 128 + dq + k], 0.f) & 0xffffu); }
    __syncthreads();
    { const int mt = wave >> 1, ntb = (wave & 1) * 2, r = lane & 31, h = lane >> 5;
      f32x16 acc[2];
#pragma unroll
      for (int i = 0; i < 16; ++i) { acc[0][i] = 0.f; acc[1][i] = 0.f; }
      const bf16* wp = GWS + ((size_t)g * 128 + 32 * mt + r) * 128 + 8 * h;
      for (int ks = 0; ks < 2 * (mt + 1); ++ks) { const bf16x8 a = ld16g(wp + 16 * ks);
#pragma unroll
          for (int nn = 0; nn < 2; ++nn) { const bf16x8 b = *(const LAS bf16x8*)(VNT + (32 * (ntb + nn) + r) * 136 + 16 * ks + 8 * h); acc[nn] = MFMA32(a, b, acc[nn]); } }
#pragma unroll
      for (int nn = 0; nn < 2; ++nn)
#pragma unroll
          for (int i = 0; i < 16; ++i) { const int t = 32 * mt + crow(i, h), d = 32 * (ntb + nn) + r; const float mixed = acc[nn][i] + bs[g * 128 + t];
              const float uv = __uint_as_float((unsigned)UA[(size_t)(row0 + t) * 512 + g * 128 + d] << 16);
              YCAT[(size_t)(row0 + t) * 1024 + g * 128 + d] = (bf16)(cvtpk2(uv * mixed, 0.f) & 0xffffu); } }
    __syncthreads();
}

DI void sb_unit(int u, const bf16* Q, const bf16* K, const bf16* VT, bf16* YCAT, int lane) {
    const int bh = u >> 8, t0 = (u & 255) * 32, r = lane & 31, h = lane >> 5;
    const bf16* qp = Q + ((size_t)bh * SEQ + t0 + r) * 64 + 8 * h; bf16x8 qf[4];
#pragma unroll
    for (int ks = 0; ks < 4; ++ks) qf[ks] = ld16g(qp + 16 * ks);
    const bf16* Kh = K + (size_t)bh * SEQ * 64; const bf16* VTh = VT + (size_t)bh * 64 * SEQ;
    f32x16 o[2];
#pragma unroll
    for (int i = 0; i < 16; ++i) { o[0][i] = 0.f; o[1][i] = 0.f; }
    float R = 0.f;
    for (int kb = t0; kb >= 0; kb -= 32) {
        f32x16 s = qk_tile(Kh + (size_t)(kb + r) * 64 + 8 * h, qf);
        const bool diag = (kb == t0);
        f32x16 x;
#pragma unroll
        for (int i = 0; i < 16; ++i) { const float z = s[i] * 0.125f; const float t = __builtin_amdgcn_exp2f(-fabsf(z) * LOG2E); const float sp = fmaxf(z, 0.f) + LN2 * __builtin_amdgcn_logf(1.0f + t);
            const bool valid = !(diag && crow(i, h) >= r); x[i] = valid ? -sp : 0.f; s[i] = valid ? z : -INFINITY; }
        float T4[4], E[16];
#pragma unroll
        for (int g = 0; g < 4; ++g) { E[4 * g + 3] = 0.f; E[4 * g + 2] = x[4 * g + 3]; E[4 * g + 1] = E[4 * g + 2] + x[4 * g + 2]; E[4 * g] = E[4 * g + 1] + x[4 * g + 1]; T4[g] = E[4 * g] + x[4 * g]; }
        float P4[4];
#pragma unroll
        for (int g = 0; g < 4; ++g) P4[g] = px32(T4[g], lane);
        float C[4]; float run = 0.f;
#pragma unroll
        for (int g = 3; g >= 0; --g) { C[g] = run + (h == 0 ? P4[g] : 0.f); run += T4[g] + P4[g]; }
#pragma unroll
        for (int i = 0; i < 16; ++i) { const float arg = x[i] + s[i] + (R + C[i >> 2] + E[i]); x[i] = __builtin_amdgcn_exp2f(arg * LOG2E); }
        pv_tile(o, VTh + (size_t)r * SEQ + kb + 4 * h, x);
        R += run;
        if (!__any(R >= -104.0f)) break;
    }
    store_ot(YCAT + ((size_t)(bh >> 4) * SEQ + t0 + r) * 1024 + (bh & 15) * 64, o, 1.0f, h);
}

#define INS16(L, x_) do { int x = (x_); _Pragma("unroll") for (int q_ = 0; q_ < 16; ++q_) { const int hi_ = max(L[q_], x); x = min(L[q_], x); L[q_] = hi_; } } while (0)
DI void peer_scores(int tokg, int head, const bf16* QP, const bf16* SUBK, unsigned* ent  , int lane) {
    const int r = lane & 31, h = lane >> 5;
    int L1[16], L2[16];
#pragma unroll
    for (int p = 0; p < 2; ++p) {
        const bf16* qp = QP + (size_t)(tokg + r) * 2048 + head * 256 + p * 128 + 8 * h; bf16x8 qf[8];
#pragma unroll
        for (int ks = 0; ks < 8; ++ks) qf[ks] = ld16g(qp + 16 * ks);
        const bf16* sk = SUBK + (size_t)((head * 2 + p) * 128 + r) * 128 + 8 * h;
        int L[16];
#pragma unroll
        for (int i = 0; i < 16; ++i) L[i] = KEY_MIN;
#pragma unroll 1
        for (int mt = 0; mt < 4; ++mt) {
            f32x16 acc;
#pragma unroll
            for (int i = 0; i < 16; ++i) acc[i] = 0.f;
#pragma unroll
            for (int ks = 0; ks < 8; ++ks) acc = MFMA32(ld16g(sk + (size_t)mt * 32 * 128 + 16 * ks), qf[ks], acc);
#pragma unroll
            for (int i = 0; i < 16; ++i) INS16(L, (f_ord(acc[i]) & ~127) | (32 * mt + crow(i, h)));
        }
        int Pn[16];
#pragma unroll
        for (int i = 0; i < 16; ++i) Pn[i] = px32(L[i], lane);
#pragma unroll
        for (int i = 0; i < 16; ++i) INS16(L, Pn[i]);
#pragma unroll
        for (int i = 0; i < 16; ++i) { if (p == 0) L1[i] = L[i]; else L2[i] = L[i]; }
    }
    int Cn[16];
#pragma unroll
    for (int i = 0; i < 16; ++i) Cn[i] = KEY_MIN;
#pragma unroll
    for (int i = 0; i < 16; ++i)
#pragma unroll
        for (int j = 0; j < 16; ++j) if ((i + 1) * (j + 1) <= 16) { const float v = f_unord(L1[i] & ~127) + f_unord(L2[j] & ~127); INS16(Cn, (f_ord(v) & ~0x3fff) | ((L1[i] & 127) << 7) | (L2[j] & 127)); }
    float e[16]; float sum = 0.f; const float m0 = f_unord(Cn[0] & ~0x3fff);
#pragma unroll
    for (int k = 0; k < 16; ++k) { e[k] = __builtin_amdgcn_exp2f((f_unord(Cn[k] & ~0x3fff) - m0) * LOG2E); sum += e[k]; }
    const float inv = 1.0f / sum;
    if (h == 0) { unsigned* dst = ent + (size_t)r * 128 + head * 16;
#pragma unroll
        for (int g4 = 0; g4 < 4; ++g4) { v4u w;
            w.x = (cvtpk2(0.f, e[4 * g4] * inv) & 0xffff0000u) | (unsigned)(Cn[4 * g4] & 0x3fff); w.y = (cvtpk2(0.f, e[4 * g4 + 1] * inv) & 0xffff0000u) | (unsigned)(Cn[4 * g4 + 1] & 0x3fff);
            w.z = (cvtpk2(0.f, e[4 * g4 + 2] * inv) & 0xffff0000u) | (unsigned)(Cn[4 * g4 + 2] & 0x3fff); w.w = (cvtpk2(0.f, e[4 * g4 + 3] * inv) & 0xffff0000u) | (unsigned)(Cn[4 * g4 + 3] & 0x3fff);
            *(v4u*)(dst + 4 * g4) = w; } }
}
typedef float f32x2 __attribute__((ext_vector_type(2)));
DI f32x2 fp8lo(unsigned w) { return __builtin_amdgcn_cvt_pk_f32_fp8((int)w, false); }
DI f32x2 fp8hi(unsigned w) { return __builtin_amdgcn_cvt_pk_f32_fp8((int)w, true); }
DI f32x2 fma2(f32x2 a, f32x2 b, f32x2 c) { float x = c.x, y = c.y; asm("v_fmac_f32 %0, %1, %2" : "+v"(x) : "v"(a.x), "v"(b.x)); asm("v_fmac_f32 %0, %1, %2" : "+v"(y) : "v"(a.y), "v"(b.y)); return (f32x2){x, y}; }
constexpr int PU_LIST = 0, PU_H = 32768, PU_USC = 98304, PU_VSC = 106496, PU_BC = 114688;
template <int VAR> DI void peer_u_issue(v4u (&rw)[16], const unsigned char* U8, const LAS unsigned* lev, int g, int cnt, int lane) {
#pragma unroll
    for (int k = 0; k < 16; ++k) { const int idx = (g + k < cnt) ? g + k : cnt - 1; const unsigned ev = (unsigned)__builtin_amdgcn_readfirstlane((int)lev[idx]);
        rw[k] = *(const v4u*)(U8 + (size_t)((VAR == 2) ? ((ev & 0x3800u) + k) : (ev & 0x3fffu)) * 1024 + 16 * lane); }
}
template <int VAR> DI void peer_u_compute(const v4u (&rw)[16], const LAS unsigned char* hrow, const LAS unsigned* lev, const LAS unsigned* lslot, int g, int cnt, int tok, const LAS float* uscs, const LAS float* vscs, float* ACT, int lane, int myk) {
    const v4u ha = *(const LAS v4u*)(hrow + 32 * lane), hb = *(const LAS v4u*)(hrow + 32 * lane + 16);
    f32x2 hf[8];
    hf[0] = (f32x2){bf_lo(ha.x), bf_hi(ha.x)}; hf[1] = (f32x2){bf_lo(ha.y), bf_hi(ha.y)}; hf[2] = (f32x2){bf_lo(ha.z), bf_hi(ha.z)}; hf[3] = (f32x2){bf_lo(ha.w), bf_hi(ha.w)};
    hf[4] = (f32x2){bf_lo(hb.x), bf_hi(hb.x)}; hf[5] = (f32x2){bf_lo(hb.y), bf_hi(hb.y)}; hf[6] = (f32x2){bf_lo(hb.z), bf_hi(hb.z)}; hf[7] = (f32x2){bf_lo(hb.w), bf_hi(hb.w)};
    float p[16];
#pragma unroll
    for (int k = 0; k < 16; ++k) { if (VAR == 3) { p[k] = __uint_as_float((rw[k].x ^ rw[k].y ^ rw[k].z ^ rw[k].w) & 0x3fffffffu) * hf[0].x; continue; } f32x2 a = (f32x2){0.f, 0.f};
        a = fma2(fp8lo(rw[k].x), hf[0], a); a = fma2(fp8hi(rw[k].x), hf[1], a); a = fma2(fp8lo(rw[k].y), hf[2], a); a = fma2(fp8hi(rw[k].y), hf[3], a);
        a = fma2(fp8lo(rw[k].z), hf[4], a); a = fma2(fp8hi(rw[k].z), hf[5], a); a = fma2(fp8lo(rw[k].w), hf[6], a); a = fma2(fp8hi(rw[k].w), hf[7], a); p[k] = a.x + a.y; }
    if (VAR == 4) { float s_ = 0.f; _Pragma("unroll") for (int k = 0; k < 16; ++k) s_ += p[k]; p[0] = s_; } else {
    { const bool up = (lane & 8) != 0;
#pragma unroll
      for (int i = 0; i < 8; ++i) { const float keep = up ? p[i + 8] : p[i], send = up ? p[i] : p[i + 8]; p[i] = keep + dppf<DPP_RM>(send); } }
    { const bool up = (lane & 4) != 0;
#pragma unroll
      for (int i = 0; i < 4; ++i) { const float keep = up ? p[i + 4] : p[i], send = up ? p[i] : p[i + 4]; p[i] = keep + dppf<DPP_HM>(send); } }
    { const bool up = (lane & 2) != 0;
#pragma unroll
      for (int i = 0; i < 2; ++i) { const float keep = up ? p[i + 2] : p[i], send = up ? p[i] : p[i + 2]; p[i] = keep + dppf<DPP_X2>(send); } }
    { const bool up = (lane & 1) != 0; const float keep = up ? p[1] : p[0], send = up ? p[0] : p[1]; p[0] = keep + dppf<DPP_X1>(send); }
    }
    float dot = sum32(sum16(p[0]));
    if (lane < 16 && g + myk < cnt) { const unsigned mev = lev[g + myk], mslot = lslot[g + myk]; const unsigned er = mev & 2047u;
        ACT[(VAR == 1) ? (size_t)lane : ((size_t)tok * 128 + mslot)] = gelu_tanh(dot * uscs[er]) * __uint_as_float(mev & 0xffff0000u) * vscs[er]; }
}
DI void peer_u_loade(int tok, const unsigned* ENT, unsigned (&e0)[4], unsigned (&e1)[4], int lane) {
#pragma unroll
    for (int t = 0; t < 4; ++t) { e0[t] = ENT[(size_t)(tok + t) * 128 + lane]; e1[t] = ENT[(size_t)(tok + t) * 128 + 64 + lane]; }
}
template <int VAR> DI void peer_u_wave(int tok0, int slab, const unsigned* ENT, const bf16* HN, const unsigned char* U8, float* ACT, LAS unsigned char* lds, int wave, int lane) {
    const int myk = lane & 15;
    LAS unsigned* lev = (LAS unsigned*)(lds + PU_LIST + wave * 4096); LAS unsigned* lslot = lev + 512; LAS unsigned char* hb = lds + PU_H + wave * 8192;
    const LAS float* uscs = (const LAS float*)(lds + PU_USC); const LAS float* vscs = (const LAS float*)(lds + PU_VSC);
    unsigned e0[4], e1[4];
    peer_u_loade(tok0, ENT, e0, e1, lane);
#pragma unroll 1
    for (int bt = 0; bt < 4; ++bt) { const int tb = tok0 + 4 * bt;
        v4u h0[4], h1[4];
#pragma unroll
        for (int t = 0; t < 4; ++t) { h0[t] = *(const v4u*)(HN + (size_t)(tb + t) * 1024 + 16 * lane); h1[t] = *(const v4u*)(HN + (size_t)(tb + t) * 1024 + 16 * lane + 8); }
        int cnt[4], off[4]; int n = 0; const unsigned long long lt = (1ull << lane) - 1ull;
#pragma unroll
        for (int t = 0; t < 4; ++t) { const bool in0 = ((e0[t] >> 11) & 7u) == (unsigned)slab, in1 = ((e1[t] >> 11) & 7u) == (unsigned)slab;
            const unsigned long long b0 = __ballot(in0), b1 = __ballot(in1); off[t] = n; const int n0 = n + __builtin_popcountll(b0);
            if (in0) { const int p = n + __builtin_popcountll(b0 & lt); lev[p] = e0[t]; lslot[p] = (unsigned)lane; }
            if (in1) { const int p = n0 + __builtin_popcountll(b1 & lt); lev[p] = e1[t]; lslot[p] = (unsigned)(64 + lane); }
            n = n0 + __builtin_popcountll(b1); cnt[t] = n - off[t]; }
        if (bt < 3) peer_u_loade(tb + 4, ENT, e0, e1, lane);
#pragma unroll
        for (int t = 0; t < 4; ++t) { *(LAS v4u*)(hb + t * 2048 + 32 * lane) = h0[t]; *(LAS v4u*)(hb + t * 2048 + 32 * lane + 16) = h1[t]; }
        asm volatile("s_waitcnt lgkmcnt(0)" ::: "memory");
#define PU_CNT(t_) ((t_) == 0 ? cnt[0] : ((t_) == 1 ? cnt[1] : ((t_) == 2 ? cnt[2] : cnt[3])))
#define PU_OFF(t_) ((t_) == 0 ? off[0] : ((t_) == 1 ? off[1] : ((t_) == 2 ? off[2] : off[3])))
#define PU_ADV(tk_, g_) do { while ((tk_) < 4 && (g_) >= PU_CNT(tk_)) { ++(tk_); (g_) = 0; } } while (0)
        int tk = 0, g = 0; PU_ADV(tk, g);
        if (tk < 4) { v4u ra[16], rb[16];
            peer_u_issue<VAR>(ra, U8, lev + PU_OFF(tk), g, PU_CNT(tk), lane);
            for (;;) {
                int ntk = tk, ng = g + 16; PU_ADV(ntk, ng);
                if (ntk < 4) peer_u_issue<VAR>(rb, U8, lev + PU_OFF(ntk), ng, PU_CNT(ntk), lane);
                peer_u_compute<VAR>(ra, hb + tk * 2048, lev + PU_OFF(tk), lslot + PU_OFF(tk), g, PU_CNT(tk), tb + tk, uscs, vscs, ACT, lane, myk);
                tk = ntk; g = ng; if (tk >= 4) break;
                ntk = tk; ng = g + 16; PU_ADV(ntk, ng);
                if (ntk < 4) peer_u_issue<VAR>(ra, U8, lev + PU_OFF(ntk), ng, PU_CNT(ntk), lane);
                peer_u_compute<VAR>(rb, hb + tk * 2048, lev + PU_OFF(tk), lslot + PU_OFF(tk), g, PU_CNT(tk), tb + tk, uscs, vscs, ACT, lane, myk);
                tk = ntk; g = ng; if (tk >= 4) break;
            } }
#undef PU_CNT
#undef PU_OFF
#undef PU_ADV
        asm volatile("s_waitcnt lgkmcnt(0)" ::: "memory");
    }
}
DI void peer_v_wave(int tok0, int slab, const unsigned* ENT, const float* ACT, const unsigned char* V8slab, float* X, const float* g2, int lane) {
    const int sub = lane & 7, j = lane >> 3;
    const int col = 128 * slab + 16 * sub + 2 * (4 * ((lane >> 5) & 1) + 2 * ((lane >> 4) & 1) + ((lane >> 3) & 1));
    const f32x2 gv = *(const f32x2*)(g2 + (tok0 >> 13) * 6144 + col);
    v4u enn[4]; f32x4 awn[4]; f32x2 xvn;
    { const v4u* ep = (const v4u*)(ENT + (size_t)tok0 * 128 + 16 * j); const f32x4* ap = (const f32x4*)(ACT + (size_t)tok0 * 128 + 16 * j);
#pragma unroll
      for (int q = 0; q < 4; ++q) { enn[q] = ep[q]; awn[q] = ap[q]; }
      xvn = *(const f32x2*)(X + (size_t)tok0 * 1024 + col); }
#pragma unroll 1
    for (int it = 0; it < 8; ++it) { const int tok = tok0 + it;
        v4u en[4]; f32x4 aw[4]; const f32x2 xv = xvn;
#pragma unroll
        for (int q = 0; q < 4; ++q) { en[q] = enn[q]; aw[q] = awn[q]; }
        v4u rw[16];
#pragma unroll
        for (int i = 0; i < 16; ++i) rw[i] = *(const v4u*)(V8slab + (size_t)(en[i >> 2][i & 3] & 0x3fffu) * 128 + 16 * sub);
        if (it < 7) { const v4u* ep = (const v4u*)(ENT + (size_t)(tok + 1) * 128 + 16 * j); const f32x4* ap = (const f32x4*)(ACT + (size_t)(tok + 1) * 128 + 16 * j);
#pragma unroll
            for (int q = 0; q < 4; ++q) { enn[q] = ep[q]; awn[q] = ap[q]; }
            xvn = *(const f32x2*)(X + (size_t)(tok + 1) * 1024 + col); }
        f32x2 acc[8];
#pragma unroll
        for (int c = 0; c < 8; ++c) acc[c] = (f32x2){0.f, 0.f};
#pragma unroll
        for (int i = 0; i < 16; ++i) { const float w = aw[i >> 2][i & 3]; const f32x2 w2 = (f32x2){w, w};
            acc[0] = fma2(fp8lo(rw[i].x), w2, acc[0]); acc[1] = fma2(fp8hi(rw[i].x), w2, acc[1]); acc[2] = fma2(fp8lo(rw[i].y), w2, acc[2]); acc[3] = fma2(fp8hi(rw[i].y), w2, acc[3]);
            acc[4] = fma2(fp8lo(rw[i].z), w2, acc[4]); acc[5] = fma2(fp8hi(rw[i].z), w2, acc[5]); acc[6] = fma2(fp8lo(rw[i].w), w2, acc[6]); acc[7] = fma2(fp8hi(rw[i].w), w2, acc[7]); }
        { const bool up = (lane & 32) != 0;
#pragma unroll
          for (int c = 0; c < 4; ++c) { const f32x2 keep = up ? acc[c + 4] : acc[c], send = up ? acc[c] : acc[c + 4]; acc[c] = (f32x2){keep.x + px32(send.x, lane), keep.y + px32(send.y, lane)}; } }
        { const bool up = (lane & 16) != 0;
#pragma unroll
          for (int c = 0; c < 2; ++c) { const f32x2 keep = up ? acc[c + 2] : acc[c], send = up ? acc[c] : acc[c + 2]; acc[c] = (f32x2){keep.x + px16(send.x, lane), keep.y + px16(send.y, lane)}; } }
        { const bool up = (lane & 8) != 0; const f32x2 keep = up ? acc[1] : acc[0], send = up ? acc[0] : acc[1]; acc[0] = (f32x2){keep.x + dppf<DPP_R8>(send.x), keep.y + dppf<DPP_R8>(send.y)}; }
        *(f32x2*)(X + (size_t)tok * 1024 + col) = (f32x2){xv.x + gv.x * acc[0].x, xv.y + gv.y * acc[0].y};
    }
}
struct PeerT { const unsigned char *U8, *V8s; const float *USC, *VSC; unsigned* ENT; float* ACT; const bf16* HN; float* X; const float* g2; };
DI void peer_scores_phase(const Frame& F, const bf16* QP, const bf16* SUBK, unsigned* ENT) {
    for (int unit = blockIdx.x; unit < MROWS / 64; unit += F.G) {
#pragma unroll 1
        for (int grp = 0; grp < 2; ++grp) { const int tokg = unit * 64 + 32 * grp; peer_scores(tokg, F.wave, QP, SUBK, ENT + (size_t)tokg * 128, F.lane); } }
}
template <int PASS, int VAR = 0> DI void peer_gather_phase(const Frame& F, int cnt_base, const PeerT& T) {
    const int xcc = (int)(xb_xcc_id() & 7u); LAS int* bc = (LAS int*)(F.lds + PU_BC);
    constexpr int CHT = (PASS == 0) ? 128 : 64;
    for (int k = 0; k < 8; ++k) { const int s = (xcc + k) & 7; unsigned* cnt = (unsigned*)(F.ctl + CW_WORK + 64 * (cnt_base + s));
        if (PASS == 0) { for (int i = F.tid; i < 2048; i += NTHR) { ((LAS float*)(F.lds + PU_USC))[i] = T.USC[2048 * s + i]; ((LAS float*)(F.lds + PU_VSC))[i] = T.VSC[2048 * s + i]; } }
        for (;;) {
            if (F.tid == 0) *bc = (int)__hip_atomic_fetch_add(cnt, 1u, __ATOMIC_RELAXED, __HIP_MEMORY_SCOPE_AGENT);
            __syncthreads(); const int chunk = *bc; __syncthreads();
            if (chunk >= MROWS / CHT) break;
            if (PASS == 0) peer_u_wave<VAR>(chunk * 128 + F.wave * 16, s, T.ENT, T.HN, T.U8, T.ACT, F.lds, F.wave, F.lane);
            else peer_v_wave(chunk * 64 + F.wave * 8, s, T.ENT, T.ACT, T.V8s + (size_t)s * 16384 * 128, T.X, T.g2, F.lane);
        } }
}
struct Args { const float* in[19]; float* out; unsigned char* ws; int stage, pad; };
__global__ void __launch_bounds__(NTHR, 2) hybrid_fwd(Args args) {
    extern __shared__ __attribute__((aligned(16))) unsigned char lds_raw[];
    for (int u = threadIdx.x; u < (LDS_BYTES - LDSCTL_OFF) / 4; u += NTHR) ((LAS unsigned*)((LAS unsigned char*)lds_raw + LDSCTL_OFF))[u] = 0u;
    __syncthreads();
    XcdBarrier bar = xcd_barrier_post((unsigned*)((gu32*)(args.ws + WS_CTL) + CW_BAR), (volatile LAS unsigned*)((LAS unsigned char*)lds_raw + MISC_OFF) + 8);
#ifdef PROBE_MASK
    volatile LAS unsigned long long* stamps_ = (volatile LAS unsigned long long*)((LAS unsigned char*)lds_raw + MISC_OFF + 256); int nst_ = 0;
#define STAMP() do { if (blockIdx.x == 0 && threadIdx.x == 0) stamps_[nst_] = __builtin_amdgcn_s_memrealtime(); ++nst_; } while (0)
#else
#define STAMP() do {} while (0)
#endif
    STAMP();
#define GRID_BAR() do { xcd_barrier(bar); STAMP(); } while (0)
#define OPQ(p) ({ size_t z_ = 0; asm volatile("" : "+s"(z_)); (p) + z_; })
#define PH_PTRS \
    unsigned char* ws = OPQ(args.ws); const float* x_in = OPQ(args.in[0]); float* X = OPQ(args.out); \
    const float *norm_mix = args.in[4], *norm_ffn = args.in[5]; \
    float* MOD = (float*)(ws + WS_MOD); float* ROPE = (float*)(ws + WS_ROPE); float* KSUM = (float*)(ws + WS_KSUM); \
    bf16 *WIN0 = (bf16*)(ws + WS_WIN0), *WOUT0 = (bf16*)(ws + WS_WOUT0), *WIN1 = (bf16*)(ws + WS_WIN1), *WOUT1 = (bf16*)(ws + WS_WOUT1), *WQ0 = (bf16*)(ws + WS_WQ0), *WQ1 = (bf16*)(ws + WS_WQ1); \
    bf16 *SUBK = (bf16*)(ws + WS_SUBK), *GWS = (bf16*)(ws + WS_GWS), *HN = (bf16*)(ws + WS_HN); \
    bf16 *UA = (bf16*)(ws + WS_A), *VA = (bf16*)(ws + WS_A + 16 * MiB), *Q0 = (bf16*)(ws + WS_A + 32 * MiB), *K0 = (bf16*)(ws + WS_A + 48 * MiB), *VT0 = (bf16*)(ws + WS_A + 64 * MiB); \
    bf16 *Q1 = (bf16*)(ws + WS_A), *K1 = (bf16*)(ws + WS_A + 32 * MiB), *VT1 = (bf16*)(ws + WS_A + 64 * MiB); \
    bf16 *YCAT = (bf16*)(ws + WS_YCAT), *QP = (bf16*)(ws + WS_QP), *PO = (bf16*)(ws + WS_PO); float* PL = (float*)(ws + WS_PL); unsigned* MASKS = (unsigned*)(ws + WS_MASK); unsigned char *U8 = ws + WS_PTU, *V8s = ws + WS_PTV; float *USC = (float*)(ws + WS_SC), *VSC = USC + 32768; unsigned* ENT = (unsigned*)(ws + WS_PO); float* ACT = (float*)(ws + WS_PO + 8 * MiB); (void)U8; (void)V8s; (void)USC; (void)VSC; (void)ENT; (void)ACT; bf16* QKR = (bf16*)(ws + WS_QP); (void)QKR; \
    (void)x_in; (void)X; (void)norm_mix; (void)norm_ffn; (void)MOD; (void)ROPE; (void)KSUM; (void)WIN0; (void)WOUT0; (void)WIN1; (void)WOUT1; (void)WQ0; (void)WQ1; (void)SUBK; (void)GWS; (void)HN; \
    (void)UA; (void)VA; (void)Q0; (void)K0; (void)VT0; (void)Q1; (void)K1; (void)VT1; (void)YCAT; (void)QP; (void)PO; (void)PL; (void)MASKS;
#define PH_FRAME Frame F; F.lds = (LAS unsigned char*)lds_raw; F.MISC = (volatile LAS unsigned*)(F.lds + MISC_OFF); { int t_ = threadIdx.x; asm volatile("" : "+v"(t_)); F.tid = t_; } F.lane = F.tid & 63; F.wave = __builtin_amdgcn_readfirstlane(F.tid >> 6); \
    F.G = gridDim.x; F.gw = blockIdx.x * NWAVES + F.wave; F.NGW = F.G * NWAVES; F.ctl = (gu32*)(OPQ(args.ws) + WS_CTL);
    { PH_FRAME PH_PTRS
      P0Args A; A.c = args.in[1]; A.w_mod = args.in[2]; A.b_mod = args.in[3]; A.win0 = args.in[6]; A.wout0 = args.in[12]; A.win1 = args.in[13]; A.wout1 = args.in[14]; A.wq = args.in[15]; A.subk = args.in[16];
      A.pu = args.in[17]; A.pv = args.in[18]; A.gws = args.in[8]; A.MOD = MOD; A.ROPE = ROPE; A.WIN0 = WIN0; A.WOUT0 = WOUT0; A.WIN1 = WIN1; A.WOUT1 = WOUT1; A.WQ0 = WQ0; A.WQ1 = WQ1; A.SUBK = SUBK; A.GWS = GWS; A.U8 = U8; A.V8s = V8s; A.USC = USC; A.VSC = VSC;
      p0_prologue(F, A); }
    GRID_BAR();
    { PH_FRAME PH_PTRS norm_rows(F, x_in, norm_mix, MOD, 0, 1, HN); }
    GRID_BAR();
    { PH_FRAME PH_PTRS
      pg8::Gemm g{HN, WIN0, MROWS, 2048, 1024}; pg8::StaticOrder S; S.init(MROWS, 2048, F.G, (int)blockIdx.x);
      pg8::EpiL0m E{UA, VA, QKR};
      pg8::gemm_phase<pg8::EpiL0m, pg8::StaticOrder, true, true>(F.lds, g, S, E); }
    { PH_FRAME PH_PTRS
      pg8::Gemm g{WIN0 + (size_t)2048 * 1024, HN, 512, MROWS, 1024}; pg8::StaticOrder S; S.init(512, MROWS, F.G, (int)blockIdx.x);
      pg8::EpiVT E{VT0, 512};
      pg8::gemm_phase<pg8::EpiVT, pg8::StaticOrder, true, true>(F.lds, g, S, E); }
    GRID_BAR();
    { PH_FRAME PH_PTRS
      for (int t = blockIdx.x; t < 256; t += F.G) qk_post_task(t, QKR, Q0, K0, KSUM, ROPE, args.in[10], args.in[11], (LAS float*)F.lds, F.tid, F.wave, F.lane);
      for (int u = blockIdx.x; u < 512; u += F.G) gmlp_unit(u, UA, VA, args.in[7], GWS, args.in[9], YCAT, F.lds, F.tid, F.wave, F.lane); }
    GRID_BAR();
    { PH_FRAME PH_PTRS
      MobaT T{Q0, K0, VT0, KSUM, MASKS, PO, PL, args.in[10], args.in[11]}; const float mc2 = moba_mc2(args.in[10], args.in[11], F.lane);
      for (int u = F.gw; u < 4096; u += F.NGW) { moba_mask_unit(u, T, F.lane); moba_own_unit(u, T, mc2, F.lane); } }
    GRID_BAR();
    { PH_FRAME PH_PTRS
      MobaT T{Q0, K0, VT0, KSUM, MASKS, PO, PL, args.in[10], args.in[11]}; const float mc2 = moba_mc2(args.in[10], args.in[11], F.lane);
      LAS unsigned* wq = (LAS unsigned*)(F.lds) + F.wave * 128;
      for (;;) { int task = 0; if (F.lane == 0) task = (int)__hip_atomic_fetch_add((unsigned*)(F.ctl + CW_WORK), 1u, __ATOMIC_RELAXED, __HIP_MEMORY_SCOPE_AGENT);
          task = __builtin_amdgcn_readfirstlane(task); if (task >= MOBA_NTASK) break;
          moba_sel_task(task, T, wq, mc2, F.lane); } }
    GRID_BAR();
    { PH_FRAME PH_PTRS moba_combine(F, PO, PL, YCAT); }
    GRID_BAR();
    { PH_FRAME PH_PTRS
      pg8::Gemm g{YCAT, WOUT0, MROWS, 1024, 1024}; pg8::StaticOrder S; S.init(MROWS, 1024, F.G, (int)blockIdx.x);
      pg8::EpiRes E{x_in, X, MOD + 2 * 1024};
      pg8::gemm_phase<pg8::EpiRes, pg8::StaticOrder, true, true>(F.lds, g, S, E); }
    GRID_BAR();
    { PH_FRAME PH_PTRS norm_rows(F, X, norm_ffn, MOD, 3, 4, HN); }
    GRID_BAR();
    { PH_FRAME PH_PTRS
      pg8::Gemm g{HN, WQ0, MROWS, 2048, 1024}; pg8::StaticOrder S; S.init(MROWS, 2048, F.G, (int)blockIdx.x);
      pg8::EpiBf16<0> E{QP, 2048, nullptr, 0, 0, 1.f};
      pg8::gemm_phase<pg8::EpiBf16<0>, pg8::StaticOrder, true, true>(F.lds, g, S, E); }
    GRID_BAR();
    { PH_FRAME PH_PTRS peer_scores_phase(F, QP, SUBK, ENT); }
    GRID_BAR();
    { PH_FRAME PH_PTRS PeerT T{U8, V8s, USC, VSC, ENT, ACT, HN, X, MOD + 5 * 1024}; peer_gather_phase<0>(F, 1, T); }
    GRID_BAR();
#ifdef XVAR
    { PH_FRAME PH_PTRS PeerT T{U8, V8s, USC, VSC, ENT, (float*)(ws + WS_PL), HN, X, MOD + 5 * 1024}; peer_gather_phase<0, XVAR>(F, 40, T); }
    GRID_BAR();
#endif
    { PH_FRAME PH_PTRS PeerT T{U8, V8s, USC, VSC, ENT, ACT, HN, X, MOD + 5 * 1024}; peer_gather_phase<1>(F, 9, T); }
    GRID_BAR();
    { PH_FRAME PH_PTRS norm_rows(F, X, norm_mix + 1024, MOD + 2 * 6144, 0, 1, HN); }
    GRID_BAR();
    { PH_FRAME PH_PTRS
      pg8::Gemm g{HN, WIN1, MROWS, 2048, 1024}; pg8::StaticOrder S; S.init(MROWS, 2048, F.G, (int)blockIdx.x);
      pg8::EpiHeads E{Q1, K1, 16};
      pg8::gemm_phase<pg8::EpiHeads, pg8::StaticOrder, true, true>(F.lds, g, S, E); }
    { PH_FRAME PH_PTRS
      pg8::Gemm g{WIN1 + (size_t)2048 * 1024, HN, 1024, MROWS, 1024}; pg8::StaticOrder S; S.init(1024, MROWS, F.G, (int)blockIdx.x);
      pg8::EpiVT E{VT1, 1024};
      pg8::gemm_phase<pg8::EpiVT, pg8::StaticOrder, true, true>(F.lds, g, S, E); }
    GRID_BAR();
    { PH_FRAME PH_PTRS for (int u = F.gw; u < 8192; u += F.NGW) sb_unit(u, Q1, K1, VT1, YCAT, F.lane); }
    GRID_BAR();
    { PH_FRAME PH_PTRS
      pg8::Gemm g{YCAT, WOUT1, MROWS, 1024, 1024}; pg8::StaticOrder S; S.init(MROWS, 1024, F.G, (int)blockIdx.x);
      pg8::EpiRes E{X, X, MOD + 2 * 6144 + 2 * 1024};
      pg8::gemm_phase<pg8::EpiRes, pg8::StaticOrder, true, true>(F.lds, g, S, E); }
    GRID_BAR();
    { PH_FRAME PH_PTRS norm_rows(F, X, norm_ffn + 1024, MOD + 2 * 6144, 3, 4, HN); }
    GRID_BAR();
    { PH_FRAME PH_PTRS
      pg8::Gemm g{HN, WQ1, MROWS, 2048, 1024}; pg8::StaticOrder S; S.init(MROWS, 2048, F.G, (int)blockIdx.x);
      pg8::EpiBf16<0> E{QP, 2048, nullptr, 0, 0, 1.f};
      pg8::gemm_phase<pg8::EpiBf16<0>, pg8::StaticOrder, true, true>(F.lds, g, S, E); }
    GRID_BAR();
    { PH_FRAME PH_PTRS peer_scores_phase(F, QP, SUBK + 262144, ENT); }
    GRID_BAR();
    { PH_FRAME PH_PTRS PeerT T{U8 + (size_t)16384 * 1024, V8s + (size_t)16384 * 1024, USC + 16384, VSC + 16384, ENT, ACT, HN, X, MOD + 2 * 6144 + 5 * 1024}; peer_gather_phase<0>(F, 17, T); }
    GRID_BAR();
    { PH_FRAME PH_PTRS PeerT T{U8 + (size_t)16384 * 1024, V8s + (size_t)16384 * 1024, USC + 16384, VSC + 16384, ENT, ACT, HN, X, MOD + 2 * 6144 + 5 * 1024}; peer_gather_phase<1>(F, 25, T);
      if (__hip_atomic_load((gu32*)((unsigned*)(F.ctl + CW_BAR) + XB_TMO), RLX_AGENT) != 0u) { for (int m = F.gw; m < MROWS; m += F.NGW) X[(size_t)m * 1024 + F.lane] = __builtin_nanf(""); } }
#ifdef PROBE_MASK
#ifdef PROBE_BARS
    for (int i = 0; i < PROBE_BARS; ++i) xcd_barrier(bar);
#endif
    STAMP();
    if (blockIdx.x == 0 && threadIdx.x == 0) { unsigned long long tsel = 0;
        for (int i = 0; i + 1 < nst_; ++i) if ((PROBE_MASK >> i) & 1ull) tsel += stamps_[i + 1] - stamps_[i];
        const unsigned long long t0 = __builtin_amdgcn_s_memrealtime(); while (__builtin_amdgcn_s_memrealtime() - t0 < tsel * PROBE_AMP) __builtin_amdgcn_s_sleep(8); }
#endif
}

extern "C" void kernel_launch(void* const* d_in, const int* in_sizes, int n_in, void* d_out, int out_size, void* d_ws, size_t ws_size, hipStream_t stream) {
    static int grid = 0;
    if (grid == 0) {
        if (n_in != 19 || out_size != MROWS * DM || ws_size < WS_END) { fprintf(stderr, "kernel_launch: unexpected shapes (n_in %d, out %d, ws %zu)\n", n_in, out_size, ws_size); grid = -1; return; }
        int dev = 0, cus = 0, per_cu = 0;
        if (hipGetDevice(&dev) != hipSuccess || hipDeviceGetAttribute(&cus, hipDeviceAttributeMultiprocessorCount, dev) != hipSuccess) { grid = -1; return; }
        if (hipFuncSetAttribute((const void*)hybrid_fwd, hipFuncAttributeMaxDynamicSharedMemorySize, LDS_BYTES) != hipSuccess) { fprintf(stderr, "kernel_launch: hipFuncSetAttribute failed\n"); grid = -1; return; }
        if (hipOccupancyMaxActiveBlocksPerMultiprocessor(&per_cu, (const void*)hybrid_fwd, NTHR, LDS_BYTES) != hipSuccess || per_cu < 1) { fprintf(stderr, "kernel_launch: occupancy query says %d\n", per_cu); per_cu = 1; }
        (void)hipGetLastError();
        grid = cus;
    }
    if (grid < 0) return;
    if (hipMemsetAsync((char*)d_ws + WS_CTL, 0, CTL_ZERO_BYTES, stream) != hipSuccess) { fprintf(stderr, "kernel_launch: memset failed\n"); return; }
    Args a{};
    for (int i = 0; i < 19; ++i) a.in[i] = (const float*)d_in[i];
    a.out = (float*)d_out; a.ws = (unsigned char*)d_ws; a.stage = 0; a.pad = 0;
    void* kargs[] = {&a};
    hipError_t e = hipLaunchCooperativeKernel((const void*)hybrid_fwd, dim3(grid), dim3(NTHR), kargs, LDS_BYTES, stream);
    if (e != hipSuccess) fprintf(stderr, "kernel_launch: cooperative launch failed: %s (grid %d)\n", hipGetErrorString(e), grid);
}
```

```cpp
#include <hip/hip_runtime.h>
#include <cstdio>
#include <cstdint>
#include <cmath>
namespace pg8 {
#define PG8_LAS __attribute__((address_space(3)))
typedef unsigned short bf16_t;
typedef short bf16x8 __attribute__((ext_vector_type(8)));
typedef float f32x4 __attribute__((ext_vector_type(4)));
typedef unsigned u32x4 __attribute__((ext_vector_type(4)));
constexpr int BM = 256, BK = 64, HALF = 128, HTB = HALF * BK * 2  , STAGE_BYTES = 8 * HTB, NXCD = 8, WGM = 8;

__host__ __device__ __forceinline__ int lds_byte(int r, int c) { const int st = (r >> 4) * 2 + (c >> 5), rr = r & 15, cc = c & 31, ob = rr * 64 + cc * 2; return st * 1024 + (ob ^ (((ob >> 9) & 1) << 5)); }
__host__ __device__ __forceinline__ void stage_rc(int b, int& R, int& C) { const int st = b / 1024, sb = b % 1024, swz = sb ^ (((sb >> 9) & 1) << 5); R = (st >> 1) * 16 + swz / 64; C = (st & 1) * 32 + (swz % 64) / 2; }
__host__ __device__ __forceinline__ int perm32(int rho) { const int n = rho >> 4, i = rho & 15; return 8 * (i >> 2) + 4 * n + (i & 3); }

struct Unit { int pm, pn; };
struct Gemm { const bf16_t* A; const bf16_t* Bt; int M, N, K; };

struct StaticOrder {
    int nM, nN, nwg, G, c;
    __host__ __device__ void init(int M, int N, int G_, int c_) { nM = M / BM; nN = N / BM; nwg = nM * nN; G = G_; c = c_; }
    __host__ __device__ bool next(int i, Unit& u) const {
        const long L = (long)i * G + c; if (L >= nwg) return false;
        int wgid = (int)L; { const int q = nwg / NXCD, r = nwg % NXCD, xcd = wgid % NXCD, off = wgid / NXCD; wgid = (xcd < r ? xcd * (q + 1) : r * (q + 1) + (xcd - r) * q) + off; }
        const int nig = WGM * nN, gid = wgid / nig, fm = gid * WGM, gsz = (nM - fm) < WGM ? (nM - fm) : WGM;
        u.pm = fm + ((wgid % nig) % gsz); u.pn = (wgid % nig) / gsz; return true;
    }
    __device__ __forceinline__ void a_ready(const Unit&) const {}
    __device__ __forceinline__ void done(const Unit&) const {}
};

__device__ __forceinline__ unsigned cvt_pk_bf16(float lo, float hi) { unsigned r; asm volatile("v_cvt_pk_bf16_f32 %0, %1, %2" : "=v"(r) : "v"(lo), "v"(hi)); return r; }
typedef float f32x2 __attribute__((ext_vector_type(2)));
__device__ __forceinline__ f32x2 gelu_pk(f32x2 v) {
    const f32x2 av = __builtin_elementwise_abs(v), d = av * 0.2316418882f + 1.0f;
    f32x2 t; t.x = __builtin_amdgcn_rcpf(d.x); t.y = __builtin_amdgcn_rcpf(d.y);
    f32x2 q = t * 0.5307027145f + (-0.7265760135f); q = q * t + 0.7107068705f; q = q * t + (-0.142248368f); q = q * t + 0.127414796f; q = q * t;
    const f32x2 s = (v * v) * (-0.72134752044f);
    f32x2 e; e.x = __builtin_amdgcn_exp2f(s.x); e.y = __builtin_amdgcn_exp2f(s.y);
    const f32x2 m = v * (q * e), r = v - m;
    f32x2 o; o.x = v.x < 0.f ? m.x : r.x; o.y = v.y < 0.f ? m.y : r.y; return o;
}

template <int ACT  > struct EpiBf16 {
    static constexpr bool PERM = true, AFTER_DRAIN = false; static_assert(ACT == 0 || ACT == 1, "EpiBf16: ACT is 0 (none) or 1 (gelu_pk)");
    bf16_t* O; int ldc; const float* bias; int split_cols; size_t split_stride; float scale0;
    __device__ __forceinline__ void operator()(const f32x4 (&acc)[2][2][4][2], const Unit& u, int wr, int wc, int fr, int fq) const {
        const int row0 = u.pm * BM + wr * 64 + fr; int colt = u.pn * BM; bf16_t* base = O;
        float sc = 1.f; if (split_cols) { const int t = colt / split_cols; base += (size_t)t * split_stride; colt -= t * split_cols; if (t == 0) sc = scale0; }
        const int col0 = colt + wc * 32 + 8 * fq, bcol0 = u.pn * BM + wc * 32 + 8 * fq;
        f32x4 bv[2][2];
#pragma unroll
        for (int bj = 0; bj < 2; ++bj)
#pragma unroll
            for (int n = 0; n < 2; ++n) bv[bj][n] = bias ? *(const f32x4*)(bias + bcol0 + bj * HALF + 4 * n) : (f32x4){0.f, 0.f, 0.f, 0.f};
#pragma unroll
        for (int ai = 0; ai < 2; ++ai)
#pragma unroll
            for (int m = 0; m < 4; ++m) { bf16_t* rowp = base + (size_t)(row0 + ai * HALF + m * 16) * ldc + col0;
#pragma unroll
                for (int bj = 0; bj < 2; ++bj) { f32x4 v0 = acc[ai][bj][m][0] + bv[bj][0], v1 = acc[ai][bj][m][1] + bv[bj][1];
                    if (ACT == 1) { f32x2 a = gelu_pk((f32x2){v0[0], v0[1]}), b = gelu_pk((f32x2){v0[2], v0[3]}), c = gelu_pk((f32x2){v1[0], v1[1]}), d = gelu_pk((f32x2){v1[2], v1[3]});
                        v0 = (f32x4){a.x, a.y, b.x, b.y}; v1 = (f32x4){c.x, c.y, d.x, d.y}; }
                    v0 = v0 * sc; v1 = v1 * sc; u32x4 w; w.x = cvt_pk_bf16(v0[0], v0[1]); w.y = cvt_pk_bf16(v0[2], v0[3]); w.z = cvt_pk_bf16(v1[0], v1[1]); w.w = cvt_pk_bf16(v1[2], v1[3]);
                    *(u32x4*)(rowp + bj * HALF) = w; } }
    }
};
constexpr int XSEQ = 8192;
typedef float f32x2e __attribute__((ext_vector_type(2))); typedef __bf16 bf16x2e __attribute__((ext_vector_type(2)));
__device__ __forceinline__ unsigned cvtpk2(float lo, float hi) { f32x2e v = {lo, hi}; bf16x2e b = __builtin_convertvector(v, bf16x2e); return __builtin_bit_cast(unsigned, b); }
__device__ __forceinline__ float gelu_tanh(float x) {
    const float u2 = x * (1.5957691216f + 0.0713548163f * x * x);
    return x * __builtin_amdgcn_rcpf(1.0f + __builtin_amdgcn_exp2f(-1.4426950409f * u2));
}
struct EpiL0m {
    static constexpr bool PERM = true, AFTER_DRAIN = false;
    bf16_t *UA, *VA, *QKR;
    template <bool ACT> __device__ __forceinline__ void tile(const f32x4 (&acc)[2][2][4][2], bf16_t* base, int ldc, int row0, int colt) const {
#pragma unroll
        for (int ai = 0; ai < 2; ++ai)
#pragma unroll
            for (int m = 0; m < 4; ++m) { bf16_t* rowp = base + (size_t)(row0 + ai * HALF + m * 16) * ldc + colt;
#pragma unroll
                for (int bj = 0; bj < 2; ++bj) { f32x4 v0 = acc[ai][bj][m][0], v1 = acc[ai][bj][m][1]; u32x4 w;
                    if (ACT) { v0[0] = gelu_tanh(v0[0]); v0[1] = gelu_tanh(v0[1]); v0[2] = gelu_tanh(v0[2]); v0[3] = gelu_tanh(v0[3]); v1[0] = gelu_tanh(v1[0]); v1[1] = gelu_tanh(v1[1]); v1[2] = gelu_tanh(v1[2]); v1[3] = gelu_tanh(v1[3]); }
                    w.x = cvtpk2(v0[0], v0[1]); w.y = cvtpk2(v0[2], v0[3]); w.z = cvtpk2(v1[0], v1[1]); w.w = cvtpk2(v1[2], v1[3]);
                    *(u32x4*)(rowp + bj * HALF) = w; } }
    }
    __device__ __forceinline__ void operator()(const f32x4 (&acc)[2][2][4][2], const Unit& u, int wr, int wc, int fr, int fq) const {
        const int pn = u.pn; const int row0 = u.pm * BM + wr * 64 + fr; const int cw = wc * 32 + 8 * fq;
        if (pn < 2) tile<true>(acc, UA, 512, row0, pn * 256 + cw);
        else if (pn < 4) tile<true>(acc, VA, 512, row0, (pn - 2) * 256 + cw);
        else tile<false>(acc, QKR, 1024, row0, (pn - 4) * 256 + cw);
    }
};
struct EpiHeads {
    static constexpr bool PERM = true, AFTER_DRAIN = false;
    bf16_t *Q, *Kp; int nh;
    __device__ __forceinline__ void operator()(const f32x4 (&acc)[2][2][4][2], const Unit& u, int wr, int wc, int fr, int fq) const {
        const int b = u.pm >> 5, sb = (u.pm & 31) * 256 + wr * 64 + fr;
#pragma unroll
        for (int bj = 0; bj < 2; ++bj) { const int c = u.pn * BM + bj * HALF + wc * 32 + 8 * fq; const int t = c / (64 * nh), cc = c - t * 64 * nh, head = cc >> 6, d = cc & 63;
            bf16_t* dst = (t ? Kp : Q) + ((size_t)(b * nh + head) * XSEQ) * 64 + d;
#pragma unroll
            for (int ai = 0; ai < 2; ++ai)
#pragma unroll
                for (int m = 0; m < 4; ++m) { const int s = sb + ai * HALF + m * 16; const f32x4 v0 = acc[ai][bj][m][0], v1 = acc[ai][bj][m][1]; u32x4 w;
                    w.x = cvtpk2(v0[0], v0[1]); w.y = cvtpk2(v0[2], v0[3]); w.z = cvtpk2(v1[0], v1[1]); w.w = cvtpk2(v1[2], v1[3]);
                    *(u32x4*)(dst + (size_t)s * 64) = w; } }
    }
};
struct EpiVT {
    static constexpr bool PERM = true, AFTER_DRAIN = false;
    bf16_t* VT; int nrows;
    __device__ __forceinline__ void operator()(const f32x4 (&acc)[2][2][4][2], const Unit& u, int wr, int wc, int fr, int fq) const {
        const int row0 = u.pm * BM + wr * 64 + fr; const int c0 = u.pn * BM + wc * 32 + 8 * fq; const int b = c0 >> 13, s0 = c0 & (XSEQ - 1);
#pragma unroll
        for (int ai = 0; ai < 2; ++ai)
#pragma unroll
            for (int m = 0; m < 4; ++m) { bf16_t* rowp = VT + ((size_t)b * nrows + row0 + ai * HALF + m * 16) * XSEQ + s0;
#pragma unroll
                for (int bj = 0; bj < 2; ++bj) { const f32x4 v0 = acc[ai][bj][m][0], v1 = acc[ai][bj][m][1]; u32x4 w;
                    w.x = cvtpk2(v0[0], v0[1]); w.y = cvtpk2(v0[2], v0[3]); w.z = cvtpk2(v1[0], v1[1]); w.w = cvtpk2(v1[2], v1[3]);
                    *(u32x4*)(rowp + bj * HALF) = w; } }
    }
};
struct EpiRes {
    static constexpr bool PERM = false, AFTER_DRAIN = false;
    const float* xin; float* xout; const float* g;
    __device__ __forceinline__ void operator()(const f32x4 (&acc)[2][2][4][2], const Unit& u, int wr, int wc, int fr, int fq) const {
        const int row0 = u.pm * BM + wr * 64 + fr, col0 = u.pn * BM + wc * 32 + 4 * fq; const int b = u.pm >> 5;
        f32x4 gv[2][2];
#pragma unroll
        for (int bj = 0; bj < 2; ++bj)
#pragma unroll
            for (int n = 0; n < 2; ++n) gv[bj][n] = *(const f32x4*)(g + b * 6144 + col0 + bj * HALF + n * 16);
#pragma unroll
        for (int ai = 0; ai < 2; ++ai)
#pragma unroll
            for (int m = 0; m < 4; ++m) { const size_t off = (size_t)(row0 + ai * HALF + m * 16) * 1024 + col0;
#pragma unroll
                for (int bj = 0; bj < 2; ++bj)
#pragma unroll
                    for (int n = 0; n < 2; ++n) { const f32x4 xi = *(const f32x4*)(xin + off + bj * HALF + n * 16); *(f32x4*)(xout + off + bj * HALF + n * 16) = xi + gv[bj][n] * acc[ai][bj][m][n]; } }
    }
};
template <class Epi, class Sched, bool ALIGN_EPI = false, bool SP2 = false>
__device__ __forceinline__ void gemm_phase(PG8_LAS unsigned char* lds, const Gemm g, const Sched& S, const Epi& E) {
    int tid_ = threadIdx.x; asm volatile("" : "+v"(tid_));
    const int tid = tid_, wid = __builtin_amdgcn_readfirstlane(tid >> 6), lane = tid & 63, wr = wid >> 2, wc = wid & 3, fr = lane & 15, fq = lane >> 4;
    const int K = g.K, nt = K / BK;
    unsigned voffA[2], voffB[2];
#pragma unroll
    for (int i = 0; i < 2; ++i) { int R, C; stage_rc(tid * 16 + i * 8192, R, C); const int Rb = Epi::PERM ? ((R & ~31) + perm32(R & 31)) : R;
        voffA[i] = (unsigned)(R * K + C) * 2u; voffB[i] = (unsigned)(Rb * K + C) * 2u; }
    const size_t kstep = (size_t)(BK * 2);
    const size_t hstep = (size_t)HALF * K * 2;
    const size_t tstep = 2 * hstep;
    const unsigned ldsw = (unsigned)wid * 1024u;
    const int aoff = lds_byte(wr * 64 + fr, fq * 8), boff = lds_byte(wc * 32 + fr, fq * 8);
#define PG8_SA(b, h) (((b) * 2 + (h)) * HTB)
#define PG8_SB(b, h) ((4 + (b) * 2 + (h)) * HTB)
#define PG8_STAGE(bufoff, gbase, voff) do { _Pragma("unroll") for (int _i = 0; _i < 2; ++_i) \
        __builtin_amdgcn_global_load_lds((const unsigned*)((const char*)(gbase) + (voff)[_i]), (PG8_LAS unsigned*)(lds + (bufoff) + ldsw + _i * 8192), 16, 0, 0); } while (0)
#define PG8_LDA(dst, b, h) do { _Pragma("unroll") for (int m = 0; m < 4; ++m) _Pragma("unroll") for (int k = 0; k < 2; ++k) dst[m][k] = *(const PG8_LAS bf16x8*)(lds + PG8_SA(b, h) + aoff + m * 2048 + k * 1024); } while (0)
#define PG8_LDB(dst, b, h) do { _Pragma("unroll") for (int n = 0; n < 2; ++n) _Pragma("unroll") for (int k = 0; k < 2; ++k) dst[n][k] = *(const PG8_LAS bf16x8*)(lds + PG8_SB(b, h) + boff + n * 2048 + k * 1024); } while (0)
#define PG8_MMA(ai, bj, At, Bt) do { __builtin_amdgcn_s_setprio(1); _Pragma("unroll") for (int m = 0; m < 4; ++m) _Pragma("unroll") for (int n = 0; n < 2; ++n) _Pragma("unroll") for (int k = 0; k < 2; ++k) \
        acc[ai][bj][m][n] = __builtin_amdgcn_mfma_f32_16x16x32_bf16(Bt[n][k], At[m][k], acc[ai][bj][m][n], 0, 0, 0); __builtin_amdgcn_s_setprio(0); } while (0)
#define PG8_WAIT_V(n) asm volatile("s_waitcnt vmcnt(" #n ")" ::: "memory")
#define PG8_WAIT_L(n) asm volatile("s_waitcnt lgkmcnt(" #n ")" ::: "memory")
#define PG8_BAR __builtin_amdgcn_s_barrier()
#define PG8_SCHED __builtin_amdgcn_sched_barrier(0)
    Unit cur, nxt; int ui = 0;
    if (!S.next(0, cur)) return;
    f32x4 acc[2][2][4][2];
#pragma unroll
    for (int a = 0; a < 2; ++a)
#pragma unroll
        for (int b = 0; b < 2; ++b)
#pragma unroll
            for (int m = 0; m < 4; ++m)
#pragma unroll
                for (int n = 0; n < 2; ++n) acc[a][b][m][n] = (f32x4){0.f, 0.f, 0.f, 0.f};
    bf16x8 At[4][2], B0[2][2], B1[2][2];
    const char* cA = (const char*)g.A + (size_t)cur.pm * tstep; const char* cB = (const char*)g.Bt + (size_t)cur.pn * tstep;
    S.a_ready(cur);
    if constexpr (SP2) {
        PG8_STAGE(PG8_SB(0, 0), cB, voffB); PG8_STAGE(PG8_SB(0, 1), cB + hstep, voffB); PG8_STAGE(PG8_SA(0, 0), cA, voffA); PG8_STAGE(PG8_SA(0, 1), cA + hstep, voffA);
        if (wr == 1) PG8_BAR;
        PG8_WAIT_V(2); PG8_BAR;
        PG8_STAGE(PG8_SB(1, 0), cB + kstep, voffB); PG8_STAGE(PG8_SA(1, 0), cA + kstep, voffA); PG8_STAGE(PG8_SB(1, 1), cB + hstep + kstep, voffB);
        PG8_WAIT_V(6); PG8_BAR;
    } else {
        PG8_STAGE(PG8_SB(0, 0), cB, voffB); PG8_STAGE(PG8_SA(0, 0), cA, voffA); PG8_STAGE(PG8_SB(0, 1), cB + hstep, voffB); PG8_STAGE(PG8_SA(0, 1), cA + hstep, voffA);
        if (wr == 1) PG8_BAR;
        PG8_WAIT_V(4); PG8_BAR;
        PG8_STAGE(PG8_SB(1, 0), cB + kstep, voffB); PG8_STAGE(PG8_SA(1, 0), cA + kstep, voffA); PG8_STAGE(PG8_SB(1, 1), cB + hstep + kstep, voffB);
        PG8_WAIT_V(6); PG8_BAR;
    }
    for (;;) {
        const bool has_next = S.next(ui + 1, nxt);
        const char* nA = has_next ? (const char*)g.A + (size_t)nxt.pm * tstep : cA; const char* nB = has_next ? (const char*)g.Bt + (size_t)nxt.pn * tstep : cB;
        for (int t = 0; t < nt; t += 2) {
            const bool last = (t == nt - 2);
            const char* a1 = cA + (size_t)(t + 1) * kstep;
            const char* a2 = last ? nA : cA + (size_t)(t + 2) * kstep; const char* b2 = last ? nB : cB + (size_t)(t + 2) * kstep;
            const char* a3 = a2 + kstep; const char* b3 = b2 + kstep;
            if (last && has_next) S.a_ready(nxt);
            if constexpr (SP2) {
            PG8_LDB(B0, 0, 0); PG8_LDB(B1, 0, 1); PG8_SCHED; PG8_LDA(At, 0, 0); PG8_STAGE(PG8_SA(1, 1), a1 + hstep, voffA);
            PG8_WAIT_V(8); PG8_WAIT_L(0); PG8_BAR; PG8_MMA(0, 0, At, B0); PG8_MMA(0, 1, At, B1); PG8_BAR; PG8_SCHED;
            PG8_LDA(At, 0, 1); PG8_STAGE(PG8_SB(0, 0), b2, voffB); PG8_STAGE(PG8_SB(0, 1), b2 + hstep, voffB); PG8_STAGE(PG8_SA(0, 0), a2, voffA);
            PG8_WAIT_V(8); PG8_WAIT_L(0); PG8_BAR; PG8_MMA(1, 0, At, B0); PG8_MMA(1, 1, At, B1); PG8_BAR; PG8_SCHED;
            PG8_LDB(B0, 1, 0); PG8_LDB(B1, 1, 1); PG8_SCHED; PG8_LDA(At, 1, 0); PG8_STAGE(PG8_SA(0, 1), a2 + hstep, voffA);
            PG8_WAIT_V(8); PG8_WAIT_L(0); PG8_BAR; PG8_MMA(0, 0, At, B0); PG8_MMA(0, 1, At, B1); PG8_BAR; PG8_SCHED;
            PG8_LDA(At, 1, 1); PG8_STAGE(PG8_SB(1, 0), b3, voffB); PG8_STAGE(PG8_SB(1, 1), b3 + hstep, voffB); PG8_STAGE(PG8_SA(1, 0), a3, voffA);
            PG8_WAIT_V(8); PG8_WAIT_L(0); PG8_BAR; PG8_MMA(1, 0, At, B0); PG8_MMA(1, 1, At, B1); PG8_BAR; PG8_SCHED;
            } else {
            PG8_LDB(B0, 0, 0); PG8_SCHED; PG8_LDA(At, 0, 0); PG8_STAGE(PG8_SA(1, 1), a1 + hstep, voffA);
            PG8_WAIT_L(8); PG8_BAR; PG8_WAIT_L(0); PG8_MMA(0, 0, At, B0); PG8_BAR; PG8_SCHED;
            PG8_LDB(B1, 0, 1); PG8_STAGE(PG8_SB(0, 0), b2, voffB);
            PG8_BAR; PG8_WAIT_L(0); PG8_MMA(0, 1, At, B1); PG8_BAR;
            PG8_LDA(At, 0, 1); PG8_STAGE(PG8_SA(0, 0), a2, voffA);
            PG8_BAR; PG8_WAIT_L(0); PG8_MMA(1, 0, At, B0); PG8_BAR; PG8_SCHED;
            PG8_STAGE(PG8_SB(0, 1), b2 + hstep, voffB);
            PG8_WAIT_V(6); PG8_BAR; PG8_MMA(1, 1, At, B1); PG8_BAR;
            PG8_LDB(B0, 1, 0); PG8_SCHED; PG8_LDA(At, 1, 0); PG8_STAGE(PG8_SA(0, 1), a2 + hstep, voffA);
            PG8_WAIT_L(8); PG8_BAR; PG8_WAIT_L(0); PG8_MMA(0, 0, At, B0); PG8_BAR; PG8_SCHED;
            PG8_LDB(B1, 1, 1); PG8_STAGE(PG8_SB(1, 0), b3, voffB);
            PG8_BAR; PG8_WAIT_L(0); PG8_MMA(0, 1, At, B1); PG8_BAR;
            PG8_LDA(At, 1, 1); PG8_STAGE(PG8_SA(1, 0), a3, voffA);
            PG8_BAR; PG8_WAIT_L(0); PG8_MMA(1, 0, At, B0); PG8_BAR; PG8_SCHED;
            PG8_STAGE(PG8_SB(1, 1), b3 + hstep, voffB);
            PG8_WAIT_V(6); PG8_BAR; PG8_MMA(1, 1, At, B1); PG8_BAR;
            }
        }
        if constexpr (ALIGN_EPI) { if (wr == 0) PG8_BAR; }
        if constexpr (!Epi::AFTER_DRAIN) { E(acc, cur, wr, wc, fr, fq); S.done(cur); }
        if (!has_next) break;
#pragma unroll
        for (int a = 0; a < 2; ++a)
#pragma unroll
            for (int b = 0; b < 2; ++b)
#pragma unroll
                for (int m = 0; m < 4; ++m)
#pragma unroll
                    for (int n = 0; n < 2; ++n) acc[a][b][m][n] = (f32x4){0.f, 0.f, 0.f, 0.f};
        cur = nxt; cA = nA; cB = nB; ++ui;
        if constexpr (ALIGN_EPI) { if (wr == 1) PG8_BAR; }
    }
    PG8_WAIT_V(0);
    if constexpr (!ALIGN_EPI) { if (wr == 0) PG8_BAR; }
    PG8_BAR;
    if constexpr (Epi::AFTER_DRAIN) { E.fused(acc, cur, wr, wc, fr, fq, lds, wid, lane); S.done(cur); }
#undef PG8_SA
#undef PG8_SB
#undef PG8_STAGE
#undef PG8_LDA
#undef PG8_LDB
#undef PG8_MMA
#undef PG8_WAIT_V
#undef PG8_WAIT_L
#undef PG8_BAR
#undef PG8_SCHED
}
}
#define GAS __attribute__((address_space(1)))
#define LAS __attribute__((address_space(3)))
typedef unsigned short bf16;
typedef unsigned v4u __attribute__((ext_vector_type(4)));
typedef float f32x4 __attribute__((ext_vector_type(4)));
typedef short bf16x8 __attribute__((ext_vector_type(8)));
typedef GAS unsigned gu32;
typedef GAS unsigned long long gu64;
#define RLX_AGENT __ATOMIC_RELAXED, __HIP_MEMORY_SCOPE_AGENT
#define LDS_WAIT() asm volatile("s_waitcnt lgkmcnt(0)" ::: "memory")
#define VM_WAIT() asm volatile("s_waitcnt vmcnt(0)" ::: "memory")
__device__ __forceinline__ unsigned long long rt() { return __builtin_amdgcn_s_memrealtime(); }
__device__ __forceinline__ unsigned f2bf(float f) { unsigned u = __builtin_bit_cast(unsigned, f); return (u + 0x7fffu + ((u >> 16) & 1u)) >> 16; }
__device__ __forceinline__ unsigned pk2(float lo, float hi) { return f2bf(lo) | (f2bf(hi) << 16); }

#define XB_TMO      128
#define XB_XCNT(j)  (256  + 64 * (j))
#define XB_XSUB(j)  (1280 + 64 * (j))
#define XB_XGEN(j)  (2304 + 64 * (j))
#define XB_TOP      3328
#define XB_TOPGEN   3392
#define XCD_BAR_WORDS 3456
#define XB_SPIN_CAP (1u << 18)

__device__ __forceinline__ unsigned xb_ld(unsigned* p)              { return __hip_atomic_load(p, __ATOMIC_RELAXED, __HIP_MEMORY_SCOPE_AGENT); }
__device__ __forceinline__ unsigned xb_add(unsigned* p, unsigned v) { return __hip_atomic_fetch_add(p, v, __ATOMIC_RELAXED, __HIP_MEMORY_SCOPE_AGENT); }
__device__ __forceinline__ unsigned xb_xcc_id() { return (unsigned)__builtin_amdgcn_s_getreg((3 << 11) | 20) & 0xFu; }
#define XB_SPIN(cond, bar) do { unsigned _sp = 0; while (cond) { __builtin_amdgcn_s_sleep(1); \
    if ((++_sp & 255u) == 0u) { if (xb_ld(&(bar)[XB_TMO])) break; if (_sp > XB_SPIN_CAP) { atomicAdd(&(bar)[XB_TMO], 1u); break; } } } } while (0)

struct XcdBarrier {
    unsigned* bar; unsigned x;
    volatile LAS unsigned* st;
};

__device__ __forceinline__ XcdBarrier xcd_barrier_post(unsigned* bar, volatile LAS unsigned* st) {
    XcdBarrier b; b.bar = bar; b.x = xb_xcc_id(); b.st = st;
    if (threadIdx.x == 0) (void)xb_add(&bar[XB_XCNT(b.x)], 1u);
    return b;
}
__device__ __forceinline__ void xcd_barrier_complete(unsigned* bar, unsigned x, unsigned& nloc, unsigned& nx) {
    const unsigned G = gridDim.x * gridDim.y * gridDim.z;
    unsigned sum, cnt, mine, sp = 0u;
    for (;;) {
        sum = 0u; cnt = 0u; mine = 0u;
#pragma unroll
        for (unsigned j = 0; j < 16; ++j) { const unsigned c = xb_ld(&bar[XB_XCNT(j)]); sum += c; cnt += (c > 0u) ? 1u : 0u; mine = (j == x) ? c : mine; }
        if (sum == G) break;
        __builtin_amdgcn_s_sleep(1);
        if ((++sp & 255u) == 0u) { if (xb_ld(&bar[XB_TMO])) break; if (sp > XB_SPIN_CAP) { atomicAdd(&bar[XB_TMO], 1u); break; } }
    }
    nloc = mine > 0u ? mine : 1u; nx = cnt > 0u ? cnt : 1u;
}

__device__ __forceinline__ void xcd_barrier(const XcdBarrier& b) {
    asm volatile("s_waitcnt vmcnt(0)" ::: "memory");
    __syncthreads();
    if (threadIdx.x == 0) {
        unsigned* bar = b.bar;
        __builtin_amdgcn_s_waitcnt(0);
        unsigned nloc = b.st[0], nx = b.st[1];
        if (nloc == 0u) { xcd_barrier_complete(bar, b.x, nloc, nx); b.st[0] = nloc; b.st[1] = nx; }
        const unsigned old = xb_add(&bar[XB_XSUB(b.x)], 1u);
        const unsigned gen = old / nloc;
        if (old + 1u == (gen + 1u) * nloc) {
            __builtin_amdgcn_fence(__ATOMIC_RELEASE, "agent");
            asm volatile("s_waitcnt vmcnt(0)" ::: "memory");
            const unsigned og = xb_add(&bar[XB_TOP], 1u);
            const unsigned tg = og / nx;
            if (og + 1u == (tg + 1u) * nx) xb_add(&bar[XB_TOPGEN], 1u);
            else XB_SPIN(xb_ld(&bar[XB_TOPGEN]) == tg, bar);
            __builtin_amdgcn_fence(__ATOMIC_ACQUIRE, "agent");
            xb_add(&bar[XB_XGEN(b.x)], 1u);
            asm volatile("s_waitcnt vmcnt(0)" ::: "memory");
        } else {
            XB_SPIN(xb_ld(&bar[XB_XGEN(b.x)]) == gen, bar);
            __builtin_amdgcn_fence(__ATOMIC_ACQUIRE, "agent");
            asm volatile("s_waitcnt vmcnt(0)" ::: "memory");
        }
    }
    __syncthreads();
}
constexpr int NWAVES = 8, NTHR = 512;
constexpr int SEQ = 8192, DM = 1024, MROWS = 16384;
constexpr size_t MiB = 1u << 20;
constexpr size_t WS_CTL = 0, CTL_ZERO_BYTES = 2 * MiB;
constexpr size_t WS_KSUM = 1 * MiB;
constexpr size_t WS_MOD = 2 * MiB;
constexpr size_t WS_ROPE = 3 * MiB;
constexpr size_t WS_WIN0 = 4 * MiB, WS_WOUT0 = 9 * MiB, WS_WIN1 = 11 * MiB, WS_WOUT1 = 17 * MiB, WS_WQ0 = 19 * MiB, WS_WQ1 = 23 * MiB;
constexpr size_t WS_SUBK = 27 * MiB, WS_GWS = 28 * MiB, WS_MASK = 29 * MiB, WS_SC = 30 * MiB;
constexpr size_t WS_PTU = 32 * MiB, WS_PTV = 96 * MiB;
constexpr size_t WS_HN = 160 * MiB;
constexpr size_t WS_A = 192 * MiB;
constexpr size_t WS_YCAT = 288 * MiB, WS_QP = 320 * MiB, WS_PO = 384 * MiB, WS_PL = 448 * MiB, WS_END = 450 * MiB;
constexpr int CW_BAR = 4096, CW_WORK = 16384;

constexpr int RING_BYTES = 131072, LDSCTL_OFF = RING_BYTES, MISC_OFF = LDSCTL_OFF + 320, LDS_BYTES = 147456;

#define DI __device__ __forceinline__
typedef short bf16x8 __attribute__((ext_vector_type(8)));
typedef short s16x4 __attribute__((ext_vector_type(4)));
typedef float f32x16 __attribute__((ext_vector_type(16)));
typedef __bf16 bf16x2t __attribute__((ext_vector_type(2)));
#define MFMA32(a, b, c) __builtin_amdgcn_mfma_f32_32x32x16_bf16((a), (b), (c), 0, 0, 0)
using pg8::cvtpk2; using pg8::gelu_tanh;
DI int crow(int reg, int h) { return (reg & 3) + 8 * (reg >> 2) + 4 * h; }
DI float bf_lo(unsigned w) { return __uint_as_float(w << 16); }
DI float bf_hi(unsigned w) { return __uint_as_float(w & 0xffff0000u); }
DI bf16x8 ld16g(const bf16* p) { return *(const bf16x8*)p; }
DI bf16x8 ld8x2g(const bf16* p0, const bf16* p1) { const s16x4 a = *(const s16x4*)p0, b = *(const s16x4*)p1; return __builtin_shufflevector(a, b, 0, 1, 2, 3, 4, 5, 6, 7); }
DI float dot2bf(unsigned a, unsigned b, float c) { return __builtin_amdgcn_fdot2_f32_bf16(__builtin_bit_cast(bf16x2t, a), __builtin_bit_cast(bf16x2t, b), c, false); }
DI int f_ord(float f) { int i = __float_as_int(f); return i ^ ((i >> 31) & 0x7fffffff); }
DI float f_unord(int i) { return __int_as_float(i ^ ((i >> 31) & 0x7fffffff)); }
constexpr float LOG2E = 1.4426950408889634f, LN2 = 0.6931471805599453f;
#define KEY_MIN ((int)0x80000000)


template <int CTRL> DI float dppf(float x) { return __builtin_bit_cast(float, __builtin_amdgcn_update_dpp(0, __builtin_bit_cast(int, x), CTRL, 0xF, 0xF, true)); }
template <int CTRL> DI int dppi(int x) { return __builtin_amdgcn_update_dpp(0, x, CTRL, 0xF, 0xF, true); }
#define DPP_X1 0xB1
#define DPP_X2 0x4E
#define DPP_HM 0x141
#define DPP_RM 0x140
#define DPP_R8 0x128
DI unsigned px32u(unsigned x, int lane) { auto r = __builtin_amdgcn_permlane32_swap(x, x, false, false); return (lane & 32) ? r[0] : r[1]; }
DI float px32(float x, int lane) { return __uint_as_float(px32u(__float_as_uint(x), lane)); }
DI int px32(int x, int lane) { return (int)px32u((unsigned)x, lane); }
DI unsigned px16u(unsigned x, int lane) { auto r = __builtin_amdgcn_permlane16_swap(x, x, false, false); return (lane & 16) ? r[0] : r[1]; }
DI float px16(float x, int lane) { return __uint_as_float(px16u(__float_as_uint(x), lane)); }
DI float sum32(float x) { auto r = __builtin_amdgcn_permlane32_swap(__float_as_uint(x), __float_as_uint(x), false, false); return __uint_as_float(r[0]) + __uint_as_float(r[1]); }
DI float sum16(float x) { auto r = __builtin_amdgcn_permlane16_swap(__float_as_uint(x), __float_as_uint(x), false, false); return __uint_as_float(r[0]) + __uint_as_float(r[1]); }
DI float row_sum16(float v) { v += dppf<DPP_X1>(v); v += dppf<DPP_X2>(v); v += dppf<DPP_HM>(v); v += dppf<DPP_RM>(v); return v; }
DI float wave_sum(float v) { return sum32(sum16(row_sum16(v))); }
DI float wave_max(float v) { v = fmaxf(v, dppf<DPP_X1>(v)); v = fmaxf(v, dppf<DPP_X2>(v)); v = fmaxf(v, dppf<DPP_HM>(v)); v = fmaxf(v, dppf<DPP_RM>(v));
    { auto r = __builtin_amdgcn_permlane16_swap(__float_as_uint(v), __float_as_uint(v), false, false); v = fmaxf(__uint_as_float(r[0]), __uint_as_float(r[1])); }
    { auto r = __builtin_amdgcn_permlane32_swap(__float_as_uint(v), __float_as_uint(v), false, false); v = fmaxf(__uint_as_float(r[0]), __uint_as_float(r[1])); } return v; }

struct Frame {
    LAS unsigned char* lds; volatile LAS unsigned* MISC; gu32* ctl; int tid, lane, wave, G, gw, NGW;
};

struct MapId { DI int operator()(int n) const { return n; } };
struct MapWin0 { DI int operator()(int n) const {
    if (n < 1024) return n;
    const int t = (n - 1024) >> 9, c = (n - 1024) & 511, hd = c >> 6, d = c & 63; int bj, p;
    if (t < 2) { if (d < 16) { const int nn = d >> 3, rr = d & 7; bj = 0; p = 8 * (rr >> 2) + 4 * nn + (rr & 3); } else if (d < 32) { bj = 0; p = d; } else { bj = 1; p = d - 32; } }
    else { bj = d >> 5; p = d & 31; }
    return 1024 + 512 * t + 256 * (hd >> 2) + 128 * bj + 32 * (hd & 3) + p; } };
struct MapWin1 { DI int operator()(int n) const { const int t = n >> 10, c = n & 1023, hd = c >> 6, d = c & 63; return 1024 * t + 256 * (hd >> 2) + 128 * (d >> 5) + 32 * (hd & 3) + (d & 31); } };
template <class Map> DI void p0_transpose_item(const float* W, int K, int N, bf16* WT, LAS float* scr, int item, int lane, Map map) {
    const int nblk = N / 32, kb = item / nblk, nb = item % nblk, k0 = 64 * kb, n0 = 32 * nb;
#pragma unroll 8
    for (int i = 0; i < 32; ++i) { const int kk = 2 * i + (lane >> 5); scr[kk * 33 + (lane & 31)] = W[(size_t)(k0 + kk) * N + n0 + (lane & 31)]; }
    LDS_WAIT(); asm volatile("" ::: "memory");
    const int c = lane & 7;
#pragma unroll
    for (int j = 0; j < 4; ++j) { const int n = (lane >> 3) + 8 * j; const LAS float* s = scr + (8 * c) * 33 + n;
        v4u o; o.x = pk2(s[0 * 33], s[1 * 33]); o.y = pk2(s[2 * 33], s[3 * 33]); o.z = pk2(s[4 * 33], s[5 * 33]); o.w = pk2(s[6 * 33], s[7 * 33]);
        *(GAS v4u*)(WT + (size_t)map(n0 + n) * K + k0 + 8 * c) = o; }
    LDS_WAIT(); asm volatile("" ::: "memory");
}
struct P0Args { const float *c, *w_mod, *b_mod, *win0, *wout0, *win1, *wout1, *wq, *subk, *pu, *pv, *gws;
                float *MOD, *ROPE; bf16 *WIN0, *WOUT0, *WIN1, *WOUT1, *WQ0, *WQ1, *SUBK, *GWS; unsigned char *U8, *V8s; float *USC, *VSC; };
DI void p0_prologue(const Frame& F, const P0Args& A) {
    { LAS float* scr = (LAS float*)F.lds;
      for (int task = blockIdx.x; task < 192; task += F.G) {
          const int l = task / 96, n0 = (task % 96) * 64; const float* W = A.w_mod + (size_t)l * 1024 * 6144;
          float a0 = 0.f, a1 = 0.f; const int k0 = F.wave * 128;
#pragma unroll 8
          for (int k = k0; k < k0 + 128; ++k) { const float c0 = A.c[k], c1 = A.c[1024 + k]; const float s0 = c0 / (1.f + __expf(-c0)), s1 = c1 / (1.f + __expf(-c1));
              const float w = W[(size_t)k * 6144 + n0 + F.lane]; a0 += s0 * w; a1 += s1 * w; }
          scr[(F.wave * 2 + 0) * 64 + F.lane] = a0; scr[(F.wave * 2 + 1) * 64 + F.lane] = a1;
          __syncthreads();
          if (F.tid < 128) { const int b = F.tid >> 6, n = F.tid & 63; float s = 0.f;
#pragma unroll
              for (int w = 0; w < 8; ++w) s += scr[(w * 2 + b) * 64 + n];
              A.MOD[(size_t)(l * 2 + b) * 6144 + n0 + n] = s + A.b_mod[l * 6144 + n0 + n]; }
          __syncthreads();
      } }
    { LAS float* scr = (LAS float*)(F.lds + F.wave * 16384);
      constexpr int I0 = 16 * 80, I1 = 16 * 32, I2 = 16 * 96, I3 = 16 * 32, I4 = 16 * 64, I5 = 16 * 64, NIT = I0 + I1 + I2 + I3 + I4 + I5;
      for (int it = F.gw; it < NIT; it += F.NGW) { int r = it;
          if (r < I0) { p0_transpose_item(A.win0, 1024, 2560, A.WIN0, scr, r, F.lane, MapId()); continue; } r -= I0;
          if (r < I1) { p0_transpose_item(A.wout0, 1024, 1024, A.WOUT0, scr, r, F.lane, MapId()); continue; } r -= I1;
          if (r < I2) { p0_transpose_item(A.win1, 1024, 3072, A.WIN1, scr, r, F.lane, MapId()); continue; } r -= I2;
          if (r < I3) { p0_transpose_item(A.wout1, 1024, 1024, A.WOUT1, scr, r, F.lane, MapId()); continue; } r -= I3;
          if (r < I4) { p0_transpose_item(A.wq, 1024, 2048, A.WQ0, scr, r, F.lane, MapId()); continue; } r -= I4;
          p0_transpose_item(A.wq + (size_t)1024 * 2048, 1024, 2048, A.WQ1, scr, r, F.lane, MapId()); } }
    for (int row = F.gw; row < 65536; row += F.NGW) { const bool isv = row >= 32768; const int rr = row & 32767;
        const float* src = (isv ? A.pv : A.pu) + (size_t)rr * 1024; f32x4 v[4]; float mx = 0.f;
#pragma unroll
        for (int k = 0; k < 4; ++k) { v[k] = *(const f32x4*)(src + 4 * F.lane + 256 * k); mx = fmaxf(mx, fmaxf(fmaxf(fabsf(v[k][0]), fabsf(v[k][1])), fmaxf(fabsf(v[k][2]), fabsf(v[k][3])))); }
        mx = wave_max(mx);
        const float sc = mx > 0.f ? 384.0f / mx : 1.0f, inv = mx > 0.f ? mx * (1.0f / 384.0f) : 1.0f;
#pragma unroll
        for (int k = 0; k < 4; ++k) { int w = 0; w = __builtin_amdgcn_cvt_pk_fp8_f32(v[k][0] * sc, v[k][1] * sc, w, false); w = __builtin_amdgcn_cvt_pk_fp8_f32(v[k][2] * sc, v[k][3] * sc, w, true);
            if (!isv) *(unsigned*)(A.U8 + (size_t)rr * 1024 + 4 * F.lane + 256 * k) = (unsigned)w;
            else { const int l = rr >> 14, e = rr & 16383, slab = 2 * k + (F.lane >> 5); *(unsigned*)(A.V8s + (((size_t)l * 8 + slab) * 16384 + e) * 128 + 4 * (F.lane & 31)) = (unsigned)w; } }
        if (F.lane == 0) (isv ? A.VSC : A.USC)[rr] = inv; }
    { const size_t gt = (size_t)F.gw * 64 + F.lane, NT = (size_t)F.NGW * 64;
      for (size_t i = gt; i < 524288 / 8; i += NT) { const float* src = A.subk + i * 8; const f32x4 a = *(const f32x4*)src, b = *(const f32x4*)(src + 4); v4u o; o.x = cvtpk2(a[0], a[1]); o.y = cvtpk2(a[2], a[3]); o.z = cvtpk2(b[0], b[1]); o.w = cvtpk2(b[2], b[3]);
          *(v4u*)(A.SUBK + i * 8) = o; }
      for (size_t i = gt; i < 65536; i += NT) { const int t = (int)(i >> 7) & 127, s = (int)i & 127; A.GWS[i] = (bf16)(cvtpk2(s <= t ? A.gws[i] : 0.f, 0.f) & 0xffffu); }
      for (size_t i = gt; i < 65536; i += NT) { const int pos = (int)(i >> 3), fi = (int)i & 7; const float inv = powf(500000.0f, -(float)fi / 8.0f); const float ang = (float)pos * inv; float sn, cs; sincosf(ang, &sn, &cs);
          A.ROPE[(size_t)pos * 16 + fi] = cs; A.ROPE[(size_t)pos * 16 + 8 + fi] = sn; } }
}

DI void norm_rows(const Frame& F, const float* xs, const float* gamma, const float* modl, int shi, int sci, bf16* HN) {
    for (int m = F.gw; m < MROWS; m += F.NGW) { const int b = m >> 13;
        const f32x4* xr = (const f32x4*)(xs + (size_t)m * 1024) + F.lane; f32x4 v[4]; float s = 0.f;
#pragma unroll
        for (int j = 0; j < 4; ++j) { v[j] = xr[64 * j]; s += (v[j][0] * v[j][0] + v[j][1] * v[j][1]) + (v[j][2] * v[j][2] + v[j][3] * v[j][3]); }
        const float rinv = rsqrtf(wave_sum(s) * (1.0f / 1024.0f) + 1e-6f);
        unsigned long long* o8 = (unsigned long long*)(HN + (size_t)m * 1024) + F.lane;
#pragma unroll
        for (int j = 0; j < 4; ++j) { const int col = 4 * F.lane + 256 * j; const f32x4 gm = *(const f32x4*)(gamma + col), sc = *(const f32x4*)(modl + b * 6144 + sci * 1024 + col), sh = *(const f32x4*)(modl + b * 6144 + shi * 1024 + col);
            const f32x4 o = v[j] * rinv * gm * (sc + 1.0f) + sh; o8[64 * j] = (unsigned long long)cvtpk2(o[0], o[1]) | ((unsigned long long)cvtpk2(o[2], o[3]) << 32); }
    }
}


DI void qk_post_task(int task, const bf16* QKR, bf16* Q0, bf16* K0, float* KSUM, const float* rope, const float* gq, const float* gk, LAS float* scr, int tid, int wave, int lane) {
    const int tb = task >> 2, cq = task & 3; const bool isk = cq >= 2; const int head0 = (cq & 1) * 4, hl = (lane >> 2) & 3, qt = lane & 3, rsub = lane >> 4;
    const float* g = (isk ? gk : gq) + qt * 16; float gv[16];
#pragma unroll
    for (int i = 0; i < 16; ++i) gv[i] = g[i];
    float ks[16];
#pragma unroll
    for (int i = 0; i < 16; ++i) ks[i] = 0.f;
    const int b = tb >> 5; bf16* dstb = (isk ? K0 : Q0) + (size_t)(b * 8 + head0 + hl) * SEQ * 64 + qt * 16;
    for (int it = 0; it < 8; ++it) { const int row = tb * 256 + wave * 32 + it * 4 + rsub, s = row & (SEQ - 1);
        const bf16* src = QKR + (size_t)row * 1024 + cq * 256 + hl * 64 + qt * 16; const v4u w0 = *(const v4u*)src, w1 = *(const v4u*)(src + 8);
        float y[16]; y[0] = bf_lo(w0.x); y[1] = bf_hi(w0.x); y[2] = bf_lo(w0.y); y[3] = bf_hi(w0.y); y[4] = bf_lo(w0.z); y[5] = bf_hi(w0.z); y[6] = bf_lo(w0.w); y[7] = bf_hi(w0.w);
        y[8] = bf_lo(w1.x); y[9] = bf_hi(w1.x); y[10] = bf_lo(w1.y); y[11] = bf_hi(w1.y); y[12] = bf_lo(w1.z); y[13] = bf_hi(w1.z); y[14] = bf_lo(w1.w); y[15] = bf_hi(w1.w);
        float ss = 0.f;
#pragma unroll
        for (int i = 0; i < 16; ++i) ss += y[i] * y[i];
        ss += dppf<DPP_X1>(ss); ss += dppf<DPP_X2>(ss);
        const float rinv = rsqrtf(ss * (1.0f / 64.0f) + 1e-6f);
#pragma unroll
        for (int i = 0; i < 16; ++i) y[i] = y[i] * rinv * gv[i];
        if (qt == 0) { const float* rp = rope + (size_t)s * 16;
#pragma unroll
            for (int i = 0; i < 8; ++i) { const float c = rp[i], sn = rp[8 + i], x1 = y[i], x2 = y[i + 8]; y[i] = x1 * c - x2 * sn; y[i + 8] = x1 * sn + x2 * c; } }
        v4u o0, o1; o0.x = cvtpk2(y[0], y[1]); o0.y = cvtpk2(y[2], y[3]); o0.z = cvtpk2(y[4], y[5]); o0.w = cvtpk2(y[6], y[7]); o1.x = cvtpk2(y[8], y[9]); o1.y = cvtpk2(y[10], y[11]); o1.z = cvtpk2(y[12], y[13]); o1.w = cvtpk2(y[14], y[15]);
        bf16* d = dstb + (size_t)s * 64; *(v4u*)d = o0; *(v4u*)(d + 8) = o1;
#pragma unroll
        for (int i = 0; i < 16; ++i) ks[i] += y[i];
    }
    if (isk) {
#pragma unroll
        for (int i = 0; i < 16; ++i) { ks[i] = sum32(sum16(ks[i])); }
        if (lane < 16) {
#pragma unroll
            for (int i = 0; i < 16; ++i) scr[(wave * 16 + lane) * 16 + i] = ks[i]; }
        __syncthreads();
        if (tid < 256) { const int l16 = tid >> 4, i = tid & 15; float sum = 0.f;
#pragma unroll
            for (int w = 0; w < 8; ++w) sum += scr[(w * 16 + l16) * 16 + i];
            KSUM[((size_t)(b * 8 + head0 + (l16 >> 2)) * 32 + (tb & 31)) * 64 + (l16 & 3) * 16 + i] = sum; }
        __syncthreads();
    }
}

DI f32x16 qk_tile(const bf16* krow, const bf16x8 (&qf)[4]) {
    f32x16 s;
#pragma unroll
    for (int i = 0; i < 16; ++i) s[i] = 0.f;
#pragma unroll
    for (int ks = 0; ks < 4; ++ks) s = MFMA32(ld16g(krow + 16 * ks), qf[ks], s);
    return s;
}
DI bf16x8 pack8(const f32x16& x, int s) { v4u p; p.x = cvtpk2(x[8 * s], x[8 * s + 1]); p.y = cvtpk2(x[8 * s + 2], x[8 * s + 3]); p.z = cvtpk2(x[8 * s + 4], x[8 * s + 5]); p.w = cvtpk2(x[8 * s + 6], x[8 * s + 7]); return __builtin_bit_cast(bf16x8, p); }
DI void pv_tile(f32x16 (&o)[2], const bf16* vt, const f32x16& p) {
#pragma unroll
    for (int s = 0; s < 2; ++s) { const bf16x8 pb = pack8(p, s);
#pragma unroll
        for (int mt = 0; mt < 2; ++mt) { const bf16* v = vt + (size_t)mt * 32 * SEQ + 16 * s; o[mt] = MFMA32(ld8x2g(v, v + 8), pb, o[mt]); } }
}
DI void store_ot(bf16* dst, const f32x16 (&o)[2], float sc, int h) {
#pragma unroll
    for (int mt = 0; mt < 2; ++mt)
#pragma unroll
        for (int g = 0; g < 4; ++g) { const unsigned lo = cvtpk2(o[mt][4 * g] * sc, o[mt][4 * g + 1] * sc), hi = cvtpk2(o[mt][4 * g + 2] * sc, o[mt][4 * g + 3] * sc);
            *(unsigned long long*)(dst + 32 * mt + 8 * g + 4 * h) = (unsigned long long)lo | ((unsigned long long)hi << 32); }
}
DI void moba_keys(const bf16* Kh, const bf16* VTh, const bf16x8 (&qf)[4], int key0, int nt, int diag, float mc2, f32x16 (&o)[2], float& l, int r, int h) {
    for (int kt = 0; kt < nt; ++kt) { const int kb = key0 + 32 * kt;
        f32x16 s = qk_tile(Kh + (size_t)(kb + r) * 64 + 8 * h, qf);
        float ls = 0.f;
#pragma unroll
        for (int i = 0; i < 16; ++i) { float p = __builtin_amdgcn_exp2f(s[i] * (0.125f * LOG2E) - mc2); if (kt == diag && crow(i, h) > r) p = 0.f; s[i] = p; ls += p; }
        l += ls;
        pv_tile(o, VTh + (size_t)r * SEQ + kb + 4 * h, s);
    }
}
DI float moba_mc2(const float* gq, const float* gk, int lane) {
    float a = fabsf(gq[lane]), b = fabsf(gk[lane]);
    a = wave_max(a); b = wave_max(b);
    return 8.0f * a * b * LOG2E;
}
struct MobaT { const bf16 *Q, *K, *VT; const float* ksum; unsigned* masks; bf16* PO; float* PL; const float *gq, *gk; };
DI void moba_mask_unit(int u, const MobaT& T, int lane) {
    const int bh = u >> 8, t0 = (u & 255) * 32, own = t0 >> 8, r = lane & 31, h = lane >> 5;
    unsigned mask = 0u;
    if (own > 0) {
        f32x16 g;
#pragma unroll
        for (int i = 0; i < 16; ++i) g[i] = 0.f;
        const float* km = T.ksum + ((size_t)bh * 32 + r) * 64 + 8 * h; const bf16* qp = T.Q + ((size_t)bh * SEQ + t0 + r) * 64 + 8 * h;
#pragma unroll
        for (int ks = 0; ks < 4; ++ks) { const f32x4 a0 = *(const f32x4*)(km + 16 * ks) * (1.0f / 256.0f), a1 = *(const f32x4*)(km + 16 * ks + 4) * (1.0f / 256.0f);
            v4u aw; aw.x = cvtpk2(a0[0], a0[1]); aw.y = cvtpk2(a0[2], a0[3]); aw.z = cvtpk2(a1[0], a1[1]); aw.w = cvtpk2(a1[2], a1[3]);
            g = MFMA32(__builtin_bit_cast(bf16x8, aw), ld16g(qp + 16 * ks), g); }
        int ka = KEY_MIN, kb2 = KEY_MIN, kc = KEY_MIN;
#define INS3(x_) do { int x = (x_); int t = min(ka, x); ka = max(ka, x); int uu = min(kb2, t); kb2 = max(kb2, t); kc = max(kc, uu); } while (0)
#pragma unroll
        for (int i = 0; i < 16; ++i) { const int blk = crow(i, h); const int key = (blk < own) ? ((f_ord(g[i]) & ~31) | (31 - blk)) : KEY_MIN; INS3(key); }
        const int pa = px32(ka, lane), pb = px32(kb2, lane), pc = px32(kc, lane);
        INS3(pa); INS3(pb); INS3(pc);
#undef INS3
        if (ka != KEY_MIN) mask |= 1u << (31 - (ka & 31));
        if (kb2 != KEY_MIN) mask |= 1u << (31 - (kb2 & 31));
        if (kc != KEY_MIN) mask |= 1u << (31 - (kc & 31));
    }
    if (h == 0) T.masks[(size_t)bh * SEQ + t0 + r] = mask;
}
DI void moba_own_unit(int u, const MobaT& T, float mc2, int lane) {
    const int bh = u >> 8, t0 = (u & 255) * 32, own = t0 >> 8, r = lane & 31, h = lane >> 5;
    const bf16* qp = T.Q + ((size_t)bh * SEQ + t0 + r) * 64 + 8 * h; bf16x8 qf[4];
#pragma unroll
    for (int ks = 0; ks < 4; ++ks) qf[ks] = ld16g(qp + 16 * ks);
    f32x16 o[2];
#pragma unroll
    for (int i = 0; i < 16; ++i) { o[0][i] = 0.f; o[1][i] = 0.f; }
    float l = 0.f; const int key0 = own * 256, nt = ((t0 - key0) >> 5) + 1;
    moba_keys(T.K + (size_t)bh * SEQ * 64, T.VT + (size_t)bh * 64 * SEQ, qf, key0, nt, nt - 1, mc2, o, l, r, h);
    l = sum32(l);
    const size_t base = ((size_t)bh * SEQ + t0 + r) * 4 + 3;
    store_ot(T.PO + base * 64, o, 1.0f, h); if (h == 0) T.PL[base] = l;
}
constexpr int MS_K = 0, MS_V = 32768, MS_VROW = 520, MS_LIST = 32768 + 64 * 520, MS_CNT = MS_LIST + 8192, MOBA_NTASK = 16 * 79;
DI void moba_sel_task(int task, const MobaT& T, LAS unsigned char* lds, float mc2, int tid, int wave, int lane) {
    int p, rem = task; if (rem < 128) p = 0; else if (rem < 384) { p = 1; rem -= 128; } else if (rem < 768) { p = 2; rem -= 384; } else { p = 3; rem -= 768; }
    const int j = rem >> 4, bh = rem & 15;
    LAS unsigned* list = (LAS unsigned*)(lds + MS_LIST); LAS unsigned* cntp = (LAS unsigned*)(lds + MS_CNT);
    { const bf16* Kg = T.K + ((size_t)bh * SEQ + 256 * j) * 64; const bf16* Vg = T.VT + (size_t)bh * 64 * SEQ + 256 * j;
      v4u kv[4], vv[4];
#pragma unroll
      for (int i = 0; i < 4; ++i) { const int c = tid + 512 * i; kv[i] = *(const v4u*)(Kg + (size_t)c * 8); const int d = c >> 5, cc = c & 31; vv[i] = *(const v4u*)(Vg + (size_t)d * SEQ + cc * 8); }
      if (tid == 0) *cntp = 0u;
#pragma unroll
      for (int i = 0; i < 4; ++i) { const int c = tid + 512 * i; const int k = c >> 3, ch = c & 7; *(LAS v4u*)(lds + MS_K + k * 128 + ((ch ^ ((k >> 1) & 7)) << 4)) = kv[i];
          const int d = c >> 5, cc = c & 31; LAS unsigned char* vp = lds + MS_V + d * MS_VROW + cc * 16; *(LAS unsigned long long*)vp = (unsigned long long)vv[i].x | ((unsigned long long)vv[i].y << 32); *(LAS unsigned long long*)(vp + 8) = (unsigned long long)vv[i].z | ((unsigned long long)vv[i].w << 32); } }
    __syncthreads();
    { const int qlo = 256 * (8 * p + 1), qhi = (8 * p + 9) * 256 < SEQ ? (8 * p + 9) * 256 : SEQ;
      for (int t0 = qlo + wave * 64; t0 < qhi; t0 += 512) { const int t = t0 + lane; const unsigned mk = T.masks[(size_t)bh * SEQ + t]; const bool sel = (mk >> j) & 1u;
          const unsigned long long bal = __ballot(sel); const int nb = __builtin_popcountll(bal);
          unsigned base = 0; if (lane == 0 && nb) base = __hip_atomic_fetch_add(cntp, (unsigned)nb, __ATOMIC_RELAXED, __HIP_MEMORY_SCOPE_WORKGROUP); base = (unsigned)__builtin_amdgcn_readfirstlane((int)base);
          if (sel) list[base + __builtin_popcountll(bal & ((1ull << lane) - 1ull))] = (unsigned)t; } }
    __syncthreads();
    const int n = (int)*cntp; const int r = lane & 31, h = lane >> 5;
    const LAS unsigned char* kb = lds + MS_K; const LAS unsigned char* vb = lds + MS_V;
    for (int b0 = wave * 32; b0 < n; b0 += 256) { const bool valid = b0 + r < n; const int t = (int)list[valid ? b0 + r : b0];
        const unsigned mk = T.masks[(size_t)bh * SEQ + t]; const int slot = __builtin_popcount(mk & ((1u << j) - 1u));
        const bf16* qp = T.Q + ((size_t)bh * SEQ + t) * 64 + 8 * h; bf16x8 qf[4];
#pragma unroll
        for (int ks = 0; ks < 4; ++ks) qf[ks] = ld16g(qp + 16 * ks);
        f32x16 o[2];
#pragma unroll
        for (int i = 0; i < 16; ++i) { o[0][i] = 0.f; o[1][i] = 0.f; }
        float l = 0.f;
#pragma unroll 2
        for (int kt = 0; kt < 8; ++kt) { const int key = 32 * kt + r;
            f32x16 s;
#pragma unroll
            for (int i = 0; i < 16; ++i) s[i] = 0.f;
#pragma unroll
            for (int ks = 0; ks < 4; ++ks) s = MFMA32(*(const LAS bf16x8*)(kb + key * 128 + (((2 * ks + h) ^ ((key >> 1) & 7)) << 4)), qf[ks], s);
            float ls = 0.f;
#pragma unroll
            for (int i = 0; i < 16; ++i) { const float pv = __builtin_amdgcn_exp2f(s[i] * (0.125f * LOG2E) - mc2); s[i] = pv; ls += pv; }
            l += ls;
#pragma unroll
            for (int sx = 0; sx < 2; ++sx) { const bf16x8 pb = pack8(s, sx);
#pragma unroll
                for (int mt = 0; mt < 2; ++mt) { const LAS unsigned char* vp = vb + (32 * mt + r) * MS_VROW + (32 * kt + 16 * sx + 4 * h) * 2;
                    const s16x4 a0 = *(const LAS s16x4*)vp, a1 = *(const LAS s16x4*)(vp + 16); o[mt] = MFMA32(__builtin_shufflevector(a0, a1, 0, 1, 2, 3, 4, 5, 6, 7), pb, o[mt]); } }
        }
        l = sum32(l);
        if (valid) { const size_t base = ((size_t)bh * SEQ + t) * 4 + slot; store_ot(T.PO + base * 64, o, 1.0f, h); if (h == 0) T.PL[base] = l; }
    }
    __syncthreads();
}
DI void moba_combine(const Frame& F, const bf16* PO, const float* PL, bf16* YCAT) {
    const size_t gt = (size_t)F.gw * 64 + F.lane, NT = (size_t)F.NGW * 64;
    for (size_t i = gt; i < (size_t)16 * SEQ * 8; i += NT) { const int dq = (int)i & 7, t = (int)(i >> 3) & (SEQ - 1), bh = (int)(i >> 16); const int own = t >> 8, ns = own < 3 ? own : 3;
        float o[8]; float l = 0.f;
#pragma unroll
        for (int k = 0; k < 8; ++k) o[k] = 0.f;
#pragma unroll
        for (int s = 0; s < 4; ++s) { if (s < ns || s == 3) { const size_t base = ((size_t)bh * SEQ + t) * 4 + s; l += PL[base]; const v4u w = *(const v4u*)(PO + base * 64 + dq * 8);
                o[0] += bf_lo(w.x); o[1] += bf_hi(w.x); o[2] += bf_lo(w.y); o[3] += bf_hi(w.y); o[4] += bf_lo(w.z); o[5] += bf_hi(w.z); o[6] += bf_lo(w.w); o[7] += bf_hi(w.w); } }
        const float il = 1.0f / l; v4u w; w.x = cvtpk2(o[0] * il, o[1] * il); w.y = cvtpk2(o[2] * il, o[3] * il); w.z = cvtpk2(o[4] * il, o[5] * il); w.w = cvtpk2(o[6] * il, o[7] * il);
        *(v4u*)(YCAT + ((size_t)(bh >> 3) * SEQ + t) * 1024 + 512 + (bh & 7) * 64 + dq * 8) = w; }
}

DI void gmlp_unit(int unit, const bf16* UA, const bf16* VA, const float* vgain, const bf16* GWS, const float* bs, bf16* YCAT, LAS unsigned char* lds, int tid, int wave, int lane) {
    const int cidx = unit >> 2, g = unit & 3, row0 = cidx * 128; LAS bf16* VNT = (LAS bf16*)lds;
    { const int row = tid >> 2, dq = (tid & 3) * 32; const bf16* src = VA + (size_t)(row0 + row) * 512 + g * 128 + dq;
      float f[32]; float ss = 0.f;
#pragma unroll
      for (int k = 0; k < 4; ++k) { const v4u w = *(const v4u*)(src + 8 * k); f[8 * k] = bf_lo(w.x); f[8 * k + 1] = bf_hi(w.x); f[8 * k + 2] = bf_lo(w.y); f[8 * k + 3] = bf_hi(w.y); f[8 * k + 4] = bf_lo(w.z); f[8 * k + 5] = bf_hi(w.z); f[8 * k + 6] = bf_lo(w.w); f[8 * k + 7] = bf_hi(w.w); }
#pragma unroll
      for (int k = 0; k < 32; ++k) ss += f[k] * f[k];
      ss += dppf<DPP_X1>(ss); ss += dppf<DPP_X2>(ss);
      const float rinv = rsqrtf(ss * (1.0f / 128.0f) + 1e-6f);
#pragma unroll
      for (int k = 0; k < 32; ++k) VNT[(dq + k) * 136 + row] = (bf16)(cvtpk2(f[k] * rinv * vgain[g * 128 + dq + k], 0.f) & 0xffffu); }
    __syncthreads();
    { const int mt = wave >> 1, ntb = (wave & 1) * 2, r = lane & 31, h = lane >> 5;
      f32x16 acc[2];
#pragma unroll
      for (int i = 0; i < 16; ++i) { acc[0][i] = 0.f; acc[1][i] = 0.f; }
      const bf16* wp = GWS + ((size_t)g * 128 + 32 * mt + r) * 128 + 8 * h;
      for (int ks = 0; ks < 2 * (mt + 1); ++ks) { const bf16x8 a = ld16g(wp + 16 * ks);
#pragma unroll
          for (int nn = 0; nn < 2; ++nn) { const bf16x8 b = *(const LAS bf16x8*)(VNT + (32 * (ntb + nn) + r) * 136 + 16 * ks + 8 * h); acc[nn] = MFMA32(a, b, acc[nn]); } }
#pragma unroll
      for (int nn = 0; nn < 2; ++nn)
#pragma unroll
          for (int i = 0; i < 16; ++i) { const int t = 32 * mt + crow(i, h), d = 32 * (ntb + nn) + r; const float mixed = acc[nn][i] + bs[g * 128 + t];
              const float uv = __uint_as_float((unsigned)UA[(size_t)(row0 + t) * 512 + g * 128 + d] << 16);
              YCAT[(size_t)(row0 + t) * 1024 + g * 128 + d] = (bf16)(cvtpk2(uv * mixed, 0.f) & 0xffffu); } }
    __syncthreads();
}

DI void sb_unit(int u, const bf16* Q, const bf16* K, const bf16* VT, bf16* YCAT, int lane) {
    const int bh = u >> 8, t0 = (u & 255) * 32, r = lane & 31, h = lane >> 5;
    const bf16* qp = Q + ((size_t)bh * SEQ + t0 + r) * 64 + 8 * h; bf16x8 qf[4];
#pragma unroll
    for (int ks = 0; ks < 4; ++ks) qf[ks] = ld16g(qp + 16 * ks);
    const bf16* Kh = K + (size_t)bh * SEQ * 64; const bf16* VTh = VT + (size_t)bh * 64 * SEQ;
    f32x16 o[2];
#pragma unroll
    for (int i = 0; i < 16; ++i) { o[0][i] = 0.f; o[1][i] = 0.f; }
    float R = 0.f;
    for (int kb = t0; kb >= 0; kb -= 32) {
        f32x16 s = qk_tile(Kh + (size_t)(kb + r) * 64 + 8 * h, qf);
        const bool diag = (kb == t0);
        f32x16 x;
#pragma unroll
        for (int i = 0; i < 16; ++i) { const float z = s[i] * 0.125f; const float t = __builtin_amdgcn_exp2f(-fabsf(z) * LOG2E); const float sp = fmaxf(z, 0.f) + LN2 * __builtin_amdgcn_logf(1.0f + t);
            const bool valid = !(diag && crow(i, h) >= r); x[i] = valid ? -sp : 0.f; s[i] = valid ? z : -INFINITY; }
        float T4[4], E[16];
#pragma unroll
        for (int g = 0; g < 4; ++g) { E[4 * g + 3] = 0.f; E[4 * g + 2] = x[4 * g + 3]; E[4 * g + 1] = E[4 * g + 2] + x[4 * g + 2]; E[4 * g] = E[4 * g + 1] + x[4 * g + 1]; T4[g] = E[4 * g] + x[4 * g]; }
        float P4[4];
#pragma unroll
        for (int g = 0; g < 4; ++g) P4[g] = px32(T4[g], lane);
        float C[4]; float run = 0.f;
#pragma unroll
        for (int g = 3; g >= 0; --g) { C[g] = run + (h == 0 ? P4[g] : 0.f); run += T4[g] + P4[g]; }
#pragma unroll
        for (int i = 0; i < 16; ++i) { const float arg = x[i] + s[i] + (R + C[i >> 2] + E[i]); x[i] = __builtin_amdgcn_exp2f(arg * LOG2E); }
        pv_tile(o, VTh + (size_t)r * SEQ + kb + 4 * h, x);
        R += run;
        if (!__any(R >= -104.0f)) break;
    }
    store_ot(YCAT + ((size_t)(bh >> 4) * SEQ + t0 + r) * 1024 + (bh & 15) * 64, o, 1.0f, h);
}

#define INS16(L, x_) do { int x = (x_); _Pragma("unroll") for (int q_ = 0; q_ < 16; ++q_) { const int hi_ = max(L[q_], x); x = min(L[q_], x); L[q_] = hi_; } } while (0)
DI void peer_scores(int tokg, int head, const bf16* QP, const bf16* SUBK, unsigned* ent  , int lane) {
    const int r = lane & 31, h = lane >> 5;
    int L1[16], L2[16];
#pragma unroll
    for (int p = 0; p < 2; ++p) {
        const bf16* qp = QP + (size_t)(tokg + r) * 2048 + head * 256 + p * 128 + 8 * h; bf16x8 qf[8];
#pragma unroll
        for (int ks = 0; ks < 8; ++ks) qf[ks] = ld16g(qp + 16 * ks);
        const bf16* sk = SUBK + (size_t)((head * 2 + p) * 128 + r) * 128 + 8 * h;
        int L[16];
#pragma unroll
        for (int i = 0; i < 16; ++i) L[i] = KEY_MIN;
#pragma unroll 1
        for (int mt = 0; mt < 4; ++mt) {
            f32x16 acc;
#pragma unroll
            for (int i = 0; i < 16; ++i) acc[i] = 0.f;
#pragma unroll
            for (int ks = 0; ks < 8; ++ks) acc = MFMA32(ld16g(sk + (size_t)mt * 32 * 128 + 16 * ks), qf[ks], acc);
#pragma unroll
            for (int i = 0; i < 16; ++i) INS16(L, (f_ord(acc[i]) & ~127) | (32 * mt + crow(i, h)));
        }
        int Pn[16];
#pragma unroll
        for (int i = 0; i < 16; ++i) Pn[i] = px32(L[i], lane);
#pragma unroll
        for (int i = 0; i < 16; ++i) INS16(L, Pn[i]);
#pragma unroll
        for (int i = 0; i < 16; ++i) { if (p == 0) L1[i] = L[i]; else L2[i] = L[i]; }
    }
    int Cn[16];
#pragma unroll
    for (int i = 0; i < 16; ++i) Cn[i] = KEY_MIN;
#pragma unroll
    for (int i = 0; i < 16; ++i)
#pragma unroll
        for (int j = 0; j < 16; ++j) if ((i + 1) * (j + 1) <= 16) { const float v = f_unord(L1[i] & ~127) + f_unord(L2[j] & ~127); INS16(Cn, (f_ord(v) & ~0x3fff) | ((L1[i] & 127) << 7) | (L2[j] & 127)); }
    float e[16]; float sum = 0.f; const float m0 = f_unord(Cn[0] & ~0x3fff);
#pragma unroll
    for (int k = 0; k < 16; ++k) { e[k] = __builtin_amdgcn_exp2f((f_unord(Cn[k] & ~0x3fff) - m0) * LOG2E); sum += e[k]; }
    const float inv = 1.0f / sum;
    if (h == 0) { unsigned* dst = ent + (size_t)r * 128 + head * 16;
#pragma unroll
        for (int g4 = 0; g4 < 4; ++g4) { v4u w;
            w.x = (cvtpk2(0.f, e[4 * g4] * inv) & 0xffff0000u) | (unsigned)(Cn[4 * g4] & 0x3fff); w.y = (cvtpk2(0.f, e[4 * g4 + 1] * inv) & 0xffff0000u) | (unsigned)(Cn[4 * g4 + 1] & 0x3fff);
            w.z = (cvtpk2(0.f, e[4 * g4 + 2] * inv) & 0xffff0000u) | (unsigned)(Cn[4 * g4 + 2] & 0x3fff); w.w = (cvtpk2(0.f, e[4 * g4 + 3] * inv) & 0xffff0000u) | (unsigned)(Cn[4 * g4 + 3] & 0x3fff);
            *(v4u*)(dst + 4 * g4) = w; } }
}
typedef float f32x2 __attribute__((ext_vector_type(2)));
DI f32x2 fp8lo(unsigned w) { return __builtin_amdgcn_cvt_pk_f32_fp8((int)w, false); }
DI f32x2 fp8hi(unsigned w) { return __builtin_amdgcn_cvt_pk_f32_fp8((int)w, true); }
DI f32x2 fma2(f32x2 a, f32x2 b, f32x2 c) { float x = c.x, y = c.y; asm("v_fmac_f32 %0, %1, %2" : "+v"(x) : "v"(a.x), "v"(b.x)); asm("v_fmac_f32 %0, %1, %2" : "+v"(y) : "v"(a.y), "v"(b.y)); return (f32x2){x, y}; }
constexpr int PU_LIST = 0, PU_H = 32768, PU_USC = 98304, PU_VSC = 106496, PU_BC = 114688;
template <int VAR> DI void peer_u_issue(v4u (&rw)[16], const unsigned char* U8, const LAS unsigned* lev, int g, int cnt, int lane) {
#pragma unroll
    for (int k = 0; k < 16; ++k) { const int idx = (g + k < cnt) ? g + k : cnt - 1; const unsigned ev = (unsigned)__builtin_amdgcn_readfirstlane((int)lev[idx]);
        rw[k] = *(const v4u*)(U8 + (size_t)((VAR == 2) ? ((ev & 0x3800u) + k) : (ev & 0x3fffu)) * 1024 + 16 * lane); }
}
template <int VAR> DI void peer_u_compute(const v4u (&rw)[16], const LAS unsigned char* hrow, const LAS unsigned* lev, const LAS unsigned* lslot, int g, int cnt, int tok, const LAS float* uscs, const LAS float* vscs, float* ACT, int lane, int myk) {
    const v4u ha = *(const LAS v4u*)(hrow + 32 * lane), hb = *(const LAS v4u*)(hrow + 32 * lane + 16);
    f32x2 hf[8];
    hf[0] = (f32x2){bf_lo(ha.x), bf_hi(ha.x)}; hf[1] = (f32x2){bf_lo(ha.y), bf_hi(ha.y)}; hf[2] = (f32x2){bf_lo(ha.z), bf_hi(ha.z)}; hf[3] = (f32x2){bf_lo(ha.w), bf_hi(ha.w)};
    hf[4] = (f32x2){bf_lo(hb.x), bf_hi(hb.x)}; hf[5] = (f32x2){bf_lo(hb.y), bf_hi(hb.y)}; hf[6] = (f32x2){bf_lo(hb.z), bf_hi(hb.z)}; hf[7] = (f32x2){bf_lo(hb.w), bf_hi(hb.w)};
    float p[16];
#pragma unroll
    for (int k = 0; k < 16; ++k) { if (VAR == 3) { p[k] = __uint_as_float((rw[k].x ^ rw[k].y ^ rw[k].z ^ rw[k].w) & 0x3fffffffu) * hf[0].x; continue; } f32x2 a = (f32x2){0.f, 0.f};
        a = fma2(fp8lo(rw[k].x), hf[0], a); a = fma2(fp8hi(rw[k].x), hf[1], a); a = fma2(fp8lo(rw[k].y), hf[2], a); a = fma2(fp8hi(rw[k].y), hf[3], a);
        a = fma2(fp8lo(rw[k].z), hf[4], a); a = fma2(fp8hi(rw[k].z), hf[5], a); a = fma2(fp8lo(rw[k].w), hf[6], a); a = fma2(fp8hi(rw[k].w), hf[7], a); p[k] = a.x + a.y; }
    if (VAR == 4) { float s_ = 0.f; _Pragma("unroll") for (int k = 0; k < 16; ++k) s_ += p[k]; p[0] = s_; } else {
    { const bool up = (lane & 8) != 0;
#pragma unroll
      for (int i = 0; i < 8; ++i) { const float keep = up ? p[i + 8] : p[i], send = up ? p[i] : p[i + 8]; p[i] = keep + dppf<DPP_RM>(send); } }
    { const bool up = (lane & 4) != 0;
#pragma unroll
      for (int i = 0; i < 4; ++i) { const float keep = up ? p[i + 4] : p[i], send = up ? p[i] : p[i + 4]; p[i] = keep + dppf<DPP_HM>(send); } }
    { const bool up = (lane & 2) != 0;
#pragma unroll
      for (int i = 0; i < 2; ++i) { const float keep = up ? p[i + 2] : p[i], send = up ? p[i] : p[i + 2]; p[i] = keep + dppf<DPP_X2>(send); } }
    { const bool up = (lane & 1) != 0; const float keep = up ? p[1] : p[0], send = up ? p[0] : p[1]; p[0] = keep + dppf<DPP_X1>(send); }
    }
    float dot = sum32(sum16(p[0]));
    if (lane < 16 && g + myk < cnt) { const unsigned mev = lev[g + myk], mslot = lslot[g + myk]; const unsigned er = mev & 2047u;
        ACT[(VAR == 1) ? (size_t)lane : ((size_t)tok * 128 + mslot)] = gelu_tanh(dot * uscs[er]) * __uint_as_float(mev & 0xffff0000u) * vscs[er]; }
}
DI void peer_u_loade(int tok, const unsigned* ENT, unsigned (&e0)[4], unsigned (&e1)[4], int lane) {
#pragma unroll
    for (int t = 0; t < 4; ++t) { e0[t] = ENT[(size_t)(tok + t) * 128 + lane]; e1[t] = ENT[(size_t)(tok + t) * 128 + 64 + lane]; }
}
template <int VAR> DI void peer_u_wave(int tok0, int slab, const unsigned* ENT, const bf16* HN, const unsigned char* U8, float* ACT, LAS unsigned char* lds, int wave, int lane) {
    const int myk = lane & 15;
    LAS unsigned* lev = (LAS unsigned*)(lds + PU_LIST + wave * 4096); LAS unsigned* lslot = lev + 512; LAS unsigned char* hb = lds + PU_H + wave * 8192;
    const LAS float* uscs = (const LAS float*)(lds + PU_USC); const LAS float* vscs = (const LAS float*)(lds + PU_VSC);
    unsigned e0[4], e1[4];
    peer_u_loade(tok0, ENT, e0, e1, lane);
#pragma unroll 1
    for (int bt = 0; bt < 4; ++bt) { const int tb = tok0 + 4 * bt;
        v4u h0[4], h1[4];
#pragma unroll
        for (int t = 0; t < 4; ++t) { h0[t] = *(const v4u*)(HN + (size_t)(tb + t) * 1024 + 16 * lane); h1[t] = *(const v4u*)(HN + (size_t)(tb + t) * 1024 + 16 * lane + 8); }
        int cnt[4], off[4]; int n = 0; const unsigned long long lt = (1ull << lane) - 1ull;
#pragma unroll
        for (int t = 0; t < 4; ++t) { const bool in0 = ((e0[t] >> 11) & 7u) == (unsigned)slab, in1 = ((e1[t] >> 11) & 7u) == (unsigned)slab;
            const unsigned long long b0 = __ballot(in0), b1 = __ballot(in1); off[t] = n; const int n0 = n + __builtin_popcountll(b0);
            if (in0) { const int p = n + __builtin_popcountll(b0 & lt); lev[p] = e0[t]; lslot[p] = (unsigned)lane; }
            if (in1) { const int p = n0 + __builtin_popcountll(b1 & lt); lev[p] = e1[t]; lslot[p] = (unsigned)(64 + lane); }
            n = n0 + __builtin_popcountll(b1); cnt[t] = n - off[t]; }
        if (bt < 3) peer_u_loade(tb + 4, ENT, e0, e1, lane);
#pragma unroll
        for (int t = 0; t < 4; ++t) { *(LAS v4u*)(hb + t * 2048 + 32 * lane) = h0[t]; *(LAS v4u*)(hb + t * 2048 + 32 * lane + 16) = h1[t]; }
        asm volatile("s_waitcnt lgkmcnt(0)" ::: "memory");
#define PU_CNT(t_) ((t_) == 0 ? cnt[0] : ((t_) == 1 ? cnt[1] : ((t_) == 2 ? cnt[2] : cnt[3])))
#define PU_OFF(t_) ((t_) == 0 ? off[0] : ((t_) == 1 ? off[1] : ((t_) == 2 ? off[2] : off[3])))
#define PU_ADV(tk_, g_) do { while ((tk_) < 4 && (g_) >= PU_CNT(tk_)) { ++(tk_); (g_) = 0; } } while (0)
        int tk = 0, g = 0; PU_ADV(tk, g);
        if (tk < 4) { v4u ra[16], rb[16];
            peer_u_issue<VAR>(ra, U8, lev + PU_OFF(tk), g, PU_CNT(tk), lane);
            for (;;) {
                int ntk = tk, ng = g + 16; PU_ADV(ntk, ng);
                if (ntk < 4) peer_u_issue<VAR>(rb, U8, lev + PU_OFF(ntk), ng, PU_CNT(ntk), lane);
                peer_u_compute<VAR>(ra, hb + tk * 2048, lev + PU_OFF(tk), lslot + PU_OFF(tk), g, PU_CNT(tk), tb + tk, uscs, vscs, ACT, lane, myk);
                tk = ntk; g = ng; if (tk >= 4) break;
                ntk = tk; ng = g + 16; PU_ADV(ntk, ng);
                if (ntk < 4) peer_u_issue<VAR>(ra, U8, lev + PU_OFF(ntk), ng, PU_CNT(ntk), lane);
                peer_u_compute<VAR>(rb, hb + tk * 2048, lev + PU_OFF(tk), lslot + PU_OFF(tk), g, PU_CNT(tk), tb + tk, uscs, vscs, ACT, lane, myk);
                tk = ntk; g = ng; if (tk >= 4) break;
            } }
#undef PU_CNT
#undef PU_OFF
#undef PU_ADV
        asm volatile("s_waitcnt lgkmcnt(0)" ::: "memory");
    }
}
DI void peer_v_wave(int tok0, int slab, const unsigned* ENT, const float* ACT, const unsigned char* V8slab, float* X, const float* g2, int lane) {
    const int sub = lane & 7, j = lane >> 3;
    const int col = 128 * slab + 16 * sub + 2 * (4 * ((lane >> 5) & 1) + 2 * ((lane >> 4) & 1) + ((lane >> 3) & 1));
    const f32x2 gv = *(const f32x2*)(g2 + (tok0 >> 13) * 6144 + col);
    v4u enn[4]; f32x4 awn[4]; f32x2 xvn;
    { const v4u* ep = (const v4u*)(ENT + (size_t)tok0 * 128 + 16 * j); const f32x4* ap = (const f32x4*)(ACT + (size_t)tok0 * 128 + 16 * j);
#pragma unroll
      for (int q = 0; q < 4; ++q) { enn[q] = ep[q]; awn[q] = ap[q]; }
      xvn = *(const f32x2*)(X + (size_t)tok0 * 1024 + col); }
#pragma unroll 1
    for (int it = 0; it < 8; ++it) { const int tok = tok0 + it;
        v4u en[4]; f32x4 aw[4]; const f32x2 xv = xvn;
#pragma unroll
        for (int q = 0; q < 4; ++q) { en[q] = enn[q]; aw[q] = awn[q]; }
        v4u rw[16];
#pragma unroll
        for (int i = 0; i < 16; ++i) rw[i] = *(const v4u*)(V8slab + (size_t)(en[i >> 2][i & 3] & 0x3fffu) * 128 + 16 * sub);
        if (it < 7) { const v4u* ep = (const v4u*)(ENT + (size_t)(tok + 1) * 128 + 16 * j); const f32x4* ap = (const f32x4*)(ACT + (size_t)(tok + 1) * 128 + 16 * j);
#pragma unroll
            for (int q = 0; q < 4; ++q) { enn[q] = ep[q]; awn[q] = ap[q]; }
            xvn = *(const f32x2*)(X + (size_t)(tok + 1) * 1024 + col); }
        f32x2 acc[8];
#pragma unroll
        for (int c = 0; c < 8; ++c) acc[c] = (f32x2){0.f, 0.f};
#pragma unroll
        for (int i = 0; i < 16; ++i) { const float w = aw[i >> 2][i & 3]; const f32x2 w2 = (f32x2){w, w};
            acc[0] = fma2(fp8lo(rw[i].x), w2, acc[0]); acc[1] = fma2(fp8hi(rw[i].x), w2, acc[1]); acc[2] = fma2(fp8lo(rw[i].y), w2, acc[2]); acc[3] = fma2(fp8hi(rw[i].y), w2, acc[3]);
            acc[4] = fma2(fp8lo(rw[i].z), w2, acc[4]); acc[5] = fma2(fp8hi(rw[i].z), w2, acc[5]); acc[6] = fma2(fp8lo(rw[i].w), w2, acc[6]); acc[7] = fma2(fp8hi(rw[i].w), w2, acc[7]); }
        { const bool up = (lane & 32) != 0;
#pragma unroll
          for (int c = 0; c < 4; ++c) { const f32x2 keep = up ? acc[c + 4] : acc[c], send = up ? acc[c] : acc[c + 4]; acc[c] = (f32x2){keep.x + px32(send.x, lane), keep.y + px32(send.y, lane)}; } }
        { const bool up = (lane & 16) != 0;
#pragma unroll
          for (int c = 0; c < 2; ++c) { const f32x2 keep = up ? acc[c + 2] : acc[c], send = up ? acc[c] : acc[c + 2]; acc[c] = (f32x2){keep.x + px16(send.x, lane), keep.y + px16(send.y, lane)}; } }
        { const bool up = (lane & 8) != 0; const f32x2 keep = up ? acc[1] : acc[0], send = up ? acc[0] : acc[1]; acc[0] = (f32x2){keep.x + dppf<DPP_R8>(send.x), keep.y + dppf<DPP_R8>(send.y)}; }
        *(f32x2*)(X + (size_t)tok * 1024 + col) = (f32x2){xv.x + gv.x * acc[0].x, xv.y + gv.y * acc[0].y};
    }
}
struct PeerT { const unsigned char *U8, *V8s; const float *USC, *VSC; unsigned* ENT; float* ACT; const bf16* HN; float* X; const float* g2; };
DI void peer_scores_phase(const Frame& F, const bf16* QP, const bf16* SUBK, unsigned* ENT) {
    for (int unit = blockIdx.x; unit < MROWS / 64; unit += F.G) {
#pragma unroll 1
        for (int grp = 0; grp < 2; ++grp) { const int tokg = unit * 64 + 32 * grp; peer_scores(tokg, F.wave, QP, SUBK, ENT + (size_t)tokg * 128, F.lane); } }
}
template <int PASS, int VAR = 0> DI void peer_gather_phase(const Frame& F, int cnt_base, const PeerT& T) {
    const int xcc = (int)(xb_xcc_id() & 7u); LAS int* bc = (LAS int*)(F.lds + PU_BC);
    constexpr int CHT = (PASS == 0) ? 128 : 64;
    for (int k = 0; k < 8; ++k) { const int s = (xcc + k) & 7; unsigned* cnt = (unsigned*)(F.ctl + CW_WORK + 64 * (cnt_base + s));
        if (PASS == 0) { for (int i = F.tid; i < 2048; i += NTHR) { ((LAS float*)(F.lds + PU_USC))[i] = T.USC[2048 * s + i]; ((LAS float*)(F.lds + PU_VSC))[i] = T.VSC[2048 * s + i]; } }
        for (;;) {
            if (F.tid == 0) *bc = (int)__hip_atomic_fetch_add(cnt, 1u, __ATOMIC_RELAXED, __HIP_MEMORY_SCOPE_AGENT);
            __syncthreads(); const int chunk = *bc; __syncthreads();
            if (chunk >= MROWS / CHT) break;
            if (PASS == 0) peer_u_wave<VAR>(chunk * 128 + F.wave * 16, s, T.ENT, T.HN, T.U8, T.ACT, F.lds, F.wave, F.lane);
            else peer_v_wave(chunk * 64 + F.wave * 8, s, T.ENT, T.ACT, T.V8s + (size_t)s * 16384 * 128, T.X, T.g2, F.lane);
        } }
}
struct Args { const float* in[19]; float* out; unsigned char* ws; int stage, pad; };
__global__ void __launch_bounds__(NTHR, 2) hybrid_fwd(Args args) {
    extern __shared__ __attribute__((aligned(16))) unsigned char lds_raw[];
    for (int u = threadIdx.x; u < (LDS_BYTES - LDSCTL_OFF) / 4; u += NTHR) ((LAS unsigned*)((LAS unsigned char*)lds_raw + LDSCTL_OFF))[u] = 0u;
    __syncthreads();
    XcdBarrier bar = xcd_barrier_post((unsigned*)((gu32*)(args.ws + WS_CTL) + CW_BAR), (volatile LAS unsigned*)((LAS unsigned char*)lds_raw + MISC_OFF) + 8);
#ifdef PROBE_MASK
    volatile LAS unsigned long long* stamps_ = (volatile LAS unsigned long long*)((LAS unsigned char*)lds_raw + MISC_OFF + 256); int nst_ = 0;
#define STAMP() do { if (blockIdx.x == 0 && threadIdx.x == 0) stamps_[nst_] = __builtin_amdgcn_s_memrealtime(); ++nst_; } while (0)
#else
#define STAMP() do {} while (0)
#endif
    STAMP();
#define GRID_BAR() do { xcd_barrier(bar); STAMP(); } while (0)
#define OPQ(p) ({ size_t z_ = 0; asm volatile("" : "+s"(z_)); (p) + z_; })
#define PH_PTRS \
    unsigned char* ws = OPQ(args.ws); const float* x_in = OPQ(args.in[0]); float* X = OPQ(args.out); \
    const float *norm_mix = args.in[4], *norm_ffn = args.in[5]; \
    float* MOD = (float*)(ws + WS_MOD); float* ROPE = (float*)(ws + WS_ROPE); float* KSUM = (float*)(ws + WS_KSUM); \
    bf16 *WIN0 = (bf16*)(ws + WS_WIN0), *WOUT0 = (bf16*)(ws + WS_WOUT0), *WIN1 = (bf16*)(ws + WS_WIN1), *WOUT1 = (bf16*)(ws + WS_WOUT1), *WQ0 = (bf16*)(ws + WS_WQ0), *WQ1 = (bf16*)(ws + WS_WQ1); \
    bf16 *SUBK = (bf16*)(ws + WS_SUBK), *GWS = (bf16*)(ws + WS_GWS), *HN = (bf16*)(ws + WS_HN); \
    bf16 *UA = (bf16*)(ws + WS_A), *VA = (bf16*)(ws + WS_A + 16 * MiB), *Q0 = (bf16*)(ws + WS_A + 32 * MiB), *K0 = (bf16*)(ws + WS_A + 48 * MiB), *VT0 = (bf16*)(ws + WS_A + 64 * MiB); \
    bf16 *Q1 = (bf16*)(ws + WS_A), *K1 = (bf16*)(ws + WS_A + 32 * MiB), *VT1 = (bf16*)(ws + WS_A + 64 * MiB); \
    bf16 *YCAT = (bf16*)(ws + WS_YCAT), *QP = (bf16*)(ws + WS_QP), *PO = (bf16*)(ws + WS_PO); float* PL = (float*)(ws + WS_PL); unsigned* MASKS = (unsigned*)(ws + WS_MASK); unsigned char *U8 = ws + WS_PTU, *V8s = ws + WS_PTV; float *USC = (float*)(ws + WS_SC), *VSC = USC + 32768; unsigned* ENT = (unsigned*)(ws + WS_PO); float* ACT = (float*)(ws + WS_PO + 8 * MiB); (void)U8; (void)V8s; (void)USC; (void)VSC; (void)ENT; (void)ACT; bf16* QKR = (bf16*)(ws + WS_QP); (void)QKR; \
    (void)x_in; (void)X; (void)norm_mix; (void)norm_ffn; (void)MOD; (void)ROPE; (void)KSUM; (void)WIN0; (void)WOUT0; (void)WIN1; (void)WOUT1; (void)WQ0; (void)WQ1; (void)SUBK; (void)GWS; (void)HN; \
    (void)UA; (void)VA; (void)Q0; (void)K0; (void)VT0; (void)Q1; (void)K1; (void)VT1; (void)YCAT; (void)QP; (void)PO; (void)PL; (void)MASKS;
#define PH_FRAME Frame F; F.lds = (LAS unsigned char*)lds_raw; F.MISC = (volatile LAS unsigned*)(F.lds + MISC_OFF); { int t_ = threadIdx.x; asm volatile("" : "+v"(t_)); F.tid = t_; } F.lane = F.tid & 63; F.wave = __builtin_amdgcn_readfirstlane(F.tid >> 6); \
    F.G = gridDim.x; F.gw = blockIdx.x * NWAVES + F.wave; F.NGW = F.G * NWAVES; F.ctl = (gu32*)(OPQ(args.ws) + WS_CTL);
    { PH_FRAME PH_PTRS
      P0Args A; A.c = args.in[1]; A.w_mod = args.in[2]; A.b_mod = args.in[3]; A.win0 = args.in[6]; A.wout0 = args.in[12]; A.win1 = args.in[13]; A.wout1 = args.in[14]; A.wq = args.in[15]; A.subk = args.in[16];
      A.pu = args.in[17]; A.pv = args.in[18]; A.gws = args.in[8]; A.MOD = MOD; A.ROPE = ROPE; A.WIN0 = WIN0; A.WOUT0 = WOUT0; A.WIN1 = WIN1; A.WOUT1 = WOUT1; A.WQ0 = WQ0; A.WQ1 = WQ1; A.SUBK = SUBK; A.GWS = GWS; A.U8 = U8; A.V8s = V8s; A.USC = USC; A.VSC = VSC;
      p0_prologue(F, A); }
    GRID_BAR();
    { PH_FRAME PH_PTRS norm_rows(F, x_in, norm_mix, MOD, 0, 1, HN); }
    GRID_BAR();
    { PH_FRAME PH_PTRS
      pg8::Gemm g{HN, WIN0, MROWS, 2048, 1024}; pg8::StaticOrder S; S.init(MROWS, 2048, F.G, (int)blockIdx.x);
      pg8::EpiL0m E{UA, VA, QKR};
      pg8::gemm_phase<pg8::EpiL0m, pg8::StaticOrder, true, true>(F.lds, g, S, E); }
    { PH_FRAME PH_PTRS
      pg8::Gemm g{WIN0 + (size_t)2048 * 1024, HN, 512, MROWS, 1024}; pg8::StaticOrder S; S.init(512, MROWS, F.G, (int)blockIdx.x);
      pg8::EpiVT E{VT0, 512};
      pg8::gemm_phase<pg8::EpiVT, pg8::StaticOrder, true, true>(F.lds, g, S, E); }
    GRID_BAR();
    { PH_FRAME PH_PTRS
      for (int t = blockIdx.x; t < 256; t += F.G) qk_post_task(t, QKR, Q0, K0, KSUM, ROPE, args.in[10], args.in[11], (LAS float*)F.lds, F.tid, F.wave, F.lane);
      for (int u = blockIdx.x; u < 512; u += F.G) gmlp_unit(u, UA, VA, args.in[7], GWS, args.in[9], YCAT, F.lds, F.tid, F.wave, F.lane); }
    GRID_BAR();
    { PH_FRAME PH_PTRS
      MobaT T{Q0, K0, VT0, KSUM, MASKS, PO, PL, args.in[10], args.in[11]}; const float mc2 = moba_mc2(args.in[10], args.in[11], F.lane);
      for (int u = F.gw; u < 4096; u += F.NGW) { moba_mask_unit(u, T, F.lane); moba_own_unit(u, T, mc2, F.lane); } }
    GRID_BAR();
    { PH_FRAME PH_PTRS
      MobaT T{Q0, K0, VT0, KSUM, MASKS, PO, PL, args.in[10], args.in[11]}; const float mc2 = moba_mc2(args.in[10], args.in[11], F.lane);
      LAS int* bc = (LAS int*)(F.lds + MS_CNT + 64);
      for (;;) { if (F.tid == 0) *bc = (int)__hip_atomic_fetch_add((unsigned*)(F.ctl + CW_WORK), 1u, __ATOMIC_RELAXED, __HIP_MEMORY_SCOPE_AGENT);
          __syncthreads(); const int task = *bc; __syncthreads(); if (task >= MOBA_NTASK) break;
          moba_sel_task(task, T, F.lds, mc2, F.tid, F.wave, F.lane); } }
    GRID_BAR();
    { PH_FRAME PH_PTRS moba_combine(F, PO, PL, YCAT); }
    GRID_BAR();
    { PH_FRAME PH_PTRS
      pg8::Gemm g{YCAT, WOUT0, MROWS, 1024, 1024}; pg8::StaticOrder S; S.init(MROWS, 1024, F.G, (int)blockIdx.x);
      pg8::EpiRes E{x_in, X, MOD + 2 * 1024};
      pg8::gemm_phase<pg8::EpiRes, pg8::StaticOrder, true, true>(F.lds, g, S, E); }
    GRID_BAR();
    { PH_FRAME PH_PTRS norm_rows(F, X, norm_ffn, MOD, 3, 4, HN); }
    GRID_BAR();
    { PH_FRAME PH_PTRS
      pg8::Gemm g{HN, WQ0, MROWS, 2048, 1024}; pg8::StaticOrder S; S.init(MROWS, 2048, F.G, (int)blockIdx.x);
      pg8::EpiBf16<0> E{QP, 2048, nullptr, 0, 0, 1.f};
      pg8::gemm_phase<pg8::EpiBf16<0>, pg8::StaticOrder, true, true>(F.lds, g, S, E); }
    GRID_BAR();
    { PH_FRAME PH_PTRS peer_scores_phase(F, QP, SUBK, ENT); }
    GRID_BAR();
    { PH_FRAME PH_PTRS PeerT T{U8, V8s, USC, VSC, ENT, ACT, HN, X, MOD + 5 * 1024}; peer_gather_phase<0>(F, 1, T); }
    GRID_BAR();
#ifdef XVAR
    { PH_FRAME PH_PTRS PeerT T{U8, V8s, USC, VSC, ENT, (float*)(ws + WS_PL), HN, X, MOD + 5 * 1024}; peer_gather_phase<0, XVAR>(F, 40, T); }
    GRID_BAR();
#endif
    { PH_FRAME PH_PTRS PeerT T{U8, V8s, USC, VSC, ENT, ACT, HN, X, MOD + 5 * 1024}; peer_gather_phase<1>(F, 9, T); }
    GRID_BAR();
    { PH_FRAME PH_PTRS norm_rows(F, X, norm_mix + 1024, MOD + 2 * 6144, 0, 1, HN); }
    GRID_BAR();
    { PH_FRAME PH_PTRS
      pg8::Gemm g{HN, WIN1, MROWS, 2048, 1024}; pg8::StaticOrder S; S.init(MROWS, 2048, F.G, (int)blockIdx.x);
      pg8::EpiHeads E{Q1, K1, 16};
      pg8::gemm_phase<pg8::EpiHeads, pg8::StaticOrder, true, true>(F.lds, g, S, E); }
    { PH_FRAME PH_PTRS
      pg8::Gemm g{WIN1 + (size_t)2048 * 1024, HN, 1024, MROWS, 1024}; pg8::StaticOrder S; S.init(1024, MROWS, F.G, (int)blockIdx.x);
      pg8::EpiVT E{VT1, 1024};
      pg8::gemm_phase<pg8::EpiVT, pg8::StaticOrder, true, true>(F.lds, g, S, E); }
    GRID_BAR();
    { PH_FRAME PH_PTRS for (int u = F.gw; u < 8192; u += F.NGW) sb_unit(u, Q1, K1, VT1, YCAT, F.lane); }
    GRID_BAR();
    { PH_FRAME PH_PTRS
      pg8::Gemm g{YCAT, WOUT1, MROWS, 1024, 1024}; pg8::StaticOrder S; S.init(MROWS, 1024, F.G, (int)blockIdx.x);
      pg8::EpiRes E{X, X, MOD + 2 * 6144 + 2 * 1024};
      pg8::gemm_phase<pg8::EpiRes, pg8::StaticOrder, true, true>(F.lds, g, S, E); }
    GRID_BAR();
    { PH_FRAME PH_PTRS norm_rows(F, X, norm_ffn + 1024, MOD + 2 * 6144, 3, 4, HN); }
    GRID_BAR();
    { PH_FRAME PH_PTRS
      pg8::Gemm g{HN, WQ1, MROWS, 2048, 1024}; pg8::StaticOrder S; S.init(MROWS, 2048, F.G, (int)blockIdx.x);
      pg8::EpiBf16<0> E{QP, 2048, nullptr, 0, 0, 1.f};
      pg8::gemm_phase<pg8::EpiBf16<0>, pg8::StaticOrder, true, true>(F.lds, g, S, E); }
    GRID_BAR();
    { PH_FRAME PH_PTRS peer_scores_phase(F, QP, SUBK + 262144, ENT); }
    GRID_BAR();
    { PH_FRAME PH_PTRS PeerT T{U8 + (size_t)16384 * 1024, V8s + (size_t)16384 * 1024, USC + 16384, VSC + 16384, ENT, ACT, HN, X, MOD + 2 * 6144 + 5 * 1024}; peer_gather_phase<0>(F, 17, T); }
    GRID_BAR();
    { PH_FRAME PH_PTRS PeerT T{U8 + (size_t)16384 * 1024, V8s + (size_t)16384 * 1024, USC + 16384, VSC + 16384, ENT, ACT, HN, X, MOD + 2 * 6144 + 5 * 1024}; peer_gather_phase<1>(F, 25, T);
      if (__hip_atomic_load((gu32*)((unsigned*)(F.ctl + CW_BAR) + XB_TMO), RLX_AGENT) != 0u) { for (int m = F.gw; m < MROWS; m += F.NGW) X[(size_t)m * 1024 + F.lane] = __builtin_nanf(""); } }
#ifdef PROBE_MASK
#ifdef PROBE_BARS
    for (int i = 0; i < PROBE_BARS; ++i) xcd_barrier(bar);
#endif
    STAMP();
    if (blockIdx.x == 0 && threadIdx.x == 0) { unsigned long long tsel = 0;
        for (int i = 0; i + 1 < nst_; ++i) if ((PROBE_MASK >> i) & 1ull) tsel += stamps_[i + 1] - stamps_[i];
        const unsigned long long t0 = __builtin_amdgcn_s_memrealtime(); while (__builtin_amdgcn_s_memrealtime() - t0 < tsel * PROBE_AMP) __builtin_amdgcn_s_sleep(8); }
#endif
}

extern "C" void kernel_launch(void* const* d_in, const int* in_sizes, int n_in, void* d_out, int out_size, void* d_ws, size_t ws_size, hipStream_t stream) {
    static int grid = 0;
    if (grid == 0) {
        if (n_in != 19 || out_size != MROWS * DM || ws_size < WS_END) { fprintf(stderr, "kernel_launch: unexpected shapes (n_in %d, out %d, ws %zu)\n", n_in, out_size, ws_size); grid = -1; return; }
        int dev = 0, cus = 0, per_cu = 0;
        if (hipGetDevice(&dev) != hipSuccess || hipDeviceGetAttribute(&cus, hipDeviceAttributeMultiprocessorCount, dev) != hipSuccess) { grid = -1; return; }
        if (hipFuncSetAttribute((const void*)hybrid_fwd, hipFuncAttributeMaxDynamicSharedMemorySize, LDS_BYTES) != hipSuccess) { fprintf(stderr, "kernel_launch: hipFuncSetAttribute failed\n"); grid = -1; return; }
        if (hipOccupancyMaxActiveBlocksPerMultiprocessor(&per_cu, (const void*)hybrid_fwd, NTHR, LDS_BYTES) != hipSuccess || per_cu < 1) { fprintf(stderr, "kernel_launch: occupancy query says %d\n", per_cu); per_cu = 1; }
        (void)hipGetLastError();
        grid = cus;
    }
    if (grid < 0) return;
    if (hipMemsetAsync((char*)d_ws + WS_CTL, 0, CTL_ZERO_BYTES, stream) != hipSuccess) { fprintf(stderr, "kernel_launch: memset failed\n"); return; }
    Args a{};
    for (int i = 0; i < 19; ++i) a.in[i] = (const float*)d_in[i];
    a.out = (float*)d_out; a.ws = (unsigned char*)d_ws; a.stage = 0; a.pad = 0;
    void* kargs[] = {&a};
    hipError_t e = hipLaunchCooperativeKernel((const void*)hybrid_fwd, dim3(grid), dim3(NTHR), kargs, LDS_BYTES, stream);
    if (e != hipSuccess) fprintf(stderr, "kernel_launch: cooperative launch failed: %s (grid %d)\n", hipGetErrorString(e), grid);
}
```

```cpp
#include <hip/hip_runtime.h>
#include <cstdio>
#include <cstdint>
#include <cmath>
namespace pg8 {
#define PG8_LAS __attribute__((address_space(3)))
typedef unsigned short bf16_t;
typedef short bf16x8 __attribute__((ext_vector_type(8)));
typedef float f32x4 __attribute__((ext_vector_type(4)));
typedef unsigned u32x4 __attribute__((ext_vector_type(4)));
constexpr int BM = 256, BK = 64, HALF = 128, HTB = HALF * BK * 2  , STAGE_BYTES = 8 * HTB, NXCD = 8, WGM = 8;

__host__ __device__ __forceinline__ int lds_byte(int r, int c) { const int st = (r >> 4) * 2 + (c >> 5), rr = r & 15, cc = c & 31, ob = rr * 64 + cc * 2; return st * 1024 + (ob ^ (((ob >> 9) & 1) << 5)); }
__host__ __device__ __forceinline__ void stage_rc(int b, int& R, int& C) { const int st = b / 1024, sb = b % 1024, swz = sb ^ (((sb >> 9) & 1) << 5); R = (st >> 1) * 16 + swz / 64; C = (st & 1) * 32 + (swz % 64) / 2; }
__host__ __device__ __forceinline__ int perm32(int rho) { const int n = rho >> 4, i = rho & 15; return 8 * (i >> 2) + 4 * n + (i & 3); }

struct Unit { int pm, pn; };
struct Gemm { const bf16_t* A; const bf16_t* Bt; int M, N, K; };

struct StaticOrder {
    int nM, nN, nwg, G, c;
    __host__ __device__ void init(int M, int N, int G_, int c_) { nM = M / BM; nN = N / BM; nwg = nM * nN; G = G_; c = c_; }
    __host__ __device__ bool next(int i, Unit& u) const {
        const long L = (long)i * G + c; if (L >= nwg) return false;
        int wgid = (int)L; { const int q = nwg / NXCD, r = nwg % NXCD, xcd = wgid % NXCD, off = wgid / NXCD; wgid = (xcd < r ? xcd * (q + 1) : r * (q + 1) + (xcd - r) * q) + off; }
        const int nig = WGM * nN, gid = wgid / nig, fm = gid * WGM, gsz = (nM - fm) < WGM ? (nM - fm) : WGM;
        u.pm = fm + ((wgid % nig) % gsz); u.pn = (wgid % nig) / gsz; return true;
    }
    __device__ __forceinline__ void a_ready(const Unit&) const {}
    __device__ __forceinline__ void done(const Unit&) const {}
};

__device__ __forceinline__ unsigned cvt_pk_bf16(float lo, float hi) { unsigned r; asm volatile("v_cvt_pk_bf16_f32 %0, %1, %2" : "=v"(r) : "v"(lo), "v"(hi)); return r; }
typedef float f32x2 __attribute__((ext_vector_type(2)));
__device__ __forceinline__ f32x2 gelu_pk(f32x2 v) {
    const f32x2 av = __builtin_elementwise_abs(v), d = av * 0.2316418882f + 1.0f;
    f32x2 t; t.x = __builtin_amdgcn_rcpf(d.x); t.y = __builtin_amdgcn_rcpf(d.y);
    f32x2 q = t * 0.5307027145f + (-0.7265760135f); q = q * t + 0.7107068705f; q = q * t + (-0.142248368f); q = q * t + 0.127414796f; q = q * t;
    const f32x2 s = (v * v) * (-0.72134752044f);
    f32x2 e; e.x = __builtin_amdgcn_exp2f(s.x); e.y = __builtin_amdgcn_exp2f(s.y);
    const f32x2 m = v * (q * e), r = v - m;
    f32x2 o; o.x = v.x < 0.f ? m.x : r.x; o.y = v.y < 0.f ? m.y : r.y; return o;
}

template <int ACT  > struct EpiBf16 {
    static constexpr bool PERM = true, AFTER_DRAIN = false; static_assert(ACT == 0 || ACT == 1, "EpiBf16: ACT is 0 (none) or 1 (gelu_pk)");
    bf16_t* O; int ldc; const float* bias; int split_cols; size_t split_stride; float scale0;
    __device__ __forceinline__ void operator()(const f32x4 (&acc)[2][2][4][2], const Unit& u, int wr, int wc, int fr, int fq) const {
        const int row0 = u.pm * BM + wr * 64 + fr; int colt = u.pn * BM; bf16_t* base = O;
        float sc = 1.f; if (split_cols) { const int t = colt / split_cols; base += (size_t)t * split_stride; colt -= t * split_cols; if (t == 0) sc = scale0; }
        const int col0 = colt + wc * 32 + 8 * fq, bcol0 = u.pn * BM + wc * 32 + 8 * fq;
        f32x4 bv[2][2];
#pragma unroll
        for (int bj = 0; bj < 2; ++bj)
#pragma unroll
            for (int n = 0; n < 2; ++n) bv[bj][n] = bias ? *(const f32x4*)(bias + bcol0 + bj * HALF + 4 * n) : (f32x4){0.f, 0.f, 0.f, 0.f};
#pragma unroll
        for (int ai = 0; ai < 2; ++ai)
#pragma unroll
            for (int m = 0; m < 4; ++m) { bf16_t* rowp = base + (size_t)(row0 + ai * HALF + m * 16) * ldc + col0;
#pragma unroll
                for (int bj = 0; bj < 2; ++bj) { f32x4 v0 = acc[ai][bj][m][0] + bv[bj][0], v1 = acc[ai][bj][m][1] + bv[bj][1];
                    if (ACT == 1) { f32x2 a = gelu_pk((f32x2){v0[0], v0[1]}), b = gelu_pk((f32x2){v0[2], v0[3]}), c = gelu_pk((f32x2){v1[0], v1[1]}), d = gelu_pk((f32x2){v1[2], v1[3]});
                        v0 = (f32x4){a.x, a.y, b.x, b.y}; v1 = (f32x4){c.x, c.y, d.x, d.y}; }
                    v0 = v0 * sc; v1 = v1 * sc; u32x4 w; w.x = cvt_pk_bf16(v0[0], v0[1]); w.y = cvt_pk_bf16(v0[2], v0[3]); w.z = cvt_pk_bf16(v1[0], v1[1]); w.w = cvt_pk_bf16(v1[2], v1[3]);
                    *(u32x4*)(rowp + bj * HALF) = w; } }
    }
};
constexpr int XSEQ = 8192;
typedef float f32x2e __attribute__((ext_vector_type(2))); typedef __bf16 bf16x2e __attribute__((ext_vector_type(2)));
__device__ __forceinline__ unsigned cvtpk2(float lo, float hi) { f32x2e v = {lo, hi}; bf16x2e b = __builtin_convertvector(v, bf16x2e); return __builtin_bit_cast(unsigned, b); }
__device__ __forceinline__ float gelu_tanh(float x) {
    const float u2 = x * (1.5957691216f + 0.0713548163f * x * x);
    return x * __builtin_amdgcn_rcpf(1.0f + __builtin_amdgcn_exp2f(-1.4426950409f * u2));
}
struct EpiL0m {
    static constexpr bool PERM = true, AFTER_DRAIN = false;
    bf16_t *UA, *VA, *QKR;
    template <bool ACT> __device__ __forceinline__ void tile(const f32x4 (&acc)[2][2][4][2], bf16_t* base, int ldc, int row0, int colt) const {
#pragma unroll
        for (int ai = 0; ai < 2; ++ai)
#pragma unroll
            for (int m = 0; m < 4; ++m) { bf16_t* rowp = base + (size_t)(row0 + ai * HALF + m * 16) * ldc + colt;
#pragma unroll
                for (int bj = 0; bj < 2; ++bj) { f32x4 v0 = acc[ai][bj][m][0], v1 = acc[ai][bj][m][1]; u32x4 w;
                    if (ACT) { v0[0] = gelu_tanh(v0[0]); v0[1] = gelu_tanh(v0[1]); v0[2] = gelu_tanh(v0[2]); v0[3] = gelu_tanh(v0[3]); v1[0] = gelu_tanh(v1[0]); v1[1] = gelu_tanh(v1[1]); v1[2] = gelu_tanh(v1[2]); v1[3] = gelu_tanh(v1[3]); }
                    w.x = cvtpk2(v0[0], v0[1]); w.y = cvtpk2(v0[2], v0[3]); w.z = cvtpk2(v1[0], v1[1]); w.w = cvtpk2(v1[2], v1[3]);
                    *(u32x4*)(rowp + bj * HALF) = w; } }
    }
    __device__ __forceinline__ void operator()(const f32x4 (&acc)[2][2][4][2], const Unit& u, int wr, int wc, int fr, int fq) const {
        const int pn = u.pn; const int row0 = u.pm * BM + wr * 64 + fr; const int cw = wc * 32 + 8 * fq;
        if (pn < 2) tile<true>(acc, UA, 512, row0, pn * 256 + cw);
        else if (pn < 4) tile<true>(acc, VA, 512, row0, (pn - 2) * 256 + cw);
        else tile<false>(acc, QKR, 1024, row0, (pn - 4) * 256 + cw);
    }
};
struct EpiHeads {
    static constexpr bool PERM = true, AFTER_DRAIN = false;
    bf16_t *Q, *Kp; int nh;
    __device__ __forceinline__ void operator()(const f32x4 (&acc)[2][2][4][2], const Unit& u, int wr, int wc, int fr, int fq) const {
        const int b = u.pm >> 5, sb = (u.pm & 31) * 256 + wr * 64 + fr;
#pragma unroll
        for (int bj = 0; bj < 2; ++bj) { const int c = u.pn * BM + bj * HALF + wc * 32 + 8 * fq; const int t = c / (64 * nh), cc = c - t * 64 * nh, head = cc >> 6, d = cc & 63;
            bf16_t* dst = (t ? Kp : Q) + ((size_t)(b * nh + head) * XSEQ) * 64 + d;
#pragma unroll
            for (int ai = 0; ai < 2; ++ai)
#pragma unroll
                for (int m = 0; m < 4; ++m) { const int s = sb + ai * HALF + m * 16; const f32x4 v0 = acc[ai][bj][m][0], v1 = acc[ai][bj][m][1]; u32x4 w;
                    w.x = cvtpk2(v0[0], v0[1]); w.y = cvtpk2(v0[2], v0[3]); w.z = cvtpk2(v1[0], v1[1]); w.w = cvtpk2(v1[2], v1[3]);
                    *(u32x4*)(dst + (size_t)s * 64) = w; } }
    }
};
struct EpiVT {
    static constexpr bool PERM = true, AFTER_DRAIN = false;
    bf16_t* VT; int nrows;
    __device__ __forceinline__ void operator()(const f32x4 (&acc)[2][2][4][2], const Unit& u, int wr, int wc, int fr, int fq) const {
        const int row0 = u.pm * BM + wr * 64 + fr; const int c0 = u.pn * BM + wc * 32 + 8 * fq; const int b = c0 >> 13, s0 = c0 & (XSEQ - 1);
#pragma unroll
        for (int ai = 0; ai < 2; ++ai)
#pragma unroll
            for (int m = 0; m < 4; ++m) { bf16_t* rowp = VT + ((size_t)b * nrows + row0 + ai * HALF + m * 16) * XSEQ + s0;
#pragma unroll
                for (int bj = 0; bj < 2; ++bj) { const f32x4 v0 = acc[ai][bj][m][0], v1 = acc[ai][bj][m][1]; u32x4 w;
                    w.x = cvtpk2(v0[0], v0[1]); w.y = cvtpk2(v0[2], v0[3]); w.z = cvtpk2(v1[0], v1[1]); w.w = cvtpk2(v1[2], v1[3]);
                    *(u32x4*)(rowp + bj * HALF) = w; } }
    }
};
struct EpiRes {
    static constexpr bool PERM = false, AFTER_DRAIN = false;
    const float* xin; float* xout; const float* g;
    __device__ __forceinline__ void operator()(const f32x4 (&acc)[2][2][4][2], const Unit& u, int wr, int wc, int fr, int fq) const {
        const int row0 = u.pm * BM + wr * 64 + fr, col0 = u.pn * BM + wc * 32 + 4 * fq; const int b = u.pm >> 5;
        f32x4 gv[2][2];
#pragma unroll
        for (int bj = 0; bj < 2; ++bj)
#pragma unroll
            for (int n = 0; n < 2; ++n) gv[bj][n] = *(const f32x4*)(g + b * 6144 + col0 + bj * HALF + n * 16);
#pragma unroll
        for (int ai = 0; ai < 2; ++ai)
#pragma unroll
            for (int m = 0; m < 4; ++m) { const size_t off = (size_t)(row0 + ai * HALF + m * 16) * 1024 + col0;
#pragma unroll
                for (int bj = 0; bj < 2; ++bj)
#pragma unroll
                    for (int n = 0; n < 2; ++n) { const f32x4 xi = *(const f32x4*)(xin + off + bj * HALF + n * 16); *(f32x4*)(xout + off + bj * HALF + n * 16) = xi + gv[bj][n] * acc[ai][bj][m][n]; } }
    }
};
template <class Epi, class Sched, bool ALIGN_EPI = false, bool SP2 = false>
__device__ __forceinline__ void gemm_phase(PG8_LAS unsigned char* lds, const Gemm g, const Sched& S, const Epi& E) {
    int tid_ = threadIdx.x; asm volatile("" : "+v"(tid_));
    const int tid = tid_, wid = __builtin_amdgcn_readfirstlane(tid >> 6), lane = tid & 63, wr = wid >> 2, wc = wid & 3, fr = lane & 15, fq = lane >> 4;
    const int K = g.K, nt = K / BK;
    unsigned voffA[2], voffB[2];
#pragma unroll
    for (int i = 0; i < 2; ++i) { int R, C; stage_rc(tid * 16 + i * 8192, R, C); const int Rb = Epi::PERM ? ((R & ~31) + perm32(R & 31)) : R;
        voffA[i] = (unsigned)(R * K + C) * 2u; voffB[i] = (unsigned)(Rb * K + C) * 2u; }
    const size_t kstep = (size_t)(BK * 2);
    const size_t hstep = (size_t)HALF * K * 2;
    const size_t tstep = 2 * hstep;
    const unsigned ldsw = (unsigned)wid * 1024u;
    const int aoff = lds_byte(wr * 64 + fr, fq * 8), boff = lds_byte(wc * 32 + fr, fq * 8);
#define PG8_SA(b, h) (((b) * 2 + (h)) * HTB)
#define PG8_SB(b, h) ((4 + (b) * 2 + (h)) * HTB)
#define PG8_STAGE(bufoff, gbase, voff) do { _Pragma("unroll") for (int _i = 0; _i < 2; ++_i) \
        __builtin_amdgcn_global_load_lds((const unsigned*)((const char*)(gbase) + (voff)[_i]), (PG8_LAS unsigned*)(lds + (bufoff) + ldsw + _i * 8192), 16, 0, 0); } while (0)
#define PG8_LDA(dst, b, h) do { _Pragma("unroll") for (int m = 0; m < 4; ++m) _Pragma("unroll") for (int k = 0; k < 2; ++k) dst[m][k] = *(const PG8_LAS bf16x8*)(lds + PG8_SA(b, h) + aoff + m * 2048 + k * 1024); } while (0)
#define PG8_LDB(dst, b, h) do { _Pragma("unroll") for (int n = 0; n < 2; ++n) _Pragma("unroll") for (int k = 0; k < 2; ++k) dst[n][k] = *(const PG8_LAS bf16x8*)(lds + PG8_SB(b, h) + boff + n * 2048 + k * 1024); } while (0)
#define PG8_MMA(ai, bj, At, Bt) do { __builtin_amdgcn_s_setprio(1); _Pragma("unroll") for (int m = 0; m < 4; ++m) _Pragma("unroll") for (int n = 0; n < 2; ++n) _Pragma("unroll") for (int k = 0; k < 2; ++k) \
        acc[ai][bj][m][n] = __builtin_amdgcn_mfma_f32_16x16x32_bf16(Bt[n][k], At[m][k], acc[ai][bj][m][n], 0, 0, 0); __builtin_amdgcn_s_setprio(0); } while (0)
#define PG8_WAIT_V(n) asm volatile("s_waitcnt vmcnt(" #n ")" ::: "memory")
#define PG8_WAIT_L(n) asm volatile("s_waitcnt lgkmcnt(" #n ")" ::: "memory")
#define PG8_BAR __builtin_amdgcn_s_barrier()
#define PG8_SCHED __builtin_amdgcn_sched_barrier(0)
    Unit cur, nxt; int ui = 0;
    if (!S.next(0, cur)) return;
    f32x4 acc[2][2][4][2];
#pragma unroll
    for (int a = 0; a < 2; ++a)
#pragma unroll
        for (int b = 0; b < 2; ++b)
#pragma unroll
            for (int m = 0; m < 4; ++m)
#pragma unroll
                for (int n = 0; n < 2; ++n) acc[a][b][m][n] = (f32x4){0.f, 0.f, 0.f, 0.f};
    bf16x8 At[4][2], B0[2][2], B1[2][2];
    const char* cA = (const char*)g.A + (size_t)cur.pm * tstep; const char* cB = (const char*)g.Bt + (size_t)cur.pn * tstep;
    S.a_ready(cur);
    if constexpr (SP2) {
        PG8_STAGE(PG8_SB(0, 0), cB, voffB); PG8_STAGE(PG8_SB(0, 1), cB + hstep, voffB); PG8_STAGE(PG8_SA(0, 0), cA, voffA); PG8_STAGE(PG8_SA(0, 1), cA + hstep, voffA);
        if (wr == 1) PG8_BAR;
        PG8_WAIT_V(2); PG8_BAR;
        PG8_STAGE(PG8_SB(1, 0), cB + kstep, voffB); PG8_STAGE(PG8_SA(1, 0), cA + kstep, voffA); PG8_STAGE(PG8_SB(1, 1), cB + hstep + kstep, voffB);
        PG8_WAIT_V(6); PG8_BAR;
    } else {
        PG8_STAGE(PG8_SB(0, 0), cB, voffB); PG8_STAGE(PG8_SA(0, 0), cA, voffA); PG8_STAGE(PG8_SB(0, 1), cB + hstep, voffB); PG8_STAGE(PG8_SA(0, 1), cA + hstep, voffA);
        if (wr == 1) PG8_BAR;
        PG8_WAIT_V(4); PG8_BAR;
        PG8_STAGE(PG8_SB(1, 0), cB + kstep, voffB); PG8_STAGE(PG8_SA(1, 0), cA + kstep, voffA); PG8_STAGE(PG8_SB(1, 1), cB + hstep + kstep, voffB);
        PG8_WAIT_V(6); PG8_BAR;
    }
    for (;;) {
        const bool has_next = S.next(ui + 1, nxt);
        const char* nA = has_next ? (const char*)g.A + (size_t)nxt.pm * tstep : cA; const char* nB = has_next ? (const char*)g.Bt + (size_t)nxt.pn * tstep : cB;
        for (int t = 0; t < nt; t += 2) {
            const bool last = (t == nt - 2);
            const char* a1 = cA + (size_t)(t + 1) * kstep;
            const char* a2 = last ? nA : cA + (size_t)(t + 2) * kstep; const char* b2 = last ? nB : cB + (size_t)(t + 2) * kstep;
            const char* a3 = a2 + kstep; const char* b3 = b2 + kstep;
            if (last && has_next) S.a_ready(nxt);
            if constexpr (SP2) {
            PG8_LDB(B0, 0, 0); PG8_LDB(B1, 0, 1); PG8_SCHED; PG8_LDA(At, 0, 0); PG8_STAGE(PG8_SA(1, 1), a1 + hstep, voffA);
            PG8_WAIT_V(8); PG8_WAIT_L(0); PG8_BAR; PG8_MMA(0, 0, At, B0); PG8_MMA(0, 1, At, B1); PG8_BAR; PG8_SCHED;
            PG8_LDA(At, 0, 1); PG8_STAGE(PG8_SB(0, 0), b2, voffB); PG8_STAGE(PG8_SB(0, 1), b2 + hstep, voffB); PG8_STAGE(PG8_SA(0, 0), a2, voffA);
            PG8_WAIT_V(8); PG8_WAIT_L(0); PG8_BAR; PG8_MMA(1, 0, At, B0); PG8_MMA(1, 1, At, B1); PG8_BAR; PG8_SCHED;
            PG8_LDB(B0, 1, 0); PG8_LDB(B1, 1, 1); PG8_SCHED; PG8_LDA(At, 1, 0); PG8_STAGE(PG8_SA(0, 1), a2 + hstep, voffA);
            PG8_WAIT_V(8); PG8_WAIT_L(0); PG8_BAR; PG8_MMA(0, 0, At, B0); PG8_MMA(0, 1, At, B1); PG8_BAR; PG8_SCHED;
            PG8_LDA(At, 1, 1); PG8_STAGE(PG8_SB(1, 0), b3, voffB); PG8_STAGE(PG8_SB(1, 1), b3 + hstep, voffB); PG8_STAGE(PG8_SA(1, 0), a3, voffA);
            PG8_WAIT_V(8); PG8_WAIT_L(0); PG8_BAR; PG8_MMA(1, 0, At, B0); PG8_MMA(1, 1, At, B1); PG8_BAR; PG8_SCHED;
            } else {
            PG8_LDB(B0, 0, 0); PG8_SCHED; PG8_LDA(At, 0, 0); PG8_STAGE(PG8_SA(1, 1), a1 + hstep, voffA);
            PG8_WAIT_L(8); PG8_BAR; PG8_WAIT_L(0); PG8_MMA(0, 0, At, B0); PG8_BAR; PG8_SCHED;
            PG8_LDB(B1, 0, 1); PG8_STAGE(PG8_SB(0, 0), b2, voffB);
            PG8_BAR; PG8_WAIT_L(0); PG8_MMA(0, 1, At, B1); PG8_BAR;
            PG8_LDA(At, 0, 1); PG8_STAGE(PG8_SA(0, 0), a2, voffA);
            PG8_BAR; PG8_WAIT_L(0); PG8_MMA(1, 0, At, B0); PG8_BAR; PG8_SCHED;
            PG8_STAGE(PG8_SB(0, 1), b2 + hstep, voffB);
            PG8_WAIT_V(6); PG8_BAR; PG8_MMA(1, 1, At, B1); PG8_BAR;
            PG8_LDB(B0, 1, 0); PG8_SCHED; PG8_LDA(At, 1, 0); PG8_STAGE(PG8_SA(0, 1), a2 + hstep, voffA);
            PG8_WAIT_L(8); PG8_BAR; PG8_WAIT_L(0); PG8_MMA(0, 0, At, B0); PG8_BAR; PG8_SCHED;
            PG8_LDB(B1, 1, 1); PG8_STAGE(PG8_SB(1, 0), b3, voffB);
            PG8_BAR; PG8_WAIT_L(0); PG8_MMA(0, 1, At, B1); PG8_BAR;
            PG8_LDA(At, 1, 1); PG8_STAGE(PG8_SA(1, 0), a3, voffA);
            PG8_BAR; PG8_WAIT_L(0); PG8_MMA(1, 0, At, B0); PG8_BAR; PG8_SCHED;
            PG8_STAGE(PG8_SB(1, 1), b3 + hstep, voffB);
            PG8_WAIT_V(6); PG8_BAR; PG8_MMA(1, 1, At, B1); PG8_BAR;
            }
        }
        if constexpr (ALIGN_EPI) { if (wr == 0) PG8_BAR; }
        if constexpr (!Epi::AFTER_DRAIN) { E(acc, cur, wr, wc, fr, fq); S.done(cur); }
        if (!has_next) break;
#pragma unroll
        for (int a = 0; a < 2; ++a)
#pragma unroll
            for (int b = 0; b < 2; ++b)
#pragma unroll
                for (int m = 0; m < 4; ++m)
#pragma unroll
                    for (int n = 0; n < 2; ++n) acc[a][b][m][n] = (f32x4){0.f, 0.f, 0.f, 0.f};
        cur = nxt; cA = nA; cB = nB; ++ui;
        if constexpr (ALIGN_EPI) { if (wr == 1) PG8_BAR; }
    }
    PG8_WAIT_V(0);
    if constexpr (!ALIGN_EPI) { if (wr == 0) PG8_BAR; }
    PG8_BAR;
    if constexpr (Epi::AFTER_DRAIN) { E.fused(acc, cur, wr, wc, fr, fq, lds, wid, lane); S.done(cur); }
#undef PG8_SA
#undef PG8_SB
#undef PG8_STAGE
#undef PG8_LDA
#undef PG8_LDB
#undef PG8_MMA
#undef PG8_WAIT_V
#undef PG8_WAIT_L
#undef PG8_BAR
#undef PG8_SCHED
}
}
#define GAS __attribute__((address_space(1)))
#define LAS __attribute__((address_space(3)))
typedef unsigned short bf16;
typedef unsigned v4u __attribute__((ext_vector_type(4)));
typedef float f32x4 __attribute__((ext_vector_type(4)));
typedef short bf16x8 __attribute__((ext_vector_type(8)));
typedef GAS unsigned gu32;
typedef GAS unsigned long long gu64;
#define RLX_AGENT __ATOMIC_RELAXED, __HIP_MEMORY_SCOPE_AGENT
#define LDS_WAIT() asm volatile("s_waitcnt lgkmcnt(0)" ::: "memory")
#define VM_WAIT() asm volatile("s_waitcnt vmcnt(0)" ::: "memory")
__device__ __forceinline__ unsigned long long rt() { return __builtin_amdgcn_s_memrealtime(); }
__device__ __forceinline__ unsigned f2bf(float f) { unsigned u = __builtin_bit_cast(unsigned, f); return (u + 0x7fffu + ((u >> 16) & 1u)) >> 16; }
__device__ __forceinline__ unsigned pk2(float lo, float hi) { return f2bf(lo) | (f2bf(hi) << 16); }

#define XB_TMO      128
#define XB_XCNT(j)  (256  + 64 * (j))
#define XB_XSUB(j)  (1280 + 64 * (j))
#define XB_XGEN(j)  (2304 + 64 * (j))
#define XB_TOP      3328
#define XB_TOPGEN   3392
#define XCD_BAR_WORDS 3456
#define XB_SPIN_CAP (1u << 18)

__device__ __forceinline__ unsigned xb_ld(unsigned* p)              { return __hip_atomic_load(p, __ATOMIC_RELAXED, __HIP_MEMORY_SCOPE_AGENT); }
__device__ __forceinline__ unsigned xb_add(unsigned* p, unsigned v) { return __hip_atomic_fetch_add(p, v, __ATOMIC_RELAXED, __HIP_MEMORY_SCOPE_AGENT); }
__device__ __forceinline__ unsigned xb_xcc_id() { return (unsigned)__builtin_amdgcn_s_getreg((3 << 11) | 20) & 0xFu; }
#define XB_SPIN(cond, bar) do { unsigned _sp = 0; while (cond) { __builtin_amdgcn_s_sleep(1); \
    if ((++_sp & 255u) == 0u) { if (xb_ld(&(bar)[XB_TMO])) break; if (_sp > XB_SPIN_CAP) { atomicAdd(&(bar)[XB_TMO], 1u); break; } } } } while (0)

struct XcdBarrier {
    unsigned* bar; unsigned x;
    volatile LAS unsigned* st;
};

__device__ __forceinline__ XcdBarrier xcd_barrier_post(unsigned* bar, volatile LAS unsigned* st) {
    XcdBarrier b; b.bar = bar; b.x = xb_xcc_id(); b.st = st;
    if (threadIdx.x == 0) (void)xb_add(&bar[XB_XCNT(b.x)], 1u);
    return b;
}
__device__ __forceinline__ void xcd_barrier_complete(unsigned* bar, unsigned x, unsigned& nloc, unsigned& nx) {
    const unsigned G = gridDim.x * gridDim.y * gridDim.z;
    unsigned sum, cnt, mine, sp = 0u;
    for (;;) {
        sum = 0u; cnt = 0u; mine = 0u;
#pragma unroll
        for (unsigned j = 0; j < 16; ++j) { const unsigned c = xb_ld(&bar[XB_XCNT(j)]); sum += c; cnt += (c > 0u) ? 1u : 0u; mine = (j == x) ? c : mine; }
        if (sum == G) break;
        __builtin_amdgcn_s_sleep(1);
        if ((++sp & 255u) == 0u) { if (xb_ld(&bar[XB_TMO])) break; if (sp > XB_SPIN_CAP) { atomicAdd(&bar[XB_TMO], 1u); break; } }
    }
    nloc = mine > 0u ? mine : 1u; nx = cnt > 0u ? cnt : 1u;
}

__device__ __forceinline__ void xcd_barrier(const XcdBarrier& b) {
    asm volatile("s_waitcnt vmcnt(0)" ::: "memory");
    __syncthreads();
    if (threadIdx.x == 0) {
        unsigned* bar = b.bar;
        __builtin_amdgcn_s_waitcnt(0);
        unsigned nloc = b.st[0], nx = b.st[1];
        if (nloc == 0u) { xcd_barrier_complete(bar, b.x, nloc, nx); b.st[0] = nloc; b.st[1] = nx; }
        const unsigned old = xb_add(&bar[XB_XSUB(b.x)], 1u);
        const unsigned gen = old / nloc;
        if (old + 1u == (gen + 1u) * nloc) {
            __builtin_amdgcn_fence(__ATOMIC_RELEASE, "agent");
            asm volatile("s_waitcnt vmcnt(0)" ::: "memory");
            const unsigned og = xb_add(&bar[XB_TOP], 1u);
            const unsigned tg = og / nx;
            if (og + 1u == (tg + 1u) * nx) xb_add(&bar[XB_TOPGEN], 1u);
            else XB_SPIN(xb_ld(&bar[XB_TOPGEN]) == tg, bar);
            __builtin_amdgcn_fence(__ATOMIC_ACQUIRE, "agent");
            xb_add(&bar[XB_XGEN(b.x)], 1u);
            asm volatile("s_waitcnt vmcnt(0)" ::: "memory");
        } else {
            XB_SPIN(xb_ld(&bar[XB_XGEN(b.x)]) == gen, bar);
            __builtin_amdgcn_fence(__ATOMIC_ACQUIRE, "agent");
            asm volatile("s_waitcnt vmcnt(0)" ::: "memory");
        }
    }
    __syncthreads();
}
constexpr int NWAVES = 8, NTHR = 512;
constexpr int SEQ = 8192, DM = 1024, MROWS = 16384;
constexpr size_t MiB = 1u << 20;
constexpr size_t WS_CTL = 0, CTL_ZERO_BYTES = 2 * MiB;
constexpr size_t WS_KSUM = 1 * MiB;
constexpr size_t WS_MOD = 2 * MiB;
constexpr size_t WS_ROPE = 3 * MiB;
constexpr size_t WS_WIN0 = 4 * MiB, WS_WOUT0 = 9 * MiB, WS_WIN1 = 11 * MiB, WS_WOUT1 = 17 * MiB, WS_WQ0 = 19 * MiB, WS_WQ1 = 23 * MiB;
constexpr size_t WS_SUBK = 27 * MiB, WS_GWS = 28 * MiB, WS_MASK = 29 * MiB, WS_SC = 30 * MiB;
constexpr size_t WS_PTU = 32 * MiB, WS_PTV = 96 * MiB;
constexpr size_t WS_HN = 160 * MiB;
constexpr size_t WS_A = 192 * MiB;
constexpr size_t WS_YCAT = 288 * MiB, WS_QP = 320 * MiB, WS_PO = 384 * MiB, WS_PL = 448 * MiB, WS_END = 450 * MiB;
constexpr int CW_BAR = 4096, CW_WORK = 16384;

constexpr int RING_BYTES = 131072, LDSCTL_OFF = RING_BYTES, MISC_OFF = LDSCTL_OFF + 320, LDS_BYTES = 147456;

#ifndef XCC_EXPR
#define XCC_EXPR ((int)(xb_xcc_id() & 7u))
#endif
#define DI __device__ __forceinline__
typedef short bf16x8 __attribute__((ext_vector_type(8)));
typedef short s16x4 __attribute__((ext_vector_type(4)));
typedef float f32x16 __attribute__((ext_vector_type(16)));
typedef __bf16 bf16x2t __attribute__((ext_vector_type(2)));
#define MFMA32(a, b, c) __builtin_amdgcn_mfma_f32_32x32x16_bf16((a), (b), (c), 0, 0, 0)
using pg8::cvtpk2; using pg8::gelu_tanh;
DI int crow(int reg, int h) { return (reg & 3) + 8 * (reg >> 2) + 4 * h; }
DI float bf_lo(unsigned w) { return __uint_as_float(w << 16); }
DI float bf_hi(unsigned w) { return __uint_as_float(w & 0xffff0000u); }
DI bf16x8 ld16g(const bf16* p) { return *(const bf16x8*)p; }
DI bf16x8 ld8x2g(const bf16* p0, const bf16* p1) { const s16x4 a = *(const s16x4*)p0, b = *(const s16x4*)p1; return __builtin_shufflevector(a, b, 0, 1, 2, 3, 4, 5, 6, 7); }
DI float dot2bf(unsigned a, unsigned b, float c) { return __builtin_amdgcn_fdot2_f32_bf16(__builtin_bit_cast(bf16x2t, a), __builtin_bit_cast(bf16x2t, b), c, false); }
DI int f_ord(float f) { int i = __float_as_int(f); return i ^ ((i >> 31) & 0x7fffffff); }
DI float f_unord(int i) { return __int_as_float(i ^ ((i >> 31) & 0x7fffffff)); }
constexpr float LOG2E = 1.4426950408889634f, LN2 = 0.6931471805599453f;
#define KEY_MIN ((int)0x80000000)


template <int CTRL> DI float dppf(float x) { return __builtin_bit_cast(float, __builtin_amdgcn_update_dpp(0, __builtin_bit_cast(int, x), CTRL, 0xF, 0xF, true)); }
template <int CTRL> DI int dppi(int x) { return __builtin_amdgcn_update_dpp(0, x, CTRL, 0xF, 0xF, true); }
#define DPP_X1 0xB1
#define DPP_X2 0x4E
#define DPP_HM 0x141
#define DPP_RM 0x140
#define DPP_R8 0x128
DI unsigned px32u(unsigned x, int lane) { auto r = __builtin_amdgcn_permlane32_swap(x, x, false, false); return (lane & 32) ? r[0] : r[1]; }
DI float px32(float x, int lane) { return __uint_as_float(px32u(__float_as_uint(x), lane)); }
DI int px32(int x, int lane) { return (int)px32u((unsigned)x, lane); }
DI unsigned px16u(unsigned x, int lane) { auto r = __builtin_amdgcn_permlane16_swap(x, x, false, false); return (lane & 16) ? r[0] : r[1]; }
DI float px16(float x, int lane) { return __uint_as_float(px16u(__float_as_uint(x), lane)); }
DI float sum32(float x) { auto r = __builtin_amdgcn_permlane32_swap(__float_as_uint(x), __float_as_uint(x), false, false); return __uint_as_float(r[0]) + __uint_as_float(r[1]); }
DI float sum16(float x) { auto r = __builtin_amdgcn_permlane16_swap(__float_as_uint(x), __float_as_uint(x), false, false); return __uint_as_float(r[0]) + __uint_as_float(r[1]); }
DI float row_sum16(float v) { v += dppf<DPP_X1>(v); v += dppf<DPP_X2>(v); v += dppf<DPP_HM>(v); v += dppf<DPP_RM>(v); return v; }
DI float wave_sum(float v) { return sum32(sum16(row_sum16(v))); }
DI float wave_max(float v) { v = fmaxf(v, dppf<DPP_X1>(v)); v = fmaxf(v, dppf<DPP_X2>(v)); v = fmaxf(v, dppf<DPP_HM>(v)); v = fmaxf(v, dppf<DPP_RM>(v));
    { auto r = __builtin_amdgcn_permlane16_swap(__float_as_uint(v), __float_as_uint(v), false, false); v = fmaxf(__uint_as_float(r[0]), __uint_as_float(r[1])); }
    { auto r = __builtin_amdgcn_permlane32_swap(__float_as_uint(v), __float_as_uint(v), false, false); v = fmaxf(__uint_as_float(r[0]), __uint_as_float(r[1])); } return v; }

struct Frame {
    LAS unsigned char* lds; volatile LAS unsigned* MISC; gu32* ctl; int tid, lane, wave, G, gw, NGW;
};

struct MapId { DI int operator()(int n) const { return n; } };
struct MapWin0 { DI int operator()(int n) const {
    if (n < 1024) return n;
    const int t = (n - 1024) >> 9, c = (n - 1024) & 511, hd = c >> 6, d = c & 63; int bj, p;
    if (t < 2) { if (d < 16) { const int nn = d >> 3, rr = d & 7; bj = 0; p = 8 * (rr >> 2) + 4 * nn + (rr & 3); } else if (d < 32) { bj = 0; p = d; } else { bj = 1; p = d - 32; } }
    else { bj = d >> 5; p = d & 31; }
    return 1024 + 512 * t + 256 * (hd >> 2) + 128 * bj + 32 * (hd & 3) + p; } };
struct MapWin1 { DI int operator()(int n) const { const int t = n >> 10, c = n & 1023, hd = c >> 6, d = c & 63; return 1024 * t + 256 * (hd >> 2) + 128 * (d >> 5) + 32 * (hd & 3) + (d & 31); } };
template <class Map> DI void p0_transpose_item(const float* W, int K, int N, bf16* WT, LAS float* scr, int item, int lane, Map map) {
    const int nblk = N / 32, kb = item / nblk, nb = item % nblk, k0 = 64 * kb, n0 = 32 * nb;
#pragma unroll 8
    for (int i = 0; i < 32; ++i) { const int kk = 2 * i + (lane >> 5); scr[kk * 33 + (lane & 31)] = W[(size_t)(k0 + kk) * N + n0 + (lane & 31)]; }
    LDS_WAIT(); asm volatile("" ::: "memory");
    const int c = lane & 7;
#pragma unroll
    for (int j = 0; j < 4; ++j) { const int n = (lane >> 3) + 8 * j; const LAS float* s = scr + (8 * c) * 33 + n;
        v4u o; o.x = pk2(s[0 * 33], s[1 * 33]); o.y = pk2(s[2 * 33], s[3 * 33]); o.z = pk2(s[4 * 33], s[5 * 33]); o.w = pk2(s[6 * 33], s[7 * 33]);
        *(GAS v4u*)(WT + (size_t)map(n0 + n) * K + k0 + 8 * c) = o; }
    LDS_WAIT(); asm volatile("" ::: "memory");
}
struct P0Args { const float *c, *w_mod, *b_mod, *win0, *wout0, *win1, *wout1, *wq, *subk, *pu, *pv, *gws;
                float *MOD, *ROPE; bf16 *WIN0, *WOUT0, *WIN1, *WOUT1, *WQ0, *WQ1, *SUBK, *GWS; unsigned char *U8, *V8s; float *USC, *VSC; };
DI void p0_prologue(const Frame& F, const P0Args& A) {
    { LAS float* scr = (LAS float*)F.lds;
      for (int task = blockIdx.x; task < 192; task += F.G) {
          const int l = task / 96, n0 = (task % 96) * 64; const float* W = A.w_mod + (size_t)l * 1024 * 6144;
          float a0 = 0.f, a1 = 0.f; const int k0 = F.wave * 128;
#pragma unroll 8
          for (int k = k0; k < k0 + 128; ++k) { const float c0 = A.c[k], c1 = A.c[1024 + k]; const float s0 = c0 / (1.f + __expf(-c0)), s1 = c1 / (1.f + __expf(-c1));
              const float w = W[(size_t)k * 6144 + n0 + F.lane]; a0 += s0 * w; a1 += s1 * w; }
          scr[(F.wave * 2 + 0) * 64 + F.lane] = a0; scr[(F.wave * 2 + 1) * 64 + F.lane] = a1;
          __syncthreads();
          if (F.tid < 128) { const int b = F.tid >> 6, n = F.tid & 63; float s = 0.f;
#pragma unroll
              for (int w = 0; w < 8; ++w) s += scr[(w * 2 + b) * 64 + n];
              A.MOD[(size_t)(l * 2 + b) * 6144 + n0 + n] = s + A.b_mod[l * 6144 + n0 + n]; }
          __syncthreads();
      } }
    { LAS float* scr = (LAS float*)(F.lds + F.wave * 16384);
      constexpr int I0 = 16 * 80, I1 = 16 * 32, I2 = 16 * 96, I3 = 16 * 32, I4 = 16 * 64, I5 = 16 * 64, NIT = I0 + I1 + I2 + I3 + I4 + I5;
      for (int it = F.gw; it < NIT; it += F.NGW) { int r = it;
          if (r < I0) { p0_transpose_item(A.win0, 1024, 2560, A.WIN0, scr, r, F.lane, MapId()); continue; } r -= I0;
          if (r < I1) { p0_transpose_item(A.wout0, 1024, 1024, A.WOUT0, scr, r, F.lane, MapId()); continue; } r -= I1;
          if (r < I2) { p0_transpose_item(A.win1, 1024, 3072, A.WIN1, scr, r, F.lane, MapId()); continue; } r -= I2;
          if (r < I3) { p0_transpose_item(A.wout1, 1024, 1024, A.WOUT1, scr, r, F.lane, MapId()); continue; } r -= I3;
          if (r < I4) { p0_transpose_item(A.wq, 1024, 2048, A.WQ0, scr, r, F.lane, MapId()); continue; } r -= I4;
          p0_transpose_item(A.wq + (size_t)1024 * 2048, 1024, 2048, A.WQ1, scr, r, F.lane, MapId()); } }
    for (int row = F.gw; row < 65536; row += F.NGW) { const bool isv = row >= 32768; const int rr = row & 32767;
        const float* src = (isv ? A.pv : A.pu) + (size_t)rr * 1024; f32x4 v[4]; float mx = 0.f;
#pragma unroll
        for (int k = 0; k < 4; ++k) { v[k] = *(const f32x4*)(src + 4 * F.lane + 256 * k); mx = fmaxf(mx, fmaxf(fmaxf(fabsf(v[k][0]), fabsf(v[k][1])), fmaxf(fabsf(v[k][2]), fabsf(v[k][3])))); }
        mx = wave_max(mx);
        const float top = isv ? 384.0f : 127.0f; const float sc = mx > 0.f ? top / mx : 1.0f, inv = mx > 0.f ? mx / top : 1.0f;
#pragma unroll
        for (int k = 0; k < 4; ++k) {
            if (!isv) { const int q0 = __float2int_rn(v[k][0] * sc), q1 = __float2int_rn(v[k][1] * sc), q2 = __float2int_rn(v[k][2] * sc), q3 = __float2int_rn(v[k][3] * sc);
                *(unsigned*)(A.U8 + (size_t)rr * 1024 + 4 * F.lane + 256 * k) = (unsigned)(q0 & 255) | ((unsigned)(q1 & 255) << 8) | ((unsigned)(q2 & 255) << 16) | ((unsigned)(q3 & 255) << 24); }
            else { int w = 0; w = __builtin_amdgcn_cvt_pk_fp8_f32(v[k][0] * sc, v[k][1] * sc, w, false); w = __builtin_amdgcn_cvt_pk_fp8_f32(v[k][2] * sc, v[k][3] * sc, w, true);
                const int l = rr >> 14, e = rr & 16383, slab = 2 * k + (F.lane >> 5); *(unsigned*)(A.V8s + (((size_t)l * 8 + slab) * 16384 + e) * 128 + 4 * (F.lane & 31)) = (unsigned)w; } }
        if (F.lane == 0) (isv ? A.VSC : A.USC)[rr] = inv; }
    { const size_t gt = (size_t)F.gw * 64 + F.lane, NT = (size_t)F.NGW * 64;
      for (size_t i = gt; i < 524288 / 8; i += NT) { const float* src = A.subk + i * 8; const f32x4 a = *(const f32x4*)src, b = *(const f32x4*)(src + 4); v4u o; o.x = cvtpk2(a[0], a[1]); o.y = cvtpk2(a[2], a[3]); o.z = cvtpk2(b[0], b[1]); o.w = cvtpk2(b[2], b[3]);
          *(v4u*)(A.SUBK + i * 8) = o; }
      for (size_t i = gt; i < 65536; i += NT) { const int t = (int)(i >> 7) & 127, s = (int)i & 127; A.GWS[i] = (bf16)(cvtpk2(s <= t ? A.gws[i] : 0.f, 0.f) & 0xffffu); }
      for (size_t i = gt; i < 65536; i += NT) { const int pos = (int)(i >> 3), fi = (int)i & 7; const float inv = powf(500000.0f, -(float)fi / 8.0f); const float ang = (float)pos * inv; float sn, cs; sincosf(ang, &sn, &cs);
          A.ROPE[(size_t)pos * 16 + fi] = cs; A.ROPE[(size_t)pos * 16 + 8 + fi] = sn; } }
}

DI void norm_rows(const Frame& F, const float* xs, const float* gamma, const float* modl, int shi, int sci, bf16* HN, unsigned char* HQ = nullptr, float* HS = nullptr) {
    for (int m = F.gw; m < MROWS; m += F.NGW) { const int b = m >> 13;
        const f32x4* xr = (const f32x4*)(xs + (size_t)m * 1024) + F.lane; f32x4 v[4]; float s = 0.f;
#pragma unroll
        for (int j = 0; j < 4; ++j) { v[j] = xr[64 * j]; s += (v[j][0] * v[j][0] + v[j][1] * v[j][1]) + (v[j][2] * v[j][2] + v[j][3] * v[j][3]); }
        const float rinv = rsqrtf(wave_sum(s) * (1.0f / 1024.0f) + 1e-6f);
        unsigned long long* o8 = (unsigned long long*)(HN + (size_t)m * 1024) + F.lane; float mx = 0.f;
#pragma unroll
        for (int j = 0; j < 4; ++j) { const int col = 4 * F.lane + 256 * j; const f32x4 gm = *(const f32x4*)(gamma + col), sc = *(const f32x4*)(modl + b * 6144 + sci * 1024 + col), sh = *(const f32x4*)(modl + b * 6144 + shi * 1024 + col);
            const f32x4 o = v[j] * rinv * gm * (sc + 1.0f) + sh; v[j] = o; mx = fmaxf(mx, fmaxf(fmaxf(fabsf(o[0]), fabsf(o[1])), fmaxf(fabsf(o[2]), fabsf(o[3]))));
            o8[64 * j] = (unsigned long long)cvtpk2(o[0], o[1]) | ((unsigned long long)cvtpk2(o[2], o[3]) << 32); }
        if (HQ) { mx = wave_max(mx); const float qs = mx > 0.f ? 127.0f / mx : 1.0f;
#pragma unroll
            for (int j = 0; j < 4; ++j) { const int q0 = __float2int_rn(v[j][0] * qs), q1 = __float2int_rn(v[j][1] * qs), q2 = __float2int_rn(v[j][2] * qs), q3 = __float2int_rn(v[j][3] * qs);
                *(unsigned*)(HQ + (size_t)m * 1024 + 4 * F.lane + 256 * j) = (unsigned)(q0 & 255) | ((unsigned)(q1 & 255) << 8) | ((unsigned)(q2 & 255) << 16) | ((unsigned)(q3 & 255) << 24); }
            if (F.lane == 0) HS[m] = mx > 0.f ? mx * (1.0f / 127.0f) : 1.0f; }
    }
}

DI void qk_post_task(int task, const bf16* QKR, bf16* Q0, bf16* K0, float* KSUM, const float* rope, const float* gq, const float* gk, LAS float* scr, int tid, int wave, int lane) {
    const int tb = task >> 2, cq = task & 3; const bool isk = cq >= 2; const int head0 = (cq & 1) * 4, hl = (lane >> 2) & 3, qt = lane & 3, rsub = lane >> 4;
    const float* g = (isk ? gk : gq) + qt * 16; float gv[16];
#pragma unroll
    for (int i = 0; i < 16; ++i) gv[i] = g[i];
    float ks[16];
#pragma unroll
    for (int i = 0; i < 16; ++i) ks[i] = 0.f;
    const int b = tb >> 5; bf16* dstb = (isk ? K0 : Q0) + (size_t)(b * 8 + head0 + hl) * SEQ * 64 + qt * 16;
    for (int it = 0; it < 8; ++it) { const int row = tb * 256 + wave * 32 + it * 4 + rsub, s = row & (SEQ - 1);
        const bf16* src = QKR + (size_t)row * 1024 + cq * 256 + hl * 64 + qt * 16; const v4u w0 = *(const v4u*)src, w1 = *(const v4u*)(src + 8);
        float y[16]; y[0] = bf_lo(w0.x); y[1] = bf_hi(w0.x); y[2] = bf_lo(w0.y); y[3] = bf_hi(w0.y); y[4] = bf_lo(w0.z); y[5] = bf_hi(w0.z); y[6] = bf_lo(w0.w); y[7] = bf_hi(w0.w);
        y[8] = bf_lo(w1.x); y[9] = bf_hi(w1.x); y[10] = bf_lo(w1.y); y[11] = bf_hi(w1.y); y[12] = bf_lo(w1.z); y[13] = bf_hi(w1.z); y[14] = bf_lo(w1.w); y[15] = bf_hi(w1.w);
        float ss = 0.f;
#pragma unroll
        for (int i = 0; i < 16; ++i) ss += y[i] * y[i];
        ss += dppf<DPP_X1>(ss); ss += dppf<DPP_X2>(ss);
        const float rinv = rsqrtf(ss * (1.0f / 64.0f) + 1e-6f);
#pragma unroll
        for (int i = 0; i < 16; ++i) y[i] = y[i] * rinv * gv[i];
        if (qt == 0) { const float* rp = rope + (size_t)s * 16;
#pragma unroll
            for (int i = 0; i < 8; ++i) { const float c = rp[i], sn = rp[8 + i], x1 = y[i], x2 = y[i + 8]; y[i] = x1 * c - x2 * sn; y[i + 8] = x1 * sn + x2 * c; } }
        v4u o0, o1; o0.x = cvtpk2(y[0], y[1]); o0.y = cvtpk2(y[2], y[3]); o0.z = cvtpk2(y[4], y[5]); o0.w = cvtpk2(y[6], y[7]); o1.x = cvtpk2(y[8], y[9]); o1.y = cvtpk2(y[10], y[11]); o1.z = cvtpk2(y[12], y[13]); o1.w = cvtpk2(y[14], y[15]);
        bf16* d = dstb + (size_t)s * 64; *(v4u*)d = o0; *(v4u*)(d + 8) = o1;
#pragma unroll
        for (int i = 0; i < 16; ++i) ks[i] += y[i];
    }
    if (isk) {
#pragma unroll
        for (int i = 0; i < 16; ++i) { ks[i] = sum32(sum16(ks[i])); }
        if (lane < 16) {
#pragma unroll
            for (int i = 0; i < 16; ++i) scr[(wave * 16 + lane) * 16 + i] = ks[i]; }
        __syncthreads();
        if (tid < 256) { const int l16 = tid >> 4, i = tid & 15; float sum = 0.f;
#pragma unroll
            for (int w = 0; w < 8; ++w) sum += scr[(w * 16 + l16) * 16 + i];
            KSUM[((size_t)(b * 8 + head0 + (l16 >> 2)) * 32 + (tb & 31)) * 64 + (l16 & 3) * 16 + i] = sum; }
        __syncthreads();
    }
}

DI f32x16 qk_tile(const bf16* krow, const bf16x8 (&qf)[4]) {
    f32x16 s;
#pragma unroll
    for (int i = 0; i < 16; ++i) s[i] = 0.f;
#pragma unroll
    for (int ks = 0; ks < 4; ++ks) s = MFMA32(ld16g(krow + 16 * ks), qf[ks], s);
    return s;
}
DI bf16x8 pack8(const f32x16& x, int s) { v4u p; p.x = cvtpk2(x[8 * s], x[8 * s + 1]); p.y = cvtpk2(x[8 * s + 2], x[8 * s + 3]); p.z = cvtpk2(x[8 * s + 4], x[8 * s + 5]); p.w = cvtpk2(x[8 * s + 6], x[8 * s + 7]); return __builtin_bit_cast(bf16x8, p); }
DI void pv_tile(f32x16 (&o)[2], const bf16* vt, const f32x16& p) {
#pragma unroll
    for (int s = 0; s < 2; ++s) { const bf16x8 pb = pack8(p, s);
#pragma unroll
        for (int mt = 0; mt < 2; ++mt) { const bf16* v = vt + (size_t)mt * 32 * SEQ + 16 * s; o[mt] = MFMA32(ld8x2g(v, v + 8), pb, o[mt]); } }
}
DI void store_ot(bf16* dst, const f32x16 (&o)[2], float sc, int h) {
#pragma unroll
    for (int mt = 0; mt < 2; ++mt)
#pragma unroll
        for (int g = 0; g < 4; ++g) { const unsigned lo = cvtpk2(o[mt][4 * g] * sc, o[mt][4 * g + 1] * sc), hi = cvtpk2(o[mt][4 * g + 2] * sc, o[mt][4 * g + 3] * sc);
            *(unsigned long long*)(dst + 32 * mt + 8 * g + 4 * h) = (unsigned long long)lo | ((unsigned long long)hi << 32); }
}
DI void moba_keys(const bf16* Kh, const bf16* VTh, const bf16x8 (&qf)[4], int key0, int nt, int diag, float mc2, f32x16 (&o)[2], float& l, int r, int h) {
    for (int kt = 0; kt < nt; ++kt) { const int kb = key0 + 32 * kt;
        f32x16 s = qk_tile(Kh + (size_t)(kb + r) * 64 + 8 * h, qf);
        float ls = 0.f;
#pragma unroll
        for (int i = 0; i < 16; ++i) { float p = __builtin_amdgcn_exp2f(s[i] * (0.125f * LOG2E) - mc2); if (kt == diag && crow(i, h) > r) p = 0.f; s[i] = p; ls += p; }
        l += ls;
        pv_tile(o, VTh + (size_t)r * SEQ + kb + 4 * h, s);
    }
}
DI float moba_mc2(const float* gq, const float* gk, int lane) {
    float a = fabsf(gq[lane]), b = fabsf(gk[lane]);
    a = wave_max(a); b = wave_max(b);
    return 8.0f * a * b * LOG2E;
}
struct MobaT { const bf16 *Q, *K, *VT; const float* ksum; unsigned* masks; bf16* PO; float* PL; const float *gq, *gk; };
DI void moba_mask_unit(int u, const MobaT& T, int lane) {
    const int bh = u >> 8, t0 = (u & 255) * 32, own = t0 >> 8, r = lane & 31, h = lane >> 5;
    unsigned mask = 0u;
    if (own > 0) {
        f32x16 g;
#pragma unroll
        for (int i = 0; i < 16; ++i) g[i] = 0.f;
        const float* km = T.ksum + ((size_t)bh * 32 + r) * 64 + 8 * h; const bf16* qp = T.Q + ((size_t)bh * SEQ + t0 + r) * 64 + 8 * h;
#pragma unroll
        for (int ks = 0; ks < 4; ++ks) { const f32x4 a0 = *(const f32x4*)(km + 16 * ks) * (1.0f / 256.0f), a1 = *(const f32x4*)(km + 16 * ks + 4) * (1.0f / 256.0f);
            v4u aw; aw.x = cvtpk2(a0[0], a0[1]); aw.y = cvtpk2(a0[2], a0[3]); aw.z = cvtpk2(a1[0], a1[1]); aw.w = cvtpk2(a1[2], a1[3]);
            g = MFMA32(__builtin_bit_cast(bf16x8, aw), ld16g(qp + 16 * ks), g); }
        int ka = KEY_MIN, kb2 = KEY_MIN, kc = KEY_MIN;
#define INS3(x_) do { int x = (x_); int t = min(ka, x); ka = max(ka, x); int uu = min(kb2, t); kb2 = max(kb2, t); kc = max(kc, uu); } while (0)
#pragma unroll
        for (int i = 0; i < 16; ++i) { const int blk = crow(i, h); const int key = (blk < own) ? ((f_ord(g[i]) & ~31) | (31 - blk)) : KEY_MIN; INS3(key); }
        const int pa = px32(ka, lane), pb = px32(kb2, lane), pc = px32(kc, lane);
        INS3(pa); INS3(pb); INS3(pc);
#undef INS3
        if (ka != KEY_MIN) mask |= 1u << (31 - (ka & 31));
        if (kb2 != KEY_MIN) mask |= 1u << (31 - (kb2 & 31));
        if (kc != KEY_MIN) mask |= 1u << (31 - (kc & 31));
    }
    if (h == 0) T.masks[(size_t)bh * SEQ + t0 + r] = mask;
}
DI void moba_own_unit(int u, const MobaT& T, float mc2, int lane) {
    const int bh = u >> 8, t0 = (u & 255) * 32, own = t0 >> 8, r = lane & 31, h = lane >> 5;
    const bf16* qp = T.Q + ((size_t)bh * SEQ + t0 + r) * 64 + 8 * h; bf16x8 qf[4];
#pragma unroll
    for (int ks = 0; ks < 4; ++ks) qf[ks] = ld16g(qp + 16 * ks);
    f32x16 o[2];
#pragma unroll
    for (int i = 0; i < 16; ++i) { o[0][i] = 0.f; o[1][i] = 0.f; }
    float l = 0.f; const int key0 = own * 256, nt = ((t0 - key0) >> 5) + 1;
    moba_keys(T.K + (size_t)bh * SEQ * 64, T.VT + (size_t)bh * 64 * SEQ, qf, key0, nt, nt - 1, mc2, o, l, r, h);
    l = sum32(l);
    const size_t base = ((size_t)bh * SEQ + t0 + r) * 4 + 3;
    store_ot(T.PO + base * 64, o, 1.0f, h); if (h == 0) T.PL[base] = l;
}
constexpr int MS_K = 0, MS_V = 32768, MS_VROW = 520, MS_LIST = 32768 + 64 * 520, MS_CNT = MS_LIST + 8192, MOBA_NTASK = 16 * 79;
DI void moba_sel_task(int task, const MobaT& T, LAS unsigned char* lds, float mc2, int tid, int wave, int lane) {
    int p, rem = task; if (rem < 128) p = 0; else if (rem < 384) { p = 1; rem -= 128; } else if (rem < 768) { p = 2; rem -= 384; } else { p = 3; rem -= 768; }
    const int j = rem >> 4, bh = rem & 15;
    LAS unsigned* list = (LAS unsigned*)(lds + MS_LIST); LAS unsigned* cntp = (LAS unsigned*)(lds + MS_CNT);
    { const bf16* Kg = T.K + ((size_t)bh * SEQ + 256 * j) * 64; const bf16* Vg = T.VT + (size_t)bh * 64 * SEQ + 256 * j;
      v4u kv[4], vv[4];
#pragma unroll
      for (int i = 0; i < 4; ++i) { const int c = tid + 512 * i; kv[i] = *(const v4u*)(Kg + (size_t)c * 8); const int d = c >> 5, cc = c & 31; vv[i] = *(const v4u*)(Vg + (size_t)d * SEQ + cc * 8); }
      if (tid == 0) *cntp = 0u;
#pragma unroll
      for (int i = 0; i < 4; ++i) { const int c = tid + 512 * i; const int k = c >> 3, ch = c & 7; *(LAS v4u*)(lds + MS_K + k * 128 + ((ch ^ ((k >> 1) & 7)) << 4)) = kv[i];
          const int d = c >> 5, cc = c & 31; LAS unsigned char* vp = lds + MS_V + d * MS_VROW + cc * 16; *(LAS unsigned long long*)vp = (unsigned long long)vv[i].x | ((unsigned long long)vv[i].y << 32); *(LAS unsigned long long*)(vp + 8) = (unsigned long long)vv[i].z | ((unsigned long long)vv[i].w << 32); } }
    __syncthreads();
    { const int qlo = 256 * (8 * p + 1), qhi = (8 * p + 9) * 256 < SEQ ? (8 * p + 9) * 256 : SEQ;
      for (int t0 = qlo + wave * 64; t0 < qhi; t0 += 512) { const int t = t0 + lane; const unsigned mk = T.masks[(size_t)bh * SEQ + t]; const bool sel = (mk >> j) & 1u;
          const unsigned long long bal = __ballot(sel); const int nb = __builtin_popcountll(bal);
          unsigned base = 0; if (lane == 0 && nb) base = __hip_atomic_fetch_add(cntp, (unsigned)nb, __ATOMIC_RELAXED, __HIP_MEMORY_SCOPE_WORKGROUP); base = (unsigned)__builtin_amdgcn_readfirstlane((int)base);
          if (sel) list[base + __builtin_popcountll(bal & ((1ull << lane) - 1ull))] = (unsigned)t; } }
    __syncthreads();
    const int n = (int)*cntp; const int r = lane & 31, h = lane >> 5;
    const LAS unsigned char* kb = lds + MS_K; const LAS unsigned char* vb = lds + MS_V;
    for (int b0 = wave * 32; b0 < n; b0 += 256) { const bool valid = b0 + r < n; const int t = (int)list[valid ? b0 + r : b0];
        const unsigned mk = T.masks[(size_t)bh * SEQ + t]; const int slot = __builtin_popcount(mk & ((1u << j) - 1u));
        const bf16* qp = T.Q + ((size_t)bh * SEQ + t) * 64 + 8 * h; bf16x8 qf[4];
#pragma unroll
        for (int ks = 0; ks < 4; ++ks) qf[ks] = ld16g(qp + 16 * ks);
        f32x16 o[2];
#pragma unroll
        for (int i = 0; i < 16; ++i) { o[0][i] = 0.f; o[1][i] = 0.f; }
        float l = 0.f;
#pragma unroll 2
        for (int kt = 0; kt < 8; ++kt) { const int key = 32 * kt + r;
            f32x16 s;
#pragma unroll
            for (int i = 0; i < 16; ++i) s[i] = 0.f;
#pragma unroll
            for (int ks = 0; ks < 4; ++ks) s = MFMA32(*(const LAS bf16x8*)(kb + key * 128 + (((2 * ks + h) ^ ((key >> 1) & 7)) << 4)), qf[ks], s);
            float ls = 0.f;
#pragma unroll
            for (int i = 0; i < 16; ++i) { const float pv = __builtin_amdgcn_exp2f(s[i] * (0.125f * LOG2E) - mc2); s[i] = pv; ls += pv; }
            l += ls;
#pragma unroll
            for (int sx = 0; sx < 2; ++sx) { const bf16x8 pb = pack8(s, sx);
#pragma unroll
                for (int mt = 0; mt < 2; ++mt) { const LAS unsigned char* vp = vb + (32 * mt + r) * MS_VROW + (32 * kt + 16 * sx + 4 * h) * 2;
                    const s16x4 a0 = *(const LAS s16x4*)vp, a1 = *(const LAS s16x4*)(vp + 16); o[mt] = MFMA32(__builtin_shufflevector(a0, a1, 0, 1, 2, 3, 4, 5, 6, 7), pb, o[mt]); } }
        }
        l = sum32(l);
        if (valid) { const size_t base = ((size_t)bh * SEQ + t) * 4 + slot; store_ot(T.PO + base * 64, o, 1.0f, h); if (h == 0) T.PL[base] = l; }
    }
    __syncthreads();
}
DI void moba_combine(const Frame& F, const bf16* PO, const float* PL, bf16* YCAT) {
    const size_t gt = (size_t)F.gw * 64 + F.lane, NT = (size_t)F.NGW * 64;
    for (size_t i = gt; i < (size_t)16 * SEQ * 8; i += NT) { const int dq = (int)i & 7, t = (int)(i >> 3) & (SEQ - 1), bh = (int)(i >> 16); const int own = t >> 8, ns = own < 3 ? own : 3;
        float o[8]; float l = 0.f;
#pragma unroll
        for (int k = 0; k < 8; ++k) o[k] = 0.f;
#pragma unroll
        for (int s = 0; s < 4; ++s) { if (s < ns || s == 3) { const size_t base = ((size_t)bh * SEQ + t) * 4 + s; l += PL[base]; const v4u w = *(const v4u*)(PO + base * 64 + dq * 8);
                o[0] += bf_lo(w.x); o[1] += bf_hi(w.x); o[2] += bf_lo(w.y); o[3] += bf_hi(w.y); o[4] += bf_lo(w.z); o[5] += bf_hi(w.z); o[6] += bf_lo(w.w); o[7] += bf_hi(w.w); } }
        const float il = 1.0f / l; v4u w; w.x = cvtpk2(o[0] * il, o[1] * il); w.y = cvtpk2(o[2] * il, o[3] * il); w.z = cvtpk2(o[4] * il, o[5] * il); w.w = cvtpk2(o[6] * il, o[7] * il);
        *(v4u*)(YCAT + ((size_t)(bh >> 3) * SEQ + t) * 1024 + 512 + (bh & 7) * 64 + dq * 8) = w; }
}

DI void gmlp_unit(int unit, const bf16* UA, const bf16* VA, const float* vgain, const bf16* GWS, const float* bs, bf16* YCAT, LAS unsigned char* lds, int tid, int wave, int lane) {
    const int cidx = unit >> 2, g = unit & 3, row0 = cidx * 128; LAS bf16* VNT = (LAS bf16*)lds;
    { const int row = tid >> 2, dq = (tid & 3) * 32; const bf16* src = VA + (size_t)(row0 + row) * 512 + g * 128 + dq;
      float f[32]; float ss = 0.f;
#pragma unroll
      for (int k = 0; k < 4; ++k) { const v4u w = *(const v4u*)(src + 8 * k); f[8 * k] = bf_lo(w.x); f[8 * k + 1] = bf_hi(w.x); f[8 * k + 2] = bf_lo(w.y); f[8 * k + 3] = bf_hi(w.y); f[8 * k + 4] = bf_lo(w.z); f[8 * k + 5] = bf_hi(w.z); f[8 * k + 6] = bf_lo(w.w); f[8 * k + 7] = bf_hi(w.w); }
#pragma unroll
      for (int k = 0; k < 32; ++k) ss += f[k] * f[k];
      ss += dppf<DPP_X1>(ss); ss += dppf<DPP_X2>(ss);
      const float rinv = rsqrtf(ss * (1.0f / 128.0f) + 1e-6f);
#pragma unroll
      for (int k = 0; k < 32; ++k) VNT[(dq + k) * 136 + row] = (bf16)(cvtpk2(f[k] * rinv * vgain[g * 128 + dq + k], 0.f) & 0xffffu); }
    __syncthreads();
    { const int mt = wave >> 1, ntb = (wave & 1) * 2, r = lane & 31, h = lane >> 5;
      f32x16 acc[2];
#pragma unroll
      for (int i = 0; i < 16; ++i) { acc[0][i] = 0.f; acc[1][i] = 0.f; }
      const bf16* wp = GWS + ((size_t)g * 128 + 32 * mt + r) * 128 + 8 * h;
      for (int ks = 0; ks < 2 * (mt + 1); ++ks) { const bf16x8 a = ld16g(wp + 16 * ks);
#pragma unroll
          for (int nn = 0; nn < 2; ++nn) { const bf16x8 b = *(const LAS bf16x8*)(VNT + (32 * (ntb + nn) + r) * 136 + 16 * ks + 8 * h); acc[nn] = MFMA32(a, b, acc[nn]); } }
#pragma unroll
      for (int nn = 0; nn < 2; ++nn)
#pragma unroll
          for (int i = 0; i < 16; ++i) { const int t = 32 * mt + crow(i, h), d = 32 * (ntb + nn) + r; const float mixed = acc[nn][i] + bs[g * 128 + t];
              const float uv = __uint_as_float((unsigned)UA[(size_t)(row0 + t) * 512 + g * 128 + d] << 16);
              YCAT[(size_t)(row0 + t) * 1024 + g * 128 + d] = (bf16)(cvtpk2(uv * mixed, 0.f) & 0xffffu); } }
    __syncthreads();
}

DI void sb_unit(int u, const bf16* Q, const bf16* K, const bf16* VT, bf16* YCAT, int lane) {
    const int bh = u >> 8, t0 = (u & 255) * 32, r = lane & 31, h = lane >> 5;
    const bf16* qp = Q + ((size_t)bh * SEQ + t0 + r) * 64 + 8 * h; bf16x8 qf[4];
#pragma unroll
    for (int ks = 0; ks < 4; ++ks) qf[ks] = ld16g(qp + 16 * ks);
    const bf16* Kh = K + (size_t)bh * SEQ * 64; const bf16* VTh = VT + (size_t)bh * 64 * SEQ;
    f32x16 o[2];
#pragma unroll
    for (int i = 0; i < 16; ++i) { o[0][i] = 0.f; o[1][i] = 0.f; }
    float R = 0.f;
    for (int kb = t0; kb >= 0; kb -= 32) {
        f32x16 s = qk_tile(Kh + (size_t)(kb + r) * 64 + 8 * h, qf);
        const bool diag = (kb == t0);
        f32x16 x;
#pragma unroll
        for (int i = 0; i < 16; ++i) { const float z = s[i] * 0.125f; const float t = __builtin_amdgcn_exp2f(-fabsf(z) * LOG2E); const float sp = fmaxf(z, 0.f) + LN2 * __builtin_amdgcn_logf(1.0f + t);
            const bool valid = !(diag && crow(i, h) >= r); x[i] = valid ? -sp : 0.f; s[i] = valid ? z : -INFINITY; }
        float T4[4], E[16];
#pragma unroll
        for (int g = 0; g < 4; ++g) { E[4 * g + 3] = 0.f; E[4 * g + 2] = x[4 * g + 3]; E[4 * g + 1] = E[4 * g + 2] + x[4 * g + 2]; E[4 * g] = E[4 * g + 1] + x[4 * g + 1]; T4[g] = E[4 * g] + x[4 * g]; }
        float P4[4];
#pragma unroll
        for (int g = 0; g < 4; ++g) P4[g] = px32(T4[g], lane);
        float C[4]; float run = 0.f;
#pragma unroll
        for (int g = 3; g >= 0; --g) { C[g] = run + (h == 0 ? P4[g] : 0.f); run += T4[g] + P4[g]; }
#pragma unroll
        for (int i = 0; i < 16; ++i) { const float arg = x[i] + s[i] + (R + C[i >> 2] + E[i]); x[i] = __builtin_amdgcn_exp2f(arg * LOG2E); }
        pv_tile(o, VTh + (size_t)r * SEQ + kb + 4 * h, x);
        R += run;
        if (!__any(R >= -104.0f)) break;
    }
    store_ot(YCAT + ((size_t)(bh >> 4) * SEQ + t0 + r) * 1024 + (bh & 15) * 64, o, 1.0f, h);
}

#define CE_(a, b) do { const int hi_ = max((a), (b)); (b) = min((a), (b)); (a) = hi_; } while (0)
DI void sort16_desc(int (&v)[16]) {
    CE_(v[0], v[1]); CE_(v[2], v[3]); CE_(v[0], v[2]); CE_(v[1], v[3]); CE_(v[1], v[2]); CE_(v[4], v[5]); CE_(v[6], v[7]); CE_(v[4], v[6]); CE_(v[5], v[7]);
    CE_(v[5], v[6]); CE_(v[0], v[4]); CE_(v[2], v[6]); CE_(v[2], v[4]); CE_(v[1], v[5]); CE_(v[3], v[7]); CE_(v[3], v[5]); CE_(v[1], v[2]); CE_(v[3], v[4]);
    CE_(v[5], v[6]); CE_(v[8], v[9]); CE_(v[10], v[11]); CE_(v[8], v[10]); CE_(v[9], v[11]); CE_(v[9], v[10]); CE_(v[12], v[13]); CE_(v[14], v[15]); CE_(v[12], v[14]);
    CE_(v[13], v[15]); CE_(v[13], v[14]); CE_(v[8], v[12]); CE_(v[10], v[14]); CE_(v[10], v[12]); CE_(v[9], v[13]); CE_(v[11], v[15]); CE_(v[11], v[13]);
    CE_(v[9], v[10]); CE_(v[11], v[12]); CE_(v[13], v[14]); CE_(v[0], v[8]); CE_(v[4], v[12]); CE_(v[4], v[8]); CE_(v[2], v[10]); CE_(v[6], v[14]); CE_(v[6], v[10]);
    CE_(v[2], v[4]); CE_(v[6], v[8]); CE_(v[10], v[12]); CE_(v[1], v[9]); CE_(v[5], v[13]); CE_(v[5], v[9]); CE_(v[3], v[11]); CE_(v[7], v[15]); CE_(v[7], v[11]);
    CE_(v[3], v[5]); CE_(v[7], v[9]); CE_(v[11], v[13]); CE_(v[1], v[2]); CE_(v[3], v[4]); CE_(v[5], v[6]); CE_(v[7], v[8]); CE_(v[9], v[10]); CE_(v[11], v[12]);
    CE_(v[13], v[14]);
}
DI void merge16_desc(int (&A)[16], const int (&B)[16]) {
#pragma unroll
    for (int i = 0; i < 16; ++i) A[i] = max(A[i], B[15 - i]);
    CE_(A[0], A[8]); CE_(A[1], A[9]); CE_(A[2], A[10]); CE_(A[3], A[11]); CE_(A[4], A[12]); CE_(A[5], A[13]); CE_(A[6], A[14]); CE_(A[7], A[15]); CE_(A[0], A[4]);
    CE_(A[1], A[5]); CE_(A[2], A[6]); CE_(A[3], A[7]); CE_(A[8], A[12]); CE_(A[9], A[13]); CE_(A[10], A[14]); CE_(A[11], A[15]); CE_(A[0], A[2]); CE_(A[1], A[3]);
    CE_(A[4], A[6]); CE_(A[5], A[7]); CE_(A[8], A[10]); CE_(A[9], A[11]); CE_(A[12], A[14]); CE_(A[13], A[15]); CE_(A[0], A[1]); CE_(A[2], A[3]); CE_(A[4], A[5]);
    CE_(A[6], A[7]); CE_(A[8], A[9]); CE_(A[10], A[11]); CE_(A[12], A[13]); CE_(A[14], A[15]);
}
#define PEER_CAND_CHUNK(C_, c_) do { \
    if ((c_) == 0) { C_[0] = (f_ord(s1[0] + s2[0]) & ~0x3fff) | a1[0] | a2[0]; C_[1] = (f_ord(s1[0] + s2[1]) & ~0x3fff) | a1[0] | a2[1]; C_[2] = (f_ord(s1[0] + s2[2]) & ~0x3fff) | a1[0] | a2[2]; C_[3] = (f_ord(s1[0] + s2[3]) & ~0x3fff) | a1[0] | a2[3]; C_[4] = (f_ord(s1[0] + s2[4]) & ~0x3fff) | a1[0] | a2[4]; C_[5] = (f_ord(s1[0] + s2[5]) & ~0x3fff) | a1[0] | a2[5]; C_[6] = (f_ord(s1[0] + s2[6]) & ~0x3fff) | a1[0] | a2[6]; C_[7] = (f_ord(s1[0] + s2[7]) & ~0x3fff) | a1[0] | a2[7]; C_[8] = (f_ord(s1[0] + s2[8]) & ~0x3fff) | a1[0] | a2[8]; C_[9] = (f_ord(s1[0] + s2[9]) & ~0x3fff) | a1[0] | a2[9]; C_[10] = (f_ord(s1[0] + s2[10]) & ~0x3fff) | a1[0] | a2[10]; C_[11] = (f_ord(s1[0] + s2[11]) & ~0x3fff) | a1[0] | a2[11]; C_[12] = (f_ord(s1[0] + s2[12]) & ~0x3fff) | a1[0] | a2[12]; C_[13] = (f_ord(s1[0] + s2[13]) & ~0x3fff) | a1[0] | a2[13]; C_[14] = (f_ord(s1[0] + s2[14]) & ~0x3fff) | a1[0] | a2[14]; C_[15] = (f_ord(s1[0] + s2[15]) & ~0x3fff) | a1[0] | a2[15]; } \
    if ((c_) == 1) { C_[0] = (f_ord(s1[1] + s2[0]) & ~0x3fff) | a1[1] | a2[0]; C_[1] = (f_ord(s1[1] + s2[1]) & ~0x3fff) | a1[1] | a2[1]; C_[2] = (f_ord(s1[1] + s2[2]) & ~0x3fff) | a1[1] | a2[2]; C_[3] = (f_ord(s1[1] + s2[3]) & ~0x3fff) | a1[1] | a2[3]; C_[4] = (f_ord(s1[1] + s2[4]) & ~0x3fff) | a1[1] | a2[4]; C_[5] = (f_ord(s1[1] + s2[5]) & ~0x3fff) | a1[1] | a2[5]; C_[6] = (f_ord(s1[1] + s2[6]) & ~0x3fff) | a1[1] | a2[6]; C_[7] = (f_ord(s1[1] + s2[7]) & ~0x3fff) | a1[1] | a2[7]; C_[8] = (f_ord(s1[2] + s2[0]) & ~0x3fff) | a1[2] | a2[0]; C_[9] = (f_ord(s1[2] + s2[1]) & ~0x3fff) | a1[2] | a2[1]; C_[10] = (f_ord(s1[2] + s2[2]) & ~0x3fff) | a1[2] | a2[2]; C_[11] = (f_ord(s1[2] + s2[3]) & ~0x3fff) | a1[2] | a2[3]; C_[12] = (f_ord(s1[2] + s2[4]) & ~0x3fff) | a1[2] | a2[4]; C_[13] = (f_ord(s1[3] + s2[0]) & ~0x3fff) | a1[3] | a2[0]; C_[14] = (f_ord(s1[3] + s2[1]) & ~0x3fff) | a1[3] | a2[1]; C_[15] = (f_ord(s1[3] + s2[2]) & ~0x3fff) | a1[3] | a2[2]; } \
    if ((c_) == 2) { C_[0] = (f_ord(s1[3] + s2[3]) & ~0x3fff) | a1[3] | a2[3]; C_[1] = (f_ord(s1[4] + s2[0]) & ~0x3fff) | a1[4] | a2[0]; C_[2] = (f_ord(s1[4] + s2[1]) & ~0x3fff) | a1[4] | a2[1]; C_[3] = (f_ord(s1[4] + s2[2]) & ~0x3fff) | a1[4] | a2[2]; C_[4] = (f_ord(s1[5] + s2[0]) & ~0x3fff) | a1[5] | a2[0]; C_[5] = (f_ord(s1[5] + s2[1]) & ~0x3fff) | a1[5] | a2[1]; C_[6] = (f_ord(s1[6] + s2[0]) & ~0x3fff) | a1[6] | a2[0]; C_[7] = (f_ord(s1[6] + s2[1]) & ~0x3fff) | a1[6] | a2[1]; C_[8] = (f_ord(s1[7] + s2[0]) & ~0x3fff) | a1[7] | a2[0]; C_[9] = (f_ord(s1[7] + s2[1]) & ~0x3fff) | a1[7] | a2[1]; C_[10] = (f_ord(s1[8] + s2[0]) & ~0x3fff) | a1[8] | a2[0]; C_[11] = (f_ord(s1[9] + s2[0]) & ~0x3fff) | a1[9] | a2[0]; C_[12] = (f_ord(s1[10] + s2[0]) & ~0x3fff) | a1[10] | a2[0]; C_[13] = (f_ord(s1[11] + s2[0]) & ~0x3fff) | a1[11] | a2[0]; C_[14] = (f_ord(s1[12] + s2[0]) & ~0x3fff) | a1[12] | a2[0]; C_[15] = (f_ord(s1[13] + s2[0]) & ~0x3fff) | a1[13] | a2[0]; } \
    if ((c_) == 3) { C_[0] = (f_ord(s1[14] + s2[0]) & ~0x3fff) | a1[14] | a2[0]; C_[1] = (f_ord(s1[15] + s2[0]) & ~0x3fff) | a1[15] | a2[0]; C_[2] = KEY_MIN; C_[3] = KEY_MIN; C_[4] = KEY_MIN; C_[5] = KEY_MIN; C_[6] = KEY_MIN; C_[7] = KEY_MIN; C_[8] = KEY_MIN; C_[9] = KEY_MIN; C_[10] = KEY_MIN; C_[11] = KEY_MIN; C_[12] = KEY_MIN; C_[13] = KEY_MIN; C_[14] = KEY_MIN; C_[15] = KEY_MIN; } \
} while (0)

DI void peer_scores(int tokg, int head, const bf16* QP, const bf16* SUBK, unsigned* ent  , int lane) {
    const int r = lane & 31, h = lane >> 5;
    int L1[16], L2[16];
#pragma unroll
    for (int p = 0; p < 2; ++p) {
        const bf16* qp = QP + (size_t)(tokg + r) * 2048 + head * 256 + p * 128 + 8 * h; bf16x8 qf[8];
#pragma unroll
        for (int ks = 0; ks < 8; ++ks) qf[ks] = ld16g(qp + 16 * ks);
        const bf16* sk = SUBK + (size_t)((head * 2 + p) * 128 + r) * 128 + 8 * h;
        int L[16];
#pragma unroll
        for (int i = 0; i < 16; ++i) L[i] = KEY_MIN;
#pragma unroll 1
        for (int mt = 0; mt < 4; ++mt) {
            f32x16 acc;
#pragma unroll
            for (int i = 0; i < 16; ++i) acc[i] = 0.f;
#pragma unroll
            for (int ks = 0; ks < 8; ++ks) acc = MFMA32(ld16g(sk + (size_t)mt * 32 * 128 + 16 * ks), qf[ks], acc);
            int Nw[16];
#pragma unroll
            for (int i = 0; i < 16; ++i) Nw[i] = (f_ord(acc[i]) & ~127) | (32 * mt + crow(i, h));
            sort16_desc(Nw); merge16_desc(L, Nw);
        }
        int Pn[16];
#pragma unroll
        for (int i = 0; i < 16; ++i) Pn[i] = px32(L[i], lane);
        merge16_desc(L, Pn);
#pragma unroll
        for (int i = 0; i < 16; ++i) { if (p == 0) L1[i] = L[i]; else L2[i] = L[i]; }
    }
    float s1[16], s2[16]; int a1[16], a2[16];
#pragma unroll
    for (int i = 0; i < 16; ++i) { s1[i] = f_unord(L1[i] & ~127); s2[i] = f_unord(L2[i] & ~127); a1[i] = (L1[i] & 127) << 7; a2[i] = L2[i] & 127; }
    int Cn[16];
    PEER_CAND_CHUNK(Cn, 0); sort16_desc(Cn);
#pragma unroll
    for (int c = 1; c < 4; ++c) { int Dn[16]; PEER_CAND_CHUNK(Dn, c); sort16_desc(Dn); merge16_desc(Cn, Dn); }
    float e[16]; float sum = 0.f; const float m0 = f_unord(Cn[0] & ~0x3fff);
#pragma unroll
    for (int k = 0; k < 16; ++k) { e[k] = __builtin_amdgcn_exp2f((f_unord(Cn[k] & ~0x3fff) - m0) * LOG2E); sum += e[k]; }
    const float inv = 1.0f / sum;
    if (h == 0) { unsigned* dst = ent + (size_t)r * 128 + head * 16;
#pragma unroll
        for (int g4 = 0; g4 < 4; ++g4) { v4u w;
            w.x = (cvtpk2(0.f, e[4 * g4] * inv) & 0xffff0000u) | (unsigned)(Cn[4 * g4] & 0x3fff); w.y = (cvtpk2(0.f, e[4 * g4 + 1] * inv) & 0xffff0000u) | (unsigned)(Cn[4 * g4 + 1] & 0x3fff);
            w.z = (cvtpk2(0.f, e[4 * g4 + 2] * inv) & 0xffff0000u) | (unsigned)(Cn[4 * g4 + 2] & 0x3fff); w.w = (cvtpk2(0.f, e[4 * g4 + 3] * inv) & 0xffff0000u) | (unsigned)(Cn[4 * g4 + 3] & 0x3fff);
            *(v4u*)(dst + 4 * g4) = w; } }
}
typedef float f32x2 __attribute__((ext_vector_type(2)));
DI f32x2 fp8lo(unsigned w) { return __builtin_amdgcn_cvt_pk_f32_fp8((int)w, false); }
DI f32x2 fp8hi(unsigned w) { return __builtin_amdgcn_cvt_pk_f32_fp8((int)w, true); }
DI f32x2 fma2(f32x2 a, f32x2 b, f32x2 c) { float x = c.x, y = c.y; asm("v_fmac_f32 %0, %1, %2" : "+v"(x) : "v"(a.x), "v"(b.x)); asm("v_fmac_f32 %0, %1, %2" : "+v"(y) : "v"(a.y), "v"(b.y)); return (f32x2){x, y}; }
constexpr int PU_LIST = 0, PU_H = 65536, PU_USC = 98304, PU_VSC = 106496, PU_BC = 114688, PU_LCAP = 160;
template <int VAR> DI void peer_u_issue(v4u (&rw)[16], const unsigned char* U8, const LAS unsigned* lev, int lane) {
#pragma unroll
    for (int k4 = 0; k4 < 4; ++k4) { const v4u ev = *(const LAS v4u*)(lev + 4 * k4);
#pragma unroll
        for (int k = 0; k < 4; ++k) rw[4 * k4 + k] = *(const v4u*)(U8 + (size_t)(ev[k] & 0x3fffu) * 1024 + 16 * lane); }
}
template <int VAR> DI void peer_u_compute(const v4u (&rw)[16], const LAS unsigned char* hrow, float hs, const LAS unsigned* lev, const LAS unsigned* lslot, int nvalid, int tok, const LAS float* uscs, const LAS float* vscs, float* ACT, int lane) {
    const v4u hq = *(const LAS v4u*)(hrow + 16 * lane);
    int p[16];
#pragma unroll
    for (int k = 0; k < 16; ++k) { int a = __builtin_amdgcn_sdot4((int)rw[k].x, (int)hq.x, 0, false); a = __builtin_amdgcn_sdot4((int)rw[k].y, (int)hq.y, a, false); a = __builtin_amdgcn_sdot4((int)rw[k].z, (int)hq.z, a, false); p[k] = __builtin_amdgcn_sdot4((int)rw[k].w, (int)hq.w, a, false); }
    { const bool up = (lane & 8) != 0;
#pragma unroll
      for (int i = 0; i < 8; ++i) { const int keep = up ? p[i + 8] : p[i], send = up ? p[i] : p[i + 8]; p[i] = keep + dppi<DPP_RM>(send); } }
    { const bool up = (lane & 4) != 0;
#pragma unroll
      for (int i = 0; i < 4; ++i) { const int keep = up ? p[i + 4] : p[i], send = up ? p[i] : p[i + 4]; p[i] = keep + dppi<DPP_HM>(send); } }
    { const bool up = (lane & 2) != 0;
#pragma unroll
      for (int i = 0; i < 2; ++i) { const int keep = up ? p[i + 2] : p[i], send = up ? p[i] : p[i + 2]; p[i] = keep + dppi<DPP_X2>(send); } }
    { const bool up = (lane & 1) != 0; const int keep = up ? p[1] : p[0], send = up ? p[0] : p[1]; p[0] = keep + dppi<DPP_X1>(send); }
    int dq = p[0];
    { auto r = __builtin_amdgcn_permlane16_swap((unsigned)dq, (unsigned)dq, false, false); dq = (int)r[0] + (int)r[1]; }
    { auto r = __builtin_amdgcn_permlane32_swap((unsigned)dq, (unsigned)dq, false, false); dq = (int)r[0] + (int)r[1]; }
    const int myk = lane & 15;
    if (lane < 16 && myk < nvalid) { const unsigned mev = lev[myk], mslot = lslot[myk]; const unsigned er = mev & 2047u;
        ACT[(VAR == 1) ? (size_t)lane : ((size_t)tok * 128 + mslot)] = gelu_tanh((float)dq * hs * uscs[er]) * __uint_as_float(mev & 0xffff0000u) * vscs[er]; }
}
DI void peer_u_loade(int tok, const unsigned* ENT, unsigned (&e0)[4], unsigned (&e1)[4], int lane) {
#pragma unroll
    for (int t = 0; t < 4; ++t) { e0[t] = ENT[(size_t)(tok + t) * 128 + lane]; e1[t] = ENT[(size_t)(tok + t) * 128 + 64 + lane]; }
}
template <int VAR> DI void peer_u_wave(int tok0, int slab, const unsigned* ENT, const unsigned char* HQ, const float* HS, const unsigned char* U8, float* ACT, LAS unsigned char* lds, int wave, int lane) {
    LAS unsigned* lev = (LAS unsigned*)(lds + PU_LIST + wave * 8192); LAS unsigned* lslot = lev + 4 * PU_LCAP; LAS unsigned char* hb = lds + PU_H + wave * 4096;
    const LAS float* uscs = (const LAS float*)(lds + PU_USC); const LAS float* vscs = (const LAS float*)(lds + PU_VSC);
    unsigned e0[4], e1[4];
    peer_u_loade(tok0, ENT, e0, e1, lane);
#pragma unroll 1
    for (int bt = 0; bt < 4; ++bt) { const int tb = tok0 + 4 * bt;
        v4u hq[4]; float hsv[4];
#pragma unroll
        for (int t = 0; t < 4; ++t) { hq[t] = *(const v4u*)(HQ + (size_t)(tb + t) * 1024 + 16 * lane); hsv[t] = HS[tb + t]; }
        int cnt[4]; const unsigned long long lt = (1ull << lane) - 1ull;
#pragma unroll
        for (int t = 0; t < 4; ++t) { const bool in0 = ((e0[t] >> 11) & 7u) == (unsigned)slab, in1 = ((e1[t] >> 11) & 7u) == (unsigned)slab;
            const unsigned long long b0 = __ballot(in0), b1 = __ballot(in1); const int n0 = __builtin_popcountll(b0), n = n0 + __builtin_popcountll(b1);
            LAS unsigned* le = lev + t * PU_LCAP; LAS unsigned* ls = lslot + t * PU_LCAP;
            if (in0) { const int p = __builtin_popcountll(b0 & lt); le[p] = e0[t]; ls[p] = (unsigned)lane; }
            if (in1) { const int p = n0 + __builtin_popcountll(b1 & lt); le[p] = e1[t]; ls[p] = (unsigned)(64 + lane); }
            if (n > 0 && lane < 16) { const unsigned pe = b0 ? (unsigned)__builtin_amdgcn_readlane((int)e0[t], (int)__builtin_ctzll(b0 | (1ull << 63))) : (unsigned)__builtin_amdgcn_readlane((int)e1[t], (int)__builtin_ctzll(b1 | (1ull << 63)));
                if (n + lane < ((n + 15) & ~15)) le[n + lane] = pe; }
            cnt[t] = n; }
        if (bt < 3) peer_u_loade(tb + 4, ENT, e0, e1, lane);
#pragma unroll
        for (int t = 0; t < 4; ++t) *(LAS v4u*)(hb + t * 1024 + 16 * lane) = hq[t];
        asm volatile("s_waitcnt lgkmcnt(0)" ::: "memory");
#define PU_CNT(t_) ((t_) == 0 ? cnt[0] : ((t_) == 1 ? cnt[1] : ((t_) == 2 ? cnt[2] : cnt[3])))
#define PU_HS(t_) ((t_) == 0 ? hsv[0] : ((t_) == 1 ? hsv[1] : ((t_) == 2 ? hsv[2] : hsv[3])))
#define PU_ADV(tk_, g_) do { while ((tk_) < 4 && (g_) >= PU_CNT(tk_)) { ++(tk_); (g_) = 0; } } while (0)
        int tk = 0, g = 0; PU_ADV(tk, g);
        if (tk < 4) { v4u ra[16], rb[16];
            peer_u_issue<VAR>(ra, U8, lev + tk * PU_LCAP + g, lane);
            for (;;) {
                int ntk = tk, ng = g + 16; PU_ADV(ntk, ng);
                if (ntk < 4) peer_u_issue<VAR>(rb, U8, lev + ntk * PU_LCAP + ng, lane);
                peer_u_compute<VAR>(ra, hb + tk * 1024, PU_HS(tk), lev + tk * PU_LCAP + g, lslot + tk * PU_LCAP + g, PU_CNT(tk) - g, tb + tk, uscs, vscs, ACT, lane);
                tk = ntk; g = ng; if (tk >= 4) break;
                ntk = tk; ng = g + 16; PU_ADV(ntk, ng);
                if (ntk < 4) peer_u_issue<VAR>(ra, U8, lev + ntk * PU_LCAP + ng, lane);
                peer_u_compute<VAR>(rb, hb + tk * 1024, PU_HS(tk), lev + tk * PU_LCAP + g, lslot + tk * PU_LCAP + g, PU_CNT(tk) - g, tb + tk, uscs, vscs, ACT, lane);
                tk = ntk; g = ng; if (tk >= 4) break;
            } }
#undef PU_CNT
#undef PU_HS
#undef PU_ADV
        asm volatile("s_waitcnt lgkmcnt(0)" ::: "memory");
    }
}
DI void peer_v_wave(int tok0, int slab, const unsigned* ENT, const float* ACT, const unsigned char* V8slab, float* X, const float* g2, int lane) {
    const int sub = lane & 7, j = lane >> 3;
    const int col = 128 * slab + 16 * sub + 2 * (4 * ((lane >> 5) & 1) + 2 * ((lane >> 4) & 1) + ((lane >> 3) & 1));
    const f32x2 gv = *(const f32x2*)(g2 + (tok0 >> 13) * 6144 + col);
    v4u enn[4]; f32x4 awn[4]; f32x2 xvn;
    { const v4u* ep = (const v4u*)(ENT + (size_t)tok0 * 128 + 16 * j); const f32x4* ap = (const f32x4*)(ACT + (size_t)tok0 * 128 + 16 * j);
#pragma unroll
      for (int q = 0; q < 4; ++q) { enn[q] = ep[q]; awn[q] = ap[q]; }
      xvn = *(const f32x2*)(X + (size_t)tok0 * 1024 + col); }
#pragma unroll 1
    for (int it = 0; it < 8; ++it) { const int tok = tok0 + it;
        v4u en[4]; f32x4 aw[4]; const f32x2 xv = xvn;
#pragma unroll
        for (int q = 0; q < 4; ++q) { en[q] = enn[q]; aw[q] = awn[q]; }
        v4u rw[16];
#pragma unroll
        for (int i = 0; i < 16; ++i) rw[i] = *(const v4u*)(V8slab + (size_t)(en[i >> 2][i & 3] & 0x3fffu) * 128 + 16 * sub);
        if (it < 7) { const v4u* ep = (const v4u*)(ENT + (size_t)(tok + 1) * 128 + 16 * j); const f32x4* ap = (const f32x4*)(ACT + (size_t)(tok + 1) * 128 + 16 * j);
#pragma unroll
            for (int q = 0; q < 4; ++q) { enn[q] = ep[q]; awn[q] = ap[q]; }
            xvn = *(const f32x2*)(X + (size_t)(tok + 1) * 1024 + col); }
        f32x2 acc[8];
#pragma unroll
        for (int c = 0; c < 8; ++c) acc[c] = (f32x2){0.f, 0.f};
#pragma unroll
        for (int i = 0; i < 16; ++i) { const float w = aw[i >> 2][i & 3]; const f32x2 w2 = (f32x2){w, w};
            acc[0] = fma2(fp8lo(rw[i].x), w2, acc[0]); acc[1] = fma2(fp8hi(rw[i].x), w2, acc[1]); acc[2] = fma2(fp8lo(rw[i].y), w2, acc[2]); acc[3] = fma2(fp8hi(rw[i].y), w2, acc[3]);
            acc[4] = fma2(fp8lo(rw[i].z), w2, acc[4]); acc[5] = fma2(fp8hi(rw[i].z), w2, acc[5]); acc[6] = fma2(fp8lo(rw[i].w), w2, acc[6]); acc[7] = fma2(fp8hi(rw[i].w), w2, acc[7]); }
        { const bool up = (lane & 32) != 0;
#pragma unroll
          for (int c = 0; c < 4; ++c) { const f32x2 keep = up ? acc[c + 4] : acc[c], send = up ? acc[c] : acc[c + 4]; acc[c] = (f32x2){keep.x + px32(send.x, lane), keep.y + px32(send.y, lane)}; } }
        { const bool up = (lane & 16) != 0;
#pragma unroll
          for (int c = 0; c < 2; ++c) { const f32x2 keep = up ? acc[c + 2] : acc[c], send = up ? acc[c] : acc[c + 2]; acc[c] = (f32x2){keep.x + px16(send.x, lane), keep.y + px16(send.y, lane)}; } }
        { const bool up = (lane & 8) != 0; const f32x2 keep = up ? acc[1] : acc[0], send = up ? acc[0] : acc[1]; acc[0] = (f32x2){keep.x + dppf<DPP_R8>(send.x), keep.y + dppf<DPP_R8>(send.y)}; }
        *(f32x2*)(X + (size_t)tok * 1024 + col) = (f32x2){xv.x + gv.x * acc[0].x, xv.y + gv.y * acc[0].y};
    }
}
struct PeerT { const unsigned char *U8, *V8s; const float *USC, *VSC; unsigned* ENT; float* ACT; const unsigned char* HQ; const float* HS; float* X; const float* g2; };
DI void peer_scores_phase(const Frame& F, const bf16* QP, const bf16* SUBK, unsigned* ENT) {
    for (int unit = blockIdx.x; unit < MROWS / 64; unit += F.G) {
#pragma unroll 1
        for (int grp = 0; grp < 2; ++grp) { const int tokg = unit * 64 + 32 * grp; peer_scores(tokg, F.wave, QP, SUBK, ENT + (size_t)tokg * 128, F.lane); } }
}
template <int PASS, int VAR = 0> DI void peer_gather_phase(const Frame& F, int cnt_base, const PeerT& T) {
    const int xcc = XCC_EXPR; LAS int* bc = (LAS int*)(F.lds + PU_BC);
    constexpr int CHT = (PASS == 0) ? 128 : 64;
    for (int k = 0; k < 8; ++k) { const int s = (xcc + k) & 7; unsigned* cnt = (unsigned*)(F.ctl + CW_WORK + 64 * (cnt_base + s));
        if (PASS == 0) { for (int i = F.tid; i < 2048; i += NTHR) { ((LAS float*)(F.lds + PU_USC))[i] = T.USC[2048 * s + i]; ((LAS float*)(F.lds + PU_VSC))[i] = T.VSC[2048 * s + i]; } }
        for (;;) {
            if (F.tid == 0) *bc = (int)__hip_atomic_fetch_add(cnt, 1u, __ATOMIC_RELAXED, __HIP_MEMORY_SCOPE_AGENT);
            __syncthreads(); const int chunk = *bc; __syncthreads();
            if (chunk >= MROWS / CHT) break;
            if (PASS == 0) peer_u_wave<VAR>(chunk * 128 + F.wave * 16, s, T.ENT, T.HQ, T.HS, T.U8, T.ACT, F.lds, F.wave, F.lane);
            else peer_v_wave(chunk * 64 + F.wave * 8, s, T.ENT, T.ACT, T.V8s + (size_t)s * 16384 * 128, T.X, T.g2, F.lane);
        } }
}
struct Args { const float* in[19]; float* out; unsigned char* ws; int stage, pad; };
__global__ void __launch_bounds__(NTHR, 2) hybrid_fwd(Args args) {
    extern __shared__ __attribute__((aligned(16))) unsigned char lds_raw[];
    for (int u = threadIdx.x; u < (LDS_BYTES - LDSCTL_OFF) / 4; u += NTHR) ((LAS unsigned*)((LAS unsigned char*)lds_raw + LDSCTL_OFF))[u] = 0u;
    __syncthreads();
    XcdBarrier bar = xcd_barrier_post((unsigned*)((gu32*)(args.ws + WS_CTL) + CW_BAR), (volatile LAS unsigned*)((LAS unsigned char*)lds_raw + MISC_OFF) + 8);
#ifdef PROBE_MASK
    volatile LAS unsigned long long* stamps_ = (volatile LAS unsigned long long*)((LAS unsigned char*)lds_raw + MISC_OFF + 256); int nst_ = 0;
#define STAMP() do { if (blockIdx.x == 0 && threadIdx.x == 0) stamps_[nst_] = __builtin_amdgcn_s_memrealtime(); ++nst_; } while (0)
#else
#define STAMP() do {} while (0)
#endif
    STAMP();
#define GRID_BAR() do { xcd_barrier(bar); STAMP(); } while (0)
#define OPQ(p) ({ size_t z_ = 0; asm volatile("" : "+s"(z_)); (p) + z_; })
#define PH_PTRS \
    unsigned char* ws = OPQ(args.ws); const float* x_in = OPQ(args.in[0]); float* X = OPQ(args.out); \
    const float *norm_mix = args.in[4], *norm_ffn = args.in[5]; \
    float* MOD = (float*)(ws + WS_MOD); float* ROPE = (float*)(ws + WS_ROPE); float* KSUM = (float*)(ws + WS_KSUM); \
    bf16 *WIN0 = (bf16*)(ws + WS_WIN0), *WOUT0 = (bf16*)(ws + WS_WOUT0), *WIN1 = (bf16*)(ws + WS_WIN1), *WOUT1 = (bf16*)(ws + WS_WOUT1), *WQ0 = (bf16*)(ws + WS_WQ0), *WQ1 = (bf16*)(ws + WS_WQ1); \
    bf16 *SUBK = (bf16*)(ws + WS_SUBK), *GWS = (bf16*)(ws + WS_GWS), *HN = (bf16*)(ws + WS_HN); \
    bf16 *UA = (bf16*)(ws + WS_A), *VA = (bf16*)(ws + WS_A + 16 * MiB), *Q0 = (bf16*)(ws + WS_A + 32 * MiB), *K0 = (bf16*)(ws + WS_A + 48 * MiB), *VT0 = (bf16*)(ws + WS_A + 64 * MiB); \
    bf16 *Q1 = (bf16*)(ws + WS_A), *K1 = (bf16*)(ws + WS_A + 32 * MiB), *VT1 = (bf16*)(ws + WS_A + 64 * MiB); \
    bf16 *YCAT = (bf16*)(ws + WS_YCAT), *QP = (bf16*)(ws + WS_QP), *PO = (bf16*)(ws + WS_PO); float* PL = (float*)(ws + WS_PL); unsigned* MASKS = (unsigned*)(ws + WS_MASK); unsigned char *U8 = ws + WS_PTU, *V8s = ws + WS_PTV; float *USC = (float*)(ws + WS_SC), *VSC = USC + 32768; unsigned* ENT = (unsigned*)(ws + WS_PO); float* ACT = (float*)(ws + WS_PO + 8 * MiB); unsigned char* HQ = ws + WS_A; float* HS = (float*)(ws + WS_SC + 512 * 1024); (void)HQ; (void)HS; (void)U8; (void)V8s; (void)USC; (void)VSC; (void)ENT; (void)ACT; bf16* QKR = (bf16*)(ws + WS_QP); (void)QKR; \
    (void)x_in; (void)X; (void)norm_mix; (void)norm_ffn; (void)MOD; (void)ROPE; (void)KSUM; (void)WIN0; (void)WOUT0; (void)WIN1; (void)WOUT1; (void)WQ0; (void)WQ1; (void)SUBK; (void)GWS; (void)HN; \
    (void)UA; (void)VA; (void)Q0; (void)K0; (void)VT0; (void)Q1; (void)K1; (void)VT1; (void)YCAT; (void)QP; (void)PO; (void)PL; (void)MASKS;
#define PH_FRAME Frame F; F.lds = (LAS unsigned char*)lds_raw; F.MISC = (volatile LAS unsigned*)(F.lds + MISC_OFF); { int t_ = threadIdx.x; asm volatile("" : "+v"(t_)); F.tid = t_; } F.lane = F.tid & 63; F.wave = __builtin_amdgcn_readfirstlane(F.tid >> 6); \
    F.G = gridDim.x; F.gw = blockIdx.x * NWAVES + F.wave; F.NGW = F.G * NWAVES; F.ctl = (gu32*)(OPQ(args.ws) + WS_CTL);
    { PH_FRAME PH_PTRS
      P0Args A; A.c = args.in[1]; A.w_mod = args.in[2]; A.b_mod = args.in[3]; A.win0 = args.in[6]; A.wout0 = args.in[12]; A.win1 = args.in[13]; A.wout1 = args.in[14]; A.wq = args.in[15]; A.subk = args.in[16];
      A.pu = args.in[17]; A.pv = args.in[18]; A.gws = args.in[8]; A.MOD = MOD; A.ROPE = ROPE; A.WIN0 = WIN0; A.WOUT0 = WOUT0; A.WIN1 = WIN1; A.WOUT1 = WOUT1; A.WQ0 = WQ0; A.WQ1 = WQ1; A.SUBK = SUBK; A.GWS = GWS; A.U8 = U8; A.V8s = V8s; A.USC = USC; A.VSC = VSC;
      p0_prologue(F, A); }
    GRID_BAR();
    { PH_FRAME PH_PTRS norm_rows(F, x_in, norm_mix, MOD, 0, 1, HN); }
    GRID_BAR();
    { PH_FRAME PH_PTRS
      pg8::Gemm g{HN, WIN0, MROWS, 2048, 1024}; pg8::StaticOrder S; S.init(MROWS, 2048, F.G, (int)blockIdx.x);
      pg8::EpiL0m E{UA, VA, QKR};
      pg8::gemm_phase<pg8::EpiL0m, pg8::StaticOrder, true, true>(F.lds, g, S, E); }
    { PH_FRAME PH_PTRS
      pg8::Gemm g{WIN0 + (size_t)2048 * 1024, HN, 512, MROWS, 1024}; pg8::StaticOrder S; S.init(512, MROWS, F.G, (int)blockIdx.x);
      pg8::EpiVT E{VT0, 512};
      pg8::gemm_phase<pg8::EpiVT, pg8::StaticOrder, true, true>(F.lds, g, S, E); }
    GRID_BAR();
    { PH_FRAME PH_PTRS
      for (int t = blockIdx.x; t < 256; t += F.G) qk_post_task(t, QKR, Q0, K0, KSUM, ROPE, args.in[10], args.in[11], (LAS float*)F.lds, F.tid, F.wave, F.lane);
      for (int u = blockIdx.x; u < 512; u += F.G) gmlp_unit(u, UA, VA, args.in[7], GWS, args.in[9], YCAT, F.lds, F.tid, F.wave, F.lane); }
    GRID_BAR();
    { PH_FRAME PH_PTRS
      MobaT T{Q0, K0, VT0, KSUM, MASKS, PO, PL, args.in[10], args.in[11]}; const float mc2 = moba_mc2(args.in[10], args.in[11], F.lane);
      for (int u = F.gw; u < 4096; u += F.NGW) { moba_mask_unit(u, T, F.lane); moba_own_unit(u, T, mc2, F.lane); } }
    GRID_BAR();
    { PH_FRAME PH_PTRS
      MobaT T{Q0, K0, VT0, KSUM, MASKS, PO, PL, args.in[10], args.in[11]}; const float mc2 = moba_mc2(args.in[10], args.in[11], F.lane);
      LAS int* bc = (LAS int*)(F.lds + MS_CNT + 64);
      for (;;) { if (F.tid == 0) *bc = (int)__hip_atomic_fetch_add((unsigned*)(F.ctl + CW_WORK), 1u, __ATOMIC_RELAXED, __HIP_MEMORY_SCOPE_AGENT);
          __syncthreads(); const int task = *bc; __syncthreads(); if (task >= MOBA_NTASK) break;
          moba_sel_task(task, T, F.lds, mc2, F.tid, F.wave, F.lane); } }
    GRID_BAR();
    { PH_FRAME PH_PTRS moba_combine(F, PO, PL, YCAT); }
    GRID_BAR();
    { PH_FRAME PH_PTRS
      pg8::Gemm g{YCAT, WOUT0, MROWS, 1024, 1024}; pg8::StaticOrder S; S.init(MROWS, 1024, F.G, (int)blockIdx.x);
      pg8::EpiRes E{x_in, X, MOD + 2 * 1024};
      pg8::gemm_phase<pg8::EpiRes, pg8::StaticOrder, true, true>(F.lds, g, S, E); }
    GRID_BAR();
    { PH_FRAME PH_PTRS norm_rows(F, X, norm_ffn, MOD, 3, 4, HN, HQ, HS); }
    GRID_BAR();
    { PH_FRAME PH_PTRS
      pg8::Gemm g{HN, WQ0, MROWS, 2048, 1024}; pg8::StaticOrder S; S.init(MROWS, 2048, F.G, (int)blockIdx.x);
      pg8::EpiBf16<0> E{QP, 2048, nullptr, 0, 0, 1.f};
      pg8::gemm_phase<pg8::EpiBf16<0>, pg8::StaticOrder, true, true>(F.lds, g, S, E); }
    GRID_BAR();
    { PH_FRAME PH_PTRS peer_scores_phase(F, QP, SUBK, ENT); }
    GRID_BAR();
    { PH_FRAME PH_PTRS PeerT T{U8, V8s, USC, VSC, ENT, ACT, HQ, HS, X, MOD + 5 * 1024}; peer_gather_phase<0>(F, 1, T); }
    GRID_BAR();
#ifdef XVAR
    { PH_FRAME PH_PTRS PeerT T{U8, V8s, USC, VSC, ENT, (float*)(ws + WS_PL), HQ, HS, X, MOD + 5 * 1024}; peer_gather_phase<0, XVAR>(F, 40, T); }
    GRID_BAR();
#endif
    { PH_FRAME PH_PTRS PeerT T{U8, V8s, USC, VSC, ENT, ACT, HQ, HS, X, MOD + 5 * 1024}; peer_gather_phase<1>(F, 9, T); }
    GRID_BAR();
    { PH_FRAME PH_PTRS norm_rows(F, X, norm_mix + 1024, MOD + 2 * 6144, 0, 1, HN); }
    GRID_BAR();
    { PH_FRAME PH_PTRS
      pg8::Gemm g{HN, WIN1, MROWS, 2048, 1024}; pg8::StaticOrder S; S.init(MROWS, 2048, F.G, (int)blockIdx.x);
      pg8::EpiHeads E{Q1, K1, 16};
      pg8::gemm_phase<pg8::EpiHeads, pg8::StaticOrder, true, true>(F.lds, g, S, E); }
    { PH_FRAME PH_PTRS
      pg8::Gemm g{WIN1 + (size_t)2048 * 1024, HN, 1024, MROWS, 1024}; pg8::StaticOrder S; S.init(1024, MROWS, F.G, (int)blockIdx.x);
      pg8::EpiVT E{VT1, 1024};
      pg8::gemm_phase<pg8::EpiVT, pg8::StaticOrder, true, true>(F.lds, g, S, E); }
    GRID_BAR();
    { PH_FRAME PH_PTRS for (int u = F.gw; u < 8192; u += F.NGW) sb_unit(u, Q1, K1, VT1, YCAT, F.lane); }
    GRID_BAR();
    { PH_FRAME PH_PTRS
      pg8::Gemm g{YCAT, WOUT1, MROWS, 1024, 1024}; pg8::StaticOrder S; S.init(MROWS, 1024, F.G, (int)blockIdx.x);
      pg8::EpiRes E{X, X, MOD + 2 * 6144 + 2 * 1024};
      pg8::gemm_phase<pg8::EpiRes, pg8::StaticOrder, true, true>(F.lds, g, S, E); }
    GRID_BAR();
    { PH_FRAME PH_PTRS norm_rows(F, X, norm_ffn + 1024, MOD + 2 * 6144, 3, 4, HN, HQ, HS); }
    GRID_BAR();
    { PH_FRAME PH_PTRS
      pg8::Gemm g{HN, WQ1, MROWS, 2048, 1024}; pg8::StaticOrder S; S.init(MROWS, 2048, F.G, (int)blockIdx.x);
      pg8::EpiBf16<0> E{QP, 2048, nullptr, 0, 0, 1.f};
      pg8::gemm_phase<pg8::EpiBf16<0>, pg8::StaticOrder, true, true>(F.lds, g, S, E); }
    GRID_BAR();
    { PH_FRAME PH_PTRS peer_scores_phase(F, QP, SUBK + 262144, ENT); }
    GRID_BAR();
    { PH_FRAME PH_PTRS PeerT T{U8 + (size_t)16384 * 1024, V8s + (size_t)16384 * 1024, USC + 16384, VSC + 16384, ENT, ACT, HQ, HS, X, MOD + 2 * 6144 + 5 * 1024}; peer_gather_phase<0>(F, 17, T); }
    GRID_BAR();
    { PH_FRAME PH_PTRS PeerT T{U8 + (size_t)16384 * 1024, V8s + (size_t)16384 * 1024, USC + 16384, VSC + 16384, ENT, ACT, HQ, HS, X, MOD + 2 * 6144 + 5 * 1024}; peer_gather_phase<1>(F, 25, T);
      if (__hip_atomic_load((gu32*)((unsigned*)(F.ctl + CW_BAR) + XB_TMO), RLX_AGENT) != 0u) { for (int m = F.gw; m < MROWS; m += F.NGW) X[(size_t)m * 1024 + F.lane] = __builtin_nanf(""); } }
#ifdef PROBE_MASK
#ifdef PROBE_BARS
    for (int i = 0; i < PROBE_BARS; ++i) xcd_barrier(bar);
#endif
    STAMP();
    if (blockIdx.x == 0 && threadIdx.x == 0) { unsigned long long tsel = 0;
        for (int i = 0; i + 1 < nst_; ++i) if ((PROBE_MASK >> i) & 1ull) tsel += stamps_[i + 1] - stamps_[i];
        const unsigned long long t0 = __builtin_amdgcn_s_memrealtime(); while (__builtin_amdgcn_s_memrealtime() - t0 < tsel * PROBE_AMP) __builtin_amdgcn_s_sleep(8); }
#endif
}

extern "C" void kernel_launch(void* const* d_in, const int* in_sizes, int n_in, void* d_out, int out_size, void* d_ws, size_t ws_size, hipStream_t stream) {
    static int grid = 0;
    if (grid == 0) {
        if (n_in != 19 || out_size != MROWS * DM || ws_size < WS_END) { fprintf(stderr, "kernel_launch: unexpected shapes (n_in %d, out %d, ws %zu)\n", n_in, out_size, ws_size); grid = -1; return; }
        int dev = 0, cus = 0, per_cu = 0;
        if (hipGetDevice(&dev) != hipSuccess || hipDeviceGetAttribute(&cus, hipDeviceAttributeMultiprocessorCount, dev) != hipSuccess) { grid = -1; return; }
        if (hipFuncSetAttribute((const void*)hybrid_fwd, hipFuncAttributeMaxDynamicSharedMemorySize, LDS_BYTES) != hipSuccess) { fprintf(stderr, "kernel_launch: hipFuncSetAttribute failed\n"); grid = -1; return; }
        if (hipOccupancyMaxActiveBlocksPerMultiprocessor(&per_cu, (const void*)hybrid_fwd, NTHR, LDS_BYTES) != hipSuccess || per_cu < 1) { fprintf(stderr, "kernel_launch: occupancy query says %d\n", per_cu); per_cu = 1; }
        (void)hipGetLastError();
        grid = cus;
    }
    if (grid < 0) return;
    if (hipMemsetAsync((char*)d_ws + WS_CTL, 0, CTL_ZERO_BYTES, stream) != hipSuccess) { fprintf(stderr, "kernel_launch: memset failed\n"); return; }
    Args a{};
    for (int i = 0; i < 19; ++i) a.in[i] = (const float*)d_in[i];
    a.out = (float*)d_out; a.ws = (unsigned char*)d_ws; a.stage = 0; a.pad = 0;
    void* kargs[] = {&a};
    hipError_t e = hipLaunchCooperativeKernel((const void*)hybrid_fwd, dim3(grid), dim3(NTHR), kargs, LDS_BYTES, stream);
    if (e != hipSuccess) fprintf(stderr, "kernel_launch: cooperative launch failed: %s (grid %d)\n", hipGetErrorString(e), grid);
}
```

```cpp
#include <hip/hip_runtime.h>
#include <cstdio>
#include <cstdint>
#include <cmath>
namespace pg8 {
#define PG8_LAS __attribute__((address_space(3)))
typedef unsigned short bf16_t;
typedef short bf16x8 __attribute__((ext_vector_type(8)));
typedef float f32x4 __attribute__((ext_vector_type(4)));
typedef unsigned u32x4 __attribute__((ext_vector_type(4)));
constexpr int BM = 256, BK = 64, HALF = 128, HTB = HALF * BK * 2  , STAGE_BYTES = 8 * HTB, NXCD = 8, WGM = 8;

__host__ __device__ __forceinline__ int lds_byte(int r, int c) { const int st = (r >> 4) * 2 + (c >> 5), rr = r & 15, cc = c & 31, ob = rr * 64 + cc * 2; return st * 1024 + (ob ^ (((ob >> 9) & 1) << 5)); }
__host__ __device__ __forceinline__ void stage_rc(int b, int& R, int& C) { const int st = b / 1024, sb = b % 1024, swz = sb ^ (((sb >> 9) & 1) << 5); R = (st >> 1) * 16 + swz / 64; C = (st & 1) * 32 + (swz % 64) / 2; }
__host__ __device__ __forceinline__ int perm32(int rho) { const int n = rho >> 4, i = rho & 15; return 8 * (i >> 2) + 4 * n + (i & 3); }

struct Unit { int pm, pn; };
struct Gemm { const bf16_t* A; const bf16_t* Bt; int M, N, K; };

struct StaticOrder {
    int nM, nN, nwg, G, c;
    __host__ __device__ void init(int M, int N, int G_, int c_) { nM = M / BM; nN = N / BM; nwg = nM * nN; G = G_; c = c_; }
    __host__ __device__ bool next(int i, Unit& u) const {
        const long L = (long)i * G + c; if (L >= nwg) return false;
        int wgid = (int)L; { const int q = nwg / NXCD, r = nwg % NXCD, xcd = wgid % NXCD, off = wgid / NXCD; wgid = (xcd < r ? xcd * (q + 1) : r * (q + 1) + (xcd - r) * q) + off; }
        const int nig = WGM * nN, gid = wgid / nig, fm = gid * WGM, gsz = (nM - fm) < WGM ? (nM - fm) : WGM;
        u.pm = fm + ((wgid % nig) % gsz); u.pn = (wgid % nig) / gsz; return true;
    }
    __device__ __forceinline__ void a_ready(const Unit&) const {}
    __device__ __forceinline__ void done(const Unit&) const {}
};

__device__ __forceinline__ unsigned cvt_pk_bf16(float lo, float hi) { unsigned r; asm volatile("v_cvt_pk_bf16_f32 %0, %1, %2" : "=v"(r) : "v"(lo), "v"(hi)); return r; }
typedef float f32x2 __attribute__((ext_vector_type(2)));
__device__ __forceinline__ f32x2 gelu_pk(f32x2 v) {
    const f32x2 av = __builtin_elementwise_abs(v), d = av * 0.2316418882f + 1.0f;
    f32x2 t; t.x = __builtin_amdgcn_rcpf(d.x); t.y = __builtin_amdgcn_rcpf(d.y);
    f32x2 q = t * 0.5307027145f + (-0.7265760135f); q = q * t + 0.7107068705f; q = q * t + (-0.142248368f); q = q * t + 0.127414796f; q = q * t;
    const f32x2 s = (v * v) * (-0.72134752044f);
    f32x2 e; e.x = __builtin_amdgcn_exp2f(s.x); e.y = __builtin_amdgcn_exp2f(s.y);
    const f32x2 m = v * (q * e), r = v - m;
    f32x2 o; o.x = v.x < 0.f ? m.x : r.x; o.y = v.y < 0.f ? m.y : r.y; return o;
}

template <int ACT  > struct EpiBf16 {
    static constexpr bool PERM = true, AFTER_DRAIN = false; static_assert(ACT == 0 || ACT == 1, "EpiBf16: ACT is 0 (none) or 1 (gelu_pk)");
    bf16_t* O; int ldc; const float* bias; int split_cols; size_t split_stride; float scale0;
    __device__ __forceinline__ void operator()(const f32x4 (&acc)[2][2][4][2], const Unit& u, int wr, int wc, int fr, int fq) const {
        const int row0 = u.pm * BM + wr * 64 + fr; int colt = u.pn * BM; bf16_t* base = O;
        float sc = 1.f; if (split_cols) { const int t = colt / split_cols; base += (size_t)t * split_stride; colt -= t * split_cols; if (t == 0) sc = scale0; }
        const int col0 = colt + wc * 32 + 8 * fq, bcol0 = u.pn * BM + wc * 32 + 8 * fq;
        f32x4 bv[2][2];
#pragma unroll
        for (int bj = 0; bj < 2; ++bj)
#pragma unroll
            for (int n = 0; n < 2; ++n) bv[bj][n] = bias ? *(const f32x4*)(bias + bcol0 + bj * HALF + 4 * n) : (f32x4){0.f, 0.f, 0.f, 0.f};
#pragma unroll
        for (int ai = 0; ai < 2; ++ai)
#pragma unroll
            for (int m = 0; m < 4; ++m) { bf16_t* rowp = base + (size_t)(row0 + ai * HALF + m * 16) * ldc + col0;
#pragma unroll
                for (int bj = 0; bj < 2; ++bj) { f32x4 v0 = acc[ai][bj][m][0] + bv[bj][0], v1 = acc[ai][bj][m][1] + bv[bj][1];
                    if (ACT == 1) { f32x2 a = gelu_pk((f32x2){v0[0], v0[1]}), b = gelu_pk((f32x2){v0[2], v0[3]}), c = gelu_pk((f32x2){v1[0], v1[1]}), d = gelu_pk((f32x2){v1[2], v1[3]});
                        v0 = (f32x4){a.x, a.y, b.x, b.y}; v1 = (f32x4){c.x, c.y, d.x, d.y}; }
                    v0 = v0 * sc; v1 = v1 * sc; u32x4 w; w.x = cvt_pk_bf16(v0[0], v0[1]); w.y = cvt_pk_bf16(v0[2], v0[3]); w.z = cvt_pk_bf16(v1[0], v1[1]); w.w = cvt_pk_bf16(v1[2], v1[3]);
                    *(u32x4*)(rowp + bj * HALF) = w; } }
    }
};
constexpr int XSEQ = 8192;
typedef float f32x2e __attribute__((ext_vector_type(2))); typedef __bf16 bf16x2e __attribute__((ext_vector_type(2)));
__device__ __forceinline__ unsigned cvtpk2(float lo, float hi) { f32x2e v = {lo, hi}; bf16x2e b = __builtin_convertvector(v, bf16x2e); return __builtin_bit_cast(unsigned, b); }
__device__ __forceinline__ float gelu_tanh(float x) {
    const float u2 = x * (1.5957691216f + 0.0713548163f * x * x);
    return x * __builtin_amdgcn_rcpf(1.0f + __builtin_amdgcn_exp2f(-1.4426950409f * u2));
}
struct EpiL0m {
    static constexpr bool PERM = true, AFTER_DRAIN = false;
    bf16_t *UA, *VA, *QKR;
    template <bool ACT> __device__ __forceinline__ void tile(const f32x4 (&acc)[2][2][4][2], bf16_t* base, int ldc, int row0, int colt) const {
#pragma unroll
        for (int ai = 0; ai < 2; ++ai)
#pragma unroll
            for (int m = 0; m < 4; ++m) { bf16_t* rowp = base + (size_t)(row0 + ai * HALF + m * 16) * ldc + colt;
#pragma unroll
                for (int bj = 0; bj < 2; ++bj) { f32x4 v0 = acc[ai][bj][m][0], v1 = acc[ai][bj][m][1]; u32x4 w;
                    if (ACT) { v0[0] = gelu_tanh(v0[0]); v0[1] = gelu_tanh(v0[1]); v0[2] = gelu_tanh(v0[2]); v0[3] = gelu_tanh(v0[3]); v1[0] = gelu_tanh(v1[0]); v1[1] = gelu_tanh(v1[1]); v1[2] = gelu_tanh(v1[2]); v1[3] = gelu_tanh(v1[3]); }
                    w.x = cvtpk2(v0[0], v0[1]); w.y = cvtpk2(v0[2], v0[3]); w.z = cvtpk2(v1[0], v1[1]); w.w = cvtpk2(v1[2], v1[3]);
                    *(u32x4*)(rowp + bj * HALF) = w; } }
    }
    __device__ __forceinline__ void operator()(const f32x4 (&acc)[2][2][4][2], const Unit& u, int wr, int wc, int fr, int fq) const {
        const int pn = u.pn; const int row0 = u.pm * BM + wr * 64 + fr; const int cw = wc * 32 + 8 * fq;
        if (pn < 2) tile<true>(acc, UA, 512, row0, pn * 256 + cw);
        else if (pn < 4) tile<true>(acc, VA, 512, row0, (pn - 2) * 256 + cw);
        else tile<false>(acc, QKR, 1024, row0, (pn - 4) * 256 + cw);
    }
};
struct EpiHeads {
    static constexpr bool PERM = true, AFTER_DRAIN = false;
    bf16_t *Q, *Kp; int nh; float qscale;
    __device__ __forceinline__ void operator()(const f32x4 (&acc)[2][2][4][2], const Unit& u, int wr, int wc, int fr, int fq) const {
        const int b = u.pm >> 5, sb = (u.pm & 31) * 256 + wr * 64 + fr;
#pragma unroll
        for (int bj = 0; bj < 2; ++bj) { const int c = u.pn * BM + bj * HALF + wc * 32 + 8 * fq; const int t = c / (64 * nh), cc = c - t * 64 * nh, head = cc >> 6, d = cc & 63;
            bf16_t* dst = (t ? Kp : Q) + ((size_t)(b * nh + head) * XSEQ) * 64 + d;
#pragma unroll
            for (int ai = 0; ai < 2; ++ai)
#pragma unroll
                for (int m = 0; m < 4; ++m) { const int s = sb + ai * HALF + m * 16; const float qs = t ? 1.0f : qscale; const f32x4 v0 = acc[ai][bj][m][0] * qs, v1 = acc[ai][bj][m][1] * qs; u32x4 w;
                    w.x = cvtpk2(v0[0], v0[1]); w.y = cvtpk2(v0[2], v0[3]); w.z = cvtpk2(v1[0], v1[1]); w.w = cvtpk2(v1[2], v1[3]);
                    *(u32x4*)(dst + (size_t)s * 64) = w; } }
    }
};
struct EpiVT {
    static constexpr bool PERM = true, AFTER_DRAIN = false;
    bf16_t* VT; int nrows;
    __device__ __forceinline__ void operator()(const f32x4 (&acc)[2][2][4][2], const Unit& u, int wr, int wc, int fr, int fq) const {
        const int row0 = u.pm * BM + wr * 64 + fr; const int c0 = u.pn * BM + wc * 32 + 8 * fq; const int b = c0 >> 13, s0 = c0 & (XSEQ - 1);
#pragma unroll
        for (int ai = 0; ai < 2; ++ai)
#pragma unroll
            for (int m = 0; m < 4; ++m) { bf16_t* rowp = VT + ((size_t)b * nrows + row0 + ai * HALF + m * 16) * XSEQ + s0;
#pragma unroll
                for (int bj = 0; bj < 2; ++bj) { const f32x4 v0 = acc[ai][bj][m][0], v1 = acc[ai][bj][m][1]; u32x4 w;
                    w.x = cvtpk2(v0[0], v0[1]); w.y = cvtpk2(v0[2], v0[3]); w.z = cvtpk2(v1[0], v1[1]); w.w = cvtpk2(v1[2], v1[3]);
                    *(u32x4*)(rowp + bj * HALF) = w; } }
    }
};
struct EpiRes {
    static constexpr bool PERM = false, AFTER_DRAIN = false;
    const float* xin; float* xout; const float* g;
    __device__ __forceinline__ void operator()(const f32x4 (&acc)[2][2][4][2], const Unit& u, int wr, int wc, int fr, int fq) const {
        const int row0 = u.pm * BM + wr * 64 + fr, col0 = u.pn * BM + wc * 32 + 4 * fq; const int b = u.pm >> 5;
        f32x4 gv[2][2];
#pragma unroll
        for (int bj = 0; bj < 2; ++bj)
#pragma unroll
            for (int n = 0; n < 2; ++n) gv[bj][n] = *(const f32x4*)(g + b * 6144 + col0 + bj * HALF + n * 16);
#pragma unroll
        for (int ai = 0; ai < 2; ++ai)
#pragma unroll
            for (int m = 0; m < 4; ++m) { const size_t off = (size_t)(row0 + ai * HALF + m * 16) * 1024 + col0;
#pragma unroll
                for (int bj = 0; bj < 2; ++bj)
#pragma unroll
                    for (int n = 0; n < 2; ++n) { const f32x4 xi = *(const f32x4*)(xin + off + bj * HALF + n * 16); *(f32x4*)(xout + off + bj * HALF + n * 16) = xi + gv[bj][n] * acc[ai][bj][m][n]; } }
    }
};
template <class Epi, class Sched, bool ALIGN_EPI = false, bool SP2 = false>
__device__ __forceinline__ void gemm_phase(PG8_LAS unsigned char* lds, const Gemm g, const Sched& S, const Epi& E) {
    int tid_ = threadIdx.x; asm volatile("" : "+v"(tid_));
    const int tid = tid_, wid = __builtin_amdgcn_readfirstlane(tid >> 6), lane = tid & 63, wr = wid >> 2, wc = wid & 3, fr = lane & 15, fq = lane >> 4;
    const int K = g.K, nt = K / BK;
    unsigned voffA[2], voffB[2];
#pragma unroll
    for (int i = 0; i < 2; ++i) { int R, C; stage_rc(tid * 16 + i * 8192, R, C); const int Rb = Epi::PERM ? ((R & ~31) + perm32(R & 31)) : R;
        voffA[i] = (unsigned)(R * K + C) * 2u; voffB[i] = (unsigned)(Rb * K + C) * 2u; }
    const size_t kstep = (size_t)(BK * 2);
    const size_t hstep = (size_t)HALF * K * 2;
    const size_t tstep = 2 * hstep;
    const unsigned ldsw = (unsigned)wid * 1024u;
    const int aoff = lds_byte(wr * 64 + fr, fq * 8), boff = lds_byte(wc * 32 + fr, fq * 8);
#define PG8_SA(b, h) (((b) * 2 + (h)) * HTB)
#define PG8_SB(b, h) ((4 + (b) * 2 + (h)) * HTB)
#define PG8_STAGE(bufoff, gbase, voff) do { _Pragma("unroll") for (int _i = 0; _i < 2; ++_i) \
        __builtin_amdgcn_global_load_lds((const unsigned*)((const char*)(gbase) + (voff)[_i]), (PG8_LAS unsigned*)(lds + (bufoff) + ldsw + _i * 8192), 16, 0, 0); } while (0)
#define PG8_LDA(dst, b, h) do { _Pragma("unroll") for (int m = 0; m < 4; ++m) _Pragma("unroll") for (int k = 0; k < 2; ++k) dst[m][k] = *(const PG8_LAS bf16x8*)(lds + PG8_SA(b, h) + aoff + m * 2048 + k * 1024); } while (0)
#define PG8_LDB(dst, b, h) do { _Pragma("unroll") for (int n = 0; n < 2; ++n) _Pragma("unroll") for (int k = 0; k < 2; ++k) dst[n][k] = *(const PG8_LAS bf16x8*)(lds + PG8_SB(b, h) + boff + n * 2048 + k * 1024); } while (0)
#define PG8_MMA(ai, bj, At, Bt) do { __builtin_amdgcn_s_setprio(1); _Pragma("unroll") for (int m = 0; m < 4; ++m) _Pragma("unroll") for (int n = 0; n < 2; ++n) _Pragma("unroll") for (int k = 0; k < 2; ++k) \
        acc[ai][bj][m][n] = __builtin_amdgcn_mfma_f32_16x16x32_bf16(Bt[n][k], At[m][k], acc[ai][bj][m][n], 0, 0, 0); __builtin_amdgcn_s_setprio(0); } while (0)
#define PG8_WAIT_V(n) asm volatile("s_waitcnt vmcnt(" #n ")" ::: "memory")
#define PG8_WAIT_L(n) asm volatile("s_waitcnt lgkmcnt(" #n ")" ::: "memory")
#define PG8_BAR __builtin_amdgcn_s_barrier()
#define PG8_SCHED __builtin_amdgcn_sched_barrier(0)
    Unit cur, nxt; int ui = 0;
    if (!S.next(0, cur)) return;
    f32x4 acc[2][2][4][2];
#pragma unroll
    for (int a = 0; a < 2; ++a)
#pragma unroll
        for (int b = 0; b < 2; ++b)
#pragma unroll
            for (int m = 0; m < 4; ++m)
#pragma unroll
                for (int n = 0; n < 2; ++n) acc[a][b][m][n] = (f32x4){0.f, 0.f, 0.f, 0.f};
    bf16x8 At[4][2], B0[2][2], B1[2][2];
    const char* cA = (const char*)g.A + (size_t)cur.pm * tstep; const char* cB = (const char*)g.Bt + (size_t)cur.pn * tstep;
    S.a_ready(cur);
    if constexpr (SP2) {
        PG8_STAGE(PG8_SB(0, 0), cB, voffB); PG8_STAGE(PG8_SB(0, 1), cB + hstep, voffB); PG8_STAGE(PG8_SA(0, 0), cA, voffA); PG8_STAGE(PG8_SA(0, 1), cA + hstep, voffA);
        if (wr == 1) PG8_BAR;
        PG8_WAIT_V(2); PG8_BAR;
        PG8_STAGE(PG8_SB(1, 0), cB + kstep, voffB); PG8_STAGE(PG8_SA(1, 0), cA + kstep, voffA); PG8_STAGE(PG8_SB(1, 1), cB + hstep + kstep, voffB);
        PG8_WAIT_V(6); PG8_BAR;
    } else {
        PG8_STAGE(PG8_SB(0, 0), cB, voffB); PG8_STAGE(PG8_SA(0, 0), cA, voffA); PG8_STAGE(PG8_SB(0, 1), cB + hstep, voffB); PG8_STAGE(PG8_SA(0, 1), cA + hstep, voffA);
        if (wr == 1) PG8_BAR;
        PG8_WAIT_V(4); PG8_BAR;
        PG8_STAGE(PG8_SB(1, 0), cB + kstep, voffB); PG8_STAGE(PG8_SA(1, 0), cA + kstep, voffA); PG8_STAGE(PG8_SB(1, 1), cB + hstep + kstep, voffB);
        PG8_WAIT_V(6); PG8_BAR;
    }
    for (;;) {
        const bool has_next = S.next(ui + 1, nxt);
        const char* nA = has_next ? (const char*)g.A + (size_t)nxt.pm * tstep : cA; const char* nB = has_next ? (const char*)g.Bt + (size_t)nxt.pn * tstep : cB;
        for (int t = 0; t < nt; t += 2) {
            const bool last = (t == nt - 2);
            const char* a1 = cA + (size_t)(t + 1) * kstep;
            const char* a2 = last ? nA : cA + (size_t)(t + 2) * kstep; const char* b2 = last ? nB : cB + (size_t)(t + 2) * kstep;
            const char* a3 = a2 + kstep; const char* b3 = b2 + kstep;
            if (last && has_next) S.a_ready(nxt);
            if constexpr (SP2) {
            PG8_LDB(B0, 0, 0); PG8_LDB(B1, 0, 1); PG8_SCHED; PG8_LDA(At, 0, 0); PG8_STAGE(PG8_SA(1, 1), a1 + hstep, voffA);
            PG8_WAIT_V(8); PG8_WAIT_L(0); PG8_BAR; PG8_MMA(0, 0, At, B0); PG8_MMA(0, 1, At, B1); PG8_BAR; PG8_SCHED;
            PG8_LDA(At, 0, 1); PG8_STAGE(PG8_SB(0, 0), b2, voffB); PG8_STAGE(PG8_SB(0, 1), b2 + hstep, voffB); PG8_STAGE(PG8_SA(0, 0), a2, voffA);
            PG8_WAIT_V(8); PG8_WAIT_L(0); PG8_BAR; PG8_MMA(1, 0, At, B0); PG8_MMA(1, 1, At, B1); PG8_BAR; PG8_SCHED;
            PG8_LDB(B0, 1, 0); PG8_LDB(B1, 1, 1); PG8_SCHED; PG8_LDA(At, 1, 0); PG8_STAGE(PG8_SA(0, 1), a2 + hstep, voffA);
            PG8_WAIT_V(8); PG8_WAIT_L(0); PG8_BAR; PG8_MMA(0, 0, At, B0); PG8_MMA(0, 1, At, B1); PG8_BAR; PG8_SCHED;
            PG8_LDA(At, 1, 1); PG8_STAGE(PG8_SB(1, 0), b3, voffB); PG8_STAGE(PG8_SB(1, 1), b3 + hstep, voffB); PG8_STAGE(PG8_SA(1, 0), a3, voffA);
            PG8_WAIT_V(8); PG8_WAIT_L(0); PG8_BAR; PG8_MMA(1, 0, At, B0); PG8_MMA(1, 1, At, B1); PG8_BAR; PG8_SCHED;
            } else {
            PG8_LDB(B0, 0, 0); PG8_SCHED; PG8_LDA(At, 0, 0); PG8_STAGE(PG8_SA(1, 1), a1 + hstep, voffA);
            PG8_WAIT_L(8); PG8_BAR; PG8_WAIT_L(0); PG8_MMA(0, 0, At, B0); PG8_BAR; PG8_SCHED;
            PG8_LDB(B1, 0, 1); PG8_STAGE(PG8_SB(0, 0), b2, voffB);
            PG8_BAR; PG8_WAIT_L(0); PG8_MMA(0, 1, At, B1); PG8_BAR;
            PG8_LDA(At, 0, 1); PG8_STAGE(PG8_SA(0, 0), a2, voffA);
            PG8_BAR; PG8_WAIT_L(0); PG8_MMA(1, 0, At, B0); PG8_BAR; PG8_SCHED;
            PG8_STAGE(PG8_SB(0, 1), b2 + hstep, voffB);
            PG8_WAIT_V(6); PG8_BAR; PG8_MMA(1, 1, At, B1); PG8_BAR;
            PG8_LDB(B0, 1, 0); PG8_SCHED; PG8_LDA(At, 1, 0); PG8_STAGE(PG8_SA(0, 1), a2 + hstep, voffA);
            PG8_WAIT_L(8); PG8_BAR; PG8_WAIT_L(0); PG8_MMA(0, 0, At, B0); PG8_BAR; PG8_SCHED;
            PG8_LDB(B1, 1, 1); PG8_STAGE(PG8_SB(1, 0), b3, voffB);
            PG8_BAR; PG8_WAIT_L(0); PG8_MMA(0, 1, At, B1); PG8_BAR;
            PG8_LDA(At, 1, 1); PG8_STAGE(PG8_SA(1, 0), a3, voffA);
            PG8_BAR; PG8_WAIT_L(0); PG8_MMA(1, 0, At, B0); PG8_BAR; PG8_SCHED;
            PG8_STAGE(PG8_SB(1, 1), b3 + hstep, voffB);
            PG8_WAIT_V(6); PG8_BAR; PG8_MMA(1, 1, At, B1); PG8_BAR;
            }
        }
        if constexpr (ALIGN_EPI) { if (wr == 0) PG8_BAR; }
        if constexpr (!Epi::AFTER_DRAIN) { E(acc, cur, wr, wc, fr, fq); S.done(cur); }
        if (!has_next) break;
#pragma unroll
        for (int a = 0; a < 2; ++a)
#pragma unroll
            for (int b = 0; b < 2; ++b)
#pragma unroll
                for (int m = 0; m < 4; ++m)
#pragma unroll
                    for (int n = 0; n < 2; ++n) acc[a][b][m][n] = (f32x4){0.f, 0.f, 0.f, 0.f};
        cur = nxt; cA = nA; cB = nB; ++ui;
        if constexpr (ALIGN_EPI) { if (wr == 1) PG8_BAR; }
    }
    PG8_WAIT_V(0);
    if constexpr (!ALIGN_EPI) { if (wr == 0) PG8_BAR; }
    PG8_BAR;
    if constexpr (Epi::AFTER_DRAIN) { E.fused(acc, cur, wr, wc, fr, fq, lds, wid, lane); S.done(cur); }
#undef PG8_SA
#undef PG8_SB
#undef PG8_STAGE
#undef PG8_LDA
#undef PG8_LDB
#undef PG8_MMA
#undef PG8_WAIT_V
#undef PG8_WAIT_L
#undef PG8_BAR
#undef PG8_SCHED
}
}
#define GAS __attribute__((address_space(1)))
#define LAS __attribute__((address_space(3)))
typedef unsigned short bf16;
typedef unsigned v4u __attribute__((ext_vector_type(4)));
typedef float f32x4 __attribute__((ext_vector_type(4)));
typedef short bf16x8 __attribute__((ext_vector_type(8)));
typedef GAS unsigned gu32;
typedef GAS unsigned long long gu64;
#define RLX_AGENT __ATOMIC_RELAXED, __HIP_MEMORY_SCOPE_AGENT
#define LDS_WAIT() asm volatile("s_waitcnt lgkmcnt(0)" ::: "memory")
#define VM_WAIT() asm volatile("s_waitcnt vmcnt(0)" ::: "memory")
__device__ __forceinline__ unsigned long long rt() { return __builtin_amdgcn_s_memrealtime(); }
__device__ __forceinline__ unsigned f2bf(float f) { unsigned u = __builtin_bit_cast(unsigned, f); return (u + 0x7fffu + ((u >> 16) & 1u)) >> 16; }
__device__ __forceinline__ unsigned pk2(float lo, float hi) { return f2bf(lo) | (f2bf(hi) << 16); }

#define XB_TMO      128
#define XB_XCNT(j)  (256  + 64 * (j))
#define XB_XSUB(j)  (1280 + 64 * (j))
#define XB_XGEN(j)  (2304 + 64 * (j))
#define XB_TOP      3328
#define XB_TOPGEN   3392
#define XCD_BAR_WORDS 3456
#define XB_SPIN_CAP (1u << 18)

__device__ __forceinline__ unsigned xb_ld(unsigned* p)              { return __hip_atomic_load(p, __ATOMIC_RELAXED, __HIP_MEMORY_SCOPE_AGENT); }
__device__ __forceinline__ unsigned xb_add(unsigned* p, unsigned v) { return __hip_atomic_fetch_add(p, v, __ATOMIC_RELAXED, __HIP_MEMORY_SCOPE_AGENT); }
__device__ __forceinline__ unsigned xb_xcc_id() { return (unsigned)__builtin_amdgcn_s_getreg((3 << 11) | 20) & 0xFu; }
#define XB_SPIN(cond, bar) do { unsigned _sp = 0; while (cond) { __builtin_amdgcn_s_sleep(1); \
    if ((++_sp & 255u) == 0u) { if (xb_ld(&(bar)[XB_TMO])) break; if (_sp > XB_SPIN_CAP) { atomicAdd(&(bar)[XB_TMO], 1u); break; } } } } while (0)

struct XcdBarrier {
    unsigned* bar; unsigned x;
    volatile LAS unsigned* st;
};

__device__ __forceinline__ XcdBarrier xcd_barrier_post(unsigned* bar, volatile LAS unsigned* st) {
    XcdBarrier b; b.bar = bar; b.x = xb_xcc_id(); b.st = st;
    if (threadIdx.x == 0) (void)xb_add(&bar[XB_XCNT(b.x)], 1u);
    return b;
}
__device__ __forceinline__ void xcd_barrier_complete(unsigned* bar, unsigned x, unsigned& nloc, unsigned& nx) {
    const unsigned G = gridDim.x * gridDim.y * gridDim.z;
    unsigned sum, cnt, mine, sp = 0u;
    for (;;) {
        sum = 0u; cnt = 0u; mine = 0u;
#pragma unroll
        for (unsigned j = 0; j < 16; ++j) { const unsigned c = xb_ld(&bar[XB_XCNT(j)]); sum += c; cnt += (c > 0u) ? 1u : 0u; mine = (j == x) ? c : mine; }
        if (sum == G) break;
        __builtin_amdgcn_s_sleep(1);
        if ((++sp & 255u) == 0u) { if (xb_ld(&bar[XB_TMO])) break; if (sp > XB_SPIN_CAP) { atomicAdd(&bar[XB_TMO], 1u); break; } }
    }
    nloc = mine > 0u ? mine : 1u; nx = cnt > 0u ? cnt : 1u;
}

__device__ __forceinline__ void xcd_barrier(const XcdBarrier& b) {
    asm volatile("s_waitcnt vmcnt(0)" ::: "memory");
    __syncthreads();
    if (threadIdx.x == 0) {
        unsigned* bar = b.bar;
        __builtin_amdgcn_s_waitcnt(0);
        unsigned nloc = b.st[0], nx = b.st[1];
        if (nloc == 0u) { xcd_barrier_complete(bar, b.x, nloc, nx); b.st[0] = nloc; b.st[1] = nx; }
        const unsigned old = xb_add(&bar[XB_XSUB(b.x)], 1u);
        const unsigned gen = old / nloc;
        if (old + 1u == (gen + 1u) * nloc) {
            __builtin_amdgcn_fence(__ATOMIC_RELEASE, "agent");
            asm volatile("s_waitcnt vmcnt(0)" ::: "memory");
            const unsigned og = xb_add(&bar[XB_TOP], 1u);
            const unsigned tg = og / nx;
            if (og + 1u == (tg + 1u) * nx) xb_add(&bar[XB_TOPGEN], 1u);
            else XB_SPIN(xb_ld(&bar[XB_TOPGEN]) == tg, bar);
            __builtin_amdgcn_fence(__ATOMIC_ACQUIRE, "agent");
            xb_add(&bar[XB_XGEN(b.x)], 1u);
            asm volatile("s_waitcnt vmcnt(0)" ::: "memory");
        } else {
            XB_SPIN(xb_ld(&bar[XB_XGEN(b.x)]) == gen, bar);
            __builtin_amdgcn_fence(__ATOMIC_ACQUIRE, "agent");
            asm volatile("s_waitcnt vmcnt(0)" ::: "memory");
        }
    }
    __syncthreads();
}
constexpr int NWAVES = 8, NTHR = 512;
constexpr int SEQ = 8192, DM = 1024, MROWS = 16384;
constexpr size_t MiB = 1u << 20;
constexpr size_t WS_CTL = 0, CTL_ZERO_BYTES = 2 * MiB;
constexpr size_t WS_KSUM = 1 * MiB;
constexpr size_t WS_MOD = 2 * MiB;
constexpr size_t WS_ROPE = 3 * MiB;
constexpr size_t WS_WIN0 = 4 * MiB, WS_WOUT0 = 9 * MiB, WS_WIN1 = 11 * MiB, WS_WOUT1 = 17 * MiB, WS_WQ0 = 19 * MiB, WS_WQ1 = 23 * MiB;
constexpr size_t WS_SUBK = 27 * MiB, WS_GWS = 28 * MiB, WS_MASK = 29 * MiB, WS_SC = 30 * MiB;
constexpr size_t WS_PTU = 32 * MiB, WS_PTV = 96 * MiB;
constexpr size_t WS_HN = 160 * MiB;
constexpr size_t WS_A = 192 * MiB;
constexpr size_t WS_YCAT = 288 * MiB, WS_QP = 320 * MiB, WS_PO = 384 * MiB, WS_PL = 448 * MiB, WS_END = 450 * MiB;
constexpr int CW_BAR = 4096, CW_WORK = 16384;

constexpr int RING_BYTES = 131072, LDSCTL_OFF = 143360, MISC_OFF = LDSCTL_OFF + 320, LDS_BYTES = 147456;

#ifndef XCC_EXPR
#define XCC_EXPR ((int)(xb_xcc_id() & 7u))
#endif
#define DI __device__ __forceinline__
typedef short bf16x8 __attribute__((ext_vector_type(8)));
typedef short s16x4 __attribute__((ext_vector_type(4)));
typedef float f32x16 __attribute__((ext_vector_type(16)));
typedef __bf16 bf16x2t __attribute__((ext_vector_type(2)));
#define MFMA32(a, b, c) __builtin_amdgcn_mfma_f32_32x32x16_bf16((a), (b), (c), 0, 0, 0)
using pg8::cvtpk2; using pg8::gelu_tanh;
DI int crow(int reg, int h) { return (reg & 3) + 8 * (reg >> 2) + 4 * h; }
DI float bf_lo(unsigned w) { return __uint_as_float(w << 16); }
DI float bf_hi(unsigned w) { return __uint_as_float(w & 0xffff0000u); }
DI bf16x8 ld16g(const bf16* p) { return *(const bf16x8*)p; }
DI bf16x8 ld8x2g(const bf16* p0, const bf16* p1) { const s16x4 a = *(const s16x4*)p0, b = *(const s16x4*)p1; return __builtin_shufflevector(a, b, 0, 1, 2, 3, 4, 5, 6, 7); }
DI float dot2bf(unsigned a, unsigned b, float c) { return __builtin_amdgcn_fdot2_f32_bf16(__builtin_bit_cast(bf16x2t, a), __builtin_bit_cast(bf16x2t, b), c, false); }
DI int f_ord(float f) { int i = __float_as_int(f); return i ^ ((i >> 31) & 0x7fffffff); }
DI float f_unord(int i) { return __int_as_float(i ^ ((i >> 31) & 0x7fffffff)); }
constexpr float LOG2E = 1.4426950408889634f, LN2 = 0.6931471805599453f;
#define KEY_MIN ((int)0x80000000)


template <int CTRL> DI float dppf(float x) { return __builtin_bit_cast(float, __builtin_amdgcn_update_dpp(0, __builtin_bit_cast(int, x), CTRL, 0xF, 0xF, true)); }
template <int CTRL> DI int dppi(int x) { return __builtin_amdgcn_update_dpp(0, x, CTRL, 0xF, 0xF, true); }
#define DPP_X1 0xB1
#define DPP_X2 0x4E
#define DPP_HM 0x141
#define DPP_RM 0x140
#define DPP_R8 0x128
DI unsigned px32u(unsigned x, int lane) { auto r = __builtin_amdgcn_permlane32_swap(x, x, false, false); return (lane & 32) ? r[0] : r[1]; }
DI float px32(float x, int lane) { return __uint_as_float(px32u(__float_as_uint(x), lane)); }
DI int px32(int x, int lane) { return (int)px32u((unsigned)x, lane); }
DI unsigned px16u(unsigned x, int lane) { auto r = __builtin_amdgcn_permlane16_swap(x, x, false, false); return (lane & 16) ? r[0] : r[1]; }
DI float px16(float x, int lane) { return __uint_as_float(px16u(__float_as_uint(x), lane)); }
DI float sum32(float x) { auto r = __builtin_amdgcn_permlane32_swap(__float_as_uint(x), __float_as_uint(x), false, false); return __uint_as_float(r[0]) + __uint_as_float(r[1]); }
DI float sum16(float x) { auto r = __builtin_amdgcn_permlane16_swap(__float_as_uint(x), __float_as_uint(x), false, false); return __uint_as_float(r[0]) + __uint_as_float(r[1]); }
DI float row_sum16(float v) { v += dppf<DPP_X1>(v); v += dppf<DPP_X2>(v); v += dppf<DPP_HM>(v); v += dppf<DPP_RM>(v); return v; }
DI float wave_sum(float v) { return sum32(sum16(row_sum16(v))); }
DI float wave_max(float v) { v = fmaxf(v, dppf<DPP_X1>(v)); v = fmaxf(v, dppf<DPP_X2>(v)); v = fmaxf(v, dppf<DPP_HM>(v)); v = fmaxf(v, dppf<DPP_RM>(v));
    { auto r = __builtin_amdgcn_permlane16_swap(__float_as_uint(v), __float_as_uint(v), false, false); v = fmaxf(__uint_as_float(r[0]), __uint_as_float(r[1])); }
    { auto r = __builtin_amdgcn_permlane32_swap(__float_as_uint(v), __float_as_uint(v), false, false); v = fmaxf(__uint_as_float(r[0]), __uint_as_float(r[1])); } return v; }

struct Frame {
    LAS unsigned char* lds; volatile LAS unsigned* MISC; gu32* ctl; int tid, lane, wave, G, gw, NGW;
};

struct MapId { DI int operator()(int n) const { return n; } };
struct MapWin0 { DI int operator()(int n) const {
    if (n < 1024) return n;
    const int t = (n - 1024) >> 9, c = (n - 1024) & 511, hd = c >> 6, d = c & 63; int bj, p;
    if (t < 2) { if (d < 16) { const int nn = d >> 3, rr = d & 7; bj = 0; p = 8 * (rr >> 2) + 4 * nn + (rr & 3); } else if (d < 32) { bj = 0; p = d; } else { bj = 1; p = d - 32; } }
    else { bj = d >> 5; p = d & 31; }
    return 1024 + 512 * t + 256 * (hd >> 2) + 128 * bj + 32 * (hd & 3) + p; } };
struct MapWin1 { DI int operator()(int n) const { const int t = n >> 10, c = n & 1023, hd = c >> 6, d = c & 63; return 1024 * t + 256 * (hd >> 2) + 128 * (d >> 5) + 32 * (hd & 3) + (d & 31); } };
template <class Map> DI void p0_transpose_item(const float* W, int K, int N, bf16* WT, LAS float* scr, int item, int lane, Map map) {
    const int nblk = N / 32, kb = item / nblk, nb = item % nblk, k0 = 64 * kb, n0 = 32 * nb;
#pragma unroll 8
    for (int i = 0; i < 32; ++i) { const int kk = 2 * i + (lane >> 5); scr[kk * 33 + (lane & 31)] = W[(size_t)(k0 + kk) * N + n0 + (lane & 31)]; }
    LDS_WAIT(); asm volatile("" ::: "memory");
    const int c = lane & 7;
#pragma unroll
    for (int j = 0; j < 4; ++j) { const int n = (lane >> 3) + 8 * j; const LAS float* s = scr + (8 * c) * 33 + n;
        v4u o; o.x = pk2(s[0 * 33], s[1 * 33]); o.y = pk2(s[2 * 33], s[3 * 33]); o.z = pk2(s[4 * 33], s[5 * 33]); o.w = pk2(s[6 * 33], s[7 * 33]);
        *(GAS v4u*)(WT + (size_t)map(n0 + n) * K + k0 + 8 * c) = o; }
    LDS_WAIT(); asm volatile("" ::: "memory");
}
struct P0Args { const float *c, *w_mod, *b_mod, *win0, *wout0, *win1, *wout1, *wq, *subk, *pu, *pv, *gws;
                float *MOD, *ROPE; bf16 *WIN0, *WOUT0, *WIN1, *WOUT1, *WQ0, *WQ1, *SUBK, *GWS; unsigned char *U8, *V8s; float *USC, *VSC; };
DI void p0_prologue(const Frame& F, const P0Args& A) {
    { LAS float* scr = (LAS float*)F.lds;
      for (int task = blockIdx.x; task < 192; task += F.G) {
          const int l = task / 96, n0 = (task % 96) * 64; const float* W = A.w_mod + (size_t)l * 1024 * 6144;
          float a0 = 0.f, a1 = 0.f; const int k0 = F.wave * 128;
#pragma unroll 1
          for (int kb = k0; kb < k0 + 128; kb += 32) { float w[32];
#pragma unroll
              for (int i = 0; i < 32; ++i) w[i] = W[(size_t)(kb + i) * 6144 + n0 + F.lane];
#pragma unroll
              for (int i = 0; i < 32; ++i) { const float c0 = A.c[kb + i], c1 = A.c[1024 + kb + i]; const float s0 = c0 / (1.f + __expf(-c0)), s1 = c1 / (1.f + __expf(-c1)); a0 += s0 * w[i]; a1 += s1 * w[i]; } }
          scr[(F.wave * 2 + 0) * 64 + F.lane] = a0; scr[(F.wave * 2 + 1) * 64 + F.lane] = a1;
          __syncthreads();
          if (F.tid < 128) { const int b = F.tid >> 6, n = F.tid & 63; float s = 0.f;
#pragma unroll
              for (int w = 0; w < 8; ++w) s += scr[(w * 2 + b) * 64 + n];
              A.MOD[(size_t)(l * 2 + b) * 6144 + n0 + n] = s + A.b_mod[l * 6144 + n0 + n]; }
          __syncthreads();
      } }
    { LAS float* scr = (LAS float*)(F.lds + F.wave * 16384);
      constexpr int I0 = 16 * 80, I1 = 16 * 32, I2 = 16 * 96, I3 = 16 * 32, I4 = 16 * 64, I5 = 16 * 64, NIT = I0 + I1 + I2 + I3 + I4 + I5;
      for (int it = F.gw; it < NIT; it += F.NGW) { int r = it;
          if (r < I0) { p0_transpose_item(A.win0, 1024, 2560, A.WIN0, scr, r, F.lane, MapId()); continue; } r -= I0;
          if (r < I1) { p0_transpose_item(A.wout0, 1024, 1024, A.WOUT0, scr, r, F.lane, MapId()); continue; } r -= I1;
          if (r < I2) { p0_transpose_item(A.win1, 1024, 3072, A.WIN1, scr, r, F.lane, MapId()); continue; } r -= I2;
          if (r < I3) { p0_transpose_item(A.wout1, 1024, 1024, A.WOUT1, scr, r, F.lane, MapId()); continue; } r -= I3;
          if (r < I4) { p0_transpose_item(A.wq, 1024, 2048, A.WQ0, scr, r, F.lane, MapId()); continue; } r -= I4;
          p0_transpose_item(A.wq + (size_t)1024 * 2048, 1024, 2048, A.WQ1, scr, r, F.lane, MapId()); } }
    for (int row = F.gw; row < 65536; row += F.NGW) { const bool isv = row >= 32768; const int rr = row & 32767;
        const float* src = (isv ? A.pv : A.pu) + (size_t)rr * 1024; f32x4 v[4]; float mx = 0.f;
#pragma unroll
        for (int k = 0; k < 4; ++k) { v[k] = *(const f32x4*)(src + 4 * F.lane + 256 * k); mx = fmaxf(mx, fmaxf(fmaxf(fabsf(v[k][0]), fabsf(v[k][1])), fmaxf(fabsf(v[k][2]), fabsf(v[k][3])))); }
        mx = wave_max(mx);
        const float top = 127.0f; const float sc = mx > 0.f ? top / mx : 1.0f, inv = mx > 0.f ? mx / top : 1.0f;
#pragma unroll
        for (int k = 0; k < 4; ++k) { const int q0 = __float2int_rn(v[k][0] * sc), q1 = __float2int_rn(v[k][1] * sc), q2 = __float2int_rn(v[k][2] * sc), q3 = __float2int_rn(v[k][3] * sc);
            const unsigned w = (unsigned)(q0 & 255) | ((unsigned)(q1 & 255) << 8) | ((unsigned)(q2 & 255) << 16) | ((unsigned)(q3 & 255) << 24);
            if (!isv) *(unsigned*)(A.U8 + (size_t)rr * 1024 + 4 * F.lane + 256 * k) = w;
            else { const int l = rr >> 14, e = rr & 16383, slab = 2 * k + (F.lane >> 5); *(unsigned*)(A.V8s + (((size_t)l * 8 + slab) * 16384 + e) * 128 + 4 * (F.lane & 31)) = w; } }
        if (F.lane == 0) (isv ? A.VSC : A.USC)[rr] = inv; }
    { const size_t gt = (size_t)F.gw * 64 + F.lane, NT = (size_t)F.NGW * 64;
      for (size_t i = gt; i < 524288 / 8; i += NT) { const float* src = A.subk + i * 8; const f32x4 a = *(const f32x4*)src, b = *(const f32x4*)(src + 4); v4u o; o.x = cvtpk2(a[0], a[1]); o.y = cvtpk2(a[2], a[3]); o.z = cvtpk2(b[0], b[1]); o.w = cvtpk2(b[2], b[3]);
          *(v4u*)(A.SUBK + i * 8) = o; }
      for (size_t i = gt; i < 65536; i += NT) { const int t = (int)(i >> 7) & 127, s = (int)i & 127; A.GWS[i] = (bf16)(cvtpk2(s <= t ? A.gws[i] : 0.f, 0.f) & 0xffffu); }
      for (size_t i = gt; i < 65536; i += NT) { const int pos = (int)(i >> 3), fi = (int)i & 7; const float inv = powf(500000.0f, -(float)fi / 8.0f); const float ang = (float)pos * inv; float sn, cs; sincosf(ang, &sn, &cs);
          A.ROPE[(size_t)pos * 16 + fi] = cs; A.ROPE[(size_t)pos * 16 + 8 + fi] = sn; } }
}

DI void norm_rows(const Frame& F, const float* xs, const float* gamma, const float* modl, int shi, int sci, bf16* HN, unsigned char* HQ = nullptr, float* HS = nullptr) {
    for (int m = F.gw; m < MROWS; m += F.NGW) { const int b = m >> 13;
        const f32x4* xr = (const f32x4*)(xs + (size_t)m * 1024) + F.lane; f32x4 v[4]; float s = 0.f;
#pragma unroll
        for (int j = 0; j < 4; ++j) { v[j] = xr[64 * j]; s += (v[j][0] * v[j][0] + v[j][1] * v[j][1]) + (v[j][2] * v[j][2] + v[j][3] * v[j][3]); }
        const float rinv = rsqrtf(wave_sum(s) * (1.0f / 1024.0f) + 1e-6f);
        unsigned long long* o8 = (unsigned long long*)(HN + (size_t)m * 1024) + F.lane; float mx = 0.f;
#pragma unroll
        for (int j = 0; j < 4; ++j) { const int col = 4 * F.lane + 256 * j; const f32x4 gm = *(const f32x4*)(gamma + col), sc = *(const f32x4*)(modl + b * 6144 + sci * 1024 + col), sh = *(const f32x4*)(modl + b * 6144 + shi * 1024 + col);
            const f32x4 o = v[j] * rinv * gm * (sc + 1.0f) + sh; v[j] = o; mx = fmaxf(mx, fmaxf(fmaxf(fabsf(o[0]), fabsf(o[1])), fmaxf(fabsf(o[2]), fabsf(o[3]))));
            o8[64 * j] = (unsigned long long)cvtpk2(o[0], o[1]) | ((unsigned long long)cvtpk2(o[2], o[3]) << 32); }
        if (HQ) { mx = wave_max(mx); const float qs = mx > 0.f ? 127.0f / mx : 1.0f;
#pragma unroll
            for (int j = 0; j < 4; ++j) { const int q0 = __float2int_rn(v[j][0] * qs), q1 = __float2int_rn(v[j][1] * qs), q2 = __float2int_rn(v[j][2] * qs), q3 = __float2int_rn(v[j][3] * qs);
                *(unsigned*)(HQ + (size_t)m * 1024 + 4 * F.lane + 256 * j) = (unsigned)(q0 & 255) | ((unsigned)(q1 & 255) << 8) | ((unsigned)(q2 & 255) << 16) | ((unsigned)(q3 & 255) << 24); }
            if (F.lane == 0) HS[m] = mx > 0.f ? mx * (1.0f / 127.0f) : 1.0f; }
    }
}

DI void qk_post_task(int task, const bf16* QKR, bf16* Q0, bf16* K0, float* KSUM, const float* rope, const float* gq, const float* gk, LAS float* scr, int tid, int wave, int lane) {
    const int tb = task >> 2, cq = task & 3; const bool isk = cq >= 2; const int head0 = (cq & 1) * 4, hl = (lane >> 2) & 3, qt = lane & 3, rsub = lane >> 4;
    const float* g = (isk ? gk : gq) + qt * 16; float gv[16];
#pragma unroll
    for (int i = 0; i < 16; ++i) gv[i] = g[i];
    float ks[16];
#pragma unroll
    for (int i = 0; i < 16; ++i) ks[i] = 0.f;
    const int b = tb >> 5; bf16* dstb = (isk ? K0 : Q0) + (size_t)(b * 8 + head0 + hl) * SEQ * 64 + qt * 16;
    for (int it = 0; it < 8; ++it) { const int row = tb * 256 + wave * 32 + it * 4 + rsub, s = row & (SEQ - 1);
        const bf16* src = QKR + (size_t)row * 1024 + cq * 256 + hl * 64 + qt * 16; const v4u w0 = *(const v4u*)src, w1 = *(const v4u*)(src + 8);
        float y[16]; y[0] = bf_lo(w0.x); y[1] = bf_hi(w0.x); y[2] = bf_lo(w0.y); y[3] = bf_hi(w0.y); y[4] = bf_lo(w0.z); y[5] = bf_hi(w0.z); y[6] = bf_lo(w0.w); y[7] = bf_hi(w0.w);
        y[8] = bf_lo(w1.x); y[9] = bf_hi(w1.x); y[10] = bf_lo(w1.y); y[11] = bf_hi(w1.y); y[12] = bf_lo(w1.z); y[13] = bf_hi(w1.z); y[14] = bf_lo(w1.w); y[15] = bf_hi(w1.w);
        float ss = 0.f;
#pragma unroll
        for (int i = 0; i < 16; ++i) ss += y[i] * y[i];
        ss += dppf<DPP_X1>(ss); ss += dppf<DPP_X2>(ss);
        const float rinv = rsqrtf(ss * (1.0f / 64.0f) + 1e-6f);
#pragma unroll
        for (int i = 0; i < 16; ++i) y[i] = y[i] * rinv * gv[i];
        if (qt == 0) { const float* rp = rope + (size_t)s * 16;
#pragma unroll
            for (int i = 0; i < 8; ++i) { const float c = rp[i], sn = rp[8 + i], x1 = y[i], x2 = y[i + 8]; y[i] = x1 * c - x2 * sn; y[i + 8] = x1 * sn + x2 * c; } }
        v4u o0, o1; o0.x = cvtpk2(y[0], y[1]); o0.y = cvtpk2(y[2], y[3]); o0.z = cvtpk2(y[4], y[5]); o0.w = cvtpk2(y[6], y[7]); o1.x = cvtpk2(y[8], y[9]); o1.y = cvtpk2(y[10], y[11]); o1.z = cvtpk2(y[12], y[13]); o1.w = cvtpk2(y[14], y[15]);
        bf16* d = dstb + (size_t)s * 64; *(v4u*)d = o0; *(v4u*)(d + 8) = o1;
#pragma unroll
        for (int i = 0; i < 16; ++i) ks[i] += y[i];
    }
    if (isk) {
#pragma unroll
        for (int i = 0; i < 16; ++i) { ks[i] = sum32(sum16(ks[i])); }
        if (lane < 16) {
#pragma unroll
            for (int i = 0; i < 16; ++i) scr[(wave * 16 + lane) * 16 + i] = ks[i]; }
        __syncthreads();
        if (tid < 256) { const int l16 = tid >> 4, i = tid & 15; float sum = 0.f;
#pragma unroll
            for (int w = 0; w < 8; ++w) sum += scr[(w * 16 + l16) * 16 + i];
            KSUM[((size_t)(b * 8 + head0 + (l16 >> 2)) * 32 + (tb & 31)) * 64 + (l16 & 3) * 16 + i] = sum; }
        __syncthreads();
    }
}

DI f32x16 qk_tile(const bf16* krow, const bf16x8 (&qf)[4]) {
    f32x16 s;
#pragma unroll
    for (int i = 0; i < 16; ++i) s[i] = 0.f;
#pragma unroll
    for (int ks = 0; ks < 4; ++ks) s = MFMA32(ld16g(krow + 16 * ks), qf[ks], s);
    return s;
}
DI bf16x8 pack8(const f32x16& x, int s) { v4u p; p.x = cvtpk2(x[8 * s], x[8 * s + 1]); p.y = cvtpk2(x[8 * s + 2], x[8 * s + 3]); p.z = cvtpk2(x[8 * s + 4], x[8 * s + 5]); p.w = cvtpk2(x[8 * s + 6], x[8 * s + 7]); return __builtin_bit_cast(bf16x8, p); }
DI void pv_tile(f32x16 (&o)[2], const bf16* vt, const f32x16& p) {
#pragma unroll
    for (int s = 0; s < 2; ++s) { const bf16x8 pb = pack8(p, s);
#pragma unroll
        for (int mt = 0; mt < 2; ++mt) { const bf16* v = vt + (size_t)mt * 32 * SEQ + 16 * s; o[mt] = MFMA32(ld8x2g(v, v + 8), pb, o[mt]); } }
}
DI void store_ot(bf16* dst, const f32x16 (&o)[2], float sc, int h) {
#pragma unroll
    for (int mt = 0; mt < 2; ++mt)
#pragma unroll
        for (int g = 0; g < 4; ++g) { const unsigned lo = cvtpk2(o[mt][4 * g] * sc, o[mt][4 * g + 1] * sc), hi = cvtpk2(o[mt][4 * g + 2] * sc, o[mt][4 * g + 3] * sc);
            *(unsigned long long*)(dst + 32 * mt + 8 * g + 4 * h) = (unsigned long long)lo | ((unsigned long long)hi << 32); }
}
DI void moba_keys(const bf16* Kh, const bf16* VTh, const bf16x8 (&qf)[4], int key0, int nt, int diag, float mc2, f32x16 (&o)[2], float& l, int r, int h) {
    for (int kt = 0; kt < nt; ++kt) { const int kb = key0 + 32 * kt;
        f32x16 s = qk_tile(Kh + (size_t)(kb + r) * 64 + 8 * h, qf);
        float ls = 0.f;
#pragma unroll
        for (int i = 0; i < 16; ++i) { float p = __builtin_amdgcn_exp2f(s[i] * (0.125f * LOG2E) - mc2); if (kt == diag && crow(i, h) > r) p = 0.f; s[i] = p; ls += p; }
        l += ls;
        pv_tile(o, VTh + (size_t)r * SEQ + kb + 4 * h, s);
    }
}
DI float moba_mc2(const float* gq, const float* gk, int lane) {
    float a = fabsf(gq[lane]), b = fabsf(gk[lane]);
    a = wave_max(a); b = wave_max(b);
    return 8.0f * a * b * LOG2E;
}
struct MobaT { const bf16 *Q, *K, *VT; const float* ksum; unsigned* masks; bf16* PO; float* PL; const float *gq, *gk; };
DI void moba_mask_unit(int u, const MobaT& T, int lane) {
    const int bh = u >> 8, t0 = (u & 255) * 32, own = t0 >> 8, r = lane & 31, h = lane >> 5;
    unsigned mask = 0u;
    if (own > 0) {
        f32x16 g;
#pragma unroll
        for (int i = 0; i < 16; ++i) g[i] = 0.f;
        const float* km = T.ksum + ((size_t)bh * 32 + r) * 64 + 8 * h; const bf16* qp = T.Q + ((size_t)bh * SEQ + t0 + r) * 64 + 8 * h;
#pragma unroll
        for (int ks = 0; ks < 4; ++ks) { const f32x4 a0 = *(const f32x4*)(km + 16 * ks) * (1.0f / 256.0f), a1 = *(const f32x4*)(km + 16 * ks + 4) * (1.0f / 256.0f);
            v4u aw; aw.x = cvtpk2(a0[0], a0[1]); aw.y = cvtpk2(a0[2], a0[3]); aw.z = cvtpk2(a1[0], a1[1]); aw.w = cvtpk2(a1[2], a1[3]);
            g = MFMA32(__builtin_bit_cast(bf16x8, aw), ld16g(qp + 16 * ks), g); }
        int ka = KEY_MIN, kb2 = KEY_MIN, kc = KEY_MIN;
#define INS3(x_) do { int x = (x_); int t = min(ka, x); ka = max(ka, x); int uu = min(kb2, t); kb2 = max(kb2, t); kc = max(kc, uu); } while (0)
#pragma unroll
        for (int i = 0; i < 16; ++i) { const int blk = crow(i, h); const int key = (blk < own) ? ((f_ord(g[i]) & ~31) | (31 - blk)) : KEY_MIN; INS3(key); }
        const int pa = px32(ka, lane), pb = px32(kb2, lane), pc = px32(kc, lane);
        INS3(pa); INS3(pb); INS3(pc);
#undef INS3
        if (ka != KEY_MIN) mask |= 1u << (31 - (ka & 31));
        if (kb2 != KEY_MIN) mask |= 1u << (31 - (kb2 & 31));
        if (kc != KEY_MIN) mask |= 1u << (31 - (kc & 31));
    }
    if (h == 0) T.masks[(size_t)bh * SEQ + t0 + r] = mask;
}
DI void moba_own_unit(int u, const MobaT& T, float mc2, int lane) {
    const int bh = u >> 8, t0 = (u & 255) * 32, own = t0 >> 8, r = lane & 31, h = lane >> 5;
    const bf16* qp = T.Q + ((size_t)bh * SEQ + t0 + r) * 64 + 8 * h; bf16x8 qf[4];
#pragma unroll
    for (int ks = 0; ks < 4; ++ks) qf[ks] = ld16g(qp + 16 * ks);
    f32x16 o[2];
#pragma unroll
    for (int i = 0; i < 16; ++i) { o[0][i] = 0.f; o[1][i] = 0.f; }
    float l = 0.f; const int key0 = own * 256, nt = ((t0 - key0) >> 5) + 1;
    moba_keys(T.K + (size_t)bh * SEQ * 64, T.VT + (size_t)bh * 64 * SEQ, qf, key0, nt, nt - 1, mc2, o, l, r, h);
    l = sum32(l);
    const size_t base = ((size_t)bh * SEQ + t0 + r) * 4 + 3;
    store_ot(T.PO + base * 64, o, 1.0f, h); if (h == 0) T.PL[base] = l;
}
constexpr int MS_K = 0, MS_V = 32768, MS_VROW = 520, MS_LIST = 32768 + 64 * 520, MS_CNT = MS_LIST + 8192, MOBA_NTASK = 16 * 79;
DI void moba_sel_task(int task, const MobaT& T, LAS unsigned char* lds, float mc2, int tid, int wave, int lane) {
    int p, rem = task; if (rem < 128) p = 0; else if (rem < 384) { p = 1; rem -= 128; } else if (rem < 768) { p = 2; rem -= 384; } else { p = 3; rem -= 768; }
    const int j = rem >> 4, bh = rem & 15;
    LAS unsigned* list = (LAS unsigned*)(lds + MS_LIST); LAS unsigned* cntp = (LAS unsigned*)(lds + MS_CNT);
    { const bf16* Kg = T.K + ((size_t)bh * SEQ + 256 * j) * 64; const bf16* Vg = T.VT + (size_t)bh * 64 * SEQ + 256 * j;
      v4u kv[4], vv[4];
#pragma unroll
      for (int i = 0; i < 4; ++i) { const int c = tid + 512 * i; kv[i] = *(const v4u*)(Kg + (size_t)c * 8); const int d = c >> 5, cc = c & 31; vv[i] = *(const v4u*)(Vg + (size_t)d * SEQ + cc * 8); }
      if (tid == 0) *cntp = 0u;
#pragma unroll
      for (int i = 0; i < 4; ++i) { const int c = tid + 512 * i; const int k = c >> 3, ch = c & 7; *(LAS v4u*)(lds + MS_K + k * 128 + ((ch ^ ((k >> 1) & 7)) << 4)) = kv[i];
          const int d = c >> 5, cc = c & 31; LAS unsigned char* vp = lds + MS_V + d * MS_VROW + cc * 16; *(LAS unsigned long long*)vp = (unsigned long long)vv[i].x | ((unsigned long long)vv[i].y << 32); *(LAS unsigned long long*)(vp + 8) = (unsigned long long)vv[i].z | ((unsigned long long)vv[i].w << 32); } }
    __syncthreads();
    { const int qlo = 256 * (8 * p + 1), qhi = (8 * p + 9) * 256 < SEQ ? (8 * p + 9) * 256 : SEQ;
      for (int t0 = qlo + wave * 64; t0 < qhi; t0 += 512) { const int t = t0 + lane; const unsigned mk = T.masks[(size_t)bh * SEQ + t]; const bool sel = (mk >> j) & 1u;
          const unsigned long long bal = __ballot(sel); const int nb = __builtin_popcountll(bal);
          unsigned base = 0; if (lane == 0 && nb) base = __hip_atomic_fetch_add(cntp, (unsigned)nb, __ATOMIC_RELAXED, __HIP_MEMORY_SCOPE_WORKGROUP); base = (unsigned)__builtin_amdgcn_readfirstlane((int)base);
          if (sel) list[base + __builtin_popcountll(bal & ((1ull << lane) - 1ull))] = (unsigned)t; } }
    __syncthreads();
    const int n = (int)*cntp; const int r = lane & 31, h = lane >> 5;
    const LAS unsigned char* kb = lds + MS_K; const LAS unsigned char* vb = lds + MS_V;
    for (int b0 = wave * 32; b0 < n; b0 += 256) { const bool valid = b0 + r < n; const int t = (int)list[valid ? b0 + r : b0];
        const unsigned mk = T.masks[(size_t)bh * SEQ + t]; const int slot = __builtin_popcount(mk & ((1u << j) - 1u));
        const bf16* qp = T.Q + ((size_t)bh * SEQ + t) * 64 + 8 * h; bf16x8 qf[4];
#pragma unroll
        for (int ks = 0; ks < 4; ++ks) qf[ks] = ld16g(qp + 16 * ks);
        f32x16 o[2];
#pragma unroll
        for (int i = 0; i < 16; ++i) { o[0][i] = 0.f; o[1][i] = 0.f; }
        float l = 0.f;
#pragma unroll 2
        for (int kt = 0; kt < 8; ++kt) { const int key = 32 * kt + r;
            f32x16 s;
#pragma unroll
            for (int i = 0; i < 16; ++i) s[i] = 0.f;
#pragma unroll
            for (int ks = 0; ks < 4; ++ks) s = MFMA32(*(const LAS bf16x8*)(kb + key * 128 + (((2 * ks + h) ^ ((key >> 1) & 7)) << 4)), qf[ks], s);
            float ls = 0.f;
#pragma unroll
            for (int i = 0; i < 16; ++i) { const float pv = __builtin_amdgcn_exp2f(s[i] * (0.125f * LOG2E) - mc2); s[i] = pv; ls += pv; }
            l += ls;
#pragma unroll
            for (int sx = 0; sx < 2; ++sx) { const bf16x8 pb = pack8(s, sx);
#pragma unroll
                for (int mt = 0; mt < 2; ++mt) { const LAS unsigned char* vp = vb + (32 * mt + r) * MS_VROW + (32 * kt + 16 * sx + 4 * h) * 2;
                    const s16x4 a0 = *(const LAS s16x4*)vp, a1 = *(const LAS s16x4*)(vp + 16); o[mt] = MFMA32(__builtin_shufflevector(a0, a1, 0, 1, 2, 3, 4, 5, 6, 7), pb, o[mt]); } }
        }
        l = sum32(l);
        if (valid) { const size_t base = ((size_t)bh * SEQ + t) * 4 + slot; store_ot(T.PO + base * 64, o, 1.0f, h); if (h == 0) T.PL[base] = l; }
    }
    __syncthreads();
}
DI void moba_combine(const Frame& F, const bf16* PO, const float* PL, bf16* YCAT) {
    const size_t gt = (size_t)F.gw * 64 + F.lane, NT = (size_t)F.NGW * 64;
    for (size_t i = gt; i < (size_t)16 * SEQ * 8; i += NT) { const int dq = (int)i & 7, t = (int)(i >> 3) & (SEQ - 1), bh = (int)(i >> 16); const int own = t >> 8, ns = own < 3 ? own : 3;
        float o[8]; float l = 0.f;
#pragma unroll
        for (int k = 0; k < 8; ++k) o[k] = 0.f;
#pragma unroll
        for (int s = 0; s < 4; ++s) { if (s < ns || s == 3) { const size_t base = ((size_t)bh * SEQ + t) * 4 + s; l += PL[base]; const v4u w = *(const v4u*)(PO + base * 64 + dq * 8);
                o[0] += bf_lo(w.x); o[1] += bf_hi(w.x); o[2] += bf_lo(w.y); o[3] += bf_hi(w.y); o[4] += bf_lo(w.z); o[5] += bf_hi(w.z); o[6] += bf_lo(w.w); o[7] += bf_hi(w.w); } }
        const float il = 1.0f / l; v4u w; w.x = cvtpk2(o[0] * il, o[1] * il); w.y = cvtpk2(o[2] * il, o[3] * il); w.z = cvtpk2(o[4] * il, o[5] * il); w.w = cvtpk2(o[6] * il, o[7] * il);
        *(v4u*)(YCAT + ((size_t)(bh >> 3) * SEQ + t) * 1024 + 512 + (bh & 7) * 64 + dq * 8) = w; }
}

DI void gmlp_unit(int unit, const bf16* UA, const bf16* VA, const float* vgain, const bf16* GWS, const float* bs, bf16* YCAT, LAS unsigned char* lds, int tid, int wave, int lane) {
    const int cidx = unit >> 2, g = unit & 3, row0 = cidx * 128; LAS bf16* VNT = (LAS bf16*)lds;
    { const int row = tid >> 2, dq = (tid & 3) * 32; const bf16* src = VA + (size_t)(row0 + row) * 512 + g * 128 + dq;
      float f[32]; float ss = 0.f;
#pragma unroll
      for (int k = 0; k < 4; ++k) { const v4u w = *(const v4u*)(src + 8 * k); f[8 * k] = bf_lo(w.x); f[8 * k + 1] = bf_hi(w.x); f[8 * k + 2] = bf_lo(w.y); f[8 * k + 3] = bf_hi(w.y); f[8 * k + 4] = bf_lo(w.z); f[8 * k + 5] = bf_hi(w.z); f[8 * k + 6] = bf_lo(w.w); f[8 * k + 7] = bf_hi(w.w); }
#pragma unroll
      for (int k = 0; k < 32; ++k) ss += f[k] * f[k];
      ss += dppf<DPP_X1>(ss); ss += dppf<DPP_X2>(ss);
      const float rinv = rsqrtf(ss * (1.0f / 128.0f) + 1e-6f);
#pragma unroll
      for (int k = 0; k < 32; ++k) VNT[(dq + k) * 136 + row] = (bf16)(cvtpk2(f[k] * rinv * vgain[g * 128 + dq + k], 0.f) & 0xffffu); }
    __syncthreads();
    { const int mt = wave >> 1, ntb = (wave & 1) * 2, r = lane & 31, h = lane >> 5;
      f32x16 acc[2];
#pragma unroll
      for (int i = 0; i < 16; ++i) { acc[0][i] = 0.f; acc[1][i] = 0.f; }
      const bf16* wp = GWS + ((size_t)g * 128 + 32 * mt + r) * 128 + 8 * h;
      for (int ks = 0; ks < 2 * (mt + 1); ++ks) { const bf16x8 a = ld16g(wp + 16 * ks);
#pragma unroll
          for (int nn = 0; nn < 2; ++nn) { const bf16x8 b = *(const LAS bf16x8*)(VNT + (32 * (ntb + nn) + r) * 136 + 16 * ks + 8 * h); acc[nn] = MFMA32(a, b, acc[nn]); } }
#pragma unroll
      for (int nn = 0; nn < 2; ++nn)
#pragma unroll
          for (int i = 0; i < 16; ++i) { const int t = 32 * mt + crow(i, h), d = 32 * (ntb + nn) + r; const float mixed = acc[nn][i] + bs[g * 128 + t];
              const float uv = __uint_as_float((unsigned)UA[(size_t)(row0 + t) * 512 + g * 128 + d] << 16);
              YCAT[(size_t)(row0 + t) * 1024 + g * 128 + d] = (bf16)(cvtpk2(uv * mixed, 0.f) & 0xffffu); } }
    __syncthreads();
}

struct SbK { bf16x8 k[4]; }; struct SbV { s16x4 v[8]; };
DI void sb_loadk(SbK& f, const bf16* Kh, int kb, int r, int h) {
    const bf16* kp = Kh + (size_t)(kb + r) * 64 + 8 * h;
#pragma unroll
    for (int ks = 0; ks < 4; ++ks) f.k[ks] = ld16g(kp + 16 * ks);
}
DI void sb_loadv(SbV& f, const bf16* VTh, int kb, int r, int h) {
    const bf16* vp = VTh + (size_t)r * SEQ + kb + 4 * h;
#pragma unroll
    for (int s = 0; s < 2; ++s)
#pragma unroll
        for (int mt = 0; mt < 2; ++mt) { const bf16* v = vp + (size_t)mt * 32 * SEQ + 16 * s; f.v[4 * s + 2 * mt] = *(const s16x4*)v; f.v[4 * s + 2 * mt + 1] = *(const s16x4*)(v + 8); }
}
template <bool DIAG> DI void sb_tile(const SbK& fk, const SbV& fv, const bf16x8 (&qf)[4], f32x16 (&o)[2], float& R, int r, int h, int lane) {
    f32x16 s;
#pragma unroll
    for (int i = 0; i < 16; ++i) s[i] = 0.f;
#pragma unroll
    for (int ks = 0; ks < 4; ++ks) s = MFMA32(fk.k[ks], qf[ks], s);
    f32x16 x;
#pragma unroll
    for (int i = 0; i < 16; ++i) { const float z = s[i]; const float t = __builtin_amdgcn_exp2f(-fabsf(z) * LOG2E); const float sp = fmaxf(z, 0.f) + LN2 * __builtin_amdgcn_logf(1.0f + t);
        if (DIAG) { const bool valid = crow(i, h) < r; x[i] = valid ? -sp : 0.f; s[i] = valid ? z : -INFINITY; } else x[i] = -sp; }
    float T4[4], E[16];
#pragma unroll
    for (int g = 0; g < 4; ++g) { E[4 * g + 3] = 0.f; E[4 * g + 2] = x[4 * g + 3]; E[4 * g + 1] = E[4 * g + 2] + x[4 * g + 2]; E[4 * g] = E[4 * g + 1] + x[4 * g + 1]; T4[g] = E[4 * g] + x[4 * g]; }
    float P4[4];
#pragma unroll
    for (int g = 0; g < 4; ++g) P4[g] = px32(T4[g], lane);
    float C[4]; float run = 0.f;
#pragma unroll
    for (int g = 3; g >= 0; --g) { C[g] = run + (h == 0 ? P4[g] : 0.f); run += T4[g] + P4[g]; }
#pragma unroll
    for (int i = 0; i < 16; ++i) { const float arg = x[i] + s[i] + (R + C[i >> 2] + E[i]); x[i] = __builtin_amdgcn_exp2f(arg * LOG2E); }
#pragma unroll
    for (int sx = 0; sx < 2; ++sx) { const bf16x8 pb = pack8(x, sx);
#pragma unroll
        for (int mt = 0; mt < 2; ++mt) o[mt] = MFMA32(__builtin_shufflevector(fv.v[4 * sx + 2 * mt], fv.v[4 * sx + 2 * mt + 1], 0, 1, 2, 3, 4, 5, 6, 7), pb, o[mt]); }
    R += run;
}
constexpr int SB_K = 0, SB_V = 65536, SB_VROW = 1032;
DI void sb_wg_unit(int u, const bf16* Q, const bf16* K, const bf16* VT, bf16* YCAT, LAS unsigned char* lds, int tid, int wave, int lane) {
    const int bh = u >> 5, qb = u & 31, r = lane & 31, h = lane >> 5; const int base = qb > 0 ? 256 * (qb - 1) : 0, nk = qb > 0 ? 512 : 256;
    const bf16* Kh = K + (size_t)bh * SEQ * 64; const bf16* VTh = VT + (size_t)bh * 64 * SEQ;
    { const bf16* Kg = Kh + (size_t)base * 64; const int nch = nk * 8;
      for (int c0 = 0; c0 < nch; c0 += 2048) { v4u kv[4];
#pragma unroll
          for (int i = 0; i < 4; ++i) kv[i] = *(const v4u*)(Kg + (size_t)(c0 + tid + 512 * i) * 8);
#pragma unroll
          for (int i = 0; i < 4; ++i) { const int c = c0 + tid + 512 * i, k = c >> 3, ch = c & 7; *(LAS v4u*)(lds + SB_K + k * 128 + ((ch ^ ((k >> 1) & 7)) << 4)) = kv[i]; } }
      const int cpr = nk / 8;
      for (int c0 = 0; c0 < 64 * cpr; c0 += 2048) { v4u vv[4];
#pragma unroll
          for (int i = 0; i < 4; ++i) { const int c = c0 + tid + 512 * i, d = c / cpr, cc = c - d * cpr; vv[i] = *(const v4u*)(VTh + (size_t)d * SEQ + base + cc * 8); }
#pragma unroll
          for (int i = 0; i < 4; ++i) { const int c = c0 + tid + 512 * i, d = c / cpr, cc = c - d * cpr; LAS unsigned char* vp = lds + SB_V + d * SB_VROW + cc * 16;
              *(LAS unsigned long long*)vp = (unsigned long long)vv[i].x | ((unsigned long long)vv[i].y << 32); *(LAS unsigned long long*)(vp + 8) = (unsigned long long)vv[i].z | ((unsigned long long)vv[i].w << 32); } } }
    const int t0 = 256 * qb + 32 * wave;
    const bf16* qp = Q + ((size_t)bh * SEQ + t0 + r) * 64 + 8 * h; bf16x8 qf[4];
#pragma unroll
    for (int ks = 0; ks < 4; ++ks) qf[ks] = ld16g(qp + 16 * ks);
    __syncthreads();
    f32x16 o[2];
#pragma unroll
    for (int i = 0; i < 16; ++i) { o[0][i] = 0.f; o[1][i] = 0.f; }
    float R = 0.f; bool diag = true;
    for (int kb = t0; kb >= 0; kb -= 32) {
        if (!diag && !__any(R >= -104.0f)) break;
        SbK fk; SbV fv;
        if (kb >= base) { const int kl = kb - base + r;
            const LAS unsigned char* kp = lds + SB_K + kl * 128;
#pragma unroll
            for (int ks = 0; ks < 4; ++ks) fk.k[ks] = *(const LAS bf16x8*)(kp + (((2 * ks + h) ^ ((kl >> 1) & 7)) << 4));
#pragma unroll
            for (int s = 0; s < 2; ++s)
#pragma unroll
                for (int mt = 0; mt < 2; ++mt) { const LAS unsigned char* vp = lds + SB_V + (32 * mt + r) * SB_VROW + (kb - base + 16 * s + 4 * h) * 2; fv.v[4 * s + 2 * mt] = *(const LAS s16x4*)vp; fv.v[4 * s + 2 * mt + 1] = *(const LAS s16x4*)(vp + 16); }
        } else { sb_loadk(fk, Kh, kb, r, h); sb_loadv(fv, VTh, kb, r, h); }
        if (diag) sb_tile<true>(fk, fv, qf, o, R, r, h, lane); else sb_tile<false>(fk, fv, qf, o, R, r, h, lane);
        diag = false;
    }
    store_ot(YCAT + ((size_t)(bh >> 4) * SEQ + t0 + r) * 1024 + (bh & 15) * 64, o, 1.0f, h);
    __syncthreads();
}

#define CE_(a, b) do { const int hi_ = max((a), (b)); (b) = min((a), (b)); (a) = hi_; } while (0)
DI void sort16_desc(int (&v)[16]) {
    CE_(v[0], v[1]); CE_(v[2], v[3]); CE_(v[0], v[2]); CE_(v[1], v[3]); CE_(v[1], v[2]); CE_(v[4], v[5]); CE_(v[6], v[7]); CE_(v[4], v[6]); CE_(v[5], v[7]);
    CE_(v[5], v[6]); CE_(v[0], v[4]); CE_(v[2], v[6]); CE_(v[2], v[4]); CE_(v[1], v[5]); CE_(v[3], v[7]); CE_(v[3], v[5]); CE_(v[1], v[2]); CE_(v[3], v[4]);
    CE_(v[5], v[6]); CE_(v[8], v[9]); CE_(v[10], v[11]); CE_(v[8], v[10]); CE_(v[9], v[11]); CE_(v[9], v[10]); CE_(v[12], v[13]); CE_(v[14], v[15]); CE_(v[12], v[14]);
    CE_(v[13], v[15]); CE_(v[13], v[14]); CE_(v[8], v[12]); CE_(v[10], v[14]); CE_(v[10], v[12]); CE_(v[9], v[13]); CE_(v[11], v[15]); CE_(v[11], v[13]);
    CE_(v[9], v[10]); CE_(v[11], v[12]); CE_(v[13], v[14]); CE_(v[0], v[8]); CE_(v[4], v[12]); CE_(v[4], v[8]); CE_(v[2], v[10]); CE_(v[6], v[14]); CE_(v[6], v[10]);
    CE_(v[2], v[4]); CE_(v[6], v[8]); CE_(v[10], v[12]); CE_(v[1], v[9]); CE_(v[5], v[13]); CE_(v[5], v[9]); CE_(v[3], v[11]); CE_(v[7], v[15]); CE_(v[7], v[11]);
    CE_(v[3], v[5]); CE_(v[7], v[9]); CE_(v[11], v[13]); CE_(v[1], v[2]); CE_(v[3], v[4]); CE_(v[5], v[6]); CE_(v[7], v[8]); CE_(v[9], v[10]); CE_(v[11], v[12]);
    CE_(v[13], v[14]);
}
DI void merge16_desc(int (&A)[16], const int (&B)[16]) {
#pragma unroll
    for (int i = 0; i < 16; ++i) A[i] = max(A[i], B[15 - i]);
    CE_(A[0], A[8]); CE_(A[1], A[9]); CE_(A[2], A[10]); CE_(A[3], A[11]); CE_(A[4], A[12]); CE_(A[5], A[13]); CE_(A[6], A[14]); CE_(A[7], A[15]); CE_(A[0], A[4]);
    CE_(A[1], A[5]); CE_(A[2], A[6]); CE_(A[3], A[7]); CE_(A[8], A[12]); CE_(A[9], A[13]); CE_(A[10], A[14]); CE_(A[11], A[15]); CE_(A[0], A[2]); CE_(A[1], A[3]);
    CE_(A[4], A[6]); CE_(A[5], A[7]); CE_(A[8], A[10]); CE_(A[9], A[11]); CE_(A[12], A[14]); CE_(A[13], A[15]); CE_(A[0], A[1]); CE_(A[2], A[3]); CE_(A[4], A[5]);
    CE_(A[6], A[7]); CE_(A[8], A[9]); CE_(A[10], A[11]); CE_(A[12], A[13]); CE_(A[14], A[15]);
}
#define PEER_CAND_CHUNK(C_, c_) do { \
    if ((c_) == 0) { C_[0] = (f_ord(s1[0] + s2[0]) & ~0x3fff) | a1[0] | a2[0]; C_[1] = (f_ord(s1[0] + s2[1]) & ~0x3fff) | a1[0] | a2[1]; C_[2] = (f_ord(s1[0] + s2[2]) & ~0x3fff) | a1[0] | a2[2]; C_[3] = (f_ord(s1[0] + s2[3]) & ~0x3fff) | a1[0] | a2[3]; C_[4] = (f_ord(s1[0] + s2[4]) & ~0x3fff) | a1[0] | a2[4]; C_[5] = (f_ord(s1[0] + s2[5]) & ~0x3fff) | a1[0] | a2[5]; C_[6] = (f_ord(s1[0] + s2[6]) & ~0x3fff) | a1[0] | a2[6]; C_[7] = (f_ord(s1[0] + s2[7]) & ~0x3fff) | a1[0] | a2[7]; C_[8] = (f_ord(s1[0] + s2[8]) & ~0x3fff) | a1[0] | a2[8]; C_[9] = (f_ord(s1[0] + s2[9]) & ~0x3fff) | a1[0] | a2[9]; C_[10] = (f_ord(s1[0] + s2[10]) & ~0x3fff) | a1[0] | a2[10]; C_[11] = (f_ord(s1[0] + s2[11]) & ~0x3fff) | a1[0] | a2[11]; C_[12] = (f_ord(s1[0] + s2[12]) & ~0x3fff) | a1[0] | a2[12]; C_[13] = (f_ord(s1[0] + s2[13]) & ~0x3fff) | a1[0] | a2[13]; C_[14] = (f_ord(s1[0] + s2[14]) & ~0x3fff) | a1[0] | a2[14]; C_[15] = (f_ord(s1[0] + s2[15]) & ~0x3fff) | a1[0] | a2[15]; } \
    if ((c_) == 1) { C_[0] = (f_ord(s1[1] + s2[0]) & ~0x3fff) | a1[1] | a2[0]; C_[1] = (f_ord(s1[1] + s2[1]) & ~0x3fff) | a1[1] | a2[1]; C_[2] = (f_ord(s1[1] + s2[2]) & ~0x3fff) | a1[1] | a2[2]; C_[3] = (f_ord(s1[1] + s2[3]) & ~0x3fff) | a1[1] | a2[3]; C_[4] = (f_ord(s1[1] + s2[4]) & ~0x3fff) | a1[1] | a2[4]; C_[5] = (f_ord(s1[1] + s2[5]) & ~0x3fff) | a1[1] | a2[5]; C_[6] = (f_ord(s1[1] + s2[6]) & ~0x3fff) | a1[1] | a2[6]; C_[7] = (f_ord(s1[1] + s2[7]) & ~0x3fff) | a1[1] | a2[7]; C_[8] = (f_ord(s1[2] + s2[0]) & ~0x3fff) | a1[2] | a2[0]; C_[9] = (f_ord(s1[2] + s2[1]) & ~0x3fff) | a1[2] | a2[1]; C_[10] = (f_ord(s1[2] + s2[2]) & ~0x3fff) | a1[2] | a2[2]; C_[11] = (f_ord(s1[2] + s2[3]) & ~0x3fff) | a1[2] | a2[3]; C_[12] = (f_ord(s1[2] + s2[4]) & ~0x3fff) | a1[2] | a2[4]; C_[13] = (f_ord(s1[3] + s2[0]) & ~0x3fff) | a1[3] | a2[0]; C_[14] = (f_ord(s1[3] + s2[1]) & ~0x3fff) | a1[3] | a2[1]; C_[15] = (f_ord(s1[3] + s2[2]) & ~0x3fff) | a1[3] | a2[2]; } \
    if ((c_) == 2) { C_[0] = (f_ord(s1[3] + s2[3]) & ~0x3fff) | a1[3] | a2[3]; C_[1] = (f_ord(s1[4] + s2[0]) & ~0x3fff) | a1[4] | a2[0]; C_[2] = (f_ord(s1[4] + s2[1]) & ~0x3fff) | a1[4] | a2[1]; C_[3] = (f_ord(s1[4] + s2[2]) & ~0x3fff) | a1[4] | a2[2]; C_[4] = (f_ord(s1[5] + s2[0]) & ~0x3fff) | a1[5] | a2[0]; C_[5] = (f_ord(s1[5] + s2[1]) & ~0x3fff) | a1[5] | a2[1]; C_[6] = (f_ord(s1[6] + s2[0]) & ~0x3fff) | a1[6] | a2[0]; C_[7] = (f_ord(s1[6] + s2[1]) & ~0x3fff) | a1[6] | a2[1]; C_[8] = (f_ord(s1[7] + s2[0]) & ~0x3fff) | a1[7] | a2[0]; C_[9] = (f_ord(s1[7] + s2[1]) & ~0x3fff) | a1[7] | a2[1]; C_[10] = (f_ord(s1[8] + s2[0]) & ~0x3fff) | a1[8] | a2[0]; C_[11] = (f_ord(s1[9] + s2[0]) & ~0x3fff) | a1[9] | a2[0]; C_[12] = (f_ord(s1[10] + s2[0]) & ~0x3fff) | a1[10] | a2[0]; C_[13] = (f_ord(s1[11] + s2[0]) & ~0x3fff) | a1[11] | a2[0]; C_[14] = (f_ord(s1[12] + s2[0]) & ~0x3fff) | a1[12] | a2[0]; C_[15] = (f_ord(s1[13] + s2[0]) & ~0x3fff) | a1[13] | a2[0]; } \
    if ((c_) == 3) { C_[0] = (f_ord(s1[14] + s2[0]) & ~0x3fff) | a1[14] | a2[0]; C_[1] = (f_ord(s1[15] + s2[0]) & ~0x3fff) | a1[15] | a2[0]; C_[2] = KEY_MIN; C_[3] = KEY_MIN; C_[4] = KEY_MIN; C_[5] = KEY_MIN; C_[6] = KEY_MIN; C_[7] = KEY_MIN; C_[8] = KEY_MIN; C_[9] = KEY_MIN; C_[10] = KEY_MIN; C_[11] = KEY_MIN; C_[12] = KEY_MIN; C_[13] = KEY_MIN; C_[14] = KEY_MIN; C_[15] = KEY_MIN; } \
} while (0)

DI void peer_scores(int tokg, int head, const bf16* QP, const bf16* SUBK, unsigned* ent  , int lane) {
    const int r = lane & 31, h = lane >> 5;
    int L1[16], L2[16];
#pragma unroll
    for (int p = 0; p < 2; ++p) {
        const bf16* qp = QP + (size_t)(tokg + r) * 2048 + head * 256 + p * 128 + 8 * h; bf16x8 qf[8];
#pragma unroll
        for (int ks = 0; ks < 8; ++ks) qf[ks] = ld16g(qp + 16 * ks);
        const bf16* sk = SUBK + (size_t)((head * 2 + p) * 128 + r) * 128 + 8 * h;
        int L[16];
#pragma unroll
        for (int i = 0; i < 16; ++i) L[i] = KEY_MIN;
#pragma unroll 1
        for (int mt = 0; mt < 4; ++mt) {
            f32x16 acc;
#pragma unroll
            for (int i = 0; i < 16; ++i) acc[i] = 0.f;
#pragma unroll
            for (int ks = 0; ks < 8; ++ks) acc = MFMA32(ld16g(sk + (size_t)mt * 32 * 128 + 16 * ks), qf[ks], acc);
            int Nw[16];
#pragma unroll
            for (int i = 0; i < 16; ++i) Nw[i] = (f_ord(acc[i]) & ~127) | (32 * mt + crow(i, h));
            sort16_desc(Nw); merge16_desc(L, Nw);
        }
        int Pn[16];
#pragma unroll
        for (int i = 0; i < 16; ++i) Pn[i] = px32(L[i], lane);
        merge16_desc(L, Pn);
#pragma unroll
        for (int i = 0; i < 16; ++i) { if (p == 0) L1[i] = L[i]; else L2[i] = L[i]; }
    }
    float s1[16], s2[16]; int a1[16], a2[16];
#pragma unroll
    for (int i = 0; i < 16; ++i) { s1[i] = f_unord(L1[i] & ~127); s2[i] = f_unord(L2[i] & ~127); a1[i] = (L1[i] & 127) << 7; a2[i] = L2[i] & 127; }
    int Cn[16];
    PEER_CAND_CHUNK(Cn, 0); sort16_desc(Cn);
#pragma unroll
    for (int c = 1; c < 4; ++c) { int Dn[16]; PEER_CAND_CHUNK(Dn, c); sort16_desc(Dn); merge16_desc(Cn, Dn); }
    float e[16]; float sum = 0.f; const float m0 = f_unord(Cn[0] & ~0x3fff);
#pragma unroll
    for (int k = 0; k < 16; ++k) { e[k] = __builtin_amdgcn_exp2f((f_unord(Cn[k] & ~0x3fff) - m0) * LOG2E); sum += e[k]; }
    const float inv = 1.0f / sum;
    if (h == 0) { unsigned* dst = ent + (size_t)r * 128 + head * 16;
#pragma unroll
        for (int g4 = 0; g4 < 4; ++g4) { v4u w;
            w.x = (cvtpk2(0.f, e[4 * g4] * inv) & 0xffff0000u) | (unsigned)(Cn[4 * g4] & 0x3fff); w.y = (cvtpk2(0.f, e[4 * g4 + 1] * inv) & 0xffff0000u) | (unsigned)(Cn[4 * g4 + 1] & 0x3fff);
            w.z = (cvtpk2(0.f, e[4 * g4 + 2] * inv) & 0xffff0000u) | (unsigned)(Cn[4 * g4 + 2] & 0x3fff); w.w = (cvtpk2(0.f, e[4 * g4 + 3] * inv) & 0xffff0000u) | (unsigned)(Cn[4 * g4 + 3] & 0x3fff);
            *(v4u*)(dst + 4 * g4) = w; } }
}
typedef float f32x2 __attribute__((ext_vector_type(2)));
DI f32x2 fp8lo(unsigned w) { return __builtin_amdgcn_cvt_pk_f32_fp8((int)w, false); }
DI f32x2 fp8hi(unsigned w) { return __builtin_amdgcn_cvt_pk_f32_fp8((int)w, true); }
DI f32x2 fma2(f32x2 a, f32x2 b, f32x2 c) { float x = c.x, y = c.y; asm("v_fmac_f32 %0, %1, %2" : "+v"(x) : "v"(a.x), "v"(b.x)); asm("v_fmac_f32 %0, %1, %2" : "+v"(y) : "v"(a.y), "v"(b.y)); return (f32x2){x, y}; }
constexpr int PU_LIST = 0, PU_H = 65536, PU_USC = 98304, PU_VSC = 106496, PU_BC = 114688, PU_LCAP = 160;
template <int VAR> DI void peer_u_issue(v4u (&rw)[16], const unsigned char* U8, const LAS unsigned* lev, int lane) {
#pragma unroll
    for (int k4 = 0; k4 < 4; ++k4) { const v4u ev = *(const LAS v4u*)(lev + 4 * k4);
#pragma unroll
        for (int k = 0; k < 4; ++k) rw[4 * k4 + k] = *(const v4u*)(U8 + (size_t)(ev[k] & 0x3fffu) * 1024 + 16 * lane); }
}
template <int VAR> DI void peer_u_compute(const v4u (&rw)[16], const LAS unsigned char* hrow, float hs, const LAS unsigned* lev, const LAS unsigned* lslot, int nvalid, int tok, const LAS float* uscs, const LAS float* vscs, float* ACT, int lane) {
    const v4u hq = *(const LAS v4u*)(hrow + 16 * lane);
    int p[16];
#pragma unroll
    for (int k = 0; k < 16; ++k) { int a = __builtin_amdgcn_sdot4((int)rw[k].x, (int)hq.x, 0, false); a = __builtin_amdgcn_sdot4((int)rw[k].y, (int)hq.y, a, false); a = __builtin_amdgcn_sdot4((int)rw[k].z, (int)hq.z, a, false); p[k] = __builtin_amdgcn_sdot4((int)rw[k].w, (int)hq.w, a, false); }
    { const bool up = (lane & 8) != 0;
#pragma unroll
      for (int i = 0; i < 8; ++i) { const int keep = up ? p[i + 8] : p[i], send = up ? p[i] : p[i + 8]; p[i] = keep + dppi<DPP_RM>(send); } }
    { const bool up = (lane & 4) != 0;
#pragma unroll
      for (int i = 0; i < 4; ++i) { const int keep = up ? p[i + 4] : p[i], send = up ? p[i] : p[i + 4]; p[i] = keep + dppi<DPP_HM>(send); } }
    { const bool up = (lane & 2) != 0;
#pragma unroll
      for (int i = 0; i < 2; ++i) { const int keep = up ? p[i + 2] : p[i], send = up ? p[i] : p[i + 2]; p[i] = keep + dppi<DPP_X2>(send); } }
    { const bool up = (lane & 1) != 0; const int keep = up ? p[1] : p[0], send = up ? p[0] : p[1]; p[0] = keep + dppi<DPP_X1>(send); }
    int dq = p[0];
    { auto r = __builtin_amdgcn_permlane16_swap((unsigned)dq, (unsigned)dq, false, false); dq = (int)r[0] + (int)r[1]; }
    { auto r = __builtin_amdgcn_permlane32_swap((unsigned)dq, (unsigned)dq, false, false); dq = (int)r[0] + (int)r[1]; }
    const int myk = lane & 15;
    if (lane < 16 && myk < nvalid) { const unsigned mev = lev[myk], mslot = lslot[myk]; const unsigned er = mev & 2047u;
        ACT[(VAR == 1) ? (size_t)lane : ((size_t)tok * 128 + mslot)] = gelu_tanh((float)dq * hs * uscs[er]) * __uint_as_float(mev & 0xffff0000u) * vscs[er]; }
}
DI void peer_u_loade(int tok, const unsigned* ENT, unsigned (&e0)[4], unsigned (&e1)[4], int lane) {
#pragma unroll
    for (int t = 0; t < 4; ++t) { e0[t] = ENT[(size_t)(tok + t) * 128 + lane]; e1[t] = ENT[(size_t)(tok + t) * 128 + 64 + lane]; }
}
template <int VAR> DI void peer_u_wave(int tok0, int slab, const unsigned* ENT, const unsigned char* HQ, const float* HS, const unsigned char* U8, float* ACT, LAS unsigned char* lds, int wave, int lane) {
    LAS unsigned* lev = (LAS unsigned*)(lds + PU_LIST + wave * 8192); LAS unsigned* lslot = lev + 4 * PU_LCAP; LAS unsigned char* hb = lds + PU_H + wave * 4096;
    const LAS float* uscs = (const LAS float*)(lds + PU_USC); const LAS float* vscs = (const LAS float*)(lds + PU_VSC);
    unsigned e0[4], e1[4];
    peer_u_loade(tok0, ENT, e0, e1, lane);
#pragma unroll 1
    for (int bt = 0; bt < 4; ++bt) { const int tb = tok0 + 4 * bt;
        v4u hq[4]; float hsv[4];
#pragma unroll
        for (int t = 0; t < 4; ++t) { hq[t] = *(const v4u*)(HQ + (size_t)(tb + t) * 1024 + 16 * lane); hsv[t] = HS[tb + t]; }
        int cnt[4]; const unsigned long long lt = (1ull << lane) - 1ull;
#pragma unroll
        for (int t = 0; t < 4; ++t) { const bool in0 = ((e0[t] >> 11) & 7u) == (unsigned)slab, in1 = ((e1[t] >> 11) & 7u) == (unsigned)slab;
            const unsigned long long b0 = __ballot(in0), b1 = __ballot(in1); const int n0 = __builtin_popcountll(b0), n = n0 + __builtin_popcountll(b1);
            LAS unsigned* le = lev + t * PU_LCAP; LAS unsigned* ls = lslot + t * PU_LCAP;
            if (in0) { const int p = __builtin_popcountll(b0 & lt); le[p] = e0[t]; ls[p] = (unsigned)lane; }
            if (in1) { const int p = n0 + __builtin_popcountll(b1 & lt); le[p] = e1[t]; ls[p] = (unsigned)(64 + lane); }
            if (n > 0 && lane < 16) { const unsigned pe = b0 ? (unsigned)__builtin_amdgcn_readlane((int)e0[t], (int)__builtin_ctzll(b0 | (1ull << 63))) : (unsigned)__builtin_amdgcn_readlane((int)e1[t], (int)__builtin_ctzll(b1 | (1ull << 63)));
                if (n + lane < ((n + 15) & ~15)) le[n + lane] = pe; }
            cnt[t] = n; }
        if (bt < 3) peer_u_loade(tb + 4, ENT, e0, e1, lane);
#pragma unroll
        for (int t = 0; t < 4; ++t) *(LAS v4u*)(hb + t * 1024 + 16 * lane) = hq[t];
        asm volatile("s_waitcnt lgkmcnt(0)" ::: "memory");
#define PU_CNT(t_) ((t_) == 0 ? cnt[0] : ((t_) == 1 ? cnt[1] : ((t_) == 2 ? cnt[2] : cnt[3])))
#define PU_HS(t_) ((t_) == 0 ? hsv[0] : ((t_) == 1 ? hsv[1] : ((t_) == 2 ? hsv[2] : hsv[3])))
#define PU_ADV(tk_, g_) do { while ((tk_) < 4 && (g_) >= PU_CNT(tk_)) { ++(tk_); (g_) = 0; } } while (0)
        int tk = 0, g = 0; PU_ADV(tk, g);
        if (tk < 4) { v4u ra[16], rb[16];
            peer_u_issue<VAR>(ra, U8, lev + tk * PU_LCAP + g, lane);
            for (;;) {
                int ntk = tk, ng = g + 16; PU_ADV(ntk, ng);
                if (ntk < 4) peer_u_issue<VAR>(rb, U8, lev + ntk * PU_LCAP + ng, lane);
                peer_u_compute<VAR>(ra, hb + tk * 1024, PU_HS(tk), lev + tk * PU_LCAP + g, lslot + tk * PU_LCAP + g, PU_CNT(tk) - g, tb + tk, uscs, vscs, ACT, lane);
                tk = ntk; g = ng; if (tk >= 4) break;
                ntk = tk; ng = g + 16; PU_ADV(ntk, ng);
                if (ntk < 4) peer_u_issue<VAR>(ra, U8, lev + ntk * PU_LCAP + ng, lane);
                peer_u_compute<VAR>(rb, hb + tk * 1024, PU_HS(tk), lev + tk * PU_LCAP + g, lslot + tk * PU_LCAP + g, PU_CNT(tk) - g, tb + tk, uscs, vscs, ACT, lane);
                tk = ntk; g = ng; if (tk >= 4) break;
            } }
#undef PU_CNT
#undef PU_HS
#undef PU_ADV
        asm volatile("s_waitcnt lgkmcnt(0)" ::: "memory");
    }
}
template <int VVAR> DI void peer_v_wave(int tok0, int slab, const unsigned* ENT, const float* ACT, const unsigned char* V8slab, float* X, const float* g2, int lane) {
    const int sub = lane & 7, j = lane >> 3;
    const int col = 128 * slab + 16 * sub + 2 * (4 * ((lane >> 5) & 1) + 2 * ((lane >> 4) & 1) + ((lane >> 3) & 1));
    const f32x2 gv = *(const f32x2*)(g2 + (tok0 >> 13) * 6144 + col);
    v4u enn[4]; f32x4 awn[4]; f32x2 xvn;
    { const v4u* ep = (const v4u*)(ENT + (size_t)tok0 * 128 + 16 * j); const f32x4* ap = (const f32x4*)(ACT + (size_t)tok0 * 128 + 16 * j);
#pragma unroll
      for (int q = 0; q < 4; ++q) { enn[q] = ep[q]; awn[q] = ap[q]; }
      xvn = *(const f32x2*)(X + (size_t)tok0 * 1024 + col); }
    (void)0;
#pragma unroll 1
    for (int it = 0; it < 8; ++it) { const int tok = tok0 + it;
        v4u en[4]; f32x4 aw[4]; const f32x2 xv = xvn;
#pragma unroll
        for (int q = 0; q < 4; ++q) { en[q] = enn[q]; aw[q] = awn[q]; }
        v4u rw[16];
#pragma unroll
        for (int i = 0; i < 16; ++i) rw[i] = *(const v4u*)(V8slab + (size_t)((VVAR >= 2) ? (unsigned)(i + 16 * j) : (en[i >> 2][i & 3] & 0x3fffu)) * 128 + 16 * sub);
        if (it < 7 && VVAR != 3) { const v4u* ep = (const v4u*)(ENT + (size_t)(tok + 1) * 128 + 16 * j); const f32x4* ap = (const f32x4*)(ACT + (size_t)(tok + 1) * 128 + 16 * j);
#pragma unroll
            for (int q = 0; q < 4; ++q) { enn[q] = ep[q]; awn[q] = ap[q]; }
            xvn = *(const f32x2*)(X + (size_t)(tok + 1) * 1024 + col); }
        float wm = 0.f;
#pragma unroll
        for (int q = 0; q < 4; ++q) wm = fmaxf(wm, fmaxf(fmaxf(fabsf(aw[q][0]), fabsf(aw[q][1])), fmaxf(fabsf(aw[q][2]), fabsf(aw[q][3]))));
        wm = fmaxf(wm, dppf<DPP_R8>(wm)); wm = fmaxf(wm, px16(wm, lane)); wm = fmaxf(wm, px32(wm, lane));
        const float wsq = wm > 0.f ? 127.0f / wm : 0.f, winv = wm * (1.0f / 127.0f);
        unsigned W[4];
#pragma unroll
        for (int q = 0; q < 4; ++q) { const int q0 = __float2int_rn(aw[q][0] * wsq), q1 = __float2int_rn(aw[q][1] * wsq), q2 = __float2int_rn(aw[q][2] * wsq), q3 = __float2int_rn(aw[q][3] * wsq);
            W[q] = (unsigned)(q0 & 255) | ((unsigned)(q1 & 255) << 8) | ((unsigned)(q2 & 255) << 16) | ((unsigned)(q3 & 255) << 24); }
        int acc[16];
#pragma unroll
        for (int c = 0; c < 16; ++c) acc[c] = 0;
#pragma unroll
        for (int g = 0; g < 4; ++g)
#pragma unroll
            for (int q = 0; q < 4; ++q) { const unsigned m0 = rw[4 * g][q], m1 = rw[4 * g + 1][q], m2 = rw[4 * g + 2][q], m3 = rw[4 * g + 3][q];
                const unsigned t0 = __builtin_amdgcn_perm(m1, m0, 0x05010400u), t1 = __builtin_amdgcn_perm(m1, m0, 0x07030602u), t2 = __builtin_amdgcn_perm(m3, m2, 0x05010400u), t3 = __builtin_amdgcn_perm(m3, m2, 0x07030602u);
                acc[4 * q] = __builtin_amdgcn_sdot4((int)__builtin_amdgcn_perm(t2, t0, 0x05040100u), (int)W[g], acc[4 * q], false);
                acc[4 * q + 1] = __builtin_amdgcn_sdot4((int)__builtin_amdgcn_perm(t2, t0, 0x07060302u), (int)W[g], acc[4 * q + 1], false);
                acc[4 * q + 2] = __builtin_amdgcn_sdot4((int)__builtin_amdgcn_perm(t3, t1, 0x05040100u), (int)W[g], acc[4 * q + 2], false);
                acc[4 * q + 3] = __builtin_amdgcn_sdot4((int)__builtin_amdgcn_perm(t3, t1, 0x07060302u), (int)W[g], acc[4 * q + 3], false); }
        { const bool up = (lane & 32) != 0;
#pragma unroll
          for (int c = 0; c < 8; ++c) { const int keep = up ? acc[c + 8] : acc[c], send = up ? acc[c] : acc[c + 8]; acc[c] = keep + px32(send, lane); } }
        { const bool up = (lane & 16) != 0;
#pragma unroll
          for (int c = 0; c < 4; ++c) { const int keep = up ? acc[c + 4] : acc[c], send = up ? acc[c] : acc[c + 4]; acc[c] = keep + (int)px16u((unsigned)send, lane); } }
        { const bool up = (lane & 8) != 0;
#pragma unroll
          for (int c = 0; c < 2; ++c) { const int keep = up ? acc[c + 2] : acc[c], send = up ? acc[c] : acc[c + 2]; acc[c] = keep + dppi<DPP_R8>(send); } }
        *(f32x2*)(X + (size_t)tok * 1024 + col) = (f32x2){xv.x + gv.x * ((float)acc[0] * winv), xv.y + gv.y * ((float)acc[1] * winv)};
    }
}
struct PeerT { const unsigned char *U8, *V8s; const float *USC, *VSC; unsigned* ENT; float* ACT; const unsigned char* HQ; const float* HS; float* X; const float* g2; };
DI void peer_scores_phase(const Frame& F, const bf16* QP, const bf16* SUBK, unsigned* ENT) {
    for (int unit = blockIdx.x; unit < MROWS / 64; unit += F.G) {
#pragma unroll 1
        for (int grp = 0; grp < 2; ++grp) { const int tokg = unit * 64 + 32 * grp; peer_scores(tokg, F.wave, QP, SUBK, ENT + (size_t)tokg * 128, F.lane); } }
}
template <int PASS, int VAR = 0> DI void peer_gather_phase(const Frame& F, int cnt_base, const PeerT& T) {
    const int xcc = XCC_EXPR; LAS int* bc = (LAS int*)(F.lds + PU_BC);
    constexpr int CHT = (PASS == 0) ? 128 : 64;
    for (int k = 0; k < 8; ++k) { const int s = (xcc + k) & 7; unsigned* cnt = (unsigned*)(F.ctl + CW_WORK + 64 * (cnt_base + s));
        if (PASS == 0) { for (int i = F.tid; i < 2048; i += NTHR) { ((LAS float*)(F.lds + PU_USC))[i] = T.USC[2048 * s + i]; ((LAS float*)(F.lds + PU_VSC))[i] = T.VSC[2048 * s + i]; } }
        for (;;) {
            if (F.tid == 0) *bc = (int)__hip_atomic_fetch_add(cnt, 1u, __ATOMIC_RELAXED, __HIP_MEMORY_SCOPE_AGENT);
            __syncthreads(); const int chunk = *bc; __syncthreads();
            if (chunk >= MROWS / CHT) break;
            if (PASS == 0) peer_u_wave<VAR>(chunk * 128 + F.wave * 16, s, T.ENT, T.HQ, T.HS, T.U8, T.ACT, F.lds, F.wave, F.lane);
            else peer_v_wave<VAR>(chunk * 64 + F.wave * 8, s, T.ENT, T.ACT, T.V8s + (size_t)s * 16384 * 128, T.X, T.g2, F.lane);
        } }
}
struct Args { const float* in[19]; float* out; unsigned char* ws; int stage, pad; };
__global__ void __launch_bounds__(NTHR, 2) hybrid_fwd(Args args) {
    extern __shared__ __attribute__((aligned(16))) unsigned char lds_raw[];
    for (int u = threadIdx.x; u < (LDS_BYTES - LDSCTL_OFF) / 4; u += NTHR) ((LAS unsigned*)((LAS unsigned char*)lds_raw + LDSCTL_OFF))[u] = 0u;
    __syncthreads();
    XcdBarrier bar = xcd_barrier_post((unsigned*)((gu32*)(args.ws + WS_CTL) + CW_BAR), (volatile LAS unsigned*)((LAS unsigned char*)lds_raw + MISC_OFF) + 8);
#ifdef PROBE_MASK
    volatile LAS unsigned long long* stamps_ = (volatile LAS unsigned long long*)((LAS unsigned char*)lds_raw + MISC_OFF + 256); int nst_ = 0;
#ifndef PROBE_BLK
#define PROBE_BLK 0
#endif
#define STAMP() do { if (blockIdx.x == PROBE_BLK && threadIdx.x == 0) stamps_[nst_] = __builtin_amdgcn_s_memrealtime(); ++nst_; } while (0)
#else
#define STAMP() do {} while (0)
#endif
    STAMP();
#define GRID_BAR() do { xcd_barrier(bar); STAMP(); } while (0)
#define OPQ(p) ({ size_t z_ = 0; asm volatile("" : "+s"(z_)); (p) + z_; })
#define PH_PTRS \
    unsigned char* ws = OPQ(args.ws); const float* x_in = OPQ(args.in[0]); float* X = OPQ(args.out); \
    const float *norm_mix = args.in[4], *norm_ffn = args.in[5]; \
    float* MOD = (float*)(ws + WS_MOD); float* ROPE = (float*)(ws + WS_ROPE); float* KSUM = (float*)(ws + WS_KSUM); \
    bf16 *WIN0 = (bf16*)(ws + WS_WIN0), *WOUT0 = (bf16*)(ws + WS_WOUT0), *WIN1 = (bf16*)(ws + WS_WIN1), *WOUT1 = (bf16*)(ws + WS_WOUT1), *WQ0 = (bf16*)(ws + WS_WQ0), *WQ1 = (bf16*)(ws + WS_WQ1); \
    bf16 *SUBK = (bf16*)(ws + WS_SUBK), *GWS = (bf16*)(ws + WS_GWS), *HN = (bf16*)(ws + WS_HN); \
    bf16 *UA = (bf16*)(ws + WS_A), *VA = (bf16*)(ws + WS_A + 16 * MiB), *Q0 = (bf16*)(ws + WS_A + 32 * MiB), *K0 = (bf16*)(ws + WS_A + 48 * MiB), *VT0 = (bf16*)(ws + WS_A + 64 * MiB); \
    bf16 *Q1 = (bf16*)(ws + WS_A), *K1 = (bf16*)(ws + WS_A + 32 * MiB), *VT1 = (bf16*)(ws + WS_A + 64 * MiB); \
    bf16 *YCAT = (bf16*)(ws + WS_YCAT), *QP = (bf16*)(ws + WS_QP), *PO = (bf16*)(ws + WS_PO); float* PL = (float*)(ws + WS_PL); unsigned* MASKS = (unsigned*)(ws + WS_MASK); unsigned char *U8 = ws + WS_PTU, *V8s = ws + WS_PTV; float *USC = (float*)(ws + WS_SC), *VSC = USC + 32768; unsigned* ENT = (unsigned*)(ws + WS_PO); float* ACT = (float*)(ws + WS_PO + 8 * MiB); unsigned char* HQ = ws + WS_A; float* HS = (float*)(ws + WS_SC + 512 * 1024); (void)HQ; (void)HS; (void)U8; (void)V8s; (void)USC; (void)VSC; (void)ENT; (void)ACT; bf16* QKR = (bf16*)(ws + WS_QP); (void)QKR; \
    (void)x_in; (void)X; (void)norm_mix; (void)norm_ffn; (void)MOD; (void)ROPE; (void)KSUM; (void)WIN0; (void)WOUT0; (void)WIN1; (void)WOUT1; (void)WQ0; (void)WQ1; (void)SUBK; (void)GWS; (void)HN; \
    (void)UA; (void)VA; (void)Q0; (void)K0; (void)VT0; (void)Q1; (void)K1; (void)VT1; (void)YCAT; (void)QP; (void)PO; (void)PL; (void)MASKS;
#define PH_FRAME Frame F; F.lds = (LAS unsigned char*)lds_raw; F.MISC = (volatile LAS unsigned*)(F.lds + MISC_OFF); { int t_ = threadIdx.x; asm volatile("" : "+v"(t_)); F.tid = t_; } F.lane = F.tid & 63; F.wave = __builtin_amdgcn_readfirstlane(F.tid >> 6); \
    F.G = gridDim.x; F.gw = blockIdx.x * NWAVES + F.wave; F.NGW = F.G * NWAVES; F.ctl = (gu32*)(OPQ(args.ws) + WS_CTL);
    { PH_FRAME PH_PTRS
      P0Args A; A.c = args.in[1]; A.w_mod = args.in[2]; A.b_mod = args.in[3]; A.win0 = args.in[6]; A.wout0 = args.in[12]; A.win1 = args.in[13]; A.wout1 = args.in[14]; A.wq = args.in[15]; A.subk = args.in[16];
      A.pu = args.in[17]; A.pv = args.in[18]; A.gws = args.in[8]; A.MOD = MOD; A.ROPE = ROPE; A.WIN0 = WIN0; A.WOUT0 = WOUT0; A.WIN1 = WIN1; A.WOUT1 = WOUT1; A.WQ0 = WQ0; A.WQ1 = WQ1; A.SUBK = SUBK; A.GWS = GWS; A.U8 = U8; A.V8s = V8s; A.USC = USC; A.VSC = VSC;
      p0_prologue(F, A); }
    GRID_BAR();
    { PH_FRAME PH_PTRS norm_rows(F, x_in, norm_mix, MOD, 0, 1, HN); }
    GRID_BAR();
    { PH_FRAME PH_PTRS
      pg8::Gemm g{HN, WIN0, MROWS, 2048, 1024}; pg8::StaticOrder S; S.init(MROWS, 2048, F.G, (int)blockIdx.x);
      pg8::EpiL0m E{UA, VA, QKR};
      pg8::gemm_phase<pg8::EpiL0m, pg8::StaticOrder, true, true>(F.lds, g, S, E); }
    { PH_FRAME PH_PTRS
      pg8::Gemm g{WIN0 + (size_t)2048 * 1024, HN, 512, MROWS, 1024}; pg8::StaticOrder S; S.init(512, MROWS, F.G, (int)blockIdx.x);
      pg8::EpiVT E{VT0, 512};
      pg8::gemm_phase<pg8::EpiVT, pg8::StaticOrder, true, true>(F.lds, g, S, E); }
    GRID_BAR();
    { PH_FRAME PH_PTRS
      for (int t = blockIdx.x; t < 256; t += F.G) qk_post_task(t, QKR, Q0, K0, KSUM, ROPE, args.in[10], args.in[11], (LAS float*)F.lds, F.tid, F.wave, F.lane);
      for (int u = blockIdx.x; u < 512; u += F.G) gmlp_unit(u, UA, VA, args.in[7], GWS, args.in[9], YCAT, F.lds, F.tid, F.wave, F.lane); }
    GRID_BAR();
    { PH_FRAME PH_PTRS
      MobaT T{Q0, K0, VT0, KSUM, MASKS, PO, PL, args.in[10], args.in[11]}; const float mc2 = moba_mc2(args.in[10], args.in[11], F.lane);
      for (int u = F.gw; u < 4096; u += F.NGW) { moba_mask_unit(u, T, F.lane); moba_own_unit(u, T, mc2, F.lane); } }
    GRID_BAR();
    { PH_FRAME PH_PTRS
      MobaT T{Q0, K0, VT0, KSUM, MASKS, PO, PL, args.in[10], args.in[11]}; const float mc2 = moba_mc2(args.in[10], args.in[11], F.lane);
      LAS int* bc = (LAS int*)(F.lds + MS_CNT + 64);
      for (;;) { if (F.tid == 0) *bc = (int)__hip_atomic_fetch_add((unsigned*)(F.ctl + CW_WORK), 1u, __ATOMIC_RELAXED, __HIP_MEMORY_SCOPE_AGENT);
          __syncthreads(); const int task = *bc; __syncthreads(); if (task >= MOBA_NTASK) break;
          moba_sel_task(task, T, F.lds, mc2, F.tid, F.wave, F.lane); } }
    GRID_BAR();
    { PH_FRAME PH_PTRS moba_combine(F, PO, PL, YCAT); }
    GRID_BAR();
    { PH_FRAME PH_PTRS
      pg8::Gemm g{YCAT, WOUT0, MROWS, 1024, 1024}; pg8::StaticOrder S; S.init(MROWS, 1024, F.G, (int)blockIdx.x);
      pg8::EpiRes E{x_in, X, MOD + 2 * 1024};
      pg8::gemm_phase<pg8::EpiRes, pg8::StaticOrder, true, true>(F.lds, g, S, E); }
    GRID_BAR();
    { PH_FRAME PH_PTRS norm_rows(F, X, norm_ffn, MOD, 3, 4, HN, HQ, HS); }
    GRID_BAR();
    { PH_FRAME PH_PTRS
      pg8::Gemm g{HN, WQ0, MROWS, 2048, 1024}; pg8::StaticOrder S; S.init(MROWS, 2048, F.G, (int)blockIdx.x);
      pg8::EpiBf16<0> E{QP, 2048, nullptr, 0, 0, 1.f};
      pg8::gemm_phase<pg8::EpiBf16<0>, pg8::StaticOrder, true, true>(F.lds, g, S, E); }
    GRID_BAR();
    { PH_FRAME PH_PTRS peer_scores_phase(F, QP, SUBK, ENT); }
    GRID_BAR();
    { PH_FRAME PH_PTRS PeerT T{U8, V8s, USC, VSC, ENT, ACT, HQ, HS, X, MOD + 5 * 1024}; peer_gather_phase<0>(F, 1, T); }
    GRID_BAR();
#ifdef XVAR
    { PH_FRAME PH_PTRS PeerT T{U8, V8s, USC, VSC, ENT, (float*)(ws + WS_PL), HQ, HS, X, MOD + 5 * 1024}; peer_gather_phase<0, XVAR>(F, 40, T); }
    GRID_BAR();
#endif
    { PH_FRAME PH_PTRS PeerT T{U8, V8s, USC, VSC, ENT, ACT, HQ, HS, X, MOD + 5 * 1024}; peer_gather_phase<1>(F, 9, T); }
    GRID_BAR();
#ifdef XVVAR
    { PH_FRAME PH_PTRS PeerT T{U8, V8s, USC, VSC, ENT, ACT, HQ, HS, (float*)(ws + WS_QP), MOD + 5 * 1024}; peer_gather_phase<1, XVVAR>(F, 48, T); }
    GRID_BAR();
#endif
    { PH_FRAME PH_PTRS norm_rows(F, X, norm_mix + 1024, MOD + 2 * 6144, 0, 1, HN); }
    GRID_BAR();
    { PH_FRAME PH_PTRS
      pg8::Gemm g{HN, WIN1, MROWS, 2048, 1024}; pg8::StaticOrder S; S.init(MROWS, 2048, F.G, (int)blockIdx.x);
      pg8::EpiHeads E{Q1, K1, 16, 0.125f};
      pg8::gemm_phase<pg8::EpiHeads, pg8::StaticOrder, true, true>(F.lds, g, S, E); }
    { PH_FRAME PH_PTRS
      pg8::Gemm g{WIN1 + (size_t)2048 * 1024, HN, 1024, MROWS, 1024}; pg8::StaticOrder S; S.init(1024, MROWS, F.G, (int)blockIdx.x);
      pg8::EpiVT E{VT1, 1024};
      pg8::gemm_phase<pg8::EpiVT, pg8::StaticOrder, true, true>(F.lds, g, S, E); }
    GRID_BAR();
    { PH_FRAME PH_PTRS for (int u = blockIdx.x; u < 1024; u += F.G) sb_wg_unit(u, Q1, K1, VT1, YCAT, F.lds, F.tid, F.wave, F.lane); }
    GRID_BAR();
    { PH_FRAME PH_PTRS
      pg8::Gemm g{YCAT, WOUT1, MROWS, 1024, 1024}; pg8::StaticOrder S; S.init(MROWS, 1024, F.G, (int)blockIdx.x);
      pg8::EpiRes E{X, X, MOD + 2 * 6144 + 2 * 1024};
      pg8::gemm_phase<pg8::EpiRes, pg8::StaticOrder, true, true>(F.lds, g, S, E); }
    GRID_BAR();
    { PH_FRAME PH_PTRS norm_rows(F, X, norm_ffn + 1024, MOD + 2 * 6144, 3, 4, HN, HQ, HS); }
    GRID_BAR();
    { PH_FRAME PH_PTRS
      pg8::Gemm g{HN, WQ1, MROWS, 2048, 1024}; pg8::StaticOrder S; S.init(MROWS, 2048, F.G, (int)blockIdx.x);
      pg8::EpiBf16<0> E{QP, 2048, nullptr, 0, 0, 1.f};
      pg8::gemm_phase<pg8::EpiBf16<0>, pg8::StaticOrder, true, true>(F.lds, g, S, E); }
    GRID_BAR();
    { PH_FRAME PH_PTRS peer_scores_phase(F, QP, SUBK + 262144, ENT); }
    GRID_BAR();
    { PH_FRAME PH_PTRS PeerT T{U8 + (size_t)16384 * 1024, V8s + (size_t)16384 * 1024, USC + 16384, VSC + 16384, ENT, ACT, HQ, HS, X, MOD + 2 * 6144 + 5 * 1024}; peer_gather_phase<0>(F, 17, T); }
    GRID_BAR();
    { PH_FRAME PH_PTRS PeerT T{U8 + (size_t)16384 * 1024, V8s + (size_t)16384 * 1024, USC + 16384, VSC + 16384, ENT, ACT, HQ, HS, X, MOD + 2 * 6144 + 5 * 1024}; peer_gather_phase<1>(F, 25, T);
      if (__hip_atomic_load((gu32*)((unsigned*)(F.ctl + CW_BAR) + XB_TMO), RLX_AGENT) != 0u) { for (int m = F.gw; m < MROWS; m += F.NGW) X[(size_t)m * 1024 + F.lane] = __builtin_nanf(""); } }
#ifdef PROBE_MASK
#ifdef PROBE_BARS
    for (int i = 0; i < PROBE_BARS; ++i) xcd_barrier(bar);
#endif
    STAMP();
    if (blockIdx.x == PROBE_BLK && threadIdx.x == 0) { unsigned long long tsel = 0;
        for (int i = 0; i + 1 < nst_; ++i) if ((PROBE_MASK >> i) & 1ull) tsel += stamps_[i + 1] - stamps_[i];

        const unsigned long long t0 = __builtin_amdgcn_s_memrealtime(); while (__builtin_amdgcn_s_memrealtime() - t0 < tsel * PROBE_AMP) __builtin_amdgcn_s_sleep(8); }
#endif
}

extern "C" void kernel_launch(void* const* d_in, const int* in_sizes, int n_in, void* d_out, int out_size, void* d_ws, size_t ws_size, hipStream_t stream) {
    static int grid = 0;
    if (grid == 0) {
        if (n_in != 19 || out_size != MROWS * DM || ws_size < WS_END) { fprintf(stderr, "kernel_launch: unexpected shapes (n_in %d, out %d, ws %zu)\n", n_in, out_size, ws_size); grid = -1; return; }
        int dev = 0, cus = 0, per_cu = 0;
        if (hipGetDevice(&dev) != hipSuccess || hipDeviceGetAttribute(&cus, hipDeviceAttributeMultiprocessorCount, dev) != hipSuccess) { grid = -1; return; }
        if (hipFuncSetAttribute((const void*)hybrid_fwd, hipFuncAttributeMaxDynamicSharedMemorySize, LDS_BYTES) != hipSuccess) { fprintf(stderr, "kernel_launch: hipFuncSetAttribute failed\n"); grid = -1; return; }
        if (hipOccupancyMaxActiveBlocksPerMultiprocessor(&per_cu, (const void*)hybrid_fwd, NTHR, LDS_BYTES) != hipSuccess || per_cu < 1) { fprintf(stderr, "kernel_launch: occupancy query says %d\n", per_cu); per_cu = 1; }
        (void)hipGetLastError();
        grid = cus;
    }
    if (grid < 0) return;
    if (hipMemsetAsync((char*)d_ws + WS_CTL, 0, CTL_ZERO_BYTES, stream) != hipSuccess) { fprintf(stderr, "kernel_launch: memset failed\n"); return; }
    Args a{};
    for (int i = 0; i < 19; ++i) a.in[i] = (const float*)d_in[i];
    a.out = (float*)d_out; a.ws = (unsigned char*)d_ws; a.stage = 0; a.pad = 0;
    void* kargs[] = {&a};
    hipError_t e = hipLaunchCooperativeKernel((const void*)hybrid_fwd, dim3(grid), dim3(NTHR), kargs, LDS_BYTES, stream);
    if (e != hipSuccess) fprintf(stderr, "kernel_launch: cooperative launch failed: %s (grid %d)\n", hipGetErrorString(e), grid);
}
```

```cpp
#include <hip/hip_runtime.h>
#include <cstdio>
#include <cstdint>
#include <cmath>
namespace pg8 {
#define PG8_LAS __attribute__((address_space(3)))
typedef unsigned short bf16_t;
typedef short bf16x8 __attribute__((ext_vector_type(8)));
typedef float f32x4 __attribute__((ext_vector_type(4)));
typedef unsigned u32x4 __attribute__((ext_vector_type(4)));
constexpr int BM = 256, BK = 64, HALF = 128, HTB = HALF * BK * 2  , STAGE_BYTES = 8 * HTB, NXCD = 8, WGM = 8;

__host__ __device__ __forceinline__ int lds_byte(int r, int c) { const int st = (r >> 4) * 2 + (c >> 5), rr = r & 15, cc = c & 31, ob = rr * 64 + cc * 2; return st * 1024 + (ob ^ (((ob >> 9) & 1) << 5)); }
__host__ __device__ __forceinline__ void stage_rc(int b, int& R, int& C) { const int st = b / 1024, sb = b % 1024, swz = sb ^ (((sb >> 9) & 1) << 5); R = (st >> 1) * 16 + swz / 64; C = (st & 1) * 32 + (swz % 64) / 2; }
__host__ __device__ __forceinline__ int perm32(int rho) { const int n = rho >> 4, i = rho & 15; return 8 * (i >> 2) + 4 * n + (i & 3); }

struct Unit { int pm, pn; };
struct Gemm { const bf16_t* A; const bf16_t* Bt; int M, N, K; };

struct StaticOrder {
    int nM, nN, nwg, G, c;
    __host__ __device__ void init(int M, int N, int G_, int c_) { nM = M / BM; nN = N / BM; nwg = nM * nN; G = G_; c = c_; }
    __host__ __device__ bool next(int i, Unit& u) const {
        const long L = (long)i * G + c; if (L >= nwg) return false;
        int wgid = (int)L; { const int q = nwg / NXCD, r = nwg % NXCD, xcd = wgid % NXCD, off = wgid / NXCD; wgid = (xcd < r ? xcd * (q + 1) : r * (q + 1) + (xcd - r) * q) + off; }
        const int nig = WGM * nN, gid = wgid / nig, fm = gid * WGM, gsz = (nM - fm) < WGM ? (nM - fm) : WGM;
        u.pm = fm + ((wgid % nig) % gsz); u.pn = (wgid % nig) / gsz; return true;
    }
    __device__ __forceinline__ void a_ready(const Unit&) const {}
    __device__ __forceinline__ void done(const Unit&) const {}
};

__device__ __forceinline__ unsigned cvt_pk_bf16(float lo, float hi) { unsigned r; asm volatile("v_cvt_pk_bf16_f32 %0, %1, %2" : "=v"(r) : "v"(lo), "v"(hi)); return r; }
typedef float f32x2 __attribute__((ext_vector_type(2)));
__device__ __forceinline__ f32x2 gelu_pk(f32x2 v) {
    const f32x2 av = __builtin_elementwise_abs(v), d = av * 0.2316418882f + 1.0f;
    f32x2 t; t.x = __builtin_amdgcn_rcpf(d.x); t.y = __builtin_amdgcn_rcpf(d.y);
    f32x2 q = t * 0.5307027145f + (-0.7265760135f); q = q * t + 0.7107068705f; q = q * t + (-0.142248368f); q = q * t + 0.127414796f; q = q * t;
    const f32x2 s = (v * v) * (-0.72134752044f);
    f32x2 e; e.x = __builtin_amdgcn_exp2f(s.x); e.y = __builtin_amdgcn_exp2f(s.y);
    const f32x2 m = v * (q * e), r = v - m;
    f32x2 o; o.x = v.x < 0.f ? m.x : r.x; o.y = v.y < 0.f ? m.y : r.y; return o;
}

template <int ACT  > struct EpiBf16 {
    static constexpr bool PERM = true, AFTER_DRAIN = false; static_assert(ACT == 0 || ACT == 1, "EpiBf16: ACT is 0 (none) or 1 (gelu_pk)");
    bf16_t* O; int ldc; const float* bias; int split_cols; size_t split_stride; float scale0;
    __device__ __forceinline__ void operator()(const f32x4 (&acc)[2][2][4][2], const Unit& u, int wr, int wc, int fr, int fq) const {
        const int row0 = u.pm * BM + wr * 64 + fr; int colt = u.pn * BM; bf16_t* base = O;
        float sc = 1.f; if (split_cols) { const int t = colt / split_cols; base += (size_t)t * split_stride; colt -= t * split_cols; if (t == 0) sc = scale0; }
        const int col0 = colt + wc * 32 + 8 * fq, bcol0 = u.pn * BM + wc * 32 + 8 * fq;
        f32x4 bv[2][2];
#pragma unroll
        for (int bj = 0; bj < 2; ++bj)
#pragma unroll
            for (int n = 0; n < 2; ++n) bv[bj][n] = bias ? *(const f32x4*)(bias + bcol0 + bj * HALF + 4 * n) : (f32x4){0.f, 0.f, 0.f, 0.f};
#pragma unroll
        for (int ai = 0; ai < 2; ++ai)
#pragma unroll
            for (int m = 0; m < 4; ++m) { bf16_t* rowp = base + (size_t)(row0 + ai * HALF + m * 16) * ldc + col0;
#pragma unroll
                for (int bj = 0; bj < 2; ++bj) { f32x4 v0 = acc[ai][bj][m][0] + bv[bj][0], v1 = acc[ai][bj][m][1] + bv[bj][1];
                    if (ACT == 1) { f32x2 a = gelu_pk((f32x2){v0[0], v0[1]}), b = gelu_pk((f32x2){v0[2], v0[3]}), c = gelu_pk((f32x2){v1[0], v1[1]}), d = gelu_pk((f32x2){v1[2], v1[3]});
                        v0 = (f32x4){a.x, a.y, b.x, b.y}; v1 = (f32x4){c.x, c.y, d.x, d.y}; }
                    v0 = v0 * sc; v1 = v1 * sc; u32x4 w; w.x = cvt_pk_bf16(v0[0], v0[1]); w.y = cvt_pk_bf16(v0[2], v0[3]); w.z = cvt_pk_bf16(v1[0], v1[1]); w.w = cvt_pk_bf16(v1[2], v1[3]);
                    *(u32x4*)(rowp + bj * HALF) = w; } }
    }
};
constexpr int XSEQ = 8192;
typedef float f32x2e __attribute__((ext_vector_type(2))); typedef __bf16 bf16x2e __attribute__((ext_vector_type(2)));
__device__ __forceinline__ unsigned cvtpk2(float lo, float hi) { f32x2e v = {lo, hi}; bf16x2e b = __builtin_convertvector(v, bf16x2e); return __builtin_bit_cast(unsigned, b); }
__device__ __forceinline__ float gelu_tanh(float x) {
    const float u2 = x * (1.5957691216f + 0.0713548163f * x * x);
    return x * __builtin_amdgcn_rcpf(1.0f + __builtin_amdgcn_exp2f(-1.4426950409f * u2));
}
struct EpiL0m {
    static constexpr bool PERM = true, AFTER_DRAIN = false;
    bf16_t *UA, *VA, *QKR;
    template <bool ACT> __device__ __forceinline__ void tile(const f32x4 (&acc)[2][2][4][2], bf16_t* base, int ldc, int row0, int colt) const {
#pragma unroll
        for (int ai = 0; ai < 2; ++ai)
#pragma unroll
            for (int m = 0; m < 4; ++m) { bf16_t* rowp = base + (size_t)(row0 + ai * HALF + m * 16) * ldc + colt;
#pragma unroll
                for (int bj = 0; bj < 2; ++bj) { f32x4 v0 = acc[ai][bj][m][0], v1 = acc[ai][bj][m][1]; u32x4 w;
                    if (ACT) { v0[0] = gelu_tanh(v0[0]); v0[1] = gelu_tanh(v0[1]); v0[2] = gelu_tanh(v0[2]); v0[3] = gelu_tanh(v0[3]); v1[0] = gelu_tanh(v1[0]); v1[1] = gelu_tanh(v1[1]); v1[2] = gelu_tanh(v1[2]); v1[3] = gelu_tanh(v1[3]); }
                    w.x = cvtpk2(v0[0], v0[1]); w.y = cvtpk2(v0[2], v0[3]); w.z = cvtpk2(v1[0], v1[1]); w.w = cvtpk2(v1[2], v1[3]);
                    *(u32x4*)(rowp + bj * HALF) = w; } }
    }
    __device__ __forceinline__ void operator()(const f32x4 (&acc)[2][2][4][2], const Unit& u, int wr, int wc, int fr, int fq) const {
        const int pn = u.pn; const int row0 = u.pm * BM + wr * 64 + fr; const int cw = wc * 32 + 8 * fq;
        if (pn < 2) tile<true>(acc, UA, 512, row0, pn * 256 + cw);
        else if (pn < 4) tile<true>(acc, VA, 512, row0, (pn - 2) * 256 + cw);
        else tile<false>(acc, QKR, 1024, row0, (pn - 4) * 256 + cw);
    }
};
struct EpiHeads {
    static constexpr bool PERM = true, AFTER_DRAIN = false;
    bf16_t *Q, *Kp; int nh; float qscale;
    __device__ __forceinline__ void operator()(const f32x4 (&acc)[2][2][4][2], const Unit& u, int wr, int wc, int fr, int fq) const {
        const int b = u.pm >> 5, sb = (u.pm & 31) * 256 + wr * 64 + fr;
#pragma unroll
        for (int bj = 0; bj < 2; ++bj) { const int c = u.pn * BM + bj * HALF + wc * 32 + 8 * fq; const int t = c / (64 * nh), cc = c - t * 64 * nh, head = cc >> 6, d = cc & 63;
            bf16_t* dst = (t ? Kp : Q) + ((size_t)(b * nh + head) * XSEQ) * 64 + d;
#pragma unroll
            for (int ai = 0; ai < 2; ++ai)
#pragma unroll
                for (int m = 0; m < 4; ++m) { const int s = sb + ai * HALF + m * 16; const float qs = t ? 1.0f : qscale; const f32x4 v0 = acc[ai][bj][m][0] * qs, v1 = acc[ai][bj][m][1] * qs; u32x4 w;
                    w.x = cvtpk2(v0[0], v0[1]); w.y = cvtpk2(v0[2], v0[3]); w.z = cvtpk2(v1[0], v1[1]); w.w = cvtpk2(v1[2], v1[3]);
                    *(u32x4*)(dst + (size_t)s * 64) = w; } }
    }
};
struct EpiVT {
    static constexpr bool PERM = true, AFTER_DRAIN = false;
    bf16_t* VT; int nrows;
    __device__ __forceinline__ void operator()(const f32x4 (&acc)[2][2][4][2], const Unit& u, int wr, int wc, int fr, int fq) const {
        const int row0 = u.pm * BM + wr * 64 + fr; const int c0 = u.pn * BM + wc * 32 + 8 * fq; const int b = c0 >> 13, s0 = c0 & (XSEQ - 1);
#pragma unroll
        for (int ai = 0; ai < 2; ++ai)
#pragma unroll
            for (int m = 0; m < 4; ++m) { bf16_t* rowp = VT + ((size_t)b * nrows + row0 + ai * HALF + m * 16) * XSEQ + s0;
#pragma unroll
                for (int bj = 0; bj < 2; ++bj) { const f32x4 v0 = acc[ai][bj][m][0], v1 = acc[ai][bj][m][1]; u32x4 w;
                    w.x = cvtpk2(v0[0], v0[1]); w.y = cvtpk2(v0[2], v0[3]); w.z = cvtpk2(v1[0], v1[1]); w.w = cvtpk2(v1[2], v1[3]);
                    *(u32x4*)(rowp + bj * HALF) = w; } }
    }
};
template <bool XIN_F32> struct EpiRes {
    static constexpr bool PERM = true, AFTER_DRAIN = false;
    const float* xin; bf16_t* XB; const float* g;
    __device__ __forceinline__ void operator()(const f32x4 (&acc)[2][2][4][2], const Unit& u, int wr, int wc, int fr, int fq) const {
        const int row0 = u.pm * BM + wr * 64 + fr, col0 = u.pn * BM + wc * 32 + 8 * fq; const int b = u.pm >> 5;
        f32x4 gv[2][2];
#pragma unroll
        for (int bj = 0; bj < 2; ++bj)
#pragma unroll
            for (int n = 0; n < 2; ++n) gv[bj][n] = *(const f32x4*)(g + b * 6144 + col0 + bj * HALF + 4 * n);
#pragma unroll
        for (int ai = 0; ai < 2; ++ai)
#pragma unroll
            for (int m = 0; m < 4; ++m) { const size_t off = (size_t)(row0 + ai * HALF + m * 16) * 1024 + col0;
#pragma unroll
                for (int bj = 0; bj < 2; ++bj) { f32x4 x0, x1;
                    if (XIN_F32) { x0 = *(const f32x4*)(xin + off + bj * HALF); x1 = *(const f32x4*)(xin + off + bj * HALF + 4); }
                    else { const u32x4 w = *(const u32x4*)(XB + off + bj * HALF); x0 = (f32x4){__uint_as_float(w.x << 16), __uint_as_float(w.x & 0xffff0000u), __uint_as_float(w.y << 16), __uint_as_float(w.y & 0xffff0000u)};
                        x1 = (f32x4){__uint_as_float(w.z << 16), __uint_as_float(w.z & 0xffff0000u), __uint_as_float(w.w << 16), __uint_as_float(w.w & 0xffff0000u)}; }
                    const f32x4 y0 = x0 + gv[bj][0] * acc[ai][bj][m][0], y1 = x1 + gv[bj][1] * acc[ai][bj][m][1]; u32x4 o;
                    o.x = cvtpk2(y0[0], y0[1]); o.y = cvtpk2(y0[2], y0[3]); o.z = cvtpk2(y1[0], y1[1]); o.w = cvtpk2(y1[2], y1[3]);
                    *(u32x4*)(XB + off + bj * HALF) = o; } }
    }
};
template <class Epi, class Sched, bool ALIGN_EPI = false, bool SP2 = false>
__device__ __forceinline__ void gemm_phase(PG8_LAS unsigned char* lds, const Gemm g, const Sched& S, const Epi& E) {
    int tid_ = threadIdx.x; asm volatile("" : "+v"(tid_));
    const int tid = tid_, wid = __builtin_amdgcn_readfirstlane(tid >> 6), lane = tid & 63, wr = wid >> 2, wc = wid & 3, fr = lane & 15, fq = lane >> 4;
    const int K = g.K, nt = K / BK;
    unsigned voffA[2], voffB[2];
#pragma unroll
    for (int i = 0; i < 2; ++i) { int R, C; stage_rc(tid * 16 + i * 8192, R, C); const int Rb = Epi::PERM ? ((R & ~31) + perm32(R & 31)) : R;
        voffA[i] = (unsigned)(R * K + C) * 2u; voffB[i] = (unsigned)(Rb * K + C) * 2u; }
    const size_t kstep = (size_t)(BK * 2);
    const size_t hstep = (size_t)HALF * K * 2;
    const size_t tstep = 2 * hstep;
    const unsigned ldsw = (unsigned)wid * 1024u;
    const int aoff = lds_byte(wr * 64 + fr, fq * 8), boff = lds_byte(wc * 32 + fr, fq * 8);
#define PG8_SA(b, h) (((b) * 2 + (h)) * HTB)
#define PG8_SB(b, h) ((4 + (b) * 2 + (h)) * HTB)
#define PG8_STAGE(bufoff, gbase, voff) do { _Pragma("unroll") for (int _i = 0; _i < 2; ++_i) \
        __builtin_amdgcn_global_load_lds((const unsigned*)((const char*)(gbase) + (voff)[_i]), (PG8_LAS unsigned*)(lds + (bufoff) + ldsw + _i * 8192), 16, 0, 0); } while (0)
#define PG8_LDA(dst, b, h) do { _Pragma("unroll") for (int m = 0; m < 4; ++m) _Pragma("unroll") for (int k = 0; k < 2; ++k) dst[m][k] = *(const PG8_LAS bf16x8*)(lds + PG8_SA(b, h) + aoff + m * 2048 + k * 1024); } while (0)
#define PG8_LDB(dst, b, h) do { _Pragma("unroll") for (int n = 0; n < 2; ++n) _Pragma("unroll") for (int k = 0; k < 2; ++k) dst[n][k] = *(const PG8_LAS bf16x8*)(lds + PG8_SB(b, h) + boff + n * 2048 + k * 1024); } while (0)
#define PG8_MMA(ai, bj, At, Bt) do { __builtin_amdgcn_s_setprio(1); _Pragma("unroll") for (int m = 0; m < 4; ++m) _Pragma("unroll") for (int n = 0; n < 2; ++n) _Pragma("unroll") for (int k = 0; k < 2; ++k) \
        acc[ai][bj][m][n] = __builtin_amdgcn_mfma_f32_16x16x32_bf16(Bt[n][k], At[m][k], acc[ai][bj][m][n], 0, 0, 0); __builtin_amdgcn_s_setprio(0); } while (0)
#define PG8_WAIT_V(n) asm volatile("s_waitcnt vmcnt(" #n ")" ::: "memory")
#define PG8_WAIT_L(n) asm volatile("s_waitcnt lgkmcnt(" #n ")" ::: "memory")
#define PG8_BAR __builtin_amdgcn_s_barrier()
#define PG8_SCHED __builtin_amdgcn_sched_barrier(0)
    Unit cur, nxt; int ui = 0;
    if (!S.next(0, cur)) return;
    f32x4 acc[2][2][4][2];
#pragma unroll
    for (int a = 0; a < 2; ++a)
#pragma unroll
        for (int b = 0; b < 2; ++b)
#pragma unroll
            for (int m = 0; m < 4; ++m)
#pragma unroll
                for (int n = 0; n < 2; ++n) acc[a][b][m][n] = (f32x4){0.f, 0.f, 0.f, 0.f};
    bf16x8 At[4][2], B0[2][2], B1[2][2];
    const char* cA = (const char*)g.A + (size_t)cur.pm * tstep; const char* cB = (const char*)g.Bt + (size_t)cur.pn * tstep;
    S.a_ready(cur);
    if constexpr (SP2) {
        PG8_STAGE(PG8_SB(0, 0), cB, voffB); PG8_STAGE(PG8_SB(0, 1), cB + hstep, voffB); PG8_STAGE(PG8_SA(0, 0), cA, voffA); PG8_STAGE(PG8_SA(0, 1), cA + hstep, voffA);
        if (wr == 1) PG8_BAR;
        PG8_WAIT_V(2); PG8_BAR;
        PG8_STAGE(PG8_SB(1, 0), cB + kstep, voffB); PG8_STAGE(PG8_SA(1, 0), cA + kstep, voffA); PG8_STAGE(PG8_SB(1, 1), cB + hstep + kstep, voffB);
        PG8_WAIT_V(6); PG8_BAR;
    } else {
        PG8_STAGE(PG8_SB(0, 0), cB, voffB); PG8_STAGE(PG8_SA(0, 0), cA, voffA); PG8_STAGE(PG8_SB(0, 1), cB + hstep, voffB); PG8_STAGE(PG8_SA(0, 1), cA + hstep, voffA);
        if (wr == 1) PG8_BAR;
        PG8_WAIT_V(4); PG8_BAR;
        PG8_STAGE(PG8_SB(1, 0), cB + kstep, voffB); PG8_STAGE(PG8_SA(1, 0), cA + kstep, voffA); PG8_STAGE(PG8_SB(1, 1), cB + hstep + kstep, voffB);
        PG8_WAIT_V(6); PG8_BAR;
    }
    for (;;) {
        const bool has_next = S.next(ui + 1, nxt);
        const char* nA = has_next ? (const char*)g.A + (size_t)nxt.pm * tstep : cA; const char* nB = has_next ? (const char*)g.Bt + (size_t)nxt.pn * tstep : cB;
        for (int t = 0; t < nt; t += 2) {
            const bool last = (t == nt - 2);
            const char* a1 = cA + (size_t)(t + 1) * kstep;
            const char* a2 = last ? nA : cA + (size_t)(t + 2) * kstep; const char* b2 = last ? nB : cB + (size_t)(t + 2) * kstep;
            const char* a3 = a2 + kstep; const char* b3 = b2 + kstep;
            if (last && has_next) S.a_ready(nxt);
            if constexpr (SP2) {
            PG8_LDB(B0, 0, 0); PG8_LDB(B1, 0, 1); PG8_SCHED; PG8_LDA(At, 0, 0); PG8_STAGE(PG8_SA(1, 1), a1 + hstep, voffA);
            PG8_WAIT_V(8); PG8_WAIT_L(0); PG8_BAR; PG8_MMA(0, 0, At, B0); PG8_MMA(0, 1, At, B1); PG8_BAR; PG8_SCHED;
            PG8_LDA(At, 0, 1); PG8_STAGE(PG8_SB(0, 0), b2, voffB); PG8_STAGE(PG8_SB(0, 1), b2 + hstep, voffB); PG8_STAGE(PG8_SA(0, 0), a2, voffA);
            PG8_WAIT_V(8); PG8_WAIT_L(0); PG8_BAR; PG8_MMA(1, 0, At, B0); PG8_MMA(1, 1, At, B1); PG8_BAR; PG8_SCHED;
            PG8_LDB(B0, 1, 0); PG8_LDB(B1, 1, 1); PG8_SCHED; PG8_LDA(At, 1, 0); PG8_STAGE(PG8_SA(0, 1), a2 + hstep, voffA);
            PG8_WAIT_V(8); PG8_WAIT_L(0); PG8_BAR; PG8_MMA(0, 0, At, B0); PG8_MMA(0, 1, At, B1); PG8_BAR; PG8_SCHED;
            PG8_LDA(At, 1, 1); PG8_STAGE(PG8_SB(1, 0), b3, voffB); PG8_STAGE(PG8_SB(1, 1), b3 + hstep, voffB); PG8_STAGE(PG8_SA(1, 0), a3, voffA);
            PG8_WAIT_V(8); PG8_WAIT_L(0); PG8_BAR; PG8_MMA(1, 0, At, B0); PG8_MMA(1, 1, At, B1); PG8_BAR; PG8_SCHED;
            } else {
            PG8_LDB(B0, 0, 0); PG8_SCHED; PG8_LDA(At, 0, 0); PG8_STAGE(PG8_SA(1, 1), a1 + hstep, voffA);
            PG8_WAIT_L(8); PG8_BAR; PG8_WAIT_L(0); PG8_MMA(0, 0, At, B0); PG8_BAR; PG8_SCHED;
            PG8_LDB(B1, 0, 1); PG8_STAGE(PG8_SB(0, 0), b2, voffB);
            PG8_BAR; PG8_WAIT_L(0); PG8_MMA(0, 1, At, B1); PG8_BAR;
            PG8_LDA(At, 0, 1); PG8_STAGE(PG8_SA(0, 0), a2, voffA);
            PG8_BAR; PG8_WAIT_L(0); PG8_MMA(1, 0, At, B0); PG8_BAR; PG8_SCHED;
            PG8_STAGE(PG8_SB(0, 1), b2 + hstep, voffB);
            PG8_WAIT_V(6); PG8_BAR; PG8_MMA(1, 1, At, B1); PG8_BAR;
            PG8_LDB(B0, 1, 0); PG8_SCHED; PG8_LDA(At, 1, 0); PG8_STAGE(PG8_SA(0, 1), a2 + hstep, voffA);
            PG8_WAIT_L(8); PG8_BAR; PG8_WAIT_L(0); PG8_MMA(0, 0, At, B0); PG8_BAR; PG8_SCHED;
            PG8_LDB(B1, 1, 1); PG8_STAGE(PG8_SB(1, 0), b3, voffB);
            PG8_BAR; PG8_WAIT_L(0); PG8_MMA(0, 1, At, B1); PG8_BAR;
            PG8_LDA(At, 1, 1); PG8_STAGE(PG8_SA(1, 0), a3, voffA);
            PG8_BAR; PG8_WAIT_L(0); PG8_MMA(1, 0, At, B0); PG8_BAR; PG8_SCHED;
            PG8_STAGE(PG8_SB(1, 1), b3 + hstep, voffB);
            PG8_WAIT_V(6); PG8_BAR; PG8_MMA(1, 1, At, B1); PG8_BAR;
            }
        }
        if constexpr (ALIGN_EPI) { if (wr == 0) PG8_BAR; }
        if constexpr (!Epi::AFTER_DRAIN) { E(acc, cur, wr, wc, fr, fq); S.done(cur); }
        if (!has_next) break;
#pragma unroll
        for (int a = 0; a < 2; ++a)
#pragma unroll
            for (int b = 0; b < 2; ++b)
#pragma unroll
                for (int m = 0; m < 4; ++m)
#pragma unroll
                    for (int n = 0; n < 2; ++n) acc[a][b][m][n] = (f32x4){0.f, 0.f, 0.f, 0.f};
        cur = nxt; cA = nA; cB = nB; ++ui;
        if constexpr (ALIGN_EPI) { if (wr == 1) PG8_BAR; }
    }
    PG8_WAIT_V(0);
    if constexpr (!ALIGN_EPI) { if (wr == 0) PG8_BAR; }
    PG8_BAR;
    if constexpr (Epi::AFTER_DRAIN) { E.fused(acc, cur, wr, wc, fr, fq, lds, wid, lane); S.done(cur); }
#undef PG8_SA
#undef PG8_SB
#undef PG8_STAGE
#undef PG8_LDA
#undef PG8_LDB
#undef PG8_MMA
#undef PG8_WAIT_V
#undef PG8_WAIT_L
#undef PG8_BAR
#undef PG8_SCHED
}
}
#define GAS __attribute__((address_space(1)))
#define LAS __attribute__((address_space(3)))
typedef unsigned short bf16;
typedef unsigned v4u __attribute__((ext_vector_type(4)));
typedef float f32x4 __attribute__((ext_vector_type(4)));
typedef short bf16x8 __attribute__((ext_vector_type(8)));
typedef GAS unsigned gu32;
typedef GAS unsigned long long gu64;
#define RLX_AGENT __ATOMIC_RELAXED, __HIP_MEMORY_SCOPE_AGENT
#define LDS_WAIT() asm volatile("s_waitcnt lgkmcnt(0)" ::: "memory")
#define VM_WAIT() asm volatile("s_waitcnt vmcnt(0)" ::: "memory")
__device__ __forceinline__ unsigned long long rt() { return __builtin_amdgcn_s_memrealtime(); }
__device__ __forceinline__ unsigned f2bf(float f) { unsigned u = __builtin_bit_cast(unsigned, f); return (u + 0x7fffu + ((u >> 16) & 1u)) >> 16; }
__device__ __forceinline__ unsigned pk2(float lo, float hi) { return f2bf(lo) | (f2bf(hi) << 16); }

#define XB_TMO      128
#define XB_XCNT(j)  (256  + 64 * (j))
#define XB_XSUB(j)  (1280 + 64 * (j))
#define XB_XGEN(j)  (2304 + 64 * (j))
#define XB_TOP      3328
#define XB_TOPGEN   3392
#define XCD_BAR_WORDS 3456
#define XB_SPIN_CAP (1u << 18)

__device__ __forceinline__ unsigned xb_ld(unsigned* p)              { return __hip_atomic_load(p, __ATOMIC_RELAXED, __HIP_MEMORY_SCOPE_AGENT); }
__device__ __forceinline__ unsigned xb_add(unsigned* p, unsigned v) { return __hip_atomic_fetch_add(p, v, __ATOMIC_RELAXED, __HIP_MEMORY_SCOPE_AGENT); }
__device__ __forceinline__ unsigned xb_xcc_id() { return (unsigned)__builtin_amdgcn_s_getreg((3 << 11) | 20) & 0xFu; }
#define XB_SPIN(cond, bar) do { unsigned _sp = 0; while (cond) { __builtin_amdgcn_s_sleep(1); \
    if ((++_sp & 255u) == 0u) { if (xb_ld(&(bar)[XB_TMO])) break; if (_sp > XB_SPIN_CAP) { atomicAdd(&(bar)[XB_TMO], 1u); break; } } } } while (0)

struct XcdBarrier {
    unsigned* bar; unsigned x;
    volatile LAS unsigned* st;
};

__device__ __forceinline__ XcdBarrier xcd_barrier_post(unsigned* bar, volatile LAS unsigned* st) {
    XcdBarrier b; b.bar = bar; b.x = xb_xcc_id(); b.st = st;
    if (threadIdx.x == 0) (void)xb_add(&bar[XB_XCNT(b.x)], 1u);
    return b;
}
__device__ __forceinline__ void xcd_barrier_complete(unsigned* bar, unsigned x, unsigned& nloc, unsigned& nx) {
    const unsigned G = gridDim.x * gridDim.y * gridDim.z;
    unsigned sum, cnt, mine, sp = 0u;
    for (;;) {
        sum = 0u; cnt = 0u; mine = 0u;
#pragma unroll
        for (unsigned j = 0; j < 16; ++j) { const unsigned c = xb_ld(&bar[XB_XCNT(j)]); sum += c; cnt += (c > 0u) ? 1u : 0u; mine = (j == x) ? c : mine; }
        if (sum == G) break;
        __builtin_amdgcn_s_sleep(1);
        if ((++sp & 255u) == 0u) { if (xb_ld(&bar[XB_TMO])) break; if (sp > XB_SPIN_CAP) { atomicAdd(&bar[XB_TMO], 1u); break; } }
    }
    nloc = mine > 0u ? mine : 1u; nx = cnt > 0u ? cnt : 1u;
}

__device__ __forceinline__ void xcd_barrier(const XcdBarrier& b) {
    asm volatile("s_waitcnt vmcnt(0)" ::: "memory");
    __syncthreads();
    if (threadIdx.x == 0) {
        unsigned* bar = b.bar;
        __builtin_amdgcn_s_waitcnt(0);
        unsigned nloc = b.st[0], nx = b.st[1];
        if (nloc == 0u) { xcd_barrier_complete(bar, b.x, nloc, nx); b.st[0] = nloc; b.st[1] = nx; }
        const unsigned old = xb_add(&bar[XB_XSUB(b.x)], 1u);
        const unsigned gen = old / nloc;
        if (old + 1u == (gen + 1u) * nloc) {
            __builtin_amdgcn_fence(__ATOMIC_RELEASE, "agent");
            asm volatile("s_waitcnt vmcnt(0)" ::: "memory");
            const unsigned og = xb_add(&bar[XB_TOP], 1u);
            const unsigned tg = og / nx;
            if (og + 1u == (tg + 1u) * nx) xb_add(&bar[XB_TOPGEN], 1u);
            else XB_SPIN(xb_ld(&bar[XB_TOPGEN]) == tg, bar);
            __builtin_amdgcn_fence(__ATOMIC_ACQUIRE, "agent");
            xb_add(&bar[XB_XGEN(b.x)], 1u);
            asm volatile("s_waitcnt vmcnt(0)" ::: "memory");
        } else {
            XB_SPIN(xb_ld(&bar[XB_XGEN(b.x)]) == gen, bar);
            __builtin_amdgcn_fence(__ATOMIC_ACQUIRE, "agent");
            asm volatile("s_waitcnt vmcnt(0)" ::: "memory");
        }
    }
    __syncthreads();
}
constexpr int NWAVES = 8, NTHR = 512;
constexpr int SEQ = 8192, DM = 1024, MROWS = 16384;
constexpr size_t MiB = 1u << 20;
constexpr size_t WS_CTL = 0, CTL_ZERO_BYTES = 2 * MiB;
constexpr size_t WS_KSUM = 1 * MiB;
constexpr size_t WS_MOD = 2 * MiB;
constexpr size_t WS_ROPE = 3 * MiB;
constexpr size_t WS_WIN0 = 4 * MiB, WS_WOUT0 = 9 * MiB, WS_WIN1 = 11 * MiB, WS_WOUT1 = 17 * MiB, WS_WQ0 = 19 * MiB, WS_WQ1 = 23 * MiB;
constexpr size_t WS_SUBK = 27 * MiB, WS_GWS = 28 * MiB, WS_MASK = 29 * MiB, WS_SC = 30 * MiB;
constexpr size_t WS_PTU = 32 * MiB, WS_PTV = 96 * MiB;
constexpr size_t WS_HN = 160 * MiB;
constexpr size_t WS_A = 192 * MiB;
constexpr size_t WS_YCAT = 288 * MiB, WS_QP = 320 * MiB, WS_PO = 384 * MiB, WS_PL = 448 * MiB, WS_XB = 450 * MiB, WS_END = 482 * MiB;
constexpr int CW_BAR = 4096, CW_WORK = 16384;

constexpr int RING_BYTES = 131072, LDSCTL_OFF = 143360, MISC_OFF = LDSCTL_OFF + 320, LDS_BYTES = 147456;

#ifndef XCC_EXPR
#define XCC_EXPR ((int)(xb_xcc_id() & 7u))
#endif
#define DI __device__ __forceinline__
typedef short bf16x8 __attribute__((ext_vector_type(8)));
typedef short s16x4 __attribute__((ext_vector_type(4)));
typedef float f32x16 __attribute__((ext_vector_type(16)));
typedef __bf16 bf16x2t __attribute__((ext_vector_type(2)));
#define MFMA32(a, b, c) __builtin_amdgcn_mfma_f32_32x32x16_bf16((a), (b), (c), 0, 0, 0)
using pg8::cvtpk2; using pg8::gelu_tanh;
DI int crow(int reg, int h) { return (reg & 3) + 8 * (reg >> 2) + 4 * h; }
DI float bf_lo(unsigned w) { return __uint_as_float(w << 16); }
DI float bf_hi(unsigned w) { return __uint_as_float(w & 0xffff0000u); }
DI bf16x8 ld16g(const bf16* p) { return *(const bf16x8*)p; }
DI bf16x8 ld8x2g(const bf16* p0, const bf16* p1) { const s16x4 a = *(const s16x4*)p0, b = *(const s16x4*)p1; return __builtin_shufflevector(a, b, 0, 1, 2, 3, 4, 5, 6, 7); }
DI float dot2bf(unsigned a, unsigned b, float c) { return __builtin_amdgcn_fdot2_f32_bf16(__builtin_bit_cast(bf16x2t, a), __builtin_bit_cast(bf16x2t, b), c, false); }
DI int f_ord(float f) { int i = __float_as_int(f); return i ^ ((i >> 31) & 0x7fffffff); }
DI float f_unord(int i) { return __int_as_float(i ^ ((i >> 31) & 0x7fffffff)); }
constexpr float LOG2E = 1.4426950408889634f, LN2 = 0.6931471805599453f;
#define KEY_MIN ((int)0x80000000)


template <int CTRL> DI float dppf(float x) { return __builtin_bit_cast(float, __builtin_amdgcn_update_dpp(0, __builtin_bit_cast(int, x), CTRL, 0xF, 0xF, true)); }
template <int CTRL> DI int dppi(int x) { return __builtin_amdgcn_update_dpp(0, x, CTRL, 0xF, 0xF, true); }
#define DPP_X1 0xB1
#define DPP_X2 0x4E
#define DPP_HM 0x141
#define DPP_RM 0x140
#define DPP_R8 0x128
DI unsigned px32u(unsigned x, int lane) { auto r = __builtin_amdgcn_permlane32_swap(x, x, false, false); return (lane & 32) ? r[0] : r[1]; }
DI float px32(float x, int lane) { return __uint_as_float(px32u(__float_as_uint(x), lane)); }
DI int px32(int x, int lane) { return (int)px32u((unsigned)x, lane); }
DI unsigned px16u(unsigned x, int lane) { auto r = __builtin_amdgcn_permlane16_swap(x, x, false, false); return (lane & 16) ? r[0] : r[1]; }
DI float px16(float x, int lane) { return __uint_as_float(px16u(__float_as_uint(x), lane)); }
DI float sum32(float x) { auto r = __builtin_amdgcn_permlane32_swap(__float_as_uint(x), __float_as_uint(x), false, false); return __uint_as_float(r[0]) + __uint_as_float(r[1]); }
DI float sum16(float x) { auto r = __builtin_amdgcn_permlane16_swap(__float_as_uint(x), __float_as_uint(x), false, false); return __uint_as_float(r[0]) + __uint_as_float(r[1]); }
DI float row_sum16(float v) { v += dppf<DPP_X1>(v); v += dppf<DPP_X2>(v); v += dppf<DPP_HM>(v); v += dppf<DPP_RM>(v); return v; }
DI float wave_sum(float v) { return sum32(sum16(row_sum16(v))); }
DI float wave_max(float v) { v = fmaxf(v, dppf<DPP_X1>(v)); v = fmaxf(v, dppf<DPP_X2>(v)); v = fmaxf(v, dppf<DPP_HM>(v)); v = fmaxf(v, dppf<DPP_RM>(v));
    { auto r = __builtin_amdgcn_permlane16_swap(__float_as_uint(v), __float_as_uint(v), false, false); v = fmaxf(__uint_as_float(r[0]), __uint_as_float(r[1])); }
    { auto r = __builtin_amdgcn_permlane32_swap(__float_as_uint(v), __float_as_uint(v), false, false); v = fmaxf(__uint_as_float(r[0]), __uint_as_float(r[1])); } return v; }

struct Frame {
    LAS unsigned char* lds; volatile LAS unsigned* MISC; gu32* ctl; int tid, lane, wave, G, gw, NGW;
};

struct MapId { DI int operator()(int n) const { return n; } };
struct MapWin0 { DI int operator()(int n) const {
    if (n < 1024) return n;
    const int t = (n - 1024) >> 9, c = (n - 1024) & 511, hd = c >> 6, d = c & 63; int bj, p;
    if (t < 2) { if (d < 16) { const int nn = d >> 3, rr = d & 7; bj = 0; p = 8 * (rr >> 2) + 4 * nn + (rr & 3); } else if (d < 32) { bj = 0; p = d; } else { bj = 1; p = d - 32; } }
    else { bj = d >> 5; p = d & 31; }
    return 1024 + 512 * t + 256 * (hd >> 2) + 128 * bj + 32 * (hd & 3) + p; } };
struct MapWin1 { DI int operator()(int n) const { const int t = n >> 10, c = n & 1023, hd = c >> 6, d = c & 63; return 1024 * t + 256 * (hd >> 2) + 128 * (d >> 5) + 32 * (hd & 3) + (d & 31); } };
template <class Map> DI void p0_transpose_item(const float* W, int K, int N, bf16* WT, LAS float* scr, int item, int lane, Map map) {
    const int nblk = N / 32, kb = item / nblk, nb = item % nblk, k0 = 64 * kb, n0 = 32 * nb;
#pragma unroll 8
    for (int i = 0; i < 32; ++i) { const int kk = 2 * i + (lane >> 5); scr[kk * 33 + (lane & 31)] = W[(size_t)(k0 + kk) * N + n0 + (lane & 31)]; }
    LDS_WAIT(); asm volatile("" ::: "memory");
    const int c = lane & 7;
#pragma unroll
    for (int j = 0; j < 4; ++j) { const int n = (lane >> 3) + 8 * j; const LAS float* s = scr + (8 * c) * 33 + n;
        v4u o; o.x = pk2(s[0 * 33], s[1 * 33]); o.y = pk2(s[2 * 33], s[3 * 33]); o.z = pk2(s[4 * 33], s[5 * 33]); o.w = pk2(s[6 * 33], s[7 * 33]);
        *(GAS v4u*)(WT + (size_t)map(n0 + n) * K + k0 + 8 * c) = o; }
    LDS_WAIT(); asm volatile("" ::: "memory");
}
struct P0Args { const float *c, *w_mod, *b_mod, *win0, *wout0, *win1, *wout1, *wq, *subk, *pu, *pv, *gws;
                float *MOD, *ROPE; bf16 *WIN0, *WOUT0, *WIN1, *WOUT1, *WQ0, *WQ1, *SUBK, *GWS; unsigned char *U8, *V8s; float *USC, *VSC; };
DI void p0_prologue(const Frame& F, const P0Args& A) {
    { LAS float* scr = (LAS float*)F.lds;
      for (int task = blockIdx.x; task < 192; task += F.G) {
          const int l = task / 96, n0 = (task % 96) * 64; const float* W = A.w_mod + (size_t)l * 1024 * 6144;
          float a0 = 0.f, a1 = 0.f; const int k0 = F.wave * 128;
#pragma unroll 1
          for (int kb = k0; kb < k0 + 128; kb += 32) { float w[32];
#pragma unroll
              for (int i = 0; i < 32; ++i) w[i] = W[(size_t)(kb + i) * 6144 + n0 + F.lane];
#pragma unroll
              for (int i = 0; i < 32; ++i) { const float c0 = A.c[kb + i], c1 = A.c[1024 + kb + i]; const float s0 = c0 / (1.f + __expf(-c0)), s1 = c1 / (1.f + __expf(-c1)); a0 += s0 * w[i]; a1 += s1 * w[i]; } }
          scr[(F.wave * 2 + 0) * 64 + F.lane] = a0; scr[(F.wave * 2 + 1) * 64 + F.lane] = a1;
          __syncthreads();
          if (F.tid < 128) { const int b = F.tid >> 6, n = F.tid & 63; float s = 0.f;
#pragma unroll
              for (int w = 0; w < 8; ++w) s += scr[(w * 2 + b) * 64 + n];
              A.MOD[(size_t)(l * 2 + b) * 6144 + n0 + n] = s + A.b_mod[l * 6144 + n0 + n]; }
          __syncthreads();
      } }
    { LAS float* scr = (LAS float*)(F.lds + F.wave * 16384);
      constexpr int I0 = 16 * 80, I1 = 16 * 32, I2 = 16 * 96, I3 = 16 * 32, I4 = 16 * 64, I5 = 16 * 64, NIT = I0 + I1 + I2 + I3 + I4 + I5;
      for (int it = F.gw; it < NIT; it += F.NGW) { int r = it;
          if (r < I0) { p0_transpose_item(A.win0, 1024, 2560, A.WIN0, scr, r, F.lane, MapId()); continue; } r -= I0;
          if (r < I1) { p0_transpose_item(A.wout0, 1024, 1024, A.WOUT0, scr, r, F.lane, MapId()); continue; } r -= I1;
          if (r < I2) { p0_transpose_item(A.win1, 1024, 3072, A.WIN1, scr, r, F.lane, MapId()); continue; } r -= I2;
          if (r < I3) { p0_transpose_item(A.wout1, 1024, 1024, A.WOUT1, scr, r, F.lane, MapId()); continue; } r -= I3;
          if (r < I4) { p0_transpose_item(A.wq, 1024, 2048, A.WQ0, scr, r, F.lane, MapId()); continue; } r -= I4;
          p0_transpose_item(A.wq + (size_t)1024 * 2048, 1024, 2048, A.WQ1, scr, r, F.lane, MapId()); } }
    for (int row0 = F.gw; row0 < 65536; row0 += 4 * F.NGW) {
        f32x4 v[4][4];
#pragma unroll
        for (int q = 0; q < 4; ++q) { const int row = row0 + q * F.NGW; const bool isv = row >= 32768; const int rr = row & 32767; const float* src = (isv ? A.pv : A.pu) + (size_t)rr * 1024;
#pragma unroll
            for (int k = 0; k < 4; ++k) v[q][k] = *(const f32x4*)(src + 4 * F.lane + 256 * k); }
#pragma unroll
        for (int q = 0; q < 4; ++q) { const int row = row0 + q * F.NGW; const bool isv = row >= 32768; const int rr = row & 32767; float mx = 0.f;
#pragma unroll
            for (int k = 0; k < 4; ++k) mx = fmaxf(mx, fmaxf(fmaxf(fabsf(v[q][k][0]), fabsf(v[q][k][1])), fmaxf(fabsf(v[q][k][2]), fabsf(v[q][k][3]))));
            mx = wave_max(mx);
            const float sc = mx > 0.f ? 127.0f / mx : 1.0f, inv = mx > 0.f ? mx * (1.0f / 127.0f) : 1.0f;
#pragma unroll
            for (int k = 0; k < 4; ++k) { const int q0 = __float2int_rn(v[q][k][0] * sc), q1 = __float2int_rn(v[q][k][1] * sc), q2 = __float2int_rn(v[q][k][2] * sc), q3 = __float2int_rn(v[q][k][3] * sc);
                const unsigned w = (unsigned)(q0 & 255) | ((unsigned)(q1 & 255) << 8) | ((unsigned)(q2 & 255) << 16) | ((unsigned)(q3 & 255) << 24);
                if (!isv) *(unsigned*)(A.U8 + (size_t)rr * 1024 + 4 * F.lane + 256 * k) = w;
                else { const int l = rr >> 14, e = rr & 16383, slab = 2 * k + (F.lane >> 5); *(unsigned*)(A.V8s + (((size_t)l * 8 + slab) * 16384 + e) * 128 + 4 * (F.lane & 31)) = w; } }
            if (F.lane == 0) (isv ? A.VSC : A.USC)[rr] = inv; } }
    { const size_t gt = (size_t)F.gw * 64 + F.lane, NT = (size_t)F.NGW * 64;
      for (size_t i = gt; i < 524288 / 8; i += NT) { const float* src = A.subk + i * 8; const f32x4 a = *(const f32x4*)src, b = *(const f32x4*)(src + 4); v4u o; o.x = cvtpk2(a[0], a[1]); o.y = cvtpk2(a[2], a[3]); o.z = cvtpk2(b[0], b[1]); o.w = cvtpk2(b[2], b[3]);
          *(v4u*)(A.SUBK + i * 8) = o; }
      for (size_t i = gt; i < 65536; i += NT) { const int t = (int)(i >> 7) & 127, s = (int)i & 127; A.GWS[i] = (bf16)(cvtpk2(s <= t ? A.gws[i] : 0.f, 0.f) & 0xffffu); }
      for (size_t i = gt; i < 65536; i += NT) { const int pos = (int)(i >> 3), fi = (int)i & 7; const float inv = powf(500000.0f, -(float)fi / 8.0f); const float ang = (float)pos * inv; float sn, cs; sincosf(ang, &sn, &cs);
          A.ROPE[(size_t)pos * 16 + fi] = cs; A.ROPE[(size_t)pos * 16 + 8 + fi] = sn; } }
}

template <bool XIN_F32> DI void norm_rows(const Frame& F, const void* xs_, const float* gamma, const float* modl, int shi, int sci, bf16* HN, unsigned char* HQ = nullptr, float* HS = nullptr) {
    for (int m0 = F.gw; m0 < MROWS; m0 += 2 * F.NGW) {
        f32x4 v[2][4]; float s[2];
#pragma unroll
        for (int q = 0; q < 2; ++q) { const int m = m0 + q * F.NGW;
            if (XIN_F32) { const f32x4* xr = (const f32x4*)((const float*)xs_ + (size_t)m * 1024) + F.lane;
#pragma unroll
                for (int j = 0; j < 4; ++j) v[q][j] = xr[64 * j]; }
            else { const unsigned long long* xr = (const unsigned long long*)((const bf16*)xs_ + (size_t)m * 1024) + F.lane;
#pragma unroll
                for (int j = 0; j < 4; ++j) { const unsigned long long w = xr[64 * j]; const unsigned lo = (unsigned)w, hi = (unsigned)(w >> 32); v[q][j] = (f32x4){bf_lo(lo), bf_hi(lo), bf_lo(hi), bf_hi(hi)}; } } }
#pragma unroll
        for (int q = 0; q < 2; ++q) { float a = 0.f;
#pragma unroll
            for (int j = 0; j < 4; ++j) a += (v[q][j][0] * v[q][j][0] + v[q][j][1] * v[q][j][1]) + (v[q][j][2] * v[q][j][2] + v[q][j][3] * v[q][j][3]);
            s[q] = a; }
#pragma unroll
        for (int q = 0; q < 2; ++q) { const int m = m0 + q * F.NGW; const int b = m >> 13;
            const float rinv = rsqrtf(wave_sum(s[q]) * (1.0f / 1024.0f) + 1e-6f);
            unsigned long long* o8 = (unsigned long long*)(HN + (size_t)m * 1024) + F.lane; float mx = 0.f;
#pragma unroll
            for (int j = 0; j < 4; ++j) { const int col = 4 * F.lane + 256 * j; const f32x4 gm = *(const f32x4*)(gamma + col), sc = *(const f32x4*)(modl + b * 6144 + sci * 1024 + col), sh = *(const f32x4*)(modl + b * 6144 + shi * 1024 + col);
                const f32x4 o = v[q][j] * rinv * gm * (sc + 1.0f) + sh; v[q][j] = o; mx = fmaxf(mx, fmaxf(fmaxf(fabsf(o[0]), fabsf(o[1])), fmaxf(fabsf(o[2]), fabsf(o[3]))));
                o8[64 * j] = (unsigned long long)cvtpk2(o[0], o[1]) | ((unsigned long long)cvtpk2(o[2], o[3]) << 32); }
            if (HQ) { mx = wave_max(mx); const float qs = mx > 0.f ? 127.0f / mx : 1.0f;
#pragma unroll
                for (int j = 0; j < 4; ++j) { const int q0 = __float2int_rn(v[q][j][0] * qs), q1 = __float2int_rn(v[q][j][1] * qs), q2 = __float2int_rn(v[q][j][2] * qs), q3 = __float2int_rn(v[q][j][3] * qs);
                    *(unsigned*)(HQ + (size_t)m * 1024 + 4 * F.lane + 256 * j) = (unsigned)(q0 & 255) | ((unsigned)(q1 & 255) << 8) | ((unsigned)(q2 & 255) << 16) | ((unsigned)(q3 & 255) << 24); }
                if (F.lane == 0) HS[m] = mx > 0.f ? mx * (1.0f / 127.0f) : 1.0f; } }
    }
}

DI void qk_post_task(int task, const bf16* QKR, bf16* Q0, bf16* K0, float* KSUM, const float* rope, const float* gq, const float* gk, LAS float* scr, int tid, int wave, int lane) {
    const int tb = task >> 2, cq = task & 3; const bool isk = cq >= 2; const int head0 = (cq & 1) * 4, hl = (lane >> 2) & 3, qt = lane & 3, rsub = lane >> 4;
    const float* g = (isk ? gk : gq) + qt * 16; float gv[16];
#pragma unroll
    for (int i = 0; i < 16; ++i) gv[i] = g[i];
    float ks[16];
#pragma unroll
    for (int i = 0; i < 16; ++i) ks[i] = 0.f;
    const int b = tb >> 5; bf16* dstb = (isk ? K0 : Q0) + (size_t)(b * 8 + head0 + hl) * SEQ * 64 + qt * 16;
    for (int it = 0; it < 8; ++it) { const int row = tb * 256 + wave * 32 + it * 4 + rsub, s = row & (SEQ - 1);
        const bf16* src = QKR + (size_t)row * 1024 + cq * 256 + hl * 64 + qt * 16; const v4u w0 = *(const v4u*)src, w1 = *(const v4u*)(src + 8);
        float y[16]; y[0] = bf_lo(w0.x); y[1] = bf_hi(w0.x); y[2] = bf_lo(w0.y); y[3] = bf_hi(w0.y); y[4] = bf_lo(w0.z); y[5] = bf_hi(w0.z); y[6] = bf_lo(w0.w); y[7] = bf_hi(w0.w);
        y[8] = bf_lo(w1.x); y[9] = bf_hi(w1.x); y[10] = bf_lo(w1.y); y[11] = bf_hi(w1.y); y[12] = bf_lo(w1.z); y[13] = bf_hi(w1.z); y[14] = bf_lo(w1.w); y[15] = bf_hi(w1.w);
        float ss = 0.f;
#pragma unroll
        for (int i = 0; i < 16; ++i) ss += y[i] * y[i];
        ss += dppf<DPP_X1>(ss); ss += dppf<DPP_X2>(ss);
        const float rinv = rsqrtf(ss * (1.0f / 64.0f) + 1e-6f);
#pragma unroll
        for (int i = 0; i < 16; ++i) y[i] = y[i] * rinv * gv[i];
        if (qt == 0) { const float* rp = rope + (size_t)s * 16;
#pragma unroll
            for (int i = 0; i < 8; ++i) { const float c = rp[i], sn = rp[8 + i], x1 = y[i], x2 = y[i + 8]; y[i] = x1 * c - x2 * sn; y[i + 8] = x1 * sn + x2 * c; } }
        v4u o0, o1; o0.x = cvtpk2(y[0], y[1]); o0.y = cvtpk2(y[2], y[3]); o0.z = cvtpk2(y[4], y[5]); o0.w = cvtpk2(y[6], y[7]); o1.x = cvtpk2(y[8], y[9]); o1.y = cvtpk2(y[10], y[11]); o1.z = cvtpk2(y[12], y[13]); o1.w = cvtpk2(y[14], y[15]);
        bf16* d = dstb + (size_t)s * 64; *(v4u*)d = o0; *(v4u*)(d + 8) = o1;
#pragma unroll
        for (int i = 0; i < 16; ++i) ks[i] += y[i];
    }
    if (isk) {
#pragma unroll
        for (int i = 0; i < 16; ++i) { ks[i] = sum32(sum16(ks[i])); }
        if (lane < 16) {
#pragma unroll
            for (int i = 0; i < 16; ++i) scr[(wave * 16 + lane) * 16 + i] = ks[i]; }
        __syncthreads();
        if (tid < 256) { const int l16 = tid >> 4, i = tid & 15; float sum = 0.f;
#pragma unroll
            for (int w = 0; w < 8; ++w) sum += scr[(w * 16 + l16) * 16 + i];
            KSUM[((size_t)(b * 8 + head0 + (l16 >> 2)) * 32 + (tb & 31)) * 64 + (l16 & 3) * 16 + i] = sum; }
        __syncthreads();
    }
}

DI f32x16 qk_tile(const bf16* krow, const bf16x8 (&qf)[4]) {
    f32x16 s;
#pragma unroll
    for (int i = 0; i < 16; ++i) s[i] = 0.f;
#pragma unroll
    for (int ks = 0; ks < 4; ++ks) s = MFMA32(ld16g(krow + 16 * ks), qf[ks], s);
    return s;
}
DI bf16x8 pack8(const f32x16& x, int s) { v4u p; p.x = cvtpk2(x[8 * s], x[8 * s + 1]); p.y = cvtpk2(x[8 * s + 2], x[8 * s + 3]); p.z = cvtpk2(x[8 * s + 4], x[8 * s + 5]); p.w = cvtpk2(x[8 * s + 6], x[8 * s + 7]); return __builtin_bit_cast(bf16x8, p); }
DI void pv_tile(f32x16 (&o)[2], const bf16* vt, const f32x16& p) {
#pragma unroll
    for (int s = 0; s < 2; ++s) { const bf16x8 pb = pack8(p, s);
#pragma unroll
        for (int mt = 0; mt < 2; ++mt) { const bf16* v = vt + (size_t)mt * 32 * SEQ + 16 * s; o[mt] = MFMA32(ld8x2g(v, v + 8), pb, o[mt]); } }
}
DI void store_ot(bf16* dst, const f32x16 (&o)[2], float sc, int h) {
#pragma unroll
    for (int mt = 0; mt < 2; ++mt)
#pragma unroll
        for (int g = 0; g < 4; ++g) { const unsigned lo = cvtpk2(o[mt][4 * g] * sc, o[mt][4 * g + 1] * sc), hi = cvtpk2(o[mt][4 * g + 2] * sc, o[mt][4 * g + 3] * sc);
            *(unsigned long long*)(dst + 32 * mt + 8 * g + 4 * h) = (unsigned long long)lo | ((unsigned long long)hi << 32); }
}
DI void moba_keys(const bf16* Kh, const bf16* VTh, const bf16x8 (&qf)[4], int key0, int nt, int diag, float mc2, f32x16 (&o)[2], float& l, int r, int h) {
    for (int kt = 0; kt < nt; ++kt) { const int kb = key0 + 32 * kt;
        f32x16 s = qk_tile(Kh + (size_t)(kb + r) * 64 + 8 * h, qf);
        float ls = 0.f;
#pragma unroll
        for (int i = 0; i < 16; ++i) { float p = __builtin_amdgcn_exp2f(s[i] * (0.125f * LOG2E) - mc2); if (kt == diag && crow(i, h) > r) p = 0.f; s[i] = p; ls += p; }
        l += ls;
        pv_tile(o, VTh + (size_t)r * SEQ + kb + 4 * h, s);
    }
}
DI float moba_mc2(const float* gq, const float* gk, int lane) {
    float a = fabsf(gq[lane]), b = fabsf(gk[lane]);
    a = wave_max(a); b = wave_max(b);
    return 8.0f * a * b * LOG2E;
}
struct MobaT { const bf16 *Q, *K, *VT; const float* ksum; unsigned* masks; bf16* PO; float* PL; const float *gq, *gk; };
DI void moba_mask_unit(int u, const MobaT& T, int lane) {
    const int bh = u >> 8, t0 = (u & 255) * 32, own = t0 >> 8, r = lane & 31, h = lane >> 5;
    unsigned mask = 0u;
    if (own > 0) {
        f32x16 g;
#pragma unroll
        for (int i = 0; i < 16; ++i) g[i] = 0.f;
        const float* km = T.ksum + ((size_t)bh * 32 + r) * 64 + 8 * h; const bf16* qp = T.Q + ((size_t)bh * SEQ + t0 + r) * 64 + 8 * h;
#pragma unroll
        for (int ks = 0; ks < 4; ++ks) { const f32x4 a0 = *(const f32x4*)(km + 16 * ks) * (1.0f / 256.0f), a1 = *(const f32x4*)(km + 16 * ks + 4) * (1.0f / 256.0f);
            v4u aw; aw.x = cvtpk2(a0[0], a0[1]); aw.y = cvtpk2(a0[2], a0[3]); aw.z = cvtpk2(a1[0], a1[1]); aw.w = cvtpk2(a1[2], a1[3]);
            g = MFMA32(__builtin_bit_cast(bf16x8, aw), ld16g(qp + 16 * ks), g); }
        int ka = KEY_MIN, kb2 = KEY_MIN, kc = KEY_MIN;
#define INS3(x_) do { int x = (x_); int t = min(ka, x); ka = max(ka, x); int uu = min(kb2, t); kb2 = max(kb2, t); kc = max(kc, uu); } while (0)
#pragma unroll
        for (int i = 0; i < 16; ++i) { const int blk = crow(i, h); const int key = (blk < own) ? ((f_ord(g[i]) & ~31) | (31 - blk)) : KEY_MIN; INS3(key); }
        const int pa = px32(ka, lane), pb = px32(kb2, lane), pc = px32(kc, lane);
        INS3(pa); INS3(pb); INS3(pc);
#undef INS3
        if (ka != KEY_MIN) mask |= 1u << (31 - (ka & 31));
        if (kb2 != KEY_MIN) mask |= 1u << (31 - (kb2 & 31));
        if (kc != KEY_MIN) mask |= 1u << (31 - (kc & 31));
    }
    if (h == 0) T.masks[(size_t)bh * SEQ + t0 + r] = mask;
}
DI void moba_own_unit(int u, const MobaT& T, float mc2, int lane) {
    const int bh = u >> 8, t0 = (u & 255) * 32, own = t0 >> 8, r = lane & 31, h = lane >> 5;
    const bf16* qp = T.Q + ((size_t)bh * SEQ + t0 + r) * 64 + 8 * h; bf16x8 qf[4];
#pragma unroll
    for (int ks = 0; ks < 4; ++ks) qf[ks] = ld16g(qp + 16 * ks);
    f32x16 o[2];
#pragma unroll
    for (int i = 0; i < 16; ++i) { o[0][i] = 0.f; o[1][i] = 0.f; }
    float l = 0.f; const int key0 = own * 256, nt = ((t0 - key0) >> 5) + 1;
    moba_keys(T.K + (size_t)bh * SEQ * 64, T.VT + (size_t)bh * 64 * SEQ, qf, key0, nt, nt - 1, mc2, o, l, r, h);
    l = sum32(l);
    const size_t base = ((size_t)bh * SEQ + t0 + r) * 4 + 3;
    store_ot(T.PO + base * 64, o, 1.0f, h); if (h == 0) T.PL[base] = l;
}
constexpr int MS_K = 0, MS_V = 32768, MS_VROW = 520, MS_LIST = 32768 + 64 * 520, MS_CNT = MS_LIST + 8192, MOBA_NTASK = 16 * 79;
DI void moba_sel_task(int task, const MobaT& T, LAS unsigned char* lds, float mc2, int tid, int wave, int lane) {
    int p, rem = task; if (rem < 128) p = 0; else if (rem < 384) { p = 1; rem -= 128; } else if (rem < 768) { p = 2; rem -= 384; } else { p = 3; rem -= 768; }
    const int j = rem >> 4, bh = rem & 15;
    LAS unsigned* list = (LAS unsigned*)(lds + MS_LIST); LAS unsigned* cntp = (LAS unsigned*)(lds + MS_CNT);
    { const bf16* Kg = T.K + ((size_t)bh * SEQ + 256 * j) * 64; const bf16* Vg = T.VT + (size_t)bh * 64 * SEQ + 256 * j;
      v4u kv[4], vv[4];
#pragma unroll
      for (int i = 0; i < 4; ++i) { const int c = tid + 512 * i; kv[i] = *(const v4u*)(Kg + (size_t)c * 8); const int d = c >> 5, cc = c & 31; vv[i] = *(const v4u*)(Vg + (size_t)d * SEQ + cc * 8); }
      if (tid == 0) *cntp = 0u;
#pragma unroll
      for (int i = 0; i < 4; ++i) { const int c = tid + 512 * i; const int k = c >> 3, ch = c & 7; *(LAS v4u*)(lds + MS_K + k * 128 + ((ch ^ ((k >> 1) & 7)) << 4)) = kv[i];
          const int d = c >> 5, cc = c & 31; LAS unsigned char* vp = lds + MS_V + d * MS_VROW + cc * 16; *(LAS unsigned long long*)vp = (unsigned long long)vv[i].x | ((unsigned long long)vv[i].y << 32); *(LAS unsigned long long*)(vp + 8) = (unsigned long long)vv[i].z | ((unsigned long long)vv[i].w << 32); } }
    __syncthreads();
    { const int qlo = 256 * (8 * p + 1), qhi = (8 * p + 9) * 256 < SEQ ? (8 * p + 9) * 256 : SEQ;
      for (int t0 = qlo + wave * 64; t0 < qhi; t0 += 512) { const int t = t0 + lane; const unsigned mk = T.masks[(size_t)bh * SEQ + t]; const bool sel = (mk >> j) & 1u;
          const unsigned long long bal = __ballot(sel); const int nb = __builtin_popcountll(bal);
          unsigned base = 0; if (lane == 0 && nb) base = __hip_atomic_fetch_add(cntp, (unsigned)nb, __ATOMIC_RELAXED, __HIP_MEMORY_SCOPE_WORKGROUP); base = (unsigned)__builtin_amdgcn_readfirstlane((int)base);
          if (sel) list[base + __builtin_popcountll(bal & ((1ull << lane) - 1ull))] = (unsigned)t; } }
    __syncthreads();
    const int n = (int)*cntp; const int r = lane & 31, h = lane >> 5;
    const LAS unsigned char* kb = lds + MS_K; const LAS unsigned char* vb = lds + MS_V;
    for (int b0 = wave * 32; b0 < n; b0 += 256) { const bool valid = b0 + r < n; const int t = (int)list[valid ? b0 + r : b0];
        const unsigned mk = T.masks[(size_t)bh * SEQ + t]; const int slot = __builtin_popcount(mk & ((1u << j) - 1u));
        const bf16* qp = T.Q + ((size_t)bh * SEQ + t) * 64 + 8 * h; bf16x8 qf[4];
#pragma unroll
        for (int ks = 0; ks < 4; ++ks) qf[ks] = ld16g(qp + 16 * ks);
        f32x16 o[2];
#pragma unroll
        for (int i = 0; i < 16; ++i) { o[0][i] = 0.f; o[1][i] = 0.f; }
        float l = 0.f;
#pragma unroll 2
        for (int kt = 0; kt < 8; ++kt) { const int key = 32 * kt + r;
            f32x16 s;
#pragma unroll
            for (int i = 0; i < 16; ++i) s[i] = 0.f;
#pragma unroll
            for (int ks = 0; ks < 4; ++ks) s = MFMA32(*(const LAS bf16x8*)(kb + key * 128 + (((2 * ks + h) ^ ((key >> 1) & 7)) << 4)), qf[ks], s);
            float ls = 0.f;
#pragma unroll
            for (int i = 0; i < 16; ++i) { const float pv = __builtin_amdgcn_exp2f(s[i] * (0.125f * LOG2E) - mc2); s[i] = pv; ls += pv; }
            l += ls;
#pragma unroll
            for (int sx = 0; sx < 2; ++sx) { const bf16x8 pb = pack8(s, sx);
#pragma unroll
                for (int mt = 0; mt < 2; ++mt) { const LAS unsigned char* vp = vb + (32 * mt + r) * MS_VROW + (32 * kt + 16 * sx + 4 * h) * 2;
                    const s16x4 a0 = *(const LAS s16x4*)vp, a1 = *(const LAS s16x4*)(vp + 16); o[mt] = MFMA32(__builtin_shufflevector(a0, a1, 0, 1, 2, 3, 4, 5, 6, 7), pb, o[mt]); } }
        }
        l = sum32(l);
        if (valid) { const size_t base = ((size_t)bh * SEQ + t) * 4 + slot; store_ot(T.PO + base * 64, o, 1.0f, h); if (h == 0) T.PL[base] = l; }
    }
    __syncthreads();
}
DI void moba_combine(const Frame& F, const bf16* PO, const float* PL, bf16* YCAT) {
    const size_t gt = (size_t)F.gw * 64 + F.lane, NT = (size_t)F.NGW * 64;
    for (size_t i = gt; i < (size_t)16 * SEQ * 8; i += NT) { const int dq = (int)i & 7, t = (int)(i >> 3) & (SEQ - 1), bh = (int)(i >> 16); const int own = t >> 8, ns = own < 3 ? own : 3;
        float o[8]; float l = 0.f;
#pragma unroll
        for (int k = 0; k < 8; ++k) o[k] = 0.f;
#pragma unroll
        for (int s = 0; s < 4; ++s) { if (s < ns || s == 3) { const size_t base = ((size_t)bh * SEQ + t) * 4 + s; l += PL[base]; const v4u w = *(const v4u*)(PO + base * 64 + dq * 8);
                o[0] += bf_lo(w.x); o[1] += bf_hi(w.x); o[2] += bf_lo(w.y); o[3] += bf_hi(w.y); o[4] += bf_lo(w.z); o[5] += bf_hi(w.z); o[6] += bf_lo(w.w); o[7] += bf_hi(w.w); } }
        const float il = 1.0f / l; v4u w; w.x = cvtpk2(o[0] * il, o[1] * il); w.y = cvtpk2(o[2] * il, o[3] * il); w.z = cvtpk2(o[4] * il, o[5] * il); w.w = cvtpk2(o[6] * il, o[7] * il);
        *(v4u*)(YCAT + ((size_t)(bh >> 3) * SEQ + t) * 1024 + 512 + (bh & 7) * 64 + dq * 8) = w; }
}

DI void gmlp_unit(int unit, const bf16* UA, const bf16* VA, const float* vgain, const bf16* GWS, const float* bs, bf16* YCAT, LAS unsigned char* lds, int tid, int wave, int lane) {
    const int cidx = unit >> 2, g = unit & 3, row0 = cidx * 128; LAS bf16* VNT = (LAS bf16*)lds;
    { const int row = tid >> 2, dq = (tid & 3) * 32; const bf16* src = VA + (size_t)(row0 + row) * 512 + g * 128 + dq;
      float f[32]; float ss = 0.f;
#pragma unroll
      for (int k = 0; k < 4; ++k) { const v4u w = *(const v4u*)(src + 8 * k); f[8 * k] = bf_lo(w.x); f[8 * k + 1] = bf_hi(w.x); f[8 * k + 2] = bf_lo(w.y); f[8 * k + 3] = bf_hi(w.y); f[8 * k + 4] = bf_lo(w.z); f[8 * k + 5] = bf_hi(w.z); f[8 * k + 6] = bf_lo(w.w); f[8 * k + 7] = bf_hi(w.w); }
#pragma unroll
      for (int k = 0; k < 32; ++k) ss += f[k] * f[k];
      ss += dppf<DPP_X1>(ss); ss += dppf<DPP_X2>(ss);
      const float rinv = rsqrtf(ss * (1.0f / 128.0f) + 1e-6f);
#pragma unroll
      for (int k = 0; k < 32; ++k) VNT[(dq + k) * 136 + row] = (bf16)(cvtpk2(f[k] * rinv * vgain[g * 128 + dq + k], 0.f) & 0xffffu); }
    __syncthreads();
    { const int mt = wave >> 1, ntb = (wave & 1) * 2, r = lane & 31, h = lane >> 5;
      f32x16 acc[2];
#pragma unroll
      for (int i = 0; i < 16; ++i) { acc[0][i] = 0.f; acc[1][i] = 0.f; }
      const bf16* wp = GWS + ((size_t)g * 128 + 32 * mt + r) * 128 + 8 * h;
      for (int ks = 0; ks < 2 * (mt + 1); ++ks) { const bf16x8 a = ld16g(wp + 16 * ks);
#pragma unroll
          for (int nn = 0; nn < 2; ++nn) { const bf16x8 b = *(const LAS bf16x8*)(VNT + (32 * (ntb + nn) + r) * 136 + 16 * ks + 8 * h); acc[nn] = MFMA32(a, b, acc[nn]); } }
#pragma unroll
      for (int nn = 0; nn < 2; ++nn)
#pragma unroll
          for (int i = 0; i < 16; ++i) { const int t = 32 * mt + crow(i, h), d = 32 * (ntb + nn) + r; const float mixed = acc[nn][i] + bs[g * 128 + t];
              const float uv = __uint_as_float((unsigned)UA[(size_t)(row0 + t) * 512 + g * 128 + d] << 16);
              YCAT[(size_t)(row0 + t) * 1024 + g * 128 + d] = (bf16)(cvtpk2(uv * mixed, 0.f) & 0xffffu); } }
    __syncthreads();
}

struct SbK { bf16x8 k[4]; }; struct SbV { s16x4 v[8]; };
DI void sb_loadk(SbK& f, const bf16* Kh, int kb, int r, int h) {
    const bf16* kp = Kh + (size_t)(kb + r) * 64 + 8 * h;
#pragma unroll
    for (int ks = 0; ks < 4; ++ks) f.k[ks] = ld16g(kp + 16 * ks);
}
DI void sb_loadv(SbV& f, const bf16* VTh, int kb, int r, int h) {
    const bf16* vp = VTh + (size_t)r * SEQ + kb + 4 * h;
#pragma unroll
    for (int s = 0; s < 2; ++s)
#pragma unroll
        for (int mt = 0; mt < 2; ++mt) { const bf16* v = vp + (size_t)mt * 32 * SEQ + 16 * s; f.v[4 * s + 2 * mt] = *(const s16x4*)v; f.v[4 * s + 2 * mt + 1] = *(const s16x4*)(v + 8); }
}
template <bool DIAG> DI void sb_tile(const SbK& fk, const SbV& fv, const bf16x8 (&qf)[4], f32x16 (&o)[2], float& R, int r, int h, int lane) {
    f32x16 s;
#pragma unroll
    for (int i = 0; i < 16; ++i) s[i] = 0.f;
#pragma unroll
    for (int ks = 0; ks < 4; ++ks) s = MFMA32(fk.k[ks], qf[ks], s);
    f32x16 x;
#pragma unroll
    for (int i = 0; i < 16; ++i) { const float z = s[i]; const float t = __builtin_amdgcn_exp2f(-fabsf(z) * LOG2E); const float sp = fmaxf(z, 0.f) + LN2 * __builtin_amdgcn_logf(1.0f + t);
        if (DIAG) { const bool valid = crow(i, h) < r; x[i] = valid ? -sp : 0.f; s[i] = valid ? z : -INFINITY; } else x[i] = -sp; }
    float T4[4], E[16];
#pragma unroll
    for (int g = 0; g < 4; ++g) { E[4 * g + 3] = 0.f; E[4 * g + 2] = x[4 * g + 3]; E[4 * g + 1] = E[4 * g + 2] + x[4 * g + 2]; E[4 * g] = E[4 * g + 1] + x[4 * g + 1]; T4[g] = E[4 * g] + x[4 * g]; }
    float P4[4];
#pragma unroll
    for (int g = 0; g < 4; ++g) P4[g] = px32(T4[g], lane);
    float C[4]; float run = 0.f;
#pragma unroll
    for (int g = 3; g >= 0; --g) { C[g] = run + (h == 0 ? P4[g] : 0.f); run += T4[g] + P4[g]; }
#pragma unroll
    for (int i = 0; i < 16; ++i) { const float arg = x[i] + s[i] + (R + C[i >> 2] + E[i]); x[i] = __builtin_amdgcn_exp2f(arg * LOG2E); }
#pragma unroll
    for (int sx = 0; sx < 2; ++sx) { const bf16x8 pb = pack8(x, sx);
#pragma unroll
        for (int mt = 0; mt < 2; ++mt) o[mt] = MFMA32(__builtin_shufflevector(fv.v[4 * sx + 2 * mt], fv.v[4 * sx + 2 * mt + 1], 0, 1, 2, 3, 4, 5, 6, 7), pb, o[mt]); }
    R += run;
}
constexpr int SB_K = 0, SB_V = 65536, SB_VROW = 1032;
DI void sb_wg_unit(int u, const bf16* Q, const bf16* K, const bf16* VT, bf16* YCAT, LAS unsigned char* lds, int tid, int wave, int lane) {
    const int bh = u >> 5, qb = u & 31, r = lane & 31, h = lane >> 5; const int base = qb > 0 ? 256 * (qb - 1) : 0, nk = qb > 0 ? 512 : 256;
    const bf16* Kh = K + (size_t)bh * SEQ * 64; const bf16* VTh = VT + (size_t)bh * 64 * SEQ;
    { const bf16* Kg = Kh + (size_t)base * 64; const int nch = nk * 8;
      for (int c0 = 0; c0 < nch; c0 += 2048) { v4u kv[4];
#pragma unroll
          for (int i = 0; i < 4; ++i) kv[i] = *(const v4u*)(Kg + (size_t)(c0 + tid + 512 * i) * 8);
#pragma unroll
          for (int i = 0; i < 4; ++i) { const int c = c0 + tid + 512 * i, k = c >> 3, ch = c & 7; *(LAS v4u*)(lds + SB_K + k * 128 + ((ch ^ ((k >> 1) & 7)) << 4)) = kv[i]; } }
      const int cpr = nk / 8;
      for (int c0 = 0; c0 < 64 * cpr; c0 += 2048) { v4u vv[4];
#pragma unroll
          for (int i = 0; i < 4; ++i) { const int c = c0 + tid + 512 * i, d = c / cpr, cc = c - d * cpr; vv[i] = *(const v4u*)(VTh + (size_t)d * SEQ + base + cc * 8); }
#pragma unroll
          for (int i = 0; i < 4; ++i) { const int c = c0 + tid + 512 * i, d = c / cpr, cc = c - d * cpr; LAS unsigned char* vp = lds + SB_V + d * SB_VROW + cc * 16;
              *(LAS unsigned long long*)vp = (unsigned long long)vv[i].x | ((unsigned long long)vv[i].y << 32); *(LAS unsigned long long*)(vp + 8) = (unsigned long long)vv[i].z | ((unsigned long long)vv[i].w << 32); } } }
    const int t0 = 256 * qb + 32 * wave;
    const bf16* qp = Q + ((size_t)bh * SEQ + t0 + r) * 64 + 8 * h; bf16x8 qf[4];
#pragma unroll
    for (int ks = 0; ks < 4; ++ks) qf[ks] = ld16g(qp + 16 * ks);
    __syncthreads();
    f32x16 o[2];
#pragma unroll
    for (int i = 0; i < 16; ++i) { o[0][i] = 0.f; o[1][i] = 0.f; }
    float R = 0.f; bool diag = true;
    for (int kb = t0; kb >= 0; kb -= 32) {
        if (!diag && !__any(R >= -104.0f)) break;
        SbK fk; SbV fv;
        if (kb >= base) { const int kl = kb - base + r;
            const LAS unsigned char* kp = lds + SB_K + kl * 128;
#pragma unroll
            for (int ks = 0; ks < 4; ++ks) fk.k[ks] = *(const LAS bf16x8*)(kp + (((2 * ks + h) ^ ((kl >> 1) & 7)) << 4));
#pragma unroll
            for (int s = 0; s < 2; ++s)
#pragma unroll
                for (int mt = 0; mt < 2; ++mt) { const LAS unsigned char* vp = lds + SB_V + (32 * mt + r) * SB_VROW + (kb - base + 16 * s + 4 * h) * 2; fv.v[4 * s + 2 * mt] = *(const LAS s16x4*)vp; fv.v[4 * s + 2 * mt + 1] = *(const LAS s16x4*)(vp + 16); }
        } else { sb_loadk(fk, Kh, kb, r, h); sb_loadv(fv, VTh, kb, r, h); }
        if (diag) sb_tile<true>(fk, fv, qf, o, R, r, h, lane); else sb_tile<false>(fk, fv, qf, o, R, r, h, lane);
        diag = false;
    }
    store_ot(YCAT + ((size_t)(bh >> 4) * SEQ + t0 + r) * 1024 + (bh & 15) * 64, o, 1.0f, h);
    __syncthreads();
}

#define CE_(a, b) do { const int hi_ = max((a), (b)); (b) = min((a), (b)); (a) = hi_; } while (0)
DI void sort16_desc(int (&v)[16]) {
    CE_(v[0], v[1]); CE_(v[2], v[3]); CE_(v[0], v[2]); CE_(v[1], v[3]); CE_(v[1], v[2]); CE_(v[4], v[5]); CE_(v[6], v[7]); CE_(v[4], v[6]); CE_(v[5], v[7]);
    CE_(v[5], v[6]); CE_(v[0], v[4]); CE_(v[2], v[6]); CE_(v[2], v[4]); CE_(v[1], v[5]); CE_(v[3], v[7]); CE_(v[3], v[5]); CE_(v[1], v[2]); CE_(v[3], v[4]);
    CE_(v[5], v[6]); CE_(v[8], v[9]); CE_(v[10], v[11]); CE_(v[8], v[10]); CE_(v[9], v[11]); CE_(v[9], v[10]); CE_(v[12], v[13]); CE_(v[14], v[15]); CE_(v[12], v[14]);
    CE_(v[13], v[15]); CE_(v[13], v[14]); CE_(v[8], v[12]); CE_(v[10], v[14]); CE_(v[10], v[12]); CE_(v[9], v[13]); CE_(v[11], v[15]); CE_(v[11], v[13]);
    CE_(v[9], v[10]); CE_(v[11], v[12]); CE_(v[13], v[14]); CE_(v[0], v[8]); CE_(v[4], v[12]); CE_(v[4], v[8]); CE_(v[2], v[10]); CE_(v[6], v[14]); CE_(v[6], v[10]);
    CE_(v[2], v[4]); CE_(v[6], v[8]); CE_(v[10], v[12]); CE_(v[1], v[9]); CE_(v[5], v[13]); CE_(v[5], v[9]); CE_(v[3], v[11]); CE_(v[7], v[15]); CE_(v[7], v[11]);
    CE_(v[3], v[5]); CE_(v[7], v[9]); CE_(v[11], v[13]); CE_(v[1], v[2]); CE_(v[3], v[4]); CE_(v[5], v[6]); CE_(v[7], v[8]); CE_(v[9], v[10]); CE_(v[11], v[12]);
    CE_(v[13], v[14]);
}
DI void merge16_desc(int (&A)[16], const int (&B)[16]) {
#pragma unroll
    for (int i = 0; i < 16; ++i) A[i] = max(A[i], B[15 - i]);
    CE_(A[0], A[8]); CE_(A[1], A[9]); CE_(A[2], A[10]); CE_(A[3], A[11]); CE_(A[4], A[12]); CE_(A[5], A[13]); CE_(A[6], A[14]); CE_(A[7], A[15]); CE_(A[0], A[4]);
    CE_(A[1], A[5]); CE_(A[2], A[6]); CE_(A[3], A[7]); CE_(A[8], A[12]); CE_(A[9], A[13]); CE_(A[10], A[14]); CE_(A[11], A[15]); CE_(A[0], A[2]); CE_(A[1], A[3]);
    CE_(A[4], A[6]); CE_(A[5], A[7]); CE_(A[8], A[10]); CE_(A[9], A[11]); CE_(A[12], A[14]); CE_(A[13], A[15]); CE_(A[0], A[1]); CE_(A[2], A[3]); CE_(A[4], A[5]);
    CE_(A[6], A[7]); CE_(A[8], A[9]); CE_(A[10], A[11]); CE_(A[12], A[13]); CE_(A[14], A[15]);
}
#define PEER_CAND_CHUNK(C_, c_) do { \
    if ((c_) == 0) { C_[0] = (f_ord(s1[0] + s2[0]) & ~0x3fff) | a1[0] | a2[0]; C_[1] = (f_ord(s1[0] + s2[1]) & ~0x3fff) | a1[0] | a2[1]; C_[2] = (f_ord(s1[0] + s2[2]) & ~0x3fff) | a1[0] | a2[2]; C_[3] = (f_ord(s1[0] + s2[3]) & ~0x3fff) | a1[0] | a2[3]; C_[4] = (f_ord(s1[0] + s2[4]) & ~0x3fff) | a1[0] | a2[4]; C_[5] = (f_ord(s1[0] + s2[5]) & ~0x3fff) | a1[0] | a2[5]; C_[6] = (f_ord(s1[0] + s2[6]) & ~0x3fff) | a1[0] | a2[6]; C_[7] = (f_ord(s1[0] + s2[7]) & ~0x3fff) | a1[0] | a2[7]; C_[8] = (f_ord(s1[0] + s2[8]) & ~0x3fff) | a1[0] | a2[8]; C_[9] = (f_ord(s1[0] + s2[9]) & ~0x3fff) | a1[0] | a2[9]; C_[10] = (f_ord(s1[0] + s2[10]) & ~0x3fff) | a1[0] | a2[10]; C_[11] = (f_ord(s1[0] + s2[11]) & ~0x3fff) | a1[0] | a2[11]; C_[12] = (f_ord(s1[0] + s2[12]) & ~0x3fff) | a1[0] | a2[12]; C_[13] = (f_ord(s1[0] + s2[13]) & ~0x3fff) | a1[0] | a2[13]; C_[14] = (f_ord(s1[0] + s2[14]) & ~0x3fff) | a1[0] | a2[14]; C_[15] = (f_ord(s1[0] + s2[15]) & ~0x3fff) | a1[0] | a2[15]; } \
    if ((c_) == 1) { C_[0] = (f_ord(s1[1] + s2[0]) & ~0x3fff) | a1[1] | a2[0]; C_[1] = (f_ord(s1[1] + s2[1]) & ~0x3fff) | a1[1] | a2[1]; C_[2] = (f_ord(s1[1] + s2[2]) & ~0x3fff) | a1[1] | a2[2]; C_[3] = (f_ord(s1[1] + s2[3]) & ~0x3fff) | a1[1] | a2[3]; C_[4] = (f_ord(s1[1] + s2[4]) & ~0x3fff) | a1[1] | a2[4]; C_[5] = (f_ord(s1[1] + s2[5]) & ~0x3fff) | a1[1] | a2[5]; C_[6] = (f_ord(s1[1] + s2[6]) & ~0x3fff) | a1[1] | a2[6]; C_[7] = (f_ord(s1[1] + s2[7]) & ~0x3fff) | a1[1] | a2[7]; C_[8] = (f_ord(s1[2] + s2[0]) & ~0x3fff) | a1[2] | a2[0]; C_[9] = (f_ord(s1[2] + s2[1]) & ~0x3fff) | a1[2] | a2[1]; C_[10] = (f_ord(s1[2] + s2[2]) & ~0x3fff) | a1[2] | a2[2]; C_[11] = (f_ord(s1[2] + s2[3]) & ~0x3fff) | a1[2] | a2[3]; C_[12] = (f_ord(s1[2] + s2[4]) & ~0x3fff) | a1[2] | a2[4]; C_[13] = (f_ord(s1[3] + s2[0]) & ~0x3fff) | a1[3] | a2[0]; C_[14] = (f_ord(s1[3] + s2[1]) & ~0x3fff) | a1[3] | a2[1]; C_[15] = (f_ord(s1[3] + s2[2]) & ~0x3fff) | a1[3] | a2[2]; } \
    if ((c_) == 2) { C_[0] = (f_ord(s1[3] + s2[3]) & ~0x3fff) | a1[3] | a2[3]; C_[1] = (f_ord(s1[4] + s2[0]) & ~0x3fff) | a1[4] | a2[0]; C_[2] = (f_ord(s1[4] + s2[1]) & ~0x3fff) | a1[4] | a2[1]; C_[3] = (f_ord(s1[4] + s2[2]) & ~0x3fff) | a1[4] | a2[2]; C_[4] = (f_ord(s1[5] + s2[0]) & ~0x3fff) | a1[5] | a2[0]; C_[5] = (f_ord(s1[5] + s2[1]) & ~0x3fff) | a1[5] | a2[1]; C_[6] = (f_ord(s1[6] + s2[0]) & ~0x3fff) | a1[6] | a2[0]; C_[7] = (f_ord(s1[6] + s2[1]) & ~0x3fff) | a1[6] | a2[1]; C_[8] = (f_ord(s1[7] + s2[0]) & ~0x3fff) | a1[7] | a2[0]; C_[9] = (f_ord(s1[7] + s2[1]) & ~0x3fff) | a1[7] | a2[1]; C_[10] = (f_ord(s1[8] + s2[0]) & ~0x3fff) | a1[8] | a2[0]; C_[11] = (f_ord(s1[9] + s2[0]) & ~0x3fff) | a1[9] | a2[0]; C_[12] = (f_ord(s1[10] + s2[0]) & ~0x3fff) | a1[10] | a2[0]; C_[13] = (f_ord(s1[11] + s2[0]) & ~0x3fff) | a1[11] | a2[0]; C_[14] = (f_ord(s1[12] + s2[0]) & ~0x3fff) | a1[12] | a2[0]; C_[15] = (f_ord(s1[13] + s2[0]) & ~0x3fff) | a1[13] | a2[0]; } \
    if ((c_) == 3) { C_[0] = (f_ord(s1[14] + s2[0]) & ~0x3fff) | a1[14] | a2[0]; C_[1] = (f_ord(s1[15] + s2[0]) & ~0x3fff) | a1[15] | a2[0]; C_[2] = KEY_MIN; C_[3] = KEY_MIN; C_[4] = KEY_MIN; C_[5] = KEY_MIN; C_[6] = KEY_MIN; C_[7] = KEY_MIN; C_[8] = KEY_MIN; C_[9] = KEY_MIN; C_[10] = KEY_MIN; C_[11] = KEY_MIN; C_[12] = KEY_MIN; C_[13] = KEY_MIN; C_[14] = KEY_MIN; C_[15] = KEY_MIN; } \
} while (0)

DI void peer_scores(int tokg, int head, const bf16* QP, const bf16* SUBK, unsigned* ent  , int lane) {
    const int r = lane & 31, h = lane >> 5;
    int L1[16], L2[16];
#pragma unroll
    for (int p = 0; p < 2; ++p) {
        const bf16* qp = QP + (size_t)(tokg + r) * 2048 + head * 256 + p * 128 + 8 * h; bf16x8 qf[8];
#pragma unroll
        for (int ks = 0; ks < 8; ++ks) qf[ks] = ld16g(qp + 16 * ks);
        const bf16* sk = SUBK + (size_t)((head * 2 + p) * 128 + r) * 128 + 8 * h;
        int L[16];
#pragma unroll
        for (int i = 0; i < 16; ++i) L[i] = KEY_MIN;
#pragma unroll 1
        for (int mt = 0; mt < 4; ++mt) {
            f32x16 acc;
#pragma unroll
            for (int i = 0; i < 16; ++i) acc[i] = 0.f;
#pragma unroll
            for (int ks = 0; ks < 8; ++ks) acc = MFMA32(ld16g(sk + (size_t)mt * 32 * 128 + 16 * ks), qf[ks], acc);
            int Nw[16];
#pragma unroll
            for (int i = 0; i < 16; ++i) Nw[i] = (f_ord(acc[i]) & ~127) | (32 * mt + crow(i, h));
            sort16_desc(Nw); merge16_desc(L, Nw);
        }
        int Pn[16];
#pragma unroll
        for (int i = 0; i < 16; ++i) Pn[i] = px32(L[i], lane);
        merge16_desc(L, Pn);
#pragma unroll
        for (int i = 0; i < 16; ++i) { if (p == 0) L1[i] = L[i]; else L2[i] = L[i]; }
    }
    float s1[16], s2[16]; int a1[16], a2[16];
#pragma unroll
    for (int i = 0; i < 16; ++i) { s1[i] = f_unord(L1[i] & ~127); s2[i] = f_unord(L2[i] & ~127); a1[i] = (L1[i] & 127) << 7; a2[i] = L2[i] & 127; }
    int Cn[16];
    PEER_CAND_CHUNK(Cn, 0); sort16_desc(Cn);
#pragma unroll
    for (int c = 1; c < 4; ++c) { int Dn[16]; PEER_CAND_CHUNK(Dn, c); sort16_desc(Dn); merge16_desc(Cn, Dn); }
    float e[16]; float sum = 0.f; const float m0 = f_unord(Cn[0] & ~0x3fff);
#pragma unroll
    for (int k = 0; k < 16; ++k) { e[k] = __builtin_amdgcn_exp2f((f_unord(Cn[k] & ~0x3fff) - m0) * LOG2E); sum += e[k]; }
    const float inv = 1.0f / sum;
    if (h == 0) { unsigned* dst = ent + (size_t)r * 128 + head * 16;
#pragma unroll
        for (int g4 = 0; g4 < 4; ++g4) { v4u w;
            w.x = (cvtpk2(0.f, e[4 * g4] * inv) & 0xffff0000u) | (unsigned)(Cn[4 * g4] & 0x3fff); w.y = (cvtpk2(0.f, e[4 * g4 + 1] * inv) & 0xffff0000u) | (unsigned)(Cn[4 * g4 + 1] & 0x3fff);
            w.z = (cvtpk2(0.f, e[4 * g4 + 2] * inv) & 0xffff0000u) | (unsigned)(Cn[4 * g4 + 2] & 0x3fff); w.w = (cvtpk2(0.f, e[4 * g4 + 3] * inv) & 0xffff0000u) | (unsigned)(Cn[4 * g4 + 3] & 0x3fff);
            *(v4u*)(dst + 4 * g4) = w; } }
}
typedef float f32x2 __attribute__((ext_vector_type(2)));
DI f32x2 fp8lo(unsigned w) { return __builtin_amdgcn_cvt_pk_f32_fp8((int)w, false); }
DI f32x2 fp8hi(unsigned w) { return __builtin_amdgcn_cvt_pk_f32_fp8((int)w, true); }
DI f32x2 fma2(f32x2 a, f32x2 b, f32x2 c) { float x = c.x, y = c.y; asm("v_fmac_f32 %0, %1, %2" : "+v"(x) : "v"(a.x), "v"(b.x)); asm("v_fmac_f32 %0, %1, %2" : "+v"(y) : "v"(a.y), "v"(b.y)); return (f32x2){x, y}; }
constexpr int PU_LIST = 0, PU_H = 65536, PU_USC = 98304, PU_VSC = 106496, PU_BC = 114688, PU_LCAP = 160;
template <int VAR> DI void peer_u_issue(v4u (&rw)[16], const unsigned char* U8, const LAS unsigned* lev, int lane) {
#pragma unroll
    for (int k4 = 0; k4 < 4; ++k4) { const v4u ev = *(const LAS v4u*)(lev + 4 * k4);
#pragma unroll
        for (int k = 0; k < 4; ++k) rw[4 * k4 + k] = *(const v4u*)(U8 + (size_t)(ev[k] & 0x3fffu) * 1024 + 16 * lane); }
}
template <int VAR> DI void peer_u_compute(const v4u (&rw)[16], const LAS unsigned char* hrow, float hs, const LAS unsigned* lev, const LAS unsigned* lslot, int nvalid, int tok, const LAS float* uscs, const LAS float* vscs, float* ACT, int lane) {
    const v4u hq = *(const LAS v4u*)(hrow + 16 * lane);
    int p[16];
#pragma unroll
    for (int k = 0; k < 16; ++k) { int a = __builtin_amdgcn_sdot4((int)rw[k].x, (int)hq.x, 0, false); a = __builtin_amdgcn_sdot4((int)rw[k].y, (int)hq.y, a, false); a = __builtin_amdgcn_sdot4((int)rw[k].z, (int)hq.z, a, false); p[k] = __builtin_amdgcn_sdot4((int)rw[k].w, (int)hq.w, a, false); }
    { const bool up = (lane & 8) != 0;
#pragma unroll
      for (int i = 0; i < 8; ++i) { const int keep = up ? p[i + 8] : p[i], send = up ? p[i] : p[i + 8]; p[i] = keep + dppi<DPP_RM>(send); } }
    { const bool up = (lane & 4) != 0;
#pragma unroll
      for (int i = 0; i < 4; ++i) { const int keep = up ? p[i + 4] : p[i], send = up ? p[i] : p[i + 4]; p[i] = keep + dppi<DPP_HM>(send); } }
    { const bool up = (lane & 2) != 0;
#pragma unroll
      for (int i = 0; i < 2; ++i) { const int keep = up ? p[i + 2] : p[i], send = up ? p[i] : p[i + 2]; p[i] = keep + dppi<DPP_X2>(send); } }
    { const bool up = (lane & 1) != 0; const int keep = up ? p[1] : p[0], send = up ? p[0] : p[1]; p[0] = keep + dppi<DPP_X1>(send); }
    int dq = p[0];
    { auto r = __builtin_amdgcn_permlane16_swap((unsigned)dq, (unsigned)dq, false, false); dq = (int)r[0] + (int)r[1]; }
    { auto r = __builtin_amdgcn_permlane32_swap((unsigned)dq, (unsigned)dq, false, false); dq = (int)r[0] + (int)r[1]; }
    const int myk = lane & 15;
    if (lane < 16 && myk < nvalid) { const unsigned mev = lev[myk], mslot = lslot[myk]; const unsigned er = mev & 2047u;
        ACT[(VAR == 1) ? (size_t)lane : ((size_t)tok * 128 + mslot)] = gelu_tanh((float)dq * hs * uscs[er]) * __uint_as_float(mev & 0xffff0000u) * vscs[er]; }
}
DI void peer_u_loade(int tok, const unsigned* ENT, unsigned (&e0)[4], unsigned (&e1)[4], int lane) {
#pragma unroll
    for (int t = 0; t < 4; ++t) { e0[t] = ENT[(size_t)(tok + t) * 128 + lane]; e1[t] = ENT[(size_t)(tok + t) * 128 + 64 + lane]; }
}
template <int VAR> DI void peer_u_wave(int tok0, int slab, const unsigned* ENT, const unsigned char* HQ, const float* HS, const unsigned char* U8, float* ACT, LAS unsigned char* lds, int wave, int lane) {
    LAS unsigned* lev = (LAS unsigned*)(lds + PU_LIST + wave * 8192); LAS unsigned* lslot = lev + 4 * PU_LCAP; LAS unsigned char* hb = lds + PU_H + wave * 4096;
    const LAS float* uscs = (const LAS float*)(lds + PU_USC); const LAS float* vscs = (const LAS float*)(lds + PU_VSC);
    unsigned e0[4], e1[4];
    peer_u_loade(tok0, ENT, e0, e1, lane);
#pragma unroll 1
    for (int bt = 0; bt < 4; ++bt) { const int tb = tok0 + 4 * bt;
        v4u hq[4]; float hsv[4];
#pragma unroll
        for (int t = 0; t < 4; ++t) { hq[t] = *(const v4u*)(HQ + (size_t)(tb + t) * 1024 + 16 * lane); hsv[t] = HS[tb + t]; }
        int cnt[4]; const unsigned long long lt = (1ull << lane) - 1ull;
#pragma unroll
        for (int t = 0; t < 4; ++t) { const bool in0 = ((e0[t] >> 11) & 7u) == (unsigned)slab, in1 = ((e1[t] >> 11) & 7u) == (unsigned)slab;
            const unsigned long long b0 = __ballot(in0), b1 = __ballot(in1); const int n0 = __builtin_popcountll(b0), n = n0 + __builtin_popcountll(b1);
            LAS unsigned* le = lev + t * PU_LCAP; LAS unsigned* ls = lslot + t * PU_LCAP;
            if (in0) { const int p = __builtin_popcountll(b0 & lt); le[p] = e0[t]; ls[p] = (unsigned)lane; }
            if (in1) { const int p = n0 + __builtin_popcountll(b1 & lt); le[p] = e1[t]; ls[p] = (unsigned)(64 + lane); }
            if (n > 0 && lane < 16) { const unsigned pe = b0 ? (unsigned)__builtin_amdgcn_readlane((int)e0[t], (int)__builtin_ctzll(b0 | (1ull << 63))) : (unsigned)__builtin_amdgcn_readlane((int)e1[t], (int)__builtin_ctzll(b1 | (1ull << 63)));
                if (n + lane < ((n + 15) & ~15)) le[n + lane] = pe; }
            cnt[t] = n; }
        if (bt < 3) peer_u_loade(tb + 4, ENT, e0, e1, lane);
#pragma unroll
        for (int t = 0; t < 4; ++t) *(LAS v4u*)(hb + t * 1024 + 16 * lane) = hq[t];
        asm volatile("s_waitcnt lgkmcnt(0)" ::: "memory");
#define PU_CNT(t_) ((t_) == 0 ? cnt[0] : ((t_) == 1 ? cnt[1] : ((t_) == 2 ? cnt[2] : cnt[3])))
#define PU_HS(t_) ((t_) == 0 ? hsv[0] : ((t_) == 1 ? hsv[1] : ((t_) == 2 ? hsv[2] : hsv[3])))
#define PU_ADV(tk_, g_) do { while ((tk_) < 4 && (g_) >= PU_CNT(tk_)) { ++(tk_); (g_) = 0; } } while (0)
        int tk = 0, g = 0; PU_ADV(tk, g);
        if (tk < 4) { v4u ra[16], rb[16];
            peer_u_issue<VAR>(ra, U8, lev + tk * PU_LCAP + g, lane);
            for (;;) {
                int ntk = tk, ng = g + 16; PU_ADV(ntk, ng);
                if (ntk < 4) peer_u_issue<VAR>(rb, U8, lev + ntk * PU_LCAP + ng, lane);
                peer_u_compute<VAR>(ra, hb + tk * 1024, PU_HS(tk), lev + tk * PU_LCAP + g, lslot + tk * PU_LCAP + g, PU_CNT(tk) - g, tb + tk, uscs, vscs, ACT, lane);
                tk = ntk; g = ng; if (tk >= 4) break;
                ntk = tk; ng = g + 16; PU_ADV(ntk, ng);
                if (ntk < 4) peer_u_issue<VAR>(ra, U8, lev + ntk * PU_LCAP + ng, lane);
                peer_u_compute<VAR>(rb, hb + tk * 1024, PU_HS(tk), lev + tk * PU_LCAP + g, lslot + tk * PU_LCAP + g, PU_CNT(tk) - g, tb + tk, uscs, vscs, ACT, lane);
                tk = ntk; g = ng; if (tk >= 4) break;
            } }
#undef PU_CNT
#undef PU_HS
#undef PU_ADV
        asm volatile("s_waitcnt lgkmcnt(0)" ::: "memory");
    }
}
template <int VVAR> DI void peer_v_wave(int tok0, int slab, const unsigned* ENT, const float* ACT, const unsigned char* V8slab, bf16* XB, float* XF, const float* g2, int lane) {
    const int sub = lane & 7, j = lane >> 3;
    const int col = 128 * slab + 16 * sub + 2 * (4 * ((lane >> 5) & 1) + 2 * ((lane >> 4) & 1) + ((lane >> 3) & 1));
    const f32x2 gv = *(const f32x2*)(g2 + (tok0 >> 13) * 6144 + col);
    v4u enn[4]; f32x4 awn[4]; unsigned xvn;
    { const v4u* ep = (const v4u*)(ENT + (size_t)tok0 * 128 + 16 * j); const f32x4* ap = (const f32x4*)(ACT + (size_t)tok0 * 128 + 16 * j);
#pragma unroll
      for (int q = 0; q < 4; ++q) { enn[q] = ep[q]; awn[q] = ap[q]; }
      xvn = *(const unsigned*)(XB + (size_t)tok0 * 1024 + col); }
    (void)0;
#pragma unroll 1
    for (int it = 0; it < 8; ++it) { const int tok = tok0 + it;
        v4u en[4]; f32x4 aw[4]; const f32x2 xv = (f32x2){bf_lo(xvn), bf_hi(xvn)};
#pragma unroll
        for (int q = 0; q < 4; ++q) { en[q] = enn[q]; aw[q] = awn[q]; }
        v4u rw[16];
#pragma unroll
        for (int i = 0; i < 16; ++i) rw[i] = *(const v4u*)(V8slab + (size_t)((VVAR >= 2) ? (unsigned)(i + 16 * j) : (en[i >> 2][i & 3] & 0x3fffu)) * 128 + 16 * sub);
        if (it < 7 && VVAR != 3) { const v4u* ep = (const v4u*)(ENT + (size_t)(tok + 1) * 128 + 16 * j); const f32x4* ap = (const f32x4*)(ACT + (size_t)(tok + 1) * 128 + 16 * j);
#pragma unroll
            for (int q = 0; q < 4; ++q) { enn[q] = ep[q]; awn[q] = ap[q]; }
            xvn = *(const unsigned*)(XB + (size_t)(tok + 1) * 1024 + col); }
        float wm = 0.f;
#pragma unroll
        for (int q = 0; q < 4; ++q) wm = fmaxf(wm, fmaxf(fmaxf(fabsf(aw[q][0]), fabsf(aw[q][1])), fmaxf(fabsf(aw[q][2]), fabsf(aw[q][3]))));
        wm = fmaxf(wm, dppf<DPP_R8>(wm)); wm = fmaxf(wm, px16(wm, lane)); wm = fmaxf(wm, px32(wm, lane));
        const float wsq = wm > 0.f ? 127.0f / wm : 0.f, winv = wm * (1.0f / 127.0f);
        unsigned W[4];
#pragma unroll
        for (int q = 0; q < 4; ++q) { const int q0 = __float2int_rn(aw[q][0] * wsq), q1 = __float2int_rn(aw[q][1] * wsq), q2 = __float2int_rn(aw[q][2] * wsq), q3 = __float2int_rn(aw[q][3] * wsq);
            W[q] = (unsigned)(q0 & 255) | ((unsigned)(q1 & 255) << 8) | ((unsigned)(q2 & 255) << 16) | ((unsigned)(q3 & 255) << 24); }
        int acc[16];
#pragma unroll
        for (int c = 0; c < 16; ++c) acc[c] = 0;
#pragma unroll
        for (int g = 0; g < 4; ++g)
#pragma unroll
            for (int q = 0; q < 4; ++q) { const unsigned m0 = rw[4 * g][q], m1 = rw[4 * g + 1][q], m2 = rw[4 * g + 2][q], m3 = rw[4 * g + 3][q];
                const unsigned t0 = __builtin_amdgcn_perm(m1, m0, 0x05010400u), t1 = __builtin_amdgcn_perm(m1, m0, 0x07030602u), t2 = __builtin_amdgcn_perm(m3, m2, 0x05010400u), t3 = __builtin_amdgcn_perm(m3, m2, 0x07030602u);
                acc[4 * q] = __builtin_amdgcn_sdot4((int)__builtin_amdgcn_perm(t2, t0, 0x05040100u), (int)W[g], acc[4 * q], false);
                acc[4 * q + 1] = __builtin_amdgcn_sdot4((int)__builtin_amdgcn_perm(t2, t0, 0x07060302u), (int)W[g], acc[4 * q + 1], false);
                acc[4 * q + 2] = __builtin_amdgcn_sdot4((int)__builtin_amdgcn_perm(t3, t1, 0x05040100u), (int)W[g], acc[4 * q + 2], false);
                acc[4 * q + 3] = __builtin_amdgcn_sdot4((int)__builtin_amdgcn_perm(t3, t1, 0x07060302u), (int)W[g], acc[4 * q + 3], false); }
        { const bool up = (lane & 32) != 0;
#pragma unroll
          for (int c = 0; c < 8; ++c) { const int keep = up ? acc[c + 8] : acc[c], send = up ? acc[c] : acc[c + 8]; acc[c] = keep + px32(send, lane); } }
        { const bool up = (lane & 16) != 0;
#pragma unroll
          for (int c = 0; c < 4; ++c) { const int keep = up ? acc[c + 4] : acc[c], send = up ? acc[c] : acc[c + 4]; acc[c] = keep + (int)px16u((unsigned)send, lane); } }
        { const bool up = (lane & 8) != 0;
#pragma unroll
          for (int c = 0; c < 2; ++c) { const int keep = up ? acc[c + 2] : acc[c], send = up ? acc[c] : acc[c + 2]; acc[c] = keep + dppi<DPP_R8>(send); } }
        { const float y0 = xv.x + gv.x * ((float)acc[0] * winv), y1 = xv.y + gv.y * ((float)acc[1] * winv);
          if (XF) *(f32x2*)(XF + (size_t)tok * 1024 + col) = (f32x2){y0, y1}; else *(unsigned*)(XB + (size_t)tok * 1024 + col) = cvtpk2(y0, y1); }
    }
}
struct PeerT { const unsigned char *U8, *V8s; const float *USC, *VSC; unsigned* ENT; float* ACT; const unsigned char* HQ; const float* HS; bf16* XB; float* XF; const float* g2; };
DI void peer_scores_phase(const Frame& F, const bf16* QP, const bf16* SUBK, unsigned* ENT) {
    for (int unit = blockIdx.x; unit < MROWS / 64; unit += F.G) {
#pragma unroll 1
        for (int grp = 0; grp < 2; ++grp) { const int tokg = unit * 64 + 32 * grp; peer_scores(tokg, F.wave, QP, SUBK, ENT + (size_t)tokg * 128, F.lane); } }
}
template <int PASS, int VAR = 0> DI void peer_gather_phase(const Frame& F, int cnt_base, const PeerT& T) {
    const int xcc = XCC_EXPR; LAS int* bc = (LAS int*)(F.lds + PU_BC);
    constexpr int CHT = (PASS == 0) ? 128 : 64;
    for (int k = 0; k < 8; ++k) { const int s = (xcc + k) & 7; unsigned* cnt = (unsigned*)(F.ctl + CW_WORK + 64 * (cnt_base + s));
        if (PASS == 0) { for (int i = F.tid; i < 2048; i += NTHR) { ((LAS float*)(F.lds + PU_USC))[i] = T.USC[2048 * s + i]; ((LAS float*)(F.lds + PU_VSC))[i] = T.VSC[2048 * s + i]; } }
        for (;;) {
            if (F.tid == 0) *bc = (int)__hip_atomic_fetch_add(cnt, 1u, __ATOMIC_RELAXED, __HIP_MEMORY_SCOPE_AGENT);
            __syncthreads(); const int chunk = *bc; __syncthreads();
            if (chunk >= MROWS / CHT) break;
            if (PASS == 0) peer_u_wave<VAR>(chunk * 128 + F.wave * 16, s, T.ENT, T.HQ, T.HS, T.U8, T.ACT, F.lds, F.wave, F.lane);
            else peer_v_wave<VAR>(chunk * 64 + F.wave * 8, s, T.ENT, T.ACT, T.V8s + (size_t)s * 16384 * 128, T.XB, T.XF, T.g2, F.lane);
        } }
}
struct Args { const float* in[19]; float* out; unsigned char* ws; int stage, pad; };
__global__ void __launch_bounds__(NTHR, 2) hybrid_fwd(Args args) {
    extern __shared__ __attribute__((aligned(16))) unsigned char lds_raw[];
    for (int u = threadIdx.x; u < (LDS_BYTES - LDSCTL_OFF) / 4; u += NTHR) ((LAS unsigned*)((LAS unsigned char*)lds_raw + LDSCTL_OFF))[u] = 0u;
    __syncthreads();
    XcdBarrier bar = xcd_barrier_post((unsigned*)((gu32*)(args.ws + WS_CTL) + CW_BAR), (volatile LAS unsigned*)((LAS unsigned char*)lds_raw + MISC_OFF) + 8);
#ifdef PROBE_MASK
    volatile LAS unsigned long long* stamps_ = (volatile LAS unsigned long long*)((LAS unsigned char*)lds_raw + MISC_OFF + 256); int nst_ = 0;
#ifndef PROBE_BLK
#define PROBE_BLK 0
#endif
#define STAMP() do { if (blockIdx.x == PROBE_BLK && threadIdx.x == 0) stamps_[nst_] = __builtin_amdgcn_s_memrealtime(); ++nst_; } while (0)
#else
#define STAMP() do {} while (0)
#endif
    STAMP();
#define GRID_BAR() do { xcd_barrier(bar); STAMP(); } while (0)
#define OPQ(p) ({ size_t z_ = 0; asm volatile("" : "+s"(z_)); (p) + z_; })
#define PH_PTRS \
    unsigned char* ws = OPQ(args.ws); const float* x_in = OPQ(args.in[0]); float* X = OPQ(args.out); \
    const float *norm_mix = args.in[4], *norm_ffn = args.in[5]; \
    float* MOD = (float*)(ws + WS_MOD); float* ROPE = (float*)(ws + WS_ROPE); float* KSUM = (float*)(ws + WS_KSUM); \
    bf16 *WIN0 = (bf16*)(ws + WS_WIN0), *WOUT0 = (bf16*)(ws + WS_WOUT0), *WIN1 = (bf16*)(ws + WS_WIN1), *WOUT1 = (bf16*)(ws + WS_WOUT1), *WQ0 = (bf16*)(ws + WS_WQ0), *WQ1 = (bf16*)(ws + WS_WQ1); \
    bf16 *SUBK = (bf16*)(ws + WS_SUBK), *GWS = (bf16*)(ws + WS_GWS), *HN = (bf16*)(ws + WS_HN); \
    bf16 *UA = (bf16*)(ws + WS_A), *VA = (bf16*)(ws + WS_A + 16 * MiB), *Q0 = (bf16*)(ws + WS_A + 32 * MiB), *K0 = (bf16*)(ws + WS_A + 48 * MiB), *VT0 = (bf16*)(ws + WS_A + 64 * MiB); \
    bf16 *Q1 = (bf16*)(ws + WS_A), *K1 = (bf16*)(ws + WS_A + 32 * MiB), *VT1 = (bf16*)(ws + WS_A + 64 * MiB); \
    bf16 *YCAT = (bf16*)(ws + WS_YCAT), *QP = (bf16*)(ws + WS_QP), *PO = (bf16*)(ws + WS_PO); float* PL = (float*)(ws + WS_PL); unsigned* MASKS = (unsigned*)(ws + WS_MASK); unsigned char *U8 = ws + WS_PTU, *V8s = ws + WS_PTV; float *USC = (float*)(ws + WS_SC), *VSC = USC + 32768; unsigned* ENT = (unsigned*)(ws + WS_PO); float* ACT = (float*)(ws + WS_PO + 8 * MiB); unsigned char* HQ = ws + WS_A; float* HS = (float*)(ws + WS_SC + 512 * 1024); (void)HQ; (void)HS; bf16* XB = (bf16*)(ws + WS_XB); (void)XB; (void)U8; (void)V8s; (void)USC; (void)VSC; (void)ENT; (void)ACT; bf16* QKR = (bf16*)(ws + WS_QP); (void)QKR; \
    (void)x_in; (void)X; (void)norm_mix; (void)norm_ffn; (void)MOD; (void)ROPE; (void)KSUM; (void)WIN0; (void)WOUT0; (void)WIN1; (void)WOUT1; (void)WQ0; (void)WQ1; (void)SUBK; (void)GWS; (void)HN; \
    (void)UA; (void)VA; (void)Q0; (void)K0; (void)VT0; (void)Q1; (void)K1; (void)VT1; (void)YCAT; (void)QP; (void)PO; (void)PL; (void)MASKS;
#define PH_FRAME Frame F; F.lds = (LAS unsigned char*)lds_raw; F.MISC = (volatile LAS unsigned*)(F.lds + MISC_OFF); { int t_ = threadIdx.x; asm volatile("" : "+v"(t_)); F.tid = t_; } F.lane = F.tid & 63; F.wave = __builtin_amdgcn_readfirstlane(F.tid >> 6); \
    F.G = gridDim.x; F.gw = blockIdx.x * NWAVES + F.wave; F.NGW = F.G * NWAVES; F.ctl = (gu32*)(OPQ(args.ws) + WS_CTL);
    { PH_FRAME PH_PTRS
      P0Args A; A.c = args.in[1]; A.w_mod = args.in[2]; A.b_mod = args.in[3]; A.win0 = args.in[6]; A.wout0 = args.in[12]; A.win1 = args.in[13]; A.wout1 = args.in[14]; A.wq = args.in[15]; A.subk = args.in[16];
      A.pu = args.in[17]; A.pv = args.in[18]; A.gws = args.in[8]; A.MOD = MOD; A.ROPE = ROPE; A.WIN0 = WIN0; A.WOUT0 = WOUT0; A.WIN1 = WIN1; A.WOUT1 = WOUT1; A.WQ0 = WQ0; A.WQ1 = WQ1; A.SUBK = SUBK; A.GWS = GWS; A.U8 = U8; A.V8s = V8s; A.USC = USC; A.VSC = VSC;
      p0_prologue(F, A); }
    GRID_BAR();
    { PH_FRAME PH_PTRS norm_rows<true>(F, x_in, norm_mix, MOD, 0, 1, HN); }
    GRID_BAR();
    { PH_FRAME PH_PTRS
      pg8::Gemm g{HN, WIN0, MROWS, 2048, 1024}; pg8::StaticOrder S; S.init(MROWS, 2048, F.G, (int)blockIdx.x);
      pg8::EpiL0m E{UA, VA, QKR};
      pg8::gemm_phase<pg8::EpiL0m, pg8::StaticOrder, true, true>(F.lds, g, S, E); }
    { PH_FRAME PH_PTRS
      pg8::Gemm g{WIN0 + (size_t)2048 * 1024, HN, 512, MROWS, 1024}; pg8::StaticOrder S; S.init(512, MROWS, F.G, (int)blockIdx.x);
      pg8::EpiVT E{VT0, 512};
      pg8::gemm_phase<pg8::EpiVT, pg8::StaticOrder, true, true>(F.lds, g, S, E); }
    GRID_BAR();
    { PH_FRAME PH_PTRS
      for (int t = blockIdx.x; t < 256; t += F.G) qk_post_task(t, QKR, Q0, K0, KSUM, ROPE, args.in[10], args.in[11], (LAS float*)F.lds, F.tid, F.wave, F.lane);
      for (int u = blockIdx.x; u < 512; u += F.G) gmlp_unit(u, UA, VA, args.in[7], GWS, args.in[9], YCAT, F.lds, F.tid, F.wave, F.lane); }
    GRID_BAR();
    { PH_FRAME PH_PTRS
      MobaT T{Q0, K0, VT0, KSUM, MASKS, PO, PL, args.in[10], args.in[11]}; const float mc2 = moba_mc2(args.in[10], args.in[11], F.lane);
      for (int u = F.gw; u < 4096; u += F.NGW) { moba_mask_unit(u, T, F.lane); moba_own_unit(u, T, mc2, F.lane); } }
    GRID_BAR();
    { PH_FRAME PH_PTRS
      MobaT T{Q0, K0, VT0, KSUM, MASKS, PO, PL, args.in[10], args.in[11]}; const float mc2 = moba_mc2(args.in[10], args.in[11], F.lane);
      LAS int* bc = (LAS int*)(F.lds + MS_CNT + 64);
      for (;;) { if (F.tid == 0) *bc = (int)__hip_atomic_fetch_add((unsigned*)(F.ctl + CW_WORK), 1u, __ATOMIC_RELAXED, __HIP_MEMORY_SCOPE_AGENT);
          __syncthreads(); const int task = *bc; __syncthreads(); if (task >= MOBA_NTASK) break;
          moba_sel_task(task, T, F.lds, mc2, F.tid, F.wave, F.lane); } }
    GRID_BAR();
    { PH_FRAME PH_PTRS moba_combine(F, PO, PL, YCAT); }
    GRID_BAR();
    { PH_FRAME PH_PTRS
      pg8::Gemm g{YCAT, WOUT0, MROWS, 1024, 1024}; pg8::StaticOrder S; S.init(MROWS, 1024, F.G, (int)blockIdx.x);
      pg8::EpiRes<true> E{x_in, XB, MOD + 2 * 1024};
      pg8::gemm_phase<pg8::EpiRes<true>, pg8::StaticOrder, true, true>(F.lds, g, S, E); }
    GRID_BAR();
    { PH_FRAME PH_PTRS norm_rows<false>(F, XB, norm_ffn, MOD, 3, 4, HN, HQ, HS); }
    GRID_BAR();
    { PH_FRAME PH_PTRS
      pg8::Gemm g{HN, WQ0, MROWS, 2048, 1024}; pg8::StaticOrder S; S.init(MROWS, 2048, F.G, (int)blockIdx.x);
      pg8::EpiBf16<0> E{QP, 2048, nullptr, 0, 0, 1.f};
      pg8::gemm_phase<pg8::EpiBf16<0>, pg8::StaticOrder, true, true>(F.lds, g, S, E); }
    GRID_BAR();
    { PH_FRAME PH_PTRS peer_scores_phase(F, QP, SUBK, ENT); }
    GRID_BAR();
    { PH_FRAME PH_PTRS PeerT T{U8, V8s, USC, VSC, ENT, ACT, HQ, HS, XB, nullptr, MOD + 5 * 1024}; peer_gather_phase<0>(F, 1, T); }
    GRID_BAR();
#ifdef XVAR
    { PH_FRAME PH_PTRS PeerT T{U8, V8s, USC, VSC, ENT, (float*)(ws + WS_PL), HQ, HS, XB, nullptr, MOD + 5 * 1024}; peer_gather_phase<0, XVAR>(F, 40, T); }
    GRID_BAR();
#endif
    { PH_FRAME PH_PTRS PeerT T{U8, V8s, USC, VSC, ENT, ACT, HQ, HS, XB, nullptr, MOD + 5 * 1024}; peer_gather_phase<1>(F, 9, T); }
    GRID_BAR();
#ifdef XVVAR
    { PH_FRAME PH_PTRS PeerT T{U8, V8s, USC, VSC, ENT, ACT, HQ, HS, XB, (float*)(ws + WS_QP), MOD + 5 * 1024}; peer_gather_phase<1, XVVAR>(F, 48, T); }
    GRID_BAR();
#endif
    { PH_FRAME PH_PTRS norm_rows<false>(F, XB, norm_mix + 1024, MOD + 2 * 6144, 0, 1, HN); }
    GRID_BAR();
    { PH_FRAME PH_PTRS
      pg8::Gemm g{HN, WIN1, MROWS, 2048, 1024}; pg8::StaticOrder S; S.init(MROWS, 2048, F.G, (int)blockIdx.x);
      pg8::EpiHeads E{Q1, K1, 16, 0.125f};
      pg8::gemm_phase<pg8::EpiHeads, pg8::StaticOrder, true, true>(F.lds, g, S, E); }
    { PH_FRAME PH_PTRS
      pg8::Gemm g{WIN1 + (size_t)2048 * 1024, HN, 1024, MROWS, 1024}; pg8::StaticOrder S; S.init(1024, MROWS, F.G, (int)blockIdx.x);
      pg8::EpiVT E{VT1, 1024};
      pg8::gemm_phase<pg8::EpiVT, pg8::StaticOrder, true, true>(F.lds, g, S, E); }
    GRID_BAR();
    { PH_FRAME PH_PTRS for (int u = blockIdx.x; u < 1024; u += F.G) sb_wg_unit(u, Q1, K1, VT1, YCAT, F.lds, F.tid, F.wave, F.lane); }
    GRID_BAR();
    { PH_FRAME PH_PTRS
      pg8::Gemm g{YCAT, WOUT1, MROWS, 1024, 1024}; pg8::StaticOrder S; S.init(MROWS, 1024, F.G, (int)blockIdx.x);
      pg8::EpiRes<false> E{nullptr, XB, MOD + 2 * 6144 + 2 * 1024};
      pg8::gemm_phase<pg8::EpiRes<false>, pg8::StaticOrder, true, true>(F.lds, g, S, E); }
    GRID_BAR();
    { PH_FRAME PH_PTRS norm_rows<false>(F, XB, norm_ffn + 1024, MOD + 2 * 6144, 3, 4, HN, HQ, HS); }
    GRID_BAR();
    { PH_FRAME PH_PTRS
      pg8::Gemm g{HN, WQ1, MROWS, 2048, 1024}; pg8::StaticOrder S; S.init(MROWS, 2048, F.G, (int)blockIdx.x);
      pg8::EpiBf16<0> E{QP, 2048, nullptr, 0, 0, 1.f};
      pg8::gemm_phase<pg8::EpiBf16<0>, pg8::StaticOrder, true, true>(F.lds, g, S, E); }
    GRID_BAR();
    { PH_FRAME PH_PTRS peer_scores_phase(F, QP, SUBK + 262144, ENT); }
    GRID_BAR();
    { PH_FRAME PH_PTRS PeerT T{U8 + (size_t)16384 * 1024, V8s + (size_t)16384 * 1024, USC + 16384, VSC + 16384, ENT, ACT, HQ, HS, XB, X, MOD + 2 * 6144 + 5 * 1024}; peer_gather_phase<0>(F, 17, T); }
    GRID_BAR();
    { PH_FRAME PH_PTRS PeerT T{U8 + (size_t)16384 * 1024, V8s + (size_t)16384 * 1024, USC + 16384, VSC + 16384, ENT, ACT, HQ, HS, XB, X, MOD + 2 * 6144 + 5 * 1024}; peer_gather_phase<1>(F, 25, T);
      if (__hip_atomic_load((gu32*)((unsigned*)(F.ctl + CW_BAR) + XB_TMO), RLX_AGENT) != 0u) { for (int m = F.gw; m < MROWS; m += F.NGW) X[(size_t)m * 1024 + F.lane] = __builtin_nanf(""); } }
#ifdef PROBE_MASK
#ifdef PROBE_BARS
    for (int i = 0; i < PROBE_BARS; ++i) xcd_barrier(bar);
#endif
    STAMP();
    if (blockIdx.x == PROBE_BLK && threadIdx.x == 0) { unsigned long long tsel = 0;
        for (int i = 0; i + 1 < nst_; ++i) if ((PROBE_MASK >> i) & 1ull) tsel += stamps_[i + 1] - stamps_[i];

        const unsigned long long t0 = __builtin_amdgcn_s_memrealtime(); while (__builtin_amdgcn_s_memrealtime() - t0 < tsel * PROBE_AMP) __builtin_amdgcn_s_sleep(8); }
#endif
}

extern "C" void kernel_launch(void* const* d_in, const int* in_sizes, int n_in, void* d_out, int out_size, void* d_ws, size_t ws_size, hipStream_t stream) {
    static int grid = 0;
    if (grid == 0) {
        if (n_in != 19 || out_size != MROWS * DM || ws_size < WS_END) { fprintf(stderr, "kernel_launch: unexpected shapes (n_in %d, out %d, ws %zu)\n", n_in, out_size, ws_size); grid = -1; return; }
        int dev = 0, cus = 0, per_cu = 0;
        if (hipGetDevice(&dev) != hipSuccess || hipDeviceGetAttribute(&cus, hipDeviceAttributeMultiprocessorCount, dev) != hipSuccess) { grid = -1; return; }
        if (hipFuncSetAttribute((const void*)hybrid_fwd, hipFuncAttributeMaxDynamicSharedMemorySize, LDS_BYTES) != hipSuccess) { fprintf(stderr, "kernel_launch: hipFuncSetAttribute failed\n"); grid = -1; return; }
        if (hipOccupancyMaxActiveBlocksPerMultiprocessor(&per_cu, (const void*)hybrid_fwd, NTHR, LDS_BYTES) != hipSuccess || per_cu < 1) { fprintf(stderr, "kernel_launch: occupancy query says %d\n", per_cu); per_cu = 1; }
        (void)hipGetLastError();
        grid = cus;
    }
    if (grid < 0) return;
    if (hipMemsetAsync((char*)d_ws + WS_CTL, 0, CTL_ZERO_BYTES, stream) != hipSuccess) { fprintf(stderr, "kernel_launch: memset failed\n"); return; }
    Args a{};
    for (int i = 0; i < 19; ++i) a.in[i] = (const float*)d_in[i];
    a.out = (float*)d_out; a.ws = (unsigned char*)d_ws; a.stage = 0; a.pad = 0;
    void* kargs[] = {&a};
    hipError_t e = hipLaunchCooperativeKernel((const void*)hybrid_fwd, dim3(grid), dim3(NTHR), kargs, LDS_BYTES, stream);
    if (e != hipSuccess) fprintf(stderr, "kernel_launch: cooperative launch failed: %s (grid %d)\n", hipGetErrorString(e), grid);
}
```

```cpp
#include <hip/hip_runtime.h>
#include <cstdio>
#include <cstdint>
#include <cmath>
namespace pg8 {
#define PG8_LAS __attribute__((address_space(3)))
typedef unsigned short bf16_t;
typedef short bf16x8 __attribute__((ext_vector_type(8)));
typedef float f32x4 __attribute__((ext_vector_type(4)));
typedef unsigned u32x4 __attribute__((ext_vector_type(4)));
constexpr int BM = 256, BK = 64, HALF = 128, HTB = HALF * BK * 2  , STAGE_BYTES = 8 * HTB, NXCD = 8, WGM = 8;

__host__ __device__ __forceinline__ int lds_byte(int r, int c) { const int st = (r >> 4) * 2 + (c >> 5), rr = r & 15, cc = c & 31, ob = rr * 64 + cc * 2; return st * 1024 + (ob ^ (((ob >> 9) & 1) << 5)); }
__host__ __device__ __forceinline__ void stage_rc(int b, int& R, int& C) { const int st = b / 1024, sb = b % 1024, swz = sb ^ (((sb >> 9) & 1) << 5); R = (st >> 1) * 16 + swz / 64; C = (st & 1) * 32 + (swz % 64) / 2; }
__host__ __device__ __forceinline__ int perm32(int rho) { const int n = rho >> 4, i = rho & 15; return 8 * (i >> 2) + 4 * n + (i & 3); }

struct Unit { int pm, pn; };
struct Gemm { const bf16_t* A; const bf16_t* Bt; int M, N, K; };

struct StaticOrder {
    int nM, nN, nwg, G, c;
    __host__ __device__ void init(int M, int N, int G_, int c_) { nM = M / BM; nN = N / BM; nwg = nM * nN; G = G_; c = c_; }
    __host__ __device__ bool next(int i, Unit& u) const {
        const long L = (long)i * G + c; if (L >= nwg) return false;
        int wgid = (int)L; { const int q = nwg / NXCD, r = nwg % NXCD, xcd = wgid % NXCD, off = wgid / NXCD; wgid = (xcd < r ? xcd * (q + 1) : r * (q + 1) + (xcd - r) * q) + off; }
        const int nig = WGM * nN, gid = wgid / nig, fm = gid * WGM, gsz = (nM - fm) < WGM ? (nM - fm) : WGM;
        u.pm = fm + ((wgid % nig) % gsz); u.pn = (wgid % nig) / gsz; return true;
    }
    __device__ __forceinline__ void a_ready(const Unit&) const {}
    __device__ __forceinline__ void done(const Unit&) const {}
};

__device__ __forceinline__ unsigned cvt_pk_bf16(float lo, float hi) { unsigned r; asm volatile("v_cvt_pk_bf16_f32 %0, %1, %2" : "=v"(r) : "v"(lo), "v"(hi)); return r; }
typedef float f32x2 __attribute__((ext_vector_type(2)));
__device__ __forceinline__ f32x2 gelu_pk(f32x2 v) {
    const f32x2 av = __builtin_elementwise_abs(v), d = av * 0.2316418882f + 1.0f;
    f32x2 t; t.x = __builtin_amdgcn_rcpf(d.x); t.y = __builtin_amdgcn_rcpf(d.y);
    f32x2 q = t * 0.5307027145f + (-0.7265760135f); q = q * t + 0.7107068705f; q = q * t + (-0.142248368f); q = q * t + 0.127414796f; q = q * t;
    const f32x2 s = (v * v) * (-0.72134752044f);
    f32x2 e; e.x = __builtin_amdgcn_exp2f(s.x); e.y = __builtin_amdgcn_exp2f(s.y);
    const f32x2 m = v * (q * e), r = v - m;
    f32x2 o; o.x = v.x < 0.f ? m.x : r.x; o.y = v.y < 0.f ? m.y : r.y; return o;
}

template <int ACT  > struct EpiBf16 {
    static constexpr bool PERM = true, AFTER_DRAIN = false; static_assert(ACT == 0 || ACT == 1, "EpiBf16: ACT is 0 (none) or 1 (gelu_pk)");
    bf16_t* O; int ldc; const float* bias; int split_cols; size_t split_stride; float scale0;
    __device__ __forceinline__ void operator()(const f32x4 (&acc)[2][2][4][2], const Unit& u, int wr, int wc, int fr, int fq) const {
        const int row0 = u.pm * BM + wr * 64 + fr; int colt = u.pn * BM; bf16_t* base = O;
        float sc = 1.f; if (split_cols) { const int t = colt / split_cols; base += (size_t)t * split_stride; colt -= t * split_cols; if (t == 0) sc = scale0; }
        const int col0 = colt + wc * 32 + 8 * fq, bcol0 = u.pn * BM + wc * 32 + 8 * fq;
        f32x4 bv[2][2];
#pragma unroll
        for (int bj = 0; bj < 2; ++bj)
#pragma unroll
            for (int n = 0; n < 2; ++n) bv[bj][n] = bias ? *(const f32x4*)(bias + bcol0 + bj * HALF + 4 * n) : (f32x4){0.f, 0.f, 0.f, 0.f};
#pragma unroll
        for (int ai = 0; ai < 2; ++ai)
#pragma unroll
            for (int m = 0; m < 4; ++m) { bf16_t* rowp = base + (size_t)(row0 + ai * HALF + m * 16) * ldc + col0;
#pragma unroll
                for (int bj = 0; bj < 2; ++bj) { f32x4 v0 = acc[ai][bj][m][0] + bv[bj][0], v1 = acc[ai][bj][m][1] + bv[bj][1];
                    if (ACT == 1) { f32x2 a = gelu_pk((f32x2){v0[0], v0[1]}), b = gelu_pk((f32x2){v0[2], v0[3]}), c = gelu_pk((f32x2){v1[0], v1[1]}), d = gelu_pk((f32x2){v1[2], v1[3]});
                        v0 = (f32x4){a.x, a.y, b.x, b.y}; v1 = (f32x4){c.x, c.y, d.x, d.y}; }
                    v0 = v0 * sc; v1 = v1 * sc; u32x4 w; w.x = cvt_pk_bf16(v0[0], v0[1]); w.y = cvt_pk_bf16(v0[2], v0[3]); w.z = cvt_pk_bf16(v1[0], v1[1]); w.w = cvt_pk_bf16(v1[2], v1[3]);
                    *(u32x4*)(rowp + bj * HALF) = w; } }
    }
};
constexpr int XSEQ = 8192;
typedef float f32x2e __attribute__((ext_vector_type(2))); typedef __bf16 bf16x2e __attribute__((ext_vector_type(2)));
__device__ __forceinline__ unsigned cvtpk2(float lo, float hi) { f32x2e v = {lo, hi}; bf16x2e b = __builtin_convertvector(v, bf16x2e); return __builtin_bit_cast(unsigned, b); }
__device__ __forceinline__ float gelu_tanh(float x) {
    const float u2 = x * (1.5957691216f + 0.0713548163f * x * x);
    return x * __builtin_amdgcn_rcpf(1.0f + __builtin_amdgcn_exp2f(-1.4426950409f * u2));
}
struct EpiL0m {
    static constexpr bool PERM = true, AFTER_DRAIN = false;
    bf16_t *UA, *VA, *QKR;
    template <bool ACT> __device__ __forceinline__ void tile(const f32x4 (&acc)[2][2][4][2], bf16_t* base, int ldc, int row0, int colt) const {
#pragma unroll
        for (int ai = 0; ai < 2; ++ai)
#pragma unroll
            for (int m = 0; m < 4; ++m) { bf16_t* rowp = base + (size_t)(row0 + ai * HALF + m * 16) * ldc + colt;
#pragma unroll
                for (int bj = 0; bj < 2; ++bj) { f32x4 v0 = acc[ai][bj][m][0], v1 = acc[ai][bj][m][1]; u32x4 w;
                    if (ACT) { v0[0] = gelu_tanh(v0[0]); v0[1] = gelu_tanh(v0[1]); v0[2] = gelu_tanh(v0[2]); v0[3] = gelu_tanh(v0[3]); v1[0] = gelu_tanh(v1[0]); v1[1] = gelu_tanh(v1[1]); v1[2] = gelu_tanh(v1[2]); v1[3] = gelu_tanh(v1[3]); }
                    w.x = cvtpk2(v0[0], v0[1]); w.y = cvtpk2(v0[2], v0[3]); w.z = cvtpk2(v1[0], v1[1]); w.w = cvtpk2(v1[2], v1[3]);
                    *(u32x4*)(rowp + bj * HALF) = w; } }
    }
    __device__ __forceinline__ void operator()(const f32x4 (&acc)[2][2][4][2], const Unit& u, int wr, int wc, int fr, int fq) const {
        const int pn = u.pn; const int row0 = u.pm * BM + wr * 64 + fr; const int cw = wc * 32 + 8 * fq;
        if (pn < 2) tile<true>(acc, UA, 512, row0, pn * 256 + cw);
        else if (pn < 4) tile<true>(acc, VA, 512, row0, (pn - 2) * 256 + cw);
        else tile<false>(acc, QKR, 1024, row0, (pn - 4) * 256 + cw);
    }
};
struct EpiHeads {
    static constexpr bool PERM = true, AFTER_DRAIN = false;
    bf16_t *Q, *Kp; int nh; float qscale;
    __device__ __forceinline__ void operator()(const f32x4 (&acc)[2][2][4][2], const Unit& u, int wr, int wc, int fr, int fq) const {
        const int b = u.pm >> 5, sb = (u.pm & 31) * 256 + wr * 64 + fr;
#pragma unroll
        for (int bj = 0; bj < 2; ++bj) { const int c = u.pn * BM + bj * HALF + wc * 32 + 8 * fq; const int t = c / (64 * nh), cc = c - t * 64 * nh, head = cc >> 6, d = cc & 63;
            bf16_t* dst = (t ? Kp : Q) + ((size_t)(b * nh + head) * XSEQ) * 64 + d;
#pragma unroll
            for (int ai = 0; ai < 2; ++ai)
#pragma unroll
                for (int m = 0; m < 4; ++m) { const int s = sb + ai * HALF + m * 16; const float qs = t ? 1.0f : qscale; const f32x4 v0 = acc[ai][bj][m][0] * qs, v1 = acc[ai][bj][m][1] * qs; u32x4 w;
                    w.x = cvtpk2(v0[0], v0[1]); w.y = cvtpk2(v0[2], v0[3]); w.z = cvtpk2(v1[0], v1[1]); w.w = cvtpk2(v1[2], v1[3]);
                    *(u32x4*)(dst + (size_t)s * 64) = w; } }
    }
};
struct EpiVT {
    static constexpr bool PERM = true, AFTER_DRAIN = false;
    bf16_t* VT; int nrows;
    __device__ __forceinline__ void operator()(const f32x4 (&acc)[2][2][4][2], const Unit& u, int wr, int wc, int fr, int fq) const {
        const int row0 = u.pm * BM + wr * 64 + fr; const int c0 = u.pn * BM + wc * 32 + 8 * fq; const int b = c0 >> 13, s0 = c0 & (XSEQ - 1);
#pragma unroll
        for (int ai = 0; ai < 2; ++ai)
#pragma unroll
            for (int m = 0; m < 4; ++m) { bf16_t* rowp = VT + ((size_t)b * nrows + row0 + ai * HALF + m * 16) * XSEQ + s0;
#pragma unroll
                for (int bj = 0; bj < 2; ++bj) { const f32x4 v0 = acc[ai][bj][m][0], v1 = acc[ai][bj][m][1]; u32x4 w;
                    w.x = cvtpk2(v0[0], v0[1]); w.y = cvtpk2(v0[2], v0[3]); w.z = cvtpk2(v1[0], v1[1]); w.w = cvtpk2(v1[2], v1[3]);
                    *(u32x4*)(rowp + bj * HALF) = w; } }
    }
};
template <bool XIN_F32> struct EpiRes {
    static constexpr bool PERM = true, AFTER_DRAIN = false;
    const float* xin; bf16_t* XB; const float* g;
    __device__ __forceinline__ void operator()(const f32x4 (&acc)[2][2][4][2], const Unit& u, int wr, int wc, int fr, int fq) const {
        const int row0 = u.pm * BM + wr * 64 + fr, col0 = u.pn * BM + wc * 32 + 8 * fq; const int b = u.pm >> 5;
        f32x4 gv[2][2];
#pragma unroll
        for (int bj = 0; bj < 2; ++bj)
#pragma unroll
            for (int n = 0; n < 2; ++n) gv[bj][n] = *(const f32x4*)(g + b * 6144 + col0 + bj * HALF + 4 * n);
#pragma unroll
        for (int ai = 0; ai < 2; ++ai)
#pragma unroll
            for (int m = 0; m < 4; ++m) { const size_t off = (size_t)(row0 + ai * HALF + m * 16) * 1024 + col0;
#pragma unroll
                for (int bj = 0; bj < 2; ++bj) { f32x4 x0, x1;
                    if (XIN_F32) { x0 = *(const f32x4*)(xin + off + bj * HALF); x1 = *(const f32x4*)(xin + off + bj * HALF + 4); }
                    else { const u32x4 w = *(const u32x4*)(XB + off + bj * HALF); x0 = (f32x4){__uint_as_float(w.x << 16), __uint_as_float(w.x & 0xffff0000u), __uint_as_float(w.y << 16), __uint_as_float(w.y & 0xffff0000u)};
                        x1 = (f32x4){__uint_as_float(w.z << 16), __uint_as_float(w.z & 0xffff0000u), __uint_as_float(w.w << 16), __uint_as_float(w.w & 0xffff0000u)}; }
                    const f32x4 y0 = x0 + gv[bj][0] * acc[ai][bj][m][0], y1 = x1 + gv[bj][1] * acc[ai][bj][m][1]; u32x4 o;
                    o.x = cvtpk2(y0[0], y0[1]); o.y = cvtpk2(y0[2], y0[3]); o.z = cvtpk2(y1[0], y1[1]); o.w = cvtpk2(y1[2], y1[3]);
                    *(u32x4*)(XB + off + bj * HALF) = o; } }
    }
};
template <class Epi, class Sched, bool ALIGN_EPI = false, bool SP2 = false>
__device__ __forceinline__ void gemm_phase(PG8_LAS unsigned char* lds, const Gemm g, const Sched& S, const Epi& E) {
    int tid_ = threadIdx.x; asm volatile("" : "+v"(tid_));
    const int tid = tid_, wid = __builtin_amdgcn_readfirstlane(tid >> 6), lane = tid & 63, wr = wid >> 2, wc = wid & 3, fr = lane & 15, fq = lane >> 4;
    const int K = g.K, nt = K / BK;
    unsigned voffA[2], voffB[2];
#pragma unroll
    for (int i = 0; i < 2; ++i) { int R, C; stage_rc(tid * 16 + i * 8192, R, C); const int Rb = Epi::PERM ? ((R & ~31) + perm32(R & 31)) : R;
        voffA[i] = (unsigned)(R * K + C) * 2u; voffB[i] = (unsigned)(Rb * K + C) * 2u; }
    const size_t kstep = (size_t)(BK * 2);
    const size_t hstep = (size_t)HALF * K * 2;
    const size_t tstep = 2 * hstep;
    const unsigned ldsw = (unsigned)wid * 1024u;
    const int aoff = lds_byte(wr * 64 + fr, fq * 8), boff = lds_byte(wc * 32 + fr, fq * 8);
#define PG8_SA(b, h) (((b) * 2 + (h)) * HTB)
#define PG8_SB(b, h) ((4 + (b) * 2 + (h)) * HTB)
#define PG8_STAGE(bufoff, gbase, voff) do { _Pragma("unroll") for (int _i = 0; _i < 2; ++_i) \
        __builtin_amdgcn_global_load_lds((const unsigned*)((const char*)(gbase) + (voff)[_i]), (PG8_LAS unsigned*)(lds + (bufoff) + ldsw + _i * 8192), 16, 0, 0); } while (0)
#define PG8_LDA(dst, b, h) do { _Pragma("unroll") for (int m = 0; m < 4; ++m) _Pragma("unroll") for (int k = 0; k < 2; ++k) dst[m][k] = *(const PG8_LAS bf16x8*)(lds + PG8_SA(b, h) + aoff + m * 2048 + k * 1024); } while (0)
#define PG8_LDB(dst, b, h) do { _Pragma("unroll") for (int n = 0; n < 2; ++n) _Pragma("unroll") for (int k = 0; k < 2; ++k) dst[n][k] = *(const PG8_LAS bf16x8*)(lds + PG8_SB(b, h) + boff + n * 2048 + k * 1024); } while (0)
#define PG8_MMA(ai, bj, At, Bt) do { __builtin_amdgcn_s_setprio(1); _Pragma("unroll") for (int m = 0; m < 4; ++m) _Pragma("unroll") for (int n = 0; n < 2; ++n) _Pragma("unroll") for (int k = 0; k < 2; ++k) \
        acc[ai][bj][m][n] = __builtin_amdgcn_mfma_f32_16x16x32_bf16(Bt[n][k], At[m][k], acc[ai][bj][m][n], 0, 0, 0); __builtin_amdgcn_s_setprio(0); } while (0)
#define PG8_WAIT_V(n) asm volatile("s_waitcnt vmcnt(" #n ")" ::: "memory")
#define PG8_WAIT_L(n) asm volatile("s_waitcnt lgkmcnt(" #n ")" ::: "memory")
#define PG8_BAR __builtin_amdgcn_s_barrier()
#define PG8_SCHED __builtin_amdgcn_sched_barrier(0)
    Unit cur, nxt; int ui = 0;
    if (!S.next(0, cur)) return;
    f32x4 acc[2][2][4][2];
#pragma unroll
    for (int a = 0; a < 2; ++a)
#pragma unroll
        for (int b = 0; b < 2; ++b)
#pragma unroll
            for (int m = 0; m < 4; ++m)
#pragma unroll
                for (int n = 0; n < 2; ++n) acc[a][b][m][n] = (f32x4){0.f, 0.f, 0.f, 0.f};
    bf16x8 At[4][2], B0[2][2], B1[2][2];
    const char* cA = (const char*)g.A + (size_t)cur.pm * tstep; const char* cB = (const char*)g.Bt + (size_t)cur.pn * tstep;
    S.a_ready(cur);
    if constexpr (SP2) {
        PG8_STAGE(PG8_SB(0, 0), cB, voffB); PG8_STAGE(PG8_SB(0, 1), cB + hstep, voffB); PG8_STAGE(PG8_SA(0, 0), cA, voffA); PG8_STAGE(PG8_SA(0, 1), cA + hstep, voffA);
        if (wr == 1) PG8_BAR;
        PG8_WAIT_V(2); PG8_BAR;
        PG8_STAGE(PG8_SB(1, 0), cB + kstep, voffB); PG8_STAGE(PG8_SA(1, 0), cA + kstep, voffA); PG8_STAGE(PG8_SB(1, 1), cB + hstep + kstep, voffB);
        PG8_WAIT_V(6); PG8_BAR;
    } else {
        PG8_STAGE(PG8_SB(0, 0), cB, voffB); PG8_STAGE(PG8_SA(0, 0), cA, voffA); PG8_STAGE(PG8_SB(0, 1), cB + hstep, voffB); PG8_STAGE(PG8_SA(0, 1), cA + hstep, voffA);
        if (wr == 1) PG8_BAR;
        PG8_WAIT_V(4); PG8_BAR;
        PG8_STAGE(PG8_SB(1, 0), cB + kstep, voffB); PG8_STAGE(PG8_SA(1, 0), cA + kstep, voffA); PG8_STAGE(PG8_SB(1, 1), cB + hstep + kstep, voffB);
        PG8_WAIT_V(6); PG8_BAR;
    }
    for (;;) {
        const bool has_next = S.next(ui + 1, nxt);
        const char* nA = has_next ? (const char*)g.A + (size_t)nxt.pm * tstep : cA; const char* nB = has_next ? (const char*)g.Bt + (size_t)nxt.pn * tstep : cB;
        for (int t = 0; t < nt; t += 2) {
            const bool last = (t == nt - 2);
            const char* a1 = cA + (size_t)(t + 1) * kstep;
            const char* a2 = last ? nA : cA + (size_t)(t + 2) * kstep; const char* b2 = last ? nB : cB + (size_t)(t + 2) * kstep;
            const char* a3 = a2 + kstep; const char* b3 = b2 + kstep;
            if (last && has_next) S.a_ready(nxt);
            if constexpr (SP2) {
            PG8_LDB(B0, 0, 0); PG8_LDB(B1, 0, 1); PG8_SCHED; PG8_LDA(At, 0, 0); PG8_STAGE(PG8_SA(1, 1), a1 + hstep, voffA);
            PG8_WAIT_V(8); PG8_WAIT_L(0); PG8_BAR; PG8_MMA(0, 0, At, B0); PG8_MMA(0, 1, At, B1); PG8_BAR; PG8_SCHED;
            PG8_LDA(At, 0, 1); PG8_STAGE(PG8_SB(0, 0), b2, voffB); PG8_STAGE(PG8_SB(0, 1), b2 + hstep, voffB); PG8_STAGE(PG8_SA(0, 0), a2, voffA);
            PG8_WAIT_V(8); PG8_WAIT_L(0); PG8_BAR; PG8_MMA(1, 0, At, B0); PG8_MMA(1, 1, At, B1); PG8_BAR; PG8_SCHED;
            PG8_LDB(B0, 1, 0); PG8_LDB(B1, 1, 1); PG8_SCHED; PG8_LDA(At, 1, 0); PG8_STAGE(PG8_SA(0, 1), a2 + hstep, voffA);
            PG8_WAIT_V(8); PG8_WAIT_L(0); PG8_BAR; PG8_MMA(0, 0, At, B0); PG8_MMA(0, 1, At, B1); PG8_BAR; PG8_SCHED;
            PG8_LDA(At, 1, 1); PG8_STAGE(PG8_SB(1, 0), b3, voffB); PG8_STAGE(PG8_SB(1, 1), b3 + hstep, voffB); PG8_STAGE(PG8_SA(1, 0), a3, voffA);
            PG8_WAIT_V(8); PG8_WAIT_L(0); PG8_BAR; PG8_MMA(1, 0, At, B0); PG8_MMA(1, 1, At, B1); PG8_BAR; PG8_SCHED;
            } else {
            PG8_LDB(B0, 0, 0); PG8_SCHED; PG8_LDA(At, 0, 0); PG8_STAGE(PG8_SA(1, 1), a1 + hstep, voffA);
            PG8_WAIT_L(8); PG8_BAR; PG8_WAIT_L(0); PG8_MMA(0, 0, At, B0); PG8_BAR; PG8_SCHED;
            PG8_LDB(B1, 0, 1); PG8_STAGE(PG8_SB(0, 0), b2, voffB);
            PG8_BAR; PG8_WAIT_L(0); PG8_MMA(0, 1, At, B1); PG8_BAR;
            PG8_LDA(At, 0, 1); PG8_STAGE(PG8_SA(0, 0), a2, voffA);
            PG8_BAR; PG8_WAIT_L(0); PG8_MMA(1, 0, At, B0); PG8_BAR; PG8_SCHED;
            PG8_STAGE(PG8_SB(0, 1), b2 + hstep, voffB);
            PG8_WAIT_V(6); PG8_BAR; PG8_MMA(1, 1, At, B1); PG8_BAR;
            PG8_LDB(B0, 1, 0); PG8_SCHED; PG8_LDA(At, 1, 0); PG8_STAGE(PG8_SA(0, 1), a2 + hstep, voffA);
            PG8_WAIT_L(8); PG8_BAR; PG8_WAIT_L(0); PG8_MMA(0, 0, At, B0); PG8_BAR; PG8_SCHED;
            PG8_LDB(B1, 1, 1); PG8_STAGE(PG8_SB(1, 0), b3, voffB);
            PG8_BAR; PG8_WAIT_L(0); PG8_MMA(0, 1, At, B1); PG8_BAR;
            PG8_LDA(At, 1, 1); PG8_STAGE(PG8_SA(1, 0), a3, voffA);
            PG8_BAR; PG8_WAIT_L(0); PG8_MMA(1, 0, At, B0); PG8_BAR; PG8_SCHED;
            PG8_STAGE(PG8_SB(1, 1), b3 + hstep, voffB);
            PG8_WAIT_V(6); PG8_BAR; PG8_MMA(1, 1, At, B1); PG8_BAR;
            }
        }
        if constexpr (ALIGN_EPI) { if (wr == 0) PG8_BAR; }
        if constexpr (!Epi::AFTER_DRAIN) { E(acc, cur, wr, wc, fr, fq); S.done(cur); }
        if (!has_next) break;
#pragma unroll
        for (int a = 0; a < 2; ++a)
#pragma unroll
            for (int b = 0; b < 2; ++b)
#pragma unroll
                for (int m = 0; m < 4; ++m)
#pragma unroll
                    for (int n = 0; n < 2; ++n) acc[a][b][m][n] = (f32x4){0.f, 0.f, 0.f, 0.f};
        cur = nxt; cA = nA; cB = nB; ++ui;
        if constexpr (ALIGN_EPI) { if (wr == 1) PG8_BAR; }
    }
    PG8_WAIT_V(0);
    if constexpr (!ALIGN_EPI) { if (wr == 0) PG8_BAR; }
    PG8_BAR;
    if constexpr (Epi::AFTER_DRAIN) { E.fused(acc, cur, wr, wc, fr, fq, lds, wid, lane); S.done(cur); }
#undef PG8_SA
#undef PG8_SB
#undef PG8_STAGE
#undef PG8_LDA
#undef PG8_LDB
#undef PG8_MMA
#undef PG8_WAIT_V
#undef PG8_WAIT_L
#undef PG8_BAR
#undef PG8_SCHED
}
}
#define GAS __attribute__((address_space(1)))
#define LAS __attribute__((address_space(3)))
typedef unsigned short bf16;
typedef unsigned v4u __attribute__((ext_vector_type(4)));
typedef float f32x4 __attribute__((ext_vector_type(4)));
typedef short bf16x8 __attribute__((ext_vector_type(8)));
typedef GAS unsigned gu32;
typedef GAS unsigned long long gu64;
#define RLX_AGENT __ATOMIC_RELAXED, __HIP_MEMORY_SCOPE_AGENT
#define LDS_WAIT() asm volatile("s_waitcnt lgkmcnt(0)" ::: "memory")
#define VM_WAIT() asm volatile("s_waitcnt vmcnt(0)" ::: "memory")
__device__ __forceinline__ unsigned long long rt() { return __builtin_amdgcn_s_memrealtime(); }
__device__ __forceinline__ unsigned f2bf(float f) { unsigned u = __builtin_bit_cast(unsigned, f); return (u + 0x7fffu + ((u >> 16) & 1u)) >> 16; }
__device__ __forceinline__ unsigned pk2(float lo, float hi) { return f2bf(lo) | (f2bf(hi) << 16); }

#define XB_TMO      128
#define XB_XCNT(j)  (256  + 64 * (j))
#define XB_XSUB(j)  (1280 + 64 * (j))
#define XB_XGEN(j)  (2304 + 64 * (j))
#define XB_TOP      3328
#define XB_TOPGEN   3392
#define XCD_BAR_WORDS 3456
#define XB_SPIN_CAP (1u << 18)

__device__ __forceinline__ unsigned xb_ld(unsigned* p)              { return __hip_atomic_load(p, __ATOMIC_RELAXED, __HIP_MEMORY_SCOPE_AGENT); }
__device__ __forceinline__ unsigned xb_add(unsigned* p, unsigned v) { return __hip_atomic_fetch_add(p, v, __ATOMIC_RELAXED, __HIP_MEMORY_SCOPE_AGENT); }
__device__ __forceinline__ unsigned xb_xcc_id() { return (unsigned)__builtin_amdgcn_s_getreg((3 << 11) | 20) & 0xFu; }
#define XB_SPIN(cond, bar) do { unsigned _sp = 0; while (cond) { __builtin_amdgcn_s_sleep(1); \
    if ((++_sp & 255u) == 0u) { if (xb_ld(&(bar)[XB_TMO])) break; if (_sp > XB_SPIN_CAP) { atomicAdd(&(bar)[XB_TMO], 1u); break; } } } } while (0)

struct XcdBarrier {
    unsigned* bar; unsigned x;
    volatile LAS unsigned* st;
};

__device__ __forceinline__ XcdBarrier xcd_barrier_post(unsigned* bar, volatile LAS unsigned* st) {
    XcdBarrier b; b.bar = bar; b.x = xb_xcc_id(); b.st = st;
    if (threadIdx.x == 0) (void)xb_add(&bar[XB_XCNT(b.x)], 1u);
    return b;
}
__device__ __forceinline__ void xcd_barrier_complete(unsigned* bar, unsigned x, unsigned& nloc, unsigned& nx) {
    const unsigned G = gridDim.x * gridDim.y * gridDim.z;
    unsigned sum, cnt, mine, sp = 0u;
    for (;;) {
        sum = 0u; cnt = 0u; mine = 0u;
#pragma unroll
        for (unsigned j = 0; j < 16; ++j) { const unsigned c = xb_ld(&bar[XB_XCNT(j)]); sum += c; cnt += (c > 0u) ? 1u : 0u; mine = (j == x) ? c : mine; }
        if (sum == G) break;
        __builtin_amdgcn_s_sleep(1);
        if ((++sp & 255u) == 0u) { if (xb_ld(&bar[XB_TMO])) break; if (sp > XB_SPIN_CAP) { atomicAdd(&bar[XB_TMO], 1u); break; } }
    }
    nloc = mine > 0u ? mine : 1u; nx = cnt > 0u ? cnt : 1u;
}

__device__ __forceinline__ void xcd_barrier(const XcdBarrier& b) {
    asm volatile("s_waitcnt vmcnt(0)" ::: "memory");
    __syncthreads();
    if (threadIdx.x == 0) {
        unsigned* bar = b.bar;
        __builtin_amdgcn_s_waitcnt(0);
        unsigned nloc = b.st[0], nx = b.st[1];
        if (nloc == 0u) { xcd_barrier_complete(bar, b.x, nloc, nx); b.st[0] = nloc; b.st[1] = nx; }
        const unsigned old = xb_add(&bar[XB_XSUB(b.x)], 1u);
        const unsigned gen = old / nloc;
        if (old + 1u == (gen + 1u) * nloc) {
            __builtin_amdgcn_fence(__ATOMIC_RELEASE, "agent");
            asm volatile("s_waitcnt vmcnt(0)" ::: "memory");
            const unsigned og = xb_add(&bar[XB_TOP], 1u);
            const unsigned tg = og / nx;
            if (og + 1u == (tg + 1u) * nx) xb_add(&bar[XB_TOPGEN], 1u);
            else XB_SPIN(xb_ld(&bar[XB_TOPGEN]) == tg, bar);
            __builtin_amdgcn_fence(__ATOMIC_ACQUIRE, "agent");
            xb_add(&bar[XB_XGEN(b.x)], 1u);
            asm volatile("s_waitcnt vmcnt(0)" ::: "memory");
        } else {
            XB_SPIN(xb_ld(&bar[XB_XGEN(b.x)]) == gen, bar);
            __builtin_amdgcn_fence(__ATOMIC_ACQUIRE, "agent");
            asm volatile("s_waitcnt vmcnt(0)" ::: "memory");
        }
    }
    __syncthreads();
}
constexpr int NWAVES = 8, NTHR = 512;
constexpr int SEQ = 8192, DM = 1024, MROWS = 16384;
constexpr size_t MiB = 1u << 20;
constexpr size_t WS_CTL = 0, CTL_ZERO_BYTES = 2 * MiB;
constexpr size_t WS_KSUM = 1 * MiB;
constexpr size_t WS_MOD = 2 * MiB;
constexpr size_t WS_ROPE = 3 * MiB;
constexpr size_t WS_WIN0 = 4 * MiB, WS_WOUT0 = 9 * MiB, WS_WIN1 = 11 * MiB, WS_WOUT1 = 17 * MiB, WS_WQ0 = 19 * MiB, WS_WQ1 = 23 * MiB;
constexpr size_t WS_SUBK = 27 * MiB, WS_GWS = 28 * MiB, WS_MASK = 29 * MiB, WS_SC = 30 * MiB;
constexpr size_t WS_PTU = 32 * MiB, WS_PTV = 96 * MiB;
constexpr size_t WS_HN = 160 * MiB;
constexpr size_t WS_A = 192 * MiB;
constexpr size_t WS_YCAT = 288 * MiB, WS_QP = 320 * MiB, WS_PO = 384 * MiB, WS_PL = 448 * MiB, WS_XB = 450 * MiB, WS_END = 482 * MiB;
constexpr int CW_BAR = 4096, CW_WORK = 16384;

constexpr int RING_BYTES = 131072, LDSCTL_OFF = 143360, MISC_OFF = LDSCTL_OFF + 320, LDS_BYTES = 147456;

#ifndef XCC_EXPR
#define XCC_EXPR ((int)(xb_xcc_id() & 7u))
#endif
#define DI __device__ __forceinline__
typedef short bf16x8 __attribute__((ext_vector_type(8)));
typedef short s16x4 __attribute__((ext_vector_type(4)));
typedef float f32x16 __attribute__((ext_vector_type(16)));
typedef __bf16 bf16x2t __attribute__((ext_vector_type(2)));
#define MFMA32(a, b, c) __builtin_amdgcn_mfma_f32_32x32x16_bf16((a), (b), (c), 0, 0, 0)
using pg8::cvtpk2; using pg8::gelu_tanh;
DI int crow(int reg, int h) { return (reg & 3) + 8 * (reg >> 2) + 4 * h; }
DI float bf_lo(unsigned w) { return __uint_as_float(w << 16); }
DI float bf_hi(unsigned w) { return __uint_as_float(w & 0xffff0000u); }
DI bf16x8 ld16g(const bf16* p) { return *(const bf16x8*)p; }
DI bf16x8 ld8x2g(const bf16* p0, const bf16* p1) { const s16x4 a = *(const s16x4*)p0, b = *(const s16x4*)p1; return __builtin_shufflevector(a, b, 0, 1, 2, 3, 4, 5, 6, 7); }
DI float dot2bf(unsigned a, unsigned b, float c) { return __builtin_amdgcn_fdot2_f32_bf16(__builtin_bit_cast(bf16x2t, a), __builtin_bit_cast(bf16x2t, b), c, false); }
DI int f_ord(float f) { int i = __float_as_int(f); return i ^ ((i >> 31) & 0x7fffffff); }
DI float f_unord(int i) { return __int_as_float(i ^ ((i >> 31) & 0x7fffffff)); }
constexpr float LOG2E = 1.4426950408889634f, LN2 = 0.6931471805599453f;
#define KEY_MIN ((int)0x80000000)


template <int CTRL> DI float dppf(float x) { return __builtin_bit_cast(float, __builtin_amdgcn_update_dpp(0, __builtin_bit_cast(int, x), CTRL, 0xF, 0xF, true)); }
template <int CTRL> DI int dppi(int x) { return __builtin_amdgcn_update_dpp(0, x, CTRL, 0xF, 0xF, true); }
#define DPP_X1 0xB1
#define DPP_X2 0x4E
#define DPP_HM 0x141
#define DPP_RM 0x140
#define DPP_R8 0x128
DI unsigned px32u(unsigned x, int lane) { auto r = __builtin_amdgcn_permlane32_swap(x, x, false, false); return (lane & 32) ? r[0] : r[1]; }
DI float px32(float x, int lane) { return __uint_as_float(px32u(__float_as_uint(x), lane)); }
DI int px32(int x, int lane) { return (int)px32u((unsigned)x, lane); }
DI unsigned px16u(unsigned x, int lane) { auto r = __builtin_amdgcn_permlane16_swap(x, x, false, false); return (lane & 16) ? r[0] : r[1]; }
DI float px16(float x, int lane) { return __uint_as_float(px16u(__float_as_uint(x), lane)); }
DI float sum32(float x) { auto r = __builtin_amdgcn_permlane32_swap(__float_as_uint(x), __float_as_uint(x), false, false); return __uint_as_float(r[0]) + __uint_as_float(r[1]); }
DI float sum16(float x) { auto r = __builtin_amdgcn_permlane16_swap(__float_as_uint(x), __float_as_uint(x), false, false); return __uint_as_float(r[0]) + __uint_as_float(r[1]); }
DI float row_sum16(float v) { v += dppf<DPP_X1>(v); v += dppf<DPP_X2>(v); v += dppf<DPP_HM>(v); v += dppf<DPP_RM>(v); return v; }
DI float wave_sum(float v) { return sum32(sum16(row_sum16(v))); }
DI float wave_max(float v) { v = fmaxf(v, dppf<DPP_X1>(v)); v = fmaxf(v, dppf<DPP_X2>(v)); v = fmaxf(v, dppf<DPP_HM>(v)); v = fmaxf(v, dppf<DPP_RM>(v));
    { auto r = __builtin_amdgcn_permlane16_swap(__float_as_uint(v), __float_as_uint(v), false, false); v = fmaxf(__uint_as_float(r[0]), __uint_as_float(r[1])); }
    { auto r = __builtin_amdgcn_permlane32_swap(__float_as_uint(v), __float_as_uint(v), false, false); v = fmaxf(__uint_as_float(r[0]), __uint_as_float(r[1])); } return v; }

struct Frame {
    LAS unsigned char* lds; volatile LAS unsigned* MISC; gu32* ctl; int tid, lane, wave, G, gw, NGW;
};

struct MapId { DI int operator()(int n) const { return n; } };
struct MapWin0 { DI int operator()(int n) const {
    if (n < 1024) return n;
    const int t = (n - 1024) >> 9, c = (n - 1024) & 511, hd = c >> 6, d = c & 63; int bj, p;
    if (t < 2) { if (d < 16) { const int nn = d >> 3, rr = d & 7; bj = 0; p = 8 * (rr >> 2) + 4 * nn + (rr & 3); } else if (d < 32) { bj = 0; p = d; } else { bj = 1; p = d - 32; } }
    else { bj = d >> 5; p = d & 31; }
    return 1024 + 512 * t + 256 * (hd >> 2) + 128 * bj + 32 * (hd & 3) + p; } };
struct MapWin1 { DI int operator()(int n) const { const int t = n >> 10, c = n & 1023, hd = c >> 6, d = c & 63; return 1024 * t + 256 * (hd >> 2) + 128 * (d >> 5) + 32 * (hd & 3) + (d & 31); } };
template <class Map> DI void p0_transpose_item(const float* W, int K, int N, bf16* WT, LAS float* scr, int item, int lane, Map map) {
    const int nblk = N / 32, kb = item / nblk, nb = item % nblk, k0 = 64 * kb, n0 = 32 * nb;
#pragma unroll 8
    for (int i = 0; i < 32; ++i) { const int kk = 2 * i + (lane >> 5); scr[kk * 33 + (lane & 31)] = W[(size_t)(k0 + kk) * N + n0 + (lane & 31)]; }
    LDS_WAIT(); asm volatile("" ::: "memory");
    const int c = lane & 7;
#pragma unroll
    for (int j = 0; j < 4; ++j) { const int n = (lane >> 3) + 8 * j; const LAS float* s = scr + (8 * c) * 33 + n;
        v4u o; o.x = pk2(s[0 * 33], s[1 * 33]); o.y = pk2(s[2 * 33], s[3 * 33]); o.z = pk2(s[4 * 33], s[5 * 33]); o.w = pk2(s[6 * 33], s[7 * 33]);
        *(GAS v4u*)(WT + (size_t)map(n0 + n) * K + k0 + 8 * c) = o; }
    LDS_WAIT(); asm volatile("" ::: "memory");
}
struct P0Args { const float *c, *w_mod, *b_mod, *win0, *wout0, *win1, *wout1, *wq, *subk, *pu, *pv, *gws;
                float *MOD, *ROPE; bf16 *WIN0, *WOUT0, *WIN1, *WOUT1, *WQ0, *WQ1, *SUBK, *GWS; unsigned char *U8, *V8s; float *USC, *VSC; };
DI void p0_prologue(const Frame& F, const P0Args& A) {
    { LAS float* scr = (LAS float*)F.lds;
      for (int task = blockIdx.x; task < 192; task += F.G) {
          const int l = task / 96, n0 = (task % 96) * 64; const float* W = A.w_mod + (size_t)l * 1024 * 6144;
          float a0 = 0.f, a1 = 0.f; const int k0 = F.wave * 128;
#pragma unroll 1
          for (int kb = k0; kb < k0 + 128; kb += 32) { float w[32];
#pragma unroll
              for (int i = 0; i < 32; ++i) w[i] = W[(size_t)(kb + i) * 6144 + n0 + F.lane];
#pragma unroll
              for (int i = 0; i < 32; ++i) { const float c0 = A.c[kb + i], c1 = A.c[1024 + kb + i]; const float s0 = c0 / (1.f + __expf(-c0)), s1 = c1 / (1.f + __expf(-c1)); a0 += s0 * w[i]; a1 += s1 * w[i]; } }
          scr[(F.wave * 2 + 0) * 64 + F.lane] = a0; scr[(F.wave * 2 + 1) * 64 + F.lane] = a1;
          __syncthreads();
          if (F.tid < 128) { const int b = F.tid >> 6, n = F.tid & 63; float s = 0.f;
#pragma unroll
              for (int w = 0; w < 8; ++w) s += scr[(w * 2 + b) * 64 + n];
              A.MOD[(size_t)(l * 2 + b) * 6144 + n0 + n] = s + A.b_mod[l * 6144 + n0 + n]; }
          __syncthreads();
      } }
    { LAS float* scr = (LAS float*)(F.lds + F.wave * 16384);
      constexpr int I0 = 16 * 80, I1 = 16 * 32, I2 = 16 * 96, I3 = 16 * 32, I4 = 16 * 64, I5 = 16 * 64, NIT = I0 + I1 + I2 + I3 + I4 + I5;
      for (int it = F.gw; it < NIT; it += F.NGW) { int r = it;
          if (r < I0) { p0_transpose_item(A.win0, 1024, 2560, A.WIN0, scr, r, F.lane, MapId()); continue; } r -= I0;
          if (r < I1) { p0_transpose_item(A.wout0, 1024, 1024, A.WOUT0, scr, r, F.lane, MapId()); continue; } r -= I1;
          if (r < I2) { p0_transpose_item(A.win1, 1024, 3072, A.WIN1, scr, r, F.lane, MapId()); continue; } r -= I2;
          if (r < I3) { p0_transpose_item(A.wout1, 1024, 1024, A.WOUT1, scr, r, F.lane, MapId()); continue; } r -= I3;
          if (r < I4) { p0_transpose_item(A.wq, 1024, 2048, A.WQ0, scr, r, F.lane, MapId()); continue; } r -= I4;
          p0_transpose_item(A.wq + (size_t)1024 * 2048, 1024, 2048, A.WQ1, scr, r, F.lane, MapId()); } }
    for (int row0 = F.gw; row0 < 65536; row0 += 4 * F.NGW) {
        f32x4 v[4][4];
#pragma unroll
        for (int q = 0; q < 4; ++q) { const int row = row0 + q * F.NGW; const bool isv = row >= 32768; const int rr = row & 32767; const float* src = (isv ? A.pv : A.pu) + (size_t)rr * 1024;
#pragma unroll
            for (int k = 0; k < 4; ++k) v[q][k] = *(const f32x4*)(src + 4 * F.lane + 256 * k); }
#pragma unroll
        for (int q = 0; q < 4; ++q) { const int row = row0 + q * F.NGW; const bool isv = row >= 32768; const int rr = row & 32767; float mx = 0.f;
#pragma unroll
            for (int k = 0; k < 4; ++k) mx = fmaxf(mx, fmaxf(fmaxf(fabsf(v[q][k][0]), fabsf(v[q][k][1])), fmaxf(fabsf(v[q][k][2]), fabsf(v[q][k][3]))));
            mx = wave_max(mx);
            const float sc = mx > 0.f ? 127.0f / mx : 1.0f, inv = mx > 0.f ? mx * (1.0f / 127.0f) : 1.0f;
#pragma unroll
            for (int k = 0; k < 4; ++k) { const int q0 = __float2int_rn(v[q][k][0] * sc), q1 = __float2int_rn(v[q][k][1] * sc), q2 = __float2int_rn(v[q][k][2] * sc), q3 = __float2int_rn(v[q][k][3] * sc);
                const unsigned w = (unsigned)(q0 & 255) | ((unsigned)(q1 & 255) << 8) | ((unsigned)(q2 & 255) << 16) | ((unsigned)(q3 & 255) << 24);
                if (!isv) *(unsigned*)(A.U8 + (size_t)rr * 1024 + 4 * F.lane + 256 * k) = w;
                else { const int l = rr >> 14, e = rr & 16383, slab = 2 * k + (F.lane >> 5); *(unsigned*)(A.V8s + (((size_t)l * 8 + slab) * 16384 + e) * 128 + 4 * (F.lane & 31)) = w; } }
            if (F.lane == 0) (isv ? A.VSC : A.USC)[rr] = inv; } }
    { const size_t gt = (size_t)F.gw * 64 + F.lane, NT = (size_t)F.NGW * 64;
      for (size_t i = gt; i < 524288 / 8; i += NT) { const float* src = A.subk + i * 8; const f32x4 a = *(const f32x4*)src, b = *(const f32x4*)(src + 4); v4u o; o.x = cvtpk2(a[0], a[1]); o.y = cvtpk2(a[2], a[3]); o.z = cvtpk2(b[0], b[1]); o.w = cvtpk2(b[2], b[3]);
          *(v4u*)(A.SUBK + i * 8) = o; }
      for (size_t i = gt; i < 65536; i += NT) { const int t = (int)(i >> 7) & 127, s = (int)i & 127; A.GWS[i] = (bf16)(cvtpk2(s <= t ? A.gws[i] : 0.f, 0.f) & 0xffffu); }
      for (size_t i = gt; i < 65536; i += NT) { const int pos = (int)(i >> 3), fi = (int)i & 7; const float inv = powf(500000.0f, -(float)fi / 8.0f); const float ang = (float)pos * inv; float sn, cs; sincosf(ang, &sn, &cs);
          A.ROPE[(size_t)pos * 16 + fi] = cs; A.ROPE[(size_t)pos * 16 + 8 + fi] = sn; } }
}

template <bool XIN_F32> DI void norm_rows(const Frame& F, const void* xs_, const float* gamma, const float* modl, int shi, int sci, bf16* HN, unsigned char* HQ = nullptr, float* HS = nullptr) {
    for (int m0 = F.gw; m0 < MROWS; m0 += 2 * F.NGW) {
        f32x4 v[2][4]; float s[2];
#pragma unroll
        for (int q = 0; q < 2; ++q) { const int m = m0 + q * F.NGW;
            if (XIN_F32) { const f32x4* xr = (const f32x4*)((const float*)xs_ + (size_t)m * 1024) + F.lane;
#pragma unroll
                for (int j = 0; j < 4; ++j) v[q][j] = xr[64 * j]; }
            else { const unsigned long long* xr = (const unsigned long long*)((const bf16*)xs_ + (size_t)m * 1024) + F.lane;
#pragma unroll
                for (int j = 0; j < 4; ++j) { const unsigned long long w = xr[64 * j]; const unsigned lo = (unsigned)w, hi = (unsigned)(w >> 32); v[q][j] = (f32x4){bf_lo(lo), bf_hi(lo), bf_lo(hi), bf_hi(hi)}; } } }
#pragma unroll
        for (int q = 0; q < 2; ++q) { float a = 0.f;
#pragma unroll
            for (int j = 0; j < 4; ++j) a += (v[q][j][0] * v[q][j][0] + v[q][j][1] * v[q][j][1]) + (v[q][j][2] * v[q][j][2] + v[q][j][3] * v[q][j][3]);
            s[q] = a; }
#pragma unroll
        for (int q = 0; q < 2; ++q) { const int m = m0 + q * F.NGW; const int b = m >> 13;
            const float rinv = rsqrtf(wave_sum(s[q]) * (1.0f / 1024.0f) + 1e-6f);
            unsigned long long* o8 = (unsigned long long*)(HN + (size_t)m * 1024) + F.lane; float mx = 0.f;
#pragma unroll
            for (int j = 0; j < 4; ++j) { const int col = 4 * F.lane + 256 * j; const f32x4 gm = *(const f32x4*)(gamma + col), sc = *(const f32x4*)(modl + b * 6144 + sci * 1024 + col), sh = *(const f32x4*)(modl + b * 6144 + shi * 1024 + col);
                const f32x4 o = v[q][j] * rinv * gm * (sc + 1.0f) + sh; v[q][j] = o; mx = fmaxf(mx, fmaxf(fmaxf(fabsf(o[0]), fabsf(o[1])), fmaxf(fabsf(o[2]), fabsf(o[3]))));
                o8[64 * j] = (unsigned long long)cvtpk2(o[0], o[1]) | ((unsigned long long)cvtpk2(o[2], o[3]) << 32); }
            if (HQ) { mx = wave_max(mx); const float qs = mx > 0.f ? 127.0f / mx : 1.0f;
#pragma unroll
                for (int j = 0; j < 4; ++j) { const int q0 = __float2int_rn(v[q][j][0] * qs), q1 = __float2int_rn(v[q][j][1] * qs), q2 = __float2int_rn(v[q][j][2] * qs), q3 = __float2int_rn(v[q][j][3] * qs);
                    *(unsigned*)(HQ + (size_t)m * 1024 + 4 * F.lane + 256 * j) = (unsigned)(q0 & 255) | ((unsigned)(q1 & 255) << 8) | ((unsigned)(q2 & 255) << 16) | ((unsigned)(q3 & 255) << 24); }
                if (F.lane == 0) HS[m] = mx > 0.f ? mx * (1.0f / 127.0f) : 1.0f; } }
    }
}

DI void qk_post_task(int task, const bf16* QKR, bf16* Q0, bf16* K0, float* KSUM, const float* rope, const float* gq, const float* gk, LAS float* scr, int tid, int wave, int lane) {
    const int tb = task >> 2, cq = task & 3; const bool isk = cq >= 2; const int head0 = (cq & 1) * 4, hl = (lane >> 2) & 3, qt = lane & 3, rsub = lane >> 4;
    const float* g = (isk ? gk : gq) + qt * 16; float gv[16];
#pragma unroll
    for (int i = 0; i < 16; ++i) gv[i] = g[i];
    float ks[16];
#pragma unroll
    for (int i = 0; i < 16; ++i) ks[i] = 0.f;
    const int b = tb >> 5; bf16* dstb = (isk ? K0 : Q0) + (size_t)(b * 8 + head0 + hl) * SEQ * 64 + qt * 16;
    v4u wq0[8], wq1[8];
#pragma unroll
    for (int it = 0; it < 8; ++it) { const int row = tb * 256 + wave * 32 + it * 4 + rsub; const bf16* src = QKR + (size_t)row * 1024 + cq * 256 + hl * 64 + qt * 16; wq0[it] = *(const v4u*)src; wq1[it] = *(const v4u*)(src + 8); }
#pragma unroll
    for (int it = 0; it < 8; ++it) { const int row = tb * 256 + wave * 32 + it * 4 + rsub, s = row & (SEQ - 1);
        const v4u w0 = wq0[it], w1 = wq1[it];
        float y[16]; y[0] = bf_lo(w0.x); y[1] = bf_hi(w0.x); y[2] = bf_lo(w0.y); y[3] = bf_hi(w0.y); y[4] = bf_lo(w0.z); y[5] = bf_hi(w0.z); y[6] = bf_lo(w0.w); y[7] = bf_hi(w0.w);
        y[8] = bf_lo(w1.x); y[9] = bf_hi(w1.x); y[10] = bf_lo(w1.y); y[11] = bf_hi(w1.y); y[12] = bf_lo(w1.z); y[13] = bf_hi(w1.z); y[14] = bf_lo(w1.w); y[15] = bf_hi(w1.w);
        float ss = 0.f;
#pragma unroll
        for (int i = 0; i < 16; ++i) ss += y[i] * y[i];
        ss += dppf<DPP_X1>(ss); ss += dppf<DPP_X2>(ss);
        const float rinv = rsqrtf(ss * (1.0f / 64.0f) + 1e-6f);
#pragma unroll
        for (int i = 0; i < 16; ++i) y[i] = y[i] * rinv * gv[i];
        if (qt == 0) { const float* rp = rope + (size_t)s * 16;
#pragma unroll
            for (int i = 0; i < 8; ++i) { const float c = rp[i], sn = rp[8 + i], x1 = y[i], x2 = y[i + 8]; y[i] = x1 * c - x2 * sn; y[i + 8] = x1 * sn + x2 * c; } }
        v4u o0, o1; o0.x = cvtpk2(y[0], y[1]); o0.y = cvtpk2(y[2], y[3]); o0.z = cvtpk2(y[4], y[5]); o0.w = cvtpk2(y[6], y[7]); o1.x = cvtpk2(y[8], y[9]); o1.y = cvtpk2(y[10], y[11]); o1.z = cvtpk2(y[12], y[13]); o1.w = cvtpk2(y[14], y[15]);
        bf16* d = dstb + (size_t)s * 64; *(v4u*)d = o0; *(v4u*)(d + 8) = o1;
#pragma unroll
        for (int i = 0; i < 16; ++i) ks[i] += y[i];
    }
    if (isk) {
#pragma unroll
        for (int i = 0; i < 16; ++i) { ks[i] = sum32(sum16(ks[i])); }
        if (lane < 16) {
#pragma unroll
            for (int i = 0; i < 16; ++i) scr[(wave * 16 + lane) * 16 + i] = ks[i]; }
        __syncthreads();
        if (tid < 256) { const int l16 = tid >> 4, i = tid & 15; float sum = 0.f;
#pragma unroll
            for (int w = 0; w < 8; ++w) sum += scr[(w * 16 + l16) * 16 + i];
            KSUM[((size_t)(b * 8 + head0 + (l16 >> 2)) * 32 + (tb & 31)) * 64 + (l16 & 3) * 16 + i] = sum; }
        __syncthreads();
    }
}

DI f32x16 qk_tile(const bf16* krow, const bf16x8 (&qf)[4]) {
    f32x16 s;
#pragma unroll
    for (int i = 0; i < 16; ++i) s[i] = 0.f;
#pragma unroll
    for (int ks = 0; ks < 4; ++ks) s = MFMA32(ld16g(krow + 16 * ks), qf[ks], s);
    return s;
}
DI bf16x8 pack8(const f32x16& x, int s) { v4u p; p.x = cvtpk2(x[8 * s], x[8 * s + 1]); p.y = cvtpk2(x[8 * s + 2], x[8 * s + 3]); p.z = cvtpk2(x[8 * s + 4], x[8 * s + 5]); p.w = cvtpk2(x[8 * s + 6], x[8 * s + 7]); return __builtin_bit_cast(bf16x8, p); }
DI void pv_tile(f32x16 (&o)[2], const bf16* vt, const f32x16& p) {
#pragma unroll
    for (int s = 0; s < 2; ++s) { const bf16x8 pb = pack8(p, s);
#pragma unroll
        for (int mt = 0; mt < 2; ++mt) { const bf16* v = vt + (size_t)mt * 32 * SEQ + 16 * s; o[mt] = MFMA32(ld8x2g(v, v + 8), pb, o[mt]); } }
}
DI void store_ot(bf16* dst, const f32x16 (&o)[2], float sc, int h) {
#pragma unroll
    for (int mt = 0; mt < 2; ++mt)
#pragma unroll
        for (int g = 0; g < 4; ++g) { const unsigned lo = cvtpk2(o[mt][4 * g] * sc, o[mt][4 * g + 1] * sc), hi = cvtpk2(o[mt][4 * g + 2] * sc, o[mt][4 * g + 3] * sc);
            *(unsigned long long*)(dst + 32 * mt + 8 * g + 4 * h) = (unsigned long long)lo | ((unsigned long long)hi << 32); }
}
DI void moba_keys(const bf16* Kh, const bf16* VTh, const bf16x8 (&qf)[4], int key0, int nt, int diag, float mc2, f32x16 (&o)[2], float& l, int r, int h) {
    for (int kt = 0; kt < nt; ++kt) { const int kb = key0 + 32 * kt;
        f32x16 s = qk_tile(Kh + (size_t)(kb + r) * 64 + 8 * h, qf);
        float ls = 0.f;
#pragma unroll
        for (int i = 0; i < 16; ++i) { float p = __builtin_amdgcn_exp2f(s[i] * (0.125f * LOG2E) - mc2); if (kt == diag && crow(i, h) > r) p = 0.f; s[i] = p; ls += p; }
        l += ls;
        pv_tile(o, VTh + (size_t)r * SEQ + kb + 4 * h, s);
    }
}
DI float moba_mc2(const float* gq, const float* gk, int lane) {
    float a = fabsf(gq[lane]), b = fabsf(gk[lane]);
    a = wave_max(a); b = wave_max(b);
    return 8.0f * a * b * LOG2E;
}
struct MobaT { const bf16 *Q, *K, *VT; const float* ksum; unsigned* masks; bf16* PO; float* PL; const float *gq, *gk; };
DI void moba_mask_unit(int u, const MobaT& T, int lane) {
    const int bh = u >> 8, t0 = (u & 255) * 32, own = t0 >> 8, r = lane & 31, h = lane >> 5;
    unsigned mask = 0u;
    if (own > 0) {
        f32x16 g;
#pragma unroll
        for (int i = 0; i < 16; ++i) g[i] = 0.f;
        const float* km = T.ksum + ((size_t)bh * 32 + r) * 64 + 8 * h; const bf16* qp = T.Q + ((size_t)bh * SEQ + t0 + r) * 64 + 8 * h;
#pragma unroll
        for (int ks = 0; ks < 4; ++ks) { const f32x4 a0 = *(const f32x4*)(km + 16 * ks) * (1.0f / 256.0f), a1 = *(const f32x4*)(km + 16 * ks + 4) * (1.0f / 256.0f);
            v4u aw; aw.x = cvtpk2(a0[0], a0[1]); aw.y = cvtpk2(a0[2], a0[3]); aw.z = cvtpk2(a1[0], a1[1]); aw.w = cvtpk2(a1[2], a1[3]);
            g = MFMA32(__builtin_bit_cast(bf16x8, aw), ld16g(qp + 16 * ks), g); }
        int ka = KEY_MIN, kb2 = KEY_MIN, kc = KEY_MIN;
#define INS3(x_) do { int x = (x_); int t = min(ka, x); ka = max(ka, x); int uu = min(kb2, t); kb2 = max(kb2, t); kc = max(kc, uu); } while (0)
#pragma unroll
        for (int i = 0; i < 16; ++i) { const int blk = crow(i, h); const int key = (blk < own) ? ((f_ord(g[i]) & ~31) | (31 - blk)) : KEY_MIN; INS3(key); }
        const int pa = px32(ka, lane), pb = px32(kb2, lane), pc = px32(kc, lane);
        INS3(pa); INS3(pb); INS3(pc);
#undef INS3
        if (ka != KEY_MIN) mask |= 1u << (31 - (ka & 31));
        if (kb2 != KEY_MIN) mask |= 1u << (31 - (kb2 & 31));
        if (kc != KEY_MIN) mask |= 1u << (31 - (kc & 31));
    }
    if (h == 0) T.masks[(size_t)bh * SEQ + t0 + r] = mask;
}
DI void moba_own_unit(int u, const MobaT& T, float mc2, int lane) {
    const int bh = u >> 8, t0 = (u & 255) * 32, own = t0 >> 8, r = lane & 31, h = lane >> 5;
    const bf16* qp = T.Q + ((size_t)bh * SEQ + t0 + r) * 64 + 8 * h; bf16x8 qf[4];
#pragma unroll
    for (int ks = 0; ks < 4; ++ks) qf[ks] = ld16g(qp + 16 * ks);
    f32x16 o[2];
#pragma unroll
    for (int i = 0; i < 16; ++i) { o[0][i] = 0.f; o[1][i] = 0.f; }
    float l = 0.f; const int key0 = own * 256, nt = ((t0 - key0) >> 5) + 1;
    moba_keys(T.K + (size_t)bh * SEQ * 64, T.VT + (size_t)bh * 64 * SEQ, qf, key0, nt, nt - 1, mc2, o, l, r, h);
    l = sum32(l);
    const size_t base = ((size_t)bh * SEQ + t0 + r) * 4 + 3;
    store_ot(T.PO + base * 64, o, 1.0f, h); if (h == 0) T.PL[base] = l;
}
constexpr int MS_K = 0, MS_V = 32768, MS_VROW = 520, MS_LIST = 32768 + 64 * 520, MS_CNT = MS_LIST + 8192, MOBA_NSEL = 16 * 79, MOBA_NTASK = MOBA_NSEL + 512;
DI void moba_sel_task(int task, const MobaT& T, LAS unsigned char* lds, float mc2, int tid, int wave, int lane) {
    const bool own = task >= MOBA_NSEL;
    int p = 0, rem = own ? 0 : task; if (own) {} else if (rem < 128) p = 0; else if (rem < 384) { p = 1; rem -= 128; } else if (rem < 768) { p = 2; rem -= 384; } else { p = 3; rem -= 768; }
    const int j = own ? ((task - MOBA_NSEL) >> 4) : (rem >> 4), bh = own ? ((task - MOBA_NSEL) & 15) : (rem & 15);
    LAS unsigned* list = (LAS unsigned*)(lds + MS_LIST); LAS unsigned* cntp = (LAS unsigned*)(lds + MS_CNT);
    { const bf16* Kg = T.K + ((size_t)bh * SEQ + 256 * j) * 64; const bf16* Vg = T.VT + (size_t)bh * 64 * SEQ + 256 * j;
      v4u kv[4], vv[4];
#pragma unroll
      for (int i = 0; i < 4; ++i) { const int c = tid + 512 * i; kv[i] = *(const v4u*)(Kg + (size_t)c * 8); const int d = c >> 5, cc = c & 31; vv[i] = *(const v4u*)(Vg + (size_t)d * SEQ + cc * 8); }
      if (tid == 0) *cntp = 0u;
#pragma unroll
      for (int i = 0; i < 4; ++i) { const int c = tid + 512 * i; const int k = c >> 3, ch = c & 7; *(LAS v4u*)(lds + MS_K + k * 128 + ((ch ^ ((k >> 1) & 7)) << 4)) = kv[i];
          const int d = c >> 5, cc = c & 31; LAS unsigned char* vp = lds + MS_V + d * MS_VROW + cc * 16; *(LAS unsigned long long*)vp = (unsigned long long)vv[i].x | ((unsigned long long)vv[i].y << 32); *(LAS unsigned long long*)(vp + 8) = (unsigned long long)vv[i].z | ((unsigned long long)vv[i].w << 32); } }
    __syncthreads();
    if (!own) { const int qlo = 256 * (8 * p + 1), qhi = (8 * p + 9) * 256 < SEQ ? (8 * p + 9) * 256 : SEQ;
      for (int t0 = qlo + wave * 64; t0 < qhi; t0 += 512) { const int t = t0 + lane; const unsigned mk = T.masks[(size_t)bh * SEQ + t]; const bool sel = (mk >> j) & 1u;
          const unsigned long long bal = __ballot(sel); const int nb = __builtin_popcountll(bal);
          unsigned base = 0; if (lane == 0 && nb) base = __hip_atomic_fetch_add(cntp, (unsigned)nb, __ATOMIC_RELAXED, __HIP_MEMORY_SCOPE_WORKGROUP); base = (unsigned)__builtin_amdgcn_readfirstlane((int)base);
          if (sel) list[base + __builtin_popcountll(bal & ((1ull << lane) - 1ull))] = (unsigned)t; } }
    __syncthreads();
    const int n = own ? 256 : (int)*cntp; const int r = lane & 31, h = lane >> 5;
    const LAS unsigned char* kb = lds + MS_K; const LAS unsigned char* vb = lds + MS_V;
    for (int b0 = wave * 32; b0 < n; b0 += 256) { const bool valid = b0 + r < n; const int t = own ? (256 * j + b0 + r) : (int)list[valid ? b0 + r : b0];
        const unsigned mk = own ? 0u : T.masks[(size_t)bh * SEQ + t]; const int slot = own ? 3 : __builtin_popcount(mk & ((1u << j) - 1u));
        const int ntile = own ? (wave + 1) : 8;
        const bf16* qp = T.Q + ((size_t)bh * SEQ + t) * 64 + 8 * h; bf16x8 qf[4];
#pragma unroll
        for (int ks = 0; ks < 4; ++ks) qf[ks] = ld16g(qp + 16 * ks);
        f32x16 o[2];
#pragma unroll
        for (int i = 0; i < 16; ++i) { o[0][i] = 0.f; o[1][i] = 0.f; }
        float l = 0.f;
#pragma unroll 1
        for (int kt = 0; kt < ntile; ++kt) { const int key = 32 * kt + r; const bool dg = own && kt == wave;
            f32x16 s;
#pragma unroll
            for (int i = 0; i < 16; ++i) s[i] = 0.f;
#pragma unroll
            for (int ks = 0; ks < 4; ++ks) s = MFMA32(*(const LAS bf16x8*)(kb + key * 128 + (((2 * ks + h) ^ ((key >> 1) & 7)) << 4)), qf[ks], s);
            float ls = 0.f;
#pragma unroll
            for (int i = 0; i < 16; ++i) { float pv = __builtin_amdgcn_exp2f(s[i] * (0.125f * LOG2E) - mc2); if (dg && crow(i, h) > r) pv = 0.f; s[i] = pv; ls += pv; }
            l += ls;
#pragma unroll
            for (int sx = 0; sx < 2; ++sx) { const bf16x8 pb = pack8(s, sx);
#pragma unroll
                for (int mt = 0; mt < 2; ++mt) { const LAS unsigned char* vp = vb + (32 * mt + r) * MS_VROW + (32 * kt + 16 * sx + 4 * h) * 2;
                    const s16x4 a0 = *(const LAS s16x4*)vp, a1 = *(const LAS s16x4*)(vp + 16); o[mt] = MFMA32(__builtin_shufflevector(a0, a1, 0, 1, 2, 3, 4, 5, 6, 7), pb, o[mt]); } }
        }
        l = sum32(l);
        if (valid) { const size_t base = ((size_t)bh * SEQ + t) * 4 + slot; store_ot(T.PO + base * 64, o, 1.0f, h); if (h == 0) T.PL[base] = l; }
    }
    __syncthreads();
}
DI void moba_combine(const Frame& F, const bf16* PO, const float* PL, bf16* YCAT) {
    const size_t gt = (size_t)F.gw * 64 + F.lane, NT = (size_t)F.NGW * 64;
    for (size_t i0 = gt; i0 < (size_t)16 * SEQ * 8; i0 += 2 * NT) {
        v4u w[2][4]; float pl[2][4];
#pragma unroll
        for (int q = 0; q < 2; ++q) { const size_t i = i0 + q * NT; const int dq = (int)i & 7, t = (int)(i >> 3) & (SEQ - 1), bh = (int)(i >> 16); const int own = t >> 8, ns = own < 3 ? own : 3;
#pragma unroll
            for (int s = 0; s < 4; ++s) { if (s < ns || s == 3) { const size_t base = ((size_t)bh * SEQ + t) * 4 + s; pl[q][s] = PL[base]; w[q][s] = *(const v4u*)(PO + base * 64 + dq * 8); } else { pl[q][s] = 0.f; w[q][s] = (v4u){0u, 0u, 0u, 0u}; } } }
#pragma unroll
        for (int q = 0; q < 2; ++q) { const size_t i = i0 + q * NT; const int dq = (int)i & 7, t = (int)(i >> 3) & (SEQ - 1), bh = (int)(i >> 16);
            float o[8]; float l = 0.f;
#pragma unroll
            for (int k = 0; k < 8; ++k) o[k] = 0.f;
#pragma unroll
            for (int s = 0; s < 4; ++s) { l += pl[q][s]; const v4u ww = w[q][s];
                o[0] += bf_lo(ww.x); o[1] += bf_hi(ww.x); o[2] += bf_lo(ww.y); o[3] += bf_hi(ww.y); o[4] += bf_lo(ww.z); o[5] += bf_hi(ww.z); o[6] += bf_lo(ww.w); o[7] += bf_hi(ww.w); }
            const float il = 1.0f / l; v4u ow; ow.x = cvtpk2(o[0] * il, o[1] * il); ow.y = cvtpk2(o[2] * il, o[3] * il); ow.z = cvtpk2(o[4] * il, o[5] * il); ow.w = cvtpk2(o[6] * il, o[7] * il);
            *(v4u*)(YCAT + ((size_t)(bh >> 3) * SEQ + t) * 1024 + 512 + (bh & 7) * 64 + dq * 8) = ow; } }
}

DI void gmlp_unit(int unit, const bf16* UA, const bf16* VA, const float* vgain, const bf16* GWS, const float* bs, bf16* YCAT, LAS unsigned char* lds, int tid, int wave, int lane) {
    const int cidx = unit >> 2, g = unit & 3, row0 = cidx * 128; LAS bf16* VNT = (LAS bf16*)lds;
    { const int row = tid >> 2, dq = (tid & 3) * 32; const bf16* src = VA + (size_t)(row0 + row) * 512 + g * 128 + dq;
      float f[32]; float ss = 0.f;
#pragma unroll
      for (int k = 0; k < 4; ++k) { const v4u w = *(const v4u*)(src + 8 * k); f[8 * k] = bf_lo(w.x); f[8 * k + 1] = bf_hi(w.x); f[8 * k + 2] = bf_lo(w.y); f[8 * k + 3] = bf_hi(w.y); f[8 * k + 4] = bf_lo(w.z); f[8 * k + 5] = bf_hi(w.z); f[8 * k + 6] = bf_lo(w.w); f[8 * k + 7] = bf_hi(w.w); }
#pragma unroll
      for (int k = 0; k < 32; ++k) ss += f[k] * f[k];
      ss += dppf<DPP_X1>(ss); ss += dppf<DPP_X2>(ss);
      const float rinv = rsqrtf(ss * (1.0f / 128.0f) + 1e-6f);
#pragma unroll
      for (int k = 0; k < 32; ++k) VNT[(dq + k) * 136 + row] = (bf16)(cvtpk2(f[k] * rinv * vgain[g * 128 + dq + k], 0.f) & 0xffffu); }
    __syncthreads();
    { const int mt = wave >> 1, ntb = (wave & 1) * 2, r = lane & 31, h = lane >> 5;
      f32x16 acc[2];
#pragma unroll
      for (int i = 0; i < 16; ++i) { acc[0][i] = 0.f; acc[1][i] = 0.f; }
      const bf16* wp = GWS + ((size_t)g * 128 + 32 * mt + r) * 128 + 8 * h;
      bf16x8 af[8];
#pragma unroll
      for (int ks = 0; ks < 8; ++ks) af[ks] = ld16g(wp + 16 * ks);
#pragma unroll
      for (int ks = 0; ks < 8; ++ks) { if (ks >= 2 * (mt + 1)) break; const bf16x8 a = af[ks];
#pragma unroll
          for (int nn = 0; nn < 2; ++nn) { const bf16x8 b = *(const LAS bf16x8*)(VNT + (32 * (ntb + nn) + r) * 136 + 16 * ks + 8 * h); acc[nn] = MFMA32(a, b, acc[nn]); } }
#pragma unroll
      for (int nn = 0; nn < 2; ++nn)
#pragma unroll
          for (int i = 0; i < 16; ++i) { const int t = 32 * mt + crow(i, h), d = 32 * (ntb + nn) + r; const float mixed = acc[nn][i] + bs[g * 128 + t];
              const float uv = __uint_as_float((unsigned)UA[(size_t)(row0 + t) * 512 + g * 128 + d] << 16);
              YCAT[(size_t)(row0 + t) * 1024 + g * 128 + d] = (bf16)(cvtpk2(uv * mixed, 0.f) & 0xffffu); } }
    __syncthreads();
}

struct SbK { bf16x8 k[4]; }; struct SbV { s16x4 v[8]; };
DI void sb_loadk(SbK& f, const bf16* Kh, int kb, int r, int h) {
    const bf16* kp = Kh + (size_t)(kb + r) * 64 + 8 * h;
#pragma unroll
    for (int ks = 0; ks < 4; ++ks) f.k[ks] = ld16g(kp + 16 * ks);
}
DI void sb_loadv(SbV& f, const bf16* VTh, int kb, int r, int h) {
    const bf16* vp = VTh + (size_t)r * SEQ + kb + 4 * h;
#pragma unroll
    for (int s = 0; s < 2; ++s)
#pragma unroll
        for (int mt = 0; mt < 2; ++mt) { const bf16* v = vp + (size_t)mt * 32 * SEQ + 16 * s; f.v[4 * s + 2 * mt] = *(const s16x4*)v; f.v[4 * s + 2 * mt + 1] = *(const s16x4*)(v + 8); }
}
template <bool DIAG> DI void sb_tile(const SbK& fk, const SbV& fv, const bf16x8 (&qf)[4], f32x16 (&o)[2], float& R, int r, int h, int lane) {
    f32x16 s;
#pragma unroll
    for (int i = 0; i < 16; ++i) s[i] = 0.f;
#pragma unroll
    for (int ks = 0; ks < 4; ++ks) s = MFMA32(fk.k[ks], qf[ks], s);
    f32x16 x;
#pragma unroll
    for (int i = 0; i < 16; ++i) { const float z = s[i]; const float t = __builtin_amdgcn_exp2f(-fabsf(z) * LOG2E); const float sp = fmaxf(z, 0.f) + LN2 * __builtin_amdgcn_logf(1.0f + t);
        if (DIAG) { const bool valid = crow(i, h) < r; x[i] = valid ? -sp : 0.f; s[i] = valid ? z : -INFINITY; } else x[i] = -sp; }
    float T4[4], E[16];
#pragma unroll
    for (int g = 0; g < 4; ++g) { E[4 * g + 3] = 0.f; E[4 * g + 2] = x[4 * g + 3]; E[4 * g + 1] = E[4 * g + 2] + x[4 * g + 2]; E[4 * g] = E[4 * g + 1] + x[4 * g + 1]; T4[g] = E[4 * g] + x[4 * g]; }
    float P4[4];
#pragma unroll
    for (int g = 0; g < 4; ++g) P4[g] = px32(T4[g], lane);
    float C[4]; float run = 0.f;
#pragma unroll
    for (int g = 3; g >= 0; --g) { C[g] = run + (h == 0 ? P4[g] : 0.f); run += T4[g] + P4[g]; }
#pragma unroll
    for (int i = 0; i < 16; ++i) { const float arg = x[i] + s[i] + (R + C[i >> 2] + E[i]); x[i] = __builtin_amdgcn_exp2f(arg * LOG2E); }
#pragma unroll
    for (int sx = 0; sx < 2; ++sx) { const bf16x8 pb = pack8(x, sx);
#pragma unroll
        for (int mt = 0; mt < 2; ++mt) o[mt] = MFMA32(__builtin_shufflevector(fv.v[4 * sx + 2 * mt], fv.v[4 * sx + 2 * mt + 1], 0, 1, 2, 3, 4, 5, 6, 7), pb, o[mt]); }
    R += run;
}
constexpr int SB_K = 0, SB_V = 65536, SB_VROW = 1032;
DI void sb_wg_unit(int u, const bf16* Q, const bf16* K, const bf16* VT, bf16* YCAT, LAS unsigned char* lds, int tid, int wave, int lane) {
    const int bh = u >> 5, qb = u & 31, r = lane & 31, h = lane >> 5; const int base = qb > 0 ? 256 * (qb - 1) : 0, nk = qb > 0 ? 512 : 256;
    const bf16* Kh = K + (size_t)bh * SEQ * 64; const bf16* VTh = VT + (size_t)bh * 64 * SEQ;
    { const bf16* Kg = Kh + (size_t)base * 64; const int nch = nk * 8;
      for (int c0 = 0; c0 < nch; c0 += 2048) { v4u kv[4];
#pragma unroll
          for (int i = 0; i < 4; ++i) kv[i] = *(const v4u*)(Kg + (size_t)(c0 + tid + 512 * i) * 8);
#pragma unroll
          for (int i = 0; i < 4; ++i) { const int c = c0 + tid + 512 * i, k = c >> 3, ch = c & 7; *(LAS v4u*)(lds + SB_K + k * 128 + ((ch ^ ((k >> 1) & 7)) << 4)) = kv[i]; } }
      const int cpr = nk / 8;
      for (int c0 = 0; c0 < 64 * cpr; c0 += 2048) { v4u vv[4];
#pragma unroll
          for (int i = 0; i < 4; ++i) { const int c = c0 + tid + 512 * i, d = c / cpr, cc = c - d * cpr; vv[i] = *(const v4u*)(VTh + (size_t)d * SEQ + base + cc * 8); }
#pragma unroll
          for (int i = 0; i < 4; ++i) { const int c = c0 + tid + 512 * i, d = c / cpr, cc = c - d * cpr; LAS unsigned char* vp = lds + SB_V + d * SB_VROW + cc * 16;
              *(LAS unsigned long long*)vp = (unsigned long long)vv[i].x | ((unsigned long long)vv[i].y << 32); *(LAS unsigned long long*)(vp + 8) = (unsigned long long)vv[i].z | ((unsigned long long)vv[i].w << 32); } } }
    const int t0 = 256 * qb + 32 * wave;
    const bf16* qp = Q + ((size_t)bh * SEQ + t0 + r) * 64 + 8 * h; bf16x8 qf[4];
#pragma unroll
    for (int ks = 0; ks < 4; ++ks) qf[ks] = ld16g(qp + 16 * ks);
    __syncthreads();
    f32x16 o[2];
#pragma unroll
    for (int i = 0; i < 16; ++i) { o[0][i] = 0.f; o[1][i] = 0.f; }
    float R = 0.f; bool diag = true;
    for (int kb = t0; kb >= 0; kb -= 32) {
        if (!diag && !__any(R >= -104.0f)) break;
        SbK fk; SbV fv;
        if (kb >= base) { const int kl = kb - base + r;
            const LAS unsigned char* kp = lds + SB_K + kl * 128;
#pragma unroll
            for (int ks = 0; ks < 4; ++ks) fk.k[ks] = *(const LAS bf16x8*)(kp + (((2 * ks + h) ^ ((kl >> 1) & 7)) << 4));
#pragma unroll
            for (int s = 0; s < 2; ++s)
#pragma unroll
                for (int mt = 0; mt < 2; ++mt) { const LAS unsigned char* vp = lds + SB_V + (32 * mt + r) * SB_VROW + (kb - base + 16 * s + 4 * h) * 2; fv.v[4 * s + 2 * mt] = *(const LAS s16x4*)vp; fv.v[4 * s + 2 * mt + 1] = *(const LAS s16x4*)(vp + 16); }
        } else { sb_loadk(fk, Kh, kb, r, h); sb_loadv(fv, VTh, kb, r, h); }
        if (diag) sb_tile<true>(fk, fv, qf, o, R, r, h, lane); else sb_tile<false>(fk, fv, qf, o, R, r, h, lane);
        diag = false;
    }
    store_ot(YCAT + ((size_t)(bh >> 4) * SEQ + t0 + r) * 1024 + (bh & 15) * 64, o, 1.0f, h);
    __syncthreads();
}

#define CE_(a, b) do { const int hi_ = max((a), (b)); (b) = min((a), (b)); (a) = hi_; } while (0)
DI void sort16_desc(int (&v)[16]) {
    CE_(v[0], v[1]); CE_(v[2], v[3]); CE_(v[0], v[2]); CE_(v[1], v[3]); CE_(v[1], v[2]); CE_(v[4], v[5]); CE_(v[6], v[7]); CE_(v[4], v[6]); CE_(v[5], v[7]);
    CE_(v[5], v[6]); CE_(v[0], v[4]); CE_(v[2], v[6]); CE_(v[2], v[4]); CE_(v[1], v[5]); CE_(v[3], v[7]); CE_(v[3], v[5]); CE_(v[1], v[2]); CE_(v[3], v[4]);
    CE_(v[5], v[6]); CE_(v[8], v[9]); CE_(v[10], v[11]); CE_(v[8], v[10]); CE_(v[9], v[11]); CE_(v[9], v[10]); CE_(v[12], v[13]); CE_(v[14], v[15]); CE_(v[12], v[14]);
    CE_(v[13], v[15]); CE_(v[13], v[14]); CE_(v[8], v[12]); CE_(v[10], v[14]); CE_(v[10], v[12]); CE_(v[9], v[13]); CE_(v[11], v[15]); CE_(v[11], v[13]);
    CE_(v[9], v[10]); CE_(v[11], v[12]); CE_(v[13], v[14]); CE_(v[0], v[8]); CE_(v[4], v[12]); CE_(v[4], v[8]); CE_(v[2], v[10]); CE_(v[6], v[14]); CE_(v[6], v[10]);
    CE_(v[2], v[4]); CE_(v[6], v[8]); CE_(v[10], v[12]); CE_(v[1], v[9]); CE_(v[5], v[13]); CE_(v[5], v[9]); CE_(v[3], v[11]); CE_(v[7], v[15]); CE_(v[7], v[11]);
    CE_(v[3], v[5]); CE_(v[7], v[9]); CE_(v[11], v[13]); CE_(v[1], v[2]); CE_(v[3], v[4]); CE_(v[5], v[6]); CE_(v[7], v[8]); CE_(v[9], v[10]); CE_(v[11], v[12]);
    CE_(v[13], v[14]);
}
DI void merge16_desc(int (&A)[16], const int (&B)[16]) {
#pragma unroll
    for (int i = 0; i < 16; ++i) A[i] = max(A[i], B[15 - i]);
    CE_(A[0], A[8]); CE_(A[1], A[9]); CE_(A[2], A[10]); CE_(A[3], A[11]); CE_(A[4], A[12]); CE_(A[5], A[13]); CE_(A[6], A[14]); CE_(A[7], A[15]); CE_(A[0], A[4]);
    CE_(A[1], A[5]); CE_(A[2], A[6]); CE_(A[3], A[7]); CE_(A[8], A[12]); CE_(A[9], A[13]); CE_(A[10], A[14]); CE_(A[11], A[15]); CE_(A[0], A[2]); CE_(A[1], A[3]);
    CE_(A[4], A[6]); CE_(A[5], A[7]); CE_(A[8], A[10]); CE_(A[9], A[11]); CE_(A[12], A[14]); CE_(A[13], A[15]); CE_(A[0], A[1]); CE_(A[2], A[3]); CE_(A[4], A[5]);
    CE_(A[6], A[7]); CE_(A[8], A[9]); CE_(A[10], A[11]); CE_(A[12], A[13]); CE_(A[14], A[15]);
}
#define PEER_CAND_CHUNK(C_, c_) do { \
    if ((c_) == 0) { C_[0] = (f_ord(s1[0] + s2[0]) & ~0x3fff) | a1[0] | a2[0]; C_[1] = (f_ord(s1[0] + s2[1]) & ~0x3fff) | a1[0] | a2[1]; C_[2] = (f_ord(s1[0] + s2[2]) & ~0x3fff) | a1[0] | a2[2]; C_[3] = (f_ord(s1[0] + s2[3]) & ~0x3fff) | a1[0] | a2[3]; C_[4] = (f_ord(s1[0] + s2[4]) & ~0x3fff) | a1[0] | a2[4]; C_[5] = (f_ord(s1[0] + s2[5]) & ~0x3fff) | a1[0] | a2[5]; C_[6] = (f_ord(s1[0] + s2[6]) & ~0x3fff) | a1[0] | a2[6]; C_[7] = (f_ord(s1[0] + s2[7]) & ~0x3fff) | a1[0] | a2[7]; C_[8] = (f_ord(s1[0] + s2[8]) & ~0x3fff) | a1[0] | a2[8]; C_[9] = (f_ord(s1[0] + s2[9]) & ~0x3fff) | a1[0] | a2[9]; C_[10] = (f_ord(s1[0] + s2[10]) & ~0x3fff) | a1[0] | a2[10]; C_[11] = (f_ord(s1[0] + s2[11]) & ~0x3fff) | a1[0] | a2[11]; C_[12] = (f_ord(s1[0] + s2[12]) & ~0x3fff) | a1[0] | a2[12]; C_[13] = (f_ord(s1[0] + s2[13]) & ~0x3fff) | a1[0] | a2[13]; C_[14] = (f_ord(s1[0] + s2[14]) & ~0x3fff) | a1[0] | a2[14]; C_[15] = (f_ord(s1[0] + s2[15]) & ~0x3fff) | a1[0] | a2[15]; } \
    if ((c_) == 1) { C_[0] = (f_ord(s1[1] + s2[0]) & ~0x3fff) | a1[1] | a2[0]; C_[1] = (f_ord(s1[1] + s2[1]) & ~0x3fff) | a1[1] | a2[1]; C_[2] = (f_ord(s1[1] + s2[2]) & ~0x3fff) | a1[1] | a2[2]; C_[3] = (f_ord(s1[1] + s2[3]) & ~0x3fff) | a1[1] | a2[3]; C_[4] = (f_ord(s1[1] + s2[4]) & ~0x3fff) | a1[1] | a2[4]; C_[5] = (f_ord(s1[1] + s2[5]) & ~0x3fff) | a1[1] | a2[5]; C_[6] = (f_ord(s1[1] + s2[6]) & ~0x3fff) | a1[1] | a2[6]; C_[7] = (f_ord(s1[1] + s2[7]) & ~0x3fff) | a1[1] | a2[7]; C_[8] = (f_ord(s1[2] + s2[0]) & ~0x3fff) | a1[2] | a2[0]; C_[9] = (f_ord(s1[2] + s2[1]) & ~0x3fff) | a1[2] | a2[1]; C_[10] = (f_ord(s1[2] + s2[2]) & ~0x3fff) | a1[2] | a2[2]; C_[11] = (f_ord(s1[2] + s2[3]) & ~0x3fff) | a1[2] | a2[3]; C_[12] = (f_ord(s1[2] + s2[4]) & ~0x3fff) | a1[2] | a2[4]; C_[13] = (f_ord(s1[3] + s2[0]) & ~0x3fff) | a1[3] | a2[0]; C_[14] = (f_ord(s1[3] + s2[1]) & ~0x3fff) | a1[3] | a2[1]; C_[15] = (f_ord(s1[3] + s2[2]) & ~0x3fff) | a1[3] | a2[2]; } \
    if ((c_) == 2) { C_[0] = (f_ord(s1[3] + s2[3]) & ~0x3fff) | a1[3] | a2[3]; C_[1] = (f_ord(s1[4] + s2[0]) & ~0x3fff) | a1[4] | a2[0]; C_[2] = (f_ord(s1[4] + s2[1]) & ~0x3fff) | a1[4] | a2[1]; C_[3] = (f_ord(s1[4] + s2[2]) & ~0x3fff) | a1[4] | a2[2]; C_[4] = (f_ord(s1[5] + s2[0]) & ~0x3fff) | a1[5] | a2[0]; C_[5] = (f_ord(s1[5] + s2[1]) & ~0x3fff) | a1[5] | a2[1]; C_[6] = (f_ord(s1[6] + s2[0]) & ~0x3fff) | a1[6] | a2[0]; C_[7] = (f_ord(s1[6] + s2[1]) & ~0x3fff) | a1[6] | a2[1]; C_[8] = (f_ord(s1[7] + s2[0]) & ~0x3fff) | a1[7] | a2[0]; C_[9] = (f_ord(s1[7] + s2[1]) & ~0x3fff) | a1[7] | a2[1]; C_[10] = (f_ord(s1[8] + s2[0]) & ~0x3fff) | a1[8] | a2[0]; C_[11] = (f_ord(s1[9] + s2[0]) & ~0x3fff) | a1[9] | a2[0]; C_[12] = (f_ord(s1[10] + s2[0]) & ~0x3fff) | a1[10] | a2[0]; C_[13] = (f_ord(s1[11] + s2[0]) & ~0x3fff) | a1[11] | a2[0]; C_[14] = (f_ord(s1[12] + s2[0]) & ~0x3fff) | a1[12] | a2[0]; C_[15] = (f_ord(s1[13] + s2[0]) & ~0x3fff) | a1[13] | a2[0]; } \
    if ((c_) == 3) { C_[0] = (f_ord(s1[14] + s2[0]) & ~0x3fff) | a1[14] | a2[0]; C_[1] = (f_ord(s1[15] + s2[0]) & ~0x3fff) | a1[15] | a2[0]; C_[2] = KEY_MIN; C_[3] = KEY_MIN; C_[4] = KEY_MIN; C_[5] = KEY_MIN; C_[6] = KEY_MIN; C_[7] = KEY_MIN; C_[8] = KEY_MIN; C_[9] = KEY_MIN; C_[10] = KEY_MIN; C_[11] = KEY_MIN; C_[12] = KEY_MIN; C_[13] = KEY_MIN; C_[14] = KEY_MIN; C_[15] = KEY_MIN; } \
} while (0)

DI void peer_scores(int tokg, int head, const bf16* QP, const bf16* SUBK, unsigned* ent  , int lane) {
    const int r = lane & 31, h = lane >> 5;
    int L1[16], L2[16];
#pragma unroll
    for (int p = 0; p < 2; ++p) {
        const bf16* qp = QP + (size_t)(tokg + r) * 2048 + head * 256 + p * 128 + 8 * h; bf16x8 qf[8];
#pragma unroll
        for (int ks = 0; ks < 8; ++ks) qf[ks] = ld16g(qp + 16 * ks);
        const bf16* sk = SUBK + (size_t)((head * 2 + p) * 128 + r) * 128 + 8 * h;
        int L[16];
#pragma unroll
        for (int i = 0; i < 16; ++i) L[i] = KEY_MIN;
        bf16x8 af[8];
#pragma unroll
        for (int ks = 0; ks < 8; ++ks) af[ks] = ld16g(sk + 16 * ks);
#pragma unroll 1
        for (int mt = 0; mt < 4; ++mt) {
            f32x16 acc;
#pragma unroll
            for (int i = 0; i < 16; ++i) acc[i] = 0.f;
#pragma unroll
            for (int ks = 0; ks < 8; ++ks) acc = MFMA32(af[ks], qf[ks], acc);
            if (mt < 3) {
#pragma unroll
                for (int ks = 0; ks < 8; ++ks) af[ks] = ld16g(sk + (size_t)(mt + 1) * 32 * 128 + 16 * ks); }
            int Nw[16];
#pragma unroll
            for (int i = 0; i < 16; ++i) Nw[i] = (f_ord(acc[i]) & ~127) | (32 * mt + crow(i, h));
            sort16_desc(Nw); merge16_desc(L, Nw);
        }
        int Pn[16];
#pragma unroll
        for (int i = 0; i < 16; ++i) Pn[i] = px32(L[i], lane);
        merge16_desc(L, Pn);
#pragma unroll
        for (int i = 0; i < 16; ++i) { if (p == 0) L1[i] = L[i]; else L2[i] = L[i]; }
    }
    float s1[16], s2[16]; int a1[16], a2[16];
#pragma unroll
    for (int i = 0; i < 16; ++i) { s1[i] = f_unord(L1[i] & ~127); s2[i] = f_unord(L2[i] & ~127); a1[i] = (L1[i] & 127) << 7; a2[i] = L2[i] & 127; }
    int Cn[16];
    PEER_CAND_CHUNK(Cn, 0); sort16_desc(Cn);
#pragma unroll
    for (int c = 1; c < 4; ++c) { int Dn[16]; PEER_CAND_CHUNK(Dn, c); sort16_desc(Dn); merge16_desc(Cn, Dn); }
    float e[16]; float sum = 0.f; const float m0 = f_unord(Cn[0] & ~0x3fff);
#pragma unroll
    for (int k = 0; k < 16; ++k) { e[k] = __builtin_amdgcn_exp2f((f_unord(Cn[k] & ~0x3fff) - m0) * LOG2E); sum += e[k]; }
    const float inv = 1.0f / sum;
    if (h == 0) { unsigned* dst = ent + (size_t)r * 128 + head * 16;
#pragma unroll
        for (int g4 = 0; g4 < 4; ++g4) { v4u w;
            w.x = (cvtpk2(0.f, e[4 * g4] * inv) & 0xffff0000u) | (unsigned)(Cn[4 * g4] & 0x3fff); w.y = (cvtpk2(0.f, e[4 * g4 + 1] * inv) & 0xffff0000u) | (unsigned)(Cn[4 * g4 + 1] & 0x3fff);
            w.z = (cvtpk2(0.f, e[4 * g4 + 2] * inv) & 0xffff0000u) | (unsigned)(Cn[4 * g4 + 2] & 0x3fff); w.w = (cvtpk2(0.f, e[4 * g4 + 3] * inv) & 0xffff0000u) | (unsigned)(Cn[4 * g4 + 3] & 0x3fff);
            *(v4u*)(dst + 4 * g4) = w; } }
}
typedef float f32x2 __attribute__((ext_vector_type(2)));
DI f32x2 fp8lo(unsigned w) { return __builtin_amdgcn_cvt_pk_f32_fp8((int)w, false); }
DI f32x2 fp8hi(unsigned w) { return __builtin_amdgcn_cvt_pk_f32_fp8((int)w, true); }
DI f32x2 fma2(f32x2 a, f32x2 b, f32x2 c) { float x = c.x, y = c.y; asm("v_fmac_f32 %0, %1, %2" : "+v"(x) : "v"(a.x), "v"(b.x)); asm("v_fmac_f32 %0, %1, %2" : "+v"(y) : "v"(a.y), "v"(b.y)); return (f32x2){x, y}; }
constexpr int PU_LIST = 0, PU_H = 65536, PU_USC = 98304, PU_VSC = 106496, PU_BC = 114688, PU_LCAP = 160;
template <int VAR> DI void peer_u_issue(v4u (&rw)[16], const unsigned char* U8, const LAS unsigned* lev, int lane) {
#pragma unroll
    for (int k4 = 0; k4 < 4; ++k4) { const v4u ev = *(const LAS v4u*)(lev + 4 * k4);
#pragma unroll
        for (int k = 0; k < 4; ++k) rw[4 * k4 + k] = *(const v4u*)(U8 + (size_t)(ev[k] & 0x3fffu) * 1024 + 16 * lane); }
}
template <int VAR> DI void peer_u_compute(const v4u (&rw)[16], const LAS unsigned char* hrow, float hs, const LAS unsigned* lev, const LAS unsigned* lslot, int nvalid, int tok, const LAS float* uscs, const LAS float* vscs, float* ACT, int lane) {
    const v4u hq = *(const LAS v4u*)(hrow + 16 * lane);
    int p[16];
#pragma unroll
    for (int k = 0; k < 16; ++k) { int a = __builtin_amdgcn_sdot4((int)rw[k].x, (int)hq.x, 0, false); a = __builtin_amdgcn_sdot4((int)rw[k].y, (int)hq.y, a, false); a = __builtin_amdgcn_sdot4((int)rw[k].z, (int)hq.z, a, false); p[k] = __builtin_amdgcn_sdot4((int)rw[k].w, (int)hq.w, a, false); }
    { const bool up = (lane & 8) != 0;
#pragma unroll
      for (int i = 0; i < 8; ++i) { const int keep = up ? p[i + 8] : p[i], send = up ? p[i] : p[i + 8]; p[i] = keep + dppi<DPP_RM>(send); } }
    { const bool up = (lane & 4) != 0;
#pragma unroll
      for (int i = 0; i < 4; ++i) { const int keep = up ? p[i + 4] : p[i], send = up ? p[i] : p[i + 4]; p[i] = keep + dppi<DPP_HM>(send); } }
    { const bool up = (lane & 2) != 0;
#pragma unroll
      for (int i = 0; i < 2; ++i) { const int keep = up ? p[i + 2] : p[i], send = up ? p[i] : p[i + 2]; p[i] = keep + dppi<DPP_X2>(send); } }
    { const bool up = (lane & 1) != 0; const int keep = up ? p[1] : p[0], send = up ? p[0] : p[1]; p[0] = keep + dppi<DPP_X1>(send); }
    int dq = p[0];
    { auto r = __builtin_amdgcn_permlane16_swap((unsigned)dq, (unsigned)dq, false, false); dq = (int)r[0] + (int)r[1]; }
    { auto r = __builtin_amdgcn_permlane32_swap((unsigned)dq, (unsigned)dq, false, false); dq = (int)r[0] + (int)r[1]; }
    const int myk = lane & 15;
    if (lane < 16 && myk < nvalid) { const unsigned mev = lev[myk], mslot = lslot[myk]; const unsigned er = mev & 2047u;
        ACT[(VAR == 1) ? (size_t)lane : ((size_t)tok * 128 + mslot)] = gelu_tanh((float)dq * hs * uscs[er]) * __uint_as_float(mev & 0xffff0000u) * vscs[er]; }
}
DI void peer_u_loade(int tok, const unsigned* ENT, unsigned (&e0)[4], unsigned (&e1)[4], int lane) {
#pragma unroll
    for (int t = 0; t < 4; ++t) { e0[t] = ENT[(size_t)(tok + t) * 128 + lane]; e1[t] = ENT[(size_t)(tok + t) * 128 + 64 + lane]; }
}
template <int VAR> DI void peer_u_wave(int tok0, int slab, const unsigned* ENT, const unsigned char* HQ, const float* HS, const unsigned char* U8, float* ACT, LAS unsigned char* lds, int wave, int lane) {
    LAS unsigned* lev = (LAS unsigned*)(lds + PU_LIST + wave * 8192); LAS unsigned* lslot = lev + 4 * PU_LCAP; LAS unsigned char* hb = lds + PU_H + wave * 4096;
    const LAS float* uscs = (const LAS float*)(lds + PU_USC); const LAS float* vscs = (const LAS float*)(lds + PU_VSC);
    unsigned e0[4], e1[4];
    peer_u_loade(tok0, ENT, e0, e1, lane);
#pragma unroll 1
    for (int bt = 0; bt < 4; ++bt) { const int tb = tok0 + 4 * bt;
        v4u hq[4]; float hsv[4];
#pragma unroll
        for (int t = 0; t < 4; ++t) { hq[t] = *(const v4u*)(HQ + (size_t)(tb + t) * 1024 + 16 * lane); hsv[t] = HS[tb + t]; }
        int cnt[4]; const unsigned long long lt = (1ull << lane) - 1ull;
#pragma unroll
        for (int t = 0; t < 4; ++t) { const bool in0 = ((e0[t] >> 11) & 7u) == (unsigned)slab, in1 = ((e1[t] >> 11) & 7u) == (unsigned)slab;
            const unsigned long long b0 = __ballot(in0), b1 = __ballot(in1); const int n0 = __builtin_popcountll(b0), n = n0 + __builtin_popcountll(b1);
            LAS unsigned* le = lev + t * PU_LCAP; LAS unsigned* ls = lslot + t * PU_LCAP;
            if (in0) { const int p = __builtin_popcountll(b0 & lt); le[p] = e0[t]; ls[p] = (unsigned)lane; }
            if (in1) { const int p = n0 + __builtin_popcountll(b1 & lt); le[p] = e1[t]; ls[p] = (unsigned)(64 + lane); }
            if (n > 0 && lane < 16) { const unsigned pe = b0 ? (unsigned)__builtin_amdgcn_readlane((int)e0[t], (int)__builtin_ctzll(b0 | (1ull << 63))) : (unsigned)__builtin_amdgcn_readlane((int)e1[t], (int)__builtin_ctzll(b1 | (1ull << 63)));
                if (n + lane < ((n + 15) & ~15)) le[n + lane] = pe; }
            cnt[t] = n; }
        if (bt < 3) peer_u_loade(tb + 4, ENT, e0, e1, lane);
#pragma unroll
        for (int t = 0; t < 4; ++t) *(LAS v4u*)(hb + t * 1024 + 16 * lane) = hq[t];
        asm volatile("s_waitcnt lgkmcnt(0)" ::: "memory");
#define PU_CNT(t_) ((t_) == 0 ? cnt[0] : ((t_) == 1 ? cnt[1] : ((t_) == 2 ? cnt[2] : cnt[3])))
#define PU_HS(t_) ((t_) == 0 ? hsv[0] : ((t_) == 1 ? hsv[1] : ((t_) == 2 ? hsv[2] : hsv[3])))
#define PU_ADV(tk_, g_) do { while ((tk_) < 4 && (g_) >= PU_CNT(tk_)) { ++(tk_); (g_) = 0; } } while (0)
        int tk = 0, g = 0; PU_ADV(tk, g);
        if (tk < 4) { v4u ra[16], rb[16];
            peer_u_issue<VAR>(ra, U8, lev + tk * PU_LCAP + g, lane);
            for (;;) {
                int ntk = tk, ng = g + 16; PU_ADV(ntk, ng);
                if (ntk < 4) peer_u_issue<VAR>(rb, U8, lev + ntk * PU_LCAP + ng, lane);
                peer_u_compute<VAR>(ra, hb + tk * 1024, PU_HS(tk), lev + tk * PU_LCAP + g, lslot + tk * PU_LCAP + g, PU_CNT(tk) - g, tb + tk, uscs, vscs, ACT, lane);
                tk = ntk; g = ng; if (tk >= 4) break;
                ntk = tk; ng = g + 16; PU_ADV(ntk, ng);
                if (ntk < 4) peer_u_issue<VAR>(ra, U8, lev + ntk * PU_LCAP + ng, lane);
                peer_u_compute<VAR>(rb, hb + tk * 1024, PU_HS(tk), lev + tk * PU_LCAP + g, lslot + tk * PU_LCAP + g, PU_CNT(tk) - g, tb + tk, uscs, vscs, ACT, lane);
                tk = ntk; g = ng; if (tk >= 4) break;
            } }
#undef PU_CNT
#undef PU_HS
#undef PU_ADV
        asm volatile("s_waitcnt lgkmcnt(0)" ::: "memory");
    }
}
template <int VVAR> DI void peer_v_wave(int tok0, int slab, const unsigned* ENT, const float* ACT, const unsigned char* V8slab, bf16* XB, float* XF, const float* g2, int lane) {
    const int sub = lane & 7, j = lane >> 3;
    const int col = 128 * slab + 16 * sub + 2 * (4 * ((lane >> 5) & 1) + 2 * ((lane >> 4) & 1) + ((lane >> 3) & 1));
    const f32x2 gv = *(const f32x2*)(g2 + (tok0 >> 13) * 6144 + col);
    v4u enn[4]; f32x4 awn[4]; unsigned xvn;
    { const v4u* ep = (const v4u*)(ENT + (size_t)tok0 * 128 + 16 * j); const f32x4* ap = (const f32x4*)(ACT + (size_t)tok0 * 128 + 16 * j);
#pragma unroll
      for (int q = 0; q < 4; ++q) { enn[q] = ep[q]; awn[q] = ap[q]; }
      xvn = *(const unsigned*)(XB + (size_t)tok0 * 1024 + col); }
    (void)0;
#pragma unroll 1
    for (int it = 0; it < 8; ++it) { const int tok = tok0 + it;
        v4u en[4]; f32x4 aw[4]; const f32x2 xv = (f32x2){bf_lo(xvn), bf_hi(xvn)};
#pragma unroll
        for (int q = 0; q < 4; ++q) { en[q] = enn[q]; aw[q] = awn[q]; }
        v4u rw[16];
#pragma unroll
        for (int i = 0; i < 16; ++i) rw[i] = *(const v4u*)(V8slab + (size_t)((VVAR >= 2) ? (unsigned)(i + 16 * j) : (en[i >> 2][i & 3] & 0x3fffu)) * 128 + 16 * sub);
        if (it < 7 && VVAR != 3) { const v4u* ep = (const v4u*)(ENT + (size_t)(tok + 1) * 128 + 16 * j); const f32x4* ap = (const f32x4*)(ACT + (size_t)(tok + 1) * 128 + 16 * j);
#pragma unroll
            for (int q = 0; q < 4; ++q) { enn[q] = ep[q]; awn[q] = ap[q]; }
            xvn = *(const unsigned*)(XB + (size_t)(tok + 1) * 1024 + col); }
        float wm = 0.f;
#pragma unroll
        for (int q = 0; q < 4; ++q) wm = fmaxf(wm, fmaxf(fmaxf(fabsf(aw[q][0]), fabsf(aw[q][1])), fmaxf(fabsf(aw[q][2]), fabsf(aw[q][3]))));
        wm = fmaxf(wm, dppf<DPP_R8>(wm)); wm = fmaxf(wm, px16(wm, lane)); wm = fmaxf(wm, px32(wm, lane));
        const float wsq = wm > 0.f ? 127.0f / wm : 0.f, winv = wm * (1.0f / 127.0f);
        unsigned W[4];
#pragma unroll
        for (int q = 0; q < 4; ++q) { const int q0 = __float2int_rn(aw[q][0] * wsq), q1 = __float2int_rn(aw[q][1] * wsq), q2 = __float2int_rn(aw[q][2] * wsq), q3 = __float2int_rn(aw[q][3] * wsq);
            W[q] = (unsigned)(q0 & 255) | ((unsigned)(q1 & 255) << 8) | ((unsigned)(q2 & 255) << 16) | ((unsigned)(q3 & 255) << 24); }
        int acc[16];
#pragma unroll
        for (int c = 0; c < 16; ++c) acc[c] = 0;
#pragma unroll
        for (int g = 0; g < 4; ++g)
#pragma unroll
            for (int q = 0; q < 4; ++q) { const unsigned m0 = rw[4 * g][q], m1 = rw[4 * g + 1][q], m2 = rw[4 * g + 2][q], m3 = rw[4 * g + 3][q];
                const unsigned t0 = __builtin_amdgcn_perm(m1, m0, 0x05010400u), t1 = __builtin_amdgcn_perm(m1, m0, 0x07030602u), t2 = __builtin_amdgcn_perm(m3, m2, 0x05010400u), t3 = __builtin_amdgcn_perm(m3, m2, 0x07030602u);
                acc[4 * q] = __builtin_amdgcn_sdot4((int)__builtin_amdgcn_perm(t2, t0, 0x05040100u), (int)W[g], acc[4 * q], false);
                acc[4 * q + 1] = __builtin_amdgcn_sdot4((int)__builtin_amdgcn_perm(t2, t0, 0x07060302u), (int)W[g], acc[4 * q + 1], false);
                acc[4 * q + 2] = __builtin_amdgcn_sdot4((int)__builtin_amdgcn_perm(t3, t1, 0x05040100u), (int)W[g], acc[4 * q + 2], false);
                acc[4 * q + 3] = __builtin_amdgcn_sdot4((int)__builtin_amdgcn_perm(t3, t1, 0x07060302u), (int)W[g], acc[4 * q + 3], false); }
        { const bool up = (lane & 32) != 0;
#pragma unroll
          for (int c = 0; c < 8; ++c) { const int keep = up ? acc[c + 8] : acc[c], send = up ? acc[c] : acc[c + 8]; acc[c] = keep + px32(send, lane); } }
        { const bool up = (lane & 16) != 0;
#pragma unroll
          for (int c = 0; c < 4; ++c) { const int keep = up ? acc[c + 4] : acc[c], send = up ? acc[c] : acc[c + 4]; acc[c] = keep + (int)px16u((unsigned)send, lane); } }
        { const bool up = (lane & 8) != 0;
#pragma unroll
          for (int c = 0; c < 2; ++c) { const int keep = up ? acc[c + 2] : acc[c], send = up ? acc[c] : acc[c + 2]; acc[c] = keep + dppi<DPP_R8>(send); } }
        { const float y0 = xv.x + gv.x * ((float)acc[0] * winv), y1 = xv.y + gv.y * ((float)acc[1] * winv);
          if (XF) *(f32x2*)(XF + (size_t)tok * 1024 + col) = (f32x2){y0, y1}; else *(unsigned*)(XB + (size_t)tok * 1024 + col) = cvtpk2(y0, y1); }
    }
}
struct PeerT { const unsigned char *U8, *V8s; const float *USC, *VSC; unsigned* ENT; float* ACT; const unsigned char* HQ; const float* HS; bf16* XB; float* XF; const float* g2; };
DI void peer_scores_phase(const Frame& F, const bf16* QP, const bf16* SUBK, unsigned* ENT) {
    for (int unit = blockIdx.x; unit < MROWS / 64; unit += F.G) {
#pragma unroll 1
        for (int grp = 0; grp < 2; ++grp) { const int tokg = unit * 64 + 32 * grp; peer_scores(tokg, F.wave, QP, SUBK, ENT + (size_t)tokg * 128, F.lane); } }
}
template <int PASS, int VAR = 0> DI void peer_gather_phase(const Frame& F, int cnt_base, const PeerT& T) {
    const int xcc = XCC_EXPR; LAS int* bc = (LAS int*)(F.lds + PU_BC);
    constexpr int CHT = (PASS == 0) ? 128 : 64;
    for (int k = 0; k < 8; ++k) { const int s = (xcc + k) & 7; unsigned* cnt = (unsigned*)(F.ctl + CW_WORK + 64 * (cnt_base + s));
        if (PASS == 0) { for (int i = F.tid; i < 2048; i += NTHR) { ((LAS float*)(F.lds + PU_USC))[i] = T.USC[2048 * s + i]; ((LAS float*)(F.lds + PU_VSC))[i] = T.VSC[2048 * s + i]; } }
        for (;;) {
            if (F.tid == 0) *bc = (int)__hip_atomic_fetch_add(cnt, 1u, __ATOMIC_RELAXED, __HIP_MEMORY_SCOPE_AGENT);
            __syncthreads(); const int chunk = *bc; __syncthreads();
            if (chunk >= MROWS / CHT) break;
            if (PASS == 0) peer_u_wave<VAR>(chunk * 128 + F.wave * 16, s, T.ENT, T.HQ, T.HS, T.U8, T.ACT, F.lds, F.wave, F.lane);
            else peer_v_wave<VAR>(chunk * 64 + F.wave * 8, s, T.ENT, T.ACT, T.V8s + (size_t)s * 16384 * 128, T.XB, T.XF, T.g2, F.lane);
        } }
}
struct Args { const float* in[19]; float* out; unsigned char* ws; int stage, pad; };
__global__ void __launch_bounds__(NTHR, 2) hybrid_fwd(Args args) {
    extern __shared__ __attribute__((aligned(16))) unsigned char lds_raw[];
    for (int u = threadIdx.x; u < (LDS_BYTES - LDSCTL_OFF) / 4; u += NTHR) ((LAS unsigned*)((LAS unsigned char*)lds_raw + LDSCTL_OFF))[u] = 0u;
    __syncthreads();
    XcdBarrier bar = xcd_barrier_post((unsigned*)((gu32*)(args.ws + WS_CTL) + CW_BAR), (volatile LAS unsigned*)((LAS unsigned char*)lds_raw + MISC_OFF) + 8);
#ifdef PROBE_MASK
    volatile LAS unsigned long long* stamps_ = (volatile LAS unsigned long long*)((LAS unsigned char*)lds_raw + MISC_OFF + 256); int nst_ = 0;
#ifndef PROBE_BLK
#define PROBE_BLK 0
#endif
#define STAMP() do { if (blockIdx.x == PROBE_BLK && threadIdx.x == 0) stamps_[nst_] = __builtin_amdgcn_s_memrealtime(); ++nst_; } while (0)
#else
#define STAMP() do {} while (0)
#endif
    STAMP();
#define GRID_BAR() do { xcd_barrier(bar); STAMP(); } while (0)
#define OPQ(p) ({ size_t z_ = 0; asm volatile("" : "+s"(z_)); (p) + z_; })
#define PH_PTRS \
    unsigned char* ws = OPQ(args.ws); const float* x_in = OPQ(args.in[0]); float* X = OPQ(args.out); \
    const float *norm_mix = args.in[4], *norm_ffn = args.in[5]; \
    float* MOD = (float*)(ws + WS_MOD); float* ROPE = (float*)(ws + WS_ROPE); float* KSUM = (float*)(ws + WS_KSUM); \
    bf16 *WIN0 = (bf16*)(ws + WS_WIN0), *WOUT0 = (bf16*)(ws + WS_WOUT0), *WIN1 = (bf16*)(ws + WS_WIN1), *WOUT1 = (bf16*)(ws + WS_WOUT1), *WQ0 = (bf16*)(ws + WS_WQ0), *WQ1 = (bf16*)(ws + WS_WQ1); \
    bf16 *SUBK = (bf16*)(ws + WS_SUBK), *GWS = (bf16*)(ws + WS_GWS), *HN = (bf16*)(ws + WS_HN); \
    bf16 *UA = (bf16*)(ws + WS_A), *VA = (bf16*)(ws + WS_A + 16 * MiB), *Q0 = (bf16*)(ws + WS_A + 32 * MiB), *K0 = (bf16*)(ws + WS_A + 48 * MiB), *VT0 = (bf16*)(ws + WS_A + 64 * MiB); \
    bf16 *Q1 = (bf16*)(ws + WS_A), *K1 = (bf16*)(ws + WS_A + 32 * MiB), *VT1 = (bf16*)(ws + WS_A + 64 * MiB); \
    bf16 *YCAT = (bf16*)(ws + WS_YCAT), *QP = (bf16*)(ws + WS_QP), *PO = (bf16*)(ws + WS_PO); float* PL = (float*)(ws + WS_PL); unsigned* MASKS = (unsigned*)(ws + WS_MASK); unsigned char *U8 = ws + WS_PTU, *V8s = ws + WS_PTV; float *USC = (float*)(ws + WS_SC), *VSC = USC + 32768; unsigned* ENT = (unsigned*)(ws + WS_PO); float* ACT = (float*)(ws + WS_PO + 8 * MiB); unsigned char* HQ = ws + WS_A; float* HS = (float*)(ws + WS_SC + 512 * 1024); (void)HQ; (void)HS; bf16* XB = (bf16*)(ws + WS_XB); (void)XB; (void)U8; (void)V8s; (void)USC; (void)VSC; (void)ENT; (void)ACT; bf16* QKR = (bf16*)(ws + WS_QP); (void)QKR; \
    (void)x_in; (void)X; (void)norm_mix; (void)norm_ffn; (void)MOD; (void)ROPE; (void)KSUM; (void)WIN0; (void)WOUT0; (void)WIN1; (void)WOUT1; (void)WQ0; (void)WQ1; (void)SUBK; (void)GWS; (void)HN; \
    (void)UA; (void)VA; (void)Q0; (void)K0; (void)VT0; (void)Q1; (void)K1; (void)VT1; (void)YCAT; (void)QP; (void)PO; (void)PL; (void)MASKS;
#define PH_FRAME Frame F; F.lds = (LAS unsigned char*)lds_raw; F.MISC = (volatile LAS unsigned*)(F.lds + MISC_OFF); { int t_ = threadIdx.x; asm volatile("" : "+v"(t_)); F.tid = t_; } F.lane = F.tid & 63; F.wave = __builtin_amdgcn_readfirstlane(F.tid >> 6); \
    F.G = gridDim.x; F.gw = blockIdx.x * NWAVES + F.wave; F.NGW = F.G * NWAVES; F.ctl = (gu32*)(OPQ(args.ws) + WS_CTL);
    { PH_FRAME PH_PTRS
      P0Args A; A.c = args.in[1]; A.w_mod = args.in[2]; A.b_mod = args.in[3]; A.win0 = args.in[6]; A.wout0 = args.in[12]; A.win1 = args.in[13]; A.wout1 = args.in[14]; A.wq = args.in[15]; A.subk = args.in[16];
      A.pu = args.in[17]; A.pv = args.in[18]; A.gws = args.in[8]; A.MOD = MOD; A.ROPE = ROPE; A.WIN0 = WIN0; A.WOUT0 = WOUT0; A.WIN1 = WIN1; A.WOUT1 = WOUT1; A.WQ0 = WQ0; A.WQ1 = WQ1; A.SUBK = SUBK; A.GWS = GWS; A.U8 = U8; A.V8s = V8s; A.USC = USC; A.VSC = VSC;
      p0_prologue(F, A); }
    GRID_BAR();
    { PH_FRAME PH_PTRS norm_rows<true>(F, x_in, norm_mix, MOD, 0, 1, HN); }
    GRID_BAR();
    { PH_FRAME PH_PTRS
      pg8::Gemm g{HN, WIN0, MROWS, 2048, 1024}; pg8::StaticOrder S; S.init(MROWS, 2048, F.G, (int)blockIdx.x);
      pg8::EpiL0m E{UA, VA, QKR};
      pg8::gemm_phase<pg8::EpiL0m, pg8::StaticOrder, true, true>(F.lds, g, S, E); }
    { PH_FRAME PH_PTRS
      pg8::Gemm g{WIN0 + (size_t)2048 * 1024, HN, 512, MROWS, 1024}; pg8::StaticOrder S; S.init(512, MROWS, F.G, (int)blockIdx.x);
      pg8::EpiVT E{VT0, 512};
      pg8::gemm_phase<pg8::EpiVT, pg8::StaticOrder, true, true>(F.lds, g, S, E); }
    GRID_BAR();
    { PH_FRAME PH_PTRS
      for (int t = blockIdx.x; t < 256; t += F.G) qk_post_task(t, QKR, Q0, K0, KSUM, ROPE, args.in[10], args.in[11], (LAS float*)F.lds, F.tid, F.wave, F.lane);
      for (int u = blockIdx.x; u < 512; u += F.G) gmlp_unit(u, UA, VA, args.in[7], GWS, args.in[9], YCAT, F.lds, F.tid, F.wave, F.lane); }
    GRID_BAR();
    { PH_FRAME PH_PTRS
      MobaT T{Q0, K0, VT0, KSUM, MASKS, PO, PL, args.in[10], args.in[11]}; const float mc2 = moba_mc2(args.in[10], args.in[11], F.lane);
      for (int u = F.gw; u < 4096; u += F.NGW) moba_mask_unit(u, T, F.lane); (void)mc2; }
    GRID_BAR();
    { PH_FRAME PH_PTRS
      MobaT T{Q0, K0, VT0, KSUM, MASKS, PO, PL, args.in[10], args.in[11]}; const float mc2 = moba_mc2(args.in[10], args.in[11], F.lane);
      LAS int* bc = (LAS int*)(F.lds + MS_CNT + 64);
      for (;;) { if (F.tid == 0) *bc = (int)__hip_atomic_fetch_add((unsigned*)(F.ctl + CW_WORK), 1u, __ATOMIC_RELAXED, __HIP_MEMORY_SCOPE_AGENT);
          __syncthreads(); const int task = *bc; __syncthreads(); if (task >= MOBA_NTASK) break;
          moba_sel_task(task, T, F.lds, mc2, F.tid, F.wave, F.lane); } }
    GRID_BAR();
    { PH_FRAME PH_PTRS moba_combine(F, PO, PL, YCAT); }
    GRID_BAR();
    { PH_FRAME PH_PTRS
      pg8::Gemm g{YCAT, WOUT0, MROWS, 1024, 1024}; pg8::StaticOrder S; S.init(MROWS, 1024, F.G, (int)blockIdx.x);
      pg8::EpiRes<true> E{x_in, XB, MOD + 2 * 1024};
      pg8::gemm_phase<pg8::EpiRes<true>, pg8::StaticOrder, true, true>(F.lds, g, S, E); }
    GRID_BAR();
    { PH_FRAME PH_PTRS norm_rows<false>(F, XB, norm_ffn, MOD, 3, 4, HN, HQ, HS); }
    GRID_BAR();
    { PH_FRAME PH_PTRS
      pg8::Gemm g{HN, WQ0, MROWS, 2048, 1024}; pg8::StaticOrder S; S.init(MROWS, 2048, F.G, (int)blockIdx.x);
      pg8::EpiBf16<0> E{QP, 2048, nullptr, 0, 0, 1.f};
      pg8::gemm_phase<pg8::EpiBf16<0>, pg8::StaticOrder, true, true>(F.lds, g, S, E); }
    GRID_BAR();
    { PH_FRAME PH_PTRS peer_scores_phase(F, QP, SUBK, ENT); }
    GRID_BAR();
    { PH_FRAME PH_PTRS PeerT T{U8, V8s, USC, VSC, ENT, ACT, HQ, HS, XB, nullptr, MOD + 5 * 1024}; peer_gather_phase<0>(F, 1, T); }
    GRID_BAR();
#ifdef XVAR
    { PH_FRAME PH_PTRS PeerT T{U8, V8s, USC, VSC, ENT, (float*)(ws + WS_PL), HQ, HS, XB, nullptr, MOD + 5 * 1024}; peer_gather_phase<0, XVAR>(F, 40, T); }
    GRID_BAR();
#endif
    { PH_FRAME PH_PTRS PeerT T{U8, V8s, USC, VSC, ENT, ACT, HQ, HS, XB, nullptr, MOD + 5 * 1024}; peer_gather_phase<1>(F, 9, T); }
    GRID_BAR();
#ifdef XVVAR
    { PH_FRAME PH_PTRS PeerT T{U8, V8s, USC, VSC, ENT, ACT, HQ, HS, XB, (float*)(ws + WS_QP), MOD + 5 * 1024}; peer_gather_phase<1, XVVAR>(F, 48, T); }
    GRID_BAR();
#endif
    { PH_FRAME PH_PTRS norm_rows<false>(F, XB, norm_mix + 1024, MOD + 2 * 6144, 0, 1, HN); }
    GRID_BAR();
    { PH_FRAME PH_PTRS
      pg8::Gemm g{HN, WIN1, MROWS, 2048, 1024}; pg8::StaticOrder S; S.init(MROWS, 2048, F.G, (int)blockIdx.x);
      pg8::EpiHeads E{Q1, K1, 16, 0.125f};
      pg8::gemm_phase<pg8::EpiHeads, pg8::StaticOrder, true, true>(F.lds, g, S, E); }
    { PH_FRAME PH_PTRS
      pg8::Gemm g{WIN1 + (size_t)2048 * 1024, HN, 1024, MROWS, 1024}; pg8::StaticOrder S; S.init(1024, MROWS, F.G, (int)blockIdx.x);
      pg8::EpiVT E{VT1, 1024};
      pg8::gemm_phase<pg8::EpiVT, pg8::StaticOrder, true, true>(F.lds, g, S, E); }
    GRID_BAR();
    { PH_FRAME PH_PTRS for (int u = blockIdx.x; u < 1024; u += F.G) sb_wg_unit(u, Q1, K1, VT1, YCAT, F.lds, F.tid, F.wave, F.lane); }
    GRID_BAR();
    { PH_FRAME PH_PTRS
      pg8::Gemm g{YCAT, WOUT1, MROWS, 1024, 1024}; pg8::StaticOrder S; S.init(MROWS, 1024, F.G, (int)blockIdx.x);
      pg8::EpiRes<false> E{nullptr, XB, MOD + 2 * 6144 + 2 * 1024};
      pg8::gemm_phase<pg8::EpiRes<false>, pg8::StaticOrder, true, true>(F.lds, g, S, E); }
    GRID_BAR();
    { PH_FRAME PH_PTRS norm_rows<false>(F, XB, norm_ffn + 1024, MOD + 2 * 6144, 3, 4, HN, HQ, HS); }
    GRID_BAR();
    { PH_FRAME PH_PTRS
      pg8::Gemm g{HN, WQ1, MROWS, 2048, 1024}; pg8::StaticOrder S; S.init(MROWS, 2048, F.G, (int)blockIdx.x);
      pg8::EpiBf16<0> E{QP, 2048, nullptr, 0, 0, 1.f};
      pg8::gemm_phase<pg8::EpiBf16<0>, pg8::StaticOrder, true, true>(F.lds, g, S, E); }
    GRID_BAR();
    { PH_FRAME PH_PTRS peer_scores_phase(F, QP, SUBK + 262144, ENT); }
    GRID_BAR();
    { PH_FRAME PH_PTRS PeerT T{U8 + (size_t)16384 * 1024, V8s + (size_t)16384 * 1024, USC + 16384, VSC + 16384, ENT, ACT, HQ, HS, XB, X, MOD + 2 * 6144 + 5 * 1024}; peer_gather_phase<0>(F, 17, T); }
    GRID_BAR();
    { PH_FRAME PH_PTRS PeerT T{U8 + (size_t)16384 * 1024, V8s + (size_t)16384 * 1024, USC + 16384, VSC + 16384, ENT, ACT, HQ, HS, XB, X, MOD + 2 * 6144 + 5 * 1024}; peer_gather_phase<1>(F, 25, T);
      if (__hip_atomic_load((gu32*)((unsigned*)(F.ctl + CW_BAR) + XB_TMO), RLX_AGENT) != 0u) { for (int m = F.gw; m < MROWS; m += F.NGW) X[(size_t)m * 1024 + F.lane] = __builtin_nanf(""); } }
#ifdef PROBE_MASK
#ifdef PROBE_BARS
    for (int i = 0; i < PROBE_BARS; ++i) xcd_barrier(bar);
#endif
    STAMP();
    if (blockIdx.x == PROBE_BLK && threadIdx.x == 0) { unsigned long long tsel = 0;
        for (int i = 0; i + 1 < nst_; ++i) if ((PROBE_MASK >> i) & 1ull) tsel += stamps_[i + 1] - stamps_[i];

        const unsigned long long t0 = __builtin_amdgcn_s_memrealtime(); while (__builtin_amdgcn_s_memrealtime() - t0 < tsel * PROBE_AMP) __builtin_amdgcn_s_sleep(8); }
#endif
}

extern "C" void kernel_launch(void* const* d_in, const int* in_sizes, int n_in, void* d_out, int out_size, void* d_ws, size_t ws_size, hipStream_t stream) {
    static int grid = 0;
    if (grid == 0) {
        if (n_in != 19 || out_size != MROWS * DM || ws_size < WS_END) { fprintf(stderr, "kernel_launch: unexpected shapes (n_in %d, out %d, ws %zu)\n", n_in, out_size, ws_size); grid = -1; return; }
        int dev = 0, cus = 0, per_cu = 0;
        if (hipGetDevice(&dev) != hipSuccess || hipDeviceGetAttribute(&cus, hipDeviceAttributeMultiprocessorCount, dev) != hipSuccess) { grid = -1; return; }
        if (hipFuncSetAttribute((const void*)hybrid_fwd, hipFuncAttributeMaxDynamicSharedMemorySize, LDS_BYTES) != hipSuccess) { fprintf(stderr, "kernel_launch: hipFuncSetAttribute failed\n"); grid = -1; return; }
        if (hipOccupancyMaxActiveBlocksPerMultiprocessor(&per_cu, (const void*)hybrid_fwd, NTHR, LDS_BYTES) != hipSuccess || per_cu < 1) { fprintf(stderr, "kernel_launch: occupancy query says %d\n", per_cu); per_cu = 1; }
        (void)hipGetLastError();
        grid = cus;
    }
    if (grid < 0) return;
    if (hipMemsetAsync((char*)d_ws + WS_CTL, 0, CTL_ZERO_BYTES, stream) != hipSuccess) { fprintf(stderr, "kernel_launch: memset failed\n"); return; }
    Args a{};
    for (int i = 0; i < 19; ++i) a.in[i] = (const float*)d_in[i];
    a.out = (float*)d_out; a.ws = (unsigned char*)d_ws; a.stage = 0; a.pad = 0;
    void* kargs[] = {&a};
    hipError_t e = hipLaunchCooperativeKernel((const void*)hybrid_fwd, dim3(grid), dim3(NTHR), kargs, LDS_BYTES, stream);
    if (e != hipSuccess) fprintf(stderr, "kernel_launch: cooperative launch failed: %s (grid %d)\n", hipGetErrorString(e), grid);
}
```

```cpp
#include <hip/hip_runtime.h>
#include <cstdio>
#include <cstdint>
#include <cmath>
namespace pg8 {
#define PG8_LAS __attribute__((address_space(3)))
typedef unsigned short bf16_t;
typedef short bf16x8 __attribute__((ext_vector_type(8)));
typedef float f32x4 __attribute__((ext_vector_type(4)));
typedef unsigned u32x4 __attribute__((ext_vector_type(4)));
constexpr int BM = 256, BK = 64, HALF = 128, HTB = HALF * BK * 2  , STAGE_BYTES = 8 * HTB, NXCD = 8, WGM = 8;

__host__ __device__ __forceinline__ int lds_byte(int r, int c) { const int st = (r >> 4) * 2 + (c >> 5), rr = r & 15, cc = c & 31, ob = rr * 64 + cc * 2; return st * 1024 + (ob ^ (((ob >> 9) & 1) << 5)); }
__host__ __device__ __forceinline__ void stage_rc(int b, int& R, int& C) { const int st = b / 1024, sb = b % 1024, swz = sb ^ (((sb >> 9) & 1) << 5); R = (st >> 1) * 16 + swz / 64; C = (st & 1) * 32 + (swz % 64) / 2; }
__host__ __device__ __forceinline__ int perm32(int rho) { const int n = rho >> 4, i = rho & 15; return 8 * (i >> 2) + 4 * n + (i & 3); }

struct Unit { int pm, pn; };
struct Gemm { const bf16_t* A; const bf16_t* Bt; int M, N, K; };

struct StaticOrder {
    int nM, nN, nwg, G, c;
    __host__ __device__ void init(int M, int N, int G_, int c_) { nM = M / BM; nN = N / BM; nwg = nM * nN; G = G_; c = c_; }
    __host__ __device__ bool next(int i, Unit& u) const {
        const long L = (long)i * G + c; if (L >= nwg) return false;
        int wgid = (int)L; { const int q = nwg / NXCD, r = nwg % NXCD, xcd = wgid % NXCD, off = wgid / NXCD; wgid = (xcd < r ? xcd * (q + 1) : r * (q + 1) + (xcd - r) * q) + off; }
        const int nig = WGM * nN, gid = wgid / nig, fm = gid * WGM, gsz = (nM - fm) < WGM ? (nM - fm) : WGM;
        u.pm = fm + ((wgid % nig) % gsz); u.pn = (wgid % nig) / gsz; return true;
    }
    __device__ __forceinline__ void a_ready(const Unit&) const {}
    __device__ __forceinline__ void done(const Unit&) const {}
};

__device__ __forceinline__ unsigned cvt_pk_bf16(float lo, float hi) { unsigned r; asm volatile("v_cvt_pk_bf16_f32 %0, %1, %2" : "=v"(r) : "v"(lo), "v"(hi)); return r; }
typedef float f32x2 __attribute__((ext_vector_type(2)));
__device__ __forceinline__ f32x2 gelu_pk(f32x2 v) {
    const f32x2 av = __builtin_elementwise_abs(v), d = av * 0.2316418882f + 1.0f;
    f32x2 t; t.x = __builtin_amdgcn_rcpf(d.x); t.y = __builtin_amdgcn_rcpf(d.y);
    f32x2 q = t * 0.5307027145f + (-0.7265760135f); q = q * t + 0.7107068705f; q = q * t + (-0.142248368f); q = q * t + 0.127414796f; q = q * t;
    const f32x2 s = (v * v) * (-0.72134752044f);
    f32x2 e; e.x = __builtin_amdgcn_exp2f(s.x); e.y = __builtin_amdgcn_exp2f(s.y);
    const f32x2 m = v * (q * e), r = v - m;
    f32x2 o; o.x = v.x < 0.f ? m.x : r.x; o.y = v.y < 0.f ? m.y : r.y; return o;
}

template <int ACT  > struct EpiBf16 {
    static constexpr bool PERM = true, AFTER_DRAIN = false; static_assert(ACT == 0 || ACT == 1, "EpiBf16: ACT is 0 (none) or 1 (gelu_pk)");
    bf16_t* O; int ldc; const float* bias; int split_cols; size_t split_stride; float scale0;
    __device__ __forceinline__ void operator()(const f32x4 (&acc)[2][2][4][2], const Unit& u, int wr, int wc, int fr, int fq) const {
        const int row0 = u.pm * BM + wr * 64 + fr; int colt = u.pn * BM; bf16_t* base = O;
        float sc = 1.f; if (split_cols) { const int t = colt / split_cols; base += (size_t)t * split_stride; colt -= t * split_cols; if (t == 0) sc = scale0; }
        const int col0 = colt + wc * 32 + 8 * fq, bcol0 = u.pn * BM + wc * 32 + 8 * fq;
        f32x4 bv[2][2];
#pragma unroll
        for (int bj = 0; bj < 2; ++bj)
#pragma unroll
            for (int n = 0; n < 2; ++n) bv[bj][n] = bias ? *(const f32x4*)(bias + bcol0 + bj * HALF + 4 * n) : (f32x4){0.f, 0.f, 0.f, 0.f};
#pragma unroll
        for (int ai = 0; ai < 2; ++ai)
#pragma unroll
            for (int m = 0; m < 4; ++m) { bf16_t* rowp = base + (size_t)(row0 + ai * HALF + m * 16) * ldc + col0;
#pragma unroll
                for (int bj = 0; bj < 2; ++bj) { f32x4 v0 = acc[ai][bj][m][0] + bv[bj][0], v1 = acc[ai][bj][m][1] + bv[bj][1];
                    if (ACT == 1) { f32x2 a = gelu_pk((f32x2){v0[0], v0[1]}), b = gelu_pk((f32x2){v0[2], v0[3]}), c = gelu_pk((f32x2){v1[0], v1[1]}), d = gelu_pk((f32x2){v1[2], v1[3]});
                        v0 = (f32x4){a.x, a.y, b.x, b.y}; v1 = (f32x4){c.x, c.y, d.x, d.y}; }
                    v0 = v0 * sc; v1 = v1 * sc; u32x4 w; w.x = cvt_pk_bf16(v0[0], v0[1]); w.y = cvt_pk_bf16(v0[2], v0[3]); w.z = cvt_pk_bf16(v1[0], v1[1]); w.w = cvt_pk_bf16(v1[2], v1[3]);
                    *(u32x4*)(rowp + bj * HALF) = w; } }
    }
};
constexpr int XSEQ = 8192;
typedef float f32x2e __attribute__((ext_vector_type(2))); typedef __bf16 bf16x2e __attribute__((ext_vector_type(2)));
__device__ __forceinline__ unsigned cvtpk2(float lo, float hi) { f32x2e v = {lo, hi}; bf16x2e b = __builtin_convertvector(v, bf16x2e); return __builtin_bit_cast(unsigned, b); }
__device__ __forceinline__ float gelu_tanh(float x) {
    const float u2 = x * (1.5957691216f + 0.0713548163f * x * x);
    return x * __builtin_amdgcn_rcpf(1.0f + __builtin_amdgcn_exp2f(-1.4426950409f * u2));
}
struct EpiL0m {
    static constexpr bool PERM = true, AFTER_DRAIN = false;
    bf16_t *UA, *VA, *QKR;
    template <bool ACT> __device__ __forceinline__ void tile(const f32x4 (&acc)[2][2][4][2], bf16_t* base, int ldc, int row0, int colt) const {
#pragma unroll
        for (int ai = 0; ai < 2; ++ai)
#pragma unroll
            for (int m = 0; m < 4; ++m) { bf16_t* rowp = base + (size_t)(row0 + ai * HALF + m * 16) * ldc + colt;
#pragma unroll
                for (int bj = 0; bj < 2; ++bj) { f32x4 v0 = acc[ai][bj][m][0], v1 = acc[ai][bj][m][1]; u32x4 w;
                    if (ACT) { v0[0] = gelu_tanh(v0[0]); v0[1] = gelu_tanh(v0[1]); v0[2] = gelu_tanh(v0[2]); v0[3] = gelu_tanh(v0[3]); v1[0] = gelu_tanh(v1[0]); v1[1] = gelu_tanh(v1[1]); v1[2] = gelu_tanh(v1[2]); v1[3] = gelu_tanh(v1[3]); }
                    w.x = cvtpk2(v0[0], v0[1]); w.y = cvtpk2(v0[2], v0[3]); w.z = cvtpk2(v1[0], v1[1]); w.w = cvtpk2(v1[2], v1[3]);
                    *(u32x4*)(rowp + bj * HALF) = w; } }
    }
    __device__ __forceinline__ void operator()(const f32x4 (&acc)[2][2][4][2], const Unit& u, int wr, int wc, int fr, int fq) const {
        const int pn = u.pn; const int row0 = u.pm * BM + wr * 64 + fr; const int cw = wc * 32 + 8 * fq;
        if (pn < 2) tile<true>(acc, UA, 512, row0, pn * 256 + cw);
        else if (pn < 4) tile<true>(acc, VA, 512, row0, (pn - 2) * 256 + cw);
        else tile<false>(acc, QKR, 1024, row0, (pn - 4) * 256 + cw);
    }
};
struct EpiHeads {
    static constexpr bool PERM = true, AFTER_DRAIN = false;
    bf16_t *Q, *Kp; int nh; float qscale;
    __device__ __forceinline__ void operator()(const f32x4 (&acc)[2][2][4][2], const Unit& u, int wr, int wc, int fr, int fq) const {
        const int b = u.pm >> 5, sb = (u.pm & 31) * 256 + wr * 64 + fr;
#pragma unroll
        for (int bj = 0; bj < 2; ++bj) { const int c = u.pn * BM + bj * HALF + wc * 32 + 8 * fq; const int t = c / (64 * nh), cc = c - t * 64 * nh, head = cc >> 6, d = cc & 63;
            bf16_t* dst = (t ? Kp : Q) + ((size_t)(b * nh + head) * XSEQ) * 64 + d;
#pragma unroll
            for (int ai = 0; ai < 2; ++ai)
#pragma unroll
                for (int m = 0; m < 4; ++m) { const int s = sb + ai * HALF + m * 16; const float qs = t ? 1.0f : qscale; const f32x4 v0 = acc[ai][bj][m][0] * qs, v1 = acc[ai][bj][m][1] * qs; u32x4 w;
                    w.x = cvtpk2(v0[0], v0[1]); w.y = cvtpk2(v0[2], v0[3]); w.z = cvtpk2(v1[0], v1[1]); w.w = cvtpk2(v1[2], v1[3]);
                    *(u32x4*)(dst + (size_t)s * 64) = w; } }
    }
};
struct EpiVT {
    static constexpr bool PERM = true, AFTER_DRAIN = false;
    bf16_t* VT; int nrows;
    __device__ __forceinline__ void operator()(const f32x4 (&acc)[2][2][4][2], const Unit& u, int wr, int wc, int fr, int fq) const {
        const int row0 = u.pm * BM + wr * 64 + fr; const int c0 = u.pn * BM + wc * 32 + 8 * fq; const int b = c0 >> 13, s0 = c0 & (XSEQ - 1);
#pragma unroll
        for (int ai = 0; ai < 2; ++ai)
#pragma unroll
            for (int m = 0; m < 4; ++m) { bf16_t* rowp = VT + ((size_t)b * nrows + row0 + ai * HALF + m * 16) * XSEQ + s0;
#pragma unroll
                for (int bj = 0; bj < 2; ++bj) { const f32x4 v0 = acc[ai][bj][m][0], v1 = acc[ai][bj][m][1]; u32x4 w;
                    w.x = cvtpk2(v0[0], v0[1]); w.y = cvtpk2(v0[2], v0[3]); w.z = cvtpk2(v1[0], v1[1]); w.w = cvtpk2(v1[2], v1[3]);
                    *(u32x4*)(rowp + bj * HALF) = w; } }
    }
};
template <bool XIN_F32> struct EpiRes {
    static constexpr bool PERM = true, AFTER_DRAIN = false;
    const float* xin; bf16_t* XB; const float* g;
    __device__ __forceinline__ void operator()(const f32x4 (&acc)[2][2][4][2], const Unit& u, int wr, int wc, int fr, int fq) const {
        const int row0 = u.pm * BM + wr * 64 + fr, col0 = u.pn * BM + wc * 32 + 8 * fq; const int b = u.pm >> 5;
        f32x4 gv[2][2];
#pragma unroll
        for (int bj = 0; bj < 2; ++bj)
#pragma unroll
            for (int n = 0; n < 2; ++n) gv[bj][n] = *(const f32x4*)(g + b * 6144 + col0 + bj * HALF + 4 * n);
#pragma unroll
        for (int ai = 0; ai < 2; ++ai)
#pragma unroll
            for (int m = 0; m < 4; ++m) { const size_t off = (size_t)(row0 + ai * HALF + m * 16) * 1024 + col0;
#pragma unroll
                for (int bj = 0; bj < 2; ++bj) { f32x4 x0, x1;
                    if (XIN_F32) { x0 = *(const f32x4*)(xin + off + bj * HALF); x1 = *(const f32x4*)(xin + off + bj * HALF + 4); }
                    else { const u32x4 w = *(const u32x4*)(XB + off + bj * HALF); x0 = (f32x4){__uint_as_float(w.x << 16), __uint_as_float(w.x & 0xffff0000u), __uint_as_float(w.y << 16), __uint_as_float(w.y & 0xffff0000u)};
                        x1 = (f32x4){__uint_as_float(w.z << 16), __uint_as_float(w.z & 0xffff0000u), __uint_as_float(w.w << 16), __uint_as_float(w.w & 0xffff0000u)}; }
                    const f32x4 y0 = x0 + gv[bj][0] * acc[ai][bj][m][0], y1 = x1 + gv[bj][1] * acc[ai][bj][m][1]; u32x4 o;
                    o.x = cvtpk2(y0[0], y0[1]); o.y = cvtpk2(y0[2], y0[3]); o.z = cvtpk2(y1[0], y1[1]); o.w = cvtpk2(y1[2], y1[3]);
                    *(u32x4*)(XB + off + bj * HALF) = o; } }
    }
};
template <class Epi, class Sched, bool ALIGN_EPI = false, bool SP2 = false>
__device__ __forceinline__ void gemm_phase(PG8_LAS unsigned char* lds, const Gemm g, const Sched& S, const Epi& E) {
    int tid_ = threadIdx.x; asm volatile("" : "+v"(tid_));
    const int tid = tid_, wid = __builtin_amdgcn_readfirstlane(tid >> 6), lane = tid & 63, wr = wid >> 2, wc = wid & 3, fr = lane & 15, fq = lane >> 4;
    const int K = g.K, nt = K / BK;
    unsigned voffA[2], voffB[2];
#pragma unroll
    for (int i = 0; i < 2; ++i) { int R, C; stage_rc(tid * 16 + i * 8192, R, C); const int Rb = Epi::PERM ? ((R & ~31) + perm32(R & 31)) : R;
        voffA[i] = (unsigned)(R * K + C) * 2u; voffB[i] = (unsigned)(Rb * K + C) * 2u; }
    const size_t kstep = (size_t)(BK * 2);
    const size_t hstep = (size_t)HALF * K * 2;
    const size_t tstep = 2 * hstep;
    const unsigned ldsw = (unsigned)wid * 1024u;
    const int aoff = lds_byte(wr * 64 + fr, fq * 8), boff = lds_byte(wc * 32 + fr, fq * 8);
#define PG8_SA(b, h) (((b) * 2 + (h)) * HTB)
#define PG8_SB(b, h) ((4 + (b) * 2 + (h)) * HTB)
#define PG8_STAGE(bufoff, gbase, voff) do { _Pragma("unroll") for (int _i = 0; _i < 2; ++_i) \
        __builtin_amdgcn_global_load_lds((const unsigned*)((const char*)(gbase) + (voff)[_i]), (PG8_LAS unsigned*)(lds + (bufoff) + ldsw + _i * 8192), 16, 0, 0); } while (0)
#define PG8_LDA(dst, b, h) do { _Pragma("unroll") for (int m = 0; m < 4; ++m) _Pragma("unroll") for (int k = 0; k < 2; ++k) dst[m][k] = *(const PG8_LAS bf16x8*)(lds + PG8_SA(b, h) + aoff + m * 2048 + k * 1024); } while (0)
#define PG8_LDB(dst, b, h) do { _Pragma("unroll") for (int n = 0; n < 2; ++n) _Pragma("unroll") for (int k = 0; k < 2; ++k) dst[n][k] = *(const PG8_LAS bf16x8*)(lds + PG8_SB(b, h) + boff + n * 2048 + k * 1024); } while (0)
#define PG8_MMA(ai, bj, At, Bt) do { __builtin_amdgcn_s_setprio(1); _Pragma("unroll") for (int m = 0; m < 4; ++m) _Pragma("unroll") for (int n = 0; n < 2; ++n) _Pragma("unroll") for (int k = 0; k < 2; ++k) \
        acc[ai][bj][m][n] = __builtin_amdgcn_mfma_f32_16x16x32_bf16(Bt[n][k], At[m][k], acc[ai][bj][m][n], 0, 0, 0); __builtin_amdgcn_s_setprio(0); } while (0)
#define PG8_WAIT_V(n) asm volatile("s_waitcnt vmcnt(" #n ")" ::: "memory")
#define PG8_WAIT_L(n) asm volatile("s_waitcnt lgkmcnt(" #n ")" ::: "memory")
#define PG8_BAR __builtin_amdgcn_s_barrier()
#define PG8_SCHED __builtin_amdgcn_sched_barrier(0)
    Unit cur, nxt; int ui = 0;
    if (!S.next(0, cur)) return;
    f32x4 acc[2][2][4][2];
#pragma unroll
    for (int a = 0; a < 2; ++a)
#pragma unroll
        for (int b = 0; b < 2; ++b)
#pragma unroll
            for (int m = 0; m < 4; ++m)
#pragma unroll
                for (int n = 0; n < 2; ++n) acc[a][b][m][n] = (f32x4){0.f, 0.f, 0.f, 0.f};
    bf16x8 At[4][2], B0[2][2], B1[2][2];
    const char* cA = (const char*)g.A + (size_t)cur.pm * tstep; const char* cB = (const char*)g.Bt + (size_t)cur.pn * tstep;
    S.a_ready(cur);
    if constexpr (SP2) {
        PG8_STAGE(PG8_SB(0, 0), cB, voffB); PG8_STAGE(PG8_SB(0, 1), cB + hstep, voffB); PG8_STAGE(PG8_SA(0, 0), cA, voffA); PG8_STAGE(PG8_SA(0, 1), cA + hstep, voffA);
        if (wr == 1) PG8_BAR;
        PG8_WAIT_V(2); PG8_BAR;
        PG8_STAGE(PG8_SB(1, 0), cB + kstep, voffB); PG8_STAGE(PG8_SA(1, 0), cA + kstep, voffA); PG8_STAGE(PG8_SB(1, 1), cB + hstep + kstep, voffB);
        PG8_WAIT_V(6); PG8_BAR;
    } else {
        PG8_STAGE(PG8_SB(0, 0), cB, voffB); PG8_STAGE(PG8_SA(0, 0), cA, voffA); PG8_STAGE(PG8_SB(0, 1), cB + hstep, voffB); PG8_STAGE(PG8_SA(0, 1), cA + hstep, voffA);
        if (wr == 1) PG8_BAR;
        PG8_WAIT_V(4); PG8_BAR;
        PG8_STAGE(PG8_SB(1, 0), cB + kstep, voffB); PG8_STAGE(PG8_SA(1, 0), cA + kstep, voffA); PG8_STAGE(PG8_SB(1, 1), cB + hstep + kstep, voffB);
        PG8_WAIT_V(6); PG8_BAR;
    }
    for (;;) {
        const bool has_next = S.next(ui + 1, nxt);
        const char* nA = has_next ? (const char*)g.A + (size_t)nxt.pm * tstep : cA; const char* nB = has_next ? (const char*)g.Bt + (size_t)nxt.pn * tstep : cB;
        for (int t = 0; t < nt; t += 2) {
            const bool last = (t == nt - 2);
            const char* a1 = cA + (size_t)(t + 1) * kstep;
            const char* a2 = last ? nA : cA + (size_t)(t + 2) * kstep; const char* b2 = last ? nB : cB + (size_t)(t + 2) * kstep;
            const char* a3 = a2 + kstep; const char* b3 = b2 + kstep;
            if (last && has_next) S.a_ready(nxt);
            if constexpr (SP2) {
            PG8_LDB(B0, 0, 0); PG8_LDB(B1, 0, 1); PG8_SCHED; PG8_LDA(At, 0, 0); PG8_STAGE(PG8_SA(1, 1), a1 + hstep, voffA);
            PG8_WAIT_V(8); PG8_WAIT_L(0); PG8_BAR; PG8_MMA(0, 0, At, B0); PG8_MMA(0, 1, At, B1); PG8_BAR; PG8_SCHED;
            PG8_LDA(At, 0, 1); PG8_STAGE(PG8_SB(0, 0), b2, voffB); PG8_STAGE(PG8_SB(0, 1), b2 + hstep, voffB); PG8_STAGE(PG8_SA(0, 0), a2, voffA);
            PG8_WAIT_V(8); PG8_WAIT_L(0); PG8_BAR; PG8_MMA(1, 0, At, B0); PG8_MMA(1, 1, At, B1); PG8_BAR; PG8_SCHED;
            PG8_LDB(B0, 1, 0); PG8_LDB(B1, 1, 1); PG8_SCHED; PG8_LDA(At, 1, 0); PG8_STAGE(PG8_SA(0, 1), a2 + hstep, voffA);
            PG8_WAIT_V(8); PG8_WAIT_L(0); PG8_BAR; PG8_MMA(0, 0, At, B0); PG8_MMA(0, 1, At, B1); PG8_BAR; PG8_SCHED;
            PG8_LDA(At, 1, 1); PG8_STAGE(PG8_SB(1, 0), b3, voffB); PG8_STAGE(PG8_SB(1, 1), b3 + hstep, voffB); PG8_STAGE(PG8_SA(1, 0), a3, voffA);
            PG8_WAIT_V(8); PG8_WAIT_L(0); PG8_BAR; PG8_MMA(1, 0, At, B0); PG8_MMA(1, 1, At, B1); PG8_BAR; PG8_SCHED;
            } else {
            PG8_LDB(B0, 0, 0); PG8_SCHED; PG8_LDA(At, 0, 0); PG8_STAGE(PG8_SA(1, 1), a1 + hstep, voffA);
            PG8_WAIT_L(8); PG8_BAR; PG8_WAIT_L(0); PG8_MMA(0, 0, At, B0); PG8_BAR; PG8_SCHED;
            PG8_LDB(B1, 0, 1); PG8_STAGE(PG8_SB(0, 0), b2, voffB);
            PG8_BAR; PG8_WAIT_L(0); PG8_MMA(0, 1, At, B1); PG8_BAR;
            PG8_LDA(At, 0, 1); PG8_STAGE(PG8_SA(0, 0), a2, voffA);
            PG8_BAR; PG8_WAIT_L(0); PG8_MMA(1, 0, At, B0); PG8_BAR; PG8_SCHED;
            PG8_STAGE(PG8_SB(0, 1), b2 + hstep, voffB);
            PG8_WAIT_V(6); PG8_BAR; PG8_MMA(1, 1, At, B1); PG8_BAR;
            PG8_LDB(B0, 1, 0); PG8_SCHED; PG8_LDA(At, 1, 0); PG8_STAGE(PG8_SA(0, 1), a2 + hstep, voffA);
            PG8_WAIT_L(8); PG8_BAR; PG8_WAIT_L(0); PG8_MMA(0, 0, At, B0); PG8_BAR; PG8_SCHED;
            PG8_LDB(B1, 1, 1); PG8_STAGE(PG8_SB(1, 0), b3, voffB);
            PG8_BAR; PG8_WAIT_L(0); PG8_MMA(0, 1, At, B1); PG8_BAR;
            PG8_LDA(At, 1, 1); PG8_STAGE(PG8_SA(1, 0), a3, voffA);
            PG8_BAR; PG8_WAIT_L(0); PG8_MMA(1, 0, At, B0); PG8_BAR; PG8_SCHED;
            PG8_STAGE(PG8_SB(1, 1), b3 + hstep, voffB);
            PG8_WAIT_V(6); PG8_BAR; PG8_MMA(1, 1, At, B1); PG8_BAR;
            }
        }
        if constexpr (ALIGN_EPI) { if (wr == 0) PG8_BAR; }
        if constexpr (!Epi::AFTER_DRAIN) { E(acc, cur, wr, wc, fr, fq); S.done(cur); }
        if (!has_next) break;
#pragma unroll
        for (int a = 0; a < 2; ++a)
#pragma unroll
            for (int b = 0; b < 2; ++b)
#pragma unroll
                for (int m = 0; m < 4; ++m)
#pragma unroll
                    for (int n = 0; n < 2; ++n) acc[a][b][m][n] = (f32x4){0.f, 0.f, 0.f, 0.f};
        cur = nxt; cA = nA; cB = nB; ++ui;
        if constexpr (ALIGN_EPI) { if (wr == 1) PG8_BAR; }
    }
    PG8_WAIT_V(0);
    if constexpr (!ALIGN_EPI) { if (wr == 0) PG8_BAR; }
    PG8_BAR;
    if constexpr (Epi::AFTER_DRAIN) { E.fused(acc, cur, wr, wc, fr, fq, lds, wid, lane); S.done(cur); }
#undef PG8_SA
#undef PG8_SB
#undef PG8_STAGE
#undef PG8_LDA
#undef PG8_LDB
#undef PG8_MMA
#undef PG8_WAIT_V
#undef PG8_WAIT_L
#undef PG8_BAR
#undef PG8_SCHED
}
}
#define GAS __attribute__((address_space(1)))
#define LAS __attribute__((address_space(3)))
typedef unsigned short bf16;
typedef unsigned v4u __attribute__((ext_vector_type(4)));
typedef float f32x4 __attribute__((ext_vector_type(4)));
typedef short bf16x8 __attribute__((ext_vector_type(8)));
typedef GAS unsigned gu32;
typedef GAS unsigned long long gu64;
#define RLX_AGENT __ATOMIC_RELAXED, __HIP_MEMORY_SCOPE_AGENT
#define LDS_WAIT() asm volatile("s_waitcnt lgkmcnt(0)" ::: "memory")
#define VM_WAIT() asm volatile("s_waitcnt vmcnt(0)" ::: "memory")
__device__ __forceinline__ unsigned long long rt() { return __builtin_amdgcn_s_memrealtime(); }
__device__ __forceinline__ unsigned f2bf(float f) { unsigned u = __builtin_bit_cast(unsigned, f); return (u + 0x7fffu + ((u >> 16) & 1u)) >> 16; }
__device__ __forceinline__ unsigned pk2(float lo, float hi) { return f2bf(lo) | (f2bf(hi) << 16); }

#define XB_TMO      128
#define XB_XCNT(j)  (256  + 64 * (j))
#define XB_XSUB(j)  (1280 + 64 * (j))
#define XB_XGEN(j)  (2304 + 64 * (j))
#define XB_TOP      3328
#define XB_TOPGEN   3392
#define XCD_BAR_WORDS 3456
#define XB_SPIN_CAP (1u << 18)

__device__ __forceinline__ unsigned xb_ld(unsigned* p)              { return __hip_atomic_load(p, __ATOMIC_RELAXED, __HIP_MEMORY_SCOPE_AGENT); }
__device__ __forceinline__ unsigned xb_add(unsigned* p, unsigned v) { return __hip_atomic_fetch_add(p, v, __ATOMIC_RELAXED, __HIP_MEMORY_SCOPE_AGENT); }
__device__ __forceinline__ unsigned xb_xcc_id() { return (unsigned)__builtin_amdgcn_s_getreg((3 << 11) | 20) & 0xFu; }
#define XB_SPIN(cond, bar) do { unsigned _sp = 0; while (cond) { __builtin_amdgcn_s_sleep(1); \
    if ((++_sp & 255u) == 0u) { if (xb_ld(&(bar)[XB_TMO])) break; if (_sp > XB_SPIN_CAP) { atomicAdd(&(bar)[XB_TMO], 1u); break; } } } } while (0)

struct XcdBarrier {
    unsigned* bar; unsigned x;
    volatile LAS unsigned* st;
};

__device__ __forceinline__ XcdBarrier xcd_barrier_post(unsigned* bar, volatile LAS unsigned* st) {
    XcdBarrier b; b.bar = bar; b.x = xb_xcc_id(); b.st = st;
    if (threadIdx.x == 0) (void)xb_add(&bar[XB_XCNT(b.x)], 1u);
    return b;
}
__device__ __forceinline__ void xcd_barrier_complete(unsigned* bar, unsigned x, unsigned& nloc, unsigned& nx) {
    const unsigned G = gridDim.x * gridDim.y * gridDim.z;
    unsigned sum, cnt, mine, sp = 0u;
    for (;;) {
        sum = 0u; cnt = 0u; mine = 0u;
#pragma unroll
        for (unsigned j = 0; j < 16; ++j) { const unsigned c = xb_ld(&bar[XB_XCNT(j)]); sum += c; cnt += (c > 0u) ? 1u : 0u; mine = (j == x) ? c : mine; }
        if (sum == G) break;
        __builtin_amdgcn_s_sleep(1);
        if ((++sp & 255u) == 0u) { if (xb_ld(&bar[XB_TMO])) break; if (sp > XB_SPIN_CAP) { atomicAdd(&bar[XB_TMO], 1u); break; } }
    }
    nloc = mine > 0u ? mine : 1u; nx = cnt > 0u ? cnt : 1u;
}

__device__ __forceinline__ void xcd_barrier(const XcdBarrier& b) {
    asm volatile("s_waitcnt vmcnt(0)" ::: "memory");
    __syncthreads();
    if (threadIdx.x == 0) {
        unsigned* bar = b.bar;
        __builtin_amdgcn_s_waitcnt(0);
        unsigned nloc = b.st[0], nx = b.st[1];
        if (nloc == 0u) { xcd_barrier_complete(bar, b.x, nloc, nx); b.st[0] = nloc; b.st[1] = nx; }
        const unsigned old = xb_add(&bar[XB_XSUB(b.x)], 1u);
        const unsigned gen = old / nloc;
        if (old + 1u == (gen + 1u) * nloc) {
            __builtin_amdgcn_fence(__ATOMIC_RELEASE, "agent");
            asm volatile("s_waitcnt vmcnt(0)" ::: "memory");
            const unsigned og = xb_add(&bar[XB_TOP], 1u);
            const unsigned tg = og / nx;
            if (og + 1u == (tg + 1u) * nx) xb_add(&bar[XB_TOPGEN], 1u);
            else XB_SPIN(xb_ld(&bar[XB_TOPGEN]) == tg, bar);
            __builtin_amdgcn_fence(__ATOMIC_ACQUIRE, "agent");
            xb_add(&bar[XB_XGEN(b.x)], 1u);
            asm volatile("s_waitcnt vmcnt(0)" ::: "memory");
        } else {
            XB_SPIN(xb_ld(&bar[XB_XGEN(b.x)]) == gen, bar);
            __builtin_amdgcn_fence(__ATOMIC_ACQUIRE, "agent");
            asm volatile("s_waitcnt vmcnt(0)" ::: "memory");
        }
    }
    __syncthreads();
}
constexpr int NWAVES = 8, NTHR = 512;
constexpr int SEQ = 8192, DM = 1024, MROWS = 16384;
constexpr size_t MiB = 1u << 20;
constexpr size_t WS_CTL = 0, CTL_ZERO_BYTES = 2 * MiB;
constexpr size_t WS_KSUM = 1 * MiB;
constexpr size_t WS_MOD = 2 * MiB;
constexpr size_t WS_ROPE = 3 * MiB;
constexpr size_t WS_WIN0 = 4 * MiB, WS_WOUT0 = 9 * MiB, WS_WIN1 = 11 * MiB, WS_WOUT1 = 17 * MiB, WS_WQ0 = 19 * MiB, WS_WQ1 = 23 * MiB;
constexpr size_t WS_SUBK = 27 * MiB, WS_GWS = 28 * MiB, WS_MASK = 29 * MiB, WS_SC = 30 * MiB;
constexpr size_t WS_PTU = 32 * MiB, WS_PTV = 96 * MiB;
constexpr size_t WS_HN = 160 * MiB;
constexpr size_t WS_A = 192 * MiB;
constexpr size_t WS_YCAT = 288 * MiB, WS_QP = 320 * MiB, WS_PO = 384 * MiB, WS_PL = 448 * MiB, WS_XB = 450 * MiB, WS_END = 482 * MiB;
constexpr int CW_BAR = 4096, CW_WORK = 16384;

constexpr int RING_BYTES = 131072, LDSCTL_OFF = 143360, MISC_OFF = LDSCTL_OFF + 320, LDS_BYTES = 147456;

#ifndef XCC_EXPR
#define XCC_EXPR ((int)(xb_xcc_id() & 7u))
#endif
#define DI __device__ __forceinline__
typedef short bf16x8 __attribute__((ext_vector_type(8)));
typedef short s16x4 __attribute__((ext_vector_type(4)));
typedef float f32x16 __attribute__((ext_vector_type(16)));
typedef __bf16 bf16x2t __attribute__((ext_vector_type(2)));
#define MFMA32(a, b, c) __builtin_amdgcn_mfma_f32_32x32x16_bf16((a), (b), (c), 0, 0, 0)
using pg8::cvtpk2; using pg8::gelu_tanh;
DI int crow(int reg, int h) { return (reg & 3) + 8 * (reg >> 2) + 4 * h; }
DI float bf_lo(unsigned w) { return __uint_as_float(w << 16); }
DI float bf_hi(unsigned w) { return __uint_as_float(w & 0xffff0000u); }
DI bf16x8 ld16g(const bf16* p) { return *(const bf16x8*)p; }
DI bf16x8 ld8x2g(const bf16* p0, const bf16* p1) { const s16x4 a = *(const s16x4*)p0, b = *(const s16x4*)p1; return __builtin_shufflevector(a, b, 0, 1, 2, 3, 4, 5, 6, 7); }
DI float dot2bf(unsigned a, unsigned b, float c) { return __builtin_amdgcn_fdot2_f32_bf16(__builtin_bit_cast(bf16x2t, a), __builtin_bit_cast(bf16x2t, b), c, false); }
DI int f_ord(float f) { int i = __float_as_int(f); return i ^ ((i >> 31) & 0x7fffffff); }
DI float f_unord(int i) { return __int_as_float(i ^ ((i >> 31) & 0x7fffffff)); }
constexpr float LOG2E = 1.4426950408889634f, LN2 = 0.6931471805599453f;
#define KEY_MIN ((int)0x80000000)


template <int CTRL> DI float dppf(float x) { return __builtin_bit_cast(float, __builtin_amdgcn_update_dpp(0, __builtin_bit_cast(int, x), CTRL, 0xF, 0xF, true)); }
template <int CTRL> DI int dppi(int x) { return __builtin_amdgcn_update_dpp(0, x, CTRL, 0xF, 0xF, true); }
#define DPP_X1 0xB1
#define DPP_X2 0x4E
#define DPP_HM 0x141
#define DPP_RM 0x140
#define DPP_R8 0x128
DI unsigned px32u(unsigned x, int lane) { auto r = __builtin_amdgcn_permlane32_swap(x, x, false, false); return (lane & 32) ? r[0] : r[1]; }
DI float px32(float x, int lane) { return __uint_as_float(px32u(__float_as_uint(x), lane)); }
DI int px32(int x, int lane) { return (int)px32u((unsigned)x, lane); }
DI unsigned px16u(unsigned x, int lane) { auto r = __builtin_amdgcn_permlane16_swap(x, x, false, false); return (lane & 16) ? r[0] : r[1]; }
DI float px16(float x, int lane) { return __uint_as_float(px16u(__float_as_uint(x), lane)); }
DI float sum32(float x) { auto r = __builtin_amdgcn_permlane32_swap(__float_as_uint(x), __float_as_uint(x), false, false); return __uint_as_float(r[0]) + __uint_as_float(r[1]); }
DI float sum16(float x) { auto r = __builtin_amdgcn_permlane16_swap(__float_as_uint(x), __float_as_uint(x), false, false); return __uint_as_float(r[0]) + __uint_as_float(r[1]); }
DI float row_sum16(float v) { v += dppf<DPP_X1>(v); v += dppf<DPP_X2>(v); v += dppf<DPP_HM>(v); v += dppf<DPP_RM>(v); return v; }
DI float wave_sum(float v) { return sum32(sum16(row_sum16(v))); }
DI float wave_max(float v) { v = fmaxf(v, dppf<DPP_X1>(v)); v = fmaxf(v, dppf<DPP_X2>(v)); v = fmaxf(v, dppf<DPP_HM>(v)); v = fmaxf(v, dppf<DPP_RM>(v));
    { auto r = __builtin_amdgcn_permlane16_swap(__float_as_uint(v), __float_as_uint(v), false, false); v = fmaxf(__uint_as_float(r[0]), __uint_as_float(r[1])); }
    { auto r = __builtin_amdgcn_permlane32_swap(__float_as_uint(v), __float_as_uint(v), false, false); v = fmaxf(__uint_as_float(r[0]), __uint_as_float(r[1])); } return v; }

struct Frame {
    LAS unsigned char* lds; volatile LAS unsigned* MISC; gu32* ctl; int tid, lane, wave, G, gw, NGW;
};

struct MapId { DI int operator()(int n) const { return n; } };
struct MapWin0 { DI int operator()(int n) const {
    if (n < 1024) return n;
    const int t = (n - 1024) >> 9, c = (n - 1024) & 511, hd = c >> 6, d = c & 63; int bj, p;
    if (t < 2) { if (d < 16) { const int nn = d >> 3, rr = d & 7; bj = 0; p = 8 * (rr >> 2) + 4 * nn + (rr & 3); } else if (d < 32) { bj = 0; p = d; } else { bj = 1; p = d - 32; } }
    else { bj = d >> 5; p = d & 31; }
    return 1024 + 512 * t + 256 * (hd >> 2) + 128 * bj + 32 * (hd & 3) + p; } };
struct MapWin1 { DI int operator()(int n) const { const int t = n >> 10, c = n & 1023, hd = c >> 6, d = c & 63; return 1024 * t + 256 * (hd >> 2) + 128 * (d >> 5) + 32 * (hd & 3) + (d & 31); } };
template <class Map> DI void p0_transpose_item(const float* W, int K, int N, bf16* WT, LAS float* scr, int item, int lane, Map map) {
    const int nblk = N / 32, kb = item / nblk, nb = item % nblk, k0 = 64 * kb, n0 = 32 * nb;
#pragma unroll 8
    for (int i = 0; i < 32; ++i) { const int kk = 2 * i + (lane >> 5); scr[kk * 33 + (lane & 31)] = W[(size_t)(k0 + kk) * N + n0 + (lane & 31)]; }
    LDS_WAIT(); asm volatile("" ::: "memory");
    const int c = lane & 7;
#pragma unroll
    for (int j = 0; j < 4; ++j) { const int n = (lane >> 3) + 8 * j; const LAS float* s = scr + (8 * c) * 33 + n;
        v4u o; o.x = pk2(s[0 * 33], s[1 * 33]); o.y = pk2(s[2 * 33], s[3 * 33]); o.z = pk2(s[4 * 33], s[5 * 33]); o.w = pk2(s[6 * 33], s[7 * 33]);
        *(GAS v4u*)(WT + (size_t)map(n0 + n) * K + k0 + 8 * c) = o; }
    LDS_WAIT(); asm volatile("" ::: "memory");
}
struct P0Args { const float *c, *w_mod, *b_mod, *win0, *wout0, *win1, *wout1, *wq, *subk, *pu, *pv, *gws;
                float *MOD, *ROPE; bf16 *WIN0, *WOUT0, *WIN1, *WOUT1, *WQ0, *WQ1, *SUBK, *GWS; unsigned char *U8, *V8s; float *USC, *VSC; };
DI void p0_prologue(const Frame& F, const P0Args& A) {
    { LAS float* scr = (LAS float*)F.lds;
      for (int task = blockIdx.x; task < 192; task += F.G) {
          const int l = task / 96, n0 = (task % 96) * 64; const float* W = A.w_mod + (size_t)l * 1024 * 6144;
          float a0 = 0.f, a1 = 0.f; const int k0 = F.wave * 128;
#pragma unroll 1
          for (int kb = k0; kb < k0 + 128; kb += 32) { float w[32];
#pragma unroll
              for (int i = 0; i < 32; ++i) w[i] = W[(size_t)(kb + i) * 6144 + n0 + F.lane];
#pragma unroll
              for (int i = 0; i < 32; ++i) { const float c0 = A.c[kb + i], c1 = A.c[1024 + kb + i]; const float s0 = c0 / (1.f + __expf(-c0)), s1 = c1 / (1.f + __expf(-c1)); a0 += s0 * w[i]; a1 += s1 * w[i]; } }
          scr[(F.wave * 2 + 0) * 64 + F.lane] = a0; scr[(F.wave * 2 + 1) * 64 + F.lane] = a1;
          __syncthreads();
          if (F.tid < 128) { const int b = F.tid >> 6, n = F.tid & 63; float s = 0.f;
#pragma unroll
              for (int w = 0; w < 8; ++w) s += scr[(w * 2 + b) * 64 + n];
              A.MOD[(size_t)(l * 2 + b) * 6144 + n0 + n] = s + A.b_mod[l * 6144 + n0 + n]; }
          __syncthreads();
      } }
    { LAS float* scr = (LAS float*)(F.lds + F.wave * 16384);
      constexpr int I0 = 16 * 80, I1 = 16 * 32, I2 = 16 * 96, I3 = 16 * 32, I4 = 16 * 64, I5 = 16 * 64, NIT = I0 + I1 + I2 + I3 + I4 + I5;
      for (int it = F.gw; it < NIT; it += F.NGW) { int r = it;
          if (r < I0) { p0_transpose_item(A.win0, 1024, 2560, A.WIN0, scr, r, F.lane, MapId()); continue; } r -= I0;
          if (r < I1) { p0_transpose_item(A.wout0, 1024, 1024, A.WOUT0, scr, r, F.lane, MapId()); continue; } r -= I1;
          if (r < I2) { p0_transpose_item(A.win1, 1024, 3072, A.WIN1, scr, r, F.lane, MapId()); continue; } r -= I2;
          if (r < I3) { p0_transpose_item(A.wout1, 1024, 1024, A.WOUT1, scr, r, F.lane, MapId()); continue; } r -= I3;
          if (r < I4) { p0_transpose_item(A.wq, 1024, 2048, A.WQ0, scr, r, F.lane, MapId()); continue; } r -= I4;
          p0_transpose_item(A.wq + (size_t)1024 * 2048, 1024, 2048, A.WQ1, scr, r, F.lane, MapId()); } }
    for (int row0 = F.gw; row0 < 65536; row0 += 4 * F.NGW) {
        f32x4 v[4][4];
#pragma unroll
        for (int q = 0; q < 4; ++q) { const int row = row0 + q * F.NGW; const bool isv = row >= 32768; const int rr = row & 32767; const float* src = (isv ? A.pv : A.pu) + (size_t)rr * 1024;
#pragma unroll
            for (int k = 0; k < 4; ++k) v[q][k] = *(const f32x4*)(src + 4 * F.lane + 256 * k); }
#pragma unroll
        for (int q = 0; q < 4; ++q) { const int row = row0 + q * F.NGW; const bool isv = row >= 32768; const int rr = row & 32767; float mx = 0.f;
#pragma unroll
            for (int k = 0; k < 4; ++k) mx = fmaxf(mx, fmaxf(fmaxf(fabsf(v[q][k][0]), fabsf(v[q][k][1])), fmaxf(fabsf(v[q][k][2]), fabsf(v[q][k][3]))));
            mx = wave_max(mx);
            const float sc = mx > 0.f ? 127.0f / mx : 1.0f, inv = mx > 0.f ? mx * (1.0f / 127.0f) : 1.0f;
#pragma unroll
            for (int k = 0; k < 4; ++k) { const int q0 = __float2int_rn(v[q][k][0] * sc), q1 = __float2int_rn(v[q][k][1] * sc), q2 = __float2int_rn(v[q][k][2] * sc), q3 = __float2int_rn(v[q][k][3] * sc);
                const unsigned w = (unsigned)(q0 & 255) | ((unsigned)(q1 & 255) << 8) | ((unsigned)(q2 & 255) << 16) | ((unsigned)(q3 & 255) << 24);
                if (!isv) *(unsigned*)(A.U8 + (size_t)rr * 1024 + 4 * F.lane + 256 * k) = w;
                else { const int l = rr >> 14, e = rr & 16383, slab = 2 * k + (F.lane >> 5); *(unsigned*)(A.V8s + (((size_t)l * 8 + slab) * 16384 + e) * 128 + 4 * (F.lane & 31)) = w; } }
            if (F.lane == 0) (isv ? A.VSC : A.USC)[rr] = inv; } }
    { const size_t gt = (size_t)F.gw * 64 + F.lane, NT = (size_t)F.NGW * 64;
      for (size_t i = gt; i < 524288 / 8; i += NT) { const float* src = A.subk + i * 8; const f32x4 a = *(const f32x4*)src, b = *(const f32x4*)(src + 4); v4u o; o.x = cvtpk2(a[0], a[1]); o.y = cvtpk2(a[2], a[3]); o.z = cvtpk2(b[0], b[1]); o.w = cvtpk2(b[2], b[3]);
          *(v4u*)(A.SUBK + i * 8) = o; }
      for (size_t i = gt; i < 65536; i += NT) { const int t = (int)(i >> 7) & 127, s = (int)i & 127; A.GWS[i] = (bf16)(cvtpk2(s <= t ? A.gws[i] : 0.f, 0.f) & 0xffffu); }
      for (size_t i = gt; i < 65536; i += NT) { const int pos = (int)(i >> 3), fi = (int)i & 7; const float inv = powf(500000.0f, -(float)fi / 8.0f); const float ang = (float)pos * inv; float sn, cs; sincosf(ang, &sn, &cs);
          A.ROPE[(size_t)pos * 16 + fi] = cs; A.ROPE[(size_t)pos * 16 + 8 + fi] = sn; } }
}

template <bool XIN_F32> DI void norm_rows(const Frame& F, const void* xs_, const float* gamma, const float* modl, int shi, int sci, bf16* HN, unsigned char* HQ = nullptr, float* HS = nullptr) {
    for (int m0 = F.gw; m0 < MROWS; m0 += 2 * F.NGW) {
        f32x4 v[2][4]; float s[2];
#pragma unroll
        for (int q = 0; q < 2; ++q) { const int m = m0 + q * F.NGW;
            if (XIN_F32) { const f32x4* xr = (const f32x4*)((const float*)xs_ + (size_t)m * 1024) + F.lane;
#pragma unroll
                for (int j = 0; j < 4; ++j) v[q][j] = xr[64 * j]; }
            else { const unsigned long long* xr = (const unsigned long long*)((const bf16*)xs_ + (size_t)m * 1024) + F.lane;
#pragma unroll
                for (int j = 0; j < 4; ++j) { const unsigned long long w = xr[64 * j]; const unsigned lo = (unsigned)w, hi = (unsigned)(w >> 32); v[q][j] = (f32x4){bf_lo(lo), bf_hi(lo), bf_lo(hi), bf_hi(hi)}; } } }
#pragma unroll
        for (int q = 0; q < 2; ++q) { float a = 0.f;
#pragma unroll
            for (int j = 0; j < 4; ++j) a += (v[q][j][0] * v[q][j][0] + v[q][j][1] * v[q][j][1]) + (v[q][j][2] * v[q][j][2] + v[q][j][3] * v[q][j][3]);
            s[q] = a; }
#pragma unroll
        for (int q = 0; q < 2; ++q) { const int m = m0 + q * F.NGW; const int b = m >> 13;
            const float rinv = rsqrtf(wave_sum(s[q]) * (1.0f / 1024.0f) + 1e-6f);
            unsigned long long* o8 = (unsigned long long*)(HN + (size_t)m * 1024) + F.lane; float mx = 0.f;
#pragma unroll
            for (int j = 0; j < 4; ++j) { const int col = 4 * F.lane + 256 * j; const f32x4 gm = *(const f32x4*)(gamma + col), sc = *(const f32x4*)(modl + b * 6144 + sci * 1024 + col), sh = *(const f32x4*)(modl + b * 6144 + shi * 1024 + col);
                const f32x4 o = v[q][j] * rinv * gm * (sc + 1.0f) + sh; v[q][j] = o; mx = fmaxf(mx, fmaxf(fmaxf(fabsf(o[0]), fabsf(o[1])), fmaxf(fabsf(o[2]), fabsf(o[3]))));
                o8[64 * j] = (unsigned long long)cvtpk2(o[0], o[1]) | ((unsigned long long)cvtpk2(o[2], o[3]) << 32); }
            if (HQ) { mx = wave_max(mx); const float qs = mx > 0.f ? 127.0f / mx : 1.0f;
#pragma unroll
                for (int j = 0; j < 4; ++j) { const int q0 = __float2int_rn(v[q][j][0] * qs), q1 = __float2int_rn(v[q][j][1] * qs), q2 = __float2int_rn(v[q][j][2] * qs), q3 = __float2int_rn(v[q][j][3] * qs);
                    *(unsigned*)(HQ + (size_t)m * 1024 + 4 * F.lane + 256 * j) = (unsigned)(q0 & 255) | ((unsigned)(q1 & 255) << 8) | ((unsigned)(q2 & 255) << 16) | ((unsigned)(q3 & 255) << 24); }
                if (F.lane == 0) HS[m] = mx > 0.f ? mx * (1.0f / 127.0f) : 1.0f; } }
    }
}

DI void qk_post_task(int task, const bf16* QKR, bf16* Q0, bf16* K0, float* KSUM, const float* rope, const float* gq, const float* gk, LAS float* scr, int tid, int wave, int lane) {
    const int tb = task >> 2, cq = task & 3; const bool isk = cq >= 2; const int head0 = (cq & 1) * 4, hl = (lane >> 2) & 3, qt = lane & 3, rsub = lane >> 4;
    const float* g = (isk ? gk : gq) + qt * 16; float gv[16];
#pragma unroll
    for (int i = 0; i < 16; ++i) gv[i] = g[i];
    float ks[16];
#pragma unroll
    for (int i = 0; i < 16; ++i) ks[i] = 0.f;
    const int b = tb >> 5; bf16* dstb = (isk ? K0 : Q0) + (size_t)(b * 8 + head0 + hl) * SEQ * 64 + qt * 16;
    v4u wq0[8], wq1[8];
#pragma unroll
    for (int it = 0; it < 8; ++it) { const int row = tb * 256 + wave * 32 + it * 4 + rsub; const bf16* src = QKR + (size_t)row * 1024 + cq * 256 + hl * 64 + qt * 16; wq0[it] = *(const v4u*)src; wq1[it] = *(const v4u*)(src + 8); }
#pragma unroll
    for (int it = 0; it < 8; ++it) { const int row = tb * 256 + wave * 32 + it * 4 + rsub, s = row & (SEQ - 1);
        const v4u w0 = wq0[it], w1 = wq1[it];
        float y[16]; y[0] = bf_lo(w0.x); y[1] = bf_hi(w0.x); y[2] = bf_lo(w0.y); y[3] = bf_hi(w0.y); y[4] = bf_lo(w0.z); y[5] = bf_hi(w0.z); y[6] = bf_lo(w0.w); y[7] = bf_hi(w0.w);
        y[8] = bf_lo(w1.x); y[9] = bf_hi(w1.x); y[10] = bf_lo(w1.y); y[11] = bf_hi(w1.y); y[12] = bf_lo(w1.z); y[13] = bf_hi(w1.z); y[14] = bf_lo(w1.w); y[15] = bf_hi(w1.w);
        float ss = 0.f;
#pragma unroll
        for (int i = 0; i < 16; ++i) ss += y[i] * y[i];
        ss += dppf<DPP_X1>(ss); ss += dppf<DPP_X2>(ss);
        const float rinv = rsqrtf(ss * (1.0f / 64.0f) + 1e-6f);
#pragma unroll
        for (int i = 0; i < 16; ++i) y[i] = y[i] * rinv * gv[i];
        if (qt == 0) { const float* rp = rope + (size_t)s * 16;
#pragma unroll
            for (int i = 0; i < 8; ++i) { const float c = rp[i], sn = rp[8 + i], x1 = y[i], x2 = y[i + 8]; y[i] = x1 * c - x2 * sn; y[i + 8] = x1 * sn + x2 * c; } }
        v4u o0, o1; o0.x = cvtpk2(y[0], y[1]); o0.y = cvtpk2(y[2], y[3]); o0.z = cvtpk2(y[4], y[5]); o0.w = cvtpk2(y[6], y[7]); o1.x = cvtpk2(y[8], y[9]); o1.y = cvtpk2(y[10], y[11]); o1.z = cvtpk2(y[12], y[13]); o1.w = cvtpk2(y[14], y[15]);
        bf16* d = dstb + (size_t)s * 64; *(v4u*)d = o0; *(v4u*)(d + 8) = o1;
#pragma unroll
        for (int i = 0; i < 16; ++i) ks[i] += y[i];
    }
    if (isk) {
#pragma unroll
        for (int i = 0; i < 16; ++i) { ks[i] = sum32(sum16(ks[i])); }
        if (lane < 16) {
#pragma unroll
            for (int i = 0; i < 16; ++i) scr[(wave * 16 + lane) * 16 + i] = ks[i]; }
        __syncthreads();
        if (tid < 256) { const int l16 = tid >> 4, i = tid & 15; float sum = 0.f;
#pragma unroll
            for (int w = 0; w < 8; ++w) sum += scr[(w * 16 + l16) * 16 + i];
            KSUM[((size_t)(b * 8 + head0 + (l16 >> 2)) * 32 + (tb & 31)) * 64 + (l16 & 3) * 16 + i] = sum; }
        __syncthreads();
    }
}

DI f32x16 qk_tile(const bf16* krow, const bf16x8 (&qf)[4]) {
    f32x16 s;
#pragma unroll
    for (int i = 0; i < 16; ++i) s[i] = 0.f;
#pragma unroll
    for (int ks = 0; ks < 4; ++ks) s = MFMA32(ld16g(krow + 16 * ks), qf[ks], s);
    return s;
}
DI bf16x8 pack8(const f32x16& x, int s) { v4u p; p.x = cvtpk2(x[8 * s], x[8 * s + 1]); p.y = cvtpk2(x[8 * s + 2], x[8 * s + 3]); p.z = cvtpk2(x[8 * s + 4], x[8 * s + 5]); p.w = cvtpk2(x[8 * s + 6], x[8 * s + 7]); return __builtin_bit_cast(bf16x8, p); }
DI void pv_tile(f32x16 (&o)[2], const bf16* vt, const f32x16& p) {
#pragma unroll
    for (int s = 0; s < 2; ++s) { const bf16x8 pb = pack8(p, s);
#pragma unroll
        for (int mt = 0; mt < 2; ++mt) { const bf16* v = vt + (size_t)mt * 32 * SEQ + 16 * s; o[mt] = MFMA32(ld8x2g(v, v + 8), pb, o[mt]); } }
}
DI void store_ot(bf16* dst, const f32x16 (&o)[2], float sc, int h) {
#pragma unroll
    for (int mt = 0; mt < 2; ++mt)
#pragma unroll
        for (int g = 0; g < 4; ++g) { const unsigned lo = cvtpk2(o[mt][4 * g] * sc, o[mt][4 * g + 1] * sc), hi = cvtpk2(o[mt][4 * g + 2] * sc, o[mt][4 * g + 3] * sc);
            *(unsigned long long*)(dst + 32 * mt + 8 * g + 4 * h) = (unsigned long long)lo | ((unsigned long long)hi << 32); }
}
DI void moba_keys(const bf16* Kh, const bf16* VTh, const bf16x8 (&qf)[4], int key0, int nt, int diag, float mc2, f32x16 (&o)[2], float& l, int r, int h) {
    for (int kt = 0; kt < nt; ++kt) { const int kb = key0 + 32 * kt;
        f32x16 s = qk_tile(Kh + (size_t)(kb + r) * 64 + 8 * h, qf);
        float ls = 0.f;
#pragma unroll
        for (int i = 0; i < 16; ++i) { float p = __builtin_amdgcn_exp2f(s[i] * (0.125f * LOG2E) - mc2); if (kt == diag && crow(i, h) > r) p = 0.f; s[i] = p; ls += p; }
        l += ls;
        pv_tile(o, VTh + (size_t)r * SEQ + kb + 4 * h, s);
    }
}
DI float moba_mc2(const float* gq, const float* gk, int lane) {
    float a = fabsf(gq[lane]), b = fabsf(gk[lane]);
    a = wave_max(a); b = wave_max(b);
    return 8.0f * a * b * LOG2E;
}
struct MobaT { const bf16 *Q, *K, *VT; const float* ksum; unsigned* masks; bf16* PO; float* PL; const float *gq, *gk; };
DI void moba_mask_unit(int u, const MobaT& T, int lane) {
    const int bh = u >> 8, t0 = (u & 255) * 32, own = t0 >> 8, r = lane & 31, h = lane >> 5;
    unsigned mask = 0u;
    if (own > 0) {
        f32x16 g;
#pragma unroll
        for (int i = 0; i < 16; ++i) g[i] = 0.f;
        const float* km = T.ksum + ((size_t)bh * 32 + r) * 64 + 8 * h; const bf16* qp = T.Q + ((size_t)bh * SEQ + t0 + r) * 64 + 8 * h;
#pragma unroll
        for (int ks = 0; ks < 4; ++ks) { const f32x4 a0 = *(const f32x4*)(km + 16 * ks) * (1.0f / 256.0f), a1 = *(const f32x4*)(km + 16 * ks + 4) * (1.0f / 256.0f);
            v4u aw; aw.x = cvtpk2(a0[0], a0[1]); aw.y = cvtpk2(a0[2], a0[3]); aw.z = cvtpk2(a1[0], a1[1]); aw.w = cvtpk2(a1[2], a1[3]);
            g = MFMA32(__builtin_bit_cast(bf16x8, aw), ld16g(qp + 16 * ks), g); }
        int ka = KEY_MIN, kb2 = KEY_MIN, kc = KEY_MIN;
#define INS3(x_) do { int x = (x_); int t = min(ka, x); ka = max(ka, x); int uu = min(kb2, t); kb2 = max(kb2, t); kc = max(kc, uu); } while (0)
#pragma unroll
        for (int i = 0; i < 16; ++i) { const int blk = crow(i, h); const int key = (blk < own) ? ((f_ord(g[i]) & ~31) | (31 - blk)) : KEY_MIN; INS3(key); }
        const int pa = px32(ka, lane), pb = px32(kb2, lane), pc = px32(kc, lane);
        INS3(pa); INS3(pb); INS3(pc);
#undef INS3
        if (ka != KEY_MIN) mask |= 1u << (31 - (ka & 31));
        if (kb2 != KEY_MIN) mask |= 1u << (31 - (kb2 & 31));
        if (kc != KEY_MIN) mask |= 1u << (31 - (kc & 31));
    }
    if (h == 0) T.masks[(size_t)bh * SEQ + t0 + r] = mask;
}
DI void moba_own_unit(int u, const MobaT& T, float mc2, int lane) {
    const int bh = u >> 8, t0 = (u & 255) * 32, own = t0 >> 8, r = lane & 31, h = lane >> 5;
    const bf16* qp = T.Q + ((size_t)bh * SEQ + t0 + r) * 64 + 8 * h; bf16x8 qf[4];
#pragma unroll
    for (int ks = 0; ks < 4; ++ks) qf[ks] = ld16g(qp + 16 * ks);
    f32x16 o[2];
#pragma unroll
    for (int i = 0; i < 16; ++i) { o[0][i] = 0.f; o[1][i] = 0.f; }
    float l = 0.f; const int key0 = own * 256, nt = ((t0 - key0) >> 5) + 1;
    moba_keys(T.K + (size_t)bh * SEQ * 64, T.VT + (size_t)bh * 64 * SEQ, qf, key0, nt, nt - 1, mc2, o, l, r, h);
    l = sum32(l);
    const size_t base = ((size_t)bh * SEQ + t0 + r) * 4 + 3;
    store_ot(T.PO + base * 64, o, 1.0f, h); if (h == 0) T.PL[base] = l;
}
constexpr int MS_K = 0, MS_V = 32768, MS_VROW = 520, MS_LIST = 32768 + 64 * 520, MS_CNT = MS_LIST + 8192, MOBA_NSEL = 16 * 79, MOBA_NTASK = MOBA_NSEL + 512;
DI void moba_sel_task(int task, const MobaT& T, LAS unsigned char* lds, float mc2, int tid, int wave, int lane) {
    const bool own = task >= MOBA_NSEL;
    int p = 0, rem = own ? 0 : task; if (own) {} else if (rem < 128) p = 0; else if (rem < 384) { p = 1; rem -= 128; } else if (rem < 768) { p = 2; rem -= 384; } else { p = 3; rem -= 768; }
    const int j = own ? ((task - MOBA_NSEL) >> 4) : (rem >> 4), bh = own ? ((task - MOBA_NSEL) & 15) : (rem & 15);
    LAS unsigned* list = (LAS unsigned*)(lds + MS_LIST); LAS unsigned* cntp = (LAS unsigned*)(lds + MS_CNT);
    { const bf16* Kg = T.K + ((size_t)bh * SEQ + 256 * j) * 64; const bf16* Vg = T.VT + (size_t)bh * 64 * SEQ + 256 * j;
      v4u kv[4], vv[4];
#pragma unroll
      for (int i = 0; i < 4; ++i) { const int c = tid + 512 * i; kv[i] = *(const v4u*)(Kg + (size_t)c * 8); const int d = c >> 5, cc = c & 31; vv[i] = *(const v4u*)(Vg + (size_t)d * SEQ + cc * 8); }
      if (tid == 0) *cntp = 0u;
#pragma unroll
      for (int i = 0; i < 4; ++i) { const int c = tid + 512 * i; const int k = c >> 3, ch = c & 7; *(LAS v4u*)(lds + MS_K + k * 128 + ((ch ^ ((k >> 1) & 7)) << 4)) = kv[i];
          const int d = c >> 5, cc = c & 31; LAS unsigned char* vp = lds + MS_V + d * MS_VROW + cc * 16; *(LAS unsigned long long*)vp = (unsigned long long)vv[i].x | ((unsigned long long)vv[i].y << 32); *(LAS unsigned long long*)(vp + 8) = (unsigned long long)vv[i].z | ((unsigned long long)vv[i].w << 32); } }
    __syncthreads();
    if (!own) { const int qlo = 256 * (8 * p + 1), qhi = (8 * p + 9) * 256 < SEQ ? (8 * p + 9) * 256 : SEQ;
      for (int t0 = qlo + wave * 64; t0 < qhi; t0 += 512) { const int t = t0 + lane; const unsigned mk = T.masks[(size_t)bh * SEQ + t]; const bool sel = (mk >> j) & 1u;
          const unsigned long long bal = __ballot(sel); const int nb = __builtin_popcountll(bal);
          unsigned base = 0; if (lane == 0 && nb) base = __hip_atomic_fetch_add(cntp, (unsigned)nb, __ATOMIC_RELAXED, __HIP_MEMORY_SCOPE_WORKGROUP); base = (unsigned)__builtin_amdgcn_readfirstlane((int)base);
          if (sel) list[base + __builtin_popcountll(bal & ((1ull << lane) - 1ull))] = (unsigned)t; } }
    __syncthreads();
    const int n = own ? 256 : (int)*cntp; const int r = lane & 31, h = lane >> 5;
    const LAS unsigned char* kb = lds + MS_K; const LAS unsigned char* vb = lds + MS_V;
    for (int b0 = wave * 32; b0 < n; b0 += 256) { const bool valid = b0 + r < n; const int t = own ? (256 * j + b0 + r) : (int)list[valid ? b0 + r : b0];
        const unsigned mk = own ? 0u : T.masks[(size_t)bh * SEQ + t]; const int slot = own ? 3 : __builtin_popcount(mk & ((1u << j) - 1u));
        const int ntile = own ? (wave + 1) : 8;
        const bf16* qp = T.Q + ((size_t)bh * SEQ + t) * 64 + 8 * h; bf16x8 qf[4];
#pragma unroll
        for (int ks = 0; ks < 4; ++ks) qf[ks] = ld16g(qp + 16 * ks);
        f32x16 o[2];
#pragma unroll
        for (int i = 0; i < 16; ++i) { o[0][i] = 0.f; o[1][i] = 0.f; }
        float l = 0.f;
#pragma unroll 1
        for (int kt = 0; kt < ntile; ++kt) { const int key = 32 * kt + r; const bool dg = own && kt == wave;
            f32x16 s;
#pragma unroll
            for (int i = 0; i < 16; ++i) s[i] = 0.f;
#pragma unroll
            for (int ks = 0; ks < 4; ++ks) s = MFMA32(*(const LAS bf16x8*)(kb + key * 128 + (((2 * ks + h) ^ ((key >> 1) & 7)) << 4)), qf[ks], s);
            float ls = 0.f;
#pragma unroll
            for (int i = 0; i < 16; ++i) { float pv = __builtin_amdgcn_exp2f(s[i] * (0.125f * LOG2E) - mc2); if (dg && crow(i, h) > r) pv = 0.f; s[i] = pv; ls += pv; }
            l += ls;
#pragma unroll
            for (int sx = 0; sx < 2; ++sx) { const bf16x8 pb = pack8(s, sx);
#pragma unroll
                for (int mt = 0; mt < 2; ++mt) { const LAS unsigned char* vp = vb + (32 * mt + r) * MS_VROW + (32 * kt + 16 * sx + 4 * h) * 2;
                    const s16x4 a0 = *(const LAS s16x4*)vp, a1 = *(const LAS s16x4*)(vp + 16); o[mt] = MFMA32(__builtin_shufflevector(a0, a1, 0, 1, 2, 3, 4, 5, 6, 7), pb, o[mt]); } }
        }
        l = sum32(l);
        if (valid) { const size_t base = ((size_t)bh * SEQ + t) * 4 + slot; store_ot(T.PO + base * 64, o, 1.0f, h); if (h == 0) T.PL[base] = l; }
    }
    __syncthreads();
}
DI void moba_combine(const Frame& F, const bf16* PO, const float* PL, bf16* YCAT) {
    const size_t gt = (size_t)F.gw * 64 + F.lane, NT = (size_t)F.NGW * 64;
    for (size_t i0 = gt; i0 < (size_t)16 * SEQ * 8; i0 += 2 * NT) {
        v4u w[2][4]; float pl[2][4];
#pragma unroll
        for (int q = 0; q < 2; ++q) { const size_t i = i0 + q * NT; const int dq = (int)i & 7, t = (int)(i >> 3) & (SEQ - 1), bh = (int)(i >> 16); const int own = t >> 8, ns = own < 3 ? own : 3;
#pragma unroll
            for (int s = 0; s < 4; ++s) { if (s < ns || s == 3) { const size_t base = ((size_t)bh * SEQ + t) * 4 + s; pl[q][s] = PL[base]; w[q][s] = *(const v4u*)(PO + base * 64 + dq * 8); } else { pl[q][s] = 0.f; w[q][s] = (v4u){0u, 0u, 0u, 0u}; } } }
#pragma unroll
        for (int q = 0; q < 2; ++q) { const size_t i = i0 + q * NT; const int dq = (int)i & 7, t = (int)(i >> 3) & (SEQ - 1), bh = (int)(i >> 16);
            float o[8]; float l = 0.f;
#pragma unroll
            for (int k = 0; k < 8; ++k) o[k] = 0.f;
#pragma unroll
            for (int s = 0; s < 4; ++s) { l += pl[q][s]; const v4u ww = w[q][s];
                o[0] += bf_lo(ww.x); o[1] += bf_hi(ww.x); o[2] += bf_lo(ww.y); o[3] += bf_hi(ww.y); o[4] += bf_lo(ww.z); o[5] += bf_hi(ww.z); o[6] += bf_lo(ww.w); o[7] += bf_hi(ww.w); }
            const float il = 1.0f / l; v4u ow; ow.x = cvtpk2(o[0] * il, o[1] * il); ow.y = cvtpk2(o[2] * il, o[3] * il); ow.z = cvtpk2(o[4] * il, o[5] * il); ow.w = cvtpk2(o[6] * il, o[7] * il);
            *(v4u*)(YCAT + ((size_t)(bh >> 3) * SEQ + t) * 1024 + 512 + (bh & 7) * 64 + dq * 8) = ow; } }
}

DI void gmlp_unit(int unit, const bf16* UA, const bf16* VA, const float* vgain, const bf16* GWS, const float* bs, bf16* YCAT, LAS unsigned char* lds, int tid, int wave, int lane) {
    const int cidx = unit >> 2, g = unit & 3, row0 = cidx * 128; LAS bf16* VNT = (LAS bf16*)lds;
    { const int row = tid >> 2, dq = (tid & 3) * 32; const bf16* src = VA + (size_t)(row0 + row) * 512 + g * 128 + dq;
      float f[32]; float ss = 0.f;
#pragma unroll
      for (int k = 0; k < 4; ++k) { const v4u w = *(const v4u*)(src + 8 * k); f[8 * k] = bf_lo(w.x); f[8 * k + 1] = bf_hi(w.x); f[8 * k + 2] = bf_lo(w.y); f[8 * k + 3] = bf_hi(w.y); f[8 * k + 4] = bf_lo(w.z); f[8 * k + 5] = bf_hi(w.z); f[8 * k + 6] = bf_lo(w.w); f[8 * k + 7] = bf_hi(w.w); }
#pragma unroll
      for (int k = 0; k < 32; ++k) ss += f[k] * f[k];
      ss += dppf<DPP_X1>(ss); ss += dppf<DPP_X2>(ss);
      const float rinv = rsqrtf(ss * (1.0f / 128.0f) + 1e-6f);
#pragma unroll
      for (int k = 0; k < 32; ++k) VNT[(dq + k) * 136 + row] = (bf16)(cvtpk2(f[k] * rinv * vgain[g * 128 + dq + k], 0.f) & 0xffffu); }
    __syncthreads();
    { const int mt = wave >> 1, ntb = (wave & 1) * 2, r = lane & 31, h = lane >> 5;
      f32x16 acc[2];
#pragma unroll
      for (int i = 0; i < 16; ++i) { acc[0][i] = 0.f; acc[1][i] = 0.f; }
      const bf16* wp = GWS + ((size_t)g * 128 + 32 * mt + r) * 128 + 8 * h;
      bf16x8 af[8];
#pragma unroll
      for (int ks = 0; ks < 8; ++ks) af[ks] = ld16g(wp + 16 * ks);
#pragma unroll
      for (int ks = 0; ks < 8; ++ks) { if (ks >= 2 * (mt + 1)) break; const bf16x8 a = af[ks];
#pragma unroll
          for (int nn = 0; nn < 2; ++nn) { const bf16x8 b = *(const LAS bf16x8*)(VNT + (32 * (ntb + nn) + r) * 136 + 16 * ks + 8 * h); acc[nn] = MFMA32(a, b, acc[nn]); } }
#pragma unroll
      for (int nn = 0; nn < 2; ++nn)
#pragma unroll
          for (int i = 0; i < 16; ++i) { const int t = 32 * mt + crow(i, h), d = 32 * (ntb + nn) + r; const float mixed = acc[nn][i] + bs[g * 128 + t];
              const float uv = __uint_as_float((unsigned)UA[(size_t)(row0 + t) * 512 + g * 128 + d] << 16);
              YCAT[(size_t)(row0 + t) * 1024 + g * 128 + d] = (bf16)(cvtpk2(uv * mixed, 0.f) & 0xffffu); } }
    __syncthreads();
}

struct SbK { bf16x8 k[4]; }; struct SbV { s16x4 v[8]; };
DI void sb_loadk(SbK& f, const bf16* Kh, int kb, int r, int h) {
    const bf16* kp = Kh + (size_t)(kb + r) * 64 + 8 * h;
#pragma unroll
    for (int ks = 0; ks < 4; ++ks) f.k[ks] = ld16g(kp + 16 * ks);
}
DI void sb_loadv(SbV& f, const bf16* VTh, int kb, int r, int h) {
    const bf16* vp = VTh + (size_t)r * SEQ + kb + 4 * h;
#pragma unroll
    for (int s = 0; s < 2; ++s)
#pragma unroll
        for (int mt = 0; mt < 2; ++mt) { const bf16* v = vp + (size_t)mt * 32 * SEQ + 16 * s; f.v[4 * s + 2 * mt] = *(const s16x4*)v; f.v[4 * s + 2 * mt + 1] = *(const s16x4*)(v + 8); }
}
template <bool DIAG> DI void sb_tile(const SbK& fk, const SbV& fv, const bf16x8 (&qf)[4], f32x16 (&o)[2], float& R, int r, int h, int lane) {
    f32x16 s;
#pragma unroll
    for (int i = 0; i < 16; ++i) s[i] = 0.f;
#pragma unroll
    for (int ks = 0; ks < 4; ++ks) s = MFMA32(fk.k[ks], qf[ks], s);
    f32x16 x;
#pragma unroll
    for (int i = 0; i < 16; ++i) { const float z = s[i]; const float t = __builtin_amdgcn_exp2f(-fabsf(z) * LOG2E); const float sp = fmaxf(z, 0.f) + LN2 * __builtin_amdgcn_logf(1.0f + t);
        if (DIAG) { const bool valid = crow(i, h) < r; x[i] = valid ? -sp : 0.f; s[i] = valid ? z : -INFINITY; } else x[i] = -sp; }
    float T4[4], E[16];
#pragma unroll
    for (int g = 0; g < 4; ++g) { E[4 * g + 3] = 0.f; E[4 * g + 2] = x[4 * g + 3]; E[4 * g + 1] = E[4 * g + 2] + x[4 * g + 2]; E[4 * g] = E[4 * g + 1] + x[4 * g + 1]; T4[g] = E[4 * g] + x[4 * g]; }
    float P4[4];
#pragma unroll
    for (int g = 0; g < 4; ++g) P4[g] = px32(T4[g], lane);
    float C[4]; float run = 0.f;
#pragma unroll
    for (int g = 3; g >= 0; --g) { C[g] = run + (h == 0 ? P4[g] : 0.f); run += T4[g] + P4[g]; }
#pragma unroll
    for (int i = 0; i < 16; ++i) { const float arg = x[i] + s[i] + (R + C[i >> 2] + E[i]); x[i] = __builtin_amdgcn_exp2f(arg * LOG2E); }
#pragma unroll
    for (int sx = 0; sx < 2; ++sx) { const bf16x8 pb = pack8(x, sx);
#pragma unroll
        for (int mt = 0; mt < 2; ++mt) o[mt] = MFMA32(__builtin_shufflevector(fv.v[4 * sx + 2 * mt], fv.v[4 * sx + 2 * mt + 1], 0, 1, 2, 3, 4, 5, 6, 7), pb, o[mt]); }
    R += run;
}
constexpr int SB_K = 0, SB_V = 65536, SB_VROW = 1032;
DI void sb_wg_unit(int u, const bf16* Q, const bf16* K, const bf16* VT, bf16* YCAT, LAS unsigned char* lds, int tid, int wave, int lane) {
    const int bh = u >> 5, qb = u & 31, r = lane & 31, h = lane >> 5; const int base = qb > 0 ? 256 * (qb - 1) : 0, nk = qb > 0 ? 512 : 256;
    const bf16* Kh = K + (size_t)bh * SEQ * 64; const bf16* VTh = VT + (size_t)bh * 64 * SEQ;
    { const bf16* Kg = Kh + (size_t)base * 64; const int nch = nk * 8;
      for (int c0 = 0; c0 < nch; c0 += 2048) { v4u kv[4];
#pragma unroll
          for (int i = 0; i < 4; ++i) kv[i] = *(const v4u*)(Kg + (size_t)(c0 + tid + 512 * i) * 8);
#pragma unroll
          for (int i = 0; i < 4; ++i) { const int c = c0 + tid + 512 * i, k = c >> 3, ch = c & 7; *(LAS v4u*)(lds + SB_K + k * 128 + ((ch ^ ((k >> 1) & 7)) << 4)) = kv[i]; } }
      const int cpr = nk / 8;
      for (int c0 = 0; c0 < 64 * cpr; c0 += 2048) { v4u vv[4];
#pragma unroll
          for (int i = 0; i < 4; ++i) { const int c = c0 + tid + 512 * i, d = c / cpr, cc = c - d * cpr; vv[i] = *(const v4u*)(VTh + (size_t)d * SEQ + base + cc * 8); }
#pragma unroll
          for (int i = 0; i < 4; ++i) { const int c = c0 + tid + 512 * i, d = c / cpr, cc = c - d * cpr; LAS unsigned char* vp = lds + SB_V + d * SB_VROW + cc * 16;
              *(LAS unsigned long long*)vp = (unsigned long long)vv[i].x | ((unsigned long long)vv[i].y << 32); *(LAS unsigned long long*)(vp + 8) = (unsigned long long)vv[i].z | ((unsigned long long)vv[i].w << 32); } } }
    const int t0 = 256 * qb + 32 * wave;
    const bf16* qp = Q + ((size_t)bh * SEQ + t0 + r) * 64 + 8 * h; bf16x8 qf[4];
#pragma unroll
    for (int ks = 0; ks < 4; ++ks) qf[ks] = ld16g(qp + 16 * ks);
    __syncthreads();
    f32x16 o[2];
#pragma unroll
    for (int i = 0; i < 16; ++i) { o[0][i] = 0.f; o[1][i] = 0.f; }
    float R = 0.f; bool diag = true;
    for (int kb = t0; kb >= 0; kb -= 32) {
        if (!diag && !__any(R >= -104.0f)) break;
        SbK fk; SbV fv;
        if (kb >= base) { const int kl = kb - base + r;
            const LAS unsigned char* kp = lds + SB_K + kl * 128;
#pragma unroll
            for (int ks = 0; ks < 4; ++ks) fk.k[ks] = *(const LAS bf16x8*)(kp + (((2 * ks + h) ^ ((kl >> 1) & 7)) << 4));
#pragma unroll
            for (int s = 0; s < 2; ++s)
#pragma unroll
                for (int mt = 0; mt < 2; ++mt) { const LAS unsigned char* vp = lds + SB_V + (32 * mt + r) * SB_VROW + (kb - base + 16 * s + 4 * h) * 2; fv.v[4 * s + 2 * mt] = *(const LAS s16x4*)vp; fv.v[4 * s + 2 * mt + 1] = *(const LAS s16x4*)(vp + 16); }
        } else { sb_loadk(fk, Kh, kb, r, h); sb_loadv(fv, VTh, kb, r, h); }
        if (diag) sb_tile<true>(fk, fv, qf, o, R, r, h, lane); else sb_tile<false>(fk, fv, qf, o, R, r, h, lane);
        diag = false;
    }
    store_ot(YCAT + ((size_t)(bh >> 4) * SEQ + t0 + r) * 1024 + (bh & 15) * 64, o, 1.0f, h);
    __syncthreads();
}

#define CE_(a, b) do { const int hi_ = max((a), (b)); (b) = min((a), (b)); (a) = hi_; } while (0)
DI void sort16_desc(int (&v)[16]) {
    CE_(v[0], v[1]); CE_(v[2], v[3]); CE_(v[0], v[2]); CE_(v[1], v[3]); CE_(v[1], v[2]); CE_(v[4], v[5]); CE_(v[6], v[7]); CE_(v[4], v[6]); CE_(v[5], v[7]);
    CE_(v[5], v[6]); CE_(v[0], v[4]); CE_(v[2], v[6]); CE_(v[2], v[4]); CE_(v[1], v[5]); CE_(v[3], v[7]); CE_(v[3], v[5]); CE_(v[1], v[2]); CE_(v[3], v[4]);
    CE_(v[5], v[6]); CE_(v[8], v[9]); CE_(v[10], v[11]); CE_(v[8], v[10]); CE_(v[9], v[11]); CE_(v[9], v[10]); CE_(v[12], v[13]); CE_(v[14], v[15]); CE_(v[12], v[14]);
    CE_(v[13], v[15]); CE_(v[13], v[14]); CE_(v[8], v[12]); CE_(v[10], v[14]); CE_(v[10], v[12]); CE_(v[9], v[13]); CE_(v[11], v[15]); CE_(v[11], v[13]);
    CE_(v[9], v[10]); CE_(v[11], v[12]); CE_(v[13], v[14]); CE_(v[0], v[8]); CE_(v[4], v[12]); CE_(v[4], v[8]); CE_(v[2], v[10]); CE_(v[6], v[14]); CE_(v[6], v[10]);
    CE_(v[2], v[4]); CE_(v[6], v[8]); CE_(v[10], v[12]); CE_(v[1], v[9]); CE_(v[5], v[13]); CE_(v[5], v[9]); CE_(v[3], v[11]); CE_(v[7], v[15]); CE_(v[7], v[11]);
    CE_(v[3], v[5]); CE_(v[7], v[9]); CE_(v[11], v[13]); CE_(v[1], v[2]); CE_(v[3], v[4]); CE_(v[5], v[6]); CE_(v[7], v[8]); CE_(v[9], v[10]); CE_(v[11], v[12]);
    CE_(v[13], v[14]);
}
DI void merge16_desc(int (&A)[16], const int (&B)[16]) {
#pragma unroll
    for (int i = 0; i < 16; ++i) A[i] = max(A[i], B[15 - i]);
    CE_(A[0], A[8]); CE_(A[1], A[9]); CE_(A[2], A[10]); CE_(A[3], A[11]); CE_(A[4], A[12]); CE_(A[5], A[13]); CE_(A[6], A[14]); CE_(A[7], A[15]); CE_(A[0], A[4]);
    CE_(A[1], A[5]); CE_(A[2], A[6]); CE_(A[3], A[7]); CE_(A[8], A[12]); CE_(A[9], A[13]); CE_(A[10], A[14]); CE_(A[11], A[15]); CE_(A[0], A[2]); CE_(A[1], A[3]);
    CE_(A[4], A[6]); CE_(A[5], A[7]); CE_(A[8], A[10]); CE_(A[9], A[11]); CE_(A[12], A[14]); CE_(A[13], A[15]); CE_(A[0], A[1]); CE_(A[2], A[3]); CE_(A[4], A[5]);
    CE_(A[6], A[7]); CE_(A[8], A[9]); CE_(A[10], A[11]); CE_(A[12], A[13]); CE_(A[14], A[15]);
}
#define PEER_CAND_CHUNK(C_, c_) do { \
    if ((c_) == 0) { C_[0] = (f_ord(s1[0] + s2[0]) & ~0x3fff) | a1[0] | a2[0]; C_[1] = (f_ord(s1[0] + s2[1]) & ~0x3fff) | a1[0] | a2[1]; C_[2] = (f_ord(s1[0] + s2[2]) & ~0x3fff) | a1[0] | a2[2]; C_[3] = (f_ord(s1[0] + s2[3]) & ~0x3fff) | a1[0] | a2[3]; C_[4] = (f_ord(s1[0] + s2[4]) & ~0x3fff) | a1[0] | a2[4]; C_[5] = (f_ord(s1[0] + s2[5]) & ~0x3fff) | a1[0] | a2[5]; C_[6] = (f_ord(s1[0] + s2[6]) & ~0x3fff) | a1[0] | a2[6]; C_[7] = (f_ord(s1[0] + s2[7]) & ~0x3fff) | a1[0] | a2[7]; C_[8] = (f_ord(s1[0] + s2[8]) & ~0x3fff) | a1[0] | a2[8]; C_[9] = (f_ord(s1[0] + s2[9]) & ~0x3fff) | a1[0] | a2[9]; C_[10] = (f_ord(s1[0] + s2[10]) & ~0x3fff) | a1[0] | a2[10]; C_[11] = (f_ord(s1[0] + s2[11]) & ~0x3fff) | a1[0] | a2[11]; C_[12] = (f_ord(s1[0] + s2[12]) & ~0x3fff) | a1[0] | a2[12]; C_[13] = (f_ord(s1[0] + s2[13]) & ~0x3fff) | a1[0] | a2[13]; C_[14] = (f_ord(s1[0] + s2[14]) & ~0x3fff) | a1[0] | a2[14]; C_[15] = (f_ord(s1[0] + s2[15]) & ~0x3fff) | a1[0] | a2[15]; } \
    if ((c_) == 1) { C_[0] = (f_ord(s1[1] + s2[0]) & ~0x3fff) | a1[1] | a2[0]; C_[1] = (f_ord(s1[1] + s2[1]) & ~0x3fff) | a1[1] | a2[1]; C_[2] = (f_ord(s1[1] + s2[2]) & ~0x3fff) | a1[1] | a2[2]; C_[3] = (f_ord(s1[1] + s2[3]) & ~0x3fff) | a1[1] | a2[3]; C_[4] = (f_ord(s1[1] + s2[4]) & ~0x3fff) | a1[1] | a2[4]; C_[5] = (f_ord(s1[1] + s2[5]) & ~0x3fff) | a1[1] | a2[5]; C_[6] = (f_ord(s1[1] + s2[6]) & ~0x3fff) | a1[1] | a2[6]; C_[7] = (f_ord(s1[1] + s2[7]) & ~0x3fff) | a1[1] | a2[7]; C_[8] = (f_ord(s1[2] + s2[0]) & ~0x3fff) | a1[2] | a2[0]; C_[9] = (f_ord(s1[2] + s2[1]) & ~0x3fff) | a1[2] | a2[1]; C_[10] = (f_ord(s1[2] + s2[2]) & ~0x3fff) | a1[2] | a2[2]; C_[11] = (f_ord(s1[2] + s2[3]) & ~0x3fff) | a1[2] | a2[3]; C_[12] = (f_ord(s1[2] + s2[4]) & ~0x3fff) | a1[2] | a2[4]; C_[13] = (f_ord(s1[3] + s2[0]) & ~0x3fff) | a1[3] | a2[0]; C_[14] = (f_ord(s1[3] + s2[1]) & ~0x3fff) | a1[3] | a2[1]; C_[15] = (f_ord(s1[3] + s2[2]) & ~0x3fff) | a1[3] | a2[2]; } \
    if ((c_) == 2) { C_[0] = (f_ord(s1[3] + s2[3]) & ~0x3fff) | a1[3] | a2[3]; C_[1] = (f_ord(s1[4] + s2[0]) & ~0x3fff) | a1[4] | a2[0]; C_[2] = (f_ord(s1[4] + s2[1]) & ~0x3fff) | a1[4] | a2[1]; C_[3] = (f_ord(s1[4] + s2[2]) & ~0x3fff) | a1[4] | a2[2]; C_[4] = (f_ord(s1[5] + s2[0]) & ~0x3fff) | a1[5] | a2[0]; C_[5] = (f_ord(s1[5] + s2[1]) & ~0x3fff) | a1[5] | a2[1]; C_[6] = (f_ord(s1[6] + s2[0]) & ~0x3fff) | a1[6] | a2[0]; C_[7] = (f_ord(s1[6] + s2[1]) & ~0x3fff) | a1[6] | a2[1]; C_[8] = (f_ord(s1[7] + s2[0]) & ~0x3fff) | a1[7] | a2[0]; C_[9] = (f_ord(s1[7] + s2[1]) & ~0x3fff) | a1[7] | a2[1]; C_[10] = (f_ord(s1[8] + s2[0]) & ~0x3fff) | a1[8] | a2[0]; C_[11] = (f_ord(s1[9] + s2[0]) & ~0x3fff) | a1[9] | a2[0]; C_[12] = (f_ord(s1[10] + s2[0]) & ~0x3fff) | a1[10] | a2[0]; C_[13] = (f_ord(s1[11] + s2[0]) & ~0x3fff) | a1[11] | a2[0]; C_[14] = (f_ord(s1[12] + s2[0]) & ~0x3fff) | a1[12] | a2[0]; C_[15] = (f_ord(s1[13] + s2[0]) & ~0x3fff) | a1[13] | a2[0]; } \
    if ((c_) == 3) { C_[0] = (f_ord(s1[14] + s2[0]) & ~0x3fff) | a1[14] | a2[0]; C_[1] = (f_ord(s1[15] + s2[0]) & ~0x3fff) | a1[15] | a2[0]; C_[2] = KEY_MIN; C_[3] = KEY_MIN; C_[4] = KEY_MIN; C_[5] = KEY_MIN; C_[6] = KEY_MIN; C_[7] = KEY_MIN; C_[8] = KEY_MIN; C_[9] = KEY_MIN; C_[10] = KEY_MIN; C_[11] = KEY_MIN; C_[12] = KEY_MIN; C_[13] = KEY_MIN; C_[14] = KEY_MIN; C_[15] = KEY_MIN; } \
} while (0)

DI void peer_scores(int tokg, int head, const bf16* QP, const bf16* SUBK, unsigned* ent  , int lane) {
    const int r = lane & 31, h = lane >> 5;
    int L1[16], L2[16];
#pragma unroll
    for (int p = 0; p < 2; ++p) {
        const bf16* qp = QP + (size_t)(tokg + r) * 2048 + head * 256 + p * 128 + 8 * h; bf16x8 qf[8];
#pragma unroll
        for (int ks = 0; ks < 8; ++ks) qf[ks] = ld16g(qp + 16 * ks);
        const bf16* sk = SUBK + (size_t)((head * 2 + p) * 128 + r) * 128 + 8 * h;
        int L[16];
#pragma unroll
        for (int i = 0; i < 16; ++i) L[i] = KEY_MIN;
        bf16x8 af[8];
#pragma unroll
        for (int ks = 0; ks < 8; ++ks) af[ks] = ld16g(sk + 16 * ks);
#pragma unroll 1
        for (int mt = 0; mt < 4; ++mt) {
            f32x16 acc;
#pragma unroll
            for (int i = 0; i < 16; ++i) acc[i] = 0.f;
#pragma unroll
            for (int ks = 0; ks < 8; ++ks) acc = MFMA32(af[ks], qf[ks], acc);
            if (mt < 3) {
#pragma unroll
                for (int ks = 0; ks < 8; ++ks) af[ks] = ld16g(sk + (size_t)(mt + 1) * 32 * 128 + 16 * ks); }
            int Nw[16];
#pragma unroll
            for (int i = 0; i < 16; ++i) Nw[i] = (f_ord(acc[i]) & ~127) | (32 * mt + crow(i, h));
            sort16_desc(Nw); merge16_desc(L, Nw);
        }
        int Pn[16];
#pragma unroll
        for (int i = 0; i < 16; ++i) Pn[i] = px32(L[i], lane);
        merge16_desc(L, Pn);
#pragma unroll
        for (int i = 0; i < 16; ++i) { if (p == 0) L1[i] = L[i]; else L2[i] = L[i]; }
    }
    float s1[16], s2[16]; int a1[16], a2[16];
#pragma unroll
    for (int i = 0; i < 16; ++i) { s1[i] = f_unord(L1[i] & ~127); s2[i] = f_unord(L2[i] & ~127); a1[i] = (L1[i] & 127) << 7; a2[i] = L2[i] & 127; }
    int Cn[16];
    PEER_CAND_CHUNK(Cn, 0); sort16_desc(Cn);
#pragma unroll
    for (int c = 1; c < 4; ++c) { int Dn[16]; PEER_CAND_CHUNK(Dn, c); sort16_desc(Dn); merge16_desc(Cn, Dn); }
    float e[16]; float sum = 0.f; const float m0 = f_unord(Cn[0] & ~0x3fff);
#pragma unroll
    for (int k = 0; k < 16; ++k) { e[k] = __builtin_amdgcn_exp2f((f_unord(Cn[k] & ~0x3fff) - m0) * LOG2E); sum += e[k]; }
    const float inv = 1.0f / sum;
    if (h == 0) { unsigned* dst = ent + (size_t)r * 128 + head * 16;
#pragma unroll
        for (int g4 = 0; g4 < 4; ++g4) { v4u w;
            w.x = (cvtpk2(0.f, e[4 * g4] * inv) & 0xffff0000u) | (unsigned)(Cn[4 * g4] & 0x3fff); w.y = (cvtpk2(0.f, e[4 * g4 + 1] * inv) & 0xffff0000u) | (unsigned)(Cn[4 * g4 + 1] & 0x3fff);
            w.z = (cvtpk2(0.f, e[4 * g4 + 2] * inv) & 0xffff0000u) | (unsigned)(Cn[4 * g4 + 2] & 0x3fff); w.w = (cvtpk2(0.f, e[4 * g4 + 3] * inv) & 0xffff0000u) | (unsigned)(Cn[4 * g4 + 3] & 0x3fff);
            *(v4u*)(dst + 4 * g4) = w; } }
}
typedef float f32x2 __attribute__((ext_vector_type(2)));
DI f32x2 fp8lo(unsigned w) { return __builtin_amdgcn_cvt_pk_f32_fp8((int)w, false); }
DI f32x2 fp8hi(unsigned w) { return __builtin_amdgcn_cvt_pk_f32_fp8((int)w, true); }
DI f32x2 fma2(f32x2 a, f32x2 b, f32x2 c) { float x = c.x, y = c.y; asm("v_fmac_f32 %0, %1, %2" : "+v"(x) : "v"(a.x), "v"(b.x)); asm("v_fmac_f32 %0, %1, %2" : "+v"(y) : "v"(a.y), "v"(b.y)); return (f32x2){x, y}; }
constexpr int PU_LIST = 0, PU_H = 65536, PU_USC = 98304, PU_VSC = 106496, PU_BC = 114688, PU_LCAP = 160;
template <int VAR> DI void peer_u_issue(v4u (&rw)[16], const unsigned char* U8, const LAS unsigned* lev, int lane) {
#pragma unroll
    for (int k4 = 0; k4 < 4; ++k4) { const v4u ev = *(const LAS v4u*)(lev + 4 * k4);
#pragma unroll
        for (int k = 0; k < 4; ++k) rw[4 * k4 + k] = *(const v4u*)(U8 + (size_t)(ev[k] & 0x3fffu) * 1024 + 16 * lane); }
}
template <int VAR> DI void peer_u_compute(const v4u (&rw)[16], const LAS unsigned char* hrow, float hs, const LAS unsigned* lev, const LAS unsigned* lslot, int nvalid, int tok, const LAS float* uscs, const LAS float* vscs, float* ACT, int lane) {
    const v4u hq = *(const LAS v4u*)(hrow + 16 * lane);
    int p[16];
#pragma unroll
    for (int k = 0; k < 16; ++k) { int a = __builtin_amdgcn_sdot4((int)rw[k].x, (int)hq.x, 0, false); a = __builtin_amdgcn_sdot4((int)rw[k].y, (int)hq.y, a, false); a = __builtin_amdgcn_sdot4((int)rw[k].z, (int)hq.z, a, false); p[k] = __builtin_amdgcn_sdot4((int)rw[k].w, (int)hq.w, a, false); }
    { const bool up = (lane & 8) != 0;
#pragma unroll
      for (int i = 0; i < 8; ++i) { const int keep = up ? p[i + 8] : p[i], send = up ? p[i] : p[i + 8]; p[i] = keep + dppi<DPP_RM>(send); } }
    { const bool up = (lane & 4) != 0;
#pragma unroll
      for (int i = 0; i < 4; ++i) { const int keep = up ? p[i + 4] : p[i], send = up ? p[i] : p[i + 4]; p[i] = keep + dppi<DPP_HM>(send); } }
    { const bool up = (lane & 2) != 0;
#pragma unroll
      for (int i = 0; i < 2; ++i) { const int keep = up ? p[i + 2] : p[i], send = up ? p[i] : p[i + 2]; p[i] = keep + dppi<DPP_X2>(send); } }
    { const bool up = (lane & 1) != 0; const int keep = up ? p[1] : p[0], send = up ? p[0] : p[1]; p[0] = keep + dppi<DPP_X1>(send); }
    int dq = p[0];
    { auto r = __builtin_amdgcn_permlane16_swap((unsigned)dq, (unsigned)dq, false, false); dq = (int)r[0] + (int)r[1]; }
    { auto r = __builtin_amdgcn_permlane32_swap((unsigned)dq, (unsigned)dq, false, false); dq = (int)r[0] + (int)r[1]; }
    const int myk = lane & 15;
    if (lane < 16 && myk < nvalid) { const unsigned mev = lev[myk], mslot = lslot[myk]; const unsigned er = mev & 2047u;
        const float w_ = gelu_tanh((float)dq * hs * uscs[er]) * __uint_as_float(mev & 0xffff0000u) * vscs[er];
        ((unsigned*)ACT)[(VAR == 1) ? (size_t)lane : ((size_t)tok * 128 + mslot)] = (cvtpk2(0.f, w_) & 0xffff0000u) | (mev & 0x3fffu); }
}
DI void peer_u_loade(int tok, const unsigned* ENT, unsigned (&e0)[4], unsigned (&e1)[4], int lane) {
#pragma unroll
    for (int t = 0; t < 4; ++t) { e0[t] = ENT[(size_t)(tok + t) * 128 + lane]; e1[t] = ENT[(size_t)(tok + t) * 128 + 64 + lane]; }
}
template <int VAR> DI void peer_u_wave(int tok0, int slab, const unsigned* ENT, const unsigned char* HQ, const float* HS, const unsigned char* U8, float* ACT, LAS unsigned char* lds, int wave, int lane) {
    LAS unsigned* lev = (LAS unsigned*)(lds + PU_LIST + wave * 8192); LAS unsigned* lslot = lev + 4 * PU_LCAP; LAS unsigned char* hb = lds + PU_H + wave * 4096;
    const LAS float* uscs = (const LAS float*)(lds + PU_USC); const LAS float* vscs = (const LAS float*)(lds + PU_VSC);
    unsigned e0[4], e1[4];
    peer_u_loade(tok0, ENT, e0, e1, lane);
#pragma unroll 1
    for (int bt = 0; bt < 4; ++bt) { const int tb = tok0 + 4 * bt;
        v4u hq[4]; float hsv[4];
#pragma unroll
        for (int t = 0; t < 4; ++t) { hq[t] = *(const v4u*)(HQ + (size_t)(tb + t) * 1024 + 16 * lane); hsv[t] = HS[tb + t]; }
        int cnt[4]; const unsigned long long lt = (1ull << lane) - 1ull;
#pragma unroll
        for (int t = 0; t < 4; ++t) { const bool in0 = ((e0[t] >> 11) & 7u) == (unsigned)slab, in1 = ((e1[t] >> 11) & 7u) == (unsigned)slab;
            const unsigned long long b0 = __ballot(in0), b1 = __ballot(in1); const int n0 = __builtin_popcountll(b0), n = n0 + __builtin_popcountll(b1);
            LAS unsigned* le = lev + t * PU_LCAP; LAS unsigned* ls = lslot + t * PU_LCAP;
            if (in0) { const int p = __builtin_popcountll(b0 & lt); le[p] = e0[t]; ls[p] = (unsigned)lane; }
            if (in1) { const int p = n0 + __builtin_popcountll(b1 & lt); le[p] = e1[t]; ls[p] = (unsigned)(64 + lane); }
            if (n > 0 && lane < 16) { const unsigned pe = b0 ? (unsigned)__builtin_amdgcn_readlane((int)e0[t], (int)__builtin_ctzll(b0 | (1ull << 63))) : (unsigned)__builtin_amdgcn_readlane((int)e1[t], (int)__builtin_ctzll(b1 | (1ull << 63)));
                if (n + lane < ((n + 15) & ~15)) le[n + lane] = pe; }
            cnt[t] = n; }
        if (bt < 3) peer_u_loade(tb + 4, ENT, e0, e1, lane);
#pragma unroll
        for (int t = 0; t < 4; ++t) *(LAS v4u*)(hb + t * 1024 + 16 * lane) = hq[t];
        asm volatile("s_waitcnt lgkmcnt(0)" ::: "memory");
#define PU_CNT(t_) ((t_) == 0 ? cnt[0] : ((t_) == 1 ? cnt[1] : ((t_) == 2 ? cnt[2] : cnt[3])))
#define PU_HS(t_) ((t_) == 0 ? hsv[0] : ((t_) == 1 ? hsv[1] : ((t_) == 2 ? hsv[2] : hsv[3])))
#define PU_ADV(tk_, g_) do { while ((tk_) < 4 && (g_) >= PU_CNT(tk_)) { ++(tk_); (g_) = 0; } } while (0)
        int tk = 0, g = 0; PU_ADV(tk, g);
        if (tk < 4) { v4u ra[16], rb[16];
            peer_u_issue<VAR>(ra, U8, lev + tk * PU_LCAP + g, lane);
            for (;;) {
                int ntk = tk, ng = g + 16; PU_ADV(ntk, ng);
                if (ntk < 4) peer_u_issue<VAR>(rb, U8, lev + ntk * PU_LCAP + ng, lane);
                peer_u_compute<VAR>(ra, hb + tk * 1024, PU_HS(tk), lev + tk * PU_LCAP + g, lslot + tk * PU_LCAP + g, PU_CNT(tk) - g, tb + tk, uscs, vscs, ACT, lane);
                tk = ntk; g = ng; if (tk >= 4) break;
                ntk = tk; ng = g + 16; PU_ADV(ntk, ng);
                if (ntk < 4) peer_u_issue<VAR>(ra, U8, lev + ntk * PU_LCAP + ng, lane);
                peer_u_compute<VAR>(rb, hb + tk * 1024, PU_HS(tk), lev + tk * PU_LCAP + g, lslot + tk * PU_LCAP + g, PU_CNT(tk) - g, tb + tk, uscs, vscs, ACT, lane);
                tk = ntk; g = ng; if (tk >= 4) break;
            } }
#undef PU_CNT
#undef PU_HS
#undef PU_ADV
        asm volatile("s_waitcnt lgkmcnt(0)" ::: "memory");
    }
}
template <int VVAR> DI void peer_v_wave(int tok0, int slab, const unsigned* ENT, const float* ACT, const unsigned char* V8slab, bf16* XB, float* XF, const float* g2, int lane) {
    const int sub = lane & 7, j = lane >> 3; const unsigned* WP = (const unsigned*)ACT;
    const int col = 128 * slab + 16 * sub + 2 * (4 * ((lane >> 5) & 1) + 2 * ((lane >> 4) & 1) + ((lane >> 3) & 1));
    const f32x2 gv = *(const f32x2*)(g2 + (tok0 >> 13) * 6144 + col);
    v4u enn[4]; unsigned xvn;
    { const v4u* ep = (const v4u*)(WP + (size_t)tok0 * 128 + 16 * j);
#pragma unroll
      for (int q = 0; q < 4; ++q) enn[q] = ep[q];
      xvn = *(const unsigned*)(XB + (size_t)tok0 * 1024 + col); }
#pragma unroll 1
    for (int it = 0; it < 8; ++it) { const int tok = tok0 + it;
        v4u en[4]; const f32x2 xv = (f32x2){bf_lo(xvn), bf_hi(xvn)};
#pragma unroll
        for (int q = 0; q < 4; ++q) en[q] = enn[q];
        v4u rw[16];
#pragma unroll
        for (int i = 0; i < 16; ++i) rw[i] = *(const v4u*)(V8slab + (size_t)(en[i >> 2][i & 3] & 0x3fffu) * 128 + 16 * sub);
        if (it < 7) { const v4u* ep = (const v4u*)(WP + (size_t)(tok + 1) * 128 + 16 * j);
#pragma unroll
            for (int q = 0; q < 4; ++q) enn[q] = ep[q];
            xvn = *(const unsigned*)(XB + (size_t)(tok + 1) * 1024 + col); }
        unsigned wmb = 0u;
#pragma unroll
        for (int q = 0; q < 4; ++q) { wmb = max(wmb, max(max(en[q][0] & 0x7fff0000u, en[q][1] & 0x7fff0000u), max(en[q][2] & 0x7fff0000u, en[q][3] & 0x7fff0000u))); }
        wmb = max(wmb, (unsigned)dppi<DPP_R8>((int)wmb)); wmb = max(wmb, px16u(wmb, lane)); wmb = max(wmb, px32u(wmb, lane));
        const float wm = __uint_as_float(wmb); const float wsq = wm > 0.f ? 127.0f / wm : 0.f, winv = wm * (1.0f / 127.0f);
        f32x4 aw[4];
#pragma unroll
        for (int q = 0; q < 4; ++q) aw[q] = (f32x4){__uint_as_float(en[q][0] & 0xffff0000u), __uint_as_float(en[q][1] & 0xffff0000u), __uint_as_float(en[q][2] & 0xffff0000u), __uint_as_float(en[q][3] & 0xffff0000u)};
        unsigned W[4];
#pragma unroll
        for (int q = 0; q < 4; ++q) { const int q0 = __float2int_rn(aw[q][0] * wsq), q1 = __float2int_rn(aw[q][1] * wsq), q2 = __float2int_rn(aw[q][2] * wsq), q3 = __float2int_rn(aw[q][3] * wsq);
            W[q] = (unsigned)(q0 & 255) | ((unsigned)(q1 & 255) << 8) | ((unsigned)(q2 & 255) << 16) | ((unsigned)(q3 & 255) << 24); }
        int acc[16];
#pragma unroll
        for (int c = 0; c < 16; ++c) acc[c] = 0;
#pragma unroll
        for (int g = 0; g < 4; ++g)
#pragma unroll
            for (int q = 0; q < 4; ++q) { const unsigned m0 = rw[4 * g][q], m1 = rw[4 * g + 1][q], m2 = rw[4 * g + 2][q], m3 = rw[4 * g + 3][q];
                const unsigned t0 = __builtin_amdgcn_perm(m1, m0, 0x05010400u), t1 = __builtin_amdgcn_perm(m1, m0, 0x07030602u), t2 = __builtin_amdgcn_perm(m3, m2, 0x05010400u), t3 = __builtin_amdgcn_perm(m3, m2, 0x07030602u);
                acc[4 * q] = __builtin_amdgcn_sdot4((int)__builtin_amdgcn_perm(t2, t0, 0x05040100u), (int)W[g], acc[4 * q], false);
                acc[4 * q + 1] = __builtin_amdgcn_sdot4((int)__builtin_amdgcn_perm(t2, t0, 0x07060302u), (int)W[g], acc[4 * q + 1], false);
                acc[4 * q + 2] = __builtin_amdgcn_sdot4((int)__builtin_amdgcn_perm(t3, t1, 0x05040100u), (int)W[g], acc[4 * q + 2], false);
                acc[4 * q + 3] = __builtin_amdgcn_sdot4((int)__builtin_amdgcn_perm(t3, t1, 0x07060302u), (int)W[g], acc[4 * q + 3], false); }
        { const bool up = (lane & 32) != 0;
#pragma unroll
          for (int c = 0; c < 8; ++c) { const int keep = up ? acc[c + 8] : acc[c], send = up ? acc[c] : acc[c + 8]; acc[c] = keep + px32(send, lane); } }
        { const bool up = (lane & 16) != 0;
#pragma unroll
          for (int c = 0; c < 4; ++c) { const int keep = up ? acc[c + 4] : acc[c], send = up ? acc[c] : acc[c + 4]; acc[c] = keep + (int)px16u((unsigned)send, lane); } }
        { const bool up = (lane & 8) != 0;
#pragma unroll
          for (int c = 0; c < 2; ++c) { const int keep = up ? acc[c + 2] : acc[c], send = up ? acc[c] : acc[c + 2]; acc[c] = keep + dppi<DPP_R8>(send); } }
        { const float y0 = xv.x + gv.x * ((float)acc[0] * winv), y1 = xv.y + gv.y * ((float)acc[1] * winv);
          if (XF) *(f32x2*)(XF + (size_t)tok * 1024 + col) = (f32x2){y0, y1}; else *(unsigned*)(XB + (size_t)tok * 1024 + col) = cvtpk2(y0, y1); }
    }
}
struct PeerT { const unsigned char *U8, *V8s; const float *USC, *VSC; unsigned* ENT; float* ACT; const unsigned char* HQ; const float* HS; bf16* XB; float* XF; const float* g2; };
DI void peer_scores_phase(const Frame& F, const bf16* QP, const bf16* SUBK, unsigned* ENT) {
    for (int unit = blockIdx.x; unit < MROWS / 64; unit += F.G) {
#pragma unroll 1
        for (int grp = 0; grp < 2; ++grp) { const int tokg = unit * 64 + 32 * grp; peer_scores(tokg, F.wave, QP, SUBK, ENT + (size_t)tokg * 128, F.lane); } }
}
template <int PASS, int VAR = 0> DI void peer_gather_phase(const Frame& F, int cnt_base, const PeerT& T) {
    const int xcc = XCC_EXPR; LAS int* bc = (LAS int*)(F.lds + PU_BC);
    constexpr int CHT = (PASS == 0) ? 128 : 64;
    for (int k = 0; k < 8; ++k) { const int s = (xcc + k) & 7; unsigned* cnt = (unsigned*)(F.ctl + CW_WORK + 64 * (cnt_base + s));
        if (PASS == 0) { for (int i = F.tid; i < 2048; i += NTHR) { ((LAS float*)(F.lds + PU_USC))[i] = T.USC[2048 * s + i]; ((LAS float*)(F.lds + PU_VSC))[i] = T.VSC[2048 * s + i]; } }
        for (;;) {
            if (F.tid == 0) *bc = (int)__hip_atomic_fetch_add(cnt, 1u, __ATOMIC_RELAXED, __HIP_MEMORY_SCOPE_AGENT);
            __syncthreads(); const int chunk = *bc; __syncthreads();
            if (chunk >= MROWS / CHT) break;
            if (PASS == 0) peer_u_wave<VAR>(chunk * 128 + F.wave * 16, s, T.ENT, T.HQ, T.HS, T.U8, T.ACT, F.lds, F.wave, F.lane);
            else peer_v_wave<VAR>(chunk * 64 + F.wave * 8, s, T.ENT, T.ACT, T.V8s + (size_t)s * 16384 * 128, T.XB, T.XF, T.g2, F.lane);
        } }
}
struct Args { const float* in[19]; float* out; unsigned char* ws; int stage, pad; };
__global__ void __launch_bounds__(NTHR, 2) hybrid_fwd(Args args) {
    extern __shared__ __attribute__((aligned(16))) unsigned char lds_raw[];
    for (int u = threadIdx.x; u < (LDS_BYTES - LDSCTL_OFF) / 4; u += NTHR) ((LAS unsigned*)((LAS unsigned char*)lds_raw + LDSCTL_OFF))[u] = 0u;
    __syncthreads();
    XcdBarrier bar = xcd_barrier_post((unsigned*)((gu32*)(args.ws + WS_CTL) + CW_BAR), (volatile LAS unsigned*)((LAS unsigned char*)lds_raw + MISC_OFF) + 8);
#ifdef PROBE_MASK
    volatile LAS unsigned long long* stamps_ = (volatile LAS unsigned long long*)((LAS unsigned char*)lds_raw + MISC_OFF + 256); int nst_ = 0;
#ifndef PROBE_BLK
#define PROBE_BLK 0
#endif
#define STAMP() do { if (blockIdx.x == PROBE_BLK && threadIdx.x == 0) stamps_[nst_] = __builtin_amdgcn_s_memrealtime(); ++nst_; } while (0)
#else
#define STAMP() do {} while (0)
#endif
    STAMP();
#define GRID_BAR() do { xcd_barrier(bar); STAMP(); } while (0)
#define OPQ(p) ({ size_t z_ = 0; asm volatile("" : "+s"(z_)); (p) + z_; })
#define PH_PTRS \
    unsigned char* ws = OPQ(args.ws); const float* x_in = OPQ(args.in[0]); float* X = OPQ(args.out); \
    const float *norm_mix = args.in[4], *norm_ffn = args.in[5]; \
    float* MOD = (float*)(ws + WS_MOD); float* ROPE = (float*)(ws + WS_ROPE); float* KSUM = (float*)(ws + WS_KSUM); \
    bf16 *WIN0 = (bf16*)(ws + WS_WIN0), *WOUT0 = (bf16*)(ws + WS_WOUT0), *WIN1 = (bf16*)(ws + WS_WIN1), *WOUT1 = (bf16*)(ws + WS_WOUT1), *WQ0 = (bf16*)(ws + WS_WQ0), *WQ1 = (bf16*)(ws + WS_WQ1); \
    bf16 *SUBK = (bf16*)(ws + WS_SUBK), *GWS = (bf16*)(ws + WS_GWS), *HN = (bf16*)(ws + WS_HN); \
    bf16 *UA = (bf16*)(ws + WS_A), *VA = (bf16*)(ws + WS_A + 16 * MiB), *Q0 = (bf16*)(ws + WS_A + 32 * MiB), *K0 = (bf16*)(ws + WS_A + 48 * MiB), *VT0 = (bf16*)(ws + WS_A + 64 * MiB); \
    bf16 *Q1 = (bf16*)(ws + WS_A), *K1 = (bf16*)(ws + WS_A + 32 * MiB), *VT1 = (bf16*)(ws + WS_A + 64 * MiB); \
    bf16 *YCAT = (bf16*)(ws + WS_YCAT), *QP = (bf16*)(ws + WS_QP), *PO = (bf16*)(ws + WS_PO); float* PL = (float*)(ws + WS_PL); unsigned* MASKS = (unsigned*)(ws + WS_MASK); unsigned char *U8 = ws + WS_PTU, *V8s = ws + WS_PTV; float *USC = (float*)(ws + WS_SC), *VSC = USC + 32768; unsigned* ENT = (unsigned*)(ws + WS_PO); float* ACT = (float*)(ws + WS_PO + 8 * MiB); unsigned char* HQ = ws + WS_A; float* HS = (float*)(ws + WS_SC + 512 * 1024); (void)HQ; (void)HS; bf16* XB = (bf16*)(ws + WS_XB); (void)XB; (void)U8; (void)V8s; (void)USC; (void)VSC; (void)ENT; (void)ACT; bf16* QKR = (bf16*)(ws + WS_QP); (void)QKR; \
    (void)x_in; (void)X; (void)norm_mix; (void)norm_ffn; (void)MOD; (void)ROPE; (void)KSUM; (void)WIN0; (void)WOUT0; (void)WIN1; (void)WOUT1; (void)WQ0; (void)WQ1; (void)SUBK; (void)GWS; (void)HN; \
    (void)UA; (void)VA; (void)Q0; (void)K0; (void)VT0; (void)Q1; (void)K1; (void)VT1; (void)YCAT; (void)QP; (void)PO; (void)PL; (void)MASKS;
#define PH_FRAME Frame F; F.lds = (LAS unsigned char*)lds_raw; F.MISC = (volatile LAS unsigned*)(F.lds + MISC_OFF); { int t_ = threadIdx.x; asm volatile("" : "+v"(t_)); F.tid = t_; } F.lane = F.tid & 63; F.wave = __builtin_amdgcn_readfirstlane(F.tid >> 6); \
    F.G = gridDim.x; F.gw = blockIdx.x * NWAVES + F.wave; F.NGW = F.G * NWAVES; F.ctl = (gu32*)(OPQ(args.ws) + WS_CTL);
    { PH_FRAME PH_PTRS
      P0Args A; A.c = args.in[1]; A.w_mod = args.in[2]; A.b_mod = args.in[3]; A.win0 = args.in[6]; A.wout0 = args.in[12]; A.win1 = args.in[13]; A.wout1 = args.in[14]; A.wq = args.in[15]; A.subk = args.in[16];
      A.pu = args.in[17]; A.pv = args.in[18]; A.gws = args.in[8]; A.MOD = MOD; A.ROPE = ROPE; A.WIN0 = WIN0; A.WOUT0 = WOUT0; A.WIN1 = WIN1; A.WOUT1 = WOUT1; A.WQ0 = WQ0; A.WQ1 = WQ1; A.SUBK = SUBK; A.GWS = GWS; A.U8 = U8; A.V8s = V8s; A.USC = USC; A.VSC = VSC;
      p0_prologue(F, A); }
    GRID_BAR();
    { PH_FRAME PH_PTRS norm_rows<true>(F, x_in, norm_mix, MOD, 0, 1, HN); }
    GRID_BAR();
    { PH_FRAME PH_PTRS
      pg8::Gemm g{HN, WIN0, MROWS, 2048, 1024}; pg8::StaticOrder S; S.init(MROWS, 2048, F.G, (int)blockIdx.x);
      pg8::EpiL0m E{UA, VA, QKR};
      pg8::gemm_phase<pg8::EpiL0m, pg8::StaticOrder, true, true>(F.lds, g, S, E); }
    { PH_FRAME PH_PTRS
      pg8::Gemm g{WIN0 + (size_t)2048 * 1024, HN, 512, MROWS, 1024}; pg8::StaticOrder S; S.init(512, MROWS, F.G, (int)blockIdx.x);
      pg8::EpiVT E{VT0, 512};
      pg8::gemm_phase<pg8::EpiVT, pg8::StaticOrder, true, true>(F.lds, g, S, E); }
    GRID_BAR();
    { PH_FRAME PH_PTRS
      for (int t = blockIdx.x; t < 256; t += F.G) qk_post_task(t, QKR, Q0, K0, KSUM, ROPE, args.in[10], args.in[11], (LAS float*)F.lds, F.tid, F.wave, F.lane);
      for (int u = blockIdx.x; u < 512; u += F.G) gmlp_unit(u, UA, VA, args.in[7], GWS, args.in[9], YCAT, F.lds, F.tid, F.wave, F.lane); }
    GRID_BAR();
    { PH_FRAME PH_PTRS
      MobaT T{Q0, K0, VT0, KSUM, MASKS, PO, PL, args.in[10], args.in[11]}; const float mc2 = moba_mc2(args.in[10], args.in[11], F.lane);
      for (int u = F.gw; u < 4096; u += F.NGW) moba_mask_unit(u, T, F.lane); (void)mc2; }
    GRID_BAR();
    { PH_FRAME PH_PTRS
      MobaT T{Q0, K0, VT0, KSUM, MASKS, PO, PL, args.in[10], args.in[11]}; const float mc2 = moba_mc2(args.in[10], args.in[11], F.lane);
      LAS int* bc = (LAS int*)(F.lds + MS_CNT + 64);
      for (;;) { if (F.tid == 0) *bc = (int)__hip_atomic_fetch_add((unsigned*)(F.ctl + CW_WORK), 1u, __ATOMIC_RELAXED, __HIP_MEMORY_SCOPE_AGENT);
          __syncthreads(); const int task = *bc; __syncthreads(); if (task >= MOBA_NTASK) break;
          moba_sel_task(task, T, F.lds, mc2, F.tid, F.wave, F.lane); } }
    GRID_BAR();
    { PH_FRAME PH_PTRS moba_combine(F, PO, PL, YCAT); }
    GRID_BAR();
    { PH_FRAME PH_PTRS
      pg8::Gemm g{YCAT, WOUT0, MROWS, 1024, 1024}; pg8::StaticOrder S; S.init(MROWS, 1024, F.G, (int)blockIdx.x);
      pg8::EpiRes<true> E{x_in, XB, MOD + 2 * 1024};
      pg8::gemm_phase<pg8::EpiRes<true>, pg8::StaticOrder, true, true>(F.lds, g, S, E); }
    GRID_BAR();
    { PH_FRAME PH_PTRS norm_rows<false>(F, XB, norm_ffn, MOD, 3, 4, HN, HQ, HS); }
    GRID_BAR();
    { PH_FRAME PH_PTRS
      pg8::Gemm g{HN, WQ0, MROWS, 2048, 1024}; pg8::StaticOrder S; S.init(MROWS, 2048, F.G, (int)blockIdx.x);
      pg8::EpiBf16<0> E{QP, 2048, nullptr, 0, 0, 1.f};
      pg8::gemm_phase<pg8::EpiBf16<0>, pg8::StaticOrder, true, true>(F.lds, g, S, E); }
    GRID_BAR();
    { PH_FRAME PH_PTRS peer_scores_phase(F, QP, SUBK, ENT); }
    GRID_BAR();
    { PH_FRAME PH_PTRS PeerT T{U8, V8s, USC, VSC, ENT, ACT, HQ, HS, XB, nullptr, MOD + 5 * 1024}; peer_gather_phase<0>(F, 1, T); }
    GRID_BAR();
#ifdef XVAR
    { PH_FRAME PH_PTRS PeerT T{U8, V8s, USC, VSC, ENT, (float*)(ws + WS_PL), HQ, HS, XB, nullptr, MOD + 5 * 1024}; peer_gather_phase<0, XVAR>(F, 40, T); }
    GRID_BAR();
#endif
    { PH_FRAME PH_PTRS PeerT T{U8, V8s, USC, VSC, ENT, ACT, HQ, HS, XB, nullptr, MOD + 5 * 1024}; peer_gather_phase<1>(F, 9, T); }
    GRID_BAR();
#ifdef XVVAR
    { PH_FRAME PH_PTRS PeerT T{U8, V8s, USC, VSC, ENT, ACT, HQ, HS, XB, (float*)(ws + WS_QP), MOD + 5 * 1024}; peer_gather_phase<1, XVVAR>(F, 48, T); }
    GRID_BAR();
#endif
    { PH_FRAME PH_PTRS norm_rows<false>(F, XB, norm_mix + 1024, MOD + 2 * 6144, 0, 1, HN); }
    GRID_BAR();
    { PH_FRAME PH_PTRS
      pg8::Gemm g{HN, WIN1, MROWS, 2048, 1024}; pg8::StaticOrder S; S.init(MROWS, 2048, F.G, (int)blockIdx.x);
      pg8::EpiHeads E{Q1, K1, 16, 0.125f};
      pg8::gemm_phase<pg8::EpiHeads, pg8::StaticOrder, true, true>(F.lds, g, S, E); }
    { PH_FRAME PH_PTRS
      pg8::Gemm g{WIN1 + (size_t)2048 * 1024, HN, 1024, MROWS, 1024}; pg8::StaticOrder S; S.init(1024, MROWS, F.G, (int)blockIdx.x);
      pg8::EpiVT E{VT1, 1024};
      pg8::gemm_phase<pg8::EpiVT, pg8::StaticOrder, true, true>(F.lds, g, S, E); }
    GRID_BAR();
    { PH_FRAME PH_PTRS for (int u = blockIdx.x; u < 1024; u += F.G) sb_wg_unit(u, Q1, K1, VT1, YCAT, F.lds, F.tid, F.wave, F.lane); }
    GRID_BAR();
    { PH_FRAME PH_PTRS
      pg8::Gemm g{YCAT, WOUT1, MROWS, 1024, 1024}; pg8::StaticOrder S; S.init(MROWS, 1024, F.G, (int)blockIdx.x);
      pg8::EpiRes<false> E{nullptr, XB, MOD + 2 * 6144 + 2 * 1024};
      pg8::gemm_phase<pg8::EpiRes<false>, pg8::StaticOrder, true, true>(F.lds, g, S, E); }
    GRID_BAR();
    { PH_FRAME PH_PTRS norm_rows<false>(F, XB, norm_ffn + 1024, MOD + 2 * 6144, 3, 4, HN, HQ, HS); }
    GRID_BAR();
    { PH_FRAME PH_PTRS
      pg8::Gemm g{HN, WQ1, MROWS, 2048, 1024}; pg8::StaticOrder S; S.init(MROWS, 2048, F.G, (int)blockIdx.x);
      pg8::EpiBf16<0> E{QP, 2048, nullptr, 0, 0, 1.f};
      pg8::gemm_phase<pg8::EpiBf16<0>, pg8::StaticOrder, true, true>(F.lds, g, S, E); }
    GRID_BAR();
    { PH_FRAME PH_PTRS peer_scores_phase(F, QP, SUBK + 262144, ENT); }
    GRID_BAR();
    { PH_FRAME PH_PTRS PeerT T{U8 + (size_t)16384 * 1024, V8s + (size_t)16384 * 1024, USC + 16384, VSC + 16384, ENT, ACT, HQ, HS, XB, X, MOD + 2 * 6144 + 5 * 1024}; peer_gather_phase<0>(F, 17, T); }
    GRID_BAR();
    { PH_FRAME PH_PTRS PeerT T{U8 + (size_t)16384 * 1024, V8s + (size_t)16384 * 1024, USC + 16384, VSC + 16384, ENT, ACT, HQ, HS, XB, X, MOD + 2 * 6144 + 5 * 1024}; peer_gather_phase<1>(F, 25, T);
      if (__hip_atomic_load((gu32*)((unsigned*)(F.ctl + CW_BAR) + XB_TMO), RLX_AGENT) != 0u) { for (int m = F.gw; m < MROWS; m += F.NGW) X[(size_t)m * 1024 + F.lane] = __builtin_nanf(""); } }
#ifdef PROBE_MASK
#ifdef PROBE_BARS
    for (int i = 0; i < PROBE_BARS; ++i) xcd_barrier(bar);
#endif
    STAMP();
    if (blockIdx.x == PROBE_BLK && threadIdx.x == 0) { unsigned long long tsel = 0;
        for (int i = 0; i + 1 < nst_; ++i) if ((PROBE_MASK >> i) & 1ull) tsel += stamps_[i + 1] - stamps_[i];

        const unsigned long long t0 = __builtin_amdgcn_s_memrealtime(); while (__builtin_amdgcn_s_memrealtime() - t0 < tsel * PROBE_AMP) __builtin_amdgcn_s_sleep(8); }
#endif
}

extern "C" void kernel_launch(void* const* d_in, const int* in_sizes, int n_in, void* d_out, int out_size, void* d_ws, size_t ws_size, hipStream_t stream) {
    static int grid = 0;
    if (grid == 0) {
        if (n_in != 19 || out_size != MROWS * DM || ws_size < WS_END) { fprintf(stderr, "kernel_launch: unexpected shapes (n_in %d, out %d, ws %zu)\n", n_in, out_size, ws_size); grid = -1; return; }
        int dev = 0, cus = 0, per_cu = 0;
        if (hipGetDevice(&dev) != hipSuccess || hipDeviceGetAttribute(&cus, hipDeviceAttributeMultiprocessorCount, dev) != hipSuccess) { grid = -1; return; }
        if (hipFuncSetAttribute((const void*)hybrid_fwd, hipFuncAttributeMaxDynamicSharedMemorySize, LDS_BYTES) != hipSuccess) { fprintf(stderr, "kernel_launch: hipFuncSetAttribute failed\n"); grid = -1; return; }
        if (hipOccupancyMaxActiveBlocksPerMultiprocessor(&per_cu, (const void*)hybrid_fwd, NTHR, LDS_BYTES) != hipSuccess || per_cu < 1) { fprintf(stderr, "kernel_launch: occupancy query says %d\n", per_cu); per_cu = 1; }
        (void)hipGetLastError();
        grid = cus;
    }
    if (grid < 0) return;
    if (hipMemsetAsync((char*)d_ws + WS_CTL, 0, CTL_ZERO_BYTES, stream) != hipSuccess) { fprintf(stderr, "kernel_launch: memset failed\n"); return; }
    Args a{};
    for (int i = 0; i < 19; ++i) a.in[i] = (const float*)d_in[i];
    a.out = (float*)d_out; a.ws = (unsigned char*)d_ws; a.stage = 0; a.pad = 0;
    void* kargs[] = {&a};
    hipError_t e = hipLaunchCooperativeKernel((const void*)hybrid_fwd, dim3(grid), dim3(NTHR), kargs, LDS_BYTES, stream);
    if (e != hipSuccess) fprintf(stderr, "kernel_launch: cooperative launch failed: %s (grid %d)\n", hipGetErrorString(e), grid);
}
```

```cpp
#include <hip/hip_runtime.h>
#include <cstdio>
#include <cstdint>
#include <cmath>
namespace pg8 {
#define PG8_LAS __attribute__((address_space(3)))
typedef unsigned short bf16_t;
typedef short bf16x8 __attribute__((ext_vector_type(8)));
typedef float f32x4 __attribute__((ext_vector_type(4)));
typedef unsigned u32x4 __attribute__((ext_vector_type(4)));
constexpr int BM = 256, BK = 64, HALF = 128, HTB = HALF * BK * 2  , STAGE_BYTES = 8 * HTB, NXCD = 8, WGM = 8;

__host__ __device__ __forceinline__ int lds_byte(int r, int c) { const int st = (r >> 4) * 2 + (c >> 5), rr = r & 15, cc = c & 31, ob = rr * 64 + cc * 2; return st * 1024 + (ob ^ (((ob >> 9) & 1) << 5)); }
__host__ __device__ __forceinline__ void stage_rc(int b, int& R, int& C) { const int st = b / 1024, sb = b % 1024, swz = sb ^ (((sb >> 9) & 1) << 5); R = (st >> 1) * 16 + swz / 64; C = (st & 1) * 32 + (swz % 64) / 2; }
__host__ __device__ __forceinline__ int perm32(int rho) { const int n = rho >> 4, i = rho & 15; return 8 * (i >> 2) + 4 * n + (i & 3); }

struct Unit { int pm, pn; };
struct Gemm { const bf16_t* A; const bf16_t* Bt; int M, N, K; };

struct StaticOrder {
    int nM, nN, nwg, G, c;
    __host__ __device__ void init(int M, int N, int G_, int c_) { nM = M / BM; nN = N / BM; nwg = nM * nN; G = G_; c = c_; }
    __host__ __device__ bool next(int i, Unit& u) const {
        const long L = (long)i * G + c; if (L >= nwg) return false;
        int wgid = (int)L; { const int q = nwg / NXCD, r = nwg % NXCD, xcd = wgid % NXCD, off = wgid / NXCD; wgid = (xcd < r ? xcd * (q + 1) : r * (q + 1) + (xcd - r) * q) + off; }
        const int nig = WGM * nN, gid = wgid / nig, fm = gid * WGM, gsz = (nM - fm) < WGM ? (nM - fm) : WGM;
        u.pm = fm + ((wgid % nig) % gsz); u.pn = (wgid % nig) / gsz; return true;
    }
    __device__ __forceinline__ void a_ready(const Unit&) const {}
    __device__ __forceinline__ void done(const Unit&) const {}
};

__device__ __forceinline__ unsigned cvt_pk_bf16(float lo, float hi) { unsigned r; asm volatile("v_cvt_pk_bf16_f32 %0, %1, %2" : "=v"(r) : "v"(lo), "v"(hi)); return r; }
typedef float f32x2 __attribute__((ext_vector_type(2)));
__device__ __forceinline__ f32x2 gelu_pk(f32x2 v) {
    const f32x2 av = __builtin_elementwise_abs(v), d = av * 0.2316418882f + 1.0f;
    f32x2 t; t.x = __builtin_amdgcn_rcpf(d.x); t.y = __builtin_amdgcn_rcpf(d.y);
    f32x2 q = t * 0.5307027145f + (-0.7265760135f); q = q * t + 0.7107068705f; q = q * t + (-0.142248368f); q = q * t + 0.127414796f; q = q * t;
    const f32x2 s = (v * v) * (-0.72134752044f);
    f32x2 e; e.x = __builtin_amdgcn_exp2f(s.x); e.y = __builtin_amdgcn_exp2f(s.y);
    const f32x2 m = v * (q * e), r = v - m;
    f32x2 o; o.x = v.x < 0.f ? m.x : r.x; o.y = v.y < 0.f ? m.y : r.y; return o;
}

template <int ACT  > struct EpiBf16 {
    static constexpr bool PERM = true, AFTER_DRAIN = false; static_assert(ACT == 0 || ACT == 1, "EpiBf16: ACT is 0 (none) or 1 (gelu_pk)");
    bf16_t* O; int ldc; const float* bias; int split_cols; size_t split_stride; float scale0;
    __device__ __forceinline__ void operator()(const f32x4 (&acc)[2][2][4][2], const Unit& u, int wr, int wc, int fr, int fq) const {
        const int row0 = u.pm * BM + wr * 64 + fr; int colt = u.pn * BM; bf16_t* base = O;
        float sc = 1.f; if (split_cols) { const int t = colt / split_cols; base += (size_t)t * split_stride; colt -= t * split_cols; if (t == 0) sc = scale0; }
        const int col0 = colt + wc * 32 + 8 * fq, bcol0 = u.pn * BM + wc * 32 + 8 * fq;
        f32x4 bv[2][2];
#pragma unroll
        for (int bj = 0; bj < 2; ++bj)
#pragma unroll
            for (int n = 0; n < 2; ++n) bv[bj][n] = bias ? *(const f32x4*)(bias + bcol0 + bj * HALF + 4 * n) : (f32x4){0.f, 0.f, 0.f, 0.f};
#pragma unroll
        for (int ai = 0; ai < 2; ++ai)
#pragma unroll
            for (int m = 0; m < 4; ++m) { bf16_t* rowp = base + (size_t)(row0 + ai * HALF + m * 16) * ldc + col0;
#pragma unroll
                for (int bj = 0; bj < 2; ++bj) { f32x4 v0 = acc[ai][bj][m][0] + bv[bj][0], v1 = acc[ai][bj][m][1] + bv[bj][1];
                    if (ACT == 1) { f32x2 a = gelu_pk((f32x2){v0[0], v0[1]}), b = gelu_pk((f32x2){v0[2], v0[3]}), c = gelu_pk((f32x2){v1[0], v1[1]}), d = gelu_pk((f32x2){v1[2], v1[3]});
                        v0 = (f32x4){a.x, a.y, b.x, b.y}; v1 = (f32x4){c.x, c.y, d.x, d.y}; }
                    v0 = v0 * sc; v1 = v1 * sc; u32x4 w; w.x = cvt_pk_bf16(v0[0], v0[1]); w.y = cvt_pk_bf16(v0[2], v0[3]); w.z = cvt_pk_bf16(v1[0], v1[1]); w.w = cvt_pk_bf16(v1[2], v1[3]);
                    *(u32x4*)(rowp + bj * HALF) = w; } }
    }
};
constexpr int XSEQ = 8192;
typedef float f32x2e __attribute__((ext_vector_type(2))); typedef __bf16 bf16x2e __attribute__((ext_vector_type(2)));
__device__ __forceinline__ unsigned cvtpk2(float lo, float hi) { f32x2e v = {lo, hi}; bf16x2e b = __builtin_convertvector(v, bf16x2e); return __builtin_bit_cast(unsigned, b); }
__device__ __forceinline__ float gelu_tanh(float x) {
    const float u2 = x * (1.5957691216f + 0.0713548163f * x * x);
    return x * __builtin_amdgcn_rcpf(1.0f + __builtin_amdgcn_exp2f(-1.4426950409f * u2));
}
struct EpiL0m {
    static constexpr bool PERM = true, AFTER_DRAIN = false;
    bf16_t *UA, *VA, *QKR;
    template <bool ACT> __device__ __forceinline__ void tile(const f32x4 (&acc)[2][2][4][2], bf16_t* base, int ldc, int row0, int colt) const {
#pragma unroll
        for (int ai = 0; ai < 2; ++ai)
#pragma unroll
            for (int m = 0; m < 4; ++m) { bf16_t* rowp = base + (size_t)(row0 + ai * HALF + m * 16) * ldc + colt;
#pragma unroll
                for (int bj = 0; bj < 2; ++bj) { f32x4 v0 = acc[ai][bj][m][0], v1 = acc[ai][bj][m][1]; u32x4 w;
                    if (ACT) { v0[0] = gelu_tanh(v0[0]); v0[1] = gelu_tanh(v0[1]); v0[2] = gelu_tanh(v0[2]); v0[3] = gelu_tanh(v0[3]); v1[0] = gelu_tanh(v1[0]); v1[1] = gelu_tanh(v1[1]); v1[2] = gelu_tanh(v1[2]); v1[3] = gelu_tanh(v1[3]); }
                    w.x = cvtpk2(v0[0], v0[1]); w.y = cvtpk2(v0[2], v0[3]); w.z = cvtpk2(v1[0], v1[1]); w.w = cvtpk2(v1[2], v1[3]);
                    *(u32x4*)(rowp + bj * HALF) = w; } }
    }
    __device__ __forceinline__ void operator()(const f32x4 (&acc)[2][2][4][2], const Unit& u, int wr, int wc, int fr, int fq) const {
        const int pn = u.pn; const int row0 = u.pm * BM + wr * 64 + fr; const int cw = wc * 32 + 8 * fq;
        if (pn < 2) tile<true>(acc, UA, 512, row0, pn * 256 + cw);
        else if (pn < 4) tile<true>(acc, VA, 512, row0, (pn - 2) * 256 + cw);
        else tile<false>(acc, QKR, 1024, row0, (pn - 4) * 256 + cw);
    }
};
struct EpiHeads {
    static constexpr bool PERM = true, AFTER_DRAIN = false;
    bf16_t *Q, *Kp; int nh; float qscale;
    __device__ __forceinline__ void operator()(const f32x4 (&acc)[2][2][4][2], const Unit& u, int wr, int wc, int fr, int fq) const {
        const int b = u.pm >> 5, sb = (u.pm & 31) * 256 + wr * 64 + fr;
#pragma unroll
        for (int bj = 0; bj < 2; ++bj) { const int c = u.pn * BM + bj * HALF + wc * 32 + 8 * fq; const int t = c / (64 * nh), cc = c - t * 64 * nh, head = cc >> 6, d = cc & 63;
            bf16_t* dst = (t ? Kp : Q) + ((size_t)(b * nh + head) * XSEQ) * 64 + d;
#pragma unroll
            for (int ai = 0; ai < 2; ++ai)
#pragma unroll
                for (int m = 0; m < 4; ++m) { const int s = sb + ai * HALF + m * 16; const float qs = t ? 1.0f : qscale; const f32x4 v0 = acc[ai][bj][m][0] * qs, v1 = acc[ai][bj][m][1] * qs; u32x4 w;
                    w.x = cvtpk2(v0[0], v0[1]); w.y = cvtpk2(v0[2], v0[3]); w.z = cvtpk2(v1[0], v1[1]); w.w = cvtpk2(v1[2], v1[3]);
                    *(u32x4*)(dst + (size_t)s * 64) = w; } }
    }
};
struct EpiVT {
    static constexpr bool PERM = true, AFTER_DRAIN = false;
    bf16_t* VT; int nrows;
    __device__ __forceinline__ void operator()(const f32x4 (&acc)[2][2][4][2], const Unit& u, int wr, int wc, int fr, int fq) const {
        const int row0 = u.pm * BM + wr * 64 + fr; const int c0 = u.pn * BM + wc * 32 + 8 * fq; const int b = c0 >> 13, s0 = c0 & (XSEQ - 1);
#pragma unroll
        for (int ai = 0; ai < 2; ++ai)
#pragma unroll
            for (int m = 0; m < 4; ++m) { bf16_t* rowp = VT + ((size_t)b * nrows + row0 + ai * HALF + m * 16) * XSEQ + s0;
#pragma unroll
                for (int bj = 0; bj < 2; ++bj) { const f32x4 v0 = acc[ai][bj][m][0], v1 = acc[ai][bj][m][1]; u32x4 w;
                    w.x = cvtpk2(v0[0], v0[1]); w.y = cvtpk2(v0[2], v0[3]); w.z = cvtpk2(v1[0], v1[1]); w.w = cvtpk2(v1[2], v1[3]);
                    *(u32x4*)(rowp + bj * HALF) = w; } }
    }
};
template <bool XIN_F32> struct EpiRes {
    static constexpr bool PERM = true, AFTER_DRAIN = false;
    const float* xin; bf16_t* XB; const float* g;
    __device__ __forceinline__ void operator()(const f32x4 (&acc)[2][2][4][2], const Unit& u, int wr, int wc, int fr, int fq) const {
        const int row0 = u.pm * BM + wr * 64 + fr, col0 = u.pn * BM + wc * 32 + 8 * fq; const int b = u.pm >> 5;
        f32x4 gv[2][2];
#pragma unroll
        for (int bj = 0; bj < 2; ++bj)
#pragma unroll
            for (int n = 0; n < 2; ++n) gv[bj][n] = *(const f32x4*)(g + b * 6144 + col0 + bj * HALF + 4 * n);
#pragma unroll
        for (int ai = 0; ai < 2; ++ai)
#pragma unroll
            for (int m = 0; m < 4; ++m) { const size_t off = (size_t)(row0 + ai * HALF + m * 16) * 1024 + col0;
#pragma unroll
                for (int bj = 0; bj < 2; ++bj) { f32x4 x0, x1;
                    if (XIN_F32) { x0 = *(const f32x4*)(xin + off + bj * HALF); x1 = *(const f32x4*)(xin + off + bj * HALF + 4); }
                    else { const u32x4 w = *(const u32x4*)(XB + off + bj * HALF); x0 = (f32x4){__uint_as_float(w.x << 16), __uint_as_float(w.x & 0xffff0000u), __uint_as_float(w.y << 16), __uint_as_float(w.y & 0xffff0000u)};
                        x1 = (f32x4){__uint_as_float(w.z << 16), __uint_as_float(w.z & 0xffff0000u), __uint_as_float(w.w << 16), __uint_as_float(w.w & 0xffff0000u)}; }
                    const f32x4 y0 = x0 + gv[bj][0] * acc[ai][bj][m][0], y1 = x1 + gv[bj][1] * acc[ai][bj][m][1]; u32x4 o;
                    o.x = cvtpk2(y0[0], y0[1]); o.y = cvtpk2(y0[2], y0[3]); o.z = cvtpk2(y1[0], y1[1]); o.w = cvtpk2(y1[2], y1[3]);
                    *(u32x4*)(XB + off + bj * HALF) = o; } }
    }
};
template <class Epi, class Sched, bool ALIGN_EPI = false, bool SP2 = false>
__device__ __forceinline__ void gemm_phase(PG8_LAS unsigned char* lds, const Gemm g, const Sched& S, const Epi& E) {
    int tid_ = threadIdx.x; asm volatile("" : "+v"(tid_));
    const int tid = tid_, wid = __builtin_amdgcn_readfirstlane(tid >> 6), lane = tid & 63, wr = wid >> 2, wc = wid & 3, fr = lane & 15, fq = lane >> 4;
    const int K = g.K, nt = K / BK;
    unsigned voffA[2], voffB[2];
#pragma unroll
    for (int i = 0; i < 2; ++i) { int R, C; stage_rc(tid * 16 + i * 8192, R, C); const int Rb = Epi::PERM ? ((R & ~31) + perm32(R & 31)) : R;
        voffA[i] = (unsigned)(R * K + C) * 2u; voffB[i] = (unsigned)(Rb * K + C) * 2u; }
    const size_t kstep = (size_t)(BK * 2);
    const size_t hstep = (size_t)HALF * K * 2;
    const size_t tstep = 2 * hstep;
    const unsigned ldsw = (unsigned)wid * 1024u;
    const int aoff = lds_byte(wr * 64 + fr, fq * 8), boff = lds_byte(wc * 32 + fr, fq * 8);
#define PG8_SA(b, h) (((b) * 2 + (h)) * HTB)
#define PG8_SB(b, h) ((4 + (b) * 2 + (h)) * HTB)
#define PG8_STAGE(bufoff, gbase, voff) do { _Pragma("unroll") for (int _i = 0; _i < 2; ++_i) \
        __builtin_amdgcn_global_load_lds((const unsigned*)((const char*)(gbase) + (voff)[_i]), (PG8_LAS unsigned*)(lds + (bufoff) + ldsw + _i * 8192), 16, 0, 0); } while (0)
#define PG8_LDA(dst, b, h) do { _Pragma("unroll") for (int m = 0; m < 4; ++m) _Pragma("unroll") for (int k = 0; k < 2; ++k) dst[m][k] = *(const PG8_LAS bf16x8*)(lds + PG8_SA(b, h) + aoff + m * 2048 + k * 1024); } while (0)
#define PG8_LDB(dst, b, h) do { _Pragma("unroll") for (int n = 0; n < 2; ++n) _Pragma("unroll") for (int k = 0; k < 2; ++k) dst[n][k] = *(const PG8_LAS bf16x8*)(lds + PG8_SB(b, h) + boff + n * 2048 + k * 1024); } while (0)
#define PG8_MMA(ai, bj, At, Bt) do { __builtin_amdgcn_s_setprio(1); _Pragma("unroll") for (int m = 0; m < 4; ++m) _Pragma("unroll") for (int n = 0; n < 2; ++n) _Pragma("unroll") for (int k = 0; k < 2; ++k) \
        acc[ai][bj][m][n] = __builtin_amdgcn_mfma_f32_16x16x32_bf16(Bt[n][k], At[m][k], acc[ai][bj][m][n], 0, 0, 0); __builtin_amdgcn_s_setprio(0); } while (0)
#define PG8_WAIT_V(n) asm volatile("s_waitcnt vmcnt(" #n ")" ::: "memory")
#define PG8_WAIT_L(n) asm volatile("s_waitcnt lgkmcnt(" #n ")" ::: "memory")
#define PG8_BAR __builtin_amdgcn_s_barrier()
#define PG8_SCHED __builtin_amdgcn_sched_barrier(0)
    Unit cur, nxt; int ui = 0;
    if (!S.next(0, cur)) return;
    f32x4 acc[2][2][4][2];
#pragma unroll
    for (int a = 0; a < 2; ++a)
#pragma unroll
        for (int b = 0; b < 2; ++b)
#pragma unroll
            for (int m = 0; m < 4; ++m)
#pragma unroll
                for (int n = 0; n < 2; ++n) acc[a][b][m][n] = (f32x4){0.f, 0.f, 0.f, 0.f};
    bf16x8 At[4][2], B0[2][2], B1[2][2];
    const char* cA = (const char*)g.A + (size_t)cur.pm * tstep; const char* cB = (const char*)g.Bt + (size_t)cur.pn * tstep;
    S.a_ready(cur);
    if constexpr (SP2) {
        PG8_STAGE(PG8_SB(0, 0), cB, voffB); PG8_STAGE(PG8_SB(0, 1), cB + hstep, voffB); PG8_STAGE(PG8_SA(0, 0), cA, voffA); PG8_STAGE(PG8_SA(0, 1), cA + hstep, voffA);
        if (wr == 1) PG8_BAR;
        PG8_WAIT_V(2); PG8_BAR;
        PG8_STAGE(PG8_SB(1, 0), cB + kstep, voffB); PG8_STAGE(PG8_SA(1, 0), cA + kstep, voffA); PG8_STAGE(PG8_SB(1, 1), cB + hstep + kstep, voffB);
        PG8_WAIT_V(6); PG8_BAR;
    } else {
        PG8_STAGE(PG8_SB(0, 0), cB, voffB); PG8_STAGE(PG8_SA(0, 0), cA, voffA); PG8_STAGE(PG8_SB(0, 1), cB + hstep, voffB); PG8_STAGE(PG8_SA(0, 1), cA + hstep, voffA);
        if (wr == 1) PG8_BAR;
        PG8_WAIT_V(4); PG8_BAR;
        PG8_STAGE(PG8_SB(1, 0), cB + kstep, voffB); PG8_STAGE(PG8_SA(1, 0), cA + kstep, voffA); PG8_STAGE(PG8_SB(1, 1), cB + hstep + kstep, voffB);
        PG8_WAIT_V(6); PG8_BAR;
    }
    for (;;) {
        const bool has_next = S.next(ui + 1, nxt);
        const char* nA = has_next ? (const char*)g.A + (size_t)nxt.pm * tstep : cA; const char* nB = has_next ? (const char*)g.Bt + (size_t)nxt.pn * tstep : cB;
        for (int t = 0; t < nt; t += 2) {
            const bool last = (t == nt - 2);
            const char* a1 = cA + (size_t)(t + 1) * kstep;
            const char* a2 = last ? nA : cA + (size_t)(t + 2) * kstep; const char* b2 = last ? nB : cB + (size_t)(t + 2) * kstep;
            const char* a3 = a2 + kstep; const char* b3 = b2 + kstep;
            if (last && has_next) S.a_ready(nxt);
            if constexpr (SP2) {
            PG8_LDB(B0, 0, 0); PG8_LDB(B1, 0, 1); PG8_SCHED; PG8_LDA(At, 0, 0); PG8_STAGE(PG8_SA(1, 1), a1 + hstep, voffA);
            PG8_WAIT_V(8); PG8_WAIT_L(0); PG8_BAR; PG8_MMA(0, 0, At, B0); PG8_MMA(0, 1, At, B1); PG8_BAR; PG8_SCHED;
            PG8_LDA(At, 0, 1); PG8_STAGE(PG8_SB(0, 0), b2, voffB); PG8_STAGE(PG8_SB(0, 1), b2 + hstep, voffB); PG8_STAGE(PG8_SA(0, 0), a2, voffA);
            PG8_WAIT_V(8); PG8_WAIT_L(0); PG8_BAR; PG8_MMA(1, 0, At, B0); PG8_MMA(1, 1, At, B1); PG8_BAR; PG8_SCHED;
            PG8_LDB(B0, 1, 0); PG8_LDB(B1, 1, 1); PG8_SCHED; PG8_LDA(At, 1, 0); PG8_STAGE(PG8_SA(0, 1), a2 + hstep, voffA);
            PG8_WAIT_V(8); PG8_WAIT_L(0); PG8_BAR; PG8_MMA(0, 0, At, B0); PG8_MMA(0, 1, At, B1); PG8_BAR; PG8_SCHED;
            PG8_LDA(At, 1, 1); PG8_STAGE(PG8_SB(1, 0), b3, voffB); PG8_STAGE(PG8_SB(1, 1), b3 + hstep, voffB); PG8_STAGE(PG8_SA(1, 0), a3, voffA);
            PG8_WAIT_V(8); PG8_WAIT_L(0); PG8_BAR; PG8_MMA(1, 0, At, B0); PG8_MMA(1, 1, At, B1); PG8_BAR; PG8_SCHED;
            } else {
            PG8_LDB(B0, 0, 0); PG8_SCHED; PG8_LDA(At, 0, 0); PG8_STAGE(PG8_SA(1, 1), a1 + hstep, voffA);
            PG8_WAIT_L(8); PG8_BAR; PG8_WAIT_L(0); PG8_MMA(0, 0, At, B0); PG8_BAR; PG8_SCHED;
            PG8_LDB(B1, 0, 1); PG8_STAGE(PG8_SB(0, 0), b2, voffB);
            PG8_BAR; PG8_WAIT_L(0); PG8_MMA(0, 1, At, B1); PG8_BAR;
            PG8_LDA(At, 0, 1); PG8_STAGE(PG8_SA(0, 0), a2, voffA);
            PG8_BAR; PG8_WAIT_L(0); PG8_MMA(1, 0, At, B0); PG8_BAR; PG8_SCHED;
            PG8_STAGE(PG8_SB(0, 1), b2 + hstep, voffB);
            PG8_WAIT_V(6); PG8_BAR; PG8_MMA(1, 1, At, B1); PG8_BAR;
            PG8_LDB(B0, 1, 0); PG8_SCHED; PG8_LDA(At, 1, 0); PG8_STAGE(PG8_SA(0, 1), a2 + hstep, voffA);
            PG8_WAIT_L(8); PG8_BAR; PG8_WAIT_L(0); PG8_MMA(0, 0, At, B0); PG8_BAR; PG8_SCHED;
            PG8_LDB(B1, 1, 1); PG8_STAGE(PG8_SB(1, 0), b3, voffB);
            PG8_BAR; PG8_WAIT_L(0); PG8_MMA(0, 1, At, B1); PG8_BAR;
            PG8_LDA(At, 1, 1); PG8_STAGE(PG8_SA(1, 0), a3, voffA);
            PG8_BAR; PG8_WAIT_L(0); PG8_MMA(1, 0, At, B0); PG8_BAR; PG8_SCHED;
            PG8_STAGE(PG8_SB(1, 1), b3 + hstep, voffB);
            PG8_WAIT_V(6); PG8_BAR; PG8_MMA(1, 1, At, B1); PG8_BAR;
            }
        }
        if constexpr (ALIGN_EPI) { if (wr == 0) PG8_BAR; }
        if constexpr (!Epi::AFTER_DRAIN) { E(acc, cur, wr, wc, fr, fq); S.done(cur); }
        if (!has_next) break;
#pragma unroll
        for (int a = 0; a < 2; ++a)
#pragma unroll
            for (int b = 0; b < 2; ++b)
#pragma unroll
                for (int m = 0; m < 4; ++m)
#pragma unroll
                    for (int n = 0; n < 2; ++n) acc[a][b][m][n] = (f32x4){0.f, 0.f, 0.f, 0.f};
        cur = nxt; cA = nA; cB = nB; ++ui;
        if constexpr (ALIGN_EPI) { if (wr == 1) PG8_BAR; }
    }
    PG8_WAIT_V(0);
    if constexpr (!ALIGN_EPI) { if (wr == 0) PG8_BAR; }
    PG8_BAR;
    if constexpr (Epi::AFTER_DRAIN) { E.fused(acc, cur, wr, wc, fr, fq, lds, wid, lane); S.done(cur); }
#undef PG8_SA
#undef PG8_SB
#undef PG8_STAGE
#undef PG8_LDA
#undef PG8_LDB
#undef PG8_MMA
#undef PG8_WAIT_V
#undef PG8_WAIT_L
#undef PG8_BAR
#undef PG8_SCHED
}
}
#define GAS __attribute__((address_space(1)))
#define LAS __attribute__((address_space(3)))
typedef unsigned short bf16;
typedef unsigned v4u __attribute__((ext_vector_type(4)));
typedef float f32x4 __attribute__((ext_vector_type(4)));
typedef short bf16x8 __attribute__((ext_vector_type(8)));
typedef GAS unsigned gu32;
typedef GAS unsigned long long gu64;
#define RLX_AGENT __ATOMIC_RELAXED, __HIP_MEMORY_SCOPE_AGENT
#define LDS_WAIT() asm volatile("s_waitcnt lgkmcnt(0)" ::: "memory")
#define VM_WAIT() asm volatile("s_waitcnt vmcnt(0)" ::: "memory")
__device__ __forceinline__ unsigned long long rt() { return __builtin_amdgcn_s_memrealtime(); }
__device__ __forceinline__ unsigned f2bf(float f) { unsigned u = __builtin_bit_cast(unsigned, f); return (u + 0x7fffu + ((u >> 16) & 1u)) >> 16; }
__device__ __forceinline__ unsigned pk2(float lo, float hi) { return f2bf(lo) | (f2bf(hi) << 16); }

#define XB_TMO      128
#define XB_XCNT(j)  (256  + 64 * (j))
#define XB_XSUB(j)  (1280 + 64 * (j))
#define XB_XGEN(j)  (2304 + 64 * (j))
#define XB_TOP      3328
#define XB_TOPGEN   3392
#define XCD_BAR_WORDS 3456
#define XB_SPIN_CAP (1u << 18)

__device__ __forceinline__ unsigned xb_ld(unsigned* p)              { return __hip_atomic_load(p, __ATOMIC_RELAXED, __HIP_MEMORY_SCOPE_AGENT); }
__device__ __forceinline__ unsigned xb_add(unsigned* p, unsigned v) { return __hip_atomic_fetch_add(p, v, __ATOMIC_RELAXED, __HIP_MEMORY_SCOPE_AGENT); }
__device__ __forceinline__ unsigned xb_xcc_id() { return (unsigned)__builtin_amdgcn_s_getreg((3 << 11) | 20) & 0xFu; }
#define XB_SPIN(cond, bar) do { unsigned _sp = 0; while (cond) { __builtin_amdgcn_s_sleep(1); \
    if ((++_sp & 255u) == 0u) { if (xb_ld(&(bar)[XB_TMO])) break; if (_sp > XB_SPIN_CAP) { atomicAdd(&(bar)[XB_TMO], 1u); break; } } } } while (0)

struct XcdBarrier {
    unsigned* bar; unsigned x;
    volatile LAS unsigned* st;
};

__device__ __forceinline__ XcdBarrier xcd_barrier_post(unsigned* bar, volatile LAS unsigned* st) {
    XcdBarrier b; b.bar = bar; b.x = xb_xcc_id(); b.st = st;
    if (threadIdx.x == 0) (void)xb_add(&bar[XB_XCNT(b.x)], 1u);
    return b;
}
__device__ __forceinline__ void xcd_barrier_complete(unsigned* bar, unsigned x, unsigned& nloc, unsigned& nx) {
    const unsigned G = gridDim.x * gridDim.y * gridDim.z;
    unsigned sum, cnt, mine, sp = 0u;
    for (;;) {
        sum = 0u; cnt = 0u; mine = 0u;
#pragma unroll
        for (unsigned j = 0; j < 16; ++j) { const unsigned c = xb_ld(&bar[XB_XCNT(j)]); sum += c; cnt += (c > 0u) ? 1u : 0u; mine = (j == x) ? c : mine; }
        if (sum == G) break;
        __builtin_amdgcn_s_sleep(1);
        if ((++sp & 255u) == 0u) { if (xb_ld(&bar[XB_TMO])) break; if (sp > XB_SPIN_CAP) { atomicAdd(&bar[XB_TMO], 1u); break; } }
    }
    nloc = mine > 0u ? mine : 1u; nx = cnt > 0u ? cnt : 1u;
}

__device__ __forceinline__ void xcd_barrier(const XcdBarrier& b) {
    asm volatile("s_waitcnt vmcnt(0)" ::: "memory");
    __syncthreads();
    if (threadIdx.x == 0) {
        unsigned* bar = b.bar;
        __builtin_amdgcn_s_waitcnt(0);
        unsigned nloc = b.st[0], nx = b.st[1];
        if (nloc == 0u) { xcd_barrier_complete(bar, b.x, nloc, nx); b.st[0] = nloc; b.st[1] = nx; }
        const unsigned old = xb_add(&bar[XB_XSUB(b.x)], 1u);
        const unsigned gen = old / nloc;
        if (old + 1u == (gen + 1u) * nloc) {
            __builtin_amdgcn_fence(__ATOMIC_RELEASE, "agent");
            asm volatile("s_waitcnt vmcnt(0)" ::: "memory");
            const unsigned og = xb_add(&bar[XB_TOP], 1u);
            const unsigned tg = og / nx;
            if (og + 1u == (tg + 1u) * nx) xb_add(&bar[XB_TOPGEN], 1u);
            else XB_SPIN(xb_ld(&bar[XB_TOPGEN]) == tg, bar);
            __builtin_amdgcn_fence(__ATOMIC_ACQUIRE, "agent");
            xb_add(&bar[XB_XGEN(b.x)], 1u);
            asm volatile("s_waitcnt vmcnt(0)" ::: "memory");
        } else {
            XB_SPIN(xb_ld(&bar[XB_XGEN(b.x)]) == gen, bar);
            __builtin_amdgcn_fence(__ATOMIC_ACQUIRE, "agent");
            asm volatile("s_waitcnt vmcnt(0)" ::: "memory");
        }
    }
    __syncthreads();
}
constexpr int NWAVES = 8, NTHR = 512;
constexpr int SEQ = 8192, DM = 1024, MROWS = 16384;
constexpr size_t MiB = 1u << 20;
constexpr size_t WS_CTL = 0, CTL_ZERO_BYTES = 2 * MiB;
constexpr size_t WS_KSUM = 1 * MiB;
constexpr size_t WS_MOD = 2 * MiB;
constexpr size_t WS_ROPE = 3 * MiB;
constexpr size_t WS_WIN0 = 4 * MiB, WS_WOUT0 = 9 * MiB, WS_WIN1 = 11 * MiB, WS_WOUT1 = 17 * MiB, WS_WQ0 = 19 * MiB, WS_WQ1 = 23 * MiB;
constexpr size_t WS_SUBK = 27 * MiB, WS_GWS = 28 * MiB, WS_MASK = 29 * MiB, WS_SC = 30 * MiB;
constexpr size_t WS_PTU = 32 * MiB, WS_PTV = 96 * MiB;
constexpr size_t WS_HN = 160 * MiB;
constexpr size_t WS_A = 192 * MiB;
constexpr size_t WS_YCAT = 288 * MiB, WS_QP = 320 * MiB, WS_PO = 384 * MiB, WS_PL = 448 * MiB, WS_XB = 450 * MiB, WS_END = 482 * MiB;
constexpr int CW_BAR = 4096, CW_WORK = 16384;

constexpr int RING_BYTES = 131072, LDSCTL_OFF = 143360, MISC_OFF = LDSCTL_OFF + 320, LDS_BYTES = 147456;

#ifndef XCC_EXPR
#define XCC_EXPR ((int)(xb_xcc_id() & 7u))
#endif
#define DI __device__ __forceinline__
typedef short bf16x8 __attribute__((ext_vector_type(8)));
typedef short s16x4 __attribute__((ext_vector_type(4)));
typedef float f32x16 __attribute__((ext_vector_type(16)));
typedef __bf16 bf16x2t __attribute__((ext_vector_type(2)));
#define MFMA32(a, b, c) __builtin_amdgcn_mfma_f32_32x32x16_bf16((a), (b), (c), 0, 0, 0)
using pg8::cvtpk2; using pg8::gelu_tanh;
DI int crow(int reg, int h) { return (reg & 3) + 8 * (reg >> 2) + 4 * h; }
DI float bf_lo(unsigned w) { return __uint_as_float(w << 16); }
DI float bf_hi(unsigned w) { return __uint_as_float(w & 0xffff0000u); }
DI bf16x8 ld16g(const bf16* p) { return *(const bf16x8*)p; }
DI bf16x8 ld8x2g(const bf16* p0, const bf16* p1) { const s16x4 a = *(const s16x4*)p0, b = *(const s16x4*)p1; return __builtin_shufflevector(a, b, 0, 1, 2, 3, 4, 5, 6, 7); }
DI float dot2bf(unsigned a, unsigned b, float c) { return __builtin_amdgcn_fdot2_f32_bf16(__builtin_bit_cast(bf16x2t, a), __builtin_bit_cast(bf16x2t, b), c, false); }
DI int f_ord(float f) { int i = __float_as_int(f); return i ^ ((i >> 31) & 0x7fffffff); }
DI float f_unord(int i) { return __int_as_float(i ^ ((i >> 31) & 0x7fffffff)); }
constexpr float LOG2E = 1.4426950408889634f, LN2 = 0.6931471805599453f;
#define KEY_MIN ((int)0x80000000)


template <int CTRL> DI float dppf(float x) { return __builtin_bit_cast(float, __builtin_amdgcn_update_dpp(0, __builtin_bit_cast(int, x), CTRL, 0xF, 0xF, true)); }
template <int CTRL> DI int dppi(int x) { return __builtin_amdgcn_update_dpp(0, x, CTRL, 0xF, 0xF, true); }
#define DPP_X1 0xB1
#define DPP_X2 0x4E
#define DPP_HM 0x141
#define DPP_RM 0x140
#define DPP_R8 0x128
DI unsigned px32u(unsigned x, int lane) { auto r = __builtin_amdgcn_permlane32_swap(x, x, false, false); return (lane & 32) ? r[0] : r[1]; }
DI float px32(float x, int lane) { return __uint_as_float(px32u(__float_as_uint(x), lane)); }
DI int px32(int x, int lane) { return (int)px32u((unsigned)x, lane); }
DI unsigned px16u(unsigned x, int lane) { auto r = __builtin_amdgcn_permlane16_swap(x, x, false, false); return (lane & 16) ? r[0] : r[1]; }
DI float px16(float x, int lane) { return __uint_as_float(px16u(__float_as_uint(x), lane)); }
DI float sum32(float x) { auto r = __builtin_amdgcn_permlane32_swap(__float_as_uint(x), __float_as_uint(x), false, false); return __uint_as_float(r[0]) + __uint_as_float(r[1]); }
DI float sum16(float x) { auto r = __builtin_amdgcn_permlane16_swap(__float_as_uint(x), __float_as_uint(x), false, false); return __uint_as_float(r[0]) + __uint_as_float(r[1]); }
DI float row_sum16(float v) { v += dppf<DPP_X1>(v); v += dppf<DPP_X2>(v); v += dppf<DPP_HM>(v); v += dppf<DPP_RM>(v); return v; }
DI float wave_sum(float v) { return sum32(sum16(row_sum16(v))); }
DI float wave_max(float v) { v = fmaxf(v, dppf<DPP_X1>(v)); v = fmaxf(v, dppf<DPP_X2>(v)); v = fmaxf(v, dppf<DPP_HM>(v)); v = fmaxf(v, dppf<DPP_RM>(v));
    { auto r = __builtin_amdgcn_permlane16_swap(__float_as_uint(v), __float_as_uint(v), false, false); v = fmaxf(__uint_as_float(r[0]), __uint_as_float(r[1])); }
    { auto r = __builtin_amdgcn_permlane32_swap(__float_as_uint(v), __float_as_uint(v), false, false); v = fmaxf(__uint_as_float(r[0]), __uint_as_float(r[1])); } return v; }

struct Frame {
    LAS unsigned char* lds; volatile LAS unsigned* MISC; gu32* ctl; int tid, lane, wave, G, gw, NGW;
};

struct MapId { DI int operator()(int n) const { return n; } };
struct MapWin0 { DI int operator()(int n) const {
    if (n < 1024) return n;
    const int t = (n - 1024) >> 9, c = (n - 1024) & 511, hd = c >> 6, d = c & 63; int bj, p;
    if (t < 2) { if (d < 16) { const int nn = d >> 3, rr = d & 7; bj = 0; p = 8 * (rr >> 2) + 4 * nn + (rr & 3); } else if (d < 32) { bj = 0; p = d; } else { bj = 1; p = d - 32; } }
    else { bj = d >> 5; p = d & 31; }
    return 1024 + 512 * t + 256 * (hd >> 2) + 128 * bj + 32 * (hd & 3) + p; } };
struct MapWin1 { DI int operator()(int n) const { const int t = n >> 10, c = n & 1023, hd = c >> 6, d = c & 63; return 1024 * t + 256 * (hd >> 2) + 128 * (d >> 5) + 32 * (hd & 3) + (d & 31); } };
template <class Map> DI void p0_transpose_item(const float* W, int K, int N, bf16* WT, LAS float* scr, int item, int lane, Map map) {
    const int nblk = N / 32, kb = item / nblk, nb = item % nblk, k0 = 64 * kb, n0 = 32 * nb;
#pragma unroll 8
    for (int i = 0; i < 32; ++i) { const int kk = 2 * i + (lane >> 5); scr[kk * 33 + (lane & 31)] = W[(size_t)(k0 + kk) * N + n0 + (lane & 31)]; }
    LDS_WAIT(); asm volatile("" ::: "memory");
    const int c = lane & 7;
#pragma unroll
    for (int j = 0; j < 4; ++j) { const int n = (lane >> 3) + 8 * j; const LAS float* s = scr + (8 * c) * 33 + n;
        v4u o; o.x = pk2(s[0 * 33], s[1 * 33]); o.y = pk2(s[2 * 33], s[3 * 33]); o.z = pk2(s[4 * 33], s[5 * 33]); o.w = pk2(s[6 * 33], s[7 * 33]);
        *(GAS v4u*)(WT + (size_t)map(n0 + n) * K + k0 + 8 * c) = o; }
    LDS_WAIT(); asm volatile("" ::: "memory");
}
struct P0Args { const float *c, *w_mod, *b_mod, *win0, *wout0, *win1, *wout1, *wq, *subk, *pu, *pv, *gws;
                float *MOD, *ROPE; bf16 *WIN0, *WOUT0, *WIN1, *WOUT1, *WQ0, *WQ1, *SUBK, *GWS; unsigned char *U8, *V8s; float *USC, *VSC; };
DI void p0_prologue(const Frame& F, const P0Args& A) {
    { LAS float* scr = (LAS float*)F.lds;
      for (int task = blockIdx.x; task < 192; task += F.G) {
          const int l = task / 96, n0 = (task % 96) * 64; const float* W = A.w_mod + (size_t)l * 1024 * 6144;
          float a0 = 0.f, a1 = 0.f; const int k0 = F.wave * 128;
#pragma unroll 1
          for (int kb = k0; kb < k0 + 128; kb += 32) { float w[32];
#pragma unroll
              for (int i = 0; i < 32; ++i) w[i] = W[(size_t)(kb + i) * 6144 + n0 + F.lane];
#pragma unroll
              for (int i = 0; i < 32; ++i) { const float c0 = A.c[kb + i], c1 = A.c[1024 + kb + i]; const float s0 = c0 / (1.f + __expf(-c0)), s1 = c1 / (1.f + __expf(-c1)); a0 += s0 * w[i]; a1 += s1 * w[i]; } }
          scr[(F.wave * 2 + 0) * 64 + F.lane] = a0; scr[(F.wave * 2 + 1) * 64 + F.lane] = a1;
          __syncthreads();
          if (F.tid < 128) { const int b = F.tid >> 6, n = F.tid & 63; float s = 0.f;
#pragma unroll
              for (int w = 0; w < 8; ++w) s += scr[(w * 2 + b) * 64 + n];
              A.MOD[(size_t)(l * 2 + b) * 6144 + n0 + n] = s + A.b_mod[l * 6144 + n0 + n]; }
          __syncthreads();
      } }
    { LAS float* scr = (LAS float*)(F.lds + F.wave * 16384);
      constexpr int I0 = 16 * 80, I1 = 16 * 32, I2 = 16 * 96, I3 = 16 * 32, I4 = 16 * 64, I5 = 16 * 64, NIT = I0 + I1 + I2 + I3 + I4 + I5;
      for (int it = F.gw; it < NIT; it += F.NGW) { int r = it;
          if (r < I0) { p0_transpose_item(A.win0, 1024, 2560, A.WIN0, scr, r, F.lane, MapId()); continue; } r -= I0;
          if (r < I1) { p0_transpose_item(A.wout0, 1024, 1024, A.WOUT0, scr, r, F.lane, MapId()); continue; } r -= I1;
          if (r < I2) { p0_transpose_item(A.win1, 1024, 3072, A.WIN1, scr, r, F.lane, MapId()); continue; } r -= I2;
          if (r < I3) { p0_transpose_item(A.wout1, 1024, 1024, A.WOUT1, scr, r, F.lane, MapId()); continue; } r -= I3;
          if (r < I4) { p0_transpose_item(A.wq, 1024, 2048, A.WQ0, scr, r, F.lane, MapId()); continue; } r -= I4;
          p0_transpose_item(A.wq + (size_t)1024 * 2048, 1024, 2048, A.WQ1, scr, r, F.lane, MapId()); } }
    for (int row0 = F.gw; row0 < 65536; row0 += 4 * F.NGW) {
        f32x4 v[4][4];
#pragma unroll
        for (int q = 0; q < 4; ++q) { const int row = row0 + q * F.NGW; const bool isv = row >= 32768; const int rr = row & 32767; const float* src = (isv ? A.pv : A.pu) + (size_t)rr * 1024;
#pragma unroll
            for (int k = 0; k < 4; ++k) v[q][k] = *(const f32x4*)(src + 4 * F.lane + 256 * k); }
#pragma unroll
        for (int q = 0; q < 4; ++q) { const int row = row0 + q * F.NGW; const bool isv = row >= 32768; const int rr = row & 32767; float mx = 0.f;
#pragma unroll
            for (int k = 0; k < 4; ++k) mx = fmaxf(mx, fmaxf(fmaxf(fabsf(v[q][k][0]), fabsf(v[q][k][1])), fmaxf(fabsf(v[q][k][2]), fabsf(v[q][k][3]))));
            mx = wave_max(mx);
            const float sc = mx > 0.f ? 127.0f / mx : 1.0f, inv = mx > 0.f ? mx * (1.0f / 127.0f) : 1.0f;
#pragma unroll
            for (int k = 0; k < 4; ++k) { const int q0 = __float2int_rn(v[q][k][0] * sc), q1 = __float2int_rn(v[q][k][1] * sc), q2 = __float2int_rn(v[q][k][2] * sc), q3 = __float2int_rn(v[q][k][3] * sc);
                const unsigned w = (unsigned)(q0 & 255) | ((unsigned)(q1 & 255) << 8) | ((unsigned)(q2 & 255) << 16) | ((unsigned)(q3 & 255) << 24);
                if (!isv) *(unsigned*)(A.U8 + (size_t)rr * 1024 + 4 * F.lane + 256 * k) = w;
                else { const int l = rr >> 14, e = rr & 16383, slab = 2 * k + (F.lane >> 5); *(unsigned*)(A.V8s + (((size_t)l * 8 + slab) * 16384 + e) * 128 + 4 * (F.lane & 31)) = w; } }
            if (F.lane == 0) (isv ? A.VSC : A.USC)[rr] = inv; } }
    { const size_t gt = (size_t)F.gw * 64 + F.lane, NT = (size_t)F.NGW * 64;
      for (size_t i = gt; i < 524288 / 8; i += NT) { const float* src = A.subk + i * 8; const f32x4 a = *(const f32x4*)src, b = *(const f32x4*)(src + 4); v4u o; o.x = cvtpk2(a[0], a[1]); o.y = cvtpk2(a[2], a[3]); o.z = cvtpk2(b[0], b[1]); o.w = cvtpk2(b[2], b[3]);
          *(v4u*)(A.SUBK + i * 8) = o; }
      for (size_t i = gt; i < 65536; i += NT) { const int t = (int)(i >> 7) & 127, s = (int)i & 127; A.GWS[i] = (bf16)(cvtpk2(s <= t ? A.gws[i] : 0.f, 0.f) & 0xffffu); }
      for (size_t i = gt; i < 65536; i += NT) { const int pos = (int)(i >> 3), fi = (int)i & 7; const float inv = powf(500000.0f, -(float)fi / 8.0f); const float ang = (float)pos * inv; float sn, cs; sincosf(ang, &sn, &cs);
          A.ROPE[(size_t)pos * 16 + fi] = cs; A.ROPE[(size_t)pos * 16 + 8 + fi] = sn; } }
}

template <bool XIN_F32> DI void norm_rows(const Frame& F, const void* xs_, const float* gamma, const float* modl, int shi, int sci, bf16* HN, unsigned char* HQ = nullptr, float* HS = nullptr) {
    for (int m0 = F.gw; m0 < MROWS; m0 += 2 * F.NGW) {
        f32x4 v[2][4]; float s[2];
#pragma unroll
        for (int q = 0; q < 2; ++q) { const int m = m0 + q * F.NGW;
            if (XIN_F32) { const f32x4* xr = (const f32x4*)((const float*)xs_ + (size_t)m * 1024) + F.lane;
#pragma unroll
                for (int j = 0; j < 4; ++j) v[q][j] = xr[64 * j]; }
            else { const unsigned long long* xr = (const unsigned long long*)((const bf16*)xs_ + (size_t)m * 1024) + F.lane;
#pragma unroll
                for (int j = 0; j < 4; ++j) { const unsigned long long w = xr[64 * j]; const unsigned lo = (unsigned)w, hi = (unsigned)(w >> 32); v[q][j] = (f32x4){bf_lo(lo), bf_hi(lo), bf_lo(hi), bf_hi(hi)}; } } }
#pragma unroll
        for (int q = 0; q < 2; ++q) { float a = 0.f;
#pragma unroll
            for (int j = 0; j < 4; ++j) a += (v[q][j][0] * v[q][j][0] + v[q][j][1] * v[q][j][1]) + (v[q][j][2] * v[q][j][2] + v[q][j][3] * v[q][j][3]);
            s[q] = a; }
#pragma unroll
        for (int q = 0; q < 2; ++q) { const int m = m0 + q * F.NGW; const int b = m >> 13;
            const float rinv = rsqrtf(wave_sum(s[q]) * (1.0f / 1024.0f) + 1e-6f);
            unsigned long long* o8 = (unsigned long long*)(HN + (size_t)m * 1024) + F.lane; float mx = 0.f;
#pragma unroll
            for (int j = 0; j < 4; ++j) { const int col = 4 * F.lane + 256 * j; const f32x4 gm = *(const f32x4*)(gamma + col), sc = *(const f32x4*)(modl + b * 6144 + sci * 1024 + col), sh = *(const f32x4*)(modl + b * 6144 + shi * 1024 + col);
                const f32x4 o = v[q][j] * rinv * gm * (sc + 1.0f) + sh; v[q][j] = o; mx = fmaxf(mx, fmaxf(fmaxf(fabsf(o[0]), fabsf(o[1])), fmaxf(fabsf(o[2]), fabsf(o[3]))));
                o8[64 * j] = (unsigned long long)cvtpk2(o[0], o[1]) | ((unsigned long long)cvtpk2(o[2], o[3]) << 32); }
            if (HQ) { mx = wave_max(mx); const float qs = mx > 0.f ? 127.0f / mx : 1.0f;
#pragma unroll
                for (int j = 0; j < 4; ++j) { const int q0 = __float2int_rn(v[q][j][0] * qs), q1 = __float2int_rn(v[q][j][1] * qs), q2 = __float2int_rn(v[q][j][2] * qs), q3 = __float2int_rn(v[q][j][3] * qs);
                    *(unsigned*)(HQ + (size_t)m * 1024 + 4 * F.lane + 256 * j) = (unsigned)(q0 & 255) | ((unsigned)(q1 & 255) << 8) | ((unsigned)(q2 & 255) << 16) | ((unsigned)(q3 & 255) << 24); }
                if (F.lane == 0) HS[m] = mx > 0.f ? mx * (1.0f / 127.0f) : 1.0f; } }
    }
}

DI void qk_post_task(int task, const bf16* QKR, bf16* Q0, bf16* K0, float* KSUM, const float* rope, const float* gq, const float* gk, LAS float* scr, int tid, int wave, int lane) {
    const int tb = task >> 2, cq = task & 3; const bool isk = cq >= 2; const int head0 = (cq & 1) * 4, hl = (lane >> 2) & 3, qt = lane & 3, rsub = lane >> 4;
    const float* g = (isk ? gk : gq) + qt * 16; float gv[16];
#pragma unroll
    for (int i = 0; i < 16; ++i) gv[i] = g[i];
    float ks[16];
#pragma unroll
    for (int i = 0; i < 16; ++i) ks[i] = 0.f;
    const int b = tb >> 5; bf16* dstb = (isk ? K0 : Q0) + (size_t)(b * 8 + head0 + hl) * SEQ * 64 + qt * 16;
    v4u wq0[8], wq1[8];
#pragma unroll
    for (int it = 0; it < 8; ++it) { const int row = tb * 256 + wave * 32 + it * 4 + rsub; const bf16* src = QKR + (size_t)row * 1024 + cq * 256 + hl * 64 + qt * 16; wq0[it] = *(const v4u*)src; wq1[it] = *(const v4u*)(src + 8); }
#pragma unroll
    for (int it = 0; it < 8; ++it) { const int row = tb * 256 + wave * 32 + it * 4 + rsub, s = row & (SEQ - 1);
        const v4u w0 = wq0[it], w1 = wq1[it];
        float y[16]; y[0] = bf_lo(w0.x); y[1] = bf_hi(w0.x); y[2] = bf_lo(w0.y); y[3] = bf_hi(w0.y); y[4] = bf_lo(w0.z); y[5] = bf_hi(w0.z); y[6] = bf_lo(w0.w); y[7] = bf_hi(w0.w);
        y[8] = bf_lo(w1.x); y[9] = bf_hi(w1.x); y[10] = bf_lo(w1.y); y[11] = bf_hi(w1.y); y[12] = bf_lo(w1.z); y[13] = bf_hi(w1.z); y[14] = bf_lo(w1.w); y[15] = bf_hi(w1.w);
        float ss = 0.f;
#pragma unroll
        for (int i = 0; i < 16; ++i) ss += y[i] * y[i];
        ss += dppf<DPP_X1>(ss); ss += dppf<DPP_X2>(ss);
        const float rinv = rsqrtf(ss * (1.0f / 64.0f) + 1e-6f);
#pragma unroll
        for (int i = 0; i < 16; ++i) y[i] = y[i] * rinv * gv[i];
        if (qt == 0) { const float* rp = rope + (size_t)s * 16;
#pragma unroll
            for (int i = 0; i < 8; ++i) { const float c = rp[i], sn = rp[8 + i], x1 = y[i], x2 = y[i + 8]; y[i] = x1 * c - x2 * sn; y[i + 8] = x1 * sn + x2 * c; } }
        v4u o0, o1; o0.x = cvtpk2(y[0], y[1]); o0.y = cvtpk2(y[2], y[3]); o0.z = cvtpk2(y[4], y[5]); o0.w = cvtpk2(y[6], y[7]); o1.x = cvtpk2(y[8], y[9]); o1.y = cvtpk2(y[10], y[11]); o1.z = cvtpk2(y[12], y[13]); o1.w = cvtpk2(y[14], y[15]);
        bf16* d = dstb + (size_t)s * 64; *(v4u*)d = o0; *(v4u*)(d + 8) = o1;
#pragma unroll
        for (int i = 0; i < 16; ++i) ks[i] += y[i];
    }
    if (isk) {
#pragma unroll
        for (int i = 0; i < 16; ++i) { ks[i] = sum32(sum16(ks[i])); }
        if (lane < 16) {
#pragma unroll
            for (int i = 0; i < 16; ++i) scr[(wave * 16 + lane) * 16 + i] = ks[i]; }
        __syncthreads();
        if (tid < 256) { const int l16 = tid >> 4, i = tid & 15; float sum = 0.f;
#pragma unroll
            for (int w = 0; w < 8; ++w) sum += scr[(w * 16 + l16) * 16 + i];
            KSUM[((size_t)(b * 8 + head0 + (l16 >> 2)) * 32 + (tb & 31)) * 64 + (l16 & 3) * 16 + i] = sum; }
        __syncthreads();
    }
}

DI f32x16 qk_tile(const bf16* krow, const bf16x8 (&qf)[4]) {
    f32x16 s;
#pragma unroll
    for (int i = 0; i < 16; ++i) s[i] = 0.f;
#pragma unroll
    for (int ks = 0; ks < 4; ++ks) s = MFMA32(ld16g(krow + 16 * ks), qf[ks], s);
    return s;
}
DI bf16x8 pack8(const f32x16& x, int s) { v4u p; p.x = cvtpk2(x[8 * s], x[8 * s + 1]); p.y = cvtpk2(x[8 * s + 2], x[8 * s + 3]); p.z = cvtpk2(x[8 * s + 4], x[8 * s + 5]); p.w = cvtpk2(x[8 * s + 6], x[8 * s + 7]); return __builtin_bit_cast(bf16x8, p); }
DI void pv_tile(f32x16 (&o)[2], const bf16* vt, const f32x16& p) {
#pragma unroll
    for (int s = 0; s < 2; ++s) { const bf16x8 pb = pack8(p, s);
#pragma unroll
        for (int mt = 0; mt < 2; ++mt) { const bf16* v = vt + (size_t)mt * 32 * SEQ + 16 * s; o[mt] = MFMA32(ld8x2g(v, v + 8), pb, o[mt]); } }
}
DI void store_ot(bf16* dst, const f32x16 (&o)[2], float sc, int h) {
#pragma unroll
    for (int mt = 0; mt < 2; ++mt)
#pragma unroll
        for (int g = 0; g < 4; ++g) { const unsigned lo = cvtpk2(o[mt][4 * g] * sc, o[mt][4 * g + 1] * sc), hi = cvtpk2(o[mt][4 * g + 2] * sc, o[mt][4 * g + 3] * sc);
            *(unsigned long long*)(dst + 32 * mt + 8 * g + 4 * h) = (unsigned long long)lo | ((unsigned long long)hi << 32); }
}
DI void moba_keys(const bf16* Kh, const bf16* VTh, const bf16x8 (&qf)[4], int key0, int nt, int diag, float mc2, f32x16 (&o)[2], float& l, int r, int h) {
    for (int kt = 0; kt < nt; ++kt) { const int kb = key0 + 32 * kt;
        f32x16 s = qk_tile(Kh + (size_t)(kb + r) * 64 + 8 * h, qf);
        float ls = 0.f;
#pragma unroll
        for (int i = 0; i < 16; ++i) { float p = __builtin_amdgcn_exp2f(s[i] * (0.125f * LOG2E) - mc2); if (kt == diag && crow(i, h) > r) p = 0.f; s[i] = p; ls += p; }
        l += ls;
        pv_tile(o, VTh + (size_t)r * SEQ + kb + 4 * h, s);
    }
}
DI float moba_mc2(const float* gq, const float* gk, int lane) {
    float a = fabsf(gq[lane]), b = fabsf(gk[lane]);
    a = wave_max(a); b = wave_max(b);
    return 8.0f * a * b * LOG2E;
}
struct MobaT { const bf16 *Q, *K, *VT; const float* ksum; unsigned* masks; bf16* PO; float* PL; const float *gq, *gk; };
DI void moba_mask_unit(int u, const MobaT& T, int lane) {
    const int bh = u >> 8, t0 = (u & 255) * 32, own = t0 >> 8, r = lane & 31, h = lane >> 5;
    unsigned mask = 0u;
    if (own > 0) {
        f32x16 g;
#pragma unroll
        for (int i = 0; i < 16; ++i) g[i] = 0.f;
        const float* km = T.ksum + ((size_t)bh * 32 + r) * 64 + 8 * h; const bf16* qp = T.Q + ((size_t)bh * SEQ + t0 + r) * 64 + 8 * h;
#pragma unroll
        for (int ks = 0; ks < 4; ++ks) { const f32x4 a0 = *(const f32x4*)(km + 16 * ks) * (1.0f / 256.0f), a1 = *(const f32x4*)(km + 16 * ks + 4) * (1.0f / 256.0f);
            v4u aw; aw.x = cvtpk2(a0[0], a0[1]); aw.y = cvtpk2(a0[2], a0[3]); aw.z = cvtpk2(a1[0], a1[1]); aw.w = cvtpk2(a1[2], a1[3]);
            g = MFMA32(__builtin_bit_cast(bf16x8, aw), ld16g(qp + 16 * ks), g); }
        int ka = KEY_MIN, kb2 = KEY_MIN, kc = KEY_MIN;
#define INS3(x_) do { int x = (x_); int t = min(ka, x); ka = max(ka, x); int uu = min(kb2, t); kb2 = max(kb2, t); kc = max(kc, uu); } while (0)
#pragma unroll
        for (int i = 0; i < 16; ++i) { const int blk = crow(i, h); const int key = (blk < own) ? ((f_ord(g[i]) & ~31) | (31 - blk)) : KEY_MIN; INS3(key); }
        const int pa = px32(ka, lane), pb = px32(kb2, lane), pc = px32(kc, lane);
        INS3(pa); INS3(pb); INS3(pc);
#undef INS3
        if (ka != KEY_MIN) mask |= 1u << (31 - (ka & 31));
        if (kb2 != KEY_MIN) mask |= 1u << (31 - (kb2 & 31));
        if (kc != KEY_MIN) mask |= 1u << (31 - (kc & 31));
    }
    if (h == 0) T.masks[(size_t)bh * SEQ + t0 + r] = mask;
}
DI void moba_own_unit(int u, const MobaT& T, float mc2, int lane) {
    const int bh = u >> 8, t0 = (u & 255) * 32, own = t0 >> 8, r = lane & 31, h = lane >> 5;
    const bf16* qp = T.Q + ((size_t)bh * SEQ + t0 + r) * 64 + 8 * h; bf16x8 qf[4];
#pragma unroll
    for (int ks = 0; ks < 4; ++ks) qf[ks] = ld16g(qp + 16 * ks);
    f32x16 o[2];
#pragma unroll
    for (int i = 0; i < 16; ++i) { o[0][i] = 0.f; o[1][i] = 0.f; }
    float l = 0.f; const int key0 = own * 256, nt = ((t0 - key0) >> 5) + 1;
    moba_keys(T.K + (size_t)bh * SEQ * 64, T.VT + (size_t)bh * 64 * SEQ, qf, key0, nt, nt - 1, mc2, o, l, r, h);
    l = sum32(l);
    const size_t base = ((size_t)bh * SEQ + t0 + r) * 4 + 3;
    store_ot(T.PO + base * 64, o, 1.0f, h); if (h == 0) T.PL[base] = l;
}
constexpr int MS_K = 0, MS_V = 32768, MS_VROW = 520, MS_LIST = 32768 + 64 * 520, MS_CNT = MS_LIST + 8192, MOBA_NSEL = 16 * 79, MOBA_NTASK = MOBA_NSEL + 512;
DI void moba_sel_task(int task, const MobaT& T, LAS unsigned char* lds, float mc2, int tid, int wave, int lane) {
    const bool own = task >= MOBA_NSEL;
    int p = 0, rem = own ? 0 : task; if (own) {} else if (rem < 128) p = 0; else if (rem < 384) { p = 1; rem -= 128; } else if (rem < 768) { p = 2; rem -= 384; } else { p = 3; rem -= 768; }
    const int j = own ? ((task - MOBA_NSEL) >> 4) : (rem >> 4), bh = own ? ((task - MOBA_NSEL) & 15) : (rem & 15);
    LAS unsigned* list = (LAS unsigned*)(lds + MS_LIST); LAS unsigned* cntp = (LAS unsigned*)(lds + MS_CNT);
    { const bf16* Kg = T.K + ((size_t)bh * SEQ + 256 * j) * 64; const bf16* Vg = T.VT + (size_t)bh * 64 * SEQ + 256 * j;
      v4u kv[4], vv[4];
#pragma unroll
      for (int i = 0; i < 4; ++i) { const int c = tid + 512 * i; kv[i] = *(const v4u*)(Kg + (size_t)c * 8); const int d = c >> 5, cc = c & 31; vv[i] = *(const v4u*)(Vg + (size_t)d * SEQ + cc * 8); }
      if (tid == 0) *cntp = 0u;
#pragma unroll
      for (int i = 0; i < 4; ++i) { const int c = tid + 512 * i; const int k = c >> 3, ch = c & 7; *(LAS v4u*)(lds + MS_K + k * 128 + ((ch ^ ((k >> 1) & 7)) << 4)) = kv[i];
          const int d = c >> 5, cc = c & 31; LAS unsigned char* vp = lds + MS_V + d * MS_VROW + cc * 16; *(LAS unsigned long long*)vp = (unsigned long long)vv[i].x | ((unsigned long long)vv[i].y << 32); *(LAS unsigned long long*)(vp + 8) = (unsigned long long)vv[i].z | ((unsigned long long)vv[i].w << 32); } }
    __syncthreads();
    if (!own) { const int qlo = 256 * (8 * p + 1), qhi = (8 * p + 9) * 256 < SEQ ? (8 * p + 9) * 256 : SEQ;
      for (int t0 = qlo + wave * 64; t0 < qhi; t0 += 512) { const int t = t0 + lane; const unsigned mk = T.masks[(size_t)bh * SEQ + t]; const bool sel = (mk >> j) & 1u;
          const unsigned long long bal = __ballot(sel); const int nb = __builtin_popcountll(bal);
          unsigned base = 0; if (lane == 0 && nb) base = __hip_atomic_fetch_add(cntp, (unsigned)nb, __ATOMIC_RELAXED, __HIP_MEMORY_SCOPE_WORKGROUP); base = (unsigned)__builtin_amdgcn_readfirstlane((int)base);
          if (sel) list[base + __builtin_popcountll(bal & ((1ull << lane) - 1ull))] = (unsigned)t; } }
    __syncthreads();
    const int n = own ? 256 : (int)*cntp; const int r = lane & 31, h = lane >> 5;
    const LAS unsigned char* kb = lds + MS_K; const LAS unsigned char* vb = lds + MS_V;
    for (int b0 = wave * 32; b0 < n; b0 += 256) { const bool valid = b0 + r < n; const int t = own ? (256 * j + b0 + r) : (int)list[valid ? b0 + r : b0];
        const unsigned mk = own ? 0u : T.masks[(size_t)bh * SEQ + t]; const int slot = own ? 3 : __builtin_popcount(mk & ((1u << j) - 1u));
        const int ntile = own ? (wave + 1) : 8;
        const bf16* qp = T.Q + ((size_t)bh * SEQ + t) * 64 + 8 * h; bf16x8 qf[4];
#pragma unroll
        for (int ks = 0; ks < 4; ++ks) qf[ks] = ld16g(qp + 16 * ks);
        f32x16 o[2];
#pragma unroll
        for (int i = 0; i < 16; ++i) { o[0][i] = 0.f; o[1][i] = 0.f; }
        float l = 0.f;
#pragma unroll 1
        for (int kt = 0; kt < ntile; ++kt) { const int key = 32 * kt + r; const bool dg = own && kt == wave;
            f32x16 s;
#pragma unroll
            for (int i = 0; i < 16; ++i) s[i] = 0.f;
#pragma unroll
            for (int ks = 0; ks < 4; ++ks) s = MFMA32(*(const LAS bf16x8*)(kb + key * 128 + (((2 * ks + h) ^ ((key >> 1) & 7)) << 4)), qf[ks], s);
            float ls = 0.f;
#pragma unroll
            for (int i = 0; i < 16; ++i) { float pv = __builtin_amdgcn_exp2f(s[i] * (0.125f * LOG2E) - mc2); if (dg && crow(i, h) > r) pv = 0.f; s[i] = pv; ls += pv; }
            l += ls;
#pragma unroll
            for (int sx = 0; sx < 2; ++sx) { const bf16x8 pb = pack8(s, sx);
#pragma unroll
                for (int mt = 0; mt < 2; ++mt) { const LAS unsigned char* vp = vb + (32 * mt + r) * MS_VROW + (32 * kt + 16 * sx + 4 * h) * 2;
                    const s16x4 a0 = *(const LAS s16x4*)vp, a1 = *(const LAS s16x4*)(vp + 16); o[mt] = MFMA32(__builtin_shufflevector(a0, a1, 0, 1, 2, 3, 4, 5, 6, 7), pb, o[mt]); } }
        }
        l = sum32(l);
        if (valid) { const size_t base = ((size_t)bh * SEQ + t) * 4 + slot; store_ot(T.PO + base * 64, o, 1.0f, h); if (h == 0) T.PL[base] = l; }
    }
    __syncthreads();
}
DI void moba_combine(const Frame& F, const bf16* PO, const float* PL, bf16* YCAT) {
    const size_t gt = (size_t)F.gw * 64 + F.lane, NT = (size_t)F.NGW * 64;
    for (size_t i0 = gt; i0 < (size_t)16 * SEQ * 8; i0 += 2 * NT) {
        v4u w[2][4]; float pl[2][4];
#pragma unroll
        for (int q = 0; q < 2; ++q) { const size_t i = i0 + q * NT; const int dq = (int)i & 7, t = (int)(i >> 3) & (SEQ - 1), bh = (int)(i >> 16); const int own = t >> 8, ns = own < 3 ? own : 3;
#pragma unroll
            for (int s = 0; s < 4; ++s) { if (s < ns || s == 3) { const size_t base = ((size_t)bh * SEQ + t) * 4 + s; pl[q][s] = PL[base]; w[q][s] = *(const v4u*)(PO + base * 64 + dq * 8); } else { pl[q][s] = 0.f; w[q][s] = (v4u){0u, 0u, 0u, 0u}; } } }
#pragma unroll
        for (int q = 0; q < 2; ++q) { const size_t i = i0 + q * NT; const int dq = (int)i & 7, t = (int)(i >> 3) & (SEQ - 1), bh = (int)(i >> 16);
            float o[8]; float l = 0.f;
#pragma unroll
            for (int k = 0; k < 8; ++k) o[k] = 0.f;
#pragma unroll
            for (int s = 0; s < 4; ++s) { l += pl[q][s]; const v4u ww = w[q][s];
                o[0] += bf_lo(ww.x); o[1] += bf_hi(ww.x); o[2] += bf_lo(ww.y); o[3] += bf_hi(ww.y); o[4] += bf_lo(ww.z); o[5] += bf_hi(ww.z); o[6] += bf_lo(ww.w); o[7] += bf_hi(ww.w); }
            const float il = 1.0f / l; v4u ow; ow.x = cvtpk2(o[0] * il, o[1] * il); ow.y = cvtpk2(o[2] * il, o[3] * il); ow.z = cvtpk2(o[4] * il, o[5] * il); ow.w = cvtpk2(o[6] * il, o[7] * il);
            *(v4u*)(YCAT + ((size_t)(bh >> 3) * SEQ + t) * 1024 + 512 + (bh & 7) * 64 + dq * 8) = ow; } }
}

DI void gmlp_unit(int unit, const bf16* UA, const bf16* VA, const float* vgain, const bf16* GWS, const float* bs, bf16* YCAT, LAS unsigned char* lds, int tid, int wave, int lane) {
    const int cidx = unit >> 2, g = unit & 3, row0 = cidx * 128; LAS bf16* VNT = (LAS bf16*)lds;
    { const int row = tid >> 2, dq = (tid & 3) * 32; const bf16* src = VA + (size_t)(row0 + row) * 512 + g * 128 + dq;
      float f[32]; float ss = 0.f;
#pragma unroll
      for (int k = 0; k < 4; ++k) { const v4u w = *(const v4u*)(src + 8 * k); f[8 * k] = bf_lo(w.x); f[8 * k + 1] = bf_hi(w.x); f[8 * k + 2] = bf_lo(w.y); f[8 * k + 3] = bf_hi(w.y); f[8 * k + 4] = bf_lo(w.z); f[8 * k + 5] = bf_hi(w.z); f[8 * k + 6] = bf_lo(w.w); f[8 * k + 7] = bf_hi(w.w); }
#pragma unroll
      for (int k = 0; k < 32; ++k) ss += f[k] * f[k];
      ss += dppf<DPP_X1>(ss); ss += dppf<DPP_X2>(ss);
      const float rinv = rsqrtf(ss * (1.0f / 128.0f) + 1e-6f);
#pragma unroll
      for (int k = 0; k < 32; ++k) VNT[(dq + k) * 136 + row] = (bf16)(cvtpk2(f[k] * rinv * vgain[g * 128 + dq + k], 0.f) & 0xffffu); }
    __syncthreads();
    { const int mt = wave >> 1, ntb = (wave & 1) * 2, r = lane & 31, h = lane >> 5;
      f32x16 acc[2];
#pragma unroll
      for (int i = 0; i < 16; ++i) { acc[0][i] = 0.f; acc[1][i] = 0.f; }
      const bf16* wp = GWS + ((size_t)g * 128 + 32 * mt + r) * 128 + 8 * h;
      bf16x8 af[8];
#pragma unroll
      for (int ks = 0; ks < 8; ++ks) af[ks] = ld16g(wp + 16 * ks);
#pragma unroll
      for (int ks = 0; ks < 8; ++ks) { if (ks >= 2 * (mt + 1)) break; const bf16x8 a = af[ks];
#pragma unroll
          for (int nn = 0; nn < 2; ++nn) { const bf16x8 b = *(const LAS bf16x8*)(VNT + (32 * (ntb + nn) + r) * 136 + 16 * ks + 8 * h); acc[nn] = MFMA32(a, b, acc[nn]); } }
#pragma unroll
      for (int nn = 0; nn < 2; ++nn)
#pragma unroll
          for (int i = 0; i < 16; ++i) { const int t = 32 * mt + crow(i, h), d = 32 * (ntb + nn) + r; const float mixed = acc[nn][i] + bs[g * 128 + t];
              const float uv = __uint_as_float((unsigned)UA[(size_t)(row0 + t) * 512 + g * 128 + d] << 16);
              YCAT[(size_t)(row0 + t) * 1024 + g * 128 + d] = (bf16)(cvtpk2(uv * mixed, 0.f) & 0xffffu); } }
    __syncthreads();
}

struct SbK { bf16x8 k[4]; }; struct SbV { s16x4 v[8]; };
DI void sb_loadk(SbK& f, const bf16* Kh, int kb, int r, int h) {
    const bf16* kp = Kh + (size_t)(kb + r) * 64 + 8 * h;
#pragma unroll
    for (int ks = 0; ks < 4; ++ks) f.k[ks] = ld16g(kp + 16 * ks);
}
DI void sb_loadv(SbV& f, const bf16* VTh, int kb, int r, int h) {
    const bf16* vp = VTh + (size_t)r * SEQ + kb + 4 * h;
#pragma unroll
    for (int s = 0; s < 2; ++s)
#pragma unroll
        for (int mt = 0; mt < 2; ++mt) { const bf16* v = vp + (size_t)mt * 32 * SEQ + 16 * s; f.v[4 * s + 2 * mt] = *(const s16x4*)v; f.v[4 * s + 2 * mt + 1] = *(const s16x4*)(v + 8); }
}
template <bool DIAG> DI void sb_tile(const SbK& fk, const SbV& fv, const bf16x8 (&qf)[4], f32x16 (&o)[2], float& R, int r, int h, int lane) {
    f32x16 s;
#pragma unroll
    for (int i = 0; i < 16; ++i) s[i] = 0.f;
#pragma unroll
    for (int ks = 0; ks < 4; ++ks) s = MFMA32(fk.k[ks], qf[ks], s);
    f32x16 x;
#pragma unroll
    for (int i = 0; i < 16; ++i) { const float z = s[i]; const float t = __builtin_amdgcn_exp2f(-fabsf(z) * LOG2E); const float sp = fmaxf(z, 0.f) + LN2 * __builtin_amdgcn_logf(1.0f + t);
        if (DIAG) { const bool valid = crow(i, h) < r; x[i] = valid ? -sp : 0.f; s[i] = valid ? z : -INFINITY; } else x[i] = -sp; }
    float T4[4], E[16];
#pragma unroll
    for (int g = 0; g < 4; ++g) { E[4 * g + 3] = 0.f; E[4 * g + 2] = x[4 * g + 3]; E[4 * g + 1] = E[4 * g + 2] + x[4 * g + 2]; E[4 * g] = E[4 * g + 1] + x[4 * g + 1]; T4[g] = E[4 * g] + x[4 * g]; }
    float P4[4];
#pragma unroll
    for (int g = 0; g < 4; ++g) P4[g] = px32(T4[g], lane);
    float C[4]; float run = 0.f;
#pragma unroll
    for (int g = 3; g >= 0; --g) { C[g] = run + (h == 0 ? P4[g] : 0.f); run += T4[g] + P4[g]; }
#pragma unroll
    for (int i = 0; i < 16; ++i) { const float arg = x[i] + s[i] + (R + C[i >> 2] + E[i]); x[i] = __builtin_amdgcn_exp2f(arg * LOG2E); }
#pragma unroll
    for (int sx = 0; sx < 2; ++sx) { const bf16x8 pb = pack8(x, sx);
#pragma unroll
        for (int mt = 0; mt < 2; ++mt) o[mt] = MFMA32(__builtin_shufflevector(fv.v[4 * sx + 2 * mt], fv.v[4 * sx + 2 * mt + 1], 0, 1, 2, 3, 4, 5, 6, 7), pb, o[mt]); }
    R += run;
}
constexpr int SB_K = 0, SB_V = 65536, SB_VROW = 1032;
DI void sb_wg_unit(int u, const bf16* Q, const bf16* K, const bf16* VT, bf16* YCAT, LAS unsigned char* lds, int tid, int wave, int lane) {
    const int bh = u >> 5, qb = u & 31, r = lane & 31, h = lane >> 5; const int base = qb > 0 ? 256 * (qb - 1) : 0, nk = qb > 0 ? 512 : 256;
    const bf16* Kh = K + (size_t)bh * SEQ * 64; const bf16* VTh = VT + (size_t)bh * 64 * SEQ;
    { const bf16* Kg = Kh + (size_t)base * 64; const int nch = nk * 8;
      for (int c0 = 0; c0 < nch; c0 += 2048) { v4u kv[4];
#pragma unroll
          for (int i = 0; i < 4; ++i) kv[i] = *(const v4u*)(Kg + (size_t)(c0 + tid + 512 * i) * 8);
#pragma unroll
          for (int i = 0; i < 4; ++i) { const int c = c0 + tid + 512 * i, k = c >> 3, ch = c & 7; *(LAS v4u*)(lds + SB_K + k * 128 + ((ch ^ ((k >> 1) & 7)) << 4)) = kv[i]; } }
      const int cpr = nk / 8;
      for (int c0 = 0; c0 < 64 * cpr; c0 += 2048) { v4u vv[4];
#pragma unroll
          for (int i = 0; i < 4; ++i) { const int c = c0 + tid + 512 * i, d = c / cpr, cc = c - d * cpr; vv[i] = *(const v4u*)(VTh + (size_t)d * SEQ + base + cc * 8); }
#pragma unroll
          for (int i = 0; i < 4; ++i) { const int c = c0 + tid + 512 * i, d = c / cpr, cc = c - d * cpr; LAS unsigned char* vp = lds + SB_V + d * SB_VROW + cc * 16;
              *(LAS unsigned long long*)vp = (unsigned long long)vv[i].x | ((unsigned long long)vv[i].y << 32); *(LAS unsigned long long*)(vp + 8) = (unsigned long long)vv[i].z | ((unsigned long long)vv[i].w << 32); } } }
    const int t0 = 256 * qb + 32 * wave;
    const bf16* qp = Q + ((size_t)bh * SEQ + t0 + r) * 64 + 8 * h; bf16x8 qf[4];
#pragma unroll
    for (int ks = 0; ks < 4; ++ks) qf[ks] = ld16g(qp + 16 * ks);
    __syncthreads();
    f32x16 o[2];
#pragma unroll
    for (int i = 0; i < 16; ++i) { o[0][i] = 0.f; o[1][i] = 0.f; }
    float R = 0.f; bool diag = true;
    for (int kb = t0; kb >= 0; kb -= 32) {
        if (!diag && !__any(R >= -104.0f)) break;
        SbK fk; SbV fv;
        if (kb >= base) { const int kl = kb - base + r;
            const LAS unsigned char* kp = lds + SB_K + kl * 128;
#pragma unroll
            for (int ks = 0; ks < 4; ++ks) fk.k[ks] = *(const LAS bf16x8*)(kp + (((2 * ks + h) ^ ((kl >> 1) & 7)) << 4));
#pragma unroll
            for (int s = 0; s < 2; ++s)
#pragma unroll
                for (int mt = 0; mt < 2; ++mt) { const LAS unsigned char* vp = lds + SB_V + (32 * mt + r) * SB_VROW + (kb - base + 16 * s + 4 * h) * 2; fv.v[4 * s + 2 * mt] = *(const LAS s16x4*)vp; fv.v[4 * s + 2 * mt + 1] = *(const LAS s16x4*)(vp + 16); }
        } else { sb_loadk(fk, Kh, kb, r, h); sb_loadv(fv, VTh, kb, r, h); }
        if (diag) sb_tile<true>(fk, fv, qf, o, R, r, h, lane); else sb_tile<false>(fk, fv, qf, o, R, r, h, lane);
        diag = false;
    }
    store_ot(YCAT + ((size_t)(bh >> 4) * SEQ + t0 + r) * 1024 + (bh & 15) * 64, o, 1.0f, h);
    __syncthreads();
}

#define CE_(a, b) do { const int hi_ = max((a), (b)); (b) = min((a), (b)); (a) = hi_; } while (0)
DI void sort16_desc(int (&v)[16]) {
    CE_(v[0], v[1]); CE_(v[2], v[3]); CE_(v[0], v[2]); CE_(v[1], v[3]); CE_(v[1], v[2]); CE_(v[4], v[5]); CE_(v[6], v[7]); CE_(v[4], v[6]); CE_(v[5], v[7]);
    CE_(v[5], v[6]); CE_(v[0], v[4]); CE_(v[2], v[6]); CE_(v[2], v[4]); CE_(v[1], v[5]); CE_(v[3], v[7]); CE_(v[3], v[5]); CE_(v[1], v[2]); CE_(v[3], v[4]);
    CE_(v[5], v[6]); CE_(v[8], v[9]); CE_(v[10], v[11]); CE_(v[8], v[10]); CE_(v[9], v[11]); CE_(v[9], v[10]); CE_(v[12], v[13]); CE_(v[14], v[15]); CE_(v[12], v[14]);
    CE_(v[13], v[15]); CE_(v[13], v[14]); CE_(v[8], v[12]); CE_(v[10], v[14]); CE_(v[10], v[12]); CE_(v[9], v[13]); CE_(v[11], v[15]); CE_(v[11], v[13]);
    CE_(v[9], v[10]); CE_(v[11], v[12]); CE_(v[13], v[14]); CE_(v[0], v[8]); CE_(v[4], v[12]); CE_(v[4], v[8]); CE_(v[2], v[10]); CE_(v[6], v[14]); CE_(v[6], v[10]);
    CE_(v[2], v[4]); CE_(v[6], v[8]); CE_(v[10], v[12]); CE_(v[1], v[9]); CE_(v[5], v[13]); CE_(v[5], v[9]); CE_(v[3], v[11]); CE_(v[7], v[15]); CE_(v[7], v[11]);
    CE_(v[3], v[5]); CE_(v[7], v[9]); CE_(v[11], v[13]); CE_(v[1], v[2]); CE_(v[3], v[4]); CE_(v[5], v[6]); CE_(v[7], v[8]); CE_(v[9], v[10]); CE_(v[11], v[12]);
    CE_(v[13], v[14]);
}
DI void merge16_desc(int (&A)[16], const int (&B)[16]) {
#pragma unroll
    for (int i = 0; i < 16; ++i) A[i] = max(A[i], B[15 - i]);
    CE_(A[0], A[8]); CE_(A[1], A[9]); CE_(A[2], A[10]); CE_(A[3], A[11]); CE_(A[4], A[12]); CE_(A[5], A[13]); CE_(A[6], A[14]); CE_(A[7], A[15]); CE_(A[0], A[4]);
    CE_(A[1], A[5]); CE_(A[2], A[6]); CE_(A[3], A[7]); CE_(A[8], A[12]); CE_(A[9], A[13]); CE_(A[10], A[14]); CE_(A[11], A[15]); CE_(A[0], A[2]); CE_(A[1], A[3]);
    CE_(A[4], A[6]); CE_(A[5], A[7]); CE_(A[8], A[10]); CE_(A[9], A[11]); CE_(A[12], A[14]); CE_(A[13], A[15]); CE_(A[0], A[1]); CE_(A[2], A[3]); CE_(A[4], A[5]);
    CE_(A[6], A[7]); CE_(A[8], A[9]); CE_(A[10], A[11]); CE_(A[12], A[13]); CE_(A[14], A[15]);
}
#define PEER_CAND_CHUNK(C_, c_) do { \
    if ((c_) == 0) { C_[0] = (f_ord(s1[0] + s2[0]) & ~0x3fff) | a1[0] | a2[0]; C_[1] = (f_ord(s1[0] + s2[1]) & ~0x3fff) | a1[0] | a2[1]; C_[2] = (f_ord(s1[0] + s2[2]) & ~0x3fff) | a1[0] | a2[2]; C_[3] = (f_ord(s1[0] + s2[3]) & ~0x3fff) | a1[0] | a2[3]; C_[4] = (f_ord(s1[0] + s2[4]) & ~0x3fff) | a1[0] | a2[4]; C_[5] = (f_ord(s1[0] + s2[5]) & ~0x3fff) | a1[0] | a2[5]; C_[6] = (f_ord(s1[0] + s2[6]) & ~0x3fff) | a1[0] | a2[6]; C_[7] = (f_ord(s1[0] + s2[7]) & ~0x3fff) | a1[0] | a2[7]; C_[8] = (f_ord(s1[0] + s2[8]) & ~0x3fff) | a1[0] | a2[8]; C_[9] = (f_ord(s1[0] + s2[9]) & ~0x3fff) | a1[0] | a2[9]; C_[10] = (f_ord(s1[0] + s2[10]) & ~0x3fff) | a1[0] | a2[10]; C_[11] = (f_ord(s1[0] + s2[11]) & ~0x3fff) | a1[0] | a2[11]; C_[12] = (f_ord(s1[0] + s2[12]) & ~0x3fff) | a1[0] | a2[12]; C_[13] = (f_ord(s1[0] + s2[13]) & ~0x3fff) | a1[0] | a2[13]; C_[14] = (f_ord(s1[0] + s2[14]) & ~0x3fff) | a1[0] | a2[14]; C_[15] = (f_ord(s1[0] + s2[15]) & ~0x3fff) | a1[0] | a2[15]; } \
    if ((c_) == 1) { C_[0] = (f_ord(s1[1] + s2[0]) & ~0x3fff) | a1[1] | a2[0]; C_[1] = (f_ord(s1[1] + s2[1]) & ~0x3fff) | a1[1] | a2[1]; C_[2] = (f_ord(s1[1] + s2[2]) & ~0x3fff) | a1[1] | a2[2]; C_[3] = (f_ord(s1[1] + s2[3]) & ~0x3fff) | a1[1] | a2[3]; C_[4] = (f_ord(s1[1] + s2[4]) & ~0x3fff) | a1[1] | a2[4]; C_[5] = (f_ord(s1[1] + s2[5]) & ~0x3fff) | a1[1] | a2[5]; C_[6] = (f_ord(s1[1] + s2[6]) & ~0x3fff) | a1[1] | a2[6]; C_[7] = (f_ord(s1[1] + s2[7]) & ~0x3fff) | a1[1] | a2[7]; C_[8] = (f_ord(s1[2] + s2[0]) & ~0x3fff) | a1[2] | a2[0]; C_[9] = (f_ord(s1[2] + s2[1]) & ~0x3fff) | a1[2] | a2[1]; C_[10] = (f_ord(s1[2] + s2[2]) & ~0x3fff) | a1[2] | a2[2]; C_[11] = (f_ord(s1[2] + s2[3]) & ~0x3fff) | a1[2] | a2[3]; C_[12] = (f_ord(s1[2] + s2[4]) & ~0x3fff) | a1[2] | a2[4]; C_[13] = (f_ord(s1[3] + s2[0]) & ~0x3fff) | a1[3] | a2[0]; C_[14] = (f_ord(s1[3] + s2[1]) & ~0x3fff) | a1[3] | a2[1]; C_[15] = (f_ord(s1[3] + s2[2]) & ~0x3fff) | a1[3] | a2[2]; } \
    if ((c_) == 2) { C_[0] = (f_ord(s1[3] + s2[3]) & ~0x3fff) | a1[3] | a2[3]; C_[1] = (f_ord(s1[4] + s2[0]) & ~0x3fff) | a1[4] | a2[0]; C_[2] = (f_ord(s1[4] + s2[1]) & ~0x3fff) | a1[4] | a2[1]; C_[3] = (f_ord(s1[4] + s2[2]) & ~0x3fff) | a1[4] | a2[2]; C_[4] = (f_ord(s1[5] + s2[0]) & ~0x3fff) | a1[5] | a2[0]; C_[5] = (f_ord(s1[5] + s2[1]) & ~0x3fff) | a1[5] | a2[1]; C_[6] = (f_ord(s1[6] + s2[0]) & ~0x3fff) | a1[6] | a2[0]; C_[7] = (f_ord(s1[6] + s2[1]) & ~0x3fff) | a1[6] | a2[1]; C_[8] = (f_ord(s1[7] + s2[0]) & ~0x3fff) | a1[7] | a2[0]; C_[9] = (f_ord(s1[7] + s2[1]) & ~0x3fff) | a1[7] | a2[1]; C_[10] = (f_ord(s1[8] + s2[0]) & ~0x3fff) | a1[8] | a2[0]; C_[11] = (f_ord(s1[9] + s2[0]) & ~0x3fff) | a1[9] | a2[0]; C_[12] = (f_ord(s1[10] + s2[0]) & ~0x3fff) | a1[10] | a2[0]; C_[13] = (f_ord(s1[11] + s2[0]) & ~0x3fff) | a1[11] | a2[0]; C_[14] = (f_ord(s1[12] + s2[0]) & ~0x3fff) | a1[12] | a2[0]; C_[15] = (f_ord(s1[13] + s2[0]) & ~0x3fff) | a1[13] | a2[0]; } \
    if ((c_) == 3) { C_[0] = (f_ord(s1[14] + s2[0]) & ~0x3fff) | a1[14] | a2[0]; C_[1] = (f_ord(s1[15] + s2[0]) & ~0x3fff) | a1[15] | a2[0]; C_[2] = KEY_MIN; C_[3] = KEY_MIN; C_[4] = KEY_MIN; C_[5] = KEY_MIN; C_[6] = KEY_MIN; C_[7] = KEY_MIN; C_[8] = KEY_MIN; C_[9] = KEY_MIN; C_[10] = KEY_MIN; C_[11] = KEY_MIN; C_[12] = KEY_MIN; C_[13] = KEY_MIN; C_[14] = KEY_MIN; C_[15] = KEY_MIN; } \
} while (0)

struct QSrcGlobal { const bf16* QP; int tokg, head; DI bf16x8 frag(int p, int ks, int r, int h) const { return ld16g(QP + (size_t)(tokg + r) * 2048 + head * 256 + p * 128 + 16 * ks + 8 * h); } };
struct QSrcLds { const LAS unsigned char* qt; int row0; DI bf16x8 frag(int p, int ks, int r, int h) const { const int row = row0 + r; return *(const LAS bf16x8*)(qt + row * 512 + (((p * 16 + 2 * ks + h) ^ (row & 15)) << 4)); } };
template <class QS> DI void peer_scores(const QS& qsrc, int head, const bf16* SUBK, unsigned* ent  , int lane) {
    const int r = lane & 31, h = lane >> 5;
    int L1[16], L2[16];
#pragma unroll
    for (int p = 0; p < 2; ++p) {
        bf16x8 qf[8];
#pragma unroll
        for (int ks = 0; ks < 8; ++ks) qf[ks] = qsrc.frag(p, ks, r, h);
        const bf16* sk = SUBK + (size_t)((head * 2 + p) * 128 + r) * 128 + 8 * h;
        int L[16];
#pragma unroll
        for (int i = 0; i < 16; ++i) L[i] = KEY_MIN;
        bf16x8 af[8];
#pragma unroll
        for (int ks = 0; ks < 8; ++ks) af[ks] = ld16g(sk + 16 * ks);
#pragma unroll 1
        for (int mt = 0; mt < 4; ++mt) {
            f32x16 acc;
#pragma unroll
            for (int i = 0; i < 16; ++i) acc[i] = 0.f;
#pragma unroll
            for (int ks = 0; ks < 8; ++ks) acc = MFMA32(af[ks], qf[ks], acc);
            if (mt < 3) {
#pragma unroll
                for (int ks = 0; ks < 8; ++ks) af[ks] = ld16g(sk + (size_t)(mt + 1) * 32 * 128 + 16 * ks); }
            int Nw[16];
#pragma unroll
            for (int i = 0; i < 16; ++i) Nw[i] = (f_ord(acc[i]) & ~127) | (32 * mt + crow(i, h));
            sort16_desc(Nw); merge16_desc(L, Nw);
        }
        int Pn[16];
#pragma unroll
        for (int i = 0; i < 16; ++i) Pn[i] = px32(L[i], lane);
        merge16_desc(L, Pn);
#pragma unroll
        for (int i = 0; i < 16; ++i) { if (p == 0) L1[i] = L[i]; else L2[i] = L[i]; }
    }
    float s1[16], s2[16]; int a1[16], a2[16];
#pragma unroll
    for (int i = 0; i < 16; ++i) { s1[i] = f_unord(L1[i] & ~127); s2[i] = f_unord(L2[i] & ~127); a1[i] = (L1[i] & 127) << 7; a2[i] = L2[i] & 127; }
    int Cn[16];
    PEER_CAND_CHUNK(Cn, 0); sort16_desc(Cn);
#pragma unroll
    for (int c = 1; c < 4; ++c) { int Dn[16]; PEER_CAND_CHUNK(Dn, c); sort16_desc(Dn); merge16_desc(Cn, Dn); }
    float e[16]; float sum = 0.f; const float m0 = f_unord(Cn[0] & ~0x3fff);
#pragma unroll
    for (int k = 0; k < 16; ++k) { e[k] = __builtin_amdgcn_exp2f((f_unord(Cn[k] & ~0x3fff) - m0) * LOG2E); sum += e[k]; }
    const float inv = 1.0f / sum;
    if (h == 0) { unsigned* dst = ent + (size_t)r * 128 + head * 16;
#pragma unroll
        for (int g4 = 0; g4 < 4; ++g4) { v4u w;
            w.x = (cvtpk2(0.f, e[4 * g4] * inv) & 0xffff0000u) | (unsigned)(Cn[4 * g4] & 0x3fff); w.y = (cvtpk2(0.f, e[4 * g4 + 1] * inv) & 0xffff0000u) | (unsigned)(Cn[4 * g4 + 1] & 0x3fff);
            w.z = (cvtpk2(0.f, e[4 * g4 + 2] * inv) & 0xffff0000u) | (unsigned)(Cn[4 * g4 + 2] & 0x3fff); w.w = (cvtpk2(0.f, e[4 * g4 + 3] * inv) & 0xffff0000u) | (unsigned)(Cn[4 * g4 + 3] & 0x3fff);
            *(v4u*)(dst + 4 * g4) = w; } }
}
typedef float f32x2 __attribute__((ext_vector_type(2)));
DI f32x2 fp8lo(unsigned w) { return __builtin_amdgcn_cvt_pk_f32_fp8((int)w, false); }
DI f32x2 fp8hi(unsigned w) { return __builtin_amdgcn_cvt_pk_f32_fp8((int)w, true); }
DI f32x2 fma2(f32x2 a, f32x2 b, f32x2 c) { float x = c.x, y = c.y; asm("v_fmac_f32 %0, %1, %2" : "+v"(x) : "v"(a.x), "v"(b.x)); asm("v_fmac_f32 %0, %1, %2" : "+v"(y) : "v"(a.y), "v"(b.y)); return (f32x2){x, y}; }
constexpr int PU_LIST = 0, PU_H = 65536, PU_USC = 98304, PU_VSC = 106496, PU_BC = 114688, PU_LCAP = 160;
template <int VAR> DI void peer_u_issue(v4u (&rw)[16], const unsigned char* U8, const LAS unsigned* lev, int lane) {
#pragma unroll
    for (int k4 = 0; k4 < 4; ++k4) { const v4u ev = *(const LAS v4u*)(lev + 4 * k4);
#pragma unroll
        for (int k = 0; k < 4; ++k) rw[4 * k4 + k] = *(const v4u*)(U8 + (size_t)(ev[k] & 0x3fffu) * 1024 + 16 * lane); }
}
template <int VAR> DI void peer_u_compute(const v4u (&rw)[16], const LAS unsigned char* hrow, float hs, const LAS unsigned* lev, const LAS unsigned* lslot, int nvalid, int tok, const LAS float* uscs, const LAS float* vscs, float* ACT, int lane) {
    const v4u hq = *(const LAS v4u*)(hrow + 16 * lane);
    int p[16];
#pragma unroll
    for (int k = 0; k < 16; ++k) { int a = __builtin_amdgcn_sdot4((int)rw[k].x, (int)hq.x, 0, false); a = __builtin_amdgcn_sdot4((int)rw[k].y, (int)hq.y, a, false); a = __builtin_amdgcn_sdot4((int)rw[k].z, (int)hq.z, a, false); p[k] = __builtin_amdgcn_sdot4((int)rw[k].w, (int)hq.w, a, false); }
    { const bool up = (lane & 8) != 0;
#pragma unroll
      for (int i = 0; i < 8; ++i) { const int keep = up ? p[i + 8] : p[i], send = up ? p[i] : p[i + 8]; p[i] = keep + dppi<DPP_RM>(send); } }
    { const bool up = (lane & 4) != 0;
#pragma unroll
      for (int i = 0; i < 4; ++i) { const int keep = up ? p[i + 4] : p[i], send = up ? p[i] : p[i + 4]; p[i] = keep + dppi<DPP_HM>(send); } }
    { const bool up = (lane & 2) != 0;
#pragma unroll
      for (int i = 0; i < 2; ++i) { const int keep = up ? p[i + 2] : p[i], send = up ? p[i] : p[i + 2]; p[i] = keep + dppi<DPP_X2>(send); } }
    { const bool up = (lane & 1) != 0; const int keep = up ? p[1] : p[0], send = up ? p[0] : p[1]; p[0] = keep + dppi<DPP_X1>(send); }
    int dq = p[0];
    { auto r = __builtin_amdgcn_permlane16_swap((unsigned)dq, (unsigned)dq, false, false); dq = (int)r[0] + (int)r[1]; }
    { auto r = __builtin_amdgcn_permlane32_swap((unsigned)dq, (unsigned)dq, false, false); dq = (int)r[0] + (int)r[1]; }
    const int myk = lane & 15;
    if (lane < 16 && myk < nvalid) { const unsigned mev = lev[myk], mslot = lslot[myk]; const unsigned er = mev & 2047u;
        const float w_ = gelu_tanh((float)dq * hs * uscs[er]) * __uint_as_float(mev & 0xffff0000u) * vscs[er];
        ((unsigned*)ACT)[(VAR == 1) ? (size_t)lane : ((size_t)tok * 128 + mslot)] = (cvtpk2(0.f, w_) & 0xffff0000u) | (mev & 0x3fffu); }
}
DI void peer_u_loade(int tok, const unsigned* ENT, unsigned (&e0)[4], unsigned (&e1)[4], int lane) {
#pragma unroll
    for (int t = 0; t < 4; ++t) { e0[t] = ENT[(size_t)(tok + t) * 128 + lane]; e1[t] = ENT[(size_t)(tok + t) * 128 + 64 + lane]; }
}
template <int VAR> DI void peer_u_wave(int tok0, int slab, const unsigned* ENT, const unsigned char* HQ, const float* HS, const unsigned char* U8, float* ACT, LAS unsigned char* lds, int wave, int lane) {
    LAS unsigned* lev = (LAS unsigned*)(lds + PU_LIST + wave * 8192); LAS unsigned* lslot = lev + 4 * PU_LCAP; LAS unsigned char* hb = lds + PU_H + wave * 4096;
    const LAS float* uscs = (const LAS float*)(lds + PU_USC); const LAS float* vscs = (const LAS float*)(lds + PU_VSC);
    unsigned e0[4], e1[4];
    peer_u_loade(tok0, ENT, e0, e1, lane);
#pragma unroll 1
    for (int bt = 0; bt < 4; ++bt) { const int tb = tok0 + 4 * bt;
        v4u hq[4]; float hsv[4];
#pragma unroll
        for (int t = 0; t < 4; ++t) { hq[t] = *(const v4u*)(HQ + (size_t)(tb + t) * 1024 + 16 * lane); hsv[t] = HS[tb + t]; }
        int cnt[4]; const unsigned long long lt = (1ull << lane) - 1ull;
#pragma unroll
        for (int t = 0; t < 4; ++t) { const bool in0 = ((e0[t] >> 11) & 7u) == (unsigned)slab, in1 = ((e1[t] >> 11) & 7u) == (unsigned)slab;
            const unsigned long long b0 = __ballot(in0), b1 = __ballot(in1); const int n0 = __builtin_popcountll(b0), n = n0 + __builtin_popcountll(b1);
            LAS unsigned* le = lev + t * PU_LCAP; LAS unsigned* ls = lslot + t * PU_LCAP;
            if (in0) { const int p = __builtin_popcountll(b0 & lt); le[p] = e0[t]; ls[p] = (unsigned)lane; }
            if (in1) { const int p = n0 + __builtin_popcountll(b1 & lt); le[p] = e1[t]; ls[p] = (unsigned)(64 + lane); }
            if (n > 0 && lane < 16) { const unsigned pe = b0 ? (unsigned)__builtin_amdgcn_readlane((int)e0[t], (int)__builtin_ctzll(b0 | (1ull << 63))) : (unsigned)__builtin_amdgcn_readlane((int)e1[t], (int)__builtin_ctzll(b1 | (1ull << 63)));
                if (n + lane < ((n + 15) & ~15)) le[n + lane] = pe; }
            cnt[t] = n; }
        if (bt < 3) peer_u_loade(tb + 4, ENT, e0, e1, lane);
#pragma unroll
        for (int t = 0; t < 4; ++t) *(LAS v4u*)(hb + t * 1024 + 16 * lane) = hq[t];
        asm volatile("s_waitcnt lgkmcnt(0)" ::: "memory");
#define PU_CNT(t_) ((t_) == 0 ? cnt[0] : ((t_) == 1 ? cnt[1] : ((t_) == 2 ? cnt[2] : cnt[3])))
#define PU_HS(t_) ((t_) == 0 ? hsv[0] : ((t_) == 1 ? hsv[1] : ((t_) == 2 ? hsv[2] : hsv[3])))
#define PU_ADV(tk_, g_) do { while ((tk_) < 4 && (g_) >= PU_CNT(tk_)) { ++(tk_); (g_) = 0; } } while (0)
        int tk = 0, g = 0; PU_ADV(tk, g);
        if (tk < 4) { v4u ra[16], rb[16];
            peer_u_issue<VAR>(ra, U8, lev + tk * PU_LCAP + g, lane);
            for (;;) {
                int ntk = tk, ng = g + 16; PU_ADV(ntk, ng);
                if (ntk < 4) peer_u_issue<VAR>(rb, U8, lev + ntk * PU_LCAP + ng, lane);
                peer_u_compute<VAR>(ra, hb + tk * 1024, PU_HS(tk), lev + tk * PU_LCAP + g, lslot + tk * PU_LCAP + g, PU_CNT(tk) - g, tb + tk, uscs, vscs, ACT, lane);
                tk = ntk; g = ng; if (tk >= 4) break;
                ntk = tk; ng = g + 16; PU_ADV(ntk, ng);
                if (ntk < 4) peer_u_issue<VAR>(ra, U8, lev + ntk * PU_LCAP + ng, lane);
                peer_u_compute<VAR>(rb, hb + tk * 1024, PU_HS(tk), lev + tk * PU_LCAP + g, lslot + tk * PU_LCAP + g, PU_CNT(tk) - g, tb + tk, uscs, vscs, ACT, lane);
                tk = ntk; g = ng; if (tk >= 4) break;
            } }
#undef PU_CNT
#undef PU_HS
#undef PU_ADV
        asm volatile("s_waitcnt lgkmcnt(0)" ::: "memory");
    }
}
template <int VVAR> DI void peer_v_wave(int tok0, int slab, const unsigned* ENT, const float* ACT, const unsigned char* V8slab, bf16* XB, float* XF, const float* g2, int lane) {
    const int sub = lane & 7, j = lane >> 3; const unsigned* WP = (const unsigned*)ACT;
    const int col = 128 * slab + 16 * sub + 2 * (4 * ((lane >> 5) & 1) + 2 * ((lane >> 4) & 1) + ((lane >> 3) & 1));
    const f32x2 gv = *(const f32x2*)(g2 + (tok0 >> 13) * 6144 + col);
    v4u enn[4]; unsigned xvn;
    { const v4u* ep = (const v4u*)(WP + (size_t)tok0 * 128 + 16 * j);
#pragma unroll
      for (int q = 0; q < 4; ++q) enn[q] = ep[q];
      xvn = *(const unsigned*)(XB + (size_t)tok0 * 1024 + col); }
#pragma unroll 1
    for (int it = 0; it < 8; ++it) { const int tok = tok0 + it;
        v4u en[4]; const f32x2 xv = (f32x2){bf_lo(xvn), bf_hi(xvn)};
#pragma unroll
        for (int q = 0; q < 4; ++q) en[q] = enn[q];
        v4u rw[16];
#pragma unroll
        for (int i = 0; i < 16; ++i) rw[i] = *(const v4u*)(V8slab + (size_t)(en[i >> 2][i & 3] & 0x3fffu) * 128 + 16 * sub);
        if (it < 7) { const v4u* ep = (const v4u*)(WP + (size_t)(tok + 1) * 128 + 16 * j);
#pragma unroll
            for (int q = 0; q < 4; ++q) enn[q] = ep[q];
            xvn = *(const unsigned*)(XB + (size_t)(tok + 1) * 1024 + col); }
        unsigned wmb = 0u;
#pragma unroll
        for (int q = 0; q < 4; ++q) { wmb = max(wmb, max(max(en[q][0] & 0x7fff0000u, en[q][1] & 0x7fff0000u), max(en[q][2] & 0x7fff0000u, en[q][3] & 0x7fff0000u))); }
        wmb = max(wmb, (unsigned)dppi<DPP_R8>((int)wmb)); wmb = max(wmb, px16u(wmb, lane)); wmb = max(wmb, px32u(wmb, lane));
        const float wm = __uint_as_float(wmb); const float wsq = wm > 0.f ? 127.0f / wm : 0.f, winv = wm * (1.0f / 127.0f);
        f32x4 aw[4];
#pragma unroll
        for (int q = 0; q < 4; ++q) aw[q] = (f32x4){__uint_as_float(en[q][0] & 0xffff0000u), __uint_as_float(en[q][1] & 0xffff0000u), __uint_as_float(en[q][2] & 0xffff0000u), __uint_as_float(en[q][3] & 0xffff0000u)};
        unsigned W[4];
#pragma unroll
        for (int q = 0; q < 4; ++q) { const int q0 = __float2int_rn(aw[q][0] * wsq), q1 = __float2int_rn(aw[q][1] * wsq), q2 = __float2int_rn(aw[q][2] * wsq), q3 = __float2int_rn(aw[q][3] * wsq);
            W[q] = (unsigned)(q0 & 255) | ((unsigned)(q1 & 255) << 8) | ((unsigned)(q2 & 255) << 16) | ((unsigned)(q3 & 255) << 24); }
        int acc[16];
#pragma unroll
        for (int c = 0; c < 16; ++c) acc[c] = 0;
#pragma unroll
        for (int g = 0; g < 4; ++g)
#pragma unroll
            for (int q = 0; q < 4; ++q) { const unsigned m0 = rw[4 * g][q], m1 = rw[4 * g + 1][q], m2 = rw[4 * g + 2][q], m3 = rw[4 * g + 3][q];
                const unsigned t0 = __builtin_amdgcn_perm(m1, m0, 0x05010400u), t1 = __builtin_amdgcn_perm(m1, m0, 0x07030602u), t2 = __builtin_amdgcn_perm(m3, m2, 0x05010400u), t3 = __builtin_amdgcn_perm(m3, m2, 0x07030602u);
                acc[4 * q] = __builtin_amdgcn_sdot4((int)__builtin_amdgcn_perm(t2, t0, 0x05040100u), (int)W[g], acc[4 * q], false);
                acc[4 * q + 1] = __builtin_amdgcn_sdot4((int)__builtin_amdgcn_perm(t2, t0, 0x07060302u), (int)W[g], acc[4 * q + 1], false);
                acc[4 * q + 2] = __builtin_amdgcn_sdot4((int)__builtin_amdgcn_perm(t3, t1, 0x05040100u), (int)W[g], acc[4 * q + 2], false);
                acc[4 * q + 3] = __builtin_amdgcn_sdot4((int)__builtin_amdgcn_perm(t3, t1, 0x07060302u), (int)W[g], acc[4 * q + 3], false); }
        { const bool up = (lane & 32) != 0;
#pragma unroll
          for (int c = 0; c < 8; ++c) { const int keep = up ? acc[c + 8] : acc[c], send = up ? acc[c] : acc[c + 8]; acc[c] = keep + px32(send, lane); } }
        { const bool up = (lane & 16) != 0;
#pragma unroll
          for (int c = 0; c < 4; ++c) { const int keep = up ? acc[c + 4] : acc[c], send = up ? acc[c] : acc[c + 4]; acc[c] = keep + (int)px16u((unsigned)send, lane); } }
        { const bool up = (lane & 8) != 0;
#pragma unroll
          for (int c = 0; c < 2; ++c) { const int keep = up ? acc[c + 2] : acc[c], send = up ? acc[c] : acc[c + 2]; acc[c] = keep + dppi<DPP_R8>(send); } }
        { const float y0 = xv.x + gv.x * ((float)acc[0] * winv), y1 = xv.y + gv.y * ((float)acc[1] * winv);
          if (XF) *(f32x2*)(XF + (size_t)tok * 1024 + col) = (f32x2){y0, y1}; else *(unsigned*)(XB + (size_t)tok * 1024 + col) = cvtpk2(y0, y1); }
    }
}
struct PeerT { const unsigned char *U8, *V8s; const float *USC, *VSC; unsigned* ENT; float* ACT; const unsigned char* HQ; const float* HS; bf16* XB; float* XF; const float* g2; };
DI void peer_scores_phase(const Frame& F, const bf16* QP, const bf16* SUBK, unsigned* ENT) {
    for (int unit = blockIdx.x; unit < MROWS / 64; unit += F.G) {
#pragma unroll 1
        for (int grp = 0; grp < 2; ++grp) { const int tokg = unit * 64 + 32 * grp; QSrcGlobal qs{QP, tokg, F.wave}; peer_scores(qs, F.wave, SUBK, ENT + (size_t)tokg * 128, F.lane); } }
}
template <int PASS, int VAR = 0> DI void peer_gather_phase(const Frame& F, int cnt_base, const PeerT& T) {
    const int xcc = XCC_EXPR; LAS int* bc = (LAS int*)(F.lds + PU_BC);
    constexpr int CHT = (PASS == 0) ? 128 : 64;
    for (int k = 0; k < 8; ++k) { const int s = (xcc + k) & 7; unsigned* cnt = (unsigned*)(F.ctl + CW_WORK + 64 * (cnt_base + s));
        if (PASS == 0) { for (int i = F.tid; i < 2048; i += NTHR) { ((LAS float*)(F.lds + PU_USC))[i] = T.USC[2048 * s + i]; ((LAS float*)(F.lds + PU_VSC))[i] = T.VSC[2048 * s + i]; } }
        for (;;) {
            if (F.tid == 0) *bc = (int)__hip_atomic_fetch_add(cnt, 1u, __ATOMIC_RELAXED, __HIP_MEMORY_SCOPE_AGENT);
            __syncthreads(); const int chunk = *bc; __syncthreads();
            if (chunk >= MROWS / CHT) break;
            if (PASS == 0) peer_u_wave<VAR>(chunk * 128 + F.wave * 16, s, T.ENT, T.HQ, T.HS, T.U8, T.ACT, F.lds, F.wave, F.lane);
            else peer_v_wave<VAR>(chunk * 64 + F.wave * 8, s, T.ENT, T.ACT, T.V8s + (size_t)s * 16384 * 128, T.XB, T.XF, T.g2, F.lane);
        } }
}

namespace pg8 {
struct EpiQScores {
    static constexpr bool PERM = true, AFTER_DRAIN = true;
    const bf16_t* SUBK; unsigned* ENT; int head0;
    __device__ __forceinline__ void operator()(const f32x4 (&)[2][2][4][2], const Unit&, int, int, int, int) const {}
    __device__ __forceinline__ void fused(f32x4 (&acc)[2][2][4][2], const Unit& u, int wr, int wc, int fr, int fq, PG8_LAS unsigned char* lds, int wid, int lane) const {
#pragma unroll
        for (int ai = 0; ai < 2; ++ai)
#pragma unroll
            for (int m = 0; m < 4; ++m) { const int row = ai * HALF + wr * 64 + m * 16 + fr;
#pragma unroll
                for (int bj = 0; bj < 2; ++bj) { const f32x4 v0 = acc[ai][bj][m][0], v1 = acc[ai][bj][m][1]; u32x4 w; w.x = cvtpk2(v0[0], v0[1]); w.y = cvtpk2(v0[2], v0[3]); w.z = cvtpk2(v1[0], v1[1]); w.w = cvtpk2(v1[2], v1[3]);
                    const int chunk = 16 * bj + 4 * wc + fq; *(PG8_LAS u32x4*)(lds + row * 512 + ((chunk ^ (row & 15)) << 4)) = w; } }
        asm volatile("s_waitcnt lgkmcnt(0)" ::: "memory"); __builtin_amdgcn_s_barrier(); asm volatile("" ::: "memory");
        const QSrcLds qs{(const LAS unsigned char*)lds, 32 * wid};
        peer_scores(qs, head0 + u.pn, (const bf16*)SUBK, ENT + (size_t)(u.pm * BM + 32 * wid) * 128, lane);
    }
};
}
struct Args { const float* in[19]; float* out; unsigned char* ws; int stage, pad; };
__global__ void __launch_bounds__(NTHR, 2) hybrid_fwd(Args args) {
    extern __shared__ __attribute__((aligned(16))) unsigned char lds_raw[];
    for (int u = threadIdx.x; u < (LDS_BYTES - LDSCTL_OFF) / 4; u += NTHR) ((LAS unsigned*)((LAS unsigned char*)lds_raw + LDSCTL_OFF))[u] = 0u;
    __syncthreads();
    XcdBarrier bar = xcd_barrier_post((unsigned*)((gu32*)(args.ws + WS_CTL) + CW_BAR), (volatile LAS unsigned*)((LAS unsigned char*)lds_raw + MISC_OFF) + 8);
#ifdef PROBE_MASK
    volatile LAS unsigned long long* stamps_ = (volatile LAS unsigned long long*)((LAS unsigned char*)lds_raw + MISC_OFF + 256); int nst_ = 0;
#ifndef PROBE_BLK
#define PROBE_BLK 0
#endif
#define STAMP() do { if (blockIdx.x == PROBE_BLK && threadIdx.x == 0) stamps_[nst_] = __builtin_amdgcn_s_memrealtime(); ++nst_; } while (0)
#else
#define STAMP() do {} while (0)
#endif
    STAMP();
#define GRID_BAR() do { xcd_barrier(bar); STAMP(); } while (0)
#define OPQ(p) ({ size_t z_ = 0; asm volatile("" : "+s"(z_)); (p) + z_; })
#define PH_PTRS \
    unsigned char* ws = OPQ(args.ws); const float* x_in = OPQ(args.in[0]); float* X = OPQ(args.out); \
    const float *norm_mix = args.in[4], *norm_ffn = args.in[5]; \
    float* MOD = (float*)(ws + WS_MOD); float* ROPE = (float*)(ws + WS_ROPE); float* KSUM = (float*)(ws + WS_KSUM); \
    bf16 *WIN0 = (bf16*)(ws + WS_WIN0), *WOUT0 = (bf16*)(ws + WS_WOUT0), *WIN1 = (bf16*)(ws + WS_WIN1), *WOUT1 = (bf16*)(ws + WS_WOUT1), *WQ0 = (bf16*)(ws + WS_WQ0), *WQ1 = (bf16*)(ws + WS_WQ1); \
    bf16 *SUBK = (bf16*)(ws + WS_SUBK), *GWS = (bf16*)(ws + WS_GWS), *HN = (bf16*)(ws + WS_HN); \
    bf16 *UA = (bf16*)(ws + WS_A), *VA = (bf16*)(ws + WS_A + 16 * MiB), *Q0 = (bf16*)(ws + WS_A + 32 * MiB), *K0 = (bf16*)(ws + WS_A + 48 * MiB), *VT0 = (bf16*)(ws + WS_A + 64 * MiB); \
    bf16 *Q1 = (bf16*)(ws + WS_A), *K1 = (bf16*)(ws + WS_A + 32 * MiB), *VT1 = (bf16*)(ws + WS_A + 64 * MiB); \
    bf16 *YCAT = (bf16*)(ws + WS_YCAT), *QP = (bf16*)(ws + WS_QP), *PO = (bf16*)(ws + WS_PO); float* PL = (float*)(ws + WS_PL); unsigned* MASKS = (unsigned*)(ws + WS_MASK); unsigned char *U8 = ws + WS_PTU, *V8s = ws + WS_PTV; float *USC = (float*)(ws + WS_SC), *VSC = USC + 32768; unsigned* ENT = (unsigned*)(ws + WS_PO); float* ACT = (float*)(ws + WS_PO + 8 * MiB); unsigned char* HQ = ws + WS_A; float* HS = (float*)(ws + WS_SC + 512 * 1024); (void)HQ; (void)HS; bf16* XB = (bf16*)(ws + WS_XB); (void)XB; (void)U8; (void)V8s; (void)USC; (void)VSC; (void)ENT; (void)ACT; bf16* QKR = (bf16*)(ws + WS_QP); (void)QKR; \
    (void)x_in; (void)X; (void)norm_mix; (void)norm_ffn; (void)MOD; (void)ROPE; (void)KSUM; (void)WIN0; (void)WOUT0; (void)WIN1; (void)WOUT1; (void)WQ0; (void)WQ1; (void)SUBK; (void)GWS; (void)HN; \
    (void)UA; (void)VA; (void)Q0; (void)K0; (void)VT0; (void)Q1; (void)K1; (void)VT1; (void)YCAT; (void)QP; (void)PO; (void)PL; (void)MASKS;
#define PH_FRAME Frame F; F.lds = (LAS unsigned char*)lds_raw; F.MISC = (volatile LAS unsigned*)(F.lds + MISC_OFF); { int t_ = threadIdx.x; asm volatile("" : "+v"(t_)); F.tid = t_; } F.lane = F.tid & 63; F.wave = __builtin_amdgcn_readfirstlane(F.tid >> 6); \
    F.G = gridDim.x; F.gw = blockIdx.x * NWAVES + F.wave; F.NGW = F.G * NWAVES; F.ctl = (gu32*)(OPQ(args.ws) + WS_CTL);
    { PH_FRAME PH_PTRS
      P0Args A; A.c = args.in[1]; A.w_mod = args.in[2]; A.b_mod = args.in[3]; A.win0 = args.in[6]; A.wout0 = args.in[12]; A.win1 = args.in[13]; A.wout1 = args.in[14]; A.wq = args.in[15]; A.subk = args.in[16];
      A.pu = args.in[17]; A.pv = args.in[18]; A.gws = args.in[8]; A.MOD = MOD; A.ROPE = ROPE; A.WIN0 = WIN0; A.WOUT0 = WOUT0; A.WIN1 = WIN1; A.WOUT1 = WOUT1; A.WQ0 = WQ0; A.WQ1 = WQ1; A.SUBK = SUBK; A.GWS = GWS; A.U8 = U8; A.V8s = V8s; A.USC = USC; A.VSC = VSC;
      p0_prologue(F, A); }
    GRID_BAR();
    { PH_FRAME PH_PTRS norm_rows<true>(F, x_in, norm_mix, MOD, 0, 1, HN); }
    GRID_BAR();
    { PH_FRAME PH_PTRS
      pg8::Gemm g{HN, WIN0, MROWS, 2048, 1024}; pg8::StaticOrder S; S.init(MROWS, 2048, F.G, (int)blockIdx.x);
      pg8::EpiL0m E{UA, VA, QKR};
      pg8::gemm_phase<pg8::EpiL0m, pg8::StaticOrder, true, true>(F.lds, g, S, E); }
    { PH_FRAME PH_PTRS
      pg8::Gemm g{WIN0 + (size_t)2048 * 1024, HN, 512, MROWS, 1024}; pg8::StaticOrder S; S.init(512, MROWS, F.G, (int)blockIdx.x);
      pg8::EpiVT E{VT0, 512};
      pg8::gemm_phase<pg8::EpiVT, pg8::StaticOrder, true, true>(F.lds, g, S, E); }
    GRID_BAR();
    { PH_FRAME PH_PTRS
      for (int t = blockIdx.x; t < 256; t += F.G) qk_post_task(t, QKR, Q0, K0, KSUM, ROPE, args.in[10], args.in[11], (LAS float*)F.lds, F.tid, F.wave, F.lane);
      for (int u = blockIdx.x; u < 512; u += F.G) gmlp_unit(u, UA, VA, args.in[7], GWS, args.in[9], YCAT, F.lds, F.tid, F.wave, F.lane); }
    GRID_BAR();
    { PH_FRAME PH_PTRS
      MobaT T{Q0, K0, VT0, KSUM, MASKS, PO, PL, args.in[10], args.in[11]}; const float mc2 = moba_mc2(args.in[10], args.in[11], F.lane);
      for (int u = F.gw; u < 4096; u += F.NGW) moba_mask_unit(u, T, F.lane); (void)mc2; }
    GRID_BAR();
    { PH_FRAME PH_PTRS
      MobaT T{Q0, K0, VT0, KSUM, MASKS, PO, PL, args.in[10], args.in[11]}; const float mc2 = moba_mc2(args.in[10], args.in[11], F.lane);
      LAS int* bc = (LAS int*)(F.lds + MS_CNT + 64);
      for (;;) { if (F.tid == 0) *bc = (int)__hip_atomic_fetch_add((unsigned*)(F.ctl + CW_WORK), 1u, __ATOMIC_RELAXED, __HIP_MEMORY_SCOPE_AGENT);
          __syncthreads(); const int task = *bc; __syncthreads(); if (task >= MOBA_NTASK) break;
          moba_sel_task(task, T, F.lds, mc2, F.tid, F.wave, F.lane); } }
    GRID_BAR();
    { PH_FRAME PH_PTRS moba_combine(F, PO, PL, YCAT); }
    GRID_BAR();
    { PH_FRAME PH_PTRS
      pg8::Gemm g{YCAT, WOUT0, MROWS, 1024, 1024}; pg8::StaticOrder S; S.init(MROWS, 1024, F.G, (int)blockIdx.x);
      pg8::EpiRes<true> E{x_in, XB, MOD + 2 * 1024};
      pg8::gemm_phase<pg8::EpiRes<true>, pg8::StaticOrder, true, true>(F.lds, g, S, E); }
    GRID_BAR();
    { PH_FRAME PH_PTRS norm_rows<false>(F, XB, norm_ffn, MOD, 3, 4, HN, HQ, HS); }
    GRID_BAR();
    { PH_FRAME PH_PTRS
      { pg8::Gemm g{HN, WQ0, MROWS, 1024, 1024}; pg8::StaticOrder S; S.init(MROWS, 1024, F.G, (int)blockIdx.x); pg8::EpiQScores E{SUBK, ENT, 0};
        pg8::gemm_phase<pg8::EpiQScores, pg8::StaticOrder, false, true>(F.lds, g, S, E); }
      __syncthreads();
      { pg8::Gemm g{HN, WQ0 + (size_t)1024 * 1024, MROWS, 1024, 1024}; pg8::StaticOrder S; S.init(MROWS, 1024, F.G, (int)blockIdx.x); pg8::EpiQScores E{SUBK, ENT, 4};
        pg8::gemm_phase<pg8::EpiQScores, pg8::StaticOrder, false, true>(F.lds, g, S, E); } }
    GRID_BAR();
    { PH_FRAME PH_PTRS PeerT T{U8, V8s, USC, VSC, ENT, ACT, HQ, HS, XB, nullptr, MOD + 5 * 1024}; peer_gather_phase<0>(F, 1, T); }
    GRID_BAR();
#ifdef XVAR
    { PH_FRAME PH_PTRS PeerT T{U8, V8s, USC, VSC, ENT, (float*)(ws + WS_PL), HQ, HS, XB, nullptr, MOD + 5 * 1024}; peer_gather_phase<0, XVAR>(F, 40, T); }
    GRID_BAR();
#endif
    { PH_FRAME PH_PTRS PeerT T{U8, V8s, USC, VSC, ENT, ACT, HQ, HS, XB, nullptr, MOD + 5 * 1024}; peer_gather_phase<1>(F, 9, T); }
    GRID_BAR();
#ifdef XVVAR
    { PH_FRAME PH_PTRS PeerT T{U8, V8s, USC, VSC, ENT, ACT, HQ, HS, XB, (float*)(ws + WS_QP), MOD + 5 * 1024}; peer_gather_phase<1, XVVAR>(F, 48, T); }
    GRID_BAR();
#endif
    { PH_FRAME PH_PTRS norm_rows<false>(F, XB, norm_mix + 1024, MOD + 2 * 6144, 0, 1, HN); }
    GRID_BAR();
    { PH_FRAME PH_PTRS
      pg8::Gemm g{HN, WIN1, MROWS, 2048, 1024}; pg8::StaticOrder S; S.init(MROWS, 2048, F.G, (int)blockIdx.x);
      pg8::EpiHeads E{Q1, K1, 16, 0.125f};
      pg8::gemm_phase<pg8::EpiHeads, pg8::StaticOrder, true, true>(F.lds, g, S, E); }
    { PH_FRAME PH_PTRS
      pg8::Gemm g{WIN1 + (size_t)2048 * 1024, HN, 1024, MROWS, 1024}; pg8::StaticOrder S; S.init(1024, MROWS, F.G, (int)blockIdx.x);
      pg8::EpiVT E{VT1, 1024};
      pg8::gemm_phase<pg8::EpiVT, pg8::StaticOrder, true, true>(F.lds, g, S, E); }
    GRID_BAR();
    { PH_FRAME PH_PTRS for (int u = blockIdx.x; u < 1024; u += F.G) sb_wg_unit(u, Q1, K1, VT1, YCAT, F.lds, F.tid, F.wave, F.lane); }
    GRID_BAR();
    { PH_FRAME PH_PTRS
      pg8::Gemm g{YCAT, WOUT1, MROWS, 1024, 1024}; pg8::StaticOrder S; S.init(MROWS, 1024, F.G, (int)blockIdx.x);
      pg8::EpiRes<false> E{nullptr, XB, MOD + 2 * 6144 + 2 * 1024};
      pg8::gemm_phase<pg8::EpiRes<false>, pg8::StaticOrder, true, true>(F.lds, g, S, E); }
    GRID_BAR();
    { PH_FRAME PH_PTRS norm_rows<false>(F, XB, norm_ffn + 1024, MOD + 2 * 6144, 3, 4, HN, HQ, HS); }
    GRID_BAR();
    { PH_FRAME PH_PTRS
      { pg8::Gemm g{HN, WQ1, MROWS, 1024, 1024}; pg8::StaticOrder S; S.init(MROWS, 1024, F.G, (int)blockIdx.x); pg8::EpiQScores E{SUBK + 262144, ENT, 0};
        pg8::gemm_phase<pg8::EpiQScores, pg8::StaticOrder, false, true>(F.lds, g, S, E); }
      __syncthreads();
      { pg8::Gemm g{HN, WQ1 + (size_t)1024 * 1024, MROWS, 1024, 1024}; pg8::StaticOrder S; S.init(MROWS, 1024, F.G, (int)blockIdx.x); pg8::EpiQScores E{SUBK + 262144, ENT, 4};
        pg8::gemm_phase<pg8::EpiQScores, pg8::StaticOrder, false, true>(F.lds, g, S, E); } }
    GRID_BAR();
    { PH_FRAME PH_PTRS PeerT T{U8 + (size_t)16384 * 1024, V8s + (size_t)16384 * 1024, USC + 16384, VSC + 16384, ENT, ACT, HQ, HS, XB, X, MOD + 2 * 6144 + 5 * 1024}; peer_gather_phase<0>(F, 17, T); }
    GRID_BAR();
    { PH_FRAME PH_PTRS PeerT T{U8 + (size_t)16384 * 1024, V8s + (size_t)16384 * 1024, USC + 16384, VSC + 16384, ENT, ACT, HQ, HS, XB, X, MOD + 2 * 6144 + 5 * 1024}; peer_gather_phase<1>(F, 25, T);
      if (__hip_atomic_load((gu32*)((unsigned*)(F.ctl + CW_BAR) + XB_TMO), RLX_AGENT) != 0u) { for (int m = F.gw; m < MROWS; m += F.NGW) X[(size_t)m * 1024 + F.lane] = __builtin_nanf(""); } }
#ifdef PROBE_MASK
#ifdef PROBE_BARS
    for (int i = 0; i < PROBE_BARS; ++i) xcd_barrier(bar);
#endif
    STAMP();
    if (blockIdx.x == PROBE_BLK && threadIdx.x == 0) { unsigned long long tsel = 0;
        for (int i = 0; i + 1 < nst_; ++i) if ((PROBE_MASK >> i) & 1ull) tsel += stamps_[i + 1] - stamps_[i];

        const unsigned long long t0 = __builtin_amdgcn_s_memrealtime(); while (__builtin_amdgcn_s_memrealtime() - t0 < tsel * PROBE_AMP) __builtin_amdgcn_s_sleep(8); }
#endif
}

extern "C" void kernel_launch(void* const* d_in, const int* in_sizes, int n_in, void* d_out, int out_size, void* d_ws, size_t ws_size, hipStream_t stream) {
    static int grid = 0;
    if (grid == 0) {
        if (n_in != 19 || out_size != MROWS * DM || ws_size < WS_END) { fprintf(stderr, "kernel_launch: unexpected shapes (n_in %d, out %d, ws %zu)\n", n_in, out_size, ws_size); grid = -1; return; }
        int dev = 0, cus = 0, per_cu = 0;
        if (hipGetDevice(&dev) != hipSuccess || hipDeviceGetAttribute(&cus, hipDeviceAttributeMultiprocessorCount, dev) != hipSuccess) { grid = -1; return; }
        if (hipFuncSetAttribute((const void*)hybrid_fwd, hipFuncAttributeMaxDynamicSharedMemorySize, LDS_BYTES) != hipSuccess) { fprintf(stderr, "kernel_launch: hipFuncSetAttribute failed\n"); grid = -1; return; }
        if (hipOccupancyMaxActiveBlocksPerMultiprocessor(&per_cu, (const void*)hybrid_fwd, NTHR, LDS_BYTES) != hipSuccess || per_cu < 1) { fprintf(stderr, "kernel_launch: occupancy query says %d\n", per_cu); per_cu = 1; }
        (void)hipGetLastError();
        grid = cus;
    }
    if (grid < 0) return;
    if (hipMemsetAsync((char*)d_ws + WS_CTL, 0, CTL_ZERO_BYTES, stream) != hipSuccess) { fprintf(stderr, "kernel_launch: memset failed\n"); return; }
    Args a{};
    for (int i = 0; i < 19; ++i) a.in[i] = (const float*)d_in[i];
    a.out = (float*)d_out; a.ws = (unsigned char*)d_ws; a.stage = 0; a.pad = 0;
    void* kargs[] = {&a};
    hipError_t e = hipLaunchCooperativeKernel((const void*)hybrid_fwd, dim3(grid), dim3(NTHR), kargs, LDS_BYTES, stream);
    if (e != hipSuccess) fprintf(stderr, "kernel_launch: cooperative launch failed: %s (grid %d)\n", hipGetErrorString(e), grid);
}
```
